# Optimizing an MI355X kernel written in HIP

```python
import jax, jax.numpy as jnp
from jax import lax
import numpy as np

D_MODEL = 1024
BATCH = 16
SEQ = 2048
DEPTH = 1

CTX_LEN = 256
GRID_W = 64
D_MIX = D_MODEL
LRU_W = D_MIX // 2
LRU_BLOCKS = 8
LRU_BD = LRU_W // LRU_BLOCKS
CONV_W = 4
CONV_PAD_L = 1
LRU_C = 8.0
HG_W = D_MIX - LRU_W
HG_HEADS = 4
HG_HD = HG_W // HG_HEADS
HG_CHUNK = 32
N_EXPERTS = 256
TOP_K = 8
N_GROUPS = 8
TOPK_GROUPS = 4
D_EXPERT = 256
D_SHARED = 256
ROUTE_SCALE = 2.5
MOE_BLOCK = 128
EPS = 1e-6
IN_COLS = 2 * LRU_W + 5 * HG_W
IN_SPLITS = [LRU_W, 2 * LRU_W, 2 * LRU_W + HG_W, 2 * LRU_W + 2 * HG_W, 2 * LRU_W + 3 * HG_W, 2 * LRU_W + 4 * HG_W]

kernel_name = 'hybrid_rglru_hgrn2_moe_dit_block'


def _rmsnorm(x, gain):
    xf = x.astype(jnp.float32)
    y = xf * lax.rsqrt(jnp.mean(xf * xf, axis=-1, keepdims=True) + EPS)
    return (y * gain.astype(jnp.float32)).astype(x.dtype)


def _to_colmajor(t):
    b, n, ch = t.shape
    rows = n // GRID_W
    return t.reshape(b, rows, GRID_W, ch).transpose(0, 2, 1, 3).reshape(b, n, ch)


def _from_colmajor(t):
    b, n, ch = t.shape
    rows = n // GRID_W
    return t.reshape(b, GRID_W, rows, ch).transpose(0, 2, 1, 3).reshape(b, n, ch)


def _dwconv_centred(t, w, bias):
    n = t.shape[1]
    tp = jnp.pad(t, ((0, 0), (CONV_PAD_L, CONV_W - 1 - CONV_PAD_L), (0, 0)))
    out = bias
    for k in range(CONV_W):
        out = out + tp[:, k:k + n] * w[k]
    return out


def _rglru_coeffs(u, wa, ba, wx, bx, lam):
    blocks = u.reshape(u.shape[:-1] + (LRU_BLOCKS, LRU_BD))
    r = jax.nn.sigmoid(jnp.einsum('blhi,hij->blhj', blocks, wa).reshape(u.shape) + ba)
    i = jax.nn.sigmoid(jnp.einsum('blhi,hij->blhj', blocks, wx).reshape(u.shape) + bx)
    log_a = -LRU_C * r * jax.nn.softplus(-lam)
    a = jnp.exp(log_a)
    b = jnp.sqrt(-jnp.expm1(2.0 * log_a)) * (i * u)
    return a, b


def _linear_scan(a, b, h0, reverse):
    if h0 is not None:
        first = b.shape[1] - 1 if reverse else 0
        b = b.at[:, first].add(a[:, first] * h0)

    def combine(e1, e2):
        a1, b1 = e1
        a2, b2 = e2
        return a1 * a2, a2 * b1 + b2

    _, h = lax.associative_scan(combine, (a, b), reverse=reverse, axis=1)
    return h


def _hgrn2_chunkwise(q, k, v, logf, s0):
    b, n, h, d = q.shape
    nc = n // HG_CHUNK

    def split(t):
        return t.reshape(b, nc, HG_CHUNK, h, d).transpose(1, 0, 3, 2, 4)

    q, k, v, logf = split(q), split(k), split(v), split(logf)
    g = jnp.cumsum(logf, axis=3)
    g_last = g[:, :, :, -1:, :]
    q_dec = q * jnp.exp(g)
    tri = jnp.tril(jnp.ones((HG_CHUNK, HG_CHUNK), dtype=bool))
    scores = jnp.einsum('nbhid,nbhjd->nbhij', q_dec, k * jnp.exp(-g))
    scores = jnp.where(tri, scores, 0.0)
    o_intra = jnp.einsum('nbhij,nbhje->nbhie', scores, v)
    kv = jnp.einsum('nbhjd,nbhje->nbhde', k * jnp.exp(g_last - g), v)
    decay = jnp.exp(g_last[:, :, :, 0, :])

    def step(s, inp):
        dec, kv_c = inp
        return dec[..., None] * s + kv_c, s

    s_final, s_prev = lax.scan(step, s0, (decay, kv))
    o = o_intra + jnp.einsum('nbhid,nbhde->nbhie', q_dec, s_prev)
    o = o.transpose(1, 0, 3, 2, 4).reshape(b, n, h, d)
    return o, s_final


def _hgrn2_direction(q, v, zf, lb, s0, reverse):
    b, n, _ = q.shape
    f32 = jnp.float32
    zf = zf.astype(f32)
    logf = jnp.log(lb + (1.0 - lb) * jax.nn.sigmoid(zf))
    k = (1.0 - lb) * jax.nn.sigmoid(-zf)

    def heads(t):
        return t.astype(f32).reshape(b, n, HG_HEADS, HG_HD)

    q, k, v, logf = heads(q), heads(k), heads(v), heads(logf)
    if reverse:
        q, k, v, logf = (jnp.flip(t, axis=1) for t in (q, k, v, logf))
    if s0 is None:
        s0 = jnp.zeros((b, HG_HEADS, HG_HD, HG_HD), f32)
    o, s = _hgrn2_chunkwise(q, k, v, logf, s0)
    if reverse:
        o = jnp.flip(o, axis=1)
    return o.reshape(b, n, HG_W), s


def _head_rmsnorm(o, gain):
    b, n, _ = o.shape
    oh = o.reshape(b, n, HG_HEADS, HG_HD)
    oh = oh * lax.rsqrt(jnp.mean(oh * oh, axis=-1, keepdims=True) + EPS)
    return oh.reshape(b, n, HG_W) * gain.astype(jnp.float32)


def _hybrid_mixer(hx, hc, w_in, w_out, conv_w, conv_b, wa, ba, wx, bx, lam, lb, head_gain, need_ctx):
    f32 = jnp.float32
    rx, rgx, qx, vx, fx_f, fx_b, gx = jnp.split(hx @ w_in, IN_SPLITS, axis=-1)
    rc, rgc, qc, vc, fc_f, fc_b, gc = jnp.split(hc @ w_in, IN_SPLITS, axis=-1)

    ul = _dwconv_centred(rx, conv_w, conv_b).astype(f32)
    uc = _dwconv_centred(rc, conv_w, conv_b).astype(f32)
    lru_l = jnp.zeros_like(ul)
    lru_c = jnp.zeros_like(uc)
    for d, rev in enumerate((False, True)):
        a, bb = _rglru_coeffs(uc, wa[d], ba[d], wx[d], bx[d], lam[d])
        h_c = _linear_scan(a, bb, None, rev)
        h0 = h_c[:, 0] if rev else h_c[:, -1]
        a, bb = _rglru_coeffs(ul, wa[d], ba[d], wx[d], bx[d], lam[d])
        lru_l = lru_l + _linear_scan(a, bb, h0, rev)
        lru_c = lru_c + h_c

    ql, vl, zl_f, zl_b = (_to_colmajor(t) for t in (qx, vx, fx_f, fx_b))
    hg_l = 0.0
    hg_c = 0.0
    for d, (zl, zc, rev) in enumerate(((zl_f, fc_f, False), (zl_b, fc_b, True))):
        o_c, s_c = _hgrn2_direction(qc, vc, zc, lb[d], None, rev)
        o_l, _ = _hgrn2_direction(ql, vl, zl, lb[d], s_c, rev)
        hg_l = hg_l + o_l
        hg_c = hg_c + o_c
    hg_l = _from_colmajor(hg_l)

    y_l = jnp.concatenate([jax.nn.gelu(rgx.astype(f32)) * lru_l,
                           _head_rmsnorm(hg_l, head_gain) * jax.nn.silu(gx.astype(f32))], axis=-1)
    y_l = y_l.astype(hx.dtype) @ w_out
    if not need_ctx:
        return y_l, None
    y_c = jnp.concatenate([jax.nn.gelu(rgc.astype(f32)) * lru_c,
                           _head_rmsnorm(hg_c, head_gain) * jax.nn.silu(gc.astype(f32))], axis=-1)
    y_c = y_c.astype(hc.dtype) @ w_out
    return y_l, y_c


def _moe(h, router_w, router_b, w13, w2, sw13, sw2):
    n, d = h.shape
    f32 = jnp.float32
    scores = jax.nn.sigmoid((h @ router_w).astype(f32))
    biased = scores + router_b.astype(f32)
    grouped = biased.reshape(n, N_GROUPS, N_EXPERTS // N_GROUPS)
    group_score = jnp.sum(lax.top_k(grouped, 2)[0], axis=-1)
    _, gidx = lax.top_k(group_score, TOPK_GROUPS)
    gmask = jnp.sum(jax.nn.one_hot(gidx, N_GROUPS, dtype=f32), axis=1) > 0
    emask = jnp.repeat(gmask, N_EXPERTS // N_GROUPS, axis=-1)
    _, eidx = lax.top_k(jnp.where(emask, biased, -jnp.inf), TOP_K)
    gate = jnp.take_along_axis(scores, eidx, axis=-1)
    gate = gate / jnp.sum(gate, axis=-1, keepdims=True) * ROUTE_SCALE

    nk = n * TOP_K
    e_flat = eidx.reshape(nk)
    order = jnp.argsort(e_flat)
    se = e_flat[order]
    st = (order // TOP_K).astype(jnp.int32)
    sw = gate.reshape(nk)[order]
    counts = jnp.bincount(e_flat, length=N_EXPERTS)
    starts = jnp.cumsum(counts) - counts
    padded = (counts + MOE_BLOCK - 1) // MOE_BLOCK * MOE_BLOCK
    pends = jnp.cumsum(padded)
    pstarts = pends - padded
    pos = pstarts[se] + jnp.arange(nk) - starts[se]
    n_blocks = -(-nk // MOE_BLOCK) + N_EXPERTS
    cap = n_blocks * MOE_BLOCK
    tok_buf = jnp.full((cap,), n, jnp.int32).at[pos].set(st)
    w_buf = jnp.zeros((cap,), f32).at[pos].set(sw)
    blk_e = jnp.minimum(jnp.searchsorted(pends, jnp.arange(n_blocks) * MOE_BLOCK, side='right'), N_EXPERTS - 1)
    h_pad = jnp.concatenate([h, jnp.zeros((1, d), h.dtype)], axis=0)

    def body(acc, inp):
        tb, wb, e = inp
        xb = h_pad[tb]
        u = xb @ w13[e]
        y = (jax.nn.silu(u[:, :D_EXPERT]) * u[:, D_EXPERT:]) @ w2[e]
        return acc.at[tb].add(y * wb[:, None].astype(y.dtype)), None

    acc, _ = lax.scan(body, jnp.zeros((n + 1, d), h.dtype),
                      (tok_buf.reshape(n_blocks, MOE_BLOCK), w_buf.reshape(n_blocks, MOE_BLOCK), blk_e))
    u = h @ sw13
    shared = (jax.nn.silu(u[:, :D_SHARED]) * u[:, D_SHARED:]) @ sw2
    return acc[:n] + shared


def setup_inputs(seed: int = 0) -> dict:
    key = jax.random.key(seed)
    ks = jax.random.split(key, 32)
    f32 = jnp.float32
    D = D_MODEL

    def nrm(k, shape, s):
        return jax.random.normal(k, shape, f32) * s

    lam_u = jax.random.uniform(ks[16], (DEPTH, 2, LRU_W), f32, 0.9, 0.999)
    sig = lam_u ** (1.0 / LRU_C)
    return {
        'x': nrm(ks[0], (BATCH, SEQ, D), 1.0),
        'c': nrm(ks[1], (BATCH, D), 1.0),
        'ctx': nrm(ks[2], (BATCH, CTX_LEN, D), 1.0),
        'c_ctx': nrm(ks[3], (D,), 1.0),
        'ada_w': nrm(ks[4], (DEPTH, D, 6 * D), 0.5 * D ** -0.5),
        'ada_b': nrm(ks[5], (DEPTH, 6 * D), 0.02),
        'norm_mix': 1.0 + nrm(ks[6], (DEPTH, D), 0.02),
        'norm_ffn': 1.0 + nrm(ks[7], (DEPTH, D), 0.02),
        'norm_final': 1.0 + nrm(ks[8], (D,), 0.02),
        'w_in': nrm(ks[9], (DEPTH, D, IN_COLS), D ** -0.5),
        'w_out': nrm(ks[10], (DEPTH, D_MIX, D), D_MIX ** -0.5),
        'lru_conv_w': nrm(ks[11], (DEPTH, CONV_W, LRU_W), CONV_W ** -0.5),
        'lru_conv_b': nrm(ks[12], (DEPTH, LRU_W), 0.01),
        'lru_wa': nrm(ks[13], (DEPTH, 2, LRU_BLOCKS, LRU_BD, LRU_BD), LRU_BD ** -0.5),
        'lru_ba': nrm(ks[14], (DEPTH, 2, LRU_W), 0.01),
        'lru_wx': nrm(ks[15], (DEPTH, 2, LRU_BLOCKS, LRU_BD, LRU_BD), LRU_BD ** -0.5),
        'lru_bx': nrm(ks[17], (DEPTH, 2, LRU_W), 0.01),
        'lru_lambda': jnp.log(sig) - jnp.log1p(-sig),
        'hgrn_lb_logits': nrm(ks[18], (2, DEPTH + 1, HG_W), 0.1),
        'hgrn_norm': 1.0 + nrm(ks[19], (DEPTH, HG_W), 0.02),
        'router_w': nrm(ks[20], (DEPTH, D, N_EXPERTS), D ** -0.5),
        'router_b': nrm(ks[21], (DEPTH, N_EXPERTS), 0.01),
        'exp_w13': nrm(ks[22], (DEPTH, N_EXPERTS, D, 2 * D_EXPERT), D ** -0.5),
        'exp_w2': nrm(ks[23], (DEPTH, N_EXPERTS, D_EXPERT, D), D_EXPERT ** -0.5),
        'shared_w13': nrm(ks[24], (DEPTH, D, 2 * D_SHARED), D ** -0.5),
        'shared_w2': nrm(ks[25], (DEPTH, D_SHARED, D), D_SHARED ** -0.5),
    }


def reference(x, c, ctx, c_ctx, ada_w, ada_b, norm_mix, norm_ffn, norm_final, w_in, w_out,
              lru_conv_w, lru_conv_b, lru_wa, lru_ba, lru_wx, lru_bx, lru_lambda,
              hgrn_lb_logits, hgrn_norm, router_w, router_b, exp_w13, exp_w2, shared_w13, shared_w2):
    b, n, d = x.shape
    lb_all = jnp.cumsum(jax.nn.softmax(hgrn_lb_logits.astype(jnp.float32), axis=1), axis=1)
    for l in range(DEPTH):
        last = l == DEPTH - 1
        mod_x = (jax.nn.silu(c) @ ada_w[l] + ada_b[l])[:, None, :]
        mod_c = jax.nn.silu(c_ctx) @ ada_w[l] + ada_b[l]
        sh1x, sc1x, g1x, sh2x, sc2x, g2x = jnp.split(mod_x, 6, axis=-1)
        sh1c, sc1c, g1c, sh2c, sc2c, g2c = jnp.split(mod_c, 6, axis=-1)

        hx = _rmsnorm(x, norm_mix[l]) * (1.0 + sc1x) + sh1x
        hc = _rmsnorm(ctx, norm_mix[l]) * (1.0 + sc1c) + sh1c
        yx, yc = _hybrid_mixer(hx, hc, w_in[l], w_out[l], lru_conv_w[l], lru_conv_b[l],
                               lru_wa[l], lru_ba[l], lru_wx[l], lru_bx[l], lru_lambda[l],
                               lb_all[:, l], hgrn_norm[l], not last)
        x = x + g1x * yx
        hx2 = _rmsnorm(x, norm_ffn[l]) * (1.0 + sc2x) + sh2x
        if last:
            y = _moe(hx2.reshape(b * n, d), router_w[l], router_b[l], exp_w13[l], exp_w2[l],
                     shared_w13[l], shared_w2[l])
            x = x + g2x * y.reshape(b, n, d)
        else:
            ctx = ctx + g1c * yc
            hc2 = _rmsnorm(ctx, norm_ffn[l]) * (1.0 + sc2c) + sh2c
            tokens = jnp.concatenate([hx2.reshape(b * n, d), hc2.reshape(-1, d)], axis=0)
            y = _moe(tokens, router_w[l], router_b[l], exp_w13[l], exp_w2[l],
                     shared_w13[l], shared_w2[l])
            x = x + g2x * y[:b * n].reshape(b, n, d)
            ctx = ctx + g2c * y[b * n:].reshape(ctx.shape)
    return _rmsnorm(x, norm_final)
```

```cpp
#include <hip/hip_runtime.h>
#include <cstdio>
#include <cstdint>

#ifndef PER_PHASE_LAUNCH
#define PER_PHASE_LAUNCH 0
#endif
#ifndef DBG_STOP
#define DBG_STOP 0
#endif

#define GAS __attribute__((address_space(1)))
#define LAS __attribute__((address_space(3)))
#define DI __device__ __forceinline__
typedef unsigned short bf16;
typedef unsigned v4u __attribute__((ext_vector_type(4)));
typedef unsigned v2u __attribute__((ext_vector_type(2)));
typedef float f32x4 __attribute__((ext_vector_type(4)));
typedef float f32x2 __attribute__((ext_vector_type(2)));
typedef short bf16x8 __attribute__((ext_vector_type(8)));
typedef __bf16 bfv2 __attribute__((ext_vector_type(2)));

constexpr int D = 1024, NB = 16, SEQ = 2048, CTXL = 256;
constexpr int NTOK = NB * SEQ;
constexpr int NCTX = NB * CTXL;
constexpr int MTOT = NTOK + NCTX;
constexpr int INC = 3584;
constexpr int NE = 256, TOPK = 8, DE = 256;
constexpr int LISTCAP = 32768;
constexpr float EPS = 1e-6f;
constexpr int NWAVES = 8, NTHR = 512;
constexpr int NSEQT = 36;

constexpr size_t MiB = 1u << 20;
constexpr size_t WS_CTL = 0, CTL_ZERO_BYTES = 1 * MiB;
constexpr size_t WS_MOD = 1 * MiB;
constexpr size_t WS_TAB = 2 * MiB;
constexpr size_t WS_WGT = 2 * MiB + 65536;
constexpr size_t WS_WIN = 3 * MiB;
constexpr size_t WS_WOUT = 10 * MiB;
constexpr size_t WS_WR = 12 * MiB;
constexpr size_t WS_SW13 = 12 * MiB + 512 * 1024;
constexpr size_t WS_SW2 = 13 * MiB + 512 * 1024;
constexpr size_t WS_DUMP = 2 * MiB + 16384;
constexpr size_t WS_SUMA = 14 * MiB;
constexpr size_t WS_SUMH = WS_SUMA + 2359296;
constexpr size_t WS_CIN = WS_SUMH + 2359296;
constexpr size_t WS_EW13 = 32 * MiB;
constexpr size_t WS_EW2 = 288 * MiB;
constexpr size_t WS_X1 = 416 * MiB;
constexpr size_t WS_HX2 = 544 * MiB;
constexpr size_t WS_LOGIT = 608 * MiB;
constexpr size_t WS_LIST = 1426 * MiB;
constexpr size_t WS_ACT = 674 * MiB;
constexpr size_t WS_YS = 850 * MiB;
constexpr size_t WS_P = 914 * MiB;
constexpr size_t WS_HX = 1166 * MiB;
constexpr size_t WS_OF = 1238 * MiB;
constexpr size_t WS_OB = 1270 * MiB;
constexpr size_t WS_YL = 1302 * MiB;
constexpr size_t WS_YB = 914 * MiB;
constexpr size_t WS_END = 1490 * MiB;
constexpr int CW_BAR = 4096;
constexpr int CW_CNT = 16384;

constexpr int RING_BYTES = 131072;
constexpr int LDS_TS = RING_BYTES;
constexpr int LDS_CNT = LDS_TS + 1088;
constexpr int LDS_IDX = LDS_CNT + 1024;
constexpr int LDS_MISC = LDS_IDX + 12 * 1024;
constexpr int LDS_BYTES = 155648;
static_assert(LDS_MISC + 64 <= LDS_BYTES, "lds map");

DI unsigned pk2(float lo, float hi) { f32x2 v = {lo, hi}; bfv2 b = __builtin_convertvector(v, bfv2); return __builtin_bit_cast(unsigned, b); }
DI float bflo(unsigned w) { return __uint_as_float(w << 16); }
DI float bfhi(unsigned w) { return __uint_as_float(w & 0xffff0000u); }
DI float bf2f(bf16 h) { return __uint_as_float(((unsigned)h) << 16); }
DI bf16 f2bf(float f) { return (bf16)(pk2(f, 0.f) & 0xffffu); }
DI float sigm(float x) { return 1.0f / (1.0f + __expf(-x)); }
DI float wave_sum(float v) {
#pragma unroll
    for (int o = 1; o < 64; o <<= 1) v += __shfl_xor(v, o);
    return v;
}
#define LDS_WAIT() asm volatile("s_waitcnt lgkmcnt(0)" ::: "memory")

#define XB_TMO      128
#define XB_XCNT(j)  (256  + 64 * (j))
#define XB_XSUB(j)  (1280 + 64 * (j))
#define XB_XGEN(j)  (2304 + 64 * (j))
#define XB_TOP      3328
#define XB_TOPGEN   3392
#define XCD_BAR_WORDS 3456
#define XB_SPIN_CAP (1u << 18)
__device__ __forceinline__ unsigned xb_ld(unsigned* p)              { return __hip_atomic_load(p, __ATOMIC_RELAXED, __HIP_MEMORY_SCOPE_AGENT); }
__device__ __forceinline__ unsigned xb_add(unsigned* p, unsigned v) { return __hip_atomic_fetch_add(p, v, __ATOMIC_RELAXED, __HIP_MEMORY_SCOPE_AGENT); }
__device__ __forceinline__ unsigned xb_xcc_id() { return (unsigned)__builtin_amdgcn_s_getreg((3 << 11) | 20) & 0xFu; }
#define XB_SPIN(cond, bar) do { unsigned _sp = 0; while (cond) { __builtin_amdgcn_s_sleep(1); \
    if ((++_sp & 255u) == 0u) { if (xb_ld(&(bar)[XB_TMO])) break; if (_sp > XB_SPIN_CAP) { atomicAdd(&(bar)[XB_TMO], 1u); break; } } } } while (0)
struct XcdBarrier { unsigned* bar; unsigned x; volatile LAS unsigned* st; };
__device__ __forceinline__ XcdBarrier xcd_barrier_post(unsigned* bar, volatile LAS unsigned* st) {
    XcdBarrier b; b.bar = bar; b.x = xb_xcc_id(); b.st = st;
    if (threadIdx.x == 0) (void)xb_add(&bar[XB_XCNT(b.x)], 1u);
    return b;
}
__device__ __forceinline__ void xcd_barrier_complete(unsigned* bar, unsigned x, unsigned& nloc, unsigned& nx) {
    const unsigned G = gridDim.x * gridDim.y * gridDim.z;
    unsigned sum, cnt, mine, sp = 0u;
    for (;;) {
        sum = 0u; cnt = 0u; mine = 0u;
#pragma unroll
        for (unsigned j = 0; j < 16; ++j) { const unsigned c = xb_ld(&bar[XB_XCNT(j)]); sum += c; cnt += (c > 0u) ? 1u : 0u; mine = (j == x) ? c : mine; }
        if (sum == G) break;
        __builtin_amdgcn_s_sleep(1);
        if ((++sp & 255u) == 0u) { if (xb_ld(&bar[XB_TMO])) break; if (sp > XB_SPIN_CAP) { atomicAdd(&bar[XB_TMO], 1u); break; } }
    }
    nloc = mine > 0u ? mine : 1u; nx = cnt > 0u ? cnt : 1u;
}
__device__ __forceinline__ void xcd_barrier(const XcdBarrier& b) {
    asm volatile("s_waitcnt vmcnt(0)" ::: "memory");
    __syncthreads();
    if (threadIdx.x == 0) {
        unsigned* bar = b.bar;
        __builtin_amdgcn_s_waitcnt(0);
        unsigned nloc = b.st[0], nx = b.st[1];
        if (nloc == 0u) { xcd_barrier_complete(bar, b.x, nloc, nx); b.st[0] = nloc; b.st[1] = nx; }
        const unsigned old = xb_add(&bar[XB_XSUB(b.x)], 1u);
        const unsigned gen = old / nloc;
        if (old + 1u == (gen + 1u) * nloc) {
            __builtin_amdgcn_fence(__ATOMIC_RELEASE, "agent");
            asm volatile("s_waitcnt vmcnt(0)" ::: "memory");
            const unsigned og = xb_add(&bar[XB_TOP], 1u);
            const unsigned tg = og / nx;
            if (og + 1u == (tg + 1u) * nx) xb_add(&bar[XB_TOPGEN], 1u);
            else XB_SPIN(xb_ld(&bar[XB_TOPGEN]) == tg, bar);
            __builtin_amdgcn_fence(__ATOMIC_ACQUIRE, "agent");
            xb_add(&bar[XB_XGEN(b.x)], 1u);
            asm volatile("s_waitcnt vmcnt(0)" ::: "memory");
        } else {
            XB_SPIN(xb_ld(&bar[XB_XGEN(b.x)]) == gen, bar);
            __builtin_amdgcn_fence(__ATOMIC_ACQUIRE, "agent");
            asm volatile("s_waitcnt vmcnt(0)" ::: "memory");
        }
    }
    __syncthreads();
}

namespace pg8 {
constexpr int BM = 256, BK = 64, HALF = 128, HTB = HALF * BK * 2, NXCD = 8, WGM = 8;
DI int lds_byte(int r, int c) { const int st = (r >> 4) * 2 + (c >> 5), rr = r & 15, cc = c & 31, ob = rr * 64 + cc * 2; return st * 1024 + (ob ^ (((ob >> 9) & 1) << 5)); }
DI void stage_rc(int b, int& R, int& C) { const int st = b / 1024, sb = b % 1024, swz = sb ^ (((sb >> 9) & 1) << 5); R = (st >> 1) * 16 + swz / 64; C = (st & 1) * 32 + (swz % 64) / 2; }
DI int perm32(int rho) { const int n = rho >> 4, i = rho & 15; return 8 * (i >> 2) + 4 * n + (i & 3); }

struct Unit { int pm, pn, e, rt, ord, nrows; };

struct DenseOrder {
    const char* A; const char* Bt; int K, nM, nN, nwg, G, c;
    DI void init(const void* A_, const void* Bt_, int M, int N, int K_, int G_, int c_) { A = (const char*)A_; Bt = (const char*)Bt_; K = K_; nM = M / BM; nN = N / BM; nwg = nM * nN; G = G_; c = c_; }
    DI bool next(int i, Unit& u) const {
        const long L = (long)i * G + c; if (L >= nwg) return false;
        int wgid = (int)L; { const int q = nwg / NXCD, r = nwg % NXCD, xcd = wgid % NXCD, off = wgid / NXCD; wgid = (xcd < r ? xcd * (q + 1) : r * (q + 1) + (xcd - r) * q) + off; }
        const int nig = WGM * nN, gid = wgid / nig, fm = gid * WGM, gsz = (nM - fm) < WGM ? (nM - fm) : WGM;
        u.pm = fm + ((wgid % nig) % gsz); u.pn = (wgid % nig) / gsz; u.e = 0; u.rt = u.pm; u.ord = i; u.nrows = 256; return true;
    }
    DI const char* a_base(const Unit& u) const { return A + (size_t)u.pm * BM * K * 2; }
    DI const char* b_base(const Unit& u) const { return Bt + (size_t)u.pn * BM * K * 2; }
    DI void a_offs(const Unit&, const int (&R)[2], const int (&C)[2], unsigned (&v)[2][2]) const {
#pragma unroll
        for (int h = 0; h < 2; ++h)
#pragma unroll
            for (int i = 0; i < 2; ++i) v[h][i] = (unsigned)((h * HALF + R[i]) * K + C[i]) * 2u;
    }
};

template <bool GATHER> struct MoeOrder {
    const char* A; const char* Bt; const char* BtS; int K, ncol; size_t estride;
    const LAS int* ts; const LAS int* cnt; const LAS int* idx; int G, vcu, total;
    DI bool next(int i, Unit& u) const {
        const int L = i * G + vcu; if (L >= total) return false;
        const int rt = L / ncol; u.pn = L - rt * ncol; u.rt = rt; u.ord = i;
        const int Te = ts[256];
        if (rt >= Te) { u.e = 256; u.pm = rt - Te; u.nrows = 256; }
        else { int lo = 0, hi = 256;
#pragma unroll 1
            while (hi - lo > 1) { const int mid = (lo + hi) >> 1; if (ts[mid] <= rt) lo = mid; else hi = mid; }
            u.e = lo; u.pm = rt - ts[lo]; const int rem = cnt[lo] - u.pm * 256; u.nrows = rem < 256 ? rem : 256; }
        return true;
    }
    DI const char* a_base(const Unit& u) const { return GATHER ? A : A + (size_t)u.rt * BM * K * 2; }
    DI const char* b_base(const Unit& u) const { return (u.e < 256 ? Bt + (size_t)u.e * estride : BtS) + (size_t)u.pn * BM * K * 2; }
    DI void a_offs(const Unit& u, const int (&R)[2], const int (&C)[2], unsigned (&v)[2][2]) const {
#pragma unroll
        for (int h = 0; h < 2; ++h)
#pragma unroll
            for (int i = 0; i < 2; ++i) {
                if (GATHER) v[h][i] = ((unsigned)idx[u.ord * 256 + h * HALF + R[i]] * (unsigned)K + (unsigned)C[i]) * 2u;
                else v[h][i] = (unsigned)((h * HALF + R[i]) * K + C[i]) * 2u;
            }
    }
};

template <class Epi, class Sched>
__device__ __forceinline__ void gemm_phase(LAS unsigned char* lds, const int K, const Sched& S, const Epi& E) {
    const int tid = threadIdx.x, wid = __builtin_amdgcn_readfirstlane(tid >> 6), lane = tid & 63, wr = wid >> 2, wc = wid & 3, fr = lane & 15, fq = lane >> 4;
    const int nt = K / BK;
    unsigned voffB[2]; int Rr[2], Cc[2];
#pragma unroll
    for (int i = 0; i < 2; ++i) { int R, C; stage_rc(tid * 16 + i * 8192, R, C); const int Rb = Epi::PERM ? ((R & ~31) + perm32(R & 31)) : R;
        voffB[i] = (unsigned)(Rb * K + C) * 2u; Rr[i] = R; Cc[i] = C; }
    const size_t kstep = (size_t)(BK * 2);
    const size_t hstep = (size_t)HALF * K * 2;
    const unsigned ldsw = (unsigned)wid * 1024u;
    const int aoff = lds_byte(wr * 64 + fr, fq * 8), boff = lds_byte(wc * 32 + fr, fq * 8);
#define PG8_SA(b, h) (((b) * 2 + (h)) * HTB)
#define PG8_SB(b, h) ((4 + (b) * 2 + (h)) * HTB)
#define PG8_STAGE(bufoff, gbase, voff) do { _Pragma("unroll") for (int _i = 0; _i < 2; ++_i) \
        __builtin_amdgcn_global_load_lds((const unsigned*)((const char*)(gbase) + (voff)[_i]), (LAS unsigned*)(lds + (bufoff) + ldsw + _i * 8192), 16, 0, 0); } while (0)
#define PG8_LDA(dst, b, h) do { _Pragma("unroll") for (int m = 0; m < 4; ++m) _Pragma("unroll") for (int k = 0; k < 2; ++k) dst[m][k] = *(const LAS bf16x8*)(lds + PG8_SA(b, h) + aoff + m * 2048 + k * 1024); } while (0)
#define PG8_LDB(dst, b, h) do { _Pragma("unroll") for (int n = 0; n < 2; ++n) _Pragma("unroll") for (int k = 0; k < 2; ++k) dst[n][k] = *(const LAS bf16x8*)(lds + PG8_SB(b, h) + boff + n * 2048 + k * 1024); } while (0)
#define PG8_MMA(ai, bj, At, Bt) do { __builtin_amdgcn_s_setprio(1); _Pragma("unroll") for (int m = 0; m < 4; ++m) _Pragma("unroll") for (int n = 0; n < 2; ++n) _Pragma("unroll") for (int k = 0; k < 2; ++k) \
        acc[ai][bj][m][n] = __builtin_amdgcn_mfma_f32_16x16x32_bf16(Bt[n][k], At[m][k], acc[ai][bj][m][n], 0, 0, 0); __builtin_amdgcn_s_setprio(0); } while (0)
#define PG8_WAIT_V(n) asm volatile("s_waitcnt vmcnt(" #n ")" ::: "memory")
#define PG8_WAIT_L(n) asm volatile("s_waitcnt lgkmcnt(" #n ")" ::: "memory")
#define PG8_BAR __builtin_amdgcn_s_barrier()
#define PG8_SCHED __builtin_amdgcn_sched_barrier(0)
    Unit cur, nxt; int ui = 0;
    if (!S.next(0, cur)) return;
    f32x4 acc[2][2][4][2];
#pragma unroll
    for (int a = 0; a < 2; ++a)
#pragma unroll
        for (int b = 0; b < 2; ++b)
#pragma unroll
            for (int m = 0; m < 4; ++m)
#pragma unroll
                for (int n = 0; n < 2; ++n) acc[a][b][m][n] = (f32x4){0.f, 0.f, 0.f, 0.f};
    bf16x8 At[4][2], B0[2][2], B1[2][2];
    unsigned vC[2][2], vN[2][2];
    S.a_offs(cur, Rr, Cc, vC);
    const char* cA = S.a_base(cur); const char* cB = S.b_base(cur);
    PG8_STAGE(PG8_SB(0, 0), cB, voffB); PG8_STAGE(PG8_SA(0, 0), cA, vC[0]); PG8_STAGE(PG8_SB(0, 1), cB + hstep, voffB); PG8_STAGE(PG8_SA(0, 1), cA, vC[1]);
    if (wr == 1) PG8_BAR;
    PG8_WAIT_V(4); PG8_BAR;
    PG8_STAGE(PG8_SB(1, 0), cB + kstep, voffB); PG8_STAGE(PG8_SA(1, 0), cA + kstep, vC[0]); PG8_STAGE(PG8_SB(1, 1), cB + hstep + kstep, voffB);
    PG8_WAIT_V(6); PG8_BAR;
    for (;;) {
        const bool has_next = S.next(ui + 1, nxt);
        const char* nA = has_next ? S.a_base(nxt) : cA; const char* nB = has_next ? S.b_base(nxt) : cB;
        if (has_next) S.a_offs(nxt, Rr, Cc, vN);
        else { vN[0][0] = vC[0][0]; vN[0][1] = vC[0][1]; vN[1][0] = vC[1][0]; vN[1][1] = vC[1][1]; }
#pragma unroll 1
        for (int t = 0; t < nt; t += 2) {
            const bool last = (t == nt - 2);
            const char* a1 = cA + (size_t)(t + 1) * kstep;
            const char* a2 = last ? nA : cA + (size_t)(t + 2) * kstep; const char* b2 = last ? nB : cB + (size_t)(t + 2) * kstep;
            const char* a3 = a2 + kstep; const char* b3 = b2 + kstep;
            unsigned x0[2], x1[2];
            x0[0] = last ? vN[0][0] : vC[0][0]; x0[1] = last ? vN[0][1] : vC[0][1]; x1[0] = last ? vN[1][0] : vC[1][0]; x1[1] = last ? vN[1][1] : vC[1][1];
            PG8_LDB(B0, 0, 0); PG8_SCHED; PG8_LDA(At, 0, 0); PG8_STAGE(PG8_SA(1, 1), a1, vC[1]);
            PG8_WAIT_L(8); PG8_BAR; PG8_WAIT_L(0); PG8_MMA(0, 0, At, B0); PG8_BAR; PG8_SCHED;
            PG8_LDB(B1, 0, 1); PG8_STAGE(PG8_SB(0, 0), b2, voffB);
            PG8_BAR; PG8_WAIT_L(0); PG8_MMA(0, 1, At, B1); PG8_BAR;
            PG8_LDA(At, 0, 1); PG8_STAGE(PG8_SA(0, 0), a2, x0);
            PG8_BAR; PG8_WAIT_L(0); PG8_MMA(1, 0, At, B0); PG8_BAR; PG8_SCHED;
            PG8_STAGE(PG8_SB(0, 1), b2 + hstep, voffB);
            PG8_WAIT_V(6); PG8_BAR; PG8_MMA(1, 1, At, B1); PG8_BAR;
            PG8_LDB(B0, 1, 0); PG8_SCHED; PG8_LDA(At, 1, 0); PG8_STAGE(PG8_SA(0, 1), a2, x1);
            PG8_WAIT_L(8); PG8_BAR; PG8_WAIT_L(0); PG8_MMA(0, 0, At, B0); PG8_BAR; PG8_SCHED;
            PG8_LDB(B1, 1, 1); PG8_STAGE(PG8_SB(1, 0), b3, voffB);
            PG8_BAR; PG8_WAIT_L(0); PG8_MMA(0, 1, At, B1); PG8_BAR;
            PG8_LDA(At, 1, 1); PG8_STAGE(PG8_SA(1, 0), a3, x0);
            PG8_BAR; PG8_WAIT_L(0); PG8_MMA(1, 0, At, B0); PG8_BAR; PG8_SCHED;
            PG8_STAGE(PG8_SB(1, 1), b3 + hstep, voffB);
            PG8_WAIT_V(6); PG8_BAR; PG8_MMA(1, 1, At, B1); PG8_BAR;
        }
        E(acc, cur, wr, wc, fr, fq);
        if (!has_next) break;
#pragma unroll
        for (int a = 0; a < 2; ++a)
#pragma unroll
            for (int b = 0; b < 2; ++b)
#pragma unroll
                for (int m = 0; m < 4; ++m)
#pragma unroll
                    for (int n = 0; n < 2; ++n) acc[a][b][m][n] = (f32x4){0.f, 0.f, 0.f, 0.f};
        cur = nxt; cA = nA; cB = nB; ++ui;
        vC[0][0] = vN[0][0]; vC[0][1] = vN[0][1]; vC[1][0] = vN[1][0]; vC[1][1] = vN[1][1];
    }
    PG8_WAIT_V(0);
    if (wr == 0) PG8_BAR;
    PG8_BAR;
#undef PG8_SA
#undef PG8_SB
#undef PG8_STAGE
#undef PG8_LDA
#undef PG8_LDB
#undef PG8_MMA
#undef PG8_WAIT_V
#undef PG8_WAIT_L
#undef PG8_BAR
#undef PG8_SCHED
}

DI float gelu_tanh(float x) { const float u = 1.5957691216f * (x + 0.044715f * x * x * x); return x / (1.0f + __expf(-u)); }
DI float silu_f(float x) { return x / (1.0f + __expf(-x)); }

struct EpiInProj {
    static constexpr bool PERM = true;
    bf16* P; const float* LB;
    DI void operator()(const f32x4 (&acc)[2][2][4][2], const Unit& u, int wr, int wc, int fr, int fq) const {
        const int row0 = u.pm * BM + wr * 64 + fr, col0 = u.pn * BM + wc * 32 + 8 * fq;
        const int pn = u.pn;
        const int kind = (pn == 2 || pn == 3) ? 1 : (pn >= 8 && pn < 12) ? 2 : (pn >= 12) ? 3 : 0;
        f32x4 lbv[2][2];
        { const int dir = (pn >> 1) & 1; const int cc = (pn & 1) * 256 + wc * 32 + 8 * fq;
#pragma unroll
            for (int bj = 0; bj < 2; ++bj)
#pragma unroll
                for (int n = 0; n < 2; ++n) lbv[bj][n] = *(const f32x4*)(LB + dir * 512 + cc + bj * HALF + 4 * n); }
#pragma unroll
        for (int ai = 0; ai < 2; ++ai)
#pragma unroll
            for (int m = 0; m < 4; ++m) { bf16* rowp = P + (size_t)(row0 + ai * HALF + m * 16) * INC + col0;
#pragma unroll
                for (int bj = 0; bj < 2; ++bj) { f32x4 v0 = acc[ai][bj][m][0], v1 = acc[ai][bj][m][1];
                    if (kind == 1) {
#pragma unroll
                        for (int j = 0; j < 4; ++j) { v0[j] = gelu_tanh(v0[j]); v1[j] = gelu_tanh(v1[j]); } }
                    else if (kind == 2) {
#pragma unroll
                        for (int j = 0; j < 4; ++j) { const float l0 = lbv[bj][0][j], l1 = lbv[bj][1][j];
                            v0[j] = __logf(l0 + (1.0f - l0) * sigm(v0[j])); v1[j] = __logf(l1 + (1.0f - l1) * sigm(v1[j])); } }
                    else if (kind == 3) {
#pragma unroll
                        for (int j = 0; j < 4; ++j) { v0[j] = silu_f(v0[j]); v1[j] = silu_f(v1[j]); } }
                    v4u w; w.x = pk2(v0[0], v0[1]); w.y = pk2(v0[2], v0[3]); w.z = pk2(v1[0], v1[1]); w.w = pk2(v1[2], v1[3]);
                    *(v4u*)(rowp + bj * HALF) = w; } }
    }
};
struct EpiResid {
    static constexpr bool PERM = false;
    const float* x; const float* mod; float* X1;
    DI void operator()(const f32x4 (&acc)[2][2][4][2], const Unit& u, int wr, int wc, int fr, int fq) const {
        const int row0 = u.pm * BM + wr * 64 + fr, col0 = u.pn * BM + wc * 32 + 4 * fq;
        const int b = (u.pm * BM) >> 11;
        f32x4 gv[2][2];
#pragma unroll
        for (int bj = 0; bj < 2; ++bj)
#pragma unroll
            for (int n = 0; n < 2; ++n) gv[bj][n] = *(const f32x4*)(mod + (size_t)b * 6144 + 2048 + col0 + bj * HALF + n * 16);
#pragma unroll
        for (int ai = 0; ai < 2; ++ai)
#pragma unroll
            for (int m = 0; m < 4; ++m) { const size_t off = (size_t)(row0 + ai * HALF + m * 16) * D + col0;
#pragma unroll
                for (int bj = 0; bj < 2; ++bj)
#pragma unroll
                    for (int n = 0; n < 2; ++n) { const f32x4 xv = *(const f32x4*)(x + off + bj * HALF + n * 16);
                        *(f32x4*)(X1 + off + bj * HALF + n * 16) = xv + gv[bj][n] * acc[ai][bj][m][n]; } }
    }
};
struct EpiF32 {
    static constexpr bool PERM = false;
    float* C; int ldc;
    DI void operator()(const f32x4 (&acc)[2][2][4][2], const Unit& u, int wr, int wc, int fr, int fq) const {
        const int row0 = u.pm * BM + wr * 64 + fr, col0 = u.pn * BM + wc * 32 + 4 * fq;
#pragma unroll
        for (int ai = 0; ai < 2; ++ai)
#pragma unroll
            for (int m = 0; m < 4; ++m) { float* rowp = C + (size_t)(row0 + ai * HALF + m * 16) * ldc + col0;
#pragma unroll
                for (int bj = 0; bj < 2; ++bj)
#pragma unroll
                    for (int n = 0; n < 2; ++n) *(f32x4*)(rowp + bj * HALF + n * 16) = acc[ai][bj][m][n]; }
    }
};
struct EpiSwiGLU {
    static constexpr bool PERM = true;
    bf16* ACT;
    DI void operator()(const f32x4 (&acc)[2][2][4][2], const Unit& u, int wr, int wc, int fr, int fq) const {
        const int row0 = wr * 64 + fr, col0 = u.pn * 128 + wc * 32 + 8 * fq;
        bf16* base = ACT + (size_t)u.rt * 256 * DE;
#pragma unroll
        for (int ai = 0; ai < 2; ++ai)
#pragma unroll
            for (int m = 0; m < 4; ++m) { bf16* rowp = base + (size_t)(row0 + ai * HALF + m * 16) * DE + col0;
                f32x4 a0 = acc[ai][0][m][0], a1 = acc[ai][0][m][1]; const f32x4 g0 = acc[ai][1][m][0], g1 = acc[ai][1][m][1];
#pragma unroll
                for (int j = 0; j < 4; ++j) { a0[j] = silu_f(a0[j]) * g0[j]; a1[j] = silu_f(a1[j]) * g1[j]; }
                v4u w; w.x = pk2(a0[0], a0[1]); w.y = pk2(a0[2], a0[3]); w.z = pk2(a1[0], a1[1]); w.w = pk2(a1[2], a1[3]);
                *(v4u*)rowp = w; }
    }
};
struct EpiScatter {
    static constexpr bool PERM = true;
    bf16* YB; bf16* YS; const v2u* LIST; bf16* DUMP;
    DI void operator()(const f32x4 (&acc)[2][2][4][2], const Unit& u, int wr, int wc, int fr, int fq) const {
        const int col0 = u.pn * BM + wc * 32 + 8 * fq;
        v2u tg[2][4];
#pragma unroll
        for (int ai = 0; ai < 2; ++ai)
#pragma unroll
            for (int m = 0; m < 4; ++m) { const int r = ai * HALF + wr * 64 + m * 16 + fr;
                const int rr = r < u.nrows ? r : u.nrows - 1; const int ee = u.e < 256 ? u.e : 0;
                tg[ai][m] = LIST[(size_t)ee * LISTCAP + (u.e < 256 ? u.pm * 256 + rr : 0)]; if (u.e >= 256) tg[ai][m].y = 0x3f800000u; }
#pragma unroll
        for (int ai = 0; ai < 2; ++ai)
#pragma unroll
            for (int m = 0; m < 4; ++m) { const int r = ai * HALF + wr * 64 + m * 16 + fr;
                const float g = __uint_as_float(tg[ai][m].y);
                bf16* dst = (u.e < 256) ? YB + (tg[ai][m].x * (unsigned)D + (unsigned)col0) : YS + ((unsigned)(u.pm * 256 + r) * (unsigned)D + (unsigned)col0);
                if (r >= u.nrows) dst = DUMP + col0;
#pragma unroll
                for (int bj = 0; bj < 2; ++bj) { const f32x4 v0 = acc[ai][bj][m][0] * g, v1 = acc[ai][bj][m][1] * g;
                    v4u w; w.x = pk2(v0[0], v0[1]); w.y = pk2(v0[2], v0[3]); w.z = pk2(v1[0], v1[1]); w.w = pk2(v1[2], v1[3]);
                    *(v4u*)(dst + bj * HALF) = w; } }
    }
};
}

struct Args { const float* in[26]; float* out; unsigned char* ws; int ph_lo, ph_hi; };
enum { I_X = 0, I_C, I_CTX, I_CCTX, I_ADAW, I_ADAB, I_NMIX, I_NFFN, I_NFIN, I_WIN, I_WOUT, I_CONVW, I_CONVB, I_WA, I_BA, I_WX, I_BX, I_LAM,
       I_LBL, I_HNORM, I_RW, I_RB, I_EW13, I_EW2, I_SW13, I_SW2 };

struct Frame {
    LAS unsigned char* lds;
    int tid, lane, wave, G, vcu, bx;
    const float* const* in; float* out; unsigned char* ws;
};

DI void transpose_item(const float* W, int ldw, bf16* WT, int ldo, int k0, int n0, int orow0, LAS float* scr, int lane) {
#pragma unroll 8
    for (int i = 0; i < 32; ++i) { const int kk = 2 * i + (lane >> 5); scr[kk * 33 + (lane & 31)] = W[(size_t)(k0 + kk) * ldw + n0 + (lane & 31)]; }
    LDS_WAIT(); asm volatile("" ::: "memory");
    const int c = lane & 7;
#pragma unroll
    for (int j = 0; j < 4; ++j) { const int n = (lane >> 3) + 8 * j; const LAS float* s = scr + (8 * c) * 33 + n;
        v4u o; o.x = pk2(s[0 * 33], s[1 * 33]); o.y = pk2(s[2 * 33], s[3 * 33]); o.z = pk2(s[4 * 33], s[5 * 33]); o.w = pk2(s[6 * 33], s[7 * 33]);
        *(v4u*)(WT + (size_t)(orow0 + n) * ldo + k0 + 8 * c) = o; }
    LDS_WAIT(); asm volatile("" ::: "memory");
}
DI int w13_row(int n) { const int half = n >> 8, idx = n & 255; return 256 * (idx >> 7) + 128 * half + (idx & 127); }

DI void phase_prologue(const Frame& F) {
    const float* const* in = F.in; unsigned char* ws = F.ws;
    {
        LAS float* sc = (LAS float*)F.lds;
        LAS float* red = (LAS float*)(F.lds + 17 * 1024 * 4);
        for (int i = F.tid; i < 17 * 1024; i += NTHR) { const int r = i >> 10, k = i & 1023; const float v = (r < 16) ? in[I_C][r * 1024 + k] : in[I_CCTX][k]; sc[i] = v / (1.0f + __expf(-v)); }
        __syncthreads();
        const float* aw = in[I_ADAW]; float* MOD = (float*)(ws + WS_MOD);
        for (int cg = F.bx; cg < 256; cg += F.G) {
            const int kg = F.tid >> 5, cl = F.tid & 31, col = cg * 24 + cl;
            float a[17];
#pragma unroll
            for (int r = 0; r < 17; ++r) a[r] = 0.f;
            if (cl < 24) {
                for (int kk = 0; kk < 64; ++kk) { const int k = kg * 64 + kk; const float w = aw[(size_t)k * 6144 + col];
#pragma unroll
                    for (int r = 0; r < 17; ++r) a[r] += sc[r * 1024 + k] * w; }
#pragma unroll
                for (int r = 0; r < 17; ++r) red[(kg * 17 + r) * 24 + cl] = a[r];
            }
            __syncthreads();
            if (F.tid < 17 * 24) { const int r = F.tid / 24, c2 = F.tid % 24; float s = 0.f;
                for (int g = 0; g < 16; ++g) s += red[(g * 17 + r) * 24 + c2];
                MOD[r * 6144 + cg * 24 + c2] = s + in[I_ADAB][cg * 24 + c2]; }
            __syncthreads();
        }
    }
    {
        float* LB = (float*)(ws + WS_TAB); float* SP = LB + 1024;
        const int gt = F.bx * NTHR + F.tid, GT = F.G * NTHR;
        for (int i = gt; i < 1024; i += GT) { const int d = i >> 9, c = i & 511;
            const float l0 = in[I_LBL][(d * 2 + 0) * 512 + c], l1 = in[I_LBL][(d * 2 + 1) * 512 + c];
            LB[i] = 1.0f / (1.0f + expf(l1 - l0));
            SP[i] = log1pf(expf(-in[I_LAM][i])); }
        bf16* WGT = (bf16*)(ws + WS_WGT);
        for (int i = gt; i < 2 * 2 * 8 * 64 * 64; i += GT) { const int ii = i & 63, j = (i >> 6) & 63, h = (i >> 12) & 7, g = (i >> 15) & 1, d = i >> 16;
            const float* src = g ? in[I_WX] : in[I_WA];
            WGT[i] = f2bf(src[((size_t)(d * 8 + h) * 64 + ii) * 64 + j]); }
    }
    {
        LAS float* scr = (LAS float*)(F.lds + F.wave * 8448);
        const int gw = F.vcu * NWAVES + F.wave, NGW = F.G * NWAVES;
        constexpr int IT_WIN = 16 * 112, IT_WOUT = 16 * 32, IT_WR = 16 * 8, IT_SW13 = 16 * 16, IT_SW2 = 4 * 32, IT_E13 = 256 * 256, IT_E2 = 256 * 128;
        constexpr int NIT = IT_WIN + IT_WOUT + IT_WR + IT_SW13 + IT_SW2 + IT_E13 + IT_E2;
        for (int it = gw; it < NIT; it += NGW) {
            int r = it;
            if (r < IT_WIN) { const int kb = r / 112, nb = r % 112; transpose_item(in[I_WIN], INC, (bf16*)(ws + WS_WIN), 1024, kb * 64, nb * 32, nb * 32, scr, F.lane); continue; } r -= IT_WIN;
            if (r < IT_WOUT) { const int kb = r / 32, nb = r % 32; transpose_item(in[I_WOUT], 1024, (bf16*)(ws + WS_WOUT), 1024, kb * 64, nb * 32, nb * 32, scr, F.lane); continue; } r -= IT_WOUT;
            if (r < IT_WR) { const int kb = r / 8, nb = r % 8; transpose_item(in[I_RW], 256, (bf16*)(ws + WS_WR), 1024, kb * 64, nb * 32, nb * 32, scr, F.lane); continue; } r -= IT_WR;
            if (r < IT_SW13) { const int kb = r / 16, nb = r % 16; transpose_item(in[I_SW13], 512, (bf16*)(ws + WS_SW13), 1024, kb * 64, nb * 32, w13_row(nb * 32), scr, F.lane); continue; } r -= IT_SW13;
            if (r < IT_SW2) { const int kb = r / 32, nb = r % 32; transpose_item(in[I_SW2], 1024, (bf16*)(ws + WS_SW2), 256, kb * 64, nb * 32, nb * 32, scr, F.lane); continue; } r -= IT_SW2;
            if (r < IT_E13) { const int e = r >> 8, q = r & 255, kb = q >> 4, nb = q & 15;
                transpose_item(in[I_EW13] + (size_t)e * 1024 * 512, 512, (bf16*)(ws + WS_EW13) + (size_t)e * 512 * 1024, 1024, kb * 64, nb * 32, w13_row(nb * 32), scr, F.lane); continue; } r -= IT_E13;
            { const int e = r >> 7, q = r & 127, kb = q >> 5, nb = q & 31;
                transpose_item(in[I_EW2] + (size_t)e * 256 * 1024, 1024, (bf16*)(ws + WS_EW2) + (size_t)e * 1024 * 256, 256, kb * 64, nb * 32, nb * 32, scr, F.lane); }
        }
    }
}

DI void phase_norm_rows(const Frame& F, int mode) {
    const float* MOD = (const float*)(F.ws + WS_MOD);
    const int gw = F.bx * NWAVES + F.wave, NGW = F.G * NWAVES;
    const int nrows = mode == 0 ? MTOT : NTOK;
    const float* gain = mode == 0 ? F.in[I_NMIX] : F.in[I_NFFN];
    bf16* dst = (bf16*)(F.ws + (mode == 0 ? WS_HX : WS_HX2));
    const int sh_off = mode == 0 ? 0 : 3072, sc_off = mode == 0 ? 1024 : 4096;
    for (int m = gw; m < nrows; m += NGW) {
        const float* src; int mr;
        if (mode == 0) { if (m < NTOK) { src = F.in[I_X] + (size_t)m * D; mr = m >> 11; } else { src = F.in[I_CTX] + (size_t)(m - NTOK) * D; mr = 16; } }
        else { src = (const float*)(F.ws + WS_X1) + (size_t)m * D; mr = m >> 11; }
        f32x4 v[4]; float ss = 0.f;
#pragma unroll
        for (int j = 0; j < 4; ++j) { v[j] = *(const f32x4*)(src + 4 * F.lane + 256 * j); ss += (v[j].x * v[j].x + v[j].y * v[j].y) + (v[j].z * v[j].z + v[j].w * v[j].w); }
        const float rs = rsqrtf(wave_sum(ss) * (1.0f / D) + EPS);
#pragma unroll
        for (int j = 0; j < 4; ++j) { const int c = 4 * F.lane + 256 * j;
            const f32x4 gn = *(const f32x4*)(gain + c), sc = *(const f32x4*)(MOD + mr * 6144 + sc_off + c), sh = *(const f32x4*)(MOD + mr * 6144 + sh_off + c);
            const f32x4 y = (v[j] * rs) * gn * (sc + 1.0f) + sh;
            v2u w; w.x = pk2(y.x, y.y); w.y = pk2(y.z, y.w);
            *(v2u*)(dst + (size_t)m * D + c) = w; }
    }
}

constexpr int LT_STR = 520;
constexpr int L_RT = 0;
constexpr int L_GT = 69888;
static_assert(L_GT + 64 * LT_STR * 2 <= LDS_MISC, "lru lds");
template <bool FINAL> DI void lru_tile(const Frame& F, int b, int s) {
    const bf16* P = (const bf16*)(F.ws + WS_P);
    const int h = F.wave, fr = F.lane & 15, fq = F.lane >> 4;
    int prow0, L, t0;
    if (s < 4) { prow0 = NTOK + b * CTXL + 64 * s; L = CTXL; t0 = 64 * s; } else { prow0 = b * SEQ + 64 * (s - 4); L = SEQ; t0 = 64 * (s - 4); }
    LAS bf16* RT = (LAS bf16*)(F.lds + L_RT); LAS bf16* GT = (LAS bf16*)(F.lds + L_GT);
#pragma unroll
    for (int it = 0; it < 9; ++it) { const int p = F.tid + it * NTHR;
        if (p < 67 * 64) { const int row = p >> 6, pc = p & 63, ts = t0 + row - 1;
            v4u v = {0u, 0u, 0u, 0u};
            if (ts >= 0 && ts < L) v = *(const v4u*)(P + (size_t)(prow0 + row - 1) * INC + 8 * pc);
            *(LAS v4u*)(RT + row * LT_STR + 8 * pc) = v; } }
    if (FINAL) {
#pragma unroll
        for (int it = 0; it < 8; ++it) { const int p = F.tid + it * NTHR; const int row = p >> 6, pc = p & 63;
            *(LAS v4u*)(GT + row * LT_STR + 8 * pc) = *(const v4u*)(P + (size_t)(prow0 + row) * INC + 512 + 8 * pc); } }
    __syncthreads();
    bf16x8 Af[4][2];
#pragma unroll
    for (int ks = 0; ks < 2; ++ks) {
        const int c0 = 64 * h + 32 * ks + 8 * fq;
        float cw[4][8], cb[8];
#pragma unroll
        for (int k = 0; k < 4; ++k) { const f32x4 w0 = *(const f32x4*)(F.in[I_CONVW] + k * 512 + c0), w1 = *(const f32x4*)(F.in[I_CONVW] + k * 512 + c0 + 4);
            cw[k][0] = w0.x; cw[k][1] = w0.y; cw[k][2] = w0.z; cw[k][3] = w0.w; cw[k][4] = w1.x; cw[k][5] = w1.y; cw[k][6] = w1.z; cw[k][7] = w1.w; }
        { const f32x4 w0 = *(const f32x4*)(F.in[I_CONVB] + c0), w1 = *(const f32x4*)(F.in[I_CONVB] + c0 + 4);
            cb[0] = w0.x; cb[1] = w0.y; cb[2] = w0.z; cb[3] = w0.w; cb[4] = w1.x; cb[5] = w1.y; cb[6] = w1.z; cb[7] = w1.w; }
        const LAS bf16* rbase = RT + fr * LT_STR + c0;
#pragma unroll
        for (int tt = 0; tt < 4; ++tt) {
            float u[8];
#pragma unroll
            for (int j = 0; j < 8; ++j) u[j] = cb[j];
#pragma unroll
            for (int k = 0; k < 4; ++k) { const v4u r8 = *(const LAS v4u*)(rbase + (16 * tt + k) * LT_STR);
                u[0] += cw[k][0] * bflo(r8.x); u[1] += cw[k][1] * bfhi(r8.x); u[2] += cw[k][2] * bflo(r8.y); u[3] += cw[k][3] * bfhi(r8.y);
                u[4] += cw[k][4] * bflo(r8.z); u[5] += cw[k][5] * bfhi(r8.z); u[6] += cw[k][6] * bflo(r8.w); u[7] += cw[k][7] * bfhi(r8.w); }
            v4u w; w.x = pk2(u[0], u[1]); w.y = pk2(u[2], u[3]); w.z = pk2(u[4], u[5]); w.w = pk2(u[6], u[7]);
            Af[tt][ks] = __builtin_bit_cast(bf16x8, w);
        }
    }
    const bf16* WGT = (const bf16*)(F.ws + WS_WGT);
    const float* SP = (const float*)(F.ws + WS_TAB) + 1024;
    LAS bf16* HL = RT;
    LAS bf16* hlb = HL + (4 * fq) * LT_STR + 64 * h + fr;
    LAS bf16* gtb = GT + (4 * fq) * LT_STR + 64 * h + fr;
#pragma unroll 1
    for (int dir = 0; dir < 2; ++dir) {
#pragma unroll 1
        for (int nt = 0; nt < 4; ++nt) {
            const int cj = 64 * h + 16 * nt + fr;
            bf16x8 Ba[2], Bx[2], Id[2];
#pragma unroll
            for (int ks = 0; ks < 2; ++ks) {
                Ba[ks] = *(const bf16x8*)(WGT + ((size_t)((dir * 2 + 0) * 8 + h) * 64 + 16 * nt + fr) * 64 + 32 * ks + 8 * fq);
                Bx[ks] = *(const bf16x8*)(WGT + ((size_t)((dir * 2 + 1) * 8 + h) * 64 + 16 * nt + fr) * 64 + 32 * ks + 8 * fq);
#pragma unroll
                for (int jj = 0; jj < 8; ++jj) Id[ks][jj] = (32 * ks + 8 * fq + jj == 16 * nt + fr) ? (short)0x3F80 : (short)0;
            }
            const float ba = F.in[I_BA][dir * 512 + cj], bx = F.in[I_BX][dir * 512 + cj], sp = SP[dir * 512 + cj];
            float cin = 0.f, ptot = 1.f;
            if (FINAL) cin = ((const float*)(F.ws + WS_CIN))[((size_t)(dir * NB + b) * NSEQT + s) * 512 + cj];
#pragma unroll
            for (int tti = 0; tti < 4; ++tti) {
                const int tt = dir ? 3 - tti : tti;
                const bf16x8 A0 = dir ? Af[3 - tti][0] : Af[tti][0], A1 = dir ? Af[3 - tti][1] : Af[tti][1];
                f32x4 pa = {0.f, 0.f, 0.f, 0.f}, px = {0.f, 0.f, 0.f, 0.f}, uc = {0.f, 0.f, 0.f, 0.f};
                pa = __builtin_amdgcn_mfma_f32_16x16x32_bf16(A0, Ba[0], pa, 0, 0, 0); pa = __builtin_amdgcn_mfma_f32_16x16x32_bf16(A1, Ba[1], pa, 0, 0, 0);
                px = __builtin_amdgcn_mfma_f32_16x16x32_bf16(A0, Bx[0], px, 0, 0, 0); px = __builtin_amdgcn_mfma_f32_16x16x32_bf16(A1, Bx[1], px, 0, 0, 0);
                uc = __builtin_amdgcn_mfma_f32_16x16x32_bf16(A0, Id[0], uc, 0, 0, 0); uc = __builtin_amdgcn_mfma_f32_16x16x32_bf16(A1, Id[1], uc, 0, 0, 0);
                float av[4], bv[4];
#pragma unroll
                for (int ri = 0; ri < 4; ++ri) { const float pav = dir ? pa[3 - ri] : pa[ri], pxv = dir ? px[3 - ri] : px[ri], ucv = dir ? uc[3 - ri] : uc[ri];
                    const float rg = sigm(pav + ba), ig = sigm(pxv + bx);
                    const float a = __expf(-8.0f * rg * sp); av[ri] = a; bv[ri] = sqrtf(fmaxf(1.0f - a * a, 0.f)) * ig * ucv; }
                float pl = 1.f, hl = 0.f;
#pragma unroll
                for (int ri = 0; ri < 4; ++ri) { hl = av[ri] * hl + bv[ri]; pl *= av[ri]; }
                float pg[4], hg[4];
#pragma unroll
                for (int gi = 0; gi < 4; ++gi) { const int g = dir ? 3 - gi : gi; pg[gi] = __shfl(pl, fr + 16 * g); hg[gi] = __shfl(hl, fr + 16 * g); }
                const int myg = dir ? 3 - fq : fq;
                float mycin = cin, run = cin;
#pragma unroll
                for (int gi = 0; gi < 4; ++gi) { if (gi == myg) mycin = run; run = pg[gi] * run + hg[gi]; }
                if (FINAL) { float hc = mycin;
#pragma unroll
                    for (int ri = 0; ri < 4; ++ri) { const int r = dir ? 3 - ri : ri; hc = av[ri] * hc + bv[ri];
                        const int o = (16 * tt + r) * LT_STR + 16 * nt;
                        if (dir == 0) hlb[o] = f2bf(hc);
                        else gtb[o] = f2bf(bf2f(gtb[o]) * (bf2f(hlb[o]) + hc)); } }
                else ptot *= (pg[0] * pg[1]) * (pg[2] * pg[3]);
                cin = run;
            }
            if (!FINAL && fq == 0) { const size_t o = ((size_t)(dir * NB + b) * NSEQT + s) * 512 + cj;
                ((float*)(F.ws + WS_SUMA))[o] = ptot; ((float*)(F.ws + WS_SUMH))[o] = cin; }
        }
    }
    if (FINAL) {
        __syncthreads();
        bf16* YL = (bf16*)(F.ws + WS_YL);
#pragma unroll
        for (int it = 0; it < 8; ++it) { const int p = F.tid + it * NTHR; const int row = p >> 6, pc = p & 63;
            *(v4u*)(YL + (size_t)(prow0 + row) * D + 8 * pc) = *(const LAS v4u*)(GT + row * LT_STR + 8 * pc); } }
    __syncthreads();
}
DI void phase_lru_pass1(const Frame& F) {
    for (int it = F.bx; it < NB * NSEQT; it += F.G) lru_tile<false>(F, it / NSEQT, it % NSEQT);
}
DI void phase_lru_carry(const Frame& F) {
    if (F.wave != 0) return;
    const float* SA = (const float*)(F.ws + WS_SUMA); const float* SH = (const float*)(F.ws + WS_SUMH); float* CI = (float*)(F.ws + WS_CIN);
    for (int id = F.bx * 64 + F.lane; id < 2 * NB * 512; id += F.G * 64) {
        const int dir = id >> 13, b = (id >> 9) & 15, c = id & 511;
        float x = 0.f;
        for (int st = 0; st < NSEQT; ++st) { const int s = dir ? (st < 4 ? 3 - st : 39 - st) : st;
            const size_t o = ((size_t)(dir * NB + b) * NSEQT + s) * 512 + c;
            CI[o] = x; x = SA[o] * x + SH[o]; }
    }
}
DI void phase_lru_pass2(const Frame& F) {
    for (int it = F.bx; it < NB * 32; it += F.G) lru_tile<true>(F, it >> 5, 4 + (it & 31));
}

constexpr int HQ_STR = 136, HV_STR = 40;
constexpr int H_QR = 0, H_LFR = H_QR + 32 * HQ_STR * 2, H_VT = H_LFR + 32 * HQ_STR * 2, H_QT = H_VT + 128 * HV_STR * 2, H_KT = H_QT + 32 * HQ_STR * 2,
              H_KH = H_KT + 32 * HQ_STR * 2, H_SC = H_KH + 128 * HV_STR * 2, H_DEC = H_SC + 32 * HV_STR * 2, H_END = H_DEC + 512;
static_assert(H_END <= RING_BYTES, "hgrn lds");
DI void hgrn_chain(const Frame& F, int item) {
    const int b = item >> 3, h = (item >> 1) & 3, dir = item & 1;
    const bf16* P = (const bf16*)(F.ws + WS_P);
    bf16* O = (bf16*)(F.ws + (dir ? WS_OB : WS_OF));
    LAS bf16* QR = (LAS bf16*)(F.lds + H_QR); LAS bf16* LFR = (LAS bf16*)(F.lds + H_LFR); LAS bf16* VT = (LAS bf16*)(F.lds + H_VT);
    LAS bf16* QT = (LAS bf16*)(F.lds + H_QT); LAS bf16* KT = (LAS bf16*)(F.lds + H_KT); LAS bf16* KH = (LAS bf16*)(F.lds + H_KH);
    LAS bf16* SC = (LAS bf16*)(F.lds + H_SC); LAS float* DEC = (LAS float*)(F.lds + H_DEC);
    const int w = F.wave, fr = F.lane & 15, fq = F.lane >> 4;
    const int li = F.tid >> 4, lp = F.tid & 15;
    f32x4 S[8];
#pragma unroll
    for (int t = 0; t < 8; ++t) S[t] = (f32x4){0.f, 0.f, 0.f, 0.f};
    auto prow = [&](int c, int i) -> size_t {
        const int ii = dir ? 31 - i : i;
        if (c < 8) { const int cc = dir ? 7 - c : c; return (size_t)NTOK + b * CTXL + 32 * cc + ii; }
        const int col = dir ? 63 - (c - 8) : (c - 8); return (size_t)b * SEQ + ii * 64 + col; };
    v4u rq, rl, rv;
    { const bf16* rp = P + prow(0, li) * INC + 128 * h + 8 * lp; rq = *(const v4u*)(rp + 1024); rv = *(const v4u*)(rp + 1536); rl = *(const v4u*)(rp + 2048 + 512 * dir); }
    bf16x8 Tri[2];
#pragma unroll
    for (int it = 0; it < 2; ++it)
#pragma unroll
        for (int jj = 0; jj < 8; ++jj) Tri[it][jj] = (8 * fq + jj <= 16 * it + fr) ? (short)0x3F80 : (short)0;
#pragma unroll 1
    for (int c = 0; c < 72; ++c) {
        const bool isctx = c < 8;
        *(LAS v4u*)(QR + li * HQ_STR + 8 * lp) = rq;
        *(LAS v4u*)(LFR + li * HQ_STR + 8 * lp) = rl;
        { const unsigned wv[4] = {rv.x, rv.y, rv.z, rv.w};
#pragma unroll
            for (int k = 0; k < 4; ++k) { VT[(8 * lp + 2 * k) * HV_STR + li] = (bf16)(wv[k] & 0xffffu); VT[(8 * lp + 2 * k + 1) * HV_STR + li] = (bf16)(wv[k] >> 16); } }
        if (c + 1 < 72) { const bf16* rp = P + prow(c + 1, li) * INC + 128 * h + 8 * lp; rq = *(const v4u*)(rp + 1024); rv = *(const v4u*)(rp + 1536); rl = *(const v4u*)(rp + 2048 + 512 * dir); }
        __syncthreads();
        {
            bf16x8 Bl;
#pragma unroll
            for (int jj = 0; jj < 8; ++jj) Bl[jj] = (short)LFR[(8 * fq + jj) * HQ_STR + 16 * w + fr];
            f32x4 Gm[2];
#pragma unroll
            for (int it = 0; it < 2; ++it) Gm[it] = __builtin_amdgcn_mfma_f32_16x16x32_bf16(Tri[it], Bl, (f32x4){0.f, 0.f, 0.f, 0.f}, 0, 0, 0);
            const float glast = __shfl(Gm[1][3], 48 + fr);
            const float dec = __expf(glast);
            if (fq == 0) DEC[16 * w + fr] = dec;
            const int d = 16 * w + fr;
#pragma unroll
            for (int it = 0; it < 2; ++it) {
                float kh[4];
#pragma unroll
                for (int r = 0; r < 4; ++r) { const int i = 16 * it + 4 * fq + r;
                    const float qv = bf2f(QR[i * HQ_STR + d]), lf = bf2f(LFR[i * HQ_STR + d]);
                    const float eg = __expf(Gm[it][r]), ieg = 1.0f / eg, kk = 1.0f - __expf(lf);
                    QT[i * HQ_STR + d] = f2bf(qv * eg); KT[i * HQ_STR + d] = f2bf(kk * ieg); kh[r] = kk * dec * ieg; }
                v2u wk; wk.x = pk2(kh[0], kh[1]); wk.y = pk2(kh[2], kh[3]);
                *(LAS v2u*)(KH + d * HV_STR + 16 * it + 4 * fq) = wk;
            }
        }
        __syncthreads();
        f32x4 oacc[2];
        oacc[0] = (f32x4){0.f, 0.f, 0.f, 0.f}; oacc[1] = (f32x4){0.f, 0.f, 0.f, 0.f};
        if (!isctx) {
            if (w < 4) { const int it = w >> 1, jt = w & 1; f32x4 sc = {0.f, 0.f, 0.f, 0.f};
#pragma unroll
                for (int ks = 0; ks < 4; ++ks) { const bf16x8 a = *(const LAS bf16x8*)(QT + (16 * it + fr) * HQ_STR + 32 * ks + 8 * fq), bb = *(const LAS bf16x8*)(KT + (16 * jt + fr) * HQ_STR + 32 * ks + 8 * fq);
                    sc = __builtin_amdgcn_mfma_f32_16x16x32_bf16(a, bb, sc, 0, 0, 0); }
#pragma unroll
                for (int r = 0; r < 4; ++r) { const int i = 16 * it + 4 * fq + r, j = 16 * jt + fr; SC[i * HV_STR + j] = f2bf(j <= i ? sc[r] : 0.f); } }
#pragma unroll
            for (int ks = 0; ks < 4; ++ks) {
                v4u sb; sb.x = pk2(S[2 * ks][0], S[2 * ks][1]); sb.y = pk2(S[2 * ks][2], S[2 * ks][3]); sb.z = pk2(S[2 * ks + 1][0], S[2 * ks + 1][1]); sb.w = pk2(S[2 * ks + 1][2], S[2 * ks + 1][3]);
                const bf16x8 Bs = __builtin_bit_cast(bf16x8, sb);
#pragma unroll
                for (int it = 0; it < 2; ++it) { const v2u a0 = *(const LAS v2u*)(QT + (16 * it + fr) * HQ_STR + 32 * ks + 4 * fq), a1 = *(const LAS v2u*)(QT + (16 * it + fr) * HQ_STR + 32 * ks + 16 + 4 * fq);
                    v4u av; av.x = a0.x; av.y = a0.y; av.z = a1.x; av.w = a1.y;
                    oacc[it] = __builtin_amdgcn_mfma_f32_16x16x32_bf16(__builtin_bit_cast(bf16x8, av), Bs, oacc[it], 0, 0, 0); }
            }
            __syncthreads();
        }
        {
            const bf16x8 Bv = *(const LAS bf16x8*)(VT + (16 * w + fr) * HV_STR + 8 * fq);
            if (!isctx) {
#pragma unroll
                for (int it = 0; it < 2; ++it) { const bf16x8 a = *(const LAS bf16x8*)(SC + (16 * it + fr) * HV_STR + 8 * fq);
                    oacc[it] = __builtin_amdgcn_mfma_f32_16x16x32_bf16(a, Bv, oacc[it], 0, 0, 0); }
                const int col = dir ? 63 - (c - 8) : (c - 8);
#pragma unroll
                for (int it = 0; it < 2; ++it)
#pragma unroll
                    for (int r = 0; r < 4; ++r) { const int i = 16 * it + 4 * fq + r, ii = dir ? 31 - i : i;
                        O[((size_t)b * SEQ + ii * 64 + col) * 512 + 128 * h + 16 * w + fr] = f2bf(oacc[it][r]); }
            }
#pragma unroll
            for (int t = 0; t < 8; ++t) { const f32x4 dv = *(const LAS f32x4*)(DEC + 16 * t + 4 * fq);
                const bf16x8 a = *(const LAS bf16x8*)(KH + (16 * t + fr) * HV_STR + 8 * fq);
                S[t] = __builtin_amdgcn_mfma_f32_16x16x32_bf16(a, Bv, S[t] * dv, 0, 0, 0); }
        }
        __syncthreads();
    }
}
DI void phase_hgrn(const Frame& F) {
    for (int it = F.bx; it < NB * 4 * 2; it += F.G) hgrn_chain(F, it);
}
DI void phase_y2(const Frame& F) {
    const bf16* OFp = (const bf16*)(F.ws + WS_OF); const bf16* OBp = (const bf16*)(F.ws + WS_OB); const bf16* P = (const bf16*)(F.ws + WS_P); bf16* YL = (bf16*)(F.ws + WS_YL);
    const int gw = F.bx * NWAVES + F.wave, NGW = F.G * NWAVES;
    const int c = 8 * F.lane;
    const f32x4 g0 = *(const f32x4*)(F.in[I_HNORM] + c), g1 = *(const f32x4*)(F.in[I_HNORM] + c + 4);
    const float gn[8] = {g0.x, g0.y, g0.z, g0.w, g1.x, g1.y, g1.z, g1.w};
    for (int m = gw; m < NTOK; m += NGW) {
        const v4u a = *(const v4u*)(OFp + (size_t)m * 512 + c), bq = *(const v4u*)(OBp + (size_t)m * 512 + c), sg = *(const v4u*)(P + (size_t)m * INC + 3072 + c);
        float o[8] = {bflo(a.x) + bflo(bq.x), bfhi(a.x) + bfhi(bq.x), bflo(a.y) + bflo(bq.y), bfhi(a.y) + bfhi(bq.y), bflo(a.z) + bflo(bq.z), bfhi(a.z) + bfhi(bq.z), bflo(a.w) + bflo(bq.w), bfhi(a.w) + bfhi(bq.w)};
        const float sgv[8] = {bflo(sg.x), bfhi(sg.x), bflo(sg.y), bfhi(sg.y), bflo(sg.z), bfhi(sg.z), bflo(sg.w), bfhi(sg.w)};
        float ss = 0.f;
#pragma unroll
        for (int j = 0; j < 8; ++j) ss += o[j] * o[j];
        ss += __shfl_xor(ss, 1); ss += __shfl_xor(ss, 2); ss += __shfl_xor(ss, 4); ss += __shfl_xor(ss, 8);
        const float rs = rsqrtf(ss * (1.0f / 128.0f) + EPS);
#pragma unroll
        for (int j = 0; j < 8; ++j) o[j] = o[j] * rs * gn[j] * sgv[j];
        v4u wv; wv.x = pk2(o[0], o[1]); wv.y = pk2(o[2], o[3]); wv.z = pk2(o[4], o[5]); wv.w = pk2(o[6], o[7]);
        *(v4u*)(YL + (size_t)m * D + 512 + c) = wv;
    }
}

DI void phase_route(const Frame& F) {
    const float* LOGIT = (const float*)(F.ws + WS_LOGIT); const float* rb = F.in[I_RB];
    unsigned* cnt = (unsigned*)(F.ws + WS_CTL) + CW_CNT; v2u* LIST = (v2u*)(F.ws + WS_LIST);
    const int gw = F.bx * NWAVES + F.wave, NGW = F.G * NWAVES, l = F.lane;
    const f32x4 rbv = *(const f32x4*)(rb + 4 * l);
    const float NEG = -__builtin_inff();
    for (int tok = gw; tok < NTOK; tok += NGW) {
        const f32x4 lg = *(const f32x4*)(LOGIT + (size_t)tok * NE + 4 * l);
        float sc[4], bs[4];
#pragma unroll
        for (int k = 0; k < 4; ++k) { sc[k] = 1.0f / (1.0f + expf(-lg[k])); bs[k] = sc[k] + rbv[k]; }
        float m1 = NEG, m2 = NEG;
#pragma unroll
        for (int k = 0; k < 4; ++k) { const float v = bs[k]; if (v > m1) { m2 = m1; m1 = v; } else if (v > m2) m2 = v; }
#pragma unroll
        for (int off = 1; off < 8; off <<= 1) { const float o1 = __shfl_xor(m1, off), o2 = __shfl_xor(m2, off);
            const float n1 = fmaxf(m1, o1), n2 = fmaxf(fminf(m1, o1), fmaxf(m2, o2)); m1 = n1; m2 = n2; }
        const float gs = m1 + m2; const int g = l >> 3; int rank = 0;
#pragma unroll
        for (int gg = 0; gg < 8; ++gg) { const float og = __shfl(gs, gg * 8); rank += (og > gs || (og == gs && gg < g)) ? 1 : 0; }
        const bool sel = rank < 4;
        float cv[4];
#pragma unroll
        for (int k = 0; k < 4; ++k) cv[k] = sel ? bs[k] : NEG;
        float sum = 0.f, mysc = 0.f; int myexp = 0;
#pragma unroll 1
        for (int r = 0; r < TOPK; ++r) {
            float v = cv[0]; int e = 4 * l;
#pragma unroll
            for (int k = 1; k < 4; ++k) if (cv[k] > v) { v = cv[k]; e = 4 * l + k; }
#pragma unroll
            for (int off = 1; off < 64; off <<= 1) { const float ov = __shfl_xor(v, off); const int oe = __shfl_xor(e, off); if (ov > v || (ov == v && oe < e)) { v = ov; e = oe; } }
            const int ek = e & 3;
            const float scsel = ek == 0 ? sc[0] : ek == 1 ? sc[1] : ek == 2 ? sc[2] : sc[3];
            const float se = __shfl(scsel, e >> 2);
            if (l == (e >> 2)) {
#pragma unroll
                for (int k = 0; k < 4; ++k) if (k == ek) cv[k] = NEG; }
            sum += se; if (l == r) { myexp = e; mysc = se; }
        }
        if (l < TOPK) { const float gate = mysc / sum * 2.5f; const unsigned pos = atomicAdd(&cnt[myexp], 1u);
            LIST[(size_t)myexp * LISTCAP + pos] = (v2u){(unsigned)(tok * TOPK + l), __float_as_uint(gate)}; }
    }
}

template <bool GATHER> DI void moe_setup(const Frame& F, int ncol, int& total) {
    LAS int* ts = (LAS int*)(F.lds + LDS_TS); LAS int* cl = (LAS int*)(F.lds + LDS_CNT); LAS int* idx = (LAS int*)(F.lds + LDS_IDX);
    const unsigned* cnt = (const unsigned*)(F.ws + WS_CTL) + CW_CNT;
    if (F.tid < 256) cl[F.tid] = (int)__hip_atomic_load(cnt + F.tid, __ATOMIC_RELAXED, __HIP_MEMORY_SCOPE_AGENT);
    __syncthreads();
    if (F.tid == 0) { int s = 0; for (int e = 0; e < 256; ++e) { ts[e] = s; s += (cl[e] + 255) >> 8; } ts[256] = s; }
    __syncthreads();
    const int Te = ts[256]; total = (Te + NTOK / 256) * ncol;
    if (GATHER) {
        const v2u* LIST = (const v2u*)(F.ws + WS_LIST);
        for (int ord = 0; ord < 12; ++ord) { const int L = ord * F.G + F.vcu; if (L >= total) break;
            const int rt = L / ncol;
            if (F.tid < 256) { int v;
                if (rt >= Te) v = (rt - Te) * 256 + F.tid;
                else { int lo = 0, hi = 256; while (hi - lo > 1) { const int mid = (lo + hi) >> 1; if (ts[mid] <= rt) lo = mid; else hi = mid; }
                    const int r = (rt - ts[lo]) * 256 + F.tid; v = (r < cl[lo]) ? (int)(LIST[(size_t)lo * LISTCAP + r].x >> 3) : 0; }
                idx[ord * 256 + F.tid] = v; } }
    }
    __syncthreads();
}

DI void phase_combine(const Frame& F, int mode) {
    const float* MOD = (const float*)(F.ws + WS_MOD);
    const bf16* YB = (const bf16*)(F.ws + WS_YB); const bf16* YS = (const bf16*)(F.ws + WS_YS);
    const int gw = F.bx * NWAVES + F.wave, NGW = F.G * NWAVES;
    const float* nf = F.in[I_NFIN];
    for (int m = gw; m < NTOK; m += NGW) {
        const int b = m >> 11;
        float x2[16]; float ss = 0.f;
#pragma unroll
        for (int j = 0; j < 2; ++j) { const int c = 8 * F.lane + 512 * j;
            float s[8];
#pragma unroll
            for (int q = 0; q < 8; ++q) s[q] = 0.f;
            const float* xsrc = mode == 2 ? F.in[I_X] : (const float*)(F.ws + WS_X1);
            if (mode == 0) {
#pragma unroll
                for (int k = 0; k < 9; ++k) { const v4u w = (k < 8) ? *(const v4u*)(YB + ((size_t)m * TOPK + k) * D + c) : *(const v4u*)(YS + (size_t)m * D + c);
                    s[0] += bflo(w.x); s[1] += bfhi(w.x); s[2] += bflo(w.y); s[3] += bfhi(w.y); s[4] += bflo(w.z); s[5] += bfhi(w.z); s[6] += bflo(w.w); s[7] += bfhi(w.w); } }
            const f32x4 xa = *(const f32x4*)(xsrc + (size_t)m * D + c), xb = *(const f32x4*)(xsrc + (size_t)m * D + c + 4);
            const f32x4 ga = *(const f32x4*)(MOD + b * 6144 + 5120 + c), gb = *(const f32x4*)(MOD + b * 6144 + 5120 + c + 4);
            const float xv[8] = {xa.x, xa.y, xa.z, xa.w, xb.x, xb.y, xb.z, xb.w}, gv[8] = {ga.x, ga.y, ga.z, ga.w, gb.x, gb.y, gb.z, gb.w};
#pragma unroll
            for (int q = 0; q < 8; ++q) { const float v = xv[q] + gv[q] * s[q]; x2[8 * j + q] = v; ss += v * v; } }
        const float rs = rsqrtf(wave_sum(ss) * (1.0f / D) + EPS);
#pragma unroll
        for (int j = 0; j < 2; ++j) { const int c = 8 * F.lane + 512 * j;
            const f32x4 na = *(const f32x4*)(nf + c), nb = *(const f32x4*)(nf + c + 4);
            f32x4 oa = {x2[8 * j] * rs * na.x, x2[8 * j + 1] * rs * na.y, x2[8 * j + 2] * rs * na.z, x2[8 * j + 3] * rs * na.w};
            f32x4 ob = {x2[8 * j + 4] * rs * nb.x, x2[8 * j + 5] * rs * nb.y, x2[8 * j + 6] * rs * nb.z, x2[8 * j + 7] * rs * nb.w};
            *(f32x4*)(F.out + (size_t)m * D + c) = oa; *(f32x4*)(F.out + (size_t)m * D + c + 4) = ob; }
    }
}

constexpr int NPHASE = 13;
__global__ void __launch_bounds__(NTHR, 2) fwd_kernel(Args args) {
    extern __shared__ __attribute__((aligned(16))) unsigned char lds_raw[];
    Frame F;
    F.lds = (LAS unsigned char*)lds_raw;
    F.tid = threadIdx.x; F.lane = F.tid & 63; F.wave = __builtin_amdgcn_readfirstlane(F.tid >> 6);
    F.G = gridDim.x; F.bx = blockIdx.x; F.vcu = (F.G % 8 == 0) ? (F.bx % 8) * (F.G / 8) + F.bx / 8 : F.bx;
    F.in = args.in; F.out = args.out; F.ws = args.ws;
    volatile LAS unsigned* MISC = (volatile LAS unsigned*)(F.lds + LDS_MISC);
    if (F.tid < 16) MISC[F.tid] = 0u;
    __syncthreads();
    XcdBarrier bar; bar.bar = (unsigned*)(F.ws + WS_CTL) + CW_BAR; bar.x = 0; bar.st = nullptr;
#if !PER_PHASE_LAUNCH
    bar = xcd_barrier_post((unsigned*)(F.ws + WS_CTL) + CW_BAR, MISC + 8);
#define GRID_BAR() xcd_barrier(bar)
#else
#define GRID_BAR() do {} while (0)
#endif
    const int lo = args.ph_lo, hi = args.ph_hi;
#ifndef PH_MASK
#define PH_MASK 0xFFFF
#endif
#define IN(k) (((PH_MASK >> (k)) & 1) && lo <= (k) && (k) < hi)
#define SEAM(k) do { if (IN(k) && IN((k) + 1)) GRID_BAR(); } while (0)
#ifndef REPEAT_MASK
#define REPEAT_MASK 0
#endif
#define REPS(k) (1 + ((REPEAT_MASK >> (k)) & 1))
    unsigned char* ws = F.ws;

    if (IN(0)) _Pragma("unroll") for (int rep = 0; rep < REPS(0); ++rep) { if (rep) GRID_BAR(); phase_prologue(F); } SEAM(0);
    if (IN(1)) _Pragma("unroll") for (int rep = 0; rep < REPS(1); ++rep) { if (rep) GRID_BAR(); phase_norm_rows(F, 0); } SEAM(1);
    if (IN(2)) _Pragma("unroll") for (int rep = 0; rep < REPS(2); ++rep) { if (rep) GRID_BAR();
        pg8::DenseOrder S; S.init(ws + WS_HX, ws + WS_WIN, MTOT, INC, D, F.G, F.bx);
        pg8::EpiInProj E{(bf16*)(ws + WS_P), (const float*)(ws + WS_TAB)};
        pg8::gemm_phase(F.lds, D, S, E);
    } SEAM(2);
    if (IN(3)) _Pragma("unroll") for (int rep = 0; rep < REPS(3); ++rep) { if (rep) GRID_BAR(); phase_lru_pass1(F); } SEAM(3);
    if (IN(4)) _Pragma("unroll") for (int rep = 0; rep < REPS(4); ++rep) { if (rep) GRID_BAR(); phase_lru_carry(F); phase_hgrn(F); } SEAM(4);
    if (IN(5)) _Pragma("unroll") for (int rep = 0; rep < REPS(5); ++rep) { if (rep) GRID_BAR(); phase_lru_pass2(F); phase_y2(F); } SEAM(5);
    if (IN(6)) _Pragma("unroll") for (int rep = 0; rep < REPS(6); ++rep) { if (rep) GRID_BAR();
        pg8::DenseOrder S; S.init(ws + WS_YL, ws + WS_WOUT, NTOK, D, D, F.G, F.bx);
        pg8::EpiResid E{F.in[I_X], (const float*)(ws + WS_MOD), (float*)(ws + WS_X1)};
        pg8::gemm_phase(F.lds, D, S, E);
    } SEAM(6);
#if DBG_STOP == 1
    if (IN(7)) _Pragma("unroll") for (int rep = 0; rep < REPS(7); ++rep) { if (rep) GRID_BAR(); phase_combine(F, 1); }
#else
    if (IN(7)) _Pragma("unroll") for (int rep = 0; rep < REPS(7); ++rep) { if (rep) GRID_BAR(); phase_norm_rows(F, 1); } SEAM(7);
    if (IN(8)) _Pragma("unroll") for (int rep = 0; rep < REPS(8); ++rep) { if (rep) GRID_BAR();
        pg8::DenseOrder S; S.init(ws + WS_HX2, ws + WS_WR, NTOK, NE, D, F.G, F.bx);
        pg8::EpiF32 E{(float*)(ws + WS_LOGIT), NE};
        pg8::gemm_phase(F.lds, D, S, E);
    } SEAM(8);
    if (IN(9)) _Pragma("unroll") for (int rep = 0; rep < REPS(9); ++rep) { if (rep) GRID_BAR(); phase_route(F); } SEAM(9);
    if (IN(10)) _Pragma("unroll") for (int rep = 0; rep < REPS(10); ++rep) { if (rep) GRID_BAR();
        int total; moe_setup<true>(F, 2, total);
        pg8::MoeOrder<true> S; S.A = (const char*)(ws + WS_HX2); S.Bt = (const char*)(ws + WS_EW13); S.BtS = (const char*)(ws + WS_SW13); S.K = D; S.ncol = 2; S.estride = (size_t)512 * 1024 * 2;
        S.ts = (const LAS int*)(F.lds + LDS_TS); S.cnt = (const LAS int*)(F.lds + LDS_CNT); S.idx = (const LAS int*)(F.lds + LDS_IDX); S.G = F.G; S.vcu = F.vcu; S.total = total;
        pg8::EpiSwiGLU E{(bf16*)(ws + WS_ACT)};
        pg8::gemm_phase(F.lds, D, S, E);
    } SEAM(10);
    if (IN(11)) _Pragma("unroll") for (int rep = 0; rep < REPS(11); ++rep) { if (rep) GRID_BAR();
        int total; moe_setup<false>(F, 4, total);
        pg8::MoeOrder<false> S; S.A = (const char*)(ws + WS_ACT); S.Bt = (const char*)(ws + WS_EW2); S.BtS = (const char*)(ws + WS_SW2); S.K = DE; S.ncol = 4; S.estride = (size_t)1024 * 256 * 2;
        S.ts = (const LAS int*)(F.lds + LDS_TS); S.cnt = (const LAS int*)(F.lds + LDS_CNT); S.idx = (const LAS int*)(F.lds + LDS_IDX); S.G = F.G; S.vcu = F.vcu; S.total = total;
        pg8::EpiScatter E{(bf16*)(ws + WS_YB), (bf16*)(ws + WS_YS), (const v2u*)(ws + WS_LIST), (bf16*)(ws + WS_DUMP)};
        pg8::gemm_phase(F.lds, DE, S, E);
    } SEAM(11);
    if (IN(12)) _Pragma("unroll") for (int rep = 0; rep < REPS(12); ++rep) { if (rep) GRID_BAR(); phase_combine(F, 0); }
#endif
}

extern "C" void kernel_launch(void* const* d_in, const int* in_sizes, int n_in, void* d_out, int out_size, void* d_ws, size_t ws_size, hipStream_t stream) {
    static int grid = 0;
    if (grid == 0) {
        if (n_in != 26 || in_sizes[0] != NTOK * D || out_size != NTOK * D || ws_size < WS_END) { fprintf(stderr, "kernel_launch: unexpected shapes (n_in %d, ws %zu)\n", n_in, ws_size); grid = -1; return; }
        int dev = 0, cus = 0, per_cu = 0;
        if (hipGetDevice(&dev) != hipSuccess || hipDeviceGetAttribute(&cus, hipDeviceAttributeMultiprocessorCount, dev) != hipSuccess) { grid = -1; return; }
        if (hipFuncSetAttribute((const void*)fwd_kernel, hipFuncAttributeMaxDynamicSharedMemorySize, LDS_BYTES) != hipSuccess) { fprintf(stderr, "kernel_launch: hipFuncSetAttribute failed\n"); grid = -1; return; }
        if (hipOccupancyMaxActiveBlocksPerMultiprocessor(&per_cu, (const void*)fwd_kernel, NTHR, LDS_BYTES) != hipSuccess || per_cu < 1) { fprintf(stderr, "kernel_launch: occupancy query says %d\n", per_cu); }
        (void)hipGetLastError();
        grid = cus;
    }
    if (grid < 0) return;
    hipMemsetAsync((char*)d_ws + WS_CTL, 0, CTL_ZERO_BYTES, stream);
    Args a{};
    for (int i = 0; i < 26; ++i) a.in[i] = (const float*)d_in[i];
    a.out = (float*)d_out; a.ws = (unsigned char*)d_ws;
#if PER_PHASE_LAUNCH
    for (int p = 0; p < NPHASE; ++p) { a.ph_lo = p; a.ph_hi = p + 1; hipLaunchKernelGGL(fwd_kernel, dim3(grid), dim3(NTHR), LDS_BYTES, stream, a); }
#else
    a.ph_lo = 0; a.ph_hi = NPHASE;
    hipLaunchKernelGGL(fwd_kernel, dim3(grid), dim3(NTHR), LDS_BYTES, stream, a);
#endif
}
```

```cpp
#include <hip/hip_runtime.h>
#include <cstdio>
#include <cstdint>

#ifndef PER_PHASE_LAUNCH
#define PER_PHASE_LAUNCH 0
#endif
#ifndef DBG_STOP
#define DBG_STOP 0
#endif

#define GAS __attribute__((address_space(1)))
#define LAS __attribute__((address_space(3)))
#define DI __device__ __forceinline__
typedef unsigned short bf16;
typedef unsigned v4u __attribute__((ext_vector_type(4)));
typedef unsigned v2u __attribute__((ext_vector_type(2)));
typedef float f32x4 __attribute__((ext_vector_type(4)));
typedef float f32x2 __attribute__((ext_vector_type(2)));
typedef short bf16x8 __attribute__((ext_vector_type(8)));
typedef __bf16 bfv2 __attribute__((ext_vector_type(2)));

constexpr int D = 1024, NB = 16, SEQ = 2048, CTXL = 256;
constexpr int NTOK = NB * SEQ;
constexpr int NCTX = NB * CTXL;
constexpr int MTOT = NTOK + NCTX;
constexpr int INC = 3584;
constexpr int NE = 256, TOPK = 8, DE = 256;
constexpr int LISTCAP = 32768;
constexpr float EPS = 1e-6f;
constexpr int NWAVES = 8, NTHR = 512;
constexpr int NSEQT = 36;

constexpr size_t MiB = 1u << 20;
constexpr size_t WS_CTL = 0, CTL_ZERO_BYTES = 1 * MiB;
constexpr size_t WS_MOD = 1 * MiB;
constexpr size_t WS_TAB = 2 * MiB;
constexpr size_t WS_WGT = 2 * MiB + 65536;
constexpr size_t WS_WIN = 3 * MiB;
constexpr size_t WS_WOUT = 10 * MiB;
constexpr size_t WS_WR = 12 * MiB;
constexpr size_t WS_SW13 = 12 * MiB + 512 * 1024;
constexpr size_t WS_SW2 = 13 * MiB + 512 * 1024;
constexpr size_t WS_DUMP = 2 * MiB + 16384;
constexpr size_t WS_SUMA = 14 * MiB;
constexpr size_t WS_SUMH = WS_SUMA + 2359296;
constexpr size_t WS_CIN = WS_SUMH + 2359296;
constexpr size_t WS_ROUTE = 21 * MiB;
constexpr size_t WS_HIST = 23 * MiB;
constexpr size_t WS_EW13 = 32 * MiB;
constexpr size_t WS_EW2 = 288 * MiB;
constexpr size_t WS_X1 = 416 * MiB;
constexpr size_t WS_HX2 = 544 * MiB;
constexpr size_t WS_LOGIT = 608 * MiB;
constexpr size_t WS_LIST = 1426 * MiB;
constexpr size_t WS_ACT = 674 * MiB;
constexpr size_t WS_YS = 850 * MiB;
constexpr size_t WS_P = 914 * MiB;
constexpr size_t WS_HX = 1166 * MiB;
constexpr size_t WS_OF = 1238 * MiB;
constexpr size_t WS_OB = 1270 * MiB;
constexpr size_t WS_YL = 1302 * MiB;
constexpr size_t WS_YB = 914 * MiB;
constexpr size_t WS_END = 1490 * MiB;
constexpr int CW_BAR = 4096;
constexpr int CW_CNT = 16384;

constexpr int RING_BYTES = 131072;
constexpr int LDS_TS = RING_BYTES;
constexpr int LDS_CNT = LDS_TS + 1088;
constexpr int LDS_IDX = LDS_CNT + 1024;
constexpr int LDS_MISC = LDS_IDX + 12 * 1024;
constexpr int LDS_BYTES = 155648;
static_assert(LDS_MISC + 64 <= LDS_BYTES, "lds map");

DI unsigned pk2(float lo, float hi) { f32x2 v = {lo, hi}; bfv2 b = __builtin_convertvector(v, bfv2); return __builtin_bit_cast(unsigned, b); }
DI float bflo(unsigned w) { return __uint_as_float(w << 16); }
DI float bfhi(unsigned w) { return __uint_as_float(w & 0xffff0000u); }
DI float bf2f(bf16 h) { return __uint_as_float(((unsigned)h) << 16); }
DI bf16 f2bf(float f) { return (bf16)(pk2(f, 0.f) & 0xffffu); }
DI float rcpf_(float x) { return __builtin_amdgcn_rcpf(x); }
DI float ex2f_(float x) { return __builtin_amdgcn_exp2f(x); }
DI float expf_(float x) { return __builtin_amdgcn_exp2f(x * 1.4426950408889634f); }
DI float logf_(float x) { return __builtin_amdgcn_logf(x) * 0.6931471805599453f; }
DI float sigm(float x) { return rcpf_(1.0f + expf_(-x)); }
DI float wave_sum(float v) {
#pragma unroll
    for (int o = 1; o < 64; o <<= 1) v += __shfl_xor(v, o);
    return v;
}
#define LDS_WAIT() asm volatile("s_waitcnt lgkmcnt(0)" ::: "memory")

#define XB_TMO      128
#define XB_XCNT(j)  (256  + 64 * (j))
#define XB_XSUB(j)  (1280 + 64 * (j))
#define XB_XGEN(j)  (2304 + 64 * (j))
#define XB_TOP      3328
#define XB_TOPGEN   3392
#define XCD_BAR_WORDS 3456
#define XB_SPIN_CAP (1u << 18)
__device__ __forceinline__ unsigned xb_ld(unsigned* p)              { return __hip_atomic_load(p, __ATOMIC_RELAXED, __HIP_MEMORY_SCOPE_AGENT); }
__device__ __forceinline__ unsigned xb_add(unsigned* p, unsigned v) { return __hip_atomic_fetch_add(p, v, __ATOMIC_RELAXED, __HIP_MEMORY_SCOPE_AGENT); }
__device__ __forceinline__ unsigned xb_xcc_id() { return (unsigned)__builtin_amdgcn_s_getreg((3 << 11) | 20) & 0xFu; }
#define XB_SPIN(cond, bar) do { unsigned _sp = 0; while (cond) { __builtin_amdgcn_s_sleep(1); \
    if ((++_sp & 255u) == 0u) { if (xb_ld(&(bar)[XB_TMO])) break; if (_sp > XB_SPIN_CAP) { atomicAdd(&(bar)[XB_TMO], 1u); break; } } } } while (0)
struct XcdBarrier { unsigned* bar; unsigned x; volatile LAS unsigned* st; };
__device__ __forceinline__ XcdBarrier xcd_barrier_post(unsigned* bar, volatile LAS unsigned* st) {
    XcdBarrier b; b.bar = bar; b.x = xb_xcc_id(); b.st = st;
    if (threadIdx.x == 0) (void)xb_add(&bar[XB_XCNT(b.x)], 1u);
    return b;
}
__device__ __forceinline__ void xcd_barrier_complete(unsigned* bar, unsigned x, unsigned& nloc, unsigned& nx) {
    const unsigned G = gridDim.x * gridDim.y * gridDim.z;
    unsigned sum, cnt, mine, sp = 0u;
    for (;;) {
        sum = 0u; cnt = 0u; mine = 0u;
#pragma unroll
        for (unsigned j = 0; j < 16; ++j) { const unsigned c = xb_ld(&bar[XB_XCNT(j)]); sum += c; cnt += (c > 0u) ? 1u : 0u; mine = (j == x) ? c : mine; }
        if (sum == G) break;
        __builtin_amdgcn_s_sleep(1);
        if ((++sp & 255u) == 0u) { if (xb_ld(&bar[XB_TMO])) break; if (sp > XB_SPIN_CAP) { atomicAdd(&bar[XB_TMO], 1u); break; } }
    }
    nloc = mine > 0u ? mine : 1u; nx = cnt > 0u ? cnt : 1u;
}
__device__ __forceinline__ void xcd_barrier(const XcdBarrier& b) {
    asm volatile("s_waitcnt vmcnt(0)" ::: "memory");
    __syncthreads();
    if (threadIdx.x == 0) {
        unsigned* bar = b.bar;
        __builtin_amdgcn_s_waitcnt(0);
        unsigned nloc = b.st[0], nx = b.st[1];
        if (nloc == 0u) { xcd_barrier_complete(bar, b.x, nloc, nx); b.st[0] = nloc; b.st[1] = nx; }
        const unsigned old = xb_add(&bar[XB_XSUB(b.x)], 1u);
        const unsigned gen = old / nloc;
        if (old + 1u == (gen + 1u) * nloc) {
            __builtin_amdgcn_fence(__ATOMIC_RELEASE, "agent");
            asm volatile("s_waitcnt vmcnt(0)" ::: "memory");
            const unsigned og = xb_add(&bar[XB_TOP], 1u);
            const unsigned tg = og / nx;
            if (og + 1u == (tg + 1u) * nx) xb_add(&bar[XB_TOPGEN], 1u);
            else XB_SPIN(xb_ld(&bar[XB_TOPGEN]) == tg, bar);
            __builtin_amdgcn_fence(__ATOMIC_ACQUIRE, "agent");
            xb_add(&bar[XB_XGEN(b.x)], 1u);
            asm volatile("s_waitcnt vmcnt(0)" ::: "memory");
        } else {
            XB_SPIN(xb_ld(&bar[XB_XGEN(b.x)]) == gen, bar);
            __builtin_amdgcn_fence(__ATOMIC_ACQUIRE, "agent");
            asm volatile("s_waitcnt vmcnt(0)" ::: "memory");
        }
    }
    __syncthreads();
}

namespace pg8 {
constexpr int BM = 256, BK = 64, HALF = 128, HTB = HALF * BK * 2, NXCD = 8, WGM = 8;
DI int lds_byte(int r, int c) { const int st = (r >> 4) * 2 + (c >> 5), rr = r & 15, cc = c & 31, ob = rr * 64 + cc * 2; return st * 1024 + (ob ^ (((ob >> 9) & 1) << 5)); }
DI void stage_rc(int b, int& R, int& C) { const int st = b / 1024, sb = b % 1024, swz = sb ^ (((sb >> 9) & 1) << 5); R = (st >> 1) * 16 + swz / 64; C = (st & 1) * 32 + (swz % 64) / 2; }
DI int perm32(int rho) { const int n = rho >> 4, i = rho & 15; return 8 * (i >> 2) + 4 * n + (i & 3); }

struct Unit { int pm, pn, e, rt, ord, nrows; };

struct DenseOrder {
    const char* A; const char* Bt; int K, nM, nN, nwg, G, c;
    DI void init(const void* A_, const void* Bt_, int M, int N, int K_, int G_, int c_) { A = (const char*)A_; Bt = (const char*)Bt_; K = K_; nM = M / BM; nN = N / BM; nwg = nM * nN; G = G_; c = c_; }
    DI bool next(int i, Unit& u) const {
        const long L = (long)i * G + c; if (L >= nwg) return false;
        int wgid = (int)L; { const int q = nwg / NXCD, r = nwg % NXCD, xcd = wgid % NXCD, off = wgid / NXCD; wgid = (xcd < r ? xcd * (q + 1) : r * (q + 1) + (xcd - r) * q) + off; }
        const int nig = WGM * nN, gid = wgid / nig, fm = gid * WGM, gsz = (nM - fm) < WGM ? (nM - fm) : WGM;
        u.pm = fm + ((wgid % nig) % gsz); u.pn = (wgid % nig) / gsz; u.e = 0; u.rt = u.pm; u.ord = i; u.nrows = 256; return true;
    }
    DI const char* a_base(const Unit& u) const { return A + (size_t)u.pm * BM * K * 2; }
    DI const char* b_base(const Unit& u) const { return Bt + (size_t)u.pn * BM * K * 2; }
    DI void a_offs(const Unit&, const int (&R)[2], const int (&C)[2], unsigned (&v)[2][2]) const {
#pragma unroll
        for (int h = 0; h < 2; ++h)
#pragma unroll
            for (int i = 0; i < 2; ++i) v[h][i] = (unsigned)((h * HALF + R[i]) * K + C[i]) * 2u;
    }
};

template <bool GATHER> struct MoeOrder {
    const char* A; const char* Bt; const char* BtS; int K, ncol; size_t estride;
    const LAS int* ts; const LAS int* cnt; const LAS int* idx; int G, vcu, total;
    DI bool next(int i, Unit& u) const {
        const int L = i * G + vcu; if (L >= total) return false;
        const int rt = L / ncol; u.pn = L - rt * ncol; u.rt = rt; u.ord = i;
        const int Te = ts[256];
        if (rt >= Te) { u.e = 256; u.pm = rt - Te; u.nrows = 256; }
        else { int lo = 0, hi = 256;
#pragma unroll 1
            while (hi - lo > 1) { const int mid = (lo + hi) >> 1; if (ts[mid] <= rt) lo = mid; else hi = mid; }
            u.e = lo; u.pm = rt - ts[lo]; const int rem = cnt[lo] - u.pm * 256; u.nrows = rem < 256 ? rem : 256; }
        return true;
    }
    DI const char* a_base(const Unit& u) const { return GATHER ? A : A + (size_t)u.rt * BM * K * 2; }
    DI const char* b_base(const Unit& u) const { return (u.e < 256 ? Bt + (size_t)u.e * estride : BtS) + (size_t)u.pn * BM * K * 2; }
    DI void a_offs(const Unit& u, const int (&R)[2], const int (&C)[2], unsigned (&v)[2][2]) const {
#pragma unroll
        for (int h = 0; h < 2; ++h)
#pragma unroll
            for (int i = 0; i < 2; ++i) {
                if (GATHER) v[h][i] = ((unsigned)idx[u.ord * 256 + h * HALF + R[i]] * (unsigned)K + (unsigned)C[i]) * 2u;
                else v[h][i] = (unsigned)((h * HALF + R[i]) * K + C[i]) * 2u;
            }
    }
};

template <class Epi, class Sched>
__device__ __forceinline__ void gemm_phase(LAS unsigned char* lds, const int K, const Sched& S, const Epi& E) {
    const int tid = threadIdx.x, wid = __builtin_amdgcn_readfirstlane(tid >> 6), lane = tid & 63, wr = wid >> 2, wc = wid & 3, fr = lane & 15, fq = lane >> 4;
    const int nt = K / BK;
    unsigned voffB[2]; int Rr[2], Cc[2];
#pragma unroll
    for (int i = 0; i < 2; ++i) { int R, C; stage_rc(tid * 16 + i * 8192, R, C); const int Rb = Epi::PERM ? ((R & ~31) + perm32(R & 31)) : R;
        voffB[i] = (unsigned)(Rb * K + C) * 2u; Rr[i] = R; Cc[i] = C; }
    const size_t kstep = (size_t)(BK * 2);
    const size_t hstep = (size_t)HALF * K * 2;
    const unsigned ldsw = (unsigned)wid * 1024u;
    const int aoff = lds_byte(wr * 64 + fr, fq * 8), boff = lds_byte(wc * 32 + fr, fq * 8);
#define PG8_SA(b, h) (((b) * 2 + (h)) * HTB)
#define PG8_SB(b, h) ((4 + (b) * 2 + (h)) * HTB)
#define PG8_STAGE(bufoff, gbase, voff) do { _Pragma("unroll") for (int _i = 0; _i < 2; ++_i) \
        __builtin_amdgcn_global_load_lds((const unsigned*)((const char*)(gbase) + (voff)[_i]), (LAS unsigned*)(lds + (bufoff) + ldsw + _i * 8192), 16, 0, 0); } while (0)
#define PG8_LDA(dst, b, h) do { _Pragma("unroll") for (int m = 0; m < 4; ++m) _Pragma("unroll") for (int k = 0; k < 2; ++k) dst[m][k] = *(const LAS bf16x8*)(lds + PG8_SA(b, h) + aoff + m * 2048 + k * 1024); } while (0)
#define PG8_LDB(dst, b, h) do { _Pragma("unroll") for (int n = 0; n < 2; ++n) _Pragma("unroll") for (int k = 0; k < 2; ++k) dst[n][k] = *(const LAS bf16x8*)(lds + PG8_SB(b, h) + boff + n * 2048 + k * 1024); } while (0)
#define PG8_MMA(ai, bj, At, Bt) do { __builtin_amdgcn_s_setprio(1); _Pragma("unroll") for (int m = 0; m < 4; ++m) _Pragma("unroll") for (int n = 0; n < 2; ++n) _Pragma("unroll") for (int k = 0; k < 2; ++k) \
        acc[ai][bj][m][n] = __builtin_amdgcn_mfma_f32_16x16x32_bf16(Bt[n][k], At[m][k], acc[ai][bj][m][n], 0, 0, 0); __builtin_amdgcn_s_setprio(0); } while (0)
#define PG8_WAIT_V(n) asm volatile("s_waitcnt vmcnt(" #n ")" ::: "memory")
#define PG8_WAIT_L(n) asm volatile("s_waitcnt lgkmcnt(" #n ")" ::: "memory")
#define PG8_BAR __builtin_amdgcn_s_barrier()
#define PG8_SCHED __builtin_amdgcn_sched_barrier(0)
    Unit cur, nxt; int ui = 0;
    if (!S.next(0, cur)) return;
    f32x4 acc[2][2][4][2];
#pragma unroll
    for (int a = 0; a < 2; ++a)
#pragma unroll
        for (int b = 0; b < 2; ++b)
#pragma unroll
            for (int m = 0; m < 4; ++m)
#pragma unroll
                for (int n = 0; n < 2; ++n) acc[a][b][m][n] = (f32x4){0.f, 0.f, 0.f, 0.f};
    bf16x8 At[4][2], B0[2][2], B1[2][2];
    unsigned vC[2][2], vN[2][2];
    S.a_offs(cur, Rr, Cc, vC);
    const char* cA = S.a_base(cur); const char* cB = S.b_base(cur);
    PG8_STAGE(PG8_SB(0, 0), cB, voffB); PG8_STAGE(PG8_SA(0, 0), cA, vC[0]); PG8_STAGE(PG8_SB(0, 1), cB + hstep, voffB); PG8_STAGE(PG8_SA(0, 1), cA, vC[1]);
    if (wr == 1) PG8_BAR;
    PG8_WAIT_V(4); PG8_BAR;
    PG8_STAGE(PG8_SB(1, 0), cB + kstep, voffB); PG8_STAGE(PG8_SA(1, 0), cA + kstep, vC[0]); PG8_STAGE(PG8_SB(1, 1), cB + hstep + kstep, voffB);
    PG8_WAIT_V(6); PG8_BAR;
    for (;;) {
        const bool has_next = S.next(ui + 1, nxt);
        const char* nA = has_next ? S.a_base(nxt) : cA; const char* nB = has_next ? S.b_base(nxt) : cB;
        if (has_next) S.a_offs(nxt, Rr, Cc, vN);
        else { vN[0][0] = vC[0][0]; vN[0][1] = vC[0][1]; vN[1][0] = vC[1][0]; vN[1][1] = vC[1][1]; }
#pragma unroll 1
        for (int t = 0; t < nt; t += 2) {
            const bool last = (t == nt - 2);
            const char* a1 = cA + (size_t)(t + 1) * kstep;
            const char* a2 = last ? nA : cA + (size_t)(t + 2) * kstep; const char* b2 = last ? nB : cB + (size_t)(t + 2) * kstep;
            const char* a3 = a2 + kstep; const char* b3 = b2 + kstep;
            unsigned x0[2], x1[2];
            x0[0] = last ? vN[0][0] : vC[0][0]; x0[1] = last ? vN[0][1] : vC[0][1]; x1[0] = last ? vN[1][0] : vC[1][0]; x1[1] = last ? vN[1][1] : vC[1][1];
            PG8_LDB(B0, 0, 0); PG8_SCHED; PG8_LDA(At, 0, 0); PG8_STAGE(PG8_SA(1, 1), a1, vC[1]);
            PG8_WAIT_L(8); PG8_BAR; PG8_WAIT_L(0); PG8_MMA(0, 0, At, B0); PG8_BAR; PG8_SCHED;
            PG8_LDB(B1, 0, 1); PG8_STAGE(PG8_SB(0, 0), b2, voffB);
            PG8_BAR; PG8_WAIT_L(0); PG8_MMA(0, 1, At, B1); PG8_BAR;
            PG8_LDA(At, 0, 1); PG8_STAGE(PG8_SA(0, 0), a2, x0);
            PG8_BAR; PG8_WAIT_L(0); PG8_MMA(1, 0, At, B0); PG8_BAR; PG8_SCHED;
            PG8_STAGE(PG8_SB(0, 1), b2 + hstep, voffB);
            PG8_WAIT_V(6); PG8_BAR; PG8_MMA(1, 1, At, B1); PG8_BAR;
            PG8_LDB(B0, 1, 0); PG8_SCHED; PG8_LDA(At, 1, 0); PG8_STAGE(PG8_SA(0, 1), a2, x1);
            PG8_WAIT_L(8); PG8_BAR; PG8_WAIT_L(0); PG8_MMA(0, 0, At, B0); PG8_BAR; PG8_SCHED;
            PG8_LDB(B1, 1, 1); PG8_STAGE(PG8_SB(1, 0), b3, voffB);
            PG8_BAR; PG8_WAIT_L(0); PG8_MMA(0, 1, At, B1); PG8_BAR;
            PG8_LDA(At, 1, 1); PG8_STAGE(PG8_SA(1, 0), a3, x0);
            PG8_BAR; PG8_WAIT_L(0); PG8_MMA(1, 0, At, B0); PG8_BAR; PG8_SCHED;
            PG8_STAGE(PG8_SB(1, 1), b3 + hstep, voffB);
            PG8_WAIT_V(6); PG8_BAR; PG8_MMA(1, 1, At, B1); PG8_BAR;
        }
        E(acc, cur, wr, wc, fr, fq);
        if (!has_next) break;
#pragma unroll
        for (int a = 0; a < 2; ++a)
#pragma unroll
            for (int b = 0; b < 2; ++b)
#pragma unroll
                for (int m = 0; m < 4; ++m)
#pragma unroll
                    for (int n = 0; n < 2; ++n) acc[a][b][m][n] = (f32x4){0.f, 0.f, 0.f, 0.f};
        cur = nxt; cA = nA; cB = nB; ++ui;
        vC[0][0] = vN[0][0]; vC[0][1] = vN[0][1]; vC[1][0] = vN[1][0]; vC[1][1] = vN[1][1];
    }
    PG8_WAIT_V(0);
    if (wr == 0) PG8_BAR;
    PG8_BAR;
#undef PG8_SA
#undef PG8_SB
#undef PG8_STAGE
#undef PG8_LDA
#undef PG8_LDB
#undef PG8_MMA
#undef PG8_WAIT_V
#undef PG8_WAIT_L
#undef PG8_BAR
#undef PG8_SCHED
}

DI float gelu_tanh(float x) { const float u = 1.5957691216f * (x + 0.044715f * x * x * x); return x * rcpf_(1.0f + expf_(-u)); }
DI float silu_f(float x) { return x * rcpf_(1.0f + expf_(-x)); }

struct EpiInProj {
    static constexpr bool PERM = true;
    bf16* P; const float* LB;
    DI void operator()(const f32x4 (&acc)[2][2][4][2], const Unit& u, int wr, int wc, int fr, int fq) const {
        const int row0 = u.pm * BM + wr * 64 + fr, col0 = u.pn * BM + wc * 32 + 8 * fq;
        const int pn = u.pn;
        const int kind = (pn == 2 || pn == 3) ? 1 : (pn >= 8 && pn < 12) ? 2 : (pn >= 12) ? 3 : 0;
        f32x4 lbv[2][2];
        { const int dir = (pn >> 1) & 1; const int cc = (pn & 1) * 256 + wc * 32 + 8 * fq;
#pragma unroll
            for (int bj = 0; bj < 2; ++bj)
#pragma unroll
                for (int n = 0; n < 2; ++n) lbv[bj][n] = *(const f32x4*)(LB + dir * 512 + cc + bj * HALF + 4 * n);
            asm volatile("" :: "v"(lbv[0][0]), "v"(lbv[0][1]), "v"(lbv[1][0]), "v"(lbv[1][1])); }
#pragma unroll
        for (int ai = 0; ai < 2; ++ai)
#pragma unroll
            for (int m = 0; m < 4; ++m) { bf16* rowp = P + (size_t)(row0 + ai * HALF + m * 16) * INC + col0;
#pragma unroll
                for (int bj = 0; bj < 2; ++bj) { f32x4 v0 = acc[ai][bj][m][0], v1 = acc[ai][bj][m][1];
                    if (kind == 1) {
#pragma unroll
                        for (int j = 0; j < 4; ++j) { v0[j] = gelu_tanh(v0[j]); v1[j] = gelu_tanh(v1[j]); } }
                    else if (kind == 2) {
#pragma unroll
                        for (int j = 0; j < 4; ++j) { const float l0 = lbv[bj][0][j], l1 = lbv[bj][1][j];
                            v0[j] = logf_(l0 + (1.0f - l0) * sigm(v0[j])); v1[j] = logf_(l1 + (1.0f - l1) * sigm(v1[j])); } }
                    else if (kind == 3) {
#pragma unroll
                        for (int j = 0; j < 4; ++j) { v0[j] = silu_f(v0[j]); v1[j] = silu_f(v1[j]); } }
                    v4u w; w.x = pk2(v0[0], v0[1]); w.y = pk2(v0[2], v0[3]); w.z = pk2(v1[0], v1[1]); w.w = pk2(v1[2], v1[3]);
                    *(v4u*)(rowp + bj * HALF) = w; } }
    }
};
struct EpiResid {
    static constexpr bool PERM = false;
    const float* x; const float* mod; float* X1;
    DI void operator()(const f32x4 (&acc)[2][2][4][2], const Unit& u, int wr, int wc, int fr, int fq) const {
        const int row0 = u.pm * BM + wr * 64 + fr, col0 = u.pn * BM + wc * 32 + 4 * fq;
        const int b = (u.pm * BM) >> 11;
        f32x4 gv[2][2];
#pragma unroll
        for (int bj = 0; bj < 2; ++bj)
#pragma unroll
            for (int n = 0; n < 2; ++n) gv[bj][n] = *(const f32x4*)(mod + (size_t)b * 6144 + 2048 + col0 + bj * HALF + n * 16);
#pragma unroll
        for (int ai = 0; ai < 2; ++ai)
#pragma unroll
            for (int m = 0; m < 4; ++m) { const size_t off = (size_t)(row0 + ai * HALF + m * 16) * D + col0;
#pragma unroll
                for (int bj = 0; bj < 2; ++bj)
#pragma unroll
                    for (int n = 0; n < 2; ++n) { const f32x4 xv = *(const f32x4*)(x + off + bj * HALF + n * 16);
                        *(f32x4*)(X1 + off + bj * HALF + n * 16) = xv + gv[bj][n] * acc[ai][bj][m][n]; } }
    }
};
struct EpiF32 {
    static constexpr bool PERM = false;
    float* C; int ldc;
    DI void operator()(const f32x4 (&acc)[2][2][4][2], const Unit& u, int wr, int wc, int fr, int fq) const {
        const int row0 = u.pm * BM + wr * 64 + fr, col0 = u.pn * BM + wc * 32 + 4 * fq;
#pragma unroll
        for (int ai = 0; ai < 2; ++ai)
#pragma unroll
            for (int m = 0; m < 4; ++m) { float* rowp = C + (size_t)(row0 + ai * HALF + m * 16) * ldc + col0;
#pragma unroll
                for (int bj = 0; bj < 2; ++bj)
#pragma unroll
                    for (int n = 0; n < 2; ++n) *(f32x4*)(rowp + bj * HALF + n * 16) = acc[ai][bj][m][n]; }
    }
};
struct EpiSwiGLU {
    static constexpr bool PERM = true;
    bf16* ACT;
    DI void operator()(const f32x4 (&acc)[2][2][4][2], const Unit& u, int wr, int wc, int fr, int fq) const {
        const int row0 = wr * 64 + fr, col0 = u.pn * 128 + wc * 32 + 8 * fq;
        bf16* base = ACT + (size_t)u.rt * 256 * DE;
#pragma unroll
        for (int ai = 0; ai < 2; ++ai)
#pragma unroll
            for (int m = 0; m < 4; ++m) { bf16* rowp = base + (size_t)(row0 + ai * HALF + m * 16) * DE + col0;
                f32x4 a0 = acc[ai][0][m][0], a1 = acc[ai][0][m][1]; const f32x4 g0 = acc[ai][1][m][0], g1 = acc[ai][1][m][1];
#pragma unroll
                for (int j = 0; j < 4; ++j) { a0[j] = silu_f(a0[j]) * g0[j]; a1[j] = silu_f(a1[j]) * g1[j]; }
                v4u w; w.x = pk2(a0[0], a0[1]); w.y = pk2(a0[2], a0[3]); w.z = pk2(a1[0], a1[1]); w.w = pk2(a1[2], a1[3]);
                *(v4u*)rowp = w; }
    }
};
struct EpiScatter {
    static constexpr bool PERM = true;
    bf16* YB; bf16* YS; const v2u* LIST; bf16* DUMP;
    DI void operator()(const f32x4 (&acc)[2][2][4][2], const Unit& u, int wr, int wc, int fr, int fq) const {
        const int col0 = u.pn * BM + wc * 32 + 8 * fq;
        v2u tg[2][4];
#pragma unroll
        for (int ai = 0; ai < 2; ++ai)
#pragma unroll
            for (int m = 0; m < 4; ++m) { const int r = ai * HALF + wr * 64 + m * 16 + fr;
                const int rr = r < u.nrows ? r : u.nrows - 1; const int ee = u.e < 256 ? u.e : 0;
                tg[ai][m] = LIST[(size_t)ee * LISTCAP + (u.e < 256 ? u.pm * 256 + rr : 0)]; if (u.e >= 256) tg[ai][m].y = 0x3f800000u; }
#pragma unroll
        for (int ai = 0; ai < 2; ++ai)
#pragma unroll
            for (int m = 0; m < 4; ++m) { const int r = ai * HALF + wr * 64 + m * 16 + fr;
                const float g = __uint_as_float(tg[ai][m].y);
                bf16* dst = (u.e < 256) ? YB + (tg[ai][m].x * (unsigned)D + (unsigned)col0) : YS + ((unsigned)(u.pm * 256 + r) * (unsigned)D + (unsigned)col0);
                if (r >= u.nrows) dst = DUMP + col0;
#pragma unroll
                for (int bj = 0; bj < 2; ++bj) { const f32x4 v0 = acc[ai][bj][m][0] * g, v1 = acc[ai][bj][m][1] * g;
                    v4u w; w.x = pk2(v0[0], v0[1]); w.y = pk2(v0[2], v0[3]); w.z = pk2(v1[0], v1[1]); w.w = pk2(v1[2], v1[3]);
                    *(v4u*)(dst + bj * HALF) = w; } }
    }
};
}

struct Args { const float* in[26]; float* out; unsigned char* ws; int ph_lo, ph_hi; };
enum { I_X = 0, I_C, I_CTX, I_CCTX, I_ADAW, I_ADAB, I_NMIX, I_NFFN, I_NFIN, I_WIN, I_WOUT, I_CONVW, I_CONVB, I_WA, I_BA, I_WX, I_BX, I_LAM,
       I_LBL, I_HNORM, I_RW, I_RB, I_EW13, I_EW2, I_SW13, I_SW2 };

struct Frame {
    LAS unsigned char* lds;
    int tid, lane, wave, G, vcu, bx;
    const float* const* in; float* out; unsigned char* ws;
};

DI void transpose_item(const float* W, int ldw, bf16* WT, int ldo, int k0, int n0, int orow0, LAS float* scr, int lane) {
#pragma unroll 8
    for (int i = 0; i < 32; ++i) { const int kk = 2 * i + (lane >> 5); scr[kk * 33 + (lane & 31)] = W[(size_t)(k0 + kk) * ldw + n0 + (lane & 31)]; }
    LDS_WAIT(); asm volatile("" ::: "memory");
    const int c = lane & 7;
#pragma unroll
    for (int j = 0; j < 4; ++j) { const int n = (lane >> 3) + 8 * j; const LAS float* s = scr + (8 * c) * 33 + n;
        v4u o; o.x = pk2(s[0 * 33], s[1 * 33]); o.y = pk2(s[2 * 33], s[3 * 33]); o.z = pk2(s[4 * 33], s[5 * 33]); o.w = pk2(s[6 * 33], s[7 * 33]);
        *(v4u*)(WT + (size_t)(orow0 + n) * ldo + k0 + 8 * c) = o; }
    LDS_WAIT(); asm volatile("" ::: "memory");
}
DI int w13_row(int n) { const int half = n >> 8, idx = n & 255; return 256 * (idx >> 7) + 128 * half + (idx & 127); }

DI void phase_prologue(const Frame& F) {
    const float* const* in = F.in; unsigned char* ws = F.ws;
    {
        LAS float* sc = (LAS float*)F.lds;
        LAS float* red = (LAS float*)(F.lds + 17 * 1024 * 4);
        for (int i = F.tid; i < 17 * 1024; i += NTHR) { const int r = i >> 10, k = i & 1023; const float v = (r < 16) ? in[I_C][r * 1024 + k] : in[I_CCTX][k]; sc[i] = v / (1.0f + __expf(-v)); }
        __syncthreads();
        const float* aw = in[I_ADAW]; float* MOD = (float*)(ws + WS_MOD);
        for (int cg = F.bx; cg < 256; cg += F.G) {
            const int kg = F.tid >> 5, cl = F.tid & 31, col = cg * 24 + cl;
            float a[17];
#pragma unroll
            for (int r = 0; r < 17; ++r) a[r] = 0.f;
            if (cl < 24) {
                for (int kk = 0; kk < 64; ++kk) { const int k = kg * 64 + kk; const float w = aw[(size_t)k * 6144 + col];
#pragma unroll
                    for (int r = 0; r < 17; ++r) a[r] += sc[r * 1024 + k] * w; }
#pragma unroll
                for (int r = 0; r < 17; ++r) red[(kg * 17 + r) * 24 + cl] = a[r];
            }
            __syncthreads();
            if (F.tid < 17 * 24) { const int r = F.tid / 24, c2 = F.tid % 24; float s = 0.f;
                for (int g = 0; g < 16; ++g) s += red[(g * 17 + r) * 24 + c2];
                MOD[r * 6144 + cg * 24 + c2] = s + in[I_ADAB][cg * 24 + c2]; }
            __syncthreads();
        }
    }
    {
        float* LB = (float*)(ws + WS_TAB); float* SP = LB + 1024;
        const int gt = F.bx * NTHR + F.tid, GT = F.G * NTHR;
        for (int i = gt; i < 1024; i += GT) { const int d = i >> 9, c = i & 511;
            const float l0 = in[I_LBL][(d * 2 + 0) * 512 + c], l1 = in[I_LBL][(d * 2 + 1) * 512 + c];
            LB[i] = 1.0f / (1.0f + expf(l1 - l0));
            SP[i] = log1pf(expf(-in[I_LAM][i])); }
        bf16* WGT = (bf16*)(ws + WS_WGT);
        for (int i = gt; i < 2 * 2 * 8 * 64 * 64; i += GT) { const int ii = i & 63, j = (i >> 6) & 63, h = (i >> 12) & 7, g = (i >> 15) & 1, d = i >> 16;
            const float* src = g ? in[I_WX] : in[I_WA];
            WGT[i] = f2bf(src[((size_t)(d * 8 + h) * 64 + ii) * 64 + j]); }
    }
    {
        LAS float* scr = (LAS float*)(F.lds + F.wave * 8448);
        const int gw = F.vcu * NWAVES + F.wave, NGW = F.G * NWAVES;
        constexpr int IT_WIN = 16 * 112, IT_WOUT = 16 * 32, IT_WR = 16 * 8, IT_SW13 = 16 * 16, IT_SW2 = 4 * 32, IT_E13 = 256 * 256, IT_E2 = 256 * 128;
        constexpr int NIT = IT_WIN + IT_WOUT + IT_WR + IT_SW13 + IT_SW2 + IT_E13 + IT_E2;
        for (int it = gw; it < NIT; it += NGW) {
            int r = it;
            if (r < IT_WIN) { const int kb = r / 112, nb = r % 112; transpose_item(in[I_WIN], INC, (bf16*)(ws + WS_WIN), 1024, kb * 64, nb * 32, nb * 32, scr, F.lane); continue; } r -= IT_WIN;
            if (r < IT_WOUT) { const int kb = r / 32, nb = r % 32; transpose_item(in[I_WOUT], 1024, (bf16*)(ws + WS_WOUT), 1024, kb * 64, nb * 32, nb * 32, scr, F.lane); continue; } r -= IT_WOUT;
            if (r < IT_WR) { const int kb = r / 8, nb = r % 8; transpose_item(in[I_RW], 256, (bf16*)(ws + WS_WR), 1024, kb * 64, nb * 32, nb * 32, scr, F.lane); continue; } r -= IT_WR;
            if (r < IT_SW13) { const int kb = r / 16, nb = r % 16; transpose_item(in[I_SW13], 512, (bf16*)(ws + WS_SW13), 1024, kb * 64, nb * 32, w13_row(nb * 32), scr, F.lane); continue; } r -= IT_SW13;
            if (r < IT_SW2) { const int kb = r / 32, nb = r % 32; transpose_item(in[I_SW2], 1024, (bf16*)(ws + WS_SW2), 256, kb * 64, nb * 32, nb * 32, scr, F.lane); continue; } r -= IT_SW2;
            if (r < IT_E13) { const int e = r >> 8, q = r & 255, kb = q >> 4, nb = q & 15;
                transpose_item(in[I_EW13] + (size_t)e * 1024 * 512, 512, (bf16*)(ws + WS_EW13) + (size_t)e * 512 * 1024, 1024, kb * 64, nb * 32, w13_row(nb * 32), scr, F.lane); continue; } r -= IT_E13;
            { const int e = r >> 7, q = r & 127, kb = q >> 5, nb = q & 31;
                transpose_item(in[I_EW2] + (size_t)e * 256 * 1024, 1024, (bf16*)(ws + WS_EW2) + (size_t)e * 1024 * 256, 256, kb * 64, nb * 32, nb * 32, scr, F.lane); }
        }
    }
}

DI void phase_norm_rows(const Frame& F, int mode) {
    const float* MOD = (const float*)(F.ws + WS_MOD);
    const int gw = F.bx * NWAVES + F.wave, NGW = F.G * NWAVES;
    const int nrows = mode == 0 ? MTOT : NTOK;
    const float* gain = mode == 0 ? F.in[I_NMIX] : F.in[I_NFFN];
    bf16* dst = (bf16*)(F.ws + (mode == 0 ? WS_HX : WS_HX2));
    const int sh_off = mode == 0 ? 0 : 3072, sc_off = mode == 0 ? 1024 : 4096;
    for (int m = gw; m < nrows; m += NGW) {
        const float* src; int mr;
        if (mode == 0) { if (m < NTOK) { src = F.in[I_X] + (size_t)m * D; mr = m >> 11; } else { src = F.in[I_CTX] + (size_t)(m - NTOK) * D; mr = 16; } }
        else { src = (const float*)(F.ws + WS_X1) + (size_t)m * D; mr = m >> 11; }
        f32x4 v[4]; float ss = 0.f;
#pragma unroll
        for (int j = 0; j < 4; ++j) { v[j] = *(const f32x4*)(src + 4 * F.lane + 256 * j); ss += (v[j].x * v[j].x + v[j].y * v[j].y) + (v[j].z * v[j].z + v[j].w * v[j].w); }
        const float rs = rsqrtf(wave_sum(ss) * (1.0f / D) + EPS);
#pragma unroll
        for (int j = 0; j < 4; ++j) { const int c = 4 * F.lane + 256 * j;
            const f32x4 gn = *(const f32x4*)(gain + c), sc = *(const f32x4*)(MOD + mr * 6144 + sc_off + c), sh = *(const f32x4*)(MOD + mr * 6144 + sh_off + c);
            const f32x4 y = (v[j] * rs) * gn * (sc + 1.0f) + sh;
            v2u w; w.x = pk2(y.x, y.y); w.y = pk2(y.z, y.w);
            *(v2u*)(dst + (size_t)m * D + c) = w; }
    }
}

constexpr int LT_STR = 520;
constexpr int L_RT = 0;
constexpr int L_GT = 69888;
static_assert(L_GT + 64 * LT_STR * 2 <= LDS_MISC, "lru lds");
template <bool FINAL> DI void lru_tile(const Frame& F, int b, int s) {
    const bf16* P = (const bf16*)(F.ws + WS_P);
    const int h = F.wave, fr = F.lane & 15, fq = F.lane >> 4;
    int prow0, L, t0;
    if (s < 4) { prow0 = NTOK + b * CTXL + 64 * s; L = CTXL; t0 = 64 * s; } else { prow0 = b * SEQ + 64 * (s - 4); L = SEQ; t0 = 64 * (s - 4); }
    LAS bf16* RT = (LAS bf16*)(F.lds + L_RT); LAS bf16* GT = (LAS bf16*)(F.lds + L_GT);
#pragma unroll
    for (int it = 0; it < 9; ++it) { const int p = F.tid + it * NTHR;
        if (p < 67 * 64) { const int row = p >> 6, pc = p & 63, ts = t0 + row - 1;
            v4u v = {0u, 0u, 0u, 0u};
            if (ts >= 0 && ts < L) v = *(const v4u*)(P + (size_t)(prow0 + row - 1) * INC + 8 * pc);
            *(LAS v4u*)(RT + row * LT_STR + 8 * pc) = v; } }
    if (FINAL) {
#pragma unroll
        for (int it = 0; it < 8; ++it) { const int p = F.tid + it * NTHR; const int row = p >> 6, pc = p & 63;
            *(LAS v4u*)(GT + row * LT_STR + 8 * pc) = *(const v4u*)(P + (size_t)(prow0 + row) * INC + 512 + 8 * pc); } }
    __syncthreads();
    bf16x8 Af[4][2];
#pragma unroll
    for (int ks = 0; ks < 2; ++ks) {
        const int c0 = 64 * h + 32 * ks + 8 * fq;
        float cw[4][8], cb[8];
#pragma unroll
        for (int k = 0; k < 4; ++k) { const f32x4 w0 = *(const f32x4*)(F.in[I_CONVW] + k * 512 + c0), w1 = *(const f32x4*)(F.in[I_CONVW] + k * 512 + c0 + 4);
            cw[k][0] = w0.x; cw[k][1] = w0.y; cw[k][2] = w0.z; cw[k][3] = w0.w; cw[k][4] = w1.x; cw[k][5] = w1.y; cw[k][6] = w1.z; cw[k][7] = w1.w; }
        { const f32x4 w0 = *(const f32x4*)(F.in[I_CONVB] + c0), w1 = *(const f32x4*)(F.in[I_CONVB] + c0 + 4);
            cb[0] = w0.x; cb[1] = w0.y; cb[2] = w0.z; cb[3] = w0.w; cb[4] = w1.x; cb[5] = w1.y; cb[6] = w1.z; cb[7] = w1.w; }
        const LAS bf16* rbase = RT + fr * LT_STR + c0;
#pragma unroll
        for (int tt = 0; tt < 4; ++tt) {
            float u[8];
#pragma unroll
            for (int j = 0; j < 8; ++j) u[j] = cb[j];
#pragma unroll
            for (int k = 0; k < 4; ++k) { const v4u r8 = *(const LAS v4u*)(rbase + (16 * tt + k) * LT_STR);
                u[0] += cw[k][0] * bflo(r8.x); u[1] += cw[k][1] * bfhi(r8.x); u[2] += cw[k][2] * bflo(r8.y); u[3] += cw[k][3] * bfhi(r8.y);
                u[4] += cw[k][4] * bflo(r8.z); u[5] += cw[k][5] * bfhi(r8.z); u[6] += cw[k][6] * bflo(r8.w); u[7] += cw[k][7] * bfhi(r8.w); }
            v4u w; w.x = pk2(u[0], u[1]); w.y = pk2(u[2], u[3]); w.z = pk2(u[4], u[5]); w.w = pk2(u[6], u[7]);
            Af[tt][ks] = __builtin_bit_cast(bf16x8, w);
        }
    }
    const bf16* WGT = (const bf16*)(F.ws + WS_WGT);
    const float* SP = (const float*)(F.ws + WS_TAB) + 1024;
    LAS bf16* HL = RT;
    LAS bf16* hlb = HL + (4 * fq) * LT_STR + 64 * h + fr;
    LAS bf16* gtb = GT + (4 * fq) * LT_STR + 64 * h + fr;
#pragma unroll 1
    for (int dir = 0; dir < 2; ++dir) {
#pragma unroll 1
        for (int nt = 0; nt < 4; ++nt) {
            const int cj = 64 * h + 16 * nt + fr;
            bf16x8 Ba[2], Bx[2], Id[2];
#pragma unroll
            for (int ks = 0; ks < 2; ++ks) {
                Ba[ks] = *(const bf16x8*)(WGT + ((size_t)((dir * 2 + 0) * 8 + h) * 64 + 16 * nt + fr) * 64 + 32 * ks + 8 * fq);
                Bx[ks] = *(const bf16x8*)(WGT + ((size_t)((dir * 2 + 1) * 8 + h) * 64 + 16 * nt + fr) * 64 + 32 * ks + 8 * fq);
#pragma unroll
                for (int jj = 0; jj < 8; ++jj) Id[ks][jj] = (32 * ks + 8 * fq + jj == 16 * nt + fr) ? (short)0x3F80 : (short)0;
            }
            const float ba = F.in[I_BA][dir * 512 + cj], bx = F.in[I_BX][dir * 512 + cj], sp = SP[dir * 512 + cj];
            float cin = 0.f, ptot = 1.f;
            if (FINAL) cin = ((const float*)(F.ws + WS_CIN))[((size_t)(dir * NB + b) * NSEQT + s) * 512 + cj];
#pragma unroll
            for (int tti = 0; tti < 4; ++tti) {
                const int tt = dir ? 3 - tti : tti;
                const bf16x8 A0 = dir ? Af[3 - tti][0] : Af[tti][0], A1 = dir ? Af[3 - tti][1] : Af[tti][1];
                f32x4 pa = {0.f, 0.f, 0.f, 0.f}, px = {0.f, 0.f, 0.f, 0.f}, uc = {0.f, 0.f, 0.f, 0.f};
                pa = __builtin_amdgcn_mfma_f32_16x16x32_bf16(A0, Ba[0], pa, 0, 0, 0); pa = __builtin_amdgcn_mfma_f32_16x16x32_bf16(A1, Ba[1], pa, 0, 0, 0);
                px = __builtin_amdgcn_mfma_f32_16x16x32_bf16(A0, Bx[0], px, 0, 0, 0); px = __builtin_amdgcn_mfma_f32_16x16x32_bf16(A1, Bx[1], px, 0, 0, 0);
                uc = __builtin_amdgcn_mfma_f32_16x16x32_bf16(A0, Id[0], uc, 0, 0, 0); uc = __builtin_amdgcn_mfma_f32_16x16x32_bf16(A1, Id[1], uc, 0, 0, 0);
                float av[4], bv[4];
#pragma unroll
                for (int ri = 0; ri < 4; ++ri) { const float pav = dir ? pa[3 - ri] : pa[ri], pxv = dir ? px[3 - ri] : px[ri], ucv = dir ? uc[3 - ri] : uc[ri];
                    const float rg = sigm(pav + ba), ig = sigm(pxv + bx);
                    const float a = expf_(-8.0f * rg * sp); av[ri] = a; bv[ri] = __builtin_amdgcn_sqrtf(fmaxf(1.0f - a * a, 0.f)) * ig * ucv; }
                float pl = 1.f, hl = 0.f;
#pragma unroll
                for (int ri = 0; ri < 4; ++ri) { hl = av[ri] * hl + bv[ri]; pl *= av[ri]; }
                float pg[4], hg[4];
#pragma unroll
                for (int gi = 0; gi < 4; ++gi) { const int g = dir ? 3 - gi : gi; pg[gi] = __shfl(pl, fr + 16 * g); hg[gi] = __shfl(hl, fr + 16 * g); }
                const int myg = dir ? 3 - fq : fq;
                float mycin = cin, run = cin;
#pragma unroll
                for (int gi = 0; gi < 4; ++gi) { if (gi == myg) mycin = run; run = pg[gi] * run + hg[gi]; }
                if (FINAL) { float hc = mycin;
#pragma unroll
                    for (int ri = 0; ri < 4; ++ri) { const int r = dir ? 3 - ri : ri; hc = av[ri] * hc + bv[ri];
                        const int o = (16 * tt + r) * LT_STR + 16 * nt;
                        if (dir == 0) hlb[o] = f2bf(hc);
                        else gtb[o] = f2bf(bf2f(gtb[o]) * (bf2f(hlb[o]) + hc)); } }
                else ptot *= (pg[0] * pg[1]) * (pg[2] * pg[3]);
                cin = run;
            }
            if (!FINAL && fq == 0) { const size_t o = ((size_t)(dir * NB + b) * NSEQT + s) * 512 + cj;
                ((float*)(F.ws + WS_SUMA))[o] = ptot; ((float*)(F.ws + WS_SUMH))[o] = cin; }
        }
    }
    if (FINAL) {
        __syncthreads();
        bf16* YL = (bf16*)(F.ws + WS_YL);
#pragma unroll
        for (int it = 0; it < 8; ++it) { const int p = F.tid + it * NTHR; const int row = p >> 6, pc = p & 63;
            *(v4u*)(YL + (size_t)(prow0 + row) * D + 8 * pc) = *(const LAS v4u*)(GT + row * LT_STR + 8 * pc); } }
    __syncthreads();
}
DI void phase_lru_pass1(const Frame& F) {
    for (int it = F.bx; it < NB * NSEQT; it += F.G) lru_tile<false>(F, it / NSEQT, it % NSEQT);
}
DI void phase_lru_carry(const Frame& F) {
    if (F.wave != 0) return;
    const float* SA = (const float*)(F.ws + WS_SUMA); const float* SH = (const float*)(F.ws + WS_SUMH); float* CI = (float*)(F.ws + WS_CIN);
    for (int id = F.bx * 64 + F.lane; id < 2 * NB * 512; id += F.G * 64) {
        const int dir = id >> 13, b = (id >> 9) & 15, c = id & 511;
        float x = 0.f; const size_t o0 = (size_t)(dir * NB + b) * NSEQT * 512 + c;
#pragma unroll
        for (int hf = 0; hf < 2; ++hf) {
            float av[18], hv[18];
#pragma unroll
            for (int q = 0; q < 18; ++q) { const int st = 18 * hf + q, s = dir ? (st < 4 ? 3 - st : 39 - st) : st; av[q] = SA[o0 + (size_t)s * 512]; hv[q] = SH[o0 + (size_t)s * 512]; }
#pragma unroll
            for (int q = 0; q < 18; ++q) { const int st = 18 * hf + q, s = dir ? (st < 4 ? 3 - st : 39 - st) : st; CI[o0 + (size_t)s * 512] = x; x = av[q] * x + hv[q]; }
        }
    }
}
DI void phase_lru_pass2(const Frame& F) {
    for (int it = F.bx; it < NB * 32; it += F.G) lru_tile<true>(F, it >> 5, 4 + (it & 31));
}

constexpr int HS = 144, SCS = 40;
constexpr int H_Q = 0, H_LF = H_Q + 32 * HS * 2, H_V = H_LF + 32 * HS * 2, H_QT = H_V + 32 * HS * 2, H_KT = H_QT + 32 * HS * 2, H_KH = H_KT + 32 * HS * 2,
              H_SC = H_KH + 32 * HS * 2, H_DEC = H_SC + 32 * SCS * 2, H_SET = H_DEC + 512;
static_assert(2 * H_SET <= RING_BYTES, "hgrn lds");
typedef short s16x4 __attribute__((ext_vector_type(4)));
DI bf16x8 tr_frag(const LAS bf16* tile, int c0, int lane) {
    const int g = lane >> 4, q = (lane & 15) >> 2, p = lane & 3;
    const LAS bf16* a = tile + (8 * g + q) * HS + c0 + 4 * p;
    const s16x4 lo = __builtin_amdgcn_ds_read_tr16_b64_v4i16((LAS s16x4*)a), hi = __builtin_amdgcn_ds_read_tr16_b64_v4i16((LAS s16x4*)(a + 4 * HS));
    bf16x8 r; r[0] = lo[0]; r[1] = lo[1]; r[2] = lo[2]; r[3] = lo[3]; r[4] = hi[0]; r[5] = hi[1]; r[6] = hi[2]; r[7] = hi[3]; return r;
}
DI void hgrn_chain(const Frame& F, int item) {
    const int b = item >> 3, h = (item >> 1) & 3, dir = item & 1;
    const bf16* P = (const bf16*)(F.ws + WS_P);
    bf16* O = (bf16*)(F.ws + (dir ? WS_OB : WS_OF));
    const int w = F.wave, lane = F.lane, fr = lane & 15, g = lane >> 4;
    const int li = F.tid >> 4, lp = F.tid & 15;
    f32x4 S[8];
#pragma unroll
    for (int t = 0; t < 8; ++t) S[t] = (f32x4){0.f, 0.f, 0.f, 0.f};
    auto prow = [&](int c, int i) -> size_t {
        const int ii = dir ? 31 - i : i;
        if (c < 8) { const int cc = dir ? 7 - c : c; return (size_t)NTOK + b * CTXL + 32 * cc + ii; }
        const int col = dir ? 63 - (c - 8) : (c - 8); return (size_t)b * SEQ + ii * 64 + col; };
    const size_t coff = 128 * h + 8 * lp;
    v4u rqA, rlA, rvA, rqB, rlB, rvB;
    { const bf16* rp = P + prow(0, li) * INC + coff; rqA = *(const v4u*)(rp + 1024); rvA = *(const v4u*)(rp + 1536); rlA = *(const v4u*)(rp + 2048 + 512 * dir); }
    { const bf16* rp = P + prow(1, li) * INC + coff; rqB = *(const v4u*)(rp + 1024); rvB = *(const v4u*)(rp + 1536); rlB = *(const v4u*)(rp + 2048 + 512 * dir); }
    bf16x8 Tri[2];
#pragma unroll
    for (int it = 0; it < 2; ++it)
#pragma unroll
        for (int jj = 0; jj < 8; ++jj) Tri[it][jj] = (8 * g + jj <= 16 * it + fr) ? (short)0x3F80 : (short)0;
#define HG_BODY(c, RQ, RL, RV, SET) do { \
        LAS unsigned char* base = F.lds + (SET) * H_SET; \
        LAS bf16* Qr = (LAS bf16*)(base + H_Q); LAS bf16* LFr = (LAS bf16*)(base + H_LF); LAS bf16* Vr = (LAS bf16*)(base + H_V); \
        LAS bf16* QT = (LAS bf16*)(base + H_QT); LAS bf16* KT = (LAS bf16*)(base + H_KT); LAS bf16* KH = (LAS bf16*)(base + H_KH); \
        LAS bf16* SC = (LAS bf16*)(base + H_SC); LAS float* DEC = (LAS float*)(base + H_DEC); \
        const bool isctx = (c) < 8; \
        *(LAS v4u*)(Qr + li * HS + 8 * lp) = RQ; *(LAS v4u*)(LFr + li * HS + 8 * lp) = RL; *(LAS v4u*)(Vr + li * HS + 8 * lp) = RV; \
        if ((c) + 2 < 72) { const bf16* rp = P + prow((c) + 2, li) * INC + coff; RQ = *(const v4u*)(rp + 1024); RV = *(const v4u*)(rp + 1536); RL = *(const v4u*)(rp + 2048 + 512 * dir); } \
        __syncthreads(); \
        {   \
            const bf16x8 Al = tr_frag(LFr, 16 * w, lane); \
            f32x4 Gm[2]; \
            _Pragma("unroll") for (int it = 0; it < 2; ++it) Gm[it] = __builtin_amdgcn_mfma_f32_16x16x32_bf16(Al, Tri[it], (f32x4){0.f, 0.f, 0.f, 0.f}, 0, 0, 0); \
            f32x4 dec; \
            _Pragma("unroll") for (int r = 0; r < 4; ++r) dec[r] = expf_(__shfl(Gm[1][r], (lane & 48) | 15)); \
            if (fr == 0) *(LAS f32x4*)(DEC + 16 * w + 4 * g) = dec; \
            _Pragma("unroll") for (int it = 0; it < 2; ++it) { const int i = 16 * it + fr, d0 = 16 * w + 4 * g; \
                const v2u q4 = *(const LAS v2u*)(Qr + i * HS + d0), l4 = *(const LAS v2u*)(LFr + i * HS + d0); \
                const float qv[4] = {bflo(q4.x), bfhi(q4.x), bflo(q4.y), bfhi(q4.y)}, lv[4] = {bflo(l4.x), bfhi(l4.x), bflo(l4.y), bfhi(l4.y)}; \
                float qt[4], kt[4], kh[4]; \
                _Pragma("unroll") for (int r = 0; r < 4; ++r) { const float eg = expf_(Gm[it][r]), ieg = rcpf_(eg), kk = 1.0f - expf_(lv[r]); qt[r] = qv[r] * eg; kt[r] = kk * ieg; kh[r] = kk * dec[r] * ieg; } \
                *(LAS v2u*)(QT + i * HS + d0) = (v2u){pk2(qt[0], qt[1]), pk2(qt[2], qt[3])}; \
                *(LAS v2u*)(KT + i * HS + d0) = (v2u){pk2(kt[0], kt[1]), pk2(kt[2], kt[3])}; \
                *(LAS v2u*)(KH + i * HS + d0) = (v2u){pk2(kh[0], kh[1]), pk2(kh[2], kh[3])}; } \
        } \
        __syncthreads(); \
        f32x4 oacc[2]; oacc[0] = (f32x4){0.f, 0.f, 0.f, 0.f}; oacc[1] = (f32x4){0.f, 0.f, 0.f, 0.f}; \
        if (!isctx) { \
            if (w < 4) {   \
                const int it = w >> 1, jt = w & 1; f32x4 sc = {0.f, 0.f, 0.f, 0.f}; \
                _Pragma("unroll") for (int ks = 0; ks < 4; ++ks) { const bf16x8 ak = *(const LAS bf16x8*)(KT + (16 * jt + fr) * HS + 32 * ks + 8 * g), bq = *(const LAS bf16x8*)(QT + (16 * it + fr) * HS + 32 * ks + 8 * g); \
                    sc = __builtin_amdgcn_mfma_f32_16x16x32_bf16(ak, bq, sc, 0, 0, 0); } \
                const int i = 16 * it + fr, j0 = 16 * jt + 4 * g; \
                *(LAS v2u*)(SC + i * SCS + j0) = (v2u){pk2(j0 <= i ? sc[0] : 0.f, j0 + 1 <= i ? sc[1] : 0.f), pk2(j0 + 2 <= i ? sc[2] : 0.f, j0 + 3 <= i ? sc[3] : 0.f)}; } \
              \
            _Pragma("unroll") for (int ks = 0; ks < 4; ++ks) { \
                v4u sb; sb.x = pk2(S[2 * ks][0], S[2 * ks][1]); sb.y = pk2(S[2 * ks][2], S[2 * ks][3]); sb.z = pk2(S[2 * ks + 1][0], S[2 * ks + 1][1]); sb.w = pk2(S[2 * ks + 1][2], S[2 * ks + 1][3]); \
                const bf16x8 As = __builtin_bit_cast(bf16x8, sb); \
                _Pragma("unroll") for (int it = 0; it < 2; ++it) { const v2u a0 = *(const LAS v2u*)(QT + (16 * it + fr) * HS + 32 * ks + 4 * g), a1 = *(const LAS v2u*)(QT + (16 * it + fr) * HS + 32 * ks + 16 + 4 * g); \
                    v4u bv; bv.x = a0.x; bv.y = a0.y; bv.z = a1.x; bv.w = a1.y; \
                    oacc[it] = __builtin_amdgcn_mfma_f32_16x16x32_bf16(As, __builtin_bit_cast(bf16x8, bv), oacc[it], 0, 0, 0); } } \
        } \
          \
        const bf16x8 Vf = tr_frag(Vr, 16 * w, lane); \
        _Pragma("unroll") for (int t = 0; t < 8; ++t) { const f32x4 dv = *(const LAS f32x4*)(DEC + 16 * t + 4 * g); \
            const bf16x8 Kf = tr_frag(KH, 16 * t, lane); \
            S[t] = __builtin_amdgcn_mfma_f32_16x16x32_bf16(Kf, Vf, S[t] * dv, 0, 0, 0); } \
        if (!isctx) { \
            __syncthreads(); \
            const int col = dir ? 63 - ((c) - 8) : ((c) - 8); \
            _Pragma("unroll") for (int it = 0; it < 2; ++it) { const bf16x8 bs = *(const LAS bf16x8*)(SC + (16 * it + fr) * SCS + 8 * g); \
                oacc[it] = __builtin_amdgcn_mfma_f32_16x16x32_bf16(Vf, bs, oacc[it], 0, 0, 0); \
                const int i = 16 * it + fr, ii = dir ? 31 - i : i; \
                *(v2u*)(O + ((size_t)b * SEQ + ii * 64 + col) * 512 + 128 * h + 16 * w + 4 * g) = (v2u){pk2(oacc[it][0], oacc[it][1]), pk2(oacc[it][2], oacc[it][3])}; } \
        } \
    } while (0)
#pragma unroll 1
    for (int c = 0; c < 72; c += 2) {
        HG_BODY(c, rqA, rlA, rvA, 0);
        HG_BODY(c + 1, rqB, rlB, rvB, 1);
    }
#undef HG_BODY
    __syncthreads();
}
DI void phase_hgrn(const Frame& F) {
    for (int it = F.bx; it < NB * 4 * 2; it += F.G) hgrn_chain(F, it);
}
DI void phase_y2(const Frame& F) {
    const bf16* OFp = (const bf16*)(F.ws + WS_OF); const bf16* OBp = (const bf16*)(F.ws + WS_OB); const bf16* P = (const bf16*)(F.ws + WS_P); bf16* YL = (bf16*)(F.ws + WS_YL);
    const int gw = F.bx * NWAVES + F.wave, NGW = F.G * NWAVES;
    const int c = 8 * F.lane;
    const f32x4 g0 = *(const f32x4*)(F.in[I_HNORM] + c), g1 = *(const f32x4*)(F.in[I_HNORM] + c + 4);
    const float gn[8] = {g0.x, g0.y, g0.z, g0.w, g1.x, g1.y, g1.z, g1.w};
    for (int m = gw; m < NTOK; m += NGW) {
        const v4u a = *(const v4u*)(OFp + (size_t)m * 512 + c), bq = *(const v4u*)(OBp + (size_t)m * 512 + c), sg = *(const v4u*)(P + (size_t)m * INC + 3072 + c);
        float o[8] = {bflo(a.x) + bflo(bq.x), bfhi(a.x) + bfhi(bq.x), bflo(a.y) + bflo(bq.y), bfhi(a.y) + bfhi(bq.y), bflo(a.z) + bflo(bq.z), bfhi(a.z) + bfhi(bq.z), bflo(a.w) + bflo(bq.w), bfhi(a.w) + bfhi(bq.w)};
        const float sgv[8] = {bflo(sg.x), bfhi(sg.x), bflo(sg.y), bfhi(sg.y), bflo(sg.z), bfhi(sg.z), bflo(sg.w), bfhi(sg.w)};
        float ss = 0.f;
#pragma unroll
        for (int j = 0; j < 8; ++j) ss += o[j] * o[j];
        ss += __shfl_xor(ss, 1); ss += __shfl_xor(ss, 2); ss += __shfl_xor(ss, 4); ss += __shfl_xor(ss, 8);
        const float rs = rsqrtf(ss * (1.0f / 128.0f) + EPS);
#pragma unroll
        for (int j = 0; j < 8; ++j) o[j] = o[j] * rs * gn[j] * sgv[j];
        v4u wv; wv.x = pk2(o[0], o[1]); wv.y = pk2(o[2], o[3]); wv.z = pk2(o[4], o[5]); wv.w = pk2(o[6], o[7]);
        *(v4u*)(YL + (size_t)m * D + 512 + c) = wv;
    }
}

DI unsigned fkey(float f) { const unsigned u = __float_as_uint(f); return u ^ ((u >> 31) ? 0xFFFFFFFFu : 0x80000000u); }
template <int CTRL> DI unsigned dpp_u(unsigned v) { return (unsigned)__builtin_amdgcn_update_dpp(0, (int)v, CTRL, 0xf, 0xf, true); }
template <int CTRL> DI float dpp_f(float v) { return __uint_as_float(dpp_u<CTRL>(__float_as_uint(v))); }
DI unsigned umax_(unsigned a, unsigned b) { return a > b ? a : b; }
DI float readlane_f(float v, int lane) { return __uint_as_float((unsigned)__builtin_amdgcn_readlane((int)__float_as_uint(v), lane)); }
DI void phase_route(const Frame& F) {
    const float* LOGIT = (const float*)(F.ws + WS_LOGIT); const float* rb = F.in[I_RB];
    v2u* ROUTE = (v2u*)(F.ws + WS_ROUTE); int* HIST = (int*)(F.ws + WS_HIST);
    LAS unsigned* hist = (LAS unsigned*)F.lds;
    const int l = F.lane;
    const f32x4 rbv = *(const f32x4*)(rb + 4 * l);
    const float NEG = -__builtin_inff();
    for (int blk = F.bx; blk < NTOK / 128; blk += F.G) {
        if (F.tid < 256) hist[F.tid] = 0u;
        __syncthreads();
        const int tok0 = blk * 128 + F.wave * 16;
        f32x4 lg = *(const f32x4*)(LOGIT + (size_t)tok0 * NE + 4 * l);
#pragma unroll 1
        for (int ti = 0; ti < 16; ++ti) {
            const int tok = tok0 + ti;
            f32x4 lgn = {0.f, 0.f, 0.f, 0.f};
            if (ti + 1 < 16) lgn = *(const f32x4*)(LOGIT + (size_t)(tok + 1) * NE + 4 * l);
            float sc[4], bs[4];
#pragma unroll
            for (int k = 0; k < 4; ++k) { sc[k] = rcpf_(1.0f + expf_(-lg[k])); bs[k] = sc[k] + rbv[k]; }
            float m1 = NEG, m2 = NEG;
#pragma unroll
            for (int k = 0; k < 4; ++k) { const float v = bs[k]; if (v > m1) { m2 = m1; m1 = v; } else if (v > m2) m2 = v; }
            { float o1 = dpp_f<0xB1>(m1), o2 = dpp_f<0xB1>(m2); float n1 = fmaxf(m1, o1), n2 = fmaxf(fminf(m1, o1), fmaxf(m2, o2)); m1 = n1; m2 = n2;
              o1 = dpp_f<0x4E>(m1); o2 = dpp_f<0x4E>(m2); n1 = fmaxf(m1, o1); n2 = fmaxf(fminf(m1, o1), fmaxf(m2, o2)); m1 = n1; m2 = n2;
              const float a1 = dpp_f<0x104>(m1), a2 = dpp_f<0x104>(m2), c1 = dpp_f<0x114>(m1), c2 = dpp_f<0x114>(m2);
              o1 = (l & 4) ? c1 : a1; o2 = (l & 4) ? c2 : a2; n1 = fmaxf(m1, o1); n2 = fmaxf(fminf(m1, o1), fmaxf(m2, o2)); m1 = n1; m2 = n2; }
            const float gs = m1 + m2; const int g = l >> 3; int rank = 0;
#pragma unroll
            for (int gg = 0; gg < 8; ++gg) { const float og = readlane_f(gs, gg * 8); rank += (og > gs || (og == gs && gg < g)) ? 1 : 0; }
            const bool sel = rank < 4;
            unsigned cv[4];
#pragma unroll
            for (int k = 0; k < 4; ++k) cv[k] = sel ? fkey(bs[k]) : 0u;
            float sum = 0.f, mysc = 0.f; int myexp = 0;
#pragma unroll
            for (int r = 0; r < TOPK; ++r) {
                unsigned bvk = cv[0]; int bk = 0;
#pragma unroll
                for (int k = 1; k < 4; ++k) if (cv[k] > bvk) { bvk = cv[k]; bk = k; }
                const float bsc = bk == 0 ? sc[0] : bk == 1 ? sc[1] : bk == 2 ? sc[2] : sc[3];
                unsigned m = bvk;
                m = umax_(m, dpp_u<0xB1>(m)); m = umax_(m, dpp_u<0x4E>(m)); m = umax_(m, dpp_u<0x124>(m)); m = umax_(m, dpp_u<0x128>(m));
                const unsigned M = umax_(umax_((unsigned)__builtin_amdgcn_readlane((int)m, 0), (unsigned)__builtin_amdgcn_readlane((int)m, 16)),
                                         umax_((unsigned)__builtin_amdgcn_readlane((int)m, 32), (unsigned)__builtin_amdgcn_readlane((int)m, 48)));
                const unsigned long long bal = __ballot(bvk == M);
                const int L = __builtin_ctzll(bal);
                const int kL = __builtin_amdgcn_readlane(bk, L);
                const float se = readlane_f(bsc, L);
                const int e = 4 * L + kL;
                if (l == L) {
#pragma unroll
                    for (int k = 0; k < 4; ++k) if (k == bk) cv[k] = 0u; }
                sum += se; if (l == r) { myexp = e; mysc = se; }
            }
            if (l < TOPK) { ROUTE[(size_t)tok * TOPK + l] = (v2u){(unsigned)myexp, __float_as_uint(mysc * rcpf_(sum) * 2.5f)}; (void)__hip_atomic_fetch_add(hist + myexp, 1u, __ATOMIC_RELAXED, __HIP_MEMORY_SCOPE_WORKGROUP); }
            lg = lgn;
        }
        __syncthreads();
        if (F.tid < 256) HIST[blk * 256 + F.tid] = (int)hist[F.tid];
        __syncthreads();
    }
}
DI void phase_lists(const Frame& F) {
    const v2u* ROUTE = (const v2u*)(F.ws + WS_ROUTE); const int* HIST = (const int*)(F.ws + WS_HIST);
    unsigned* cnt = (unsigned*)(F.ws + WS_CTL) + CW_CNT; v2u* LIST = (v2u*)(F.ws + WS_LIST);
    LAS int* part = (LAS int*)F.lds;
    LAS int* lbase = part + 1024; LAS unsigned* lcnt = (LAS unsigned*)(lbase + 256);
    for (int blk = F.bx; blk < NTOK / 128; blk += F.G) {
        const int e = F.tid & 255, hf = F.tid >> 8;
        int below = 0, all = 0;
#pragma unroll 8
        for (int q = 0; q < 128; ++q) { const int row = hf * 128 + q; const int v = HIST[row * 256 + e]; all += v; below += (row < blk) ? v : 0; }
        part[hf * 512 + e] = below; part[hf * 512 + 256 + e] = all;
        __syncthreads();
        if (F.tid < 256) { lbase[e] = part[e] + part[512 + e]; lcnt[e] = 0u; if (blk == 0) cnt[e] = (unsigned)(part[256 + e] + part[768 + e]); }
        __syncthreads();
#pragma unroll
        for (int q = 0; q < 2; ++q) { const int a = F.tid + q * NTHR; const unsigned tk = (unsigned)(blk * 128 * TOPK + a);
            const v2u rt = ROUTE[tk]; const unsigned pos = (unsigned)lbase[rt.x] + __hip_atomic_fetch_add(lcnt + rt.x, 1u, __ATOMIC_RELAXED, __HIP_MEMORY_SCOPE_WORKGROUP);
            LIST[(size_t)rt.x * LISTCAP + pos] = (v2u){tk, rt.y}; }
        __syncthreads();
    }
}

template <bool GATHER> DI void moe_setup(const Frame& F, int ncol, int& total) {
    LAS int* ts = (LAS int*)(F.lds + LDS_TS); LAS int* cl = (LAS int*)(F.lds + LDS_CNT); LAS int* idx = (LAS int*)(F.lds + LDS_IDX);
    const unsigned* cnt = (const unsigned*)(F.ws + WS_CTL) + CW_CNT;
    if (F.tid < 256) cl[F.tid] = (int)__hip_atomic_load(cnt + F.tid, __ATOMIC_RELAXED, __HIP_MEMORY_SCOPE_AGENT);
    __syncthreads();
    if (F.tid == 0) { int s = 0; for (int e = 0; e < 256; ++e) { ts[e] = s; s += (cl[e] + 255) >> 8; } ts[256] = s; }
    __syncthreads();
    const int Te = ts[256]; total = (Te + NTOK / 256) * ncol;
    if (GATHER) {
        const v2u* LIST = (const v2u*)(F.ws + WS_LIST);
        for (int ord = 0; ord < 12; ++ord) { const int L = ord * F.G + F.vcu; if (L >= total) break;
            const int rt = L / ncol;
            if (F.tid < 256) { int v;
                if (rt >= Te) v = (rt - Te) * 256 + F.tid;
                else { int lo = 0, hi = 256; while (hi - lo > 1) { const int mid = (lo + hi) >> 1; if (ts[mid] <= rt) lo = mid; else hi = mid; }
                    const int r = (rt - ts[lo]) * 256 + F.tid; v = (r < cl[lo]) ? (int)(LIST[(size_t)lo * LISTCAP + r].x >> 3) : 0; }
                idx[ord * 256 + F.tid] = v; } }
    }
    __syncthreads();
}

DI void phase_combine(const Frame& F, int mode) {
    const float* MOD = (const float*)(F.ws + WS_MOD);
    const bf16* YB = (const bf16*)(F.ws + WS_YB); const bf16* YS = (const bf16*)(F.ws + WS_YS);
    const int gw = F.bx * NWAVES + F.wave, NGW = F.G * NWAVES;
    const float* nf = F.in[I_NFIN];
    for (int m = gw; m < NTOK; m += NGW) {
        const int b = m >> 11;
        float x2[16]; float ss = 0.f;
#pragma unroll
        for (int j = 0; j < 2; ++j) { const int c = 8 * F.lane + 512 * j;
            float s[8];
#pragma unroll
            for (int q = 0; q < 8; ++q) s[q] = 0.f;
            const float* xsrc = mode == 2 ? F.in[I_X] : (const float*)(F.ws + WS_X1);
            if (mode == 0) {
#pragma unroll
                for (int k = 0; k < 9; ++k) { const v4u w = (k < 8) ? *(const v4u*)(YB + ((size_t)m * TOPK + k) * D + c) : *(const v4u*)(YS + (size_t)m * D + c);
                    s[0] += bflo(w.x); s[1] += bfhi(w.x); s[2] += bflo(w.y); s[3] += bfhi(w.y); s[4] += bflo(w.z); s[5] += bfhi(w.z); s[6] += bflo(w.w); s[7] += bfhi(w.w); } }
            const f32x4 xa = *(const f32x4*)(xsrc + (size_t)m * D + c), xb = *(const f32x4*)(xsrc + (size_t)m * D + c + 4);
            const f32x4 ga = *(const f32x4*)(MOD + b * 6144 + 5120 + c), gb = *(const f32x4*)(MOD + b * 6144 + 5120 + c + 4);
            const float xv[8] = {xa.x, xa.y, xa.z, xa.w, xb.x, xb.y, xb.z, xb.w}, gv[8] = {ga.x, ga.y, ga.z, ga.w, gb.x, gb.y, gb.z, gb.w};
#pragma unroll
            for (int q = 0; q < 8; ++q) { const float v = xv[q] + gv[q] * s[q]; x2[8 * j + q] = v; ss += v * v; } }
        const float rs = rsqrtf(wave_sum(ss) * (1.0f / D) + EPS);
#pragma unroll
        for (int j = 0; j < 2; ++j) { const int c = 8 * F.lane + 512 * j;
            const f32x4 na = *(const f32x4*)(nf + c), nb = *(const f32x4*)(nf + c + 4);
            f32x4 oa = {x2[8 * j] * rs * na.x, x2[8 * j + 1] * rs * na.y, x2[8 * j + 2] * rs * na.z, x2[8 * j + 3] * rs * na.w};
            f32x4 ob = {x2[8 * j + 4] * rs * nb.x, x2[8 * j + 5] * rs * nb.y, x2[8 * j + 6] * rs * nb.z, x2[8 * j + 7] * rs * nb.w};
            *(f32x4*)(F.out + (size_t)m * D + c) = oa; *(f32x4*)(F.out + (size_t)m * D + c + 4) = ob; }
    }
}

constexpr int NPHASE = 14;
__global__ void __launch_bounds__(NTHR, 2) fwd_kernel(Args args) {
    extern __shared__ __attribute__((aligned(16))) unsigned char lds_raw[];
    Frame F;
    F.lds = (LAS unsigned char*)lds_raw;
    F.tid = threadIdx.x; F.lane = F.tid & 63; F.wave = __builtin_amdgcn_readfirstlane(F.tid >> 6);
    F.G = gridDim.x; F.bx = blockIdx.x; F.vcu = (F.G % 8 == 0) ? (F.bx % 8) * (F.G / 8) + F.bx / 8 : F.bx;
    F.in = args.in; F.out = args.out; F.ws = args.ws;
    volatile LAS unsigned* MISC = (volatile LAS unsigned*)(F.lds + LDS_MISC);
    if (F.tid < 16) MISC[F.tid] = 0u;
    __syncthreads();
    XcdBarrier bar; bar.bar = (unsigned*)(F.ws + WS_CTL) + CW_BAR; bar.x = 0; bar.st = nullptr;
#if !PER_PHASE_LAUNCH
    bar = xcd_barrier_post((unsigned*)(F.ws + WS_CTL) + CW_BAR, MISC + 8);
#define GRID_BAR() xcd_barrier(bar)
#else
#define GRID_BAR() do {} while (0)
#endif
    const int lo = args.ph_lo, hi = args.ph_hi;
#ifndef PH_MASK
#define PH_MASK 0xFFFF
#endif
#define IN(k) (((PH_MASK >> (k)) & 1) && lo <= (k) && (k) < hi)
#ifndef PROBE_PH
#define PROBE_PH -1
#endif
#ifndef PROBE_MULT
#define PROBE_MULT 4
#endif
    unsigned long long pr_t0 = 0ull, pr_t1 = 0ull;
    if (PROBE_PH == 0) pr_t0 = __builtin_amdgcn_s_memrealtime();
#define SEAM(k) do { if (IN(k) && IN((k) + 1)) GRID_BAR(); \
        if (PROBE_PH >= 0) { if ((k) == PROBE_PH - 1) pr_t0 = __builtin_amdgcn_s_memrealtime(); if ((k) == PROBE_PH) pr_t1 = __builtin_amdgcn_s_memrealtime(); } } while (0)
#ifndef REPEAT_MASK
#define REPEAT_MASK 0
#endif
#define REPS(k) (1 + ((REPEAT_MASK >> (k)) & 1))
    unsigned char* ws = F.ws;

    if (IN(0)) _Pragma("unroll 1") for (int rep = 0; rep < REPS(0); ++rep) { if (rep) GRID_BAR(); phase_prologue(F); } SEAM(0);
    if (IN(1)) _Pragma("unroll 1") for (int rep = 0; rep < REPS(1); ++rep) { if (rep) GRID_BAR(); phase_norm_rows(F, 0); } SEAM(1);
    if (IN(2)) _Pragma("unroll 1") for (int rep = 0; rep < REPS(2); ++rep) { if (rep) GRID_BAR();
        pg8::DenseOrder S; S.init(ws + WS_HX, ws + WS_WIN, MTOT, INC, D, F.G, F.bx);
        pg8::EpiInProj E{(bf16*)(ws + WS_P), (const float*)(ws + WS_TAB)};
        pg8::gemm_phase(F.lds, D, S, E);
    } SEAM(2);
    if (IN(3)) _Pragma("unroll 1") for (int rep = 0; rep < REPS(3); ++rep) { if (rep) GRID_BAR(); phase_lru_pass1(F); } SEAM(3);
    if (IN(4)) _Pragma("unroll 1") for (int rep = 0; rep < REPS(4); ++rep) { if (rep) GRID_BAR(); phase_lru_carry(F); phase_hgrn(F); } SEAM(4);
    if (IN(5)) _Pragma("unroll 1") for (int rep = 0; rep < REPS(5); ++rep) { if (rep) GRID_BAR(); phase_lru_pass2(F); phase_y2(F); } SEAM(5);
    if (IN(6)) _Pragma("unroll 1") for (int rep = 0; rep < REPS(6); ++rep) { if (rep) GRID_BAR();
        pg8::DenseOrder S; S.init(ws + WS_YL, ws + WS_WOUT, NTOK, D, D, F.G, F.bx);
        pg8::EpiResid E{F.in[I_X], (const float*)(ws + WS_MOD), (float*)(ws + WS_X1)};
        pg8::gemm_phase(F.lds, D, S, E);
    } SEAM(6);
#if DBG_STOP == 1
    if (IN(7)) _Pragma("unroll 1") for (int rep = 0; rep < REPS(7); ++rep) { if (rep) GRID_BAR(); phase_combine(F, 1); }
#else
    if (IN(7)) _Pragma("unroll 1") for (int rep = 0; rep < REPS(7); ++rep) { if (rep) GRID_BAR(); phase_norm_rows(F, 1); } SEAM(7);
    if (IN(8)) _Pragma("unroll 1") for (int rep = 0; rep < REPS(8); ++rep) { if (rep) GRID_BAR();
        pg8::DenseOrder S; S.init(ws + WS_HX2, ws + WS_WR, NTOK, NE, D, F.G, F.bx);
        pg8::EpiF32 E{(float*)(ws + WS_LOGIT), NE};
        pg8::gemm_phase(F.lds, D, S, E);
    } SEAM(8);
    if (IN(9)) _Pragma("unroll 1") for (int rep = 0; rep < REPS(9); ++rep) { if (rep) GRID_BAR(); phase_route(F); } SEAM(9);
    if (IN(10)) _Pragma("unroll 1") for (int rep = 0; rep < REPS(10); ++rep) { if (rep) GRID_BAR(); phase_lists(F); } SEAM(10);
    if (IN(11)) _Pragma("unroll 1") for (int rep = 0; rep < REPS(11); ++rep) { if (rep) GRID_BAR();
        int total; moe_setup<true>(F, 2, total);
        pg8::MoeOrder<true> S; S.A = (const char*)(ws + WS_HX2); S.Bt = (const char*)(ws + WS_EW13); S.BtS = (const char*)(ws + WS_SW13); S.K = D; S.ncol = 2; S.estride = (size_t)512 * 1024 * 2;
        S.ts = (const LAS int*)(F.lds + LDS_TS); S.cnt = (const LAS int*)(F.lds + LDS_CNT); S.idx = (const LAS int*)(F.lds + LDS_IDX); S.G = F.G; S.vcu = F.vcu; S.total = total;
        pg8::EpiSwiGLU E{(bf16*)(ws + WS_ACT)};
        pg8::gemm_phase(F.lds, D, S, E);
    } SEAM(11);
    if (IN(12)) _Pragma("unroll 1") for (int rep = 0; rep < REPS(12); ++rep) { if (rep) GRID_BAR();
        int total; moe_setup<false>(F, 4, total);
        pg8::MoeOrder<false> S; S.A = (const char*)(ws + WS_ACT); S.Bt = (const char*)(ws + WS_EW2); S.BtS = (const char*)(ws + WS_SW2); S.K = DE; S.ncol = 4; S.estride = (size_t)1024 * 256 * 2;
        S.ts = (const LAS int*)(F.lds + LDS_TS); S.cnt = (const LAS int*)(F.lds + LDS_CNT); S.idx = (const LAS int*)(F.lds + LDS_IDX); S.G = F.G; S.vcu = F.vcu; S.total = total;
        pg8::EpiScatter E{(bf16*)(ws + WS_YB), (bf16*)(ws + WS_YS), (const v2u*)(ws + WS_LIST), (bf16*)(ws + WS_DUMP)};
        pg8::gemm_phase(F.lds, DE, S, E);
    } SEAM(12);
    if (IN(13)) _Pragma("unroll 1") for (int rep = 0; rep < REPS(13); ++rep) { if (rep) GRID_BAR(); phase_combine(F, 0); }
#endif
    if (PROBE_PH >= 0 && F.bx == 0 && F.tid == 0) {
        const unsigned long long te = __builtin_amdgcn_s_memrealtime(); if (PROBE_PH == NPHASE - 1) pr_t1 = te;
        const unsigned long long target = (unsigned long long)PROBE_MULT * (pr_t1 - pr_t0);
        while (__builtin_amdgcn_s_memrealtime() - te < target) __builtin_amdgcn_s_sleep(20);
    }
}

extern "C" void kernel_launch(void* const* d_in, const int* in_sizes, int n_in, void* d_out, int out_size, void* d_ws, size_t ws_size, hipStream_t stream) {
    static int grid = 0;
    if (grid == 0) {
        if (n_in != 26 || in_sizes[0] != NTOK * D || out_size != NTOK * D || ws_size < WS_END) { fprintf(stderr, "kernel_launch: unexpected shapes (n_in %d, ws %zu)\n", n_in, ws_size); grid = -1; return; }
        int dev = 0, cus = 0, per_cu = 0;
        if (hipGetDevice(&dev) != hipSuccess || hipDeviceGetAttribute(&cus, hipDeviceAttributeMultiprocessorCount, dev) != hipSuccess) { grid = -1; return; }
        if (hipFuncSetAttribute((const void*)fwd_kernel, hipFuncAttributeMaxDynamicSharedMemorySize, LDS_BYTES) != hipSuccess) { fprintf(stderr, "kernel_launch: hipFuncSetAttribute failed\n"); grid = -1; return; }
        if (hipOccupancyMaxActiveBlocksPerMultiprocessor(&per_cu, (const void*)fwd_kernel, NTHR, LDS_BYTES) != hipSuccess || per_cu < 1) { fprintf(stderr, "kernel_launch: occupancy query says %d\n", per_cu); }
        (void)hipGetLastError();
        grid = cus;
    }
    if (grid < 0) return;
    hipMemsetAsync((char*)d_ws + WS_CTL, 0, CTL_ZERO_BYTES, stream);
    Args a{};
    for (int i = 0; i < 26; ++i) a.in[i] = (const float*)d_in[i];
    a.out = (float*)d_out; a.ws = (unsigned char*)d_ws;
#if PER_PHASE_LAUNCH
    for (int p = 0; p < NPHASE; ++p) { a.ph_lo = p; a.ph_hi = p + 1; hipLaunchKernelGGL(fwd_kernel, dim3(grid), dim3(NTHR), LDS_BYTES, stream, a); }
#else
    a.ph_lo = 0; a.ph_hi = NPHASE;
    hipLaunchKernelGGL(fwd_kernel, dim3(grid), dim3(NTHR), LDS_BYTES, stream, a);
#endif
}
```

```cpp
#include <hip/hip_runtime.h>
#include <cstdio>
#include <cstdint>

#ifndef PER_PHASE_LAUNCH
#define PER_PHASE_LAUNCH 0
#endif
#ifndef DBG_STOP
#define DBG_STOP 0
#endif

#define GAS __attribute__((address_space(1)))
#define LAS __attribute__((address_space(3)))
#define DI __device__ __forceinline__
typedef unsigned short bf16;
typedef unsigned v4u __attribute__((ext_vector_type(4)));
typedef unsigned v2u __attribute__((ext_vector_type(2)));
typedef float f32x4 __attribute__((ext_vector_type(4)));
typedef float f32x2 __attribute__((ext_vector_type(2)));
typedef short bf16x8 __attribute__((ext_vector_type(8)));
typedef __bf16 bfv2 __attribute__((ext_vector_type(2)));

constexpr int D = 1024, NB = 16, SEQ = 2048, CTXL = 256;
constexpr int NTOK = NB * SEQ;
constexpr int NCTX = NB * CTXL;
constexpr int MTOT = NTOK + NCTX;
constexpr int INC = 3584;
constexpr int NE = 256, TOPK = 8, DE = 256;
constexpr int LISTCAP = 32768;
constexpr float EPS = 1e-6f;
constexpr int NWAVES = 8, NTHR = 512;
constexpr int NSEQT = 36;

constexpr size_t MiB = 1u << 20;
constexpr size_t WS_CTL = 0, CTL_ZERO_BYTES = 1 * MiB;
constexpr size_t WS_MOD = 1 * MiB;
constexpr size_t WS_TAB = 2 * MiB;
constexpr size_t WS_WGT = 2 * MiB + 65536;
constexpr size_t WS_WIN = 3 * MiB;
constexpr size_t WS_WOUT = 10 * MiB;
constexpr size_t WS_WR = 12 * MiB;
constexpr size_t WS_SW13 = 12 * MiB + 512 * 1024;
constexpr size_t WS_SW2 = 13 * MiB + 512 * 1024;
constexpr size_t WS_DUMP = 2 * MiB + 16384;
constexpr size_t WS_SUMA = 14 * MiB;
constexpr size_t WS_SUMH = WS_SUMA + 2359296;
constexpr size_t WS_CIN = WS_SUMH + 2359296;
constexpr size_t WS_ROUTE = 21 * MiB;
constexpr size_t WS_HIST = 23 * MiB;
constexpr size_t WS_EW13 = 32 * MiB;
constexpr size_t WS_EW2 = 288 * MiB;
constexpr size_t WS_X1 = 416 * MiB;
constexpr size_t WS_HX2 = 544 * MiB;
constexpr size_t WS_LOGIT = 608 * MiB;
constexpr size_t WS_LIST = 1620 * MiB;
constexpr size_t WS_ACT = 674 * MiB;
constexpr size_t WS_YS = 850 * MiB;
constexpr size_t WS_P = 914 * MiB;
constexpr size_t WS_HX = 1166 * MiB;
constexpr size_t WS_OF = 1238 * MiB;
constexpr size_t WS_OB = 1270 * MiB;
constexpr size_t WS_YL = 1302 * MiB;
constexpr size_t WS_YE = 914 * MiB;
constexpr size_t WS_INV = 24 * MiB;
constexpr size_t WS_HX2F = 1684 * MiB;
constexpr size_t WS_END = 1716 * MiB;
constexpr int CW_BAR = 4096;
constexpr int CW_CNT = 16384;

constexpr int RING_BYTES = 131072;
constexpr int LDS_TS = RING_BYTES;
constexpr int LDS_CNT = LDS_TS + 1088;
constexpr int LDS_IDX = LDS_CNT + 1024;
constexpr int LDS_MISC = LDS_IDX + 12 * 1024;
constexpr int LDS_BYTES = 155648;
static_assert(LDS_MISC + 64 <= LDS_BYTES, "lds map");

DI unsigned pk2(float lo, float hi) { f32x2 v = {lo, hi}; bfv2 b = __builtin_convertvector(v, bfv2); return __builtin_bit_cast(unsigned, b); }
DI float clamp448(float x) { return fminf(fmaxf(x, -448.0f), 448.0f); }
DI unsigned pk4_f8(float a, float b, float c, float d) {
    int w = __builtin_amdgcn_cvt_pk_fp8_f32(clamp448(a), clamp448(b), 0, false); w = __builtin_amdgcn_cvt_pk_fp8_f32(clamp448(c), clamp448(d), w, true); return (unsigned)w; }
DI float bflo(unsigned w) { return __uint_as_float(w << 16); }
DI float bfhi(unsigned w) { return __uint_as_float(w & 0xffff0000u); }
DI float bf2f(bf16 h) { return __uint_as_float(((unsigned)h) << 16); }
DI bf16 f2bf(float f) { return (bf16)(pk2(f, 0.f) & 0xffffu); }
DI float rcpf_(float x) { return __builtin_amdgcn_rcpf(x); }
DI float ex2f_(float x) { return __builtin_amdgcn_exp2f(x); }
DI float expf_(float x) { return __builtin_amdgcn_exp2f(x * 1.4426950408889634f); }
DI float logf_(float x) { return __builtin_amdgcn_logf(x) * 0.6931471805599453f; }
DI float sigm(float x) { return rcpf_(1.0f + expf_(-x)); }
DI float wave_sum(float v) {
#pragma unroll
    for (int o = 1; o < 64; o <<= 1) v += __shfl_xor(v, o);
    return v;
}
#define LDS_WAIT() asm volatile("s_waitcnt lgkmcnt(0)" ::: "memory")

#define XB_TMO      128
#define XB_XCNT(j)  (256  + 64 * (j))
#define XB_XSUB(j)  (1280 + 64 * (j))
#define XB_XGEN(j)  (2304 + 64 * (j))
#define XB_TOP      3328
#define XB_TOPGEN   3392
#define XCD_BAR_WORDS 3456
#define XB_SPIN_CAP (1u << 18)
__device__ __forceinline__ unsigned xb_ld(unsigned* p)              { return __hip_atomic_load(p, __ATOMIC_RELAXED, __HIP_MEMORY_SCOPE_AGENT); }
__device__ __forceinline__ unsigned xb_add(unsigned* p, unsigned v) { return __hip_atomic_fetch_add(p, v, __ATOMIC_RELAXED, __HIP_MEMORY_SCOPE_AGENT); }
__device__ __forceinline__ unsigned xb_xcc_id() { return (unsigned)__builtin_amdgcn_s_getreg((3 << 11) | 20) & 0xFu; }
#define XB_SPIN(cond, bar) do { unsigned _sp = 0; while (cond) { __builtin_amdgcn_s_sleep(1); \
    if ((++_sp & 255u) == 0u) { if (xb_ld(&(bar)[XB_TMO])) break; if (_sp > XB_SPIN_CAP) { atomicAdd(&(bar)[XB_TMO], 1u); break; } } } } while (0)
struct XcdBarrier { unsigned* bar; unsigned x; volatile LAS unsigned* st; };
__device__ __forceinline__ XcdBarrier xcd_barrier_post(unsigned* bar, volatile LAS unsigned* st) {
    XcdBarrier b; b.bar = bar; b.x = xb_xcc_id(); b.st = st;
    if (threadIdx.x == 0) (void)xb_add(&bar[XB_XCNT(b.x)], 1u);
    return b;
}
__device__ __forceinline__ void xcd_barrier_complete(unsigned* bar, unsigned x, unsigned& nloc, unsigned& nx) {
    const unsigned G = gridDim.x * gridDim.y * gridDim.z;
    unsigned sum, cnt, mine, sp = 0u;
    for (;;) {
        sum = 0u; cnt = 0u; mine = 0u;
#pragma unroll
        for (unsigned j = 0; j < 16; ++j) { const unsigned c = xb_ld(&bar[XB_XCNT(j)]); sum += c; cnt += (c > 0u) ? 1u : 0u; mine = (j == x) ? c : mine; }
        if (sum == G) break;
        __builtin_amdgcn_s_sleep(1);
        if ((++sp & 255u) == 0u) { if (xb_ld(&bar[XB_TMO])) break; if (sp > XB_SPIN_CAP) { atomicAdd(&bar[XB_TMO], 1u); break; } }
    }
    nloc = mine > 0u ? mine : 1u; nx = cnt > 0u ? cnt : 1u;
}
__device__ __forceinline__ void xcd_barrier(const XcdBarrier& b) {
    asm volatile("s_waitcnt vmcnt(0)" ::: "memory");
    __syncthreads();
    if (threadIdx.x == 0) {
        unsigned* bar = b.bar;
        __builtin_amdgcn_s_waitcnt(0);
        unsigned nloc = b.st[0], nx = b.st[1];
        if (nloc == 0u) { xcd_barrier_complete(bar, b.x, nloc, nx); b.st[0] = nloc; b.st[1] = nx; }
        const unsigned old = xb_add(&bar[XB_XSUB(b.x)], 1u);
        const unsigned gen = old / nloc;
        if (old + 1u == (gen + 1u) * nloc) {
            __builtin_amdgcn_fence(__ATOMIC_RELEASE, "agent");
            asm volatile("s_waitcnt vmcnt(0)" ::: "memory");
            const unsigned og = xb_add(&bar[XB_TOP], 1u);
            const unsigned tg = og / nx;
            if (og + 1u == (tg + 1u) * nx) xb_add(&bar[XB_TOPGEN], 1u);
            else XB_SPIN(xb_ld(&bar[XB_TOPGEN]) == tg, bar);
            __builtin_amdgcn_fence(__ATOMIC_ACQUIRE, "agent");
            xb_add(&bar[XB_XGEN(b.x)], 1u);
            asm volatile("s_waitcnt vmcnt(0)" ::: "memory");
        } else {
            XB_SPIN(xb_ld(&bar[XB_XGEN(b.x)]) == gen, bar);
            __builtin_amdgcn_fence(__ATOMIC_ACQUIRE, "agent");
            asm volatile("s_waitcnt vmcnt(0)" ::: "memory");
        }
    }
    __syncthreads();
}

namespace pg8 {
constexpr int BM = 256, BK = 64, HALF = 128, HTB = HALF * BK * 2, NXCD = 8, WGM = 8;
DI int lds_byte(int r, int c) { const int st = (r >> 4) * 2 + (c >> 5), rr = r & 15, cc = c & 31, ob = rr * 64 + cc * 2; return st * 1024 + (ob ^ (((ob >> 9) & 1) << 5)); }
DI void stage_rc(int b, int& R, int& C) { const int st = b / 1024, sb = b % 1024, swz = sb ^ (((sb >> 9) & 1) << 5); R = (st >> 1) * 16 + swz / 64; C = (st & 1) * 32 + (swz % 64) / 2; }
DI int perm32(int rho) { const int n = rho >> 4, i = rho & 15; return 8 * (i >> 2) + 4 * n + (i & 3); }

struct Unit { int pm, pn, e, rt, ord, nrows; };

struct DenseOrder {
    const char* A; const char* Bt; int K, nM, nN, nwg, G, c;
    DI void init(const void* A_, const void* Bt_, int M, int N, int K_, int G_, int c_) { A = (const char*)A_; Bt = (const char*)Bt_; K = K_; nM = M / BM; nN = N / BM; nwg = nM * nN; G = G_; c = c_; }
    DI bool next(int i, Unit& u) const {
        const long L = (long)i * G + c; if (L >= nwg) return false;
        int wgid = (int)L; { const int q = nwg / NXCD, r = nwg % NXCD, xcd = wgid % NXCD, off = wgid / NXCD; wgid = (xcd < r ? xcd * (q + 1) : r * (q + 1) + (xcd - r) * q) + off; }
        const int nig = WGM * nN, gid = wgid / nig, fm = gid * WGM, gsz = (nM - fm) < WGM ? (nM - fm) : WGM;
        u.pm = fm + ((wgid % nig) % gsz); u.pn = (wgid % nig) / gsz; u.e = 0; u.rt = u.pm; u.ord = i; u.nrows = 256; return true;
    }
    DI const char* a_base(const Unit& u) const { return A + (size_t)u.pm * BM * K * 2; }
    DI const char* b_base(const Unit& u) const { return Bt + (size_t)u.pn * BM * K * 2; }
    DI void a_offs(const Unit&, const int (&R)[2], const int (&C)[2], unsigned (&v)[2][2]) const {
#pragma unroll
        for (int h = 0; h < 2; ++h)
#pragma unroll
            for (int i = 0; i < 2; ++i) v[h][i] = (unsigned)((h * HALF + R[i]) * K + C[i]) * 2u;
    }
};

template <bool GATHER> struct MoeOrder {
    const char* A; const char* Bt; const char* BtS; int K, ncol; size_t estride;
    const LAS int* ts; const LAS int* cnt; const LAS int* idx; int G, vcu, total;
    DI bool next(int i, Unit& u) const {
        const int L = i * G + vcu; if (L >= total) return false;
        const int rt = L / ncol; u.pn = L - rt * ncol; u.rt = rt; u.ord = i;
        const int Te = ts[256];
        if (rt >= Te) { u.e = 256; u.pm = rt - Te; u.nrows = 256; }
        else { int lo = 0, hi = 256;
#pragma unroll 1
            while (hi - lo > 1) { const int mid = (lo + hi) >> 1; if (ts[mid] <= rt) lo = mid; else hi = mid; }
            u.e = lo; u.pm = rt - ts[lo]; const int rem = cnt[lo] - u.pm * 256; u.nrows = rem < 256 ? rem : 256; }
        return true;
    }
    DI const char* a_base(const Unit& u) const { return GATHER ? A : A + (size_t)u.rt * BM * K * 2; }
    DI const char* b_base(const Unit& u) const { return (u.e < 256 ? Bt + (size_t)u.e * estride : BtS) + (size_t)u.pn * BM * K * 2; }
    DI void a_offs(const Unit& u, const int (&R)[2], const int (&C)[2], unsigned (&v)[2][2]) const {
#pragma unroll
        for (int h = 0; h < 2; ++h)
#pragma unroll
            for (int i = 0; i < 2; ++i) {
                if (GATHER) v[h][i] = ((unsigned)idx[u.ord * 256 + h * HALF + R[i]] * (unsigned)K + (unsigned)C[i]) * 2u;
                else v[h][i] = (unsigned)((h * HALF + R[i]) * K + C[i]) * 2u;
            }
    }
};

struct GProf { unsigned long long t_loop, t_epi, t_next; };
typedef int v8i __attribute__((ext_vector_type(8)));
template <class Epi, class Sched, bool PROF = false, bool F8 = false>
__device__ __forceinline__ void gemm_phase(LAS unsigned char* lds, const int K, const Sched& S, const Epi& E, GProf* prof = nullptr) {
    unsigned long long pt0 = 0, pt1 = 0, pt2 = 0, pt3 = 0;
    const int tid = threadIdx.x, wid = __builtin_amdgcn_readfirstlane(tid >> 6), lane = tid & 63, wr = wid >> 2, wc = wid & 3, fr = lane & 15, fq = lane >> 4;
    const int nt = K / BK;
    unsigned voffBh[2][2]; int Rr[2], Cc[2];
#pragma unroll
    for (int i = 0; i < 2; ++i) { int R, C; stage_rc(tid * 16 + i * 8192, R, C); Rr[i] = R; Cc[i] = C;
#pragma unroll
        for (int h = 0; h < 2; ++h) { int Rb;
            if (Epi::PERM == 2) Rb = 64 * ((R >> 5) & 3) + 16 * ((R >> 2) & 3) + 8 * h + 4 * ((R >> 4) & 1) + (R & 3);
            else Rb = HALF * h + (Epi::PERM == 1 ? ((R & ~31) + perm32(R & 31)) : R);
            voffBh[h][i] = (unsigned)(Rb * K + C) * 2u; } }
    const size_t kstep = (size_t)(BK * 2);
    const size_t hstep = (size_t)HALF * K * 2;
    const unsigned ldsw = (unsigned)wid * 1024u;
    const int aoff = F8 ? lds_byte(wr * 64 + fr, fq * 16) : lds_byte(wr * 64 + fr, fq * 8), boff = F8 ? lds_byte(wc * 32 + fr, fq * 16) : lds_byte(wc * 32 + fr, fq * 8);
#define PG8_SA(b, h) (((b) * 2 + (h)) * HTB)
#define PG8_SB(b, h) ((4 + (b) * 2 + (h)) * HTB)
#define PG8_STAGE(bufoff, gbase, voff) do { _Pragma("unroll") for (int _i = 0; _i < 2; ++_i) \
        __builtin_amdgcn_global_load_lds((const unsigned*)((const char*)(gbase) + (voff)[_i]), (LAS unsigned*)(lds + (bufoff) + ldsw + _i * 8192), 16, 0, 0); } while (0)
#define PG8_LD8(dst, off) do { const v4u _lo = *(const LAS v4u*)(lds + (off)), _hi = *(const LAS v4u*)(lds + (off) + 16); \
        dst[0] = (int)_lo.x; dst[1] = (int)_lo.y; dst[2] = (int)_lo.z; dst[3] = (int)_lo.w; dst[4] = (int)_hi.x; dst[5] = (int)_hi.y; dst[6] = (int)_hi.z; dst[7] = (int)_hi.w; } while (0)
#define PG8_LDA(dst, b, h) do { if (F8) { _Pragma("unroll") for (int m = 0; m < 4; ++m) PG8_LD8(dst##8[m], PG8_SA(b, h) + aoff + m * 2048); } \
        else { _Pragma("unroll") for (int m = 0; m < 4; ++m) _Pragma("unroll") for (int k = 0; k < 2; ++k) dst[m][k] = *(const LAS bf16x8*)(lds + PG8_SA(b, h) + aoff + m * 2048 + k * 1024); } } while (0)
#define PG8_LDB(dst, b, h) do { if (F8) { _Pragma("unroll") for (int n = 0; n < 2; ++n) PG8_LD8(dst##8[n], PG8_SB(b, h) + boff + n * 2048); } \
        else { _Pragma("unroll") for (int n = 0; n < 2; ++n) _Pragma("unroll") for (int k = 0; k < 2; ++k) dst[n][k] = *(const LAS bf16x8*)(lds + PG8_SB(b, h) + boff + n * 2048 + k * 1024); } } while (0)
#define PG8_MMA(ai, bj, At, Bt) do { __builtin_amdgcn_s_setprio(1); \
        if (F8) { _Pragma("unroll") for (int m = 0; m < 4; ++m) _Pragma("unroll") for (int n = 0; n < 2; ++n) \
            asm volatile("v_mfma_scale_f32_16x16x128_f8f6f4 %0, %1, %2, %0, %3, %3 op_sel_hi:[0,0,0]" : "+v"(acc[ai][bj][m][n]) : "v"(Bt##8[n]), "v"(At##8[m]), "v"(sc127)); } \
        else { _Pragma("unroll") for (int m = 0; m < 4; ++m) _Pragma("unroll") for (int n = 0; n < 2; ++n) _Pragma("unroll") for (int k = 0; k < 2; ++k) \
            acc[ai][bj][m][n] = __builtin_amdgcn_mfma_f32_16x16x32_bf16(Bt[n][k], At[m][k], acc[ai][bj][m][n], 0, 0, 0); } \
        __builtin_amdgcn_s_setprio(0); } while (0)
#define PG8_WAIT_V(n) asm volatile("s_waitcnt vmcnt(" #n ")" ::: "memory")
#define PG8_WAIT_L(n) asm volatile("s_waitcnt lgkmcnt(" #n ")" ::: "memory")
#define PG8_BAR __builtin_amdgcn_s_barrier()
#define PG8_SCHED __builtin_amdgcn_sched_barrier(0)
    Unit cur, nxt; int ui = 0;
    if (!S.next(0, cur)) return;
    f32x4 acc[2][2][4][2];
#pragma unroll
    for (int a = 0; a < 2; ++a)
#pragma unroll
        for (int b = 0; b < 2; ++b)
#pragma unroll
            for (int m = 0; m < 4; ++m)
#pragma unroll
                for (int n = 0; n < 2; ++n) acc[a][b][m][n] = (f32x4){0.f, 0.f, 0.f, 0.f};
    bf16x8 At[4][2], B0[2][2], B1[2][2];
    v8i At8[4], B08[2], B18[2];
    int sc127 = 127; asm volatile("" : "+v"(sc127));
    unsigned vC[2][2], vN[2][2];
    S.a_offs(cur, Rr, Cc, vC);
    const char* cA = S.a_base(cur); const char* cB = S.b_base(cur);
    PG8_STAGE(PG8_SB(0, 0), cB, voffBh[0]); PG8_STAGE(PG8_SA(0, 0), cA, vC[0]); PG8_STAGE(PG8_SB(0, 1), cB, voffBh[1]); PG8_STAGE(PG8_SA(0, 1), cA, vC[1]);
    if (wr == 1) PG8_BAR;
    PG8_WAIT_V(4); PG8_BAR;
    PG8_STAGE(PG8_SB(1, 0), cB + kstep, voffBh[0]); PG8_STAGE(PG8_SA(1, 0), cA + kstep, vC[0]); PG8_STAGE(PG8_SB(1, 1), cB + kstep, voffBh[1]);
    PG8_WAIT_V(6); PG8_BAR;
    for (;;) {
        if (PROF) pt0 = __builtin_amdgcn_s_memrealtime();
        const bool has_next = S.next(ui + 1, nxt);
        const char* nA = has_next ? S.a_base(nxt) : cA; const char* nB = has_next ? S.b_base(nxt) : cB;
        if (has_next) S.a_offs(nxt, Rr, Cc, vN);
        else { vN[0][0] = vC[0][0]; vN[0][1] = vC[0][1]; vN[1][0] = vC[1][0]; vN[1][1] = vC[1][1]; }
        if (PROF) pt1 = __builtin_amdgcn_s_memrealtime();
#pragma unroll 1
        for (int t = 0; t < nt; t += 2) {
            const bool last = (t == nt - 2);
            const char* a1 = cA + (size_t)(t + 1) * kstep;
            const char* a2 = last ? nA : cA + (size_t)(t + 2) * kstep; const char* b2 = last ? nB : cB + (size_t)(t + 2) * kstep;
            const char* a3 = a2 + kstep; const char* b3 = b2 + kstep;
            unsigned x0[2], x1[2];
            x0[0] = last ? vN[0][0] : vC[0][0]; x0[1] = last ? vN[0][1] : vC[0][1]; x1[0] = last ? vN[1][0] : vC[1][0]; x1[1] = last ? vN[1][1] : vC[1][1];
            PG8_LDB(B0, 0, 0); PG8_SCHED; PG8_LDA(At, 0, 0); PG8_STAGE(PG8_SA(1, 1), a1, vC[1]);
            PG8_WAIT_L(8); PG8_BAR; PG8_WAIT_L(0); PG8_MMA(0, 0, At, B0); PG8_BAR; PG8_SCHED;
            PG8_LDB(B1, 0, 1); PG8_STAGE(PG8_SB(0, 0), b2, voffBh[0]);
            PG8_BAR; PG8_WAIT_L(0); PG8_MMA(0, 1, At, B1); PG8_BAR;
            PG8_LDA(At, 0, 1); PG8_STAGE(PG8_SA(0, 0), a2, x0);
            PG8_BAR; PG8_WAIT_L(0); PG8_MMA(1, 0, At, B0); PG8_BAR; PG8_SCHED;
            PG8_STAGE(PG8_SB(0, 1), b2, voffBh[1]);
            PG8_WAIT_V(6); PG8_BAR; PG8_MMA(1, 1, At, B1); PG8_BAR;
            PG8_LDB(B0, 1, 0); PG8_SCHED; PG8_LDA(At, 1, 0); PG8_STAGE(PG8_SA(0, 1), a2, x1);
            PG8_WAIT_L(8); PG8_BAR; PG8_WAIT_L(0); PG8_MMA(0, 0, At, B0); PG8_BAR; PG8_SCHED;
            PG8_LDB(B1, 1, 1); PG8_STAGE(PG8_SB(1, 0), b3, voffBh[0]);
            PG8_BAR; PG8_WAIT_L(0); PG8_MMA(0, 1, At, B1); PG8_BAR;
            PG8_LDA(At, 1, 1); PG8_STAGE(PG8_SA(1, 0), a3, x0);
            PG8_BAR; PG8_WAIT_L(0); PG8_MMA(1, 0, At, B0); PG8_BAR; PG8_SCHED;
            PG8_STAGE(PG8_SB(1, 1), b3, voffBh[1]);
            PG8_WAIT_V(6); PG8_BAR; PG8_MMA(1, 1, At, B1); PG8_BAR;
        }
        if (PROF) pt2 = __builtin_amdgcn_s_memrealtime();
        if (F8) asm volatile("s_nop 15\n\ts_nop 15" ::: "memory");
        E(acc, cur, wr, wc, fr, fq);
        if (PROF) { asm volatile("s_waitcnt vmcnt(0)" ::: "memory"); pt3 = __builtin_amdgcn_s_memrealtime(); prof->t_next += pt1 - pt0; prof->t_loop += pt2 - pt1; prof->t_epi += pt3 - pt2; }
        if (!has_next) break;
#pragma unroll
        for (int a = 0; a < 2; ++a)
#pragma unroll
            for (int b = 0; b < 2; ++b)
#pragma unroll
                for (int m = 0; m < 4; ++m)
#pragma unroll
                    for (int n = 0; n < 2; ++n) acc[a][b][m][n] = (f32x4){0.f, 0.f, 0.f, 0.f};
        cur = nxt; cA = nA; cB = nB; ++ui;
        vC[0][0] = vN[0][0]; vC[0][1] = vN[0][1]; vC[1][0] = vN[1][0]; vC[1][1] = vN[1][1];
    }
    PG8_WAIT_V(0);
    if (wr == 0) PG8_BAR;
    PG8_BAR;
#undef PG8_SA
#undef PG8_SB
#undef PG8_STAGE
#undef PG8_LD8
#undef PG8_LDA
#undef PG8_LDB
#undef PG8_MMA
#undef PG8_WAIT_V
#undef PG8_WAIT_L
#undef PG8_BAR
#undef PG8_SCHED
}

DI float gelu_tanh(float x) { const float u = 1.5957691216f * (x + 0.044715f * x * x * x); return x * rcpf_(1.0f + expf_(-u)); }
DI float silu_f(float x) { return x * rcpf_(1.0f + expf_(-x)); }

struct EpiInProj {
    static constexpr int PERM = 1;
    bf16* P; const float* LB;
    DI void operator()(const f32x4 (&acc)[2][2][4][2], const Unit& u, int wr, int wc, int fr, int fq) const {
        const int row0 = u.pm * BM + wr * 64 + fr, col0 = u.pn * BM + wc * 32 + 8 * fq;
        const int pn = u.pn;
        const int kind = (pn == 2 || pn == 3) ? 1 : (pn >= 8 && pn < 12) ? 2 : (pn >= 12) ? 3 : 0;
        f32x4 lbv[2][2];
        { const int dir = (pn >> 1) & 1; const int cc = (pn & 1) * 256 + wc * 32 + 8 * fq;
#pragma unroll
            for (int bj = 0; bj < 2; ++bj)
#pragma unroll
                for (int n = 0; n < 2; ++n) lbv[bj][n] = *(const f32x4*)(LB + dir * 512 + cc + bj * HALF + 4 * n);
            asm volatile("" :: "v"(lbv[0][0]), "v"(lbv[0][1]), "v"(lbv[1][0]), "v"(lbv[1][1])); }
#pragma unroll
        for (int ai = 0; ai < 2; ++ai)
#pragma unroll
            for (int m = 0; m < 4; ++m) { bf16* rowp = P + (size_t)(row0 + ai * HALF + m * 16) * INC + col0;
#pragma unroll
                for (int bj = 0; bj < 2; ++bj) { f32x4 v0 = acc[ai][bj][m][0], v1 = acc[ai][bj][m][1];
                    if (kind == 1) {
#pragma unroll
                        for (int j = 0; j < 4; ++j) { v0[j] = gelu_tanh(v0[j]); v1[j] = gelu_tanh(v1[j]); } }
                    else if (kind == 2) {
#pragma unroll
                        for (int j = 0; j < 4; ++j) { const float l0 = lbv[bj][0][j], l1 = lbv[bj][1][j];
                            v0[j] = logf_(l0 + (1.0f - l0) * sigm(v0[j])); v1[j] = logf_(l1 + (1.0f - l1) * sigm(v1[j])); } }
                    else if (kind == 3) {
#pragma unroll
                        for (int j = 0; j < 4; ++j) { v0[j] = silu_f(v0[j]); v1[j] = silu_f(v1[j]); } }
                    v4u w; w.x = pk2(v0[0], v0[1]); w.y = pk2(v0[2], v0[3]); w.z = pk2(v1[0], v1[1]); w.w = pk2(v1[2], v1[3]);
                    *(v4u*)(rowp + bj * HALF) = w; } }
    }
};
struct EpiResid {
    static constexpr int PERM = 0;
    const float* x; const float* mod; float* X1;
    DI void operator()(const f32x4 (&acc)[2][2][4][2], const Unit& u, int wr, int wc, int fr, int fq) const {
        const int row0 = u.pm * BM + wr * 64 + fr, col0 = u.pn * BM + wc * 32 + 4 * fq;
        const int b = (u.pm * BM) >> 11;
        f32x4 gv[2][2];
#pragma unroll
        for (int bj = 0; bj < 2; ++bj)
#pragma unroll
            for (int n = 0; n < 2; ++n) gv[bj][n] = *(const f32x4*)(mod + (size_t)b * 6144 + 2048 + col0 + bj * HALF + n * 16);
#pragma unroll
        for (int ai = 0; ai < 2; ++ai)
#pragma unroll
            for (int m = 0; m < 4; ++m) { const size_t off = (size_t)(row0 + ai * HALF + m * 16) * D + col0;
#pragma unroll
                for (int bj = 0; bj < 2; ++bj)
#pragma unroll
                    for (int n = 0; n < 2; ++n) { const f32x4 xv = *(const f32x4*)(x + off + bj * HALF + n * 16);
                        *(f32x4*)(X1 + off + bj * HALF + n * 16) = xv + gv[bj][n] * acc[ai][bj][m][n]; } }
    }
};
struct EpiF32 {
    static constexpr int PERM = 0;
    float* C; int ldc;
    DI void operator()(const f32x4 (&acc)[2][2][4][2], const Unit& u, int wr, int wc, int fr, int fq) const {
        const int row0 = u.pm * BM + wr * 64 + fr, col0 = u.pn * BM + wc * 32 + 4 * fq;
#pragma unroll
        for (int ai = 0; ai < 2; ++ai)
#pragma unroll
            for (int m = 0; m < 4; ++m) { float* rowp = C + (size_t)(row0 + ai * HALF + m * 16) * ldc + col0;
#pragma unroll
                for (int bj = 0; bj < 2; ++bj)
#pragma unroll
                    for (int n = 0; n < 2; ++n) *(f32x4*)(rowp + bj * HALF + n * 16) = acc[ai][bj][m][n]; }
    }
};
struct EpiSwiGLU8 {
    static constexpr int PERM = 1;
    unsigned char* ACT;
    DI void operator()(const f32x4 (&acc)[2][2][4][2], const Unit& u, int wr, int wc, int fr, int fq) const {
        const unsigned off0 = ((unsigned)u.rt * 256u + (unsigned)(wr * 64 + fr)) * (unsigned)DE + (unsigned)(u.pn * 128 + wc * 32 + 8 * fq);
#pragma unroll
        for (int ai = 0; ai < 2; ++ai)
#pragma unroll
            for (int m = 0; m < 4; ++m) {
                f32x4 a0 = acc[ai][0][m][0] * 0.03125f, a1 = acc[ai][0][m][1] * 0.03125f; const f32x4 g0 = acc[ai][1][m][0] * 0.25f, g1 = acc[ai][1][m][1] * 0.25f;
#pragma unroll
                for (int j = 0; j < 4; ++j) { a0[j] = silu_f(a0[j]) * g0[j]; a1[j] = silu_f(a1[j]) * g1[j]; }
                v2u w; w.x = pk4_f8(a0[0], a0[1], a0[2], a0[3]); w.y = pk4_f8(a1[0], a1[1], a1[2], a1[3]);
                *(v2u*)(ACT + (off0 + (unsigned)((ai * HALF + m * 16) * DE))) = w; }
    }
};
struct EpiSwiGLU {
    static constexpr int PERM = 1;
    bf16* ACT;
    DI void operator()(const f32x4 (&acc)[2][2][4][2], const Unit& u, int wr, int wc, int fr, int fq) const {
        const int row0 = wr * 64 + fr, col0 = u.pn * 128 + wc * 32 + 8 * fq;
        bf16* base = ACT + (size_t)u.rt * 256 * DE;
#pragma unroll
        for (int ai = 0; ai < 2; ++ai)
#pragma unroll
            for (int m = 0; m < 4; ++m) { bf16* rowp = base + (size_t)(row0 + ai * HALF + m * 16) * DE + col0;
                f32x4 a0 = acc[ai][0][m][0], a1 = acc[ai][0][m][1]; const f32x4 g0 = acc[ai][1][m][0], g1 = acc[ai][1][m][1];
#pragma unroll
                for (int j = 0; j < 4; ++j) { a0[j] = silu_f(a0[j]) * g0[j]; a1[j] = silu_f(a1[j]) * g1[j]; }
                v4u w; w.x = pk2(a0[0], a0[1]); w.y = pk2(a0[2], a0[3]); w.z = pk2(a1[0], a1[1]); w.w = pk2(a1[2], a1[3]);
                *(v4u*)rowp = w; }
    }
};
struct EpiScatter {
    static constexpr int PERM = 2;
    bf16* YE; const v2u* LIST; float oscale;
    DI void operator()(const f32x4 (&acc)[2][2][4][2], const Unit& u, int wr, int wc, int fr, int fq) const {
        const unsigned col0 = (unsigned)(u.pn * BM + wc * 64 + 16 * fq);
        const unsigned lbase = (u.e < 256) ? (unsigned)u.e * (unsigned)LISTCAP + (unsigned)u.pm * 256u : 0u;
        float gt[2][4];
#pragma unroll
        for (int ai = 0; ai < 2; ++ai)
#pragma unroll
            for (int m = 0; m < 4; ++m) { const int r = ai * HALF + wr * 64 + m * 16 + fr;
                const int rr = r < u.nrows ? r : u.nrows - 1;
                const v2u t2 = LIST[lbase + (u.e < 256 ? (unsigned)rr : 0u)]; gt[ai][m] = ((u.e < 256) ? __uint_as_float(t2.y) : 1.0f) * oscale; }
#pragma unroll
        for (int ai = 0; ai < 2; ++ai)
#pragma unroll
            for (int m = 0; m < 4; ++m) { const int r = ai * HALF + wr * 64 + m * 16 + fr; const float g = gt[ai][m];
                const unsigned row = (r < u.nrows) ? (unsigned)u.rt * 256u + (unsigned)r : 360448u;
                bf16* dst = YE + (row * (unsigned)D + col0);
#pragma unroll
                for (int bj = 0; bj < 2; ++bj) { const f32x4 v0 = acc[ai][bj][m][0] * g, v1 = acc[ai][bj][m][1] * g;
                    v4u w; w.x = pk2(v0[0], v0[1]); w.y = pk2(v0[2], v0[3]); w.z = pk2(v1[0], v1[1]); w.w = pk2(v1[2], v1[3]);
                    *(v4u*)(dst + 8 * bj) = w; } }
    }
};
}

struct Args { const float* in[26]; float* out; unsigned char* ws; int ph_lo, ph_hi; };
enum { I_X = 0, I_C, I_CTX, I_CCTX, I_ADAW, I_ADAB, I_NMIX, I_NFFN, I_NFIN, I_WIN, I_WOUT, I_CONVW, I_CONVB, I_WA, I_BA, I_WX, I_BX, I_LAM,
       I_LBL, I_HNORM, I_RW, I_RB, I_EW13, I_EW2, I_SW13, I_SW2 };

struct Frame {
    LAS unsigned char* lds;
    int tid, lane, wave, G, vcu, bx;
    const float* const* in; float* out; unsigned char* ws;
};

DI void transpose_item(const float* W, int ldw, bf16* WT, int ldo, int k0, int n0, int orow0, LAS float* scr, int lane) {
    const int sub = lane >> 3, c4 = (lane & 7) * 4;
    f32x4 v[8];
#pragma unroll
    for (int i = 0; i < 8; ++i) v[i] = __builtin_nontemporal_load((const f32x4*)(W + (size_t)(k0 + 8 * i + sub) * ldw + n0 + c4));
#pragma unroll
    for (int i = 0; i < 8; ++i) { LAS float* d = scr + (8 * i + sub) * 33 + c4; d[0] = v[i].x; d[1] = v[i].y; d[2] = v[i].z; d[3] = v[i].w; }
    LDS_WAIT(); asm volatile("" ::: "memory");
    const int c = lane & 7;
#pragma unroll
    for (int j = 0; j < 4; ++j) { const int n = (lane >> 3) + 8 * j; const LAS float* s = scr + (8 * c) * 33 + n;
        v4u o; o.x = pk2(s[0 * 33], s[1 * 33]); o.y = pk2(s[2 * 33], s[3 * 33]); o.z = pk2(s[4 * 33], s[5 * 33]); o.w = pk2(s[6 * 33], s[7 * 33]);
        *(v4u*)(WT + (size_t)(orow0 + n) * ldo + k0 + 8 * c) = o; }
    LDS_WAIT(); asm volatile("" ::: "memory");
}
DI void transpose_item8(const float* W, int ldw, unsigned char* WT, int ldo, int k0, int n0, int orow0, float scale, LAS float* scr, int lane) {
    const int sub = lane >> 3, c4 = (lane & 7) * 4;
    f32x4 v[16];
#pragma unroll
    for (int i = 0; i < 16; ++i) v[i] = __builtin_nontemporal_load((const f32x4*)(W + (size_t)(k0 + 8 * i + sub) * ldw + n0 + c4));
#pragma unroll
    for (int i = 0; i < 16; ++i) { LAS float* d = scr + (8 * i + sub) * 33 + c4; d[0] = v[i].x; d[1] = v[i].y; d[2] = v[i].z; d[3] = v[i].w; }
    LDS_WAIT(); asm volatile("" ::: "memory");
    const int c = lane & 7;
#pragma unroll
    for (int j = 0; j < 4; ++j) { const int n = (lane >> 3) + 8 * j; const LAS float* sp = scr + (16 * c) * 33 + n;
        v4u o; o.x = pk4_f8(sp[0] * scale, sp[33] * scale, sp[66] * scale, sp[99] * scale); o.y = pk4_f8(sp[132] * scale, sp[165] * scale, sp[198] * scale, sp[231] * scale);
        o.z = pk4_f8(sp[264] * scale, sp[297] * scale, sp[330] * scale, sp[363] * scale); o.w = pk4_f8(sp[396] * scale, sp[429] * scale, sp[462] * scale, sp[495] * scale);
        *(v4u*)(WT + (size_t)(orow0 + n) * ldo + k0 + 16 * c) = o; }
    LDS_WAIT(); asm volatile("" ::: "memory");
}
DI int w13_row(int n) { const int half = n >> 8, idx = n & 255; return 256 * (idx >> 7) + 128 * half + (idx & 127); }

DI void phase_prologue(const Frame& F) {
    const float* const* in = F.in; unsigned char* ws = F.ws;
    {
        LAS float* sc = (LAS float*)F.lds;
        LAS float* red = (LAS float*)(F.lds + 17 * 1024 * 4);
        for (int i = F.tid; i < 17 * 1024; i += NTHR) { const int r = i >> 10, k = i & 1023; const float v = (r < 16) ? in[I_C][r * 1024 + k] : in[I_CCTX][k]; sc[i] = v / (1.0f + __expf(-v)); }
        __syncthreads();
        const float* aw = in[I_ADAW]; float* MOD = (float*)(ws + WS_MOD);
        for (int cg = F.bx; cg < 256; cg += F.G) {
            const int kg = F.tid >> 5, cl = F.tid & 31, col = cg * 24 + cl;
            float a[17];
#pragma unroll
            for (int r = 0; r < 17; ++r) a[r] = 0.f;
            if (cl < 24) {
                for (int kk = 0; kk < 64; ++kk) { const int k = kg * 64 + kk; const float w = aw[(size_t)k * 6144 + col];
#pragma unroll
                    for (int r = 0; r < 17; ++r) a[r] += sc[r * 1024 + k] * w; }
#pragma unroll
                for (int r = 0; r < 17; ++r) red[(kg * 17 + r) * 24 + cl] = a[r];
            }
            __syncthreads();
            if (F.tid < 17 * 24) { const int r = F.tid / 24, c2 = F.tid % 24; float s = 0.f;
                for (int g = 0; g < 16; ++g) s += red[(g * 17 + r) * 24 + c2];
                MOD[r * 6144 + cg * 24 + c2] = s + in[I_ADAB][cg * 24 + c2]; }
            __syncthreads();
        }
    }
    {
        float* LB = (float*)(ws + WS_TAB); float* SP = LB + 1024;
        const int gt = F.bx * NTHR + F.tid, GT = F.G * NTHR;
        for (int i = gt; i < 1024; i += GT) { const int d = i >> 9, c = i & 511;
            const float l0 = in[I_LBL][(d * 2 + 0) * 512 + c], l1 = in[I_LBL][(d * 2 + 1) * 512 + c];
            LB[i] = 1.0f / (1.0f + expf(l1 - l0));
            SP[i] = log1pf(expf(-in[I_LAM][i])); }
        bf16* WGT = (bf16*)(ws + WS_WGT);
        for (int i = gt; i < 2 * 2 * 8 * 64 * 64; i += GT) { const int ii = i & 63, j = (i >> 6) & 63, h = (i >> 12) & 7, g = (i >> 15) & 1, d = i >> 16;
            const float* src = g ? in[I_WX] : in[I_WA];
            WGT[i] = f2bf(src[((size_t)(d * 8 + h) * 64 + ii) * 64 + j]); }
    }
    {
        LAS float* scr = (LAS float*)(F.lds + F.wave * 16896);
        const int gw = F.vcu * NWAVES + F.wave, NGW = F.G * NWAVES;
        constexpr int IT_WIN = 16 * 112, IT_WOUT = 16 * 32, IT_WR = 16 * 8, IT_SW13 = 8 * 16, IT_SW2 = 2 * 32;
        LAS float* scr8 = (LAS float*)(F.lds + F.wave * 16896);
        constexpr int NIT = IT_WIN + IT_WOUT + IT_WR + IT_SW13 + IT_SW2;
        for (int it = gw; it < NIT; it += NGW) {
            int r = it;
            if (r < IT_WIN) { const int kb = r / 112, nb = r % 112; transpose_item(in[I_WIN], INC, (bf16*)(ws + WS_WIN), 1024, kb * 64, nb * 32, nb * 32, scr, F.lane); continue; } r -= IT_WIN;
            if (r < IT_WOUT) { const int kb = r / 32, nb = r % 32; transpose_item(in[I_WOUT], 1024, (bf16*)(ws + WS_WOUT), 1024, kb * 64, nb * 32, nb * 32, scr, F.lane); continue; } r -= IT_WOUT;
            if (r < IT_WR) { const int kb = r / 8, nb = r % 8; transpose_item(in[I_RW], 256, (bf16*)(ws + WS_WR), 1024, kb * 64, nb * 32, nb * 32, scr, F.lane); continue; } r -= IT_WR;
            if (r < IT_SW13) { const int kb = r / 16, nb = r % 16; transpose_item8(in[I_SW13], 512, ws + WS_SW13, 1024, kb * 128, nb * 32, w13_row(nb * 32), 32.0f, scr8, F.lane); continue; } r -= IT_SW13;
            { const int kb = r / 32, nb = r % 32; transpose_item8(in[I_SW2], 1024, ws + WS_SW2, 256, kb * 128, nb * 32, nb * 32, 16.0f, scr8, F.lane); }
        }
    }
}
DI void convert_experts(const Frame& F, int gw, int NGW) {
    const float* const* in = F.in; unsigned char* ws = F.ws;
    LAS float* scr = (LAS float*)(F.lds + F.wave * 16896);
    constexpr int IT_E13 = 256 * 128, IT_E2 = 256 * 64;
    for (int it = gw; it < IT_E13 + IT_E2; it += NGW) {
        int r = it;
        if (r < IT_E13) { const int e = r >> 7, q = r & 127, kb = q >> 4, nb = q & 15;
            transpose_item8(in[I_EW13] + (size_t)e * 1024 * 512, 512, ws + WS_EW13 + (size_t)e * 512 * 1024, 1024, kb * 128, nb * 32, w13_row(nb * 32), 32.0f, scr, F.lane); continue; } r -= IT_E13;
        { const int e = r >> 6, q = r & 63, kb = q >> 5, nb = q & 31;
            transpose_item8(in[I_EW2] + (size_t)e * 256 * 1024, 1024, ws + WS_EW2 + (size_t)e * 1024 * 256, 256, kb * 128, nb * 32, nb * 32, 16.0f, scr, F.lane); }
    }
}

DI void phase_norm_rows(const Frame& F, int mode) {
    const float* MOD = (const float*)(F.ws + WS_MOD);
    const int gw = F.bx * NWAVES + F.wave, NGW = F.G * NWAVES;
    const int nrows = mode == 0 ? MTOT : NTOK;
    const float* gain = mode == 0 ? F.in[I_NMIX] : F.in[I_NFFN];
    bf16* dst = (bf16*)(F.ws + (mode == 0 ? WS_HX : WS_HX2));
    const int sh_off = mode == 0 ? 0 : 3072, sc_off = mode == 0 ? 1024 : 4096;
    for (int m = gw; m < nrows; m += NGW) {
        const float* src; int mr;
        if (mode == 0) { if (m < NTOK) { src = F.in[I_X] + (size_t)m * D; mr = m >> 11; } else { src = F.in[I_CTX] + (size_t)(m - NTOK) * D; mr = 16; } }
        else { src = (const float*)(F.ws + WS_X1) + (size_t)m * D; mr = m >> 11; }
        f32x4 v[4]; float ss = 0.f;
#pragma unroll
        for (int j = 0; j < 4; ++j) { v[j] = *(const f32x4*)(src + 4 * F.lane + 256 * j); ss += (v[j].x * v[j].x + v[j].y * v[j].y) + (v[j].z * v[j].z + v[j].w * v[j].w); }
        const float rs = rsqrtf(wave_sum(ss) * (1.0f / D) + EPS);
#pragma unroll
        for (int j = 0; j < 4; ++j) { const int c = 4 * F.lane + 256 * j;
            const f32x4 gn = *(const f32x4*)(gain + c), sc = *(const f32x4*)(MOD + mr * 6144 + sc_off + c), sh = *(const f32x4*)(MOD + mr * 6144 + sh_off + c);
            const f32x4 y = (v[j] * rs) * gn * (sc + 1.0f) + sh;
            v2u w; w.x = pk2(y.x, y.y); w.y = pk2(y.z, y.w);
            *(v2u*)(dst + (size_t)m * D + c) = w;
            if (mode == 1) *(unsigned*)(F.ws + WS_HX2F + (size_t)m * D + c) = pk4_f8(y.x, y.y, y.z, y.w); }
    }
}

constexpr int LT_STR = 520;
constexpr int L_RT = 0;
constexpr int L_GT = 69888;
static_assert(L_GT + 64 * LT_STR * 2 <= LDS_MISC, "lru lds");
template <bool FINAL> DI void lru_tile(const Frame& F, int b, int s) {
    const bf16* P = (const bf16*)(F.ws + WS_P);
    const int h = F.wave, fr = F.lane & 15, fq = F.lane >> 4;
    int prow0, L, t0;
    if (s < 4) { prow0 = NTOK + b * CTXL + 64 * s; L = CTXL; t0 = 64 * s; } else { prow0 = b * SEQ + 64 * (s - 4); L = SEQ; t0 = 64 * (s - 4); }
    LAS bf16* RT = (LAS bf16*)(F.lds + L_RT); LAS bf16* GT = (LAS bf16*)(F.lds + L_GT);
#pragma unroll
    for (int it = 0; it < 9; ++it) { const int p = F.tid + it * NTHR;
        if (p < 67 * 64) { const int row = p >> 6, pc = p & 63, ts = t0 + row - 1;
            v4u v = {0u, 0u, 0u, 0u};
            if (ts >= 0 && ts < L) v = *(const v4u*)(P + (size_t)(prow0 + row - 1) * INC + 8 * pc);
            *(LAS v4u*)(RT + row * LT_STR + 8 * pc) = v; } }
    if (FINAL) {
#pragma unroll
        for (int it = 0; it < 8; ++it) { const int p = F.tid + it * NTHR; const int row = p >> 6, pc = p & 63;
            *(LAS v4u*)(GT + row * LT_STR + 8 * pc) = *(const v4u*)(P + (size_t)(prow0 + row) * INC + 512 + 8 * pc); } }
    __syncthreads();
    bf16x8 Af[4][2];
#pragma unroll
    for (int ks = 0; ks < 2; ++ks) {
        const int c0 = 64 * h + 32 * ks + 8 * fq;
        float cw[4][8], cb[8];
#pragma unroll
        for (int k = 0; k < 4; ++k) { const f32x4 w0 = *(const f32x4*)(F.in[I_CONVW] + k * 512 + c0), w1 = *(const f32x4*)(F.in[I_CONVW] + k * 512 + c0 + 4);
            cw[k][0] = w0.x; cw[k][1] = w0.y; cw[k][2] = w0.z; cw[k][3] = w0.w; cw[k][4] = w1.x; cw[k][5] = w1.y; cw[k][6] = w1.z; cw[k][7] = w1.w; }
        { const f32x4 w0 = *(const f32x4*)(F.in[I_CONVB] + c0), w1 = *(const f32x4*)(F.in[I_CONVB] + c0 + 4);
            cb[0] = w0.x; cb[1] = w0.y; cb[2] = w0.z; cb[3] = w0.w; cb[4] = w1.x; cb[5] = w1.y; cb[6] = w1.z; cb[7] = w1.w; }
        const LAS bf16* rbase = RT + fr * LT_STR + c0;
#pragma unroll
        for (int tt = 0; tt < 4; ++tt) {
            float u[8];
#pragma unroll
            for (int j = 0; j < 8; ++j) u[j] = cb[j];
#pragma unroll
            for (int k = 0; k < 4; ++k) { const v4u r8 = *(const LAS v4u*)(rbase + (16 * tt + k) * LT_STR);
                u[0] += cw[k][0] * bflo(r8.x); u[1] += cw[k][1] * bfhi(r8.x); u[2] += cw[k][2] * bflo(r8.y); u[3] += cw[k][3] * bfhi(r8.y);
                u[4] += cw[k][4] * bflo(r8.z); u[5] += cw[k][5] * bfhi(r8.z); u[6] += cw[k][6] * bflo(r8.w); u[7] += cw[k][7] * bfhi(r8.w); }
            v4u w; w.x = pk2(u[0], u[1]); w.y = pk2(u[2], u[3]); w.z = pk2(u[4], u[5]); w.w = pk2(u[6], u[7]);
            Af[tt][ks] = __builtin_bit_cast(bf16x8, w);
        }
    }
    const bf16* WGT = (const bf16*)(F.ws + WS_WGT);
    const float* SP = (const float*)(F.ws + WS_TAB) + 1024;
    LAS bf16* HL = RT;
    LAS bf16* hlb = HL + (4 * fq) * LT_STR + 64 * h + fr;
    LAS bf16* gtb = GT + (4 * fq) * LT_STR + 64 * h + fr;
#pragma unroll 1
    for (int dir = 0; dir < 2; ++dir) {
#pragma unroll 1
        for (int nt = 0; nt < 4; ++nt) {
            const int cj = 64 * h + 16 * nt + fr;
            bf16x8 Ba[2], Bx[2], Id[2];
#pragma unroll
            for (int ks = 0; ks < 2; ++ks) {
                Ba[ks] = *(const bf16x8*)(WGT + ((size_t)((dir * 2 + 0) * 8 + h) * 64 + 16 * nt + fr) * 64 + 32 * ks + 8 * fq);
                Bx[ks] = *(const bf16x8*)(WGT + ((size_t)((dir * 2 + 1) * 8 + h) * 64 + 16 * nt + fr) * 64 + 32 * ks + 8 * fq);
#pragma unroll
                for (int jj = 0; jj < 8; ++jj) Id[ks][jj] = (32 * ks + 8 * fq + jj == 16 * nt + fr) ? (short)0x3F80 : (short)0;
            }
            const float ba = F.in[I_BA][dir * 512 + cj], bx = F.in[I_BX][dir * 512 + cj], sp = SP[dir * 512 + cj];
            float cin = 0.f, ptot = 1.f;
            if (FINAL) cin = ((const float*)(F.ws + WS_CIN))[((size_t)(dir * NB + b) * NSEQT + s) * 512 + cj];
#pragma unroll
            for (int tti = 0; tti < 4; ++tti) {
                const int tt = dir ? 3 - tti : tti;
                const bf16x8 A0 = dir ? Af[3 - tti][0] : Af[tti][0], A1 = dir ? Af[3 - tti][1] : Af[tti][1];
                f32x4 pa = {0.f, 0.f, 0.f, 0.f}, px = {0.f, 0.f, 0.f, 0.f}, uc = {0.f, 0.f, 0.f, 0.f};
                pa = __builtin_amdgcn_mfma_f32_16x16x32_bf16(A0, Ba[0], pa, 0, 0, 0); pa = __builtin_amdgcn_mfma_f32_16x16x32_bf16(A1, Ba[1], pa, 0, 0, 0);
                px = __builtin_amdgcn_mfma_f32_16x16x32_bf16(A0, Bx[0], px, 0, 0, 0); px = __builtin_amdgcn_mfma_f32_16x16x32_bf16(A1, Bx[1], px, 0, 0, 0);
                uc = __builtin_amdgcn_mfma_f32_16x16x32_bf16(A0, Id[0], uc, 0, 0, 0); uc = __builtin_amdgcn_mfma_f32_16x16x32_bf16(A1, Id[1], uc, 0, 0, 0);
                float av[4], bv[4];
#pragma unroll
                for (int ri = 0; ri < 4; ++ri) { const float pav = dir ? pa[3 - ri] : pa[ri], pxv = dir ? px[3 - ri] : px[ri], ucv = dir ? uc[3 - ri] : uc[ri];
                    const float rg = sigm(pav + ba), ig = sigm(pxv + bx);
                    const float a = expf_(-8.0f * rg * sp); av[ri] = a; bv[ri] = __builtin_amdgcn_sqrtf(fmaxf(1.0f - a * a, 0.f)) * ig * ucv; }
                float pl = 1.f, hl = 0.f;
#pragma unroll
                for (int ri = 0; ri < 4; ++ri) { hl = av[ri] * hl + bv[ri]; pl *= av[ri]; }
                float pg[4], hg[4];
#pragma unroll
                for (int gi = 0; gi < 4; ++gi) { const int g = dir ? 3 - gi : gi; pg[gi] = __shfl(pl, fr + 16 * g); hg[gi] = __shfl(hl, fr + 16 * g); }
                const int myg = dir ? 3 - fq : fq;
                float mycin = cin, run = cin;
#pragma unroll
                for (int gi = 0; gi < 4; ++gi) { if (gi == myg) mycin = run; run = pg[gi] * run + hg[gi]; }
                if (FINAL) { float hc = mycin;
#pragma unroll
                    for (int ri = 0; ri < 4; ++ri) { const int r = dir ? 3 - ri : ri; hc = av[ri] * hc + bv[ri];
                        const int o = (16 * tt + r) * LT_STR + 16 * nt;
                        if (dir == 0) hlb[o] = f2bf(hc);
                        else gtb[o] = f2bf(bf2f(gtb[o]) * (bf2f(hlb[o]) + hc)); } }
                else ptot *= (pg[0] * pg[1]) * (pg[2] * pg[3]);
                cin = run;
            }
            if (!FINAL && fq == 0) { const size_t o = ((size_t)(dir * NB + b) * NSEQT + s) * 512 + cj;
                ((float*)(F.ws + WS_SUMA))[o] = ptot; ((float*)(F.ws + WS_SUMH))[o] = cin; }
        }
    }
    if (FINAL) {
        __syncthreads();
        bf16* YL = (bf16*)(F.ws + WS_YL);
#pragma unroll
        for (int it = 0; it < 8; ++it) { const int p = F.tid + it * NTHR; const int row = p >> 6, pc = p & 63;
            *(v4u*)(YL + (size_t)(prow0 + row) * D + 8 * pc) = *(const LAS v4u*)(GT + row * LT_STR + 8 * pc); } }
    __syncthreads();
}
DI void phase_lru_pass1(const Frame& F) {
    for (int it = F.bx; it < NB * NSEQT; it += F.G) lru_tile<false>(F, it / NSEQT, it % NSEQT);
}
DI void phase_lru_carry(const Frame& F) {
    if (F.wave != 0) return;
    const float* SA = (const float*)(F.ws + WS_SUMA); const float* SH = (const float*)(F.ws + WS_SUMH); float* CI = (float*)(F.ws + WS_CIN);
    for (int id = F.bx * 64 + F.lane; id < 2 * NB * 512; id += F.G * 64) {
        const int dir = id >> 13, b = (id >> 9) & 15, c = id & 511;
        float x = 0.f; const size_t o0 = (size_t)(dir * NB + b) * NSEQT * 512 + c;
#pragma unroll
        for (int hf = 0; hf < 2; ++hf) {
            float av[18], hv[18];
#pragma unroll
            for (int q = 0; q < 18; ++q) { const int st = 18 * hf + q, s = dir ? (st < 4 ? 3 - st : 39 - st) : st; av[q] = SA[o0 + (size_t)s * 512]; hv[q] = SH[o0 + (size_t)s * 512]; }
#pragma unroll
            for (int q = 0; q < 18; ++q) { const int st = 18 * hf + q, s = dir ? (st < 4 ? 3 - st : 39 - st) : st; CI[o0 + (size_t)s * 512] = x; x = av[q] * x + hv[q]; }
        }
    }
}
DI void phase_lru_pass2(const Frame& F) {
    for (int it = F.bx; it < NB * 32; it += F.G) lru_tile<true>(F, it >> 5, 4 + (it & 31));
}

constexpr int HS = 144, SCS = 40;
constexpr int H_Q = 0, H_LF = H_Q + 32 * HS * 2, H_V = H_LF + 32 * HS * 2, H_QT = H_V + 32 * HS * 2, H_KT = H_QT + 32 * HS * 2, H_KH = H_KT + 32 * HS * 2,
              H_SC = H_KH + 32 * HS * 2, H_DEC = H_SC + 32 * SCS * 2, H_SET = H_DEC + 512;
static_assert(2 * H_SET <= RING_BYTES, "hgrn lds");
typedef short s16x4 __attribute__((ext_vector_type(4)));
DI bf16x8 tr_frag(const LAS bf16* tile, int c0, int lane) {
    const int g = lane >> 4, q = (lane & 15) >> 2, p = lane & 3;
    const LAS bf16* a = tile + (8 * g + q) * HS + c0 + 4 * p;
    const s16x4 lo = __builtin_amdgcn_ds_read_tr16_b64_v4i16((LAS s16x4*)a), hi = __builtin_amdgcn_ds_read_tr16_b64_v4i16((LAS s16x4*)(a + 4 * HS));
    bf16x8 r; r[0] = lo[0]; r[1] = lo[1]; r[2] = lo[2]; r[3] = lo[3]; r[4] = hi[0]; r[5] = hi[1]; r[6] = hi[2]; r[7] = hi[3]; return r;
}
DI void hgrn_chain(const Frame& F, int item) {
    const int b = item >> 3, h = (item >> 1) & 3, dir = item & 1;
    const bf16* P = (const bf16*)(F.ws + WS_P);
    bf16* O = (bf16*)(F.ws + (dir ? WS_OB : WS_OF));
    const int w = F.wave, lane = F.lane, fr = lane & 15, g = lane >> 4;
    const int li = F.tid >> 4, lp = F.tid & 15;
    f32x4 S[8];
#pragma unroll
    for (int t = 0; t < 8; ++t) S[t] = (f32x4){0.f, 0.f, 0.f, 0.f};
    auto prow = [&](int c, int i) -> size_t {
        const int ii = dir ? 31 - i : i;
        if (c < 8) { const int cc = dir ? 7 - c : c; return (size_t)NTOK + b * CTXL + 32 * cc + ii; }
        const int col = dir ? 63 - (c - 8) : (c - 8); return (size_t)b * SEQ + ii * 64 + col; };
    const size_t coff = 128 * h + 8 * lp;
    v4u rqA, rlA, rvA, rqB, rlB, rvB;
    { const bf16* rp = P + prow(0, li) * INC + coff; rqA = *(const v4u*)(rp + 1024); rvA = *(const v4u*)(rp + 1536); rlA = *(const v4u*)(rp + 2048 + 512 * dir); }
    { const bf16* rp = P + prow(1, li) * INC + coff; rqB = *(const v4u*)(rp + 1024); rvB = *(const v4u*)(rp + 1536); rlB = *(const v4u*)(rp + 2048 + 512 * dir); }
    bf16x8 Tri[2];
#pragma unroll
    for (int it = 0; it < 2; ++it)
#pragma unroll
        for (int jj = 0; jj < 8; ++jj) Tri[it][jj] = (8 * g + jj <= 16 * it + fr) ? (short)0x3F80 : (short)0;
#define HG_BODY(c, RQ, RL, RV, SET) do { \
        LAS unsigned char* base = F.lds + (SET) * H_SET; \
        LAS bf16* Qr = (LAS bf16*)(base + H_Q); LAS bf16* LFr = (LAS bf16*)(base + H_LF); LAS bf16* Vr = (LAS bf16*)(base + H_V); \
        LAS bf16* QT = (LAS bf16*)(base + H_QT); LAS bf16* KT = (LAS bf16*)(base + H_KT); LAS bf16* KH = (LAS bf16*)(base + H_KH); \
        LAS bf16* SC = (LAS bf16*)(base + H_SC); LAS float* DEC = (LAS float*)(base + H_DEC); \
        const bool isctx = (c) < 8; \
        *(LAS v4u*)(Qr + li * HS + 8 * lp) = RQ; *(LAS v4u*)(LFr + li * HS + 8 * lp) = RL; *(LAS v4u*)(Vr + li * HS + 8 * lp) = RV; \
        if ((c) + 2 < 72) { const bf16* rp = P + prow((c) + 2, li) * INC + coff; RQ = *(const v4u*)(rp + 1024); RV = *(const v4u*)(rp + 1536); RL = *(const v4u*)(rp + 2048 + 512 * dir); } \
        __syncthreads(); \
        {   \
            const bf16x8 Al = tr_frag(LFr, 16 * w, lane); \
            f32x4 Gm[2]; \
            _Pragma("unroll") for (int it = 0; it < 2; ++it) Gm[it] = __builtin_amdgcn_mfma_f32_16x16x32_bf16(Al, Tri[it], (f32x4){0.f, 0.f, 0.f, 0.f}, 0, 0, 0); \
            f32x4 dec; \
            _Pragma("unroll") for (int r = 0; r < 4; ++r) dec[r] = expf_(__shfl(Gm[1][r], (lane & 48) | 15)); \
            if (fr == 0) *(LAS f32x4*)(DEC + 16 * w + 4 * g) = dec; \
            _Pragma("unroll") for (int it = 0; it < 2; ++it) { const int i = 16 * it + fr, d0 = 16 * w + 4 * g; \
                const v2u q4 = *(const LAS v2u*)(Qr + i * HS + d0), l4 = *(const LAS v2u*)(LFr + i * HS + d0); \
                const float qv[4] = {bflo(q4.x), bfhi(q4.x), bflo(q4.y), bfhi(q4.y)}, lv[4] = {bflo(l4.x), bfhi(l4.x), bflo(l4.y), bfhi(l4.y)}; \
                float qt[4], kt[4], kh[4]; \
                _Pragma("unroll") for (int r = 0; r < 4; ++r) { const float eg = expf_(Gm[it][r]), ieg = rcpf_(eg), kk = 1.0f - expf_(lv[r]); qt[r] = qv[r] * eg; kt[r] = kk * ieg; kh[r] = kk * dec[r] * ieg; } \
                *(LAS v2u*)(QT + i * HS + d0) = (v2u){pk2(qt[0], qt[1]), pk2(qt[2], qt[3])}; \
                *(LAS v2u*)(KT + i * HS + d0) = (v2u){pk2(kt[0], kt[1]), pk2(kt[2], kt[3])}; \
                *(LAS v2u*)(KH + i * HS + d0) = (v2u){pk2(kh[0], kh[1]), pk2(kh[2], kh[3])}; } \
        } \
        __syncthreads(); \
        f32x4 oacc[2]; oacc[0] = (f32x4){0.f, 0.f, 0.f, 0.f}; oacc[1] = (f32x4){0.f, 0.f, 0.f, 0.f}; \
        if (!isctx) { \
            if (w < 4) {   \
                const int it = w >> 1, jt = w & 1; f32x4 sc = {0.f, 0.f, 0.f, 0.f}; \
                _Pragma("unroll") for (int ks = 0; ks < 4; ++ks) { const bf16x8 ak = *(const LAS bf16x8*)(KT + (16 * jt + fr) * HS + 32 * ks + 8 * g), bq = *(const LAS bf16x8*)(QT + (16 * it + fr) * HS + 32 * ks + 8 * g); \
                    sc = __builtin_amdgcn_mfma_f32_16x16x32_bf16(ak, bq, sc, 0, 0, 0); } \
                const int i = 16 * it + fr, j0 = 16 * jt + 4 * g; \
                *(LAS v2u*)(SC + i * SCS + j0) = (v2u){pk2(j0 <= i ? sc[0] : 0.f, j0 + 1 <= i ? sc[1] : 0.f), pk2(j0 + 2 <= i ? sc[2] : 0.f, j0 + 3 <= i ? sc[3] : 0.f)}; } \
              \
            _Pragma("unroll") for (int ks = 0; ks < 4; ++ks) { \
                v4u sb; sb.x = pk2(S[2 * ks][0], S[2 * ks][1]); sb.y = pk2(S[2 * ks][2], S[2 * ks][3]); sb.z = pk2(S[2 * ks + 1][0], S[2 * ks + 1][1]); sb.w = pk2(S[2 * ks + 1][2], S[2 * ks + 1][3]); \
                const bf16x8 As = __builtin_bit_cast(bf16x8, sb); \
                _Pragma("unroll") for (int it = 0; it < 2; ++it) { const v2u a0 = *(const LAS v2u*)(QT + (16 * it + fr) * HS + 32 * ks + 4 * g), a1 = *(const LAS v2u*)(QT + (16 * it + fr) * HS + 32 * ks + 16 + 4 * g); \
                    v4u bv; bv.x = a0.x; bv.y = a0.y; bv.z = a1.x; bv.w = a1.y; \
                    oacc[it] = __builtin_amdgcn_mfma_f32_16x16x32_bf16(As, __builtin_bit_cast(bf16x8, bv), oacc[it], 0, 0, 0); } } \
        } \
          \
        const bf16x8 Vf = tr_frag(Vr, 16 * w, lane); \
        _Pragma("unroll") for (int t = 0; t < 8; ++t) { const f32x4 dv = *(const LAS f32x4*)(DEC + 16 * t + 4 * g); \
            const bf16x8 Kf = tr_frag(KH, 16 * t, lane); \
            S[t] = __builtin_amdgcn_mfma_f32_16x16x32_bf16(Kf, Vf, S[t] * dv, 0, 0, 0); } \
        if (!isctx) { \
            __syncthreads(); \
            const int col = dir ? 63 - ((c) - 8) : ((c) - 8); \
            _Pragma("unroll") for (int it = 0; it < 2; ++it) { const bf16x8 bs = *(const LAS bf16x8*)(SC + (16 * it + fr) * SCS + 8 * g); \
                oacc[it] = __builtin_amdgcn_mfma_f32_16x16x32_bf16(Vf, bs, oacc[it], 0, 0, 0); \
                const int i = 16 * it + fr, ii = dir ? 31 - i : i; \
                *(v2u*)(O + ((size_t)b * SEQ + ii * 64 + col) * 512 + 128 * h + 16 * w + 4 * g) = (v2u){pk2(oacc[it][0], oacc[it][1]), pk2(oacc[it][2], oacc[it][3])}; } \
        } \
    } while (0)
#pragma unroll 1
    for (int c = 0; c < 72; c += 2) {
        HG_BODY(c, rqA, rlA, rvA, 0);
        HG_BODY(c + 1, rqB, rlB, rvB, 1);
    }
#undef HG_BODY
    __syncthreads();
}
DI void phase_hgrn(const Frame& F) {
    for (int it = F.bx; it < NB * 4 * 2; it += F.G) hgrn_chain(F, it);
}
DI void phase_y2(const Frame& F) {
    const bf16* OFp = (const bf16*)(F.ws + WS_OF); const bf16* OBp = (const bf16*)(F.ws + WS_OB); const bf16* P = (const bf16*)(F.ws + WS_P); bf16* YL = (bf16*)(F.ws + WS_YL);
    const int gw = F.bx * NWAVES + F.wave, NGW = F.G * NWAVES;
    const int c = 8 * F.lane;
    const f32x4 g0 = *(const f32x4*)(F.in[I_HNORM] + c), g1 = *(const f32x4*)(F.in[I_HNORM] + c + 4);
    const float gn[8] = {g0.x, g0.y, g0.z, g0.w, g1.x, g1.y, g1.z, g1.w};
    for (int m = gw; m < NTOK; m += NGW) {
        const v4u a = *(const v4u*)(OFp + (size_t)m * 512 + c), bq = *(const v4u*)(OBp + (size_t)m * 512 + c), sg = *(const v4u*)(P + (size_t)m * INC + 3072 + c);
        float o[8] = {bflo(a.x) + bflo(bq.x), bfhi(a.x) + bfhi(bq.x), bflo(a.y) + bflo(bq.y), bfhi(a.y) + bfhi(bq.y), bflo(a.z) + bflo(bq.z), bfhi(a.z) + bfhi(bq.z), bflo(a.w) + bflo(bq.w), bfhi(a.w) + bfhi(bq.w)};
        const float sgv[8] = {bflo(sg.x), bfhi(sg.x), bflo(sg.y), bfhi(sg.y), bflo(sg.z), bfhi(sg.z), bflo(sg.w), bfhi(sg.w)};
        float ss = 0.f;
#pragma unroll
        for (int j = 0; j < 8; ++j) ss += o[j] * o[j];
        ss += __shfl_xor(ss, 1); ss += __shfl_xor(ss, 2); ss += __shfl_xor(ss, 4); ss += __shfl_xor(ss, 8);
        const float rs = rsqrtf(ss * (1.0f / 128.0f) + EPS);
#pragma unroll
        for (int j = 0; j < 8; ++j) o[j] = o[j] * rs * gn[j] * sgv[j];
        v4u wv; wv.x = pk2(o[0], o[1]); wv.y = pk2(o[2], o[3]); wv.z = pk2(o[4], o[5]); wv.w = pk2(o[6], o[7]);
        *(v4u*)(YL + (size_t)m * D + 512 + c) = wv;
    }
}

DI unsigned fkey(float f) { const unsigned u = __float_as_uint(f); return u ^ ((u >> 31) ? 0xFFFFFFFFu : 0x80000000u); }
template <int CTRL> DI unsigned dpp_u(unsigned v) { return (unsigned)__builtin_amdgcn_update_dpp(0, (int)v, CTRL, 0xf, 0xf, true); }
template <int CTRL> DI float dpp_f(float v) { return __uint_as_float(dpp_u<CTRL>(__float_as_uint(v))); }
DI unsigned umax_(unsigned a, unsigned b) { return a > b ? a : b; }
DI float readlane_f(float v, int lane) { return __uint_as_float((unsigned)__builtin_amdgcn_readlane((int)__float_as_uint(v), lane)); }
DI void phase_route(const Frame& F) {
    const float* LOGIT = (const float*)(F.ws + WS_LOGIT); const float* rb = F.in[I_RB];
    v2u* ROUTE = (v2u*)(F.ws + WS_ROUTE); int* HIST = (int*)(F.ws + WS_HIST);
    LAS unsigned* hist = (LAS unsigned*)F.lds;
    const int l = F.lane;
    const f32x4 rbv = *(const f32x4*)(rb + 4 * l);
    const float NEG = -__builtin_inff();
    for (int blk = F.bx; blk < NTOK / 128; blk += F.G) {
        if (F.tid < 256) hist[F.tid] = 0u;
        __syncthreads();
        const int tok0 = blk * 128 + F.wave * 16;
        f32x4 lg = *(const f32x4*)(LOGIT + (size_t)tok0 * NE + 4 * l);
#pragma unroll 1
        for (int ti = 0; ti < 16; ++ti) {
            const int tok = tok0 + ti;
            f32x4 lgn = {0.f, 0.f, 0.f, 0.f};
            if (ti + 1 < 16) lgn = *(const f32x4*)(LOGIT + (size_t)(tok + 1) * NE + 4 * l);
            float sc[4], bs[4];
#pragma unroll
            for (int k = 0; k < 4; ++k) { sc[k] = rcpf_(1.0f + expf_(-lg[k])); bs[k] = sc[k] + rbv[k]; }
            float m1 = NEG, m2 = NEG;
#pragma unroll
            for (int k = 0; k < 4; ++k) { const float v = bs[k]; if (v > m1) { m2 = m1; m1 = v; } else if (v > m2) m2 = v; }
            { float o1 = dpp_f<0xB1>(m1), o2 = dpp_f<0xB1>(m2); float n1 = fmaxf(m1, o1), n2 = fmaxf(fminf(m1, o1), fmaxf(m2, o2)); m1 = n1; m2 = n2;
              o1 = dpp_f<0x4E>(m1); o2 = dpp_f<0x4E>(m2); n1 = fmaxf(m1, o1); n2 = fmaxf(fminf(m1, o1), fmaxf(m2, o2)); m1 = n1; m2 = n2;
              const float a1 = dpp_f<0x104>(m1), a2 = dpp_f<0x104>(m2), c1 = dpp_f<0x114>(m1), c2 = dpp_f<0x114>(m2);
              o1 = (l & 4) ? c1 : a1; o2 = (l & 4) ? c2 : a2; n1 = fmaxf(m1, o1); n2 = fmaxf(fminf(m1, o1), fmaxf(m2, o2)); m1 = n1; m2 = n2; }
            const float gs = m1 + m2; const int g = l >> 3; int rank = 0;
#pragma unroll
            for (int gg = 0; gg < 8; ++gg) { const float og = readlane_f(gs, gg * 8); rank += (og > gs || (og == gs && gg < g)) ? 1 : 0; }
            const bool sel = rank < 4;
            unsigned cv[4];
#pragma unroll
            for (int k = 0; k < 4; ++k) cv[k] = sel ? fkey(bs[k]) : 0u;
            float sum = 0.f, mysc = 0.f; int myexp = 0;
#pragma unroll
            for (int r = 0; r < TOPK; ++r) {
                unsigned bvk = cv[0]; int bk = 0;
#pragma unroll
                for (int k = 1; k < 4; ++k) if (cv[k] > bvk) { bvk = cv[k]; bk = k; }
                const float bsc = bk == 0 ? sc[0] : bk == 1 ? sc[1] : bk == 2 ? sc[2] : sc[3];
                unsigned m = bvk;
                m = umax_(m, dpp_u<0xB1>(m)); m = umax_(m, dpp_u<0x4E>(m)); m = umax_(m, dpp_u<0x124>(m)); m = umax_(m, dpp_u<0x128>(m));
                const unsigned M = umax_(umax_((unsigned)__builtin_amdgcn_readlane((int)m, 0), (unsigned)__builtin_amdgcn_readlane((int)m, 16)),
                                         umax_((unsigned)__builtin_amdgcn_readlane((int)m, 32), (unsigned)__builtin_amdgcn_readlane((int)m, 48)));
                const unsigned long long bal = __ballot(bvk == M);
                const int L = __builtin_ctzll(bal);
                const int kL = __builtin_amdgcn_readlane(bk, L);
                const float se = readlane_f(bsc, L);
                const int e = 4 * L + kL;
                if (l == L) {
#pragma unroll
                    for (int k = 0; k < 4; ++k) if (k == bk) cv[k] = 0u; }
                sum += se; if (l == r) { myexp = e; mysc = se; }
            }
            if (l < TOPK) { ROUTE[(size_t)tok * TOPK + l] = (v2u){(unsigned)myexp, __float_as_uint(mysc * rcpf_(sum) * 2.5f)}; (void)__hip_atomic_fetch_add(hist + myexp, 1u, __ATOMIC_RELAXED, __HIP_MEMORY_SCOPE_WORKGROUP); }
            lg = lgn;
        }
        __syncthreads();
        if (F.tid < 256) HIST[blk * 256 + F.tid] = (int)hist[F.tid];
        __syncthreads();
    }
}
DI void phase_lists(const Frame& F) {
    const v2u* ROUTE = (const v2u*)(F.ws + WS_ROUTE); const int* HIST = (const int*)(F.ws + WS_HIST);
    unsigned* cnt = (unsigned*)(F.ws + WS_CTL) + CW_CNT; v2u* LIST = (v2u*)(F.ws + WS_LIST);
    LAS int* part = (LAS int*)F.lds;
    LAS int* lbase = part + 1024; LAS unsigned* lcnt = (LAS unsigned*)(lbase + 256); LAS int* ltot = lbase + 512; LAS int* lts = lbase + 768;
    int* INV = (int*)(F.ws + WS_INV);
    for (int blk = F.bx; blk < NTOK / 128; blk += F.G) {
        const int e = F.tid & 255, hf = F.tid >> 8;
        int below = 0, all = 0;
#pragma unroll 8
        for (int q = 0; q < 128; ++q) { const int row = hf * 128 + q; const int v = HIST[row * 256 + e]; all += v; below += (row < blk) ? v : 0; }
        part[hf * 512 + e] = below; part[hf * 512 + 256 + e] = all;
        __syncthreads();
        if (F.tid < 256) { lbase[e] = part[e] + part[512 + e]; lcnt[e] = 0u; const int tot = part[256 + e] + part[768 + e]; ltot[e] = tot; if (blk == 0) cnt[e] = (unsigned)tot; }
        __syncthreads();
        if (F.tid == 0) { int s2 = 0; for (int q = 0; q < 256; ++q) { lts[q] = s2; s2 += (ltot[q] + 255) >> 8; } }
        __syncthreads();
#pragma unroll
        for (int q = 0; q < 2; ++q) { const int a = F.tid + q * NTHR; const unsigned tk = (unsigned)(blk * 128 * TOPK + a);
            const v2u rt = ROUTE[tk]; const unsigned pos = (unsigned)lbase[rt.x] + __hip_atomic_fetch_add(lcnt + rt.x, 1u, __ATOMIC_RELAXED, __HIP_MEMORY_SCOPE_WORKGROUP);
            LIST[(size_t)rt.x * LISTCAP + pos] = (v2u){tk, rt.y}; INV[tk] = lts[rt.x] * 256 + (int)pos; }
        __syncthreads();
    }
}

template <bool GATHER> DI void moe_setup(const Frame& F, int ncol, int& total) {
    LAS int* ts = (LAS int*)(F.lds + LDS_TS); LAS int* cl = (LAS int*)(F.lds + LDS_CNT); LAS int* idx = (LAS int*)(F.lds + LDS_IDX);
    const unsigned* cnt = (const unsigned*)(F.ws + WS_CTL) + CW_CNT;
    if (F.tid < 256) cl[F.tid] = (int)__hip_atomic_load(cnt + F.tid, __ATOMIC_RELAXED, __HIP_MEMORY_SCOPE_AGENT);
    __syncthreads();
    if (F.tid == 0) { int s = 0; for (int e = 0; e < 256; ++e) { ts[e] = s; s += (cl[e] + 255) >> 8; } ts[256] = s; }
    __syncthreads();
    const int Te = ts[256]; total = (Te + NTOK / 256) * ncol;
    if (GATHER) {
        const v2u* LIST = (const v2u*)(F.ws + WS_LIST);
        for (int ord = 0; ord < 12; ++ord) { const int L = ord * F.G + F.vcu; if (L >= total) break;
            const int rt = L / ncol;
            if (F.tid < 256) { int v;
                if (rt >= Te) v = (rt - Te) * 256 + F.tid;
                else { int lo = 0, hi = 256; while (hi - lo > 1) { const int mid = (lo + hi) >> 1; if (ts[mid] <= rt) lo = mid; else hi = mid; }
                    const int r = (rt - ts[lo]) * 256 + F.tid; v = (r < cl[lo]) ? (int)(LIST[(size_t)lo * LISTCAP + r].x >> 3) : 0; }
                idx[ord * 256 + F.tid] = v; } }
    }
    __syncthreads();
}

DI void phase_combine(const Frame& F, int mode) {
    const float* MOD = (const float*)(F.ws + WS_MOD);
    const bf16* YE = (const bf16*)(F.ws + WS_YE); const int* INV = (const int*)(F.ws + WS_INV);
    int Te = 0; if (mode == 0) { const unsigned* cnt = (const unsigned*)(F.ws + WS_CTL) + CW_CNT; int t4 = 0;
#pragma unroll
        for (int q = 0; q < 4; ++q) t4 += (int)((cnt[F.lane + 64 * q] + 255u) >> 8);
#pragma unroll
        for (int o = 1; o < 64; o <<= 1) t4 += __shfl_xor(t4, o);
        Te = __builtin_amdgcn_readfirstlane(t4); }
    const int gw = F.bx * NWAVES + F.wave, NGW = F.G * NWAVES;
    const float* nf = F.in[I_NFIN];
    for (int m = gw; m < NTOK; m += NGW) {
        const int b = m >> 11;
        float x2[16]; float ss = 0.f;
#pragma unroll
        for (int j = 0; j < 2; ++j) { const int c = 8 * F.lane + 512 * j;
            float s[8];
#pragma unroll
            for (int q = 0; q < 8; ++q) s[q] = 0.f;
            const float* xsrc = mode == 2 ? F.in[I_X] : (const float*)(F.ws + WS_X1);
            if (mode == 0) {
#pragma unroll
                for (int k = 0; k < 9; ++k) { const int row = (k < 8) ? INV[m * TOPK + k] : Te * 256 + m; const v4u w = *(const v4u*)(YE + (size_t)row * D + c);
                    s[0] += bflo(w.x); s[1] += bfhi(w.x); s[2] += bflo(w.y); s[3] += bfhi(w.y); s[4] += bflo(w.z); s[5] += bfhi(w.z); s[6] += bflo(w.w); s[7] += bfhi(w.w); } }
            const f32x4 xa = *(const f32x4*)(xsrc + (size_t)m * D + c), xb = *(const f32x4*)(xsrc + (size_t)m * D + c + 4);
            const f32x4 ga = *(const f32x4*)(MOD + b * 6144 + 5120 + c), gb = *(const f32x4*)(MOD + b * 6144 + 5120 + c + 4);
            const float xv[8] = {xa.x, xa.y, xa.z, xa.w, xb.x, xb.y, xb.z, xb.w}, gv[8] = {ga.x, ga.y, ga.z, ga.w, gb.x, gb.y, gb.z, gb.w};
#pragma unroll
            for (int q = 0; q < 8; ++q) { const float v = xv[q] + gv[q] * s[q]; x2[8 * j + q] = v; ss += v * v; } }
        const float rs = rsqrtf(wave_sum(ss) * (1.0f / D) + EPS);
#pragma unroll
        for (int j = 0; j < 2; ++j) { const int c = 8 * F.lane + 512 * j;
            const f32x4 na = *(const f32x4*)(nf + c), nb = *(const f32x4*)(nf + c + 4);
            f32x4 oa = {x2[8 * j] * rs * na.x, x2[8 * j + 1] * rs * na.y, x2[8 * j + 2] * rs * na.z, x2[8 * j + 3] * rs * na.w};
            f32x4 ob = {x2[8 * j + 4] * rs * nb.x, x2[8 * j + 5] * rs * nb.y, x2[8 * j + 6] * rs * nb.z, x2[8 * j + 7] * rs * nb.w};
            *(f32x4*)(F.out + (size_t)m * D + c) = oa; *(f32x4*)(F.out + (size_t)m * D + c + 4) = ob; }
    }
}

constexpr int NPHASE = 14;
__global__ void __launch_bounds__(NTHR, 2) fwd_kernel(Args args) {
    extern __shared__ __attribute__((aligned(16))) unsigned char lds_raw[];
    Frame F;
    F.lds = (LAS unsigned char*)lds_raw;
    F.tid = threadIdx.x; F.lane = F.tid & 63; F.wave = __builtin_amdgcn_readfirstlane(F.tid >> 6);
    F.G = gridDim.x; F.bx = blockIdx.x; F.vcu = (F.G % 8 == 0) ? (F.bx % 8) * (F.G / 8) + F.bx / 8 : F.bx;
    F.in = args.in; F.out = args.out; F.ws = args.ws;
    volatile LAS unsigned* MISC = (volatile LAS unsigned*)(F.lds + LDS_MISC);
    if (F.tid < 16) MISC[F.tid] = 0u;
    __syncthreads();
    XcdBarrier bar; bar.bar = (unsigned*)(F.ws + WS_CTL) + CW_BAR; bar.x = 0; bar.st = nullptr;
#if !PER_PHASE_LAUNCH
    bar = xcd_barrier_post((unsigned*)(F.ws + WS_CTL) + CW_BAR, MISC + 8);
#define GRID_BAR() xcd_barrier(bar)
#else
#define GRID_BAR() do {} while (0)
#endif
    const int lo = args.ph_lo, hi = args.ph_hi;
#ifndef PH_MASK
#define PH_MASK 0xFFFF
#endif
#define IN(k) (((PH_MASK >> (k)) & 1) && lo <= (k) && (k) < hi)
#ifndef PROBE_PH
#define PROBE_PH -1
#endif
#ifndef PROBE_MULT
#define PROBE_MULT 4
#endif
    unsigned long long pr_t0 = 0ull, pr_t1 = 0ull;
    if (PROBE_PH == 0) pr_t0 = __builtin_amdgcn_s_memrealtime();
#define SEAM(k) do { if (IN(k) && IN((k) + 1)) GRID_BAR(); \
        if (PROBE_PH >= 0) { if ((k) == PROBE_PH - 1) pr_t0 = __builtin_amdgcn_s_memrealtime(); if ((k) == PROBE_PH) pr_t1 = __builtin_amdgcn_s_memrealtime(); } } while (0)
#ifndef REPEAT_MASK
#define REPEAT_MASK 0
#endif
#define REPS(k) (1 + ((REPEAT_MASK >> (k)) & 1))
    unsigned char* ws = F.ws;

    if (IN(0)) _Pragma("unroll 1") for (int rep = 0; rep < REPS(0); ++rep) { if (rep) GRID_BAR(); phase_prologue(F); } SEAM(0);
    if (IN(1)) _Pragma("unroll 1") for (int rep = 0; rep < REPS(1); ++rep) { if (rep) GRID_BAR(); phase_norm_rows(F, 0); } SEAM(1);
    if (IN(2)) _Pragma("unroll 1") for (int rep = 0; rep < REPS(2); ++rep) { if (rep) GRID_BAR();
        pg8::DenseOrder S; S.init(ws + WS_HX, ws + WS_WIN, MTOT, INC, D, F.G, F.bx);
        pg8::EpiInProj E{(bf16*)(ws + WS_P), (const float*)(ws + WS_TAB)};
        pg8::gemm_phase(F.lds, D, S, E);
    } SEAM(2);
    if (IN(3)) _Pragma("unroll 1") for (int rep = 0; rep < REPS(3); ++rep) { if (rep) GRID_BAR(); phase_lru_pass1(F); } SEAM(3);
    if (IN(4)) _Pragma("unroll 1") for (int rep = 0; rep < REPS(4); ++rep) { if (rep) GRID_BAR(); phase_lru_carry(F);
        if (F.G >= 256) { if (F.bx < 128) hgrn_chain(F, F.bx); else convert_experts(F, (F.bx - 128) * NWAVES + F.wave, (F.G - 128) * NWAVES); }
        else { phase_hgrn(F); convert_experts(F, F.bx * NWAVES + F.wave, F.G * NWAVES); } } SEAM(4);
    if (IN(5)) _Pragma("unroll 1") for (int rep = 0; rep < REPS(5); ++rep) { if (rep) GRID_BAR(); phase_lru_pass2(F); phase_y2(F); } SEAM(5);
    if (IN(6)) _Pragma("unroll 1") for (int rep = 0; rep < REPS(6); ++rep) { if (rep) GRID_BAR();
        pg8::DenseOrder S; S.init(ws + WS_YL, ws + WS_WOUT, NTOK, D, D, F.G, F.bx);
        pg8::EpiResid E{F.in[I_X], (const float*)(ws + WS_MOD), (float*)(ws + WS_X1)};
        pg8::gemm_phase(F.lds, D, S, E);
    } SEAM(6);
#if DBG_STOP == 1
    if (IN(7)) _Pragma("unroll 1") for (int rep = 0; rep < REPS(7); ++rep) { if (rep) GRID_BAR(); phase_combine(F, 1); }
#else
    if (IN(7)) _Pragma("unroll 1") for (int rep = 0; rep < REPS(7); ++rep) { if (rep) GRID_BAR(); phase_norm_rows(F, 1); } SEAM(7);
    if (IN(8)) _Pragma("unroll 1") for (int rep = 0; rep < REPS(8); ++rep) { if (rep) GRID_BAR();
        pg8::DenseOrder S; S.init(ws + WS_HX2, ws + WS_WR, NTOK, NE, D, F.G, F.bx);
        pg8::EpiF32 E{(float*)(ws + WS_LOGIT), NE};
        pg8::gemm_phase(F.lds, D, S, E);
    } SEAM(8);
    if (IN(9)) _Pragma("unroll 1") for (int rep = 0; rep < REPS(9); ++rep) { if (rep) GRID_BAR(); phase_route(F); } SEAM(9);
    if (IN(10)) _Pragma("unroll 1") for (int rep = 0; rep < REPS(10); ++rep) { if (rep) GRID_BAR(); phase_lists(F); } SEAM(10);
    if (IN(11)) _Pragma("unroll 1") for (int rep = 0; rep < REPS(11); ++rep) { if (rep) GRID_BAR();
        int total; moe_setup<true>(F, 2, total);
        pg8::MoeOrder<true> S; S.A = (const char*)(ws + WS_HX2F); S.Bt = (const char*)(ws + WS_EW13); S.BtS = (const char*)(ws + WS_SW13); S.K = D / 2; S.ncol = 2; S.estride = (size_t)512 * 1024;
        S.ts = (const LAS int*)(F.lds + LDS_TS); S.cnt = (const LAS int*)(F.lds + LDS_CNT); S.idx = (const LAS int*)(F.lds + LDS_IDX); S.G = F.G; S.vcu = F.vcu; S.total = total;
        pg8::EpiSwiGLU8 E{ws + WS_ACT};
        pg8::gemm_phase<pg8::EpiSwiGLU8, pg8::MoeOrder<true>, false, true>(F.lds, D / 2, S, E);
    } SEAM(11);
    if (IN(12)) _Pragma("unroll 1") for (int rep = 0; rep < REPS(12); ++rep) { if (rep) GRID_BAR();
        int total; moe_setup<false>(F, 4, total);
        pg8::MoeOrder<false> S; S.A = (const char*)(ws + WS_ACT); S.Bt = (const char*)(ws + WS_EW2); S.BtS = (const char*)(ws + WS_SW2); S.K = DE / 2; S.ncol = 4; S.estride = (size_t)1024 * 256;
        S.ts = (const LAS int*)(F.lds + LDS_TS); S.cnt = (const LAS int*)(F.lds + LDS_CNT); S.idx = (const LAS int*)(F.lds + LDS_IDX); S.G = F.G; S.vcu = F.vcu; S.total = total;
        pg8::EpiScatter E{(bf16*)(ws + WS_YE), (const v2u*)(ws + WS_LIST), 1.0f / 128.0f};
#if defined(PROBE_GEMM)
        pg8::GProf gp{0ull, 0ull, 0ull};
        pg8::gemm_phase<pg8::EpiScatter, pg8::MoeOrder<false>, true, true>(F.lds, DE / 2, S, E, &gp);
        pr_t0 = 0ull; pr_t1 = (PROBE_GEMM == 0) ? gp.t_loop : (PROBE_GEMM == 1) ? gp.t_epi : gp.t_next;
#else
        pg8::gemm_phase<pg8::EpiScatter, pg8::MoeOrder<false>, false, true>(F.lds, DE / 2, S, E);
#endif
    } SEAM(12);
    if (IN(13)) _Pragma("unroll 1") for (int rep = 0; rep < REPS(13); ++rep) { if (rep) GRID_BAR(); phase_combine(F, 0); }
#endif
#if defined(PROBE_GEMM)
    if (F.bx == 0 && F.tid == 0) {
#else
    if (PROBE_PH >= 0 && F.bx == 0 && F.tid == 0) {
#endif
        const unsigned long long te = __builtin_amdgcn_s_memrealtime(); if (PROBE_PH == NPHASE - 1) pr_t1 = te;
        const unsigned long long target = (unsigned long long)PROBE_MULT * (pr_t1 - pr_t0);
        while (__builtin_amdgcn_s_memrealtime() - te < target) __builtin_amdgcn_s_sleep(20);
    }
}

extern "C" void kernel_launch(void* const* d_in, const int* in_sizes, int n_in, void* d_out, int out_size, void* d_ws, size_t ws_size, hipStream_t stream) {
    static int grid = 0;
    if (grid == 0) {
        if (n_in != 26 || in_sizes[0] != NTOK * D || out_size != NTOK * D || ws_size < WS_END) { fprintf(stderr, "kernel_launch: unexpected shapes (n_in %d, ws %zu)\n", n_in, ws_size); grid = -1; return; }
        int dev = 0, cus = 0, per_cu = 0;
        if (hipGetDevice(&dev) != hipSuccess || hipDeviceGetAttribute(&cus, hipDeviceAttributeMultiprocessorCount, dev) != hipSuccess) { grid = -1; return; }
        if (hipFuncSetAttribute((const void*)fwd_kernel, hipFuncAttributeMaxDynamicSharedMemorySize, LDS_BYTES) != hipSuccess) { fprintf(stderr, "kernel_launch: hipFuncSetAttribute failed\n"); grid = -1; return; }
        if (hipOccupancyMaxActiveBlocksPerMultiprocessor(&per_cu, (const void*)fwd_kernel, NTHR, LDS_BYTES) != hipSuccess || per_cu < 1) { fprintf(stderr, "kernel_launch: occupancy query says %d\n", per_cu); }
        (void)hipGetLastError();
        grid = cus;
    }
    if (grid < 0) return;
    hipMemsetAsync((char*)d_ws + WS_CTL, 0, CTL_ZERO_BYTES, stream);
    Args a{};
    for (int i = 0; i < 26; ++i) a.in[i] = (const float*)d_in[i];
    a.out = (float*)d_out; a.ws = (unsigned char*)d_ws;
#if PER_PHASE_LAUNCH
    for (int p = 0; p < NPHASE; ++p) { a.ph_lo = p; a.ph_hi = p + 1; hipLaunchKernelGGL(fwd_kernel, dim3(grid), dim3(NTHR), LDS_BYTES, stream, a); }
#else
    a.ph_lo = 0; a.ph_hi = NPHASE;
    hipLaunchKernelGGL(fwd_kernel, dim3(grid), dim3(NTHR), LDS_BYTES, stream, a);
#endif
}
```

```cpp
#include <hip/hip_runtime.h>
#include <cstdio>
#include <cstdint>

#ifndef PER_PHASE_LAUNCH
#define PER_PHASE_LAUNCH 0
#endif
#ifndef DBG_STOP
#define DBG_STOP 0
#endif

#define GAS __attribute__((address_space(1)))
#define LAS __attribute__((address_space(3)))
#define DI __device__ __forceinline__
typedef unsigned short bf16;
typedef unsigned v4u __attribute__((ext_vector_type(4)));
typedef unsigned v2u __attribute__((ext_vector_type(2)));
typedef float f32x4 __attribute__((ext_vector_type(4)));
typedef float f32x2 __attribute__((ext_vector_type(2)));
typedef short bf16x8 __attribute__((ext_vector_type(8)));
typedef __bf16 bfv2 __attribute__((ext_vector_type(2)));

constexpr int D = 1024, NB = 16, SEQ = 2048, CTXL = 256;
constexpr int NTOK = NB * SEQ;
constexpr int NCTX = NB * CTXL;
constexpr int MTOT = NTOK + NCTX;
constexpr int INC = 3584;
constexpr int NE = 256, TOPK = 8, DE = 256;
constexpr int LISTCAP = 32768;
constexpr float EPS = 1e-6f;
constexpr int NWAVES = 8, NTHR = 512;
constexpr int NSEQT = 36;

constexpr size_t MiB = 1u << 20;
constexpr size_t WS_CTL = 0, CTL_ZERO_BYTES = 1 * MiB;
constexpr size_t WS_MOD = 1 * MiB;
constexpr size_t WS_TAB = 2 * MiB;
constexpr size_t WS_WGT = 2 * MiB + 65536;
constexpr size_t WS_WIN = 3 * MiB;
constexpr size_t WS_WOUT = 10 * MiB;
constexpr size_t WS_WR = 12 * MiB;
constexpr size_t WS_SW13 = 12 * MiB + 512 * 1024;
constexpr size_t WS_SW2 = 13 * MiB + 512 * 1024;
constexpr size_t WS_DUMP = 2 * MiB + 16384;
constexpr size_t WS_SUMA = 14 * MiB;
constexpr size_t WS_SUMH = WS_SUMA + 2359296;
constexpr size_t WS_CIN = WS_SUMH + 2359296;
constexpr size_t WS_ROUTE = 21 * MiB;
constexpr size_t WS_HIST = 23 * MiB;
constexpr size_t WS_EW13 = 32 * MiB;
constexpr size_t WS_EW2 = 288 * MiB;
constexpr size_t WS_X1 = 416 * MiB;
constexpr size_t WS_HX2 = 544 * MiB;
constexpr size_t WS_LOGIT = 608 * MiB;
constexpr size_t WS_LIST = 1620 * MiB;
constexpr size_t WS_ACT = 674 * MiB;
constexpr size_t WS_YS = 850 * MiB;
constexpr size_t WS_P = 914 * MiB;
constexpr size_t WS_HX = 1166 * MiB;
constexpr size_t WS_OF = 1238 * MiB;
constexpr size_t WS_OB = 1270 * MiB;
constexpr size_t WS_YL = 1302 * MiB;
constexpr size_t WS_YE = 914 * MiB;
constexpr size_t WS_INV = 24 * MiB;
constexpr size_t WS_HX2F = 1684 * MiB;
constexpr size_t WS_END = 1716 * MiB;
constexpr int CW_BAR = 4096;
constexpr int CW_CNT = 16384;

constexpr int RING_BYTES = 131072;
constexpr int LDS_TS = RING_BYTES;
constexpr int LDS_CNT = LDS_TS + 1088;
constexpr int LDS_IDX = LDS_CNT + 1024;
constexpr int LDS_MISC = LDS_IDX + 12 * 1024;
constexpr int LDS_BYTES = 155648;
static_assert(LDS_MISC + 64 <= LDS_BYTES, "lds map");

DI unsigned pk2(float lo, float hi) { f32x2 v = {lo, hi}; bfv2 b = __builtin_convertvector(v, bfv2); return __builtin_bit_cast(unsigned, b); }
DI float clamp448(float x) { return fminf(fmaxf(x, -448.0f), 448.0f); }
DI unsigned pk4_f8(float a, float b, float c, float d) {
    int w = __builtin_amdgcn_cvt_pk_fp8_f32(clamp448(a), clamp448(b), 0, false); w = __builtin_amdgcn_cvt_pk_fp8_f32(clamp448(c), clamp448(d), w, true); return (unsigned)w; }
DI float bflo(unsigned w) { return __uint_as_float(w << 16); }
DI float bfhi(unsigned w) { return __uint_as_float(w & 0xffff0000u); }
DI float bf2f(bf16 h) { return __uint_as_float(((unsigned)h) << 16); }
DI bf16 f2bf(float f) { return (bf16)(pk2(f, 0.f) & 0xffffu); }
DI float rcpf_(float x) { return __builtin_amdgcn_rcpf(x); }
DI float ex2f_(float x) { return __builtin_amdgcn_exp2f(x); }
DI float expf_(float x) { return __builtin_amdgcn_exp2f(x * 1.4426950408889634f); }
DI float logf_(float x) { return __builtin_amdgcn_logf(x) * 0.6931471805599453f; }
DI float sigm(float x) { return rcpf_(1.0f + expf_(-x)); }
DI float wave_sum(float v) {
#pragma unroll
    for (int o = 1; o < 64; o <<= 1) v += __shfl_xor(v, o);
    return v;
}
#define LDS_WAIT() asm volatile("s_waitcnt lgkmcnt(0)" ::: "memory")

#define XB_TMO      128
#define XB_XCNT(j)  (256  + 64 * (j))
#define XB_XSUB(j)  (1280 + 64 * (j))
#define XB_XGEN(j)  (2304 + 64 * (j))
#define XB_TOP      3328
#define XB_TOPGEN   3392
#define XCD_BAR_WORDS 3456
#define XB_SPIN_CAP (1u << 18)
__device__ __forceinline__ unsigned xb_ld(unsigned* p)              { return __hip_atomic_load(p, __ATOMIC_RELAXED, __HIP_MEMORY_SCOPE_AGENT); }
__device__ __forceinline__ unsigned xb_add(unsigned* p, unsigned v) { return __hip_atomic_fetch_add(p, v, __ATOMIC_RELAXED, __HIP_MEMORY_SCOPE_AGENT); }
__device__ __forceinline__ unsigned xb_xcc_id() { return (unsigned)__builtin_amdgcn_s_getreg((3 << 11) | 20) & 0xFu; }
#define XB_SPIN(cond, bar) do { unsigned _sp = 0; while (cond) { __builtin_amdgcn_s_sleep(1); \
    if ((++_sp & 255u) == 0u) { if (xb_ld(&(bar)[XB_TMO])) break; if (_sp > XB_SPIN_CAP) { atomicAdd(&(bar)[XB_TMO], 1u); break; } } } } while (0)
struct XcdBarrier { unsigned* bar; unsigned x; volatile LAS unsigned* st; };
__device__ __forceinline__ XcdBarrier xcd_barrier_post(unsigned* bar, volatile LAS unsigned* st) {
    XcdBarrier b; b.bar = bar; b.x = xb_xcc_id(); b.st = st;
    if (threadIdx.x == 0) (void)xb_add(&bar[XB_XCNT(b.x)], 1u);
    return b;
}
__device__ __forceinline__ void xcd_barrier_complete(unsigned* bar, unsigned x, unsigned& nloc, unsigned& nx) {
    const unsigned G = gridDim.x * gridDim.y * gridDim.z;
    unsigned sum, cnt, mine, sp = 0u;
    for (;;) {
        sum = 0u; cnt = 0u; mine = 0u;
#pragma unroll
        for (unsigned j = 0; j < 16; ++j) { const unsigned c = xb_ld(&bar[XB_XCNT(j)]); sum += c; cnt += (c > 0u) ? 1u : 0u; mine = (j == x) ? c : mine; }
        if (sum == G) break;
        __builtin_amdgcn_s_sleep(1);
        if ((++sp & 255u) == 0u) { if (xb_ld(&bar[XB_TMO])) break; if (sp > XB_SPIN_CAP) { atomicAdd(&bar[XB_TMO], 1u); break; } }
    }
    nloc = mine > 0u ? mine : 1u; nx = cnt > 0u ? cnt : 1u;
}
__device__ __forceinline__ void xcd_barrier(const XcdBarrier& b) {
    asm volatile("s_waitcnt vmcnt(0)" ::: "memory");
    __syncthreads();
    if (threadIdx.x == 0) {
        unsigned* bar = b.bar;
        __builtin_amdgcn_s_waitcnt(0);
        unsigned nloc = b.st[0], nx = b.st[1];
        if (nloc == 0u) { xcd_barrier_complete(bar, b.x, nloc, nx); b.st[0] = nloc; b.st[1] = nx; }
        const unsigned old = xb_add(&bar[XB_XSUB(b.x)], 1u);
        const unsigned gen = old / nloc;
        if (old + 1u == (gen + 1u) * nloc) {
            __builtin_amdgcn_fence(__ATOMIC_RELEASE, "agent");
            asm volatile("s_waitcnt vmcnt(0)" ::: "memory");
            const unsigned og = xb_add(&bar[XB_TOP], 1u);
            const unsigned tg = og / nx;
            if (og + 1u == (tg + 1u) * nx) xb_add(&bar[XB_TOPGEN], 1u);
            else XB_SPIN(xb_ld(&bar[XB_TOPGEN]) == tg, bar);
            __builtin_amdgcn_fence(__ATOMIC_ACQUIRE, "agent");
            xb_add(&bar[XB_XGEN(b.x)], 1u);
            asm volatile("s_waitcnt vmcnt(0)" ::: "memory");
        } else {
            XB_SPIN(xb_ld(&bar[XB_XGEN(b.x)]) == gen, bar);
            __builtin_amdgcn_fence(__ATOMIC_ACQUIRE, "agent");
            asm volatile("s_waitcnt vmcnt(0)" ::: "memory");
        }
    }
    __syncthreads();
}

namespace pg8 {
constexpr int BM = 256, BK = 64, HALF = 128, HTB = HALF * BK * 2, NXCD = 8, WGM = 8;
DI int lds_byte(int r, int c) { const int st = (r >> 4) * 2 + (c >> 5), rr = r & 15, cc = c & 31, ob = rr * 64 + cc * 2; return st * 1024 + (ob ^ (((ob >> 9) & 1) << 5)); }
DI void stage_rc(int b, int& R, int& C) { const int st = b / 1024, sb = b % 1024, swz = sb ^ (((sb >> 9) & 1) << 5); R = (st >> 1) * 16 + swz / 64; C = (st & 1) * 32 + (swz % 64) / 2; }
DI int perm32(int rho) { const int n = rho >> 4, i = rho & 15; return 8 * (i >> 2) + 4 * n + (i & 3); }

struct Unit { int pm, pn, e, rt, ord, nrows; };

struct DenseOrder {
    const char* A; const char* Bt; int K, nM, nN, nwg, G, c;
    DI void init(const void* A_, const void* Bt_, int M, int N, int K_, int G_, int c_) { A = (const char*)A_; Bt = (const char*)Bt_; K = K_; nM = M / BM; nN = N / BM; nwg = nM * nN; G = G_; c = c_; }
    DI bool next(int i, Unit& u) const {
        const long L = (long)i * G + c; if (L >= nwg) return false;
        int wgid = (int)L; { const int q = nwg / NXCD, r = nwg % NXCD, xcd = wgid % NXCD, off = wgid / NXCD; wgid = (xcd < r ? xcd * (q + 1) : r * (q + 1) + (xcd - r) * q) + off; }
        const int nig = WGM * nN, gid = wgid / nig, fm = gid * WGM, gsz = (nM - fm) < WGM ? (nM - fm) : WGM;
        u.pm = fm + ((wgid % nig) % gsz); u.pn = (wgid % nig) / gsz; u.e = 0; u.rt = u.pm; u.ord = i; u.nrows = 256; return true;
    }
    DI const char* a_base(const Unit& u) const { return A + (size_t)u.pm * BM * K * 2; }
    DI const char* b_base(const Unit& u) const { return Bt + (size_t)u.pn * BM * K * 2; }
    static constexpr bool GATHER_A = false;
    DI void a_offs(const Unit&, int tid, unsigned (&v)[2][2]) const {
#pragma unroll
        for (int i = 0; i < 2; ++i) { int R, C; stage_rc(tid * 16 + i * 8192, R, C);
#pragma unroll
            for (int h = 0; h < 2; ++h) v[h][i] = (unsigned)((h * HALF + R) * K + C) * 2u; }
    }
};

template <bool GATHER> struct MoeOrder {
    const char* A; const char* Bt; const char* BtS; int K, ncol; size_t estride;
    const LAS int* ts; const LAS int* cnt; const LAS int* idx; int G, vcu, total;
    DI bool next(int i, Unit& u) const {
        const int L = i * G + vcu; if (L >= total) return false;
        const int rt = L / ncol; u.pn = L - rt * ncol; u.rt = rt; u.ord = i;
        const int Te = ts[256];
        if (rt >= Te) { u.e = 256; u.pm = rt - Te; u.nrows = 256; }
        else { int lo = 0, hi = 256;
#pragma unroll 1
            while (hi - lo > 1) { const int mid = (lo + hi) >> 1; if (ts[mid] <= rt) lo = mid; else hi = mid; }
            u.e = lo; u.pm = rt - ts[lo]; const int rem = cnt[lo] - u.pm * 256; u.nrows = rem < 256 ? rem : 256; }
        return true;
    }
    DI const char* a_base(const Unit& u) const { return GATHER ? A : A + (size_t)u.rt * BM * K * 2; }
    DI const char* b_base(const Unit& u) const { return (u.e < 256 ? Bt + (size_t)u.e * estride : BtS) + (size_t)u.pn * BM * K * 2; }
    static constexpr bool GATHER_A = GATHER;
    DI void a_offs(const Unit& u, int tid, unsigned (&v)[2][2]) const {
#pragma unroll
        for (int i = 0; i < 2; ++i) { int R, C; stage_rc(tid * 16 + i * 8192, R, C);
#pragma unroll
            for (int h = 0; h < 2; ++h) {
                if (GATHER) v[h][i] = ((unsigned)idx[u.ord * 256 + h * HALF + R] * (unsigned)K + (unsigned)C) * 2u;
                else v[h][i] = (unsigned)((h * HALF + R) * K + C) * 2u; } }
    }
};

struct GProf { unsigned long long t_loop, t_epi, t_next; };
typedef int v8i __attribute__((ext_vector_type(8)));
template <class Epi, class Sched, bool PROF = false, bool F8 = false>
__device__ __forceinline__ void gemm_phase(LAS unsigned char* lds, const int K, const Sched& S, const Epi& E, GProf* prof = nullptr) {
    unsigned long long pt0 = 0, pt1 = 0, pt2 = 0, pt3 = 0;
    const int tid = threadIdx.x, wid = __builtin_amdgcn_readfirstlane(tid >> 6), lane = tid & 63, wr = wid >> 2, wc = wid & 3, fr = lane & 15, fq = lane >> 4;
    const int nt = K / BK;
    unsigned voffBh[2][2];
#pragma unroll
    for (int i = 0; i < 2; ++i) { int R, C; stage_rc(tid * 16 + i * 8192, R, C);
#pragma unroll
        for (int h = 0; h < 2; ++h) { int Rb;
            if (Epi::PERM == 2) Rb = 64 * ((R >> 5) & 3) + 16 * ((R >> 2) & 3) + 8 * h + 4 * ((R >> 4) & 1) + (R & 3);
            else Rb = HALF * h + (Epi::PERM == 1 ? ((R & ~31) + perm32(R & 31)) : R);
            voffBh[h][i] = (unsigned)(Rb * K + C) * 2u; } }
    const size_t kstep = (size_t)(BK * 2);
    const size_t hstep = (size_t)HALF * K * 2;
    const unsigned ldsw = (unsigned)wid * 1024u;
    const int aoff = F8 ? lds_byte(wr * 64 + fr, fq * 16) : lds_byte(wr * 64 + fr, fq * 8), boff = F8 ? lds_byte(wc * 32 + fr, fq * 16) : lds_byte(wc * 32 + fr, fq * 8);
#define PG8_SA(b, h) (((b) * 2 + (h)) * HTB)
#define PG8_SB(b, h) ((4 + (b) * 2 + (h)) * HTB)
#define PG8_STAGE(bufoff, gbase, voff) do { _Pragma("unroll") for (int _i = 0; _i < 2; ++_i) \
        __builtin_amdgcn_global_load_lds((const unsigned*)((const char*)(gbase) + (voff)[_i]), (LAS unsigned*)(lds + (bufoff) + ldsw + _i * 8192), 16, 0, 0); } while (0)
#define PG8_LD8(dst, off) do { const v4u _lo = *(const LAS v4u*)(lds + (off)), _hi = *(const LAS v4u*)(lds + (off) + 16); \
        dst[0] = (int)_lo.x; dst[1] = (int)_lo.y; dst[2] = (int)_lo.z; dst[3] = (int)_lo.w; dst[4] = (int)_hi.x; dst[5] = (int)_hi.y; dst[6] = (int)_hi.z; dst[7] = (int)_hi.w; } while (0)
#define PG8_LDA(dst, b, h) do { if (F8) { _Pragma("unroll") for (int m = 0; m < 4; ++m) PG8_LD8(dst##8[m], PG8_SA(b, h) + aoff + m * 2048); } \
        else { _Pragma("unroll") for (int m = 0; m < 4; ++m) _Pragma("unroll") for (int k = 0; k < 2; ++k) dst[m][k] = *(const LAS bf16x8*)(lds + PG8_SA(b, h) + aoff + m * 2048 + k * 1024); } } while (0)
#define PG8_LDB(dst, b, h) do { if (F8) { _Pragma("unroll") for (int n = 0; n < 2; ++n) PG8_LD8(dst##8[n], PG8_SB(b, h) + boff + n * 2048); } \
        else { _Pragma("unroll") for (int n = 0; n < 2; ++n) _Pragma("unroll") for (int k = 0; k < 2; ++k) dst[n][k] = *(const LAS bf16x8*)(lds + PG8_SB(b, h) + boff + n * 2048 + k * 1024); } } while (0)
#define PG8_MMA(ai, bj, At, Bt) do { __builtin_amdgcn_s_setprio(1); \
        if (F8) { _Pragma("unroll") for (int m = 0; m < 4; ++m) _Pragma("unroll") for (int n = 0; n < 2; ++n) \
            asm volatile("v_mfma_scale_f32_16x16x128_f8f6f4 %0, %1, %2, %0, %3, %3 op_sel_hi:[0,0,0]" : "+v"(acc[ai][bj][m][n]) : "v"(Bt##8[n]), "v"(At##8[m]), "v"(sc127)); } \
        else { _Pragma("unroll") for (int m = 0; m < 4; ++m) _Pragma("unroll") for (int n = 0; n < 2; ++n) _Pragma("unroll") for (int k = 0; k < 2; ++k) \
            acc[ai][bj][m][n] = __builtin_amdgcn_mfma_f32_16x16x32_bf16(Bt[n][k], At[m][k], acc[ai][bj][m][n], 0, 0, 0); } \
        __builtin_amdgcn_s_setprio(0); } while (0)
#define PG8_WAIT_V(n) asm volatile("s_waitcnt vmcnt(" #n ")" ::: "memory")
#define PG8_WAIT_L(n) asm volatile("s_waitcnt lgkmcnt(" #n ")" ::: "memory")
#define PG8_BAR __builtin_amdgcn_s_barrier()
#define PG8_SCHED __builtin_amdgcn_sched_barrier(0)
    Unit cur, nxt; int ui = 0;
    if (!S.next(0, cur)) return;
    f32x4 acc[2][2][4][2];
#pragma unroll
    for (int a = 0; a < 2; ++a)
#pragma unroll
        for (int b = 0; b < 2; ++b)
#pragma unroll
            for (int m = 0; m < 4; ++m)
#pragma unroll
                for (int n = 0; n < 2; ++n) acc[a][b][m][n] = (f32x4){0.f, 0.f, 0.f, 0.f};
    bf16x8 At[4][2], B0[2][2], B1[2][2];
    v8i At8[4], B08[2], B18[2];
    int sc127 = 127; asm volatile("" : "+v"(sc127));
    unsigned vC[2][2], vN[2][2];
    S.a_offs(cur, tid, vC);
    const char* cA = S.a_base(cur); const char* cB = S.b_base(cur);
    PG8_STAGE(PG8_SB(0, 0), cB, voffBh[0]); PG8_STAGE(PG8_SA(0, 0), cA, vC[0]); PG8_STAGE(PG8_SB(0, 1), cB, voffBh[1]); PG8_STAGE(PG8_SA(0, 1), cA, vC[1]);
    if (wr == 1) PG8_BAR;
    PG8_WAIT_V(4); PG8_BAR;
    PG8_STAGE(PG8_SB(1, 0), cB + kstep, voffBh[0]); PG8_STAGE(PG8_SA(1, 0), cA + kstep, vC[0]); PG8_STAGE(PG8_SB(1, 1), cB + kstep, voffBh[1]);
    PG8_WAIT_V(6); PG8_BAR;
    for (;;) {
        if (PROF) pt0 = __builtin_amdgcn_s_memrealtime();
        const bool has_next = S.next(ui + 1, nxt);
        const char* nA = has_next ? S.a_base(nxt) : cA; const char* nB = has_next ? S.b_base(nxt) : cB;
        if (Sched::GATHER_A) { if (has_next) S.a_offs(nxt, tid, vN); else { vN[0][0] = vC[0][0]; vN[0][1] = vC[0][1]; vN[1][0] = vC[1][0]; vN[1][1] = vC[1][1]; } }
        if (PROF) pt1 = __builtin_amdgcn_s_memrealtime();
#pragma unroll 1
        for (int t = 0; t < nt; t += 2) {
            const bool last = (t == nt - 2);
            const char* a1 = cA + (size_t)(t + 1) * kstep;
            const char* a2 = last ? nA : cA + (size_t)(t + 2) * kstep; const char* b2 = last ? nB : cB + (size_t)(t + 2) * kstep;
            const char* a3 = a2 + kstep; const char* b3 = b2 + kstep;
            unsigned x0[2], x1[2];
            if (Sched::GATHER_A) { x0[0] = last ? vN[0][0] : vC[0][0]; x0[1] = last ? vN[0][1] : vC[0][1]; x1[0] = last ? vN[1][0] : vC[1][0]; x1[1] = last ? vN[1][1] : vC[1][1]; }
            else { x0[0] = vC[0][0]; x0[1] = vC[0][1]; x1[0] = vC[1][0]; x1[1] = vC[1][1]; }
            PG8_LDB(B0, 0, 0); PG8_SCHED; PG8_LDA(At, 0, 0); PG8_STAGE(PG8_SA(1, 1), a1, vC[1]);
            PG8_WAIT_L(8); PG8_BAR; PG8_WAIT_L(0); PG8_MMA(0, 0, At, B0); PG8_BAR; PG8_SCHED;
            PG8_LDB(B1, 0, 1); PG8_STAGE(PG8_SB(0, 0), b2, voffBh[0]);
            PG8_BAR; PG8_WAIT_L(0); PG8_MMA(0, 1, At, B1); PG8_BAR;
            PG8_LDA(At, 0, 1); PG8_STAGE(PG8_SA(0, 0), a2, x0);
            PG8_BAR; PG8_WAIT_L(0); PG8_MMA(1, 0, At, B0); PG8_BAR; PG8_SCHED;
            PG8_STAGE(PG8_SB(0, 1), b2, voffBh[1]);
            PG8_WAIT_V(6); PG8_BAR; PG8_MMA(1, 1, At, B1); PG8_BAR;
            PG8_LDB(B0, 1, 0); PG8_SCHED; PG8_LDA(At, 1, 0); PG8_STAGE(PG8_SA(0, 1), a2, x1);
            PG8_WAIT_L(8); PG8_BAR; PG8_WAIT_L(0); PG8_MMA(0, 0, At, B0); PG8_BAR; PG8_SCHED;
            PG8_LDB(B1, 1, 1); PG8_STAGE(PG8_SB(1, 0), b3, voffBh[0]);
            PG8_BAR; PG8_WAIT_L(0); PG8_MMA(0, 1, At, B1); PG8_BAR;
            PG8_LDA(At, 1, 1); PG8_STAGE(PG8_SA(1, 0), a3, x0);
            PG8_BAR; PG8_WAIT_L(0); PG8_MMA(1, 0, At, B0); PG8_BAR; PG8_SCHED;
            PG8_STAGE(PG8_SB(1, 1), b3, voffBh[1]);
            PG8_WAIT_V(6); PG8_BAR; PG8_MMA(1, 1, At, B1); PG8_BAR;
        }
        if (PROF) pt2 = __builtin_amdgcn_s_memrealtime();
        if (F8) asm volatile("s_nop 15\n\ts_nop 15" ::: "memory");
        E(acc, cur, wr, wc, fr, fq);
        if (PROF) { asm volatile("s_waitcnt vmcnt(0)" ::: "memory"); pt3 = __builtin_amdgcn_s_memrealtime(); prof->t_next += pt1 - pt0; prof->t_loop += pt2 - pt1; prof->t_epi += pt3 - pt2; }
        if (!has_next) break;
#pragma unroll
        for (int a = 0; a < 2; ++a)
#pragma unroll
            for (int b = 0; b < 2; ++b)
#pragma unroll
                for (int m = 0; m < 4; ++m)
#pragma unroll
                    for (int n = 0; n < 2; ++n) acc[a][b][m][n] = (f32x4){0.f, 0.f, 0.f, 0.f};
        cur = nxt; cA = nA; cB = nB; ++ui;
        if (Sched::GATHER_A) { vC[0][0] = vN[0][0]; vC[0][1] = vN[0][1]; vC[1][0] = vN[1][0]; vC[1][1] = vN[1][1]; }
    }
    PG8_WAIT_V(0);
    if (wr == 0) PG8_BAR;
    PG8_BAR;
#undef PG8_SA
#undef PG8_SB
#undef PG8_STAGE
#undef PG8_LD8
#undef PG8_LDA
#undef PG8_LDB
#undef PG8_MMA
#undef PG8_WAIT_V
#undef PG8_WAIT_L
#undef PG8_BAR
#undef PG8_SCHED
}

DI float gelu_tanh(float x) { const float u = 1.5957691216f * (x + 0.044715f * x * x * x); return x * rcpf_(1.0f + expf_(-u)); }
DI float silu_f(float x) { return x * rcpf_(1.0f + expf_(-x)); }

struct EpiInProj {
    static constexpr int PERM = 1;
    bf16* P; const float* LB;
    DI void operator()(const f32x4 (&acc)[2][2][4][2], const Unit& u, int wr, int wc, int fr, int fq) const {
        const int row0 = u.pm * BM + wr * 64 + fr, col0 = u.pn * BM + wc * 32 + 8 * fq;
        const int pn = u.pn;
        const int kind = (pn == 2 || pn == 3) ? 1 : (pn >= 8 && pn < 12) ? 2 : (pn >= 12) ? 3 : 0;
        f32x4 lbv[2][2];
        { const int dir = (pn >> 1) & 1; const int cc = (pn & 1) * 256 + wc * 32 + 8 * fq;
#pragma unroll
            for (int bj = 0; bj < 2; ++bj)
#pragma unroll
                for (int n = 0; n < 2; ++n) lbv[bj][n] = *(const f32x4*)(LB + dir * 512 + cc + bj * HALF + 4 * n);
            asm volatile("" :: "v"(lbv[0][0]), "v"(lbv[0][1]), "v"(lbv[1][0]), "v"(lbv[1][1])); }
#pragma unroll
        for (int ai = 0; ai < 2; ++ai)
#pragma unroll
            for (int m = 0; m < 4; ++m) { bf16* rowp = P + (size_t)(row0 + ai * HALF + m * 16) * INC + col0;
#pragma unroll
                for (int bj = 0; bj < 2; ++bj) { f32x4 v0 = acc[ai][bj][m][0], v1 = acc[ai][bj][m][1];
                    if (kind == 1) {
#pragma unroll
                        for (int j = 0; j < 4; ++j) { v0[j] = gelu_tanh(v0[j]); v1[j] = gelu_tanh(v1[j]); } }
                    else if (kind == 2) {
#pragma unroll
                        for (int j = 0; j < 4; ++j) { const float l0 = lbv[bj][0][j], l1 = lbv[bj][1][j];
                            v0[j] = logf_(l0 + (1.0f - l0) * sigm(v0[j])); v1[j] = logf_(l1 + (1.0f - l1) * sigm(v1[j])); } }
                    else if (kind == 3) {
#pragma unroll
                        for (int j = 0; j < 4; ++j) { v0[j] = silu_f(v0[j]); v1[j] = silu_f(v1[j]); } }
                    v4u w; w.x = pk2(v0[0], v0[1]); w.y = pk2(v0[2], v0[3]); w.z = pk2(v1[0], v1[1]); w.w = pk2(v1[2], v1[3]);
                    *(v4u*)(rowp + bj * HALF) = w; } }
    }
};
struct EpiResid {
    static constexpr int PERM = 0;
    const float* x; const float* mod; float* X1;
    DI void operator()(const f32x4 (&acc)[2][2][4][2], const Unit& u, int wr, int wc, int fr, int fq) const {
        const int row0 = u.pm * BM + wr * 64 + fr, col0 = u.pn * BM + wc * 32 + 4 * fq;
        const int b = (u.pm * BM) >> 11;
        f32x4 gv[2][2];
#pragma unroll
        for (int bj = 0; bj < 2; ++bj)
#pragma unroll
            for (int n = 0; n < 2; ++n) gv[bj][n] = *(const f32x4*)(mod + (size_t)b * 6144 + 2048 + col0 + bj * HALF + n * 16);
#pragma unroll
        for (int ai = 0; ai < 2; ++ai)
#pragma unroll
            for (int m = 0; m < 4; ++m) { const size_t off = (size_t)(row0 + ai * HALF + m * 16) * D + col0;
#pragma unroll
                for (int bj = 0; bj < 2; ++bj)
#pragma unroll
                    for (int n = 0; n < 2; ++n) { const f32x4 xv = *(const f32x4*)(x + off + bj * HALF + n * 16);
                        *(f32x4*)(X1 + off + bj * HALF + n * 16) = xv + gv[bj][n] * acc[ai][bj][m][n]; } }
    }
};
struct EpiF32 {
    static constexpr int PERM = 0;
    float* C; int ldc;
    DI void operator()(const f32x4 (&acc)[2][2][4][2], const Unit& u, int wr, int wc, int fr, int fq) const {
        const int row0 = u.pm * BM + wr * 64 + fr, col0 = u.pn * BM + wc * 32 + 4 * fq;
#pragma unroll
        for (int ai = 0; ai < 2; ++ai)
#pragma unroll
            for (int m = 0; m < 4; ++m) { float* rowp = C + (size_t)(row0 + ai * HALF + m * 16) * ldc + col0;
#pragma unroll
                for (int bj = 0; bj < 2; ++bj)
#pragma unroll
                    for (int n = 0; n < 2; ++n) *(f32x4*)(rowp + bj * HALF + n * 16) = acc[ai][bj][m][n]; }
    }
};
struct EpiSwiGLU8 {
    static constexpr int PERM = 1;
    unsigned char* ACT;
    DI void operator()(const f32x4 (&acc)[2][2][4][2], const Unit& u, int wr, int wc, int fr, int fq) const {
        const unsigned off0 = ((unsigned)u.rt * 256u + (unsigned)(wr * 64 + fr)) * (unsigned)DE + (unsigned)(u.pn * 128 + wc * 32 + 8 * fq);
#pragma unroll
        for (int ai = 0; ai < 2; ++ai)
#pragma unroll
            for (int m = 0; m < 4; ++m) {
                f32x4 a0 = acc[ai][0][m][0] * 0.03125f, a1 = acc[ai][0][m][1] * 0.03125f; const f32x4 g0 = acc[ai][1][m][0] * 0.25f, g1 = acc[ai][1][m][1] * 0.25f;
#pragma unroll
                for (int j = 0; j < 4; ++j) { a0[j] = silu_f(a0[j]) * g0[j]; a1[j] = silu_f(a1[j]) * g1[j]; }
                v2u w; w.x = pk4_f8(a0[0], a0[1], a0[2], a0[3]); w.y = pk4_f8(a1[0], a1[1], a1[2], a1[3]);
                *(v2u*)(ACT + (off0 + (unsigned)((ai * HALF + m * 16) * DE))) = w; }
    }
};
struct EpiSwiGLU {
    static constexpr int PERM = 1;
    bf16* ACT;
    DI void operator()(const f32x4 (&acc)[2][2][4][2], const Unit& u, int wr, int wc, int fr, int fq) const {
        const int row0 = wr * 64 + fr, col0 = u.pn * 128 + wc * 32 + 8 * fq;
        bf16* base = ACT + (size_t)u.rt * 256 * DE;
#pragma unroll
        for (int ai = 0; ai < 2; ++ai)
#pragma unroll
            for (int m = 0; m < 4; ++m) { bf16* rowp = base + (size_t)(row0 + ai * HALF + m * 16) * DE + col0;
                f32x4 a0 = acc[ai][0][m][0], a1 = acc[ai][0][m][1]; const f32x4 g0 = acc[ai][1][m][0], g1 = acc[ai][1][m][1];
#pragma unroll
                for (int j = 0; j < 4; ++j) { a0[j] = silu_f(a0[j]) * g0[j]; a1[j] = silu_f(a1[j]) * g1[j]; }
                v4u w; w.x = pk2(a0[0], a0[1]); w.y = pk2(a0[2], a0[3]); w.z = pk2(a1[0], a1[1]); w.w = pk2(a1[2], a1[3]);
                *(v4u*)rowp = w; }
    }
};
struct EpiScatter {
    static constexpr int PERM = 2;
    unsigned char* YE; const v2u* LIST; float oscale;
    DI void operator()(const f32x4 (&acc)[2][2][4][2], const Unit& u, int wr, int wc, int fr, int fq) const {
        const unsigned col0 = (unsigned)(u.pn * BM + wc * 64 + 16 * fq);
        const unsigned lbase = (u.e < 256) ? (unsigned)u.e * (unsigned)LISTCAP + (unsigned)u.pm * 256u : 0u;
        float gt[2][4];
#pragma unroll
        for (int ai = 0; ai < 2; ++ai)
#pragma unroll
            for (int m = 0; m < 4; ++m) { const int r = ai * HALF + wr * 64 + m * 16 + fr;
                const int rr = r < u.nrows ? r : u.nrows - 1;
                const v2u t2 = LIST[lbase + (u.e < 256 ? (unsigned)rr : 0u)]; gt[ai][m] = ((u.e < 256) ? __uint_as_float(t2.y) : 1.0f) * oscale; }
#pragma unroll
        for (int ai = 0; ai < 2; ++ai)
#pragma unroll
            for (int m = 0; m < 4; ++m) { const int r = ai * HALF + wr * 64 + m * 16 + fr; const float g = gt[ai][m];
                const unsigned row = (r < u.nrows) ? (unsigned)u.rt * 256u + (unsigned)r : 360448u;
                const f32x4 v0 = acc[ai][0][m][0] * g, v1 = acc[ai][0][m][1] * g, v2 = acc[ai][1][m][0] * g, v3 = acc[ai][1][m][1] * g;
                v4u w; w.x = pk4_f8(v0[0], v0[1], v0[2], v0[3]); w.y = pk4_f8(v1[0], v1[1], v1[2], v1[3]); w.z = pk4_f8(v2[0], v2[1], v2[2], v2[3]); w.w = pk4_f8(v3[0], v3[1], v3[2], v3[3]);
                *(v4u*)(YE + (row * (unsigned)D + col0)) = w; }
    }
};
}

struct Args { const float* in[26]; float* out; unsigned char* ws; int ph_lo, ph_hi; };
enum { I_X = 0, I_C, I_CTX, I_CCTX, I_ADAW, I_ADAB, I_NMIX, I_NFFN, I_NFIN, I_WIN, I_WOUT, I_CONVW, I_CONVB, I_WA, I_BA, I_WX, I_BX, I_LAM,
       I_LBL, I_HNORM, I_RW, I_RB, I_EW13, I_EW2, I_SW13, I_SW2 };

struct Frame {
    LAS unsigned char* lds;
    int tid, lane, wave, G, vcu, bx;
    const float* const* in; float* out; unsigned char* ws;
};

DI void transpose_item(const float* W, int ldw, bf16* WT, int ldo, int k0, int n0, int orow0, LAS float* scr, int lane) {
    const int sub = lane >> 3, c4 = (lane & 7) * 4;
    f32x4 v[8];
#pragma unroll
    for (int i = 0; i < 8; ++i) v[i] = __builtin_nontemporal_load((const f32x4*)(W + (size_t)(k0 + 8 * i + sub) * ldw + n0 + c4));
#pragma unroll
    for (int i = 0; i < 8; ++i) { LAS float* d = scr + (8 * i + sub) * 33 + c4; d[0] = v[i].x; d[1] = v[i].y; d[2] = v[i].z; d[3] = v[i].w; }
    LDS_WAIT(); asm volatile("" ::: "memory");
    const int c = lane & 7;
#pragma unroll
    for (int j = 0; j < 4; ++j) { const int n = (lane >> 3) + 8 * j; const LAS float* s = scr + (8 * c) * 33 + n;
        v4u o; o.x = pk2(s[0 * 33], s[1 * 33]); o.y = pk2(s[2 * 33], s[3 * 33]); o.z = pk2(s[4 * 33], s[5 * 33]); o.w = pk2(s[6 * 33], s[7 * 33]);
        *(v4u*)(WT + (size_t)(orow0 + n) * ldo + k0 + 8 * c) = o; }
    LDS_WAIT(); asm volatile("" ::: "memory");
}
DI void transpose_item8(const float* W, int ldw, unsigned char* WT, int ldo, int k0, int n0, int orow0, float scale, LAS float* scr, int lane) {
    const int sub = lane >> 3, c4 = (lane & 7) * 4;
    f32x4 v[16];
#pragma unroll
    for (int i = 0; i < 16; ++i) v[i] = __builtin_nontemporal_load((const f32x4*)(W + (size_t)(k0 + 8 * i + sub) * ldw + n0 + c4));
#pragma unroll
    for (int i = 0; i < 16; ++i) { LAS float* d = scr + (8 * i + sub) * 33 + c4; d[0] = v[i].x; d[1] = v[i].y; d[2] = v[i].z; d[3] = v[i].w; }
    LDS_WAIT(); asm volatile("" ::: "memory");
    const int c = lane & 7;
#pragma unroll
    for (int j = 0; j < 4; ++j) { const int n = (lane >> 3) + 8 * j; const LAS float* sp = scr + (16 * c) * 33 + n;
        v4u o; o.x = pk4_f8(sp[0] * scale, sp[33] * scale, sp[66] * scale, sp[99] * scale); o.y = pk4_f8(sp[132] * scale, sp[165] * scale, sp[198] * scale, sp[231] * scale);
        o.z = pk4_f8(sp[264] * scale, sp[297] * scale, sp[330] * scale, sp[363] * scale); o.w = pk4_f8(sp[396] * scale, sp[429] * scale, sp[462] * scale, sp[495] * scale);
        *(v4u*)(WT + (size_t)(orow0 + n) * ldo + k0 + 16 * c) = o; }
    LDS_WAIT(); asm volatile("" ::: "memory");
}
DI int w13_row(int n) { const int half = n >> 8, idx = n & 255; return 256 * (idx >> 7) + 128 * half + (idx & 127); }

DI void phase_prologue(const Frame& F) {
    const float* const* in = F.in; unsigned char* ws = F.ws;
    {
        LAS float* sc = (LAS float*)F.lds;
        LAS float* red = (LAS float*)(F.lds + 17 * 1024 * 4);
        for (int i = F.tid; i < 17 * 1024; i += NTHR) { const int r = i >> 10, k = i & 1023; const float v = (r < 16) ? in[I_C][r * 1024 + k] : in[I_CCTX][k]; sc[i] = v / (1.0f + __expf(-v)); }
        __syncthreads();
        const float* aw = in[I_ADAW]; float* MOD = (float*)(ws + WS_MOD);
        for (int cg = F.bx; cg < 256; cg += F.G) {
            const int kg = F.tid >> 5, cl = F.tid & 31, col = cg * 24 + cl;
            float a[17];
#pragma unroll
            for (int r = 0; r < 17; ++r) a[r] = 0.f;
            if (cl < 24) {
                for (int kk = 0; kk < 64; ++kk) { const int k = kg * 64 + kk; const float w = aw[(size_t)k * 6144 + col];
#pragma unroll
                    for (int r = 0; r < 17; ++r) a[r] += sc[r * 1024 + k] * w; }
#pragma unroll
                for (int r = 0; r < 17; ++r) red[(kg * 17 + r) * 24 + cl] = a[r];
            }
            __syncthreads();
            if (F.tid < 17 * 24) { const int r = F.tid / 24, c2 = F.tid % 24; float s = 0.f;
                for (int g = 0; g < 16; ++g) s += red[(g * 17 + r) * 24 + c2];
                MOD[r * 6144 + cg * 24 + c2] = s + in[I_ADAB][cg * 24 + c2]; }
            __syncthreads();
        }
    }
    {
        float* LB = (float*)(ws + WS_TAB); float* SP = LB + 1024;
        const int gt = F.bx * NTHR + F.tid, GT = F.G * NTHR;
        for (int i = gt; i < 1024; i += GT) { const int d = i >> 9, c = i & 511;
            const float l0 = in[I_LBL][(d * 2 + 0) * 512 + c], l1 = in[I_LBL][(d * 2 + 1) * 512 + c];
            LB[i] = 1.0f / (1.0f + expf(l1 - l0));
            SP[i] = log1pf(expf(-in[I_LAM][i])); }
        bf16* WGT = (bf16*)(ws + WS_WGT);
        for (int i = gt; i < 2 * 2 * 8 * 64 * 64; i += GT) { const int ii = i & 63, j = (i >> 6) & 63, h = (i >> 12) & 7, g = (i >> 15) & 1, d = i >> 16;
            const float* src = g ? in[I_WX] : in[I_WA];
            WGT[i] = f2bf(src[((size_t)(d * 8 + h) * 64 + ii) * 64 + j]); }
    }
    {
        LAS float* scr = (LAS float*)(F.lds + F.wave * 16896);
        const int gw = F.vcu * NWAVES + F.wave, NGW = F.G * NWAVES;
        constexpr int IT_WIN = 16 * 112, IT_WOUT = 16 * 32, IT_WR = 16 * 8, IT_SW13 = 8 * 16, IT_SW2 = 2 * 32;
        LAS float* scr8 = (LAS float*)(F.lds + F.wave * 16896);
        constexpr int NIT = IT_WIN + IT_WOUT + IT_WR + IT_SW13 + IT_SW2;
        for (int it = gw; it < NIT; it += NGW) {
            int r = it;
            if (r < IT_WIN) { const int kb = r / 112, nb = r % 112; transpose_item(in[I_WIN], INC, (bf16*)(ws + WS_WIN), 1024, kb * 64, nb * 32, nb * 32, scr, F.lane); continue; } r -= IT_WIN;
            if (r < IT_WOUT) { const int kb = r / 32, nb = r % 32; transpose_item(in[I_WOUT], 1024, (bf16*)(ws + WS_WOUT), 1024, kb * 64, nb * 32, nb * 32, scr, F.lane); continue; } r -= IT_WOUT;
            if (r < IT_WR) { const int kb = r / 8, nb = r % 8; transpose_item(in[I_RW], 256, (bf16*)(ws + WS_WR), 1024, kb * 64, nb * 32, nb * 32, scr, F.lane); continue; } r -= IT_WR;
            if (r < IT_SW13) { const int kb = r / 16, nb = r % 16; transpose_item8(in[I_SW13], 512, ws + WS_SW13, 1024, kb * 128, nb * 32, w13_row(nb * 32), 32.0f, scr8, F.lane); continue; } r -= IT_SW13;
            { const int kb = r / 32, nb = r % 32; transpose_item8(in[I_SW2], 1024, ws + WS_SW2, 256, kb * 128, nb * 32, nb * 32, 16.0f, scr8, F.lane); }
        }
    }
}
DI void convert_experts(const Frame& F, int gw, int NGW) {
    const float* const* in = F.in; unsigned char* ws = F.ws;
    LAS float* scr = (LAS float*)(F.lds + F.wave * 16896);
    constexpr int IT_E13 = 256 * 128, IT_E2 = 256 * 64;
    for (int it = gw; it < IT_E13 + IT_E2; it += NGW) {
        int r = it;
        if (r < IT_E13) { const int e = r >> 7, q = r & 127, kb = q >> 4, nb = q & 15;
            transpose_item8(in[I_EW13] + (size_t)e * 1024 * 512, 512, ws + WS_EW13 + (size_t)e * 512 * 1024, 1024, kb * 128, nb * 32, w13_row(nb * 32), 32.0f, scr, F.lane); continue; } r -= IT_E13;
        { const int e = r >> 6, q = r & 63, kb = q >> 5, nb = q & 31;
            transpose_item8(in[I_EW2] + (size_t)e * 256 * 1024, 1024, ws + WS_EW2 + (size_t)e * 1024 * 256, 256, kb * 128, nb * 32, nb * 32, 16.0f, scr, F.lane); }
    }
}

DI void phase_norm_rows(const Frame& F, int mode) {
    const float* MOD = (const float*)(F.ws + WS_MOD);
    const int gw = F.bx * NWAVES + F.wave, NGW = F.G * NWAVES;
    const int nrows = mode == 0 ? MTOT : NTOK;
    const float* gain = mode == 0 ? F.in[I_NMIX] : F.in[I_NFFN];
    bf16* dst = (bf16*)(F.ws + (mode == 0 ? WS_HX : WS_HX2));
    const int sh_off = mode == 0 ? 0 : 3072, sc_off = mode == 0 ? 1024 : 4096;
    for (int m = gw; m < nrows; m += NGW) {
        const float* src; int mr;
        if (mode == 0) { if (m < NTOK) { src = F.in[I_X] + (size_t)m * D; mr = m >> 11; } else { src = F.in[I_CTX] + (size_t)(m - NTOK) * D; mr = 16; } }
        else { src = (const float*)(F.ws + WS_X1) + (size_t)m * D; mr = m >> 11; }
        f32x4 v[4]; float ss = 0.f;
#pragma unroll
        for (int j = 0; j < 4; ++j) { v[j] = *(const f32x4*)(src + 4 * F.lane + 256 * j); ss += (v[j].x * v[j].x + v[j].y * v[j].y) + (v[j].z * v[j].z + v[j].w * v[j].w); }
        const float rs = rsqrtf(wave_sum(ss) * (1.0f / D) + EPS);
#pragma unroll
        for (int j = 0; j < 4; ++j) { const int c = 4 * F.lane + 256 * j;
            const f32x4 gn = *(const f32x4*)(gain + c), sc = *(const f32x4*)(MOD + mr * 6144 + sc_off + c), sh = *(const f32x4*)(MOD + mr * 6144 + sh_off + c);
            const f32x4 y = (v[j] * rs) * gn * (sc + 1.0f) + sh;
            v2u w; w.x = pk2(y.x, y.y); w.y = pk2(y.z, y.w);
            *(v2u*)(dst + (size_t)m * D + c) = w;
            if (mode == 1) *(unsigned*)(F.ws + WS_HX2F + (size_t)m * D + c) = pk4_f8(y.x, y.y, y.z, y.w); }
    }
}

constexpr int LT_STR = 520;
constexpr int L_RT = 0;
constexpr int L_GT = 69888;
static_assert(L_GT + 64 * LT_STR * 2 <= LDS_MISC, "lru lds");
template <bool FINAL> DI void lru_tile(const Frame& F, int b, int s) {
    const bf16* P = (const bf16*)(F.ws + WS_P);
    const int h = F.wave, fr = F.lane & 15, fq = F.lane >> 4;
    int prow0, L, t0;
    if (s < 4) { prow0 = NTOK + b * CTXL + 64 * s; L = CTXL; t0 = 64 * s; } else { prow0 = b * SEQ + 64 * (s - 4); L = SEQ; t0 = 64 * (s - 4); }
    LAS bf16* RT = (LAS bf16*)(F.lds + L_RT); LAS bf16* GT = (LAS bf16*)(F.lds + L_GT);
#pragma unroll
    for (int it = 0; it < 9; ++it) { const int p = F.tid + it * NTHR;
        if (p < 67 * 64) { const int row = p >> 6, pc = p & 63, ts = t0 + row - 1;
            v4u v = {0u, 0u, 0u, 0u};
            if (ts >= 0 && ts < L) v = *(const v4u*)(P + (size_t)(prow0 + row - 1) * INC + 8 * pc);
            *(LAS v4u*)(RT + row * LT_STR + 8 * pc) = v; } }
    if (FINAL) {
#pragma unroll
        for (int it = 0; it < 8; ++it) { const int p = F.tid + it * NTHR; const int row = p >> 6, pc = p & 63;
            *(LAS v4u*)(GT + row * LT_STR + 8 * pc) = *(const v4u*)(P + (size_t)(prow0 + row) * INC + 512 + 8 * pc); } }
    __syncthreads();
    bf16x8 Af[4][2];
#pragma unroll
    for (int ks = 0; ks < 2; ++ks) {
        const int c0 = 64 * h + 32 * ks + 8 * fq;
        float cw[4][8], cb[8];
#pragma unroll
        for (int k = 0; k < 4; ++k) { const f32x4 w0 = *(const f32x4*)(F.in[I_CONVW] + k * 512 + c0), w1 = *(const f32x4*)(F.in[I_CONVW] + k * 512 + c0 + 4);
            cw[k][0] = w0.x; cw[k][1] = w0.y; cw[k][2] = w0.z; cw[k][3] = w0.w; cw[k][4] = w1.x; cw[k][5] = w1.y; cw[k][6] = w1.z; cw[k][7] = w1.w; }
        { const f32x4 w0 = *(const f32x4*)(F.in[I_CONVB] + c0), w1 = *(const f32x4*)(F.in[I_CONVB] + c0 + 4);
            cb[0] = w0.x; cb[1] = w0.y; cb[2] = w0.z; cb[3] = w0.w; cb[4] = w1.x; cb[5] = w1.y; cb[6] = w1.z; cb[7] = w1.w; }
        const LAS bf16* rbase = RT + fr * LT_STR + c0;
#pragma unroll
        for (int tt = 0; tt < 4; ++tt) {
            float u[8];
#pragma unroll
            for (int j = 0; j < 8; ++j) u[j] = cb[j];
#pragma unroll
            for (int k = 0; k < 4; ++k) { const v4u r8 = *(const LAS v4u*)(rbase + (16 * tt + k) * LT_STR);
                u[0] += cw[k][0] * bflo(r8.x); u[1] += cw[k][1] * bfhi(r8.x); u[2] += cw[k][2] * bflo(r8.y); u[3] += cw[k][3] * bfhi(r8.y);
                u[4] += cw[k][4] * bflo(r8.z); u[5] += cw[k][5] * bfhi(r8.z); u[6] += cw[k][6] * bflo(r8.w); u[7] += cw[k][7] * bfhi(r8.w); }
            v4u w; w.x = pk2(u[0], u[1]); w.y = pk2(u[2], u[3]); w.z = pk2(u[4], u[5]); w.w = pk2(u[6], u[7]);
            Af[tt][ks] = __builtin_bit_cast(bf16x8, w);
        }
    }
    const bf16* WGT = (const bf16*)(F.ws + WS_WGT);
    const float* SP = (const float*)(F.ws + WS_TAB) + 1024;
    LAS bf16* HL = RT;
    LAS bf16* hlb = HL + (4 * fq) * LT_STR + 64 * h + fr;
    LAS bf16* gtb = GT + (4 * fq) * LT_STR + 64 * h + fr;
#pragma unroll 1
    for (int dir = 0; dir < 2; ++dir) {
#pragma unroll 1
        for (int nt = 0; nt < 4; ++nt) {
            const int cj = 64 * h + 16 * nt + fr;
            bf16x8 Ba[2], Bx[2], Id[2];
#pragma unroll
            for (int ks = 0; ks < 2; ++ks) {
                Ba[ks] = *(const bf16x8*)(WGT + ((size_t)((dir * 2 + 0) * 8 + h) * 64 + 16 * nt + fr) * 64 + 32 * ks + 8 * fq);
                Bx[ks] = *(const bf16x8*)(WGT + ((size_t)((dir * 2 + 1) * 8 + h) * 64 + 16 * nt + fr) * 64 + 32 * ks + 8 * fq);
#pragma unroll
                for (int jj = 0; jj < 8; ++jj) Id[ks][jj] = (32 * ks + 8 * fq + jj == 16 * nt + fr) ? (short)0x3F80 : (short)0;
            }
            const float ba = F.in[I_BA][dir * 512 + cj], bx = F.in[I_BX][dir * 512 + cj], sp = SP[dir * 512 + cj];
            float cin = 0.f, ptot = 1.f;
            if (FINAL) cin = ((const float*)(F.ws + WS_CIN))[((size_t)(dir * NB + b) * NSEQT + s) * 512 + cj];
#pragma unroll
            for (int tti = 0; tti < 4; ++tti) {
                const int tt = dir ? 3 - tti : tti;
                const bf16x8 A0 = dir ? Af[3 - tti][0] : Af[tti][0], A1 = dir ? Af[3 - tti][1] : Af[tti][1];
                f32x4 pa = {0.f, 0.f, 0.f, 0.f}, px = {0.f, 0.f, 0.f, 0.f}, uc = {0.f, 0.f, 0.f, 0.f};
                pa = __builtin_amdgcn_mfma_f32_16x16x32_bf16(A0, Ba[0], pa, 0, 0, 0); pa = __builtin_amdgcn_mfma_f32_16x16x32_bf16(A1, Ba[1], pa, 0, 0, 0);
                px = __builtin_amdgcn_mfma_f32_16x16x32_bf16(A0, Bx[0], px, 0, 0, 0); px = __builtin_amdgcn_mfma_f32_16x16x32_bf16(A1, Bx[1], px, 0, 0, 0);
                uc = __builtin_amdgcn_mfma_f32_16x16x32_bf16(A0, Id[0], uc, 0, 0, 0); uc = __builtin_amdgcn_mfma_f32_16x16x32_bf16(A1, Id[1], uc, 0, 0, 0);
                float av[4], bv[4];
#pragma unroll
                for (int ri = 0; ri < 4; ++ri) { const float pav = dir ? pa[3 - ri] : pa[ri], pxv = dir ? px[3 - ri] : px[ri], ucv = dir ? uc[3 - ri] : uc[ri];
                    const float rg = sigm(pav + ba), ig = sigm(pxv + bx);
                    const float a = expf_(-8.0f * rg * sp); av[ri] = a; bv[ri] = __builtin_amdgcn_sqrtf(fmaxf(1.0f - a * a, 0.f)) * ig * ucv; }
                float pl = 1.f, hl = 0.f;
#pragma unroll
                for (int ri = 0; ri < 4; ++ri) { hl = av[ri] * hl + bv[ri]; pl *= av[ri]; }
                float pg[4], hg[4];
#pragma unroll
                for (int gi = 0; gi < 4; ++gi) { const int g = dir ? 3 - gi : gi; pg[gi] = __shfl(pl, fr + 16 * g); hg[gi] = __shfl(hl, fr + 16 * g); }
                const int myg = dir ? 3 - fq : fq;
                float mycin = cin, run = cin;
#pragma unroll
                for (int gi = 0; gi < 4; ++gi) { if (gi == myg) mycin = run; run = pg[gi] * run + hg[gi]; }
                if (FINAL) { float hc = mycin;
#pragma unroll
                    for (int ri = 0; ri < 4; ++ri) { const int r = dir ? 3 - ri : ri; hc = av[ri] * hc + bv[ri];
                        const int o = (16 * tt + r) * LT_STR + 16 * nt;
                        if (dir == 0) hlb[o] = f2bf(hc);
                        else gtb[o] = f2bf(bf2f(gtb[o]) * (bf2f(hlb[o]) + hc)); } }
                else ptot *= (pg[0] * pg[1]) * (pg[2] * pg[3]);
                cin = run;
            }
            if (!FINAL && fq == 0) { const size_t o = ((size_t)(dir * NB + b) * NSEQT + s) * 512 + cj;
                ((float*)(F.ws + WS_SUMA))[o] = ptot; ((float*)(F.ws + WS_SUMH))[o] = cin; }
        }
    }
    if (FINAL) {
        __syncthreads();
        bf16* YL = (bf16*)(F.ws + WS_YL);
#pragma unroll
        for (int it = 0; it < 8; ++it) { const int p = F.tid + it * NTHR; const int row = p >> 6, pc = p & 63;
            *(v4u*)(YL + (size_t)(prow0 + row) * D + 8 * pc) = *(const LAS v4u*)(GT + row * LT_STR + 8 * pc); } }
    __syncthreads();
}
DI void phase_lru_pass1(const Frame& F) {
    for (int it = F.bx; it < NB * NSEQT; it += F.G) lru_tile<false>(F, it / NSEQT, it % NSEQT);
}
DI void phase_lru_carry(const Frame& F) {
    if (F.wave != 0) return;
    const float* SA = (const float*)(F.ws + WS_SUMA); const float* SH = (const float*)(F.ws + WS_SUMH); float* CI = (float*)(F.ws + WS_CIN);
    for (int id = F.bx * 64 + F.lane; id < 2 * NB * 512; id += F.G * 64) {
        const int dir = id >> 13, b = (id >> 9) & 15, c = id & 511;
        float x = 0.f; const size_t o0 = (size_t)(dir * NB + b) * NSEQT * 512 + c;
#pragma unroll
        for (int hf = 0; hf < 2; ++hf) {
            float av[18], hv[18];
#pragma unroll
            for (int q = 0; q < 18; ++q) { const int st = 18 * hf + q, s = dir ? (st < 4 ? 3 - st : 39 - st) : st; av[q] = SA[o0 + (size_t)s * 512]; hv[q] = SH[o0 + (size_t)s * 512]; }
#pragma unroll
            for (int q = 0; q < 18; ++q) { const int st = 18 * hf + q, s = dir ? (st < 4 ? 3 - st : 39 - st) : st; CI[o0 + (size_t)s * 512] = x; x = av[q] * x + hv[q]; }
        }
    }
}
DI void phase_lru_pass2(const Frame& F) {
    for (int it = F.bx; it < NB * 32; it += F.G) lru_tile<true>(F, it >> 5, 4 + (it & 31));
}

constexpr int HS = 144, SCS = 40;
constexpr int H_Q = 0, H_LF = H_Q + 32 * HS * 2, H_V = H_LF + 32 * HS * 2, H_QT = H_V + 32 * HS * 2, H_KT = H_QT + 32 * HS * 2, H_KH = H_KT + 32 * HS * 2,
              H_SC = H_KH + 32 * HS * 2, H_DEC = H_SC + 32 * SCS * 2, H_SET = H_DEC + 512;
static_assert(2 * H_SET <= RING_BYTES, "hgrn lds");
typedef short s16x4 __attribute__((ext_vector_type(4)));
DI bf16x8 tr_frag(const LAS bf16* tile, int c0, int lane) {
    const int g = lane >> 4, q = (lane & 15) >> 2, p = lane & 3;
    const LAS bf16* a = tile + (8 * g + q) * HS + c0 + 4 * p;
    const s16x4 lo = __builtin_amdgcn_ds_read_tr16_b64_v4i16((LAS s16x4*)a), hi = __builtin_amdgcn_ds_read_tr16_b64_v4i16((LAS s16x4*)(a + 4 * HS));
    bf16x8 r; r[0] = lo[0]; r[1] = lo[1]; r[2] = lo[2]; r[3] = lo[3]; r[4] = hi[0]; r[5] = hi[1]; r[6] = hi[2]; r[7] = hi[3]; return r;
}
DI void hgrn_chain(const Frame& F, int item) {
    const int b = item >> 3, h = (item >> 1) & 3, dir = item & 1;
    const bf16* P = (const bf16*)(F.ws + WS_P);
    bf16* O = (bf16*)(F.ws + (dir ? WS_OB : WS_OF));
    const int w = F.wave, lane = F.lane, fr = lane & 15, g = lane >> 4;
    const int li = F.tid >> 4, lp = F.tid & 15;
    f32x4 S[8];
#pragma unroll
    for (int t = 0; t < 8; ++t) S[t] = (f32x4){0.f, 0.f, 0.f, 0.f};
    auto prow = [&](int c, int i) -> size_t {
        const int ii = dir ? 31 - i : i;
        if (c < 8) { const int cc = dir ? 7 - c : c; return (size_t)NTOK + b * CTXL + 32 * cc + ii; }
        const int col = dir ? 63 - (c - 8) : (c - 8); return (size_t)b * SEQ + ii * 64 + col; };
    const size_t coff = 128 * h + 8 * lp;
    v4u rqA, rlA, rvA, rqB, rlB, rvB;
    { const bf16* rp = P + prow(0, li) * INC + coff; rqA = *(const v4u*)(rp + 1024); rvA = *(const v4u*)(rp + 1536); rlA = *(const v4u*)(rp + 2048 + 512 * dir); }
    { const bf16* rp = P + prow(1, li) * INC + coff; rqB = *(const v4u*)(rp + 1024); rvB = *(const v4u*)(rp + 1536); rlB = *(const v4u*)(rp + 2048 + 512 * dir); }
    bf16x8 Tri[2];
#pragma unroll
    for (int it = 0; it < 2; ++it)
#pragma unroll
        for (int jj = 0; jj < 8; ++jj) Tri[it][jj] = (8 * g + jj <= 16 * it + fr) ? (short)0x3F80 : (short)0;
#define HG_BODY(c, RQ, RL, RV, SET) do { \
        LAS unsigned char* base = F.lds + (SET) * H_SET; \
        LAS bf16* Qr = (LAS bf16*)(base + H_Q); LAS bf16* LFr = (LAS bf16*)(base + H_LF); LAS bf16* Vr = (LAS bf16*)(base + H_V); \
        LAS bf16* QT = (LAS bf16*)(base + H_QT); LAS bf16* KT = (LAS bf16*)(base + H_KT); LAS bf16* KH = (LAS bf16*)(base + H_KH); \
        LAS bf16* SC = (LAS bf16*)(base + H_SC); LAS float* DEC = (LAS float*)(base + H_DEC); \
        const bool isctx = (c) < 8; \
        *(LAS v4u*)(Qr + li * HS + 8 * lp) = RQ; *(LAS v4u*)(LFr + li * HS + 8 * lp) = RL; *(LAS v4u*)(Vr + li * HS + 8 * lp) = RV; \
        if ((c) + 2 < 72) { const bf16* rp = P + prow((c) + 2, li) * INC + coff; RQ = *(const v4u*)(rp + 1024); RV = *(const v4u*)(rp + 1536); RL = *(const v4u*)(rp + 2048 + 512 * dir); } \
        __syncthreads(); \
        {   \
            const bf16x8 Al = tr_frag(LFr, 16 * w, lane); \
            f32x4 Gm[2]; \
            _Pragma("unroll") for (int it = 0; it < 2; ++it) Gm[it] = __builtin_amdgcn_mfma_f32_16x16x32_bf16(Al, Tri[it], (f32x4){0.f, 0.f, 0.f, 0.f}, 0, 0, 0); \
            f32x4 dec; \
            _Pragma("unroll") for (int r = 0; r < 4; ++r) dec[r] = expf_(__shfl(Gm[1][r], (lane & 48) | 15)); \
            if (fr == 0) *(LAS f32x4*)(DEC + 16 * w + 4 * g) = dec; \
            _Pragma("unroll") for (int it = 0; it < 2; ++it) { const int i = 16 * it + fr, d0 = 16 * w + 4 * g; \
                const v2u q4 = *(const LAS v2u*)(Qr + i * HS + d0), l4 = *(const LAS v2u*)(LFr + i * HS + d0); \
                const float qv[4] = {bflo(q4.x), bfhi(q4.x), bflo(q4.y), bfhi(q4.y)}, lv[4] = {bflo(l4.x), bfhi(l4.x), bflo(l4.y), bfhi(l4.y)}; \
                float qt[4], kt[4], kh[4]; \
                _Pragma("unroll") for (int r = 0; r < 4; ++r) { const float eg = expf_(Gm[it][r]), ieg = rcpf_(eg), kk = 1.0f - expf_(lv[r]); qt[r] = qv[r] * eg; kt[r] = kk * ieg; kh[r] = kk * dec[r] * ieg; } \
                *(LAS v2u*)(QT + i * HS + d0) = (v2u){pk2(qt[0], qt[1]), pk2(qt[2], qt[3])}; \
                *(LAS v2u*)(KT + i * HS + d0) = (v2u){pk2(kt[0], kt[1]), pk2(kt[2], kt[3])}; \
                *(LAS v2u*)(KH + i * HS + d0) = (v2u){pk2(kh[0], kh[1]), pk2(kh[2], kh[3])}; } \
        } \
        __syncthreads(); \
        f32x4 oacc[2]; oacc[0] = (f32x4){0.f, 0.f, 0.f, 0.f}; oacc[1] = (f32x4){0.f, 0.f, 0.f, 0.f}; \
        if (!isctx) { \
            if (w < 4) {   \
                const int it = w >> 1, jt = w & 1; f32x4 sc = {0.f, 0.f, 0.f, 0.f}; \
                _Pragma("unroll") for (int ks = 0; ks < 4; ++ks) { const bf16x8 ak = *(const LAS bf16x8*)(KT + (16 * jt + fr) * HS + 32 * ks + 8 * g), bq = *(const LAS bf16x8*)(QT + (16 * it + fr) * HS + 32 * ks + 8 * g); \
                    sc = __builtin_amdgcn_mfma_f32_16x16x32_bf16(ak, bq, sc, 0, 0, 0); } \
                const int i = 16 * it + fr, j0 = 16 * jt + 4 * g; \
                *(LAS v2u*)(SC + i * SCS + j0) = (v2u){pk2(j0 <= i ? sc[0] : 0.f, j0 + 1 <= i ? sc[1] : 0.f), pk2(j0 + 2 <= i ? sc[2] : 0.f, j0 + 3 <= i ? sc[3] : 0.f)}; } \
              \
            _Pragma("unroll") for (int ks = 0; ks < 4; ++ks) { \
                v4u sb; sb.x = pk2(S[2 * ks][0], S[2 * ks][1]); sb.y = pk2(S[2 * ks][2], S[2 * ks][3]); sb.z = pk2(S[2 * ks + 1][0], S[2 * ks + 1][1]); sb.w = pk2(S[2 * ks + 1][2], S[2 * ks + 1][3]); \
                const bf16x8 As = __builtin_bit_cast(bf16x8, sb); \
                _Pragma("unroll") for (int it = 0; it < 2; ++it) { const v2u a0 = *(const LAS v2u*)(QT + (16 * it + fr) * HS + 32 * ks + 4 * g), a1 = *(const LAS v2u*)(QT + (16 * it + fr) * HS + 32 * ks + 16 + 4 * g); \
                    v4u bv; bv.x = a0.x; bv.y = a0.y; bv.z = a1.x; bv.w = a1.y; \
                    oacc[it] = __builtin_amdgcn_mfma_f32_16x16x32_bf16(As, __builtin_bit_cast(bf16x8, bv), oacc[it], 0, 0, 0); } } \
        } \
          \
        const bf16x8 Vf = tr_frag(Vr, 16 * w, lane); \
        _Pragma("unroll") for (int t = 0; t < 8; ++t) { const f32x4 dv = *(const LAS f32x4*)(DEC + 16 * t + 4 * g); \
            const bf16x8 Kf = tr_frag(KH, 16 * t, lane); \
            S[t] = __builtin_amdgcn_mfma_f32_16x16x32_bf16(Kf, Vf, S[t] * dv, 0, 0, 0); } \
        if (!isctx) { \
            __syncthreads(); \
            const int col = dir ? 63 - ((c) - 8) : ((c) - 8); \
            _Pragma("unroll") for (int it = 0; it < 2; ++it) { const bf16x8 bs = *(const LAS bf16x8*)(SC + (16 * it + fr) * SCS + 8 * g); \
                oacc[it] = __builtin_amdgcn_mfma_f32_16x16x32_bf16(Vf, bs, oacc[it], 0, 0, 0); \
                const int i = 16 * it + fr, ii = dir ? 31 - i : i; \
                *(v2u*)(O + ((size_t)b * SEQ + ii * 64 + col) * 512 + 128 * h + 16 * w + 4 * g) = (v2u){pk2(oacc[it][0], oacc[it][1]), pk2(oacc[it][2], oacc[it][3])}; } \
        } \
    } while (0)
#pragma unroll 1
    for (int c = 0; c < 72; c += 2) {
        HG_BODY(c, rqA, rlA, rvA, 0);
        HG_BODY(c + 1, rqB, rlB, rvB, 1);
    }
#undef HG_BODY
    __syncthreads();
}
DI void phase_hgrn(const Frame& F) {
    for (int it = F.bx; it < NB * 4 * 2; it += F.G) hgrn_chain(F, it);
}
DI void phase_y2(const Frame& F) {
    const bf16* OFp = (const bf16*)(F.ws + WS_OF); const bf16* OBp = (const bf16*)(F.ws + WS_OB); const bf16* P = (const bf16*)(F.ws + WS_P); bf16* YL = (bf16*)(F.ws + WS_YL);
    const int gw = F.bx * NWAVES + F.wave, NGW = F.G * NWAVES;
    const int c = 8 * F.lane;
    const f32x4 g0 = *(const f32x4*)(F.in[I_HNORM] + c), g1 = *(const f32x4*)(F.in[I_HNORM] + c + 4);
    const float gn[8] = {g0.x, g0.y, g0.z, g0.w, g1.x, g1.y, g1.z, g1.w};
    for (int m = gw; m < NTOK; m += NGW) {
        const v4u a = *(const v4u*)(OFp + (size_t)m * 512 + c), bq = *(const v4u*)(OBp + (size_t)m * 512 + c), sg = *(const v4u*)(P + (size_t)m * INC + 3072 + c);
        float o[8] = {bflo(a.x) + bflo(bq.x), bfhi(a.x) + bfhi(bq.x), bflo(a.y) + bflo(bq.y), bfhi(a.y) + bfhi(bq.y), bflo(a.z) + bflo(bq.z), bfhi(a.z) + bfhi(bq.z), bflo(a.w) + bflo(bq.w), bfhi(a.w) + bfhi(bq.w)};
        const float sgv[8] = {bflo(sg.x), bfhi(sg.x), bflo(sg.y), bfhi(sg.y), bflo(sg.z), bfhi(sg.z), bflo(sg.w), bfhi(sg.w)};
        float ss = 0.f;
#pragma unroll
        for (int j = 0; j < 8; ++j) ss += o[j] * o[j];
        ss += __shfl_xor(ss, 1); ss += __shfl_xor(ss, 2); ss += __shfl_xor(ss, 4); ss += __shfl_xor(ss, 8);
        const float rs = rsqrtf(ss * (1.0f / 128.0f) + EPS);
#pragma unroll
        for (int j = 0; j < 8; ++j) o[j] = o[j] * rs * gn[j] * sgv[j];
        v4u wv; wv.x = pk2(o[0], o[1]); wv.y = pk2(o[2], o[3]); wv.z = pk2(o[4], o[5]); wv.w = pk2(o[6], o[7]);
        *(v4u*)(YL + (size_t)m * D + 512 + c) = wv;
    }
}

DI unsigned fkey(float f) { const unsigned u = __float_as_uint(f); return u ^ ((u >> 31) ? 0xFFFFFFFFu : 0x80000000u); }
template <int CTRL> DI unsigned dpp_u(unsigned v) { return (unsigned)__builtin_amdgcn_update_dpp(0, (int)v, CTRL, 0xf, 0xf, true); }
template <int CTRL> DI float dpp_f(float v) { return __uint_as_float(dpp_u<CTRL>(__float_as_uint(v))); }
DI unsigned umax_(unsigned a, unsigned b) { return a > b ? a : b; }
DI float readlane_f(float v, int lane) { return __uint_as_float((unsigned)__builtin_amdgcn_readlane((int)__float_as_uint(v), lane)); }
DI void phase_route(const Frame& F) {
    const float* LOGIT = (const float*)(F.ws + WS_LOGIT); const float* rb = F.in[I_RB];
    v2u* ROUTE = (v2u*)(F.ws + WS_ROUTE); int* HIST = (int*)(F.ws + WS_HIST);
    LAS unsigned* hist = (LAS unsigned*)F.lds;
    const int l = F.lane;
    const f32x4 rbv = *(const f32x4*)(rb + 4 * l);
    const float NEG = -__builtin_inff();
    for (int blk = F.bx; blk < NTOK / 128; blk += F.G) {
        if (F.tid < 256) hist[F.tid] = 0u;
        __syncthreads();
        const int tok0 = blk * 128 + F.wave * 16;
        f32x4 lg = *(const f32x4*)(LOGIT + (size_t)tok0 * NE + 4 * l);
#pragma unroll 1
        for (int ti = 0; ti < 16; ++ti) {
            const int tok = tok0 + ti;
            f32x4 lgn = {0.f, 0.f, 0.f, 0.f};
            if (ti + 1 < 16) lgn = *(const f32x4*)(LOGIT + (size_t)(tok + 1) * NE + 4 * l);
            float sc[4], bs[4];
#pragma unroll
            for (int k = 0; k < 4; ++k) { sc[k] = rcpf_(1.0f + expf_(-lg[k])); bs[k] = sc[k] + rbv[k]; }
            float m1 = NEG, m2 = NEG;
#pragma unroll
            for (int k = 0; k < 4; ++k) { const float v = bs[k]; if (v > m1) { m2 = m1; m1 = v; } else if (v > m2) m2 = v; }
            { float o1 = dpp_f<0xB1>(m1), o2 = dpp_f<0xB1>(m2); float n1 = fmaxf(m1, o1), n2 = fmaxf(fminf(m1, o1), fmaxf(m2, o2)); m1 = n1; m2 = n2;
              o1 = dpp_f<0x4E>(m1); o2 = dpp_f<0x4E>(m2); n1 = fmaxf(m1, o1); n2 = fmaxf(fminf(m1, o1), fmaxf(m2, o2)); m1 = n1; m2 = n2;
              const float a1 = dpp_f<0x104>(m1), a2 = dpp_f<0x104>(m2), c1 = dpp_f<0x114>(m1), c2 = dpp_f<0x114>(m2);
              o1 = (l & 4) ? c1 : a1; o2 = (l & 4) ? c2 : a2; n1 = fmaxf(m1, o1); n2 = fmaxf(fminf(m1, o1), fmaxf(m2, o2)); m1 = n1; m2 = n2; }
            const float gs = m1 + m2; const int g = l >> 3; int rank = 0;
#pragma unroll
            for (int gg = 0; gg < 8; ++gg) { const float og = readlane_f(gs, gg * 8); rank += (og > gs || (og == gs && gg < g)) ? 1 : 0; }
            const bool sel = rank < 4;
            unsigned cv[4];
#pragma unroll
            for (int k = 0; k < 4; ++k) cv[k] = sel ? fkey(bs[k]) : 0u;
            float sum = 0.f, mysc = 0.f; int myexp = 0;
#pragma unroll
            for (int r = 0; r < TOPK; ++r) {
                unsigned bvk = cv[0]; int bk = 0;
#pragma unroll
                for (int k = 1; k < 4; ++k) if (cv[k] > bvk) { bvk = cv[k]; bk = k; }
                const float bsc = bk == 0 ? sc[0] : bk == 1 ? sc[1] : bk == 2 ? sc[2] : sc[3];
                unsigned m = bvk;
                m = umax_(m, dpp_u<0xB1>(m)); m = umax_(m, dpp_u<0x4E>(m)); m = umax_(m, dpp_u<0x124>(m)); m = umax_(m, dpp_u<0x128>(m));
                const unsigned M = umax_(umax_((unsigned)__builtin_amdgcn_readlane((int)m, 0), (unsigned)__builtin_amdgcn_readlane((int)m, 16)),
                                         umax_((unsigned)__builtin_amdgcn_readlane((int)m, 32), (unsigned)__builtin_amdgcn_readlane((int)m, 48)));
                const unsigned long long bal = __ballot(bvk == M);
                const int L = __builtin_ctzll(bal);
                const int kL = __builtin_amdgcn_readlane(bk, L);
                const float se = readlane_f(bsc, L);
                const int e = 4 * L + kL;
                if (l == L) {
#pragma unroll
                    for (int k = 0; k < 4; ++k) if (k == bk) cv[k] = 0u; }
                sum += se; if (l == r) { myexp = e; mysc = se; }
            }
            if (l < TOPK) { ROUTE[(size_t)tok * TOPK + l] = (v2u){(unsigned)myexp, __float_as_uint(mysc * rcpf_(sum) * 2.5f)}; (void)__hip_atomic_fetch_add(hist + myexp, 1u, __ATOMIC_RELAXED, __HIP_MEMORY_SCOPE_WORKGROUP); }
            lg = lgn;
        }
        __syncthreads();
        if (F.tid < 256) HIST[blk * 256 + F.tid] = (int)hist[F.tid];
        __syncthreads();
    }
}
DI void phase_lists(const Frame& F) {
    const v2u* ROUTE = (const v2u*)(F.ws + WS_ROUTE); const int* HIST = (const int*)(F.ws + WS_HIST);
    unsigned* cnt = (unsigned*)(F.ws + WS_CTL) + CW_CNT; v2u* LIST = (v2u*)(F.ws + WS_LIST);
    LAS int* part = (LAS int*)F.lds;
    LAS int* lbase = part + 1024; LAS unsigned* lcnt = (LAS unsigned*)(lbase + 256); LAS int* ltot = lbase + 512; LAS int* lts = lbase + 768;
    int* INV = (int*)(F.ws + WS_INV);
    for (int blk = F.bx; blk < NTOK / 128; blk += F.G) {
        const int e = F.tid & 255, hf = F.tid >> 8;
        int below = 0, all = 0;
#pragma unroll 8
        for (int q = 0; q < 128; ++q) { const int row = hf * 128 + q; const int v = HIST[row * 256 + e]; all += v; below += (row < blk) ? v : 0; }
        part[hf * 512 + e] = below; part[hf * 512 + 256 + e] = all;
        __syncthreads();
        if (F.tid < 256) { lbase[e] = part[e] + part[512 + e]; lcnt[e] = 0u; const int tot = part[256 + e] + part[768 + e]; ltot[e] = tot; if (blk == 0) cnt[e] = (unsigned)tot; }
        __syncthreads();
        if (F.tid == 0) { int s2 = 0; for (int q = 0; q < 256; ++q) { lts[q] = s2; s2 += (ltot[q] + 255) >> 8; } }
        __syncthreads();
#pragma unroll
        for (int q = 0; q < 2; ++q) { const int a = F.tid + q * NTHR; const unsigned tk = (unsigned)(blk * 128 * TOPK + a);
            const v2u rt = ROUTE[tk]; const unsigned pos = (unsigned)lbase[rt.x] + __hip_atomic_fetch_add(lcnt + rt.x, 1u, __ATOMIC_RELAXED, __HIP_MEMORY_SCOPE_WORKGROUP);
            LIST[(size_t)rt.x * LISTCAP + pos] = (v2u){tk, rt.y}; INV[tk] = lts[rt.x] * 256 + (int)pos; }
        __syncthreads();
    }
}

template <bool GATHER> DI void moe_setup(const Frame& F, int ncol, int& total) {
    LAS int* ts = (LAS int*)(F.lds + LDS_TS); LAS int* cl = (LAS int*)(F.lds + LDS_CNT); LAS int* idx = (LAS int*)(F.lds + LDS_IDX);
    const unsigned* cnt = (const unsigned*)(F.ws + WS_CTL) + CW_CNT;
    if (F.tid < 256) cl[F.tid] = (int)__hip_atomic_load(cnt + F.tid, __ATOMIC_RELAXED, __HIP_MEMORY_SCOPE_AGENT);
    __syncthreads();
    if (F.tid == 0) { int s = 0; for (int e = 0; e < 256; ++e) { ts[e] = s; s += (cl[e] + 255) >> 8; } ts[256] = s; }
    __syncthreads();
    const int Te = ts[256]; total = (Te + NTOK / 256) * ncol;
    if (GATHER) {
        const v2u* LIST = (const v2u*)(F.ws + WS_LIST);
        for (int ord = 0; ord < 12; ++ord) { const int L = ord * F.G + F.vcu; if (L >= total) break;
            const int rt = L / ncol;
            if (F.tid < 256) { int v;
                if (rt >= Te) v = (rt - Te) * 256 + F.tid;
                else { int lo = 0, hi = 256; while (hi - lo > 1) { const int mid = (lo + hi) >> 1; if (ts[mid] <= rt) lo = mid; else hi = mid; }
                    const int r = (rt - ts[lo]) * 256 + F.tid; v = (r < cl[lo]) ? (int)(LIST[(size_t)lo * LISTCAP + r].x >> 3) : 0; }
                idx[ord * 256 + F.tid] = v; } }
    }
    __syncthreads();
}

DI void phase_combine(const Frame& F, int mode) {
    const float* MOD = (const float*)(F.ws + WS_MOD);
    const unsigned char* YE = F.ws + WS_YE; const int* INV = (const int*)(F.ws + WS_INV);
    int Te = 0; if (mode == 0) { const unsigned* cnt = (const unsigned*)(F.ws + WS_CTL) + CW_CNT; int t4 = 0;
#pragma unroll
        for (int q = 0; q < 4; ++q) t4 += (int)((cnt[F.lane + 64 * q] + 255u) >> 8);
#pragma unroll
        for (int o = 1; o < 64; o <<= 1) t4 += __shfl_xor(t4, o);
        Te = __builtin_amdgcn_readfirstlane(t4); }
    const int gw = F.bx * NWAVES + F.wave, NGW = F.G * NWAVES;
    const float* nf = F.in[I_NFIN];
    const int c = 16 * F.lane;
    for (int m = gw; m < NTOK; m += NGW) {
        const int b = m >> 11;
        float s[16];
#pragma unroll
        for (int q = 0; q < 16; ++q) s[q] = 0.f;
        const float* xsrc = mode == 2 ? F.in[I_X] : (const float*)(F.ws + WS_X1);
        if (mode == 0) {
#pragma unroll
            for (int k = 0; k < 9; ++k) { const int row = (k < 8) ? INV[m * TOPK + k] : Te * 256 + m; const v4u w = *(const v4u*)(YE + (size_t)row * D + c);
                const unsigned ww[4] = {w.x, w.y, w.z, w.w};
#pragma unroll
                for (int q = 0; q < 4; ++q) { const f32x2 lo = __builtin_amdgcn_cvt_pk_f32_fp8((int)ww[q], false), hi = __builtin_amdgcn_cvt_pk_f32_fp8((int)ww[q], true);
                    s[4 * q] += lo.x; s[4 * q + 1] += lo.y; s[4 * q + 2] += hi.x; s[4 * q + 3] += hi.y; } } }
        float x2[16]; float ss = 0.f;
#pragma unroll
        for (int q = 0; q < 4; ++q) { const f32x4 xa = *(const f32x4*)(xsrc + (size_t)m * D + c + 4 * q), ga = *(const f32x4*)(MOD + b * 6144 + 5120 + c + 4 * q);
#pragma unroll
            for (int j = 0; j < 4; ++j) { const float v = xa[j] + ga[j] * (s[4 * q + j] * 0.015625f); x2[4 * q + j] = v; ss += v * v; } }
        const float rs = rsqrtf(wave_sum(ss) * (1.0f / D) + EPS);
#pragma unroll
        for (int q = 0; q < 4; ++q) { const f32x4 na = *(const f32x4*)(nf + c + 4 * q);
            f32x4 oa = {x2[4 * q] * rs * na.x, x2[4 * q + 1] * rs * na.y, x2[4 * q + 2] * rs * na.z, x2[4 * q + 3] * rs * na.w};
            *(f32x4*)(F.out + (size_t)m * D + c + 4 * q) = oa; }
    }
}

constexpr int NPHASE = 14;
__global__ void __launch_bounds__(NTHR, 2) fwd_kernel(Args args) {
    extern __shared__ __attribute__((aligned(16))) unsigned char lds_raw[];
    Frame F;
    F.lds = (LAS unsigned char*)lds_raw;
    F.tid = threadIdx.x; F.lane = F.tid & 63; F.wave = __builtin_amdgcn_readfirstlane(F.tid >> 6);
    F.G = gridDim.x; F.bx = blockIdx.x; F.vcu = (F.G % 8 == 0) ? (F.bx % 8) * (F.G / 8) + F.bx / 8 : F.bx;
    F.in = args.in; F.out = args.out; F.ws = args.ws;
    volatile LAS unsigned* MISC = (volatile LAS unsigned*)(F.lds + LDS_MISC);
    if (F.tid < 16) MISC[F.tid] = 0u;
    __syncthreads();
    XcdBarrier bar; bar.bar = (unsigned*)(F.ws + WS_CTL) + CW_BAR; bar.x = 0; bar.st = nullptr;
#if !PER_PHASE_LAUNCH
    bar = xcd_barrier_post((unsigned*)(F.ws + WS_CTL) + CW_BAR, MISC + 8);
#define GRID_BAR() xcd_barrier(bar)
#else
#define GRID_BAR() do {} while (0)
#endif
    const int lo = args.ph_lo, hi = args.ph_hi;
#ifndef PH_MASK
#define PH_MASK 0xFFFF
#endif
#define IN(k) (((PH_MASK >> (k)) & 1) && lo <= (k) && (k) < hi)
#ifndef PROBE_PH
#define PROBE_PH -1
#endif
#ifndef PROBE_MULT
#define PROBE_MULT 4
#endif
    volatile LAS unsigned long long* PRT = (volatile LAS unsigned long long*)(F.lds + LDS_MISC);
    if (PROBE_PH == 0 && F.wave == 0) PRT[0] = __builtin_amdgcn_s_memrealtime();
#define SEAM(k) do { if (IN(k) && IN((k) + 1)) GRID_BAR(); \
        if (PROBE_PH >= 0 && F.wave == 0) { if ((k) == PROBE_PH - 1) PRT[0] = __builtin_amdgcn_s_memrealtime(); if ((k) == PROBE_PH) PRT[1] = __builtin_amdgcn_s_memrealtime(); } } while (0)
#ifndef REPEAT_MASK
#define REPEAT_MASK 0
#endif
#define REPS(k) (1 + ((REPEAT_MASK >> (k)) & 1))
    unsigned char* ws = F.ws;

    if (IN(0)) _Pragma("unroll 1") for (int rep = 0; rep < REPS(0); ++rep) { if (rep) GRID_BAR(); phase_prologue(F); } SEAM(0);
    if (IN(1)) _Pragma("unroll 1") for (int rep = 0; rep < REPS(1); ++rep) { if (rep) GRID_BAR(); phase_norm_rows(F, 0); } SEAM(1);
    if (IN(2)) _Pragma("unroll 1") for (int rep = 0; rep < REPS(2); ++rep) { if (rep) GRID_BAR();
        pg8::DenseOrder S; S.init(ws + WS_HX, ws + WS_WIN, MTOT, INC, D, F.G, F.bx);
        pg8::EpiInProj E{(bf16*)(ws + WS_P), (const float*)(ws + WS_TAB)};
        pg8::gemm_phase(F.lds, D, S, E);
    } SEAM(2);
    if (IN(3)) _Pragma("unroll 1") for (int rep = 0; rep < REPS(3); ++rep) { if (rep) GRID_BAR(); phase_lru_pass1(F); } SEAM(3);
    if (IN(4)) _Pragma("unroll 1") for (int rep = 0; rep < REPS(4); ++rep) { if (rep) GRID_BAR(); phase_lru_carry(F);
        if (F.G >= 256) { if (F.bx < 128) hgrn_chain(F, F.bx); else convert_experts(F, (F.bx - 128) * NWAVES + F.wave, (F.G - 128) * NWAVES); }
        else { phase_hgrn(F); convert_experts(F, F.bx * NWAVES + F.wave, F.G * NWAVES); } } SEAM(4);
    if (IN(5)) _Pragma("unroll 1") for (int rep = 0; rep < REPS(5); ++rep) { if (rep) GRID_BAR(); phase_lru_pass2(F); phase_y2(F); } SEAM(5);
    if (IN(6)) _Pragma("unroll 1") for (int rep = 0; rep < REPS(6); ++rep) { if (rep) GRID_BAR();
        pg8::DenseOrder S; S.init(ws + WS_YL, ws + WS_WOUT, NTOK, D, D, F.G, F.bx);
        pg8::EpiResid E{F.in[I_X], (const float*)(ws + WS_MOD), (float*)(ws + WS_X1)};
        pg8::gemm_phase(F.lds, D, S, E);
    } SEAM(6);
#if DBG_STOP == 1
    if (IN(7)) _Pragma("unroll 1") for (int rep = 0; rep < REPS(7); ++rep) { if (rep) GRID_BAR(); phase_combine(F, 1); }
#else
    if (IN(7)) _Pragma("unroll 1") for (int rep = 0; rep < REPS(7); ++rep) { if (rep) GRID_BAR(); phase_norm_rows(F, 1); } SEAM(7);
    if (IN(8)) _Pragma("unroll 1") for (int rep = 0; rep < REPS(8); ++rep) { if (rep) GRID_BAR();
        pg8::DenseOrder S; S.init(ws + WS_HX2, ws + WS_WR, NTOK, NE, D, F.G, F.bx);
        pg8::EpiF32 E{(float*)(ws + WS_LOGIT), NE};
        pg8::gemm_phase(F.lds, D, S, E);
    } SEAM(8);
    if (IN(9)) _Pragma("unroll 1") for (int rep = 0; rep < REPS(9); ++rep) { if (rep) GRID_BAR(); phase_route(F); } SEAM(9);
    if (IN(10)) _Pragma("unroll 1") for (int rep = 0; rep < REPS(10); ++rep) { if (rep) GRID_BAR(); phase_lists(F); } SEAM(10);
    if (IN(11)) _Pragma("unroll 1") for (int rep = 0; rep < REPS(11); ++rep) { if (rep) GRID_BAR();
        int total; moe_setup<true>(F, 2, total);
        pg8::MoeOrder<true> S; S.A = (const char*)(ws + WS_HX2F); S.Bt = (const char*)(ws + WS_EW13); S.BtS = (const char*)(ws + WS_SW13); S.K = D / 2; S.ncol = 2; S.estride = (size_t)512 * 1024;
        S.ts = (const LAS int*)(F.lds + LDS_TS); S.cnt = (const LAS int*)(F.lds + LDS_CNT); S.idx = (const LAS int*)(F.lds + LDS_IDX); S.G = F.G; S.vcu = F.vcu; S.total = total;
        pg8::EpiSwiGLU8 E{ws + WS_ACT};
        pg8::gemm_phase<pg8::EpiSwiGLU8, pg8::MoeOrder<true>, false, true>(F.lds, D / 2, S, E);
    } SEAM(11);
    if (IN(12)) _Pragma("unroll 1") for (int rep = 0; rep < REPS(12); ++rep) { if (rep) GRID_BAR();
        int total; moe_setup<false>(F, 4, total);
        pg8::MoeOrder<false> S; S.A = (const char*)(ws + WS_ACT); S.Bt = (const char*)(ws + WS_EW2); S.BtS = (const char*)(ws + WS_SW2); S.K = DE / 2; S.ncol = 4; S.estride = (size_t)1024 * 256;
        S.ts = (const LAS int*)(F.lds + LDS_TS); S.cnt = (const LAS int*)(F.lds + LDS_CNT); S.idx = (const LAS int*)(F.lds + LDS_IDX); S.G = F.G; S.vcu = F.vcu; S.total = total;
        pg8::EpiScatter E{ws + WS_YE, (const v2u*)(ws + WS_LIST), 0.5f};
#if defined(PROBE_GEMM)
        pg8::GProf gp{0ull, 0ull, 0ull};
        pg8::gemm_phase<pg8::EpiScatter, pg8::MoeOrder<false>, true, true>(F.lds, DE / 2, S, E, &gp);
        if (F.wave == 0) { PRT[0] = 0ull; PRT[1] = (PROBE_GEMM == 0) ? gp.t_loop : (PROBE_GEMM == 1) ? gp.t_epi : gp.t_next; }
#else
        pg8::gemm_phase<pg8::EpiScatter, pg8::MoeOrder<false>, false, true>(F.lds, DE / 2, S, E);
#endif
    } SEAM(12);
    if (IN(13)) _Pragma("unroll 1") for (int rep = 0; rep < REPS(13); ++rep) { if (rep) GRID_BAR(); phase_combine(F, 0); }
#endif
#if defined(PROBE_GEMM)
    if (F.bx == 0 && F.wave == 0) {
#else
    if (PROBE_PH >= 0 && F.bx == 0 && F.wave == 0) {
#endif
        const unsigned long long te = __builtin_amdgcn_s_memrealtime(); if (PROBE_PH == NPHASE - 1) PRT[1] = te;
        const unsigned long long target = (unsigned long long)PROBE_MULT * (PRT[1] - PRT[0]);
        while (__builtin_amdgcn_s_memrealtime() - te < target) __builtin_amdgcn_s_sleep(20);
    }
}

extern "C" void kernel_launch(void* const* d_in, const int* in_sizes, int n_in, void* d_out, int out_size, void* d_ws, size_t ws_size, hipStream_t stream) {
    static int grid = 0;
    if (grid == 0) {
        if (n_in != 26 || in_sizes[0] != NTOK * D || out_size != NTOK * D || ws_size < WS_END) { fprintf(stderr, "kernel_launch: unexpected shapes (n_in %d, ws %zu)\n", n_in, ws_size); grid = -1; return; }
        int dev = 0, cus = 0, per_cu = 0;
        if (hipGetDevice(&dev) != hipSuccess || hipDeviceGetAttribute(&cus, hipDeviceAttributeMultiprocessorCount, dev) != hipSuccess) { grid = -1; return; }
        if (hipFuncSetAttribute((const void*)fwd_kernel, hipFuncAttributeMaxDynamicSharedMemorySize, LDS_BYTES) != hipSuccess) { fprintf(stderr, "kernel_launch: hipFuncSetAttribute failed\n"); grid = -1; return; }
        if (hipOccupancyMaxActiveBlocksPerMultiprocessor(&per_cu, (const void*)fwd_kernel, NTHR, LDS_BYTES) != hipSuccess || per_cu < 1) { fprintf(stderr, "kernel_launch: occupancy query says %d\n", per_cu); }
        (void)hipGetLastError();
        grid = cus;
    }
    if (grid < 0) return;
    hipMemsetAsync((char*)d_ws + WS_CTL, 0, CTL_ZERO_BYTES, stream);
    Args a{};
    for (int i = 0; i < 26; ++i) a.in[i] = (const float*)d_in[i];
    a.out = (float*)d_out; a.ws = (unsigned char*)d_ws;
#if PER_PHASE_LAUNCH
    for (int p = 0; p < NPHASE; ++p) { a.ph_lo = p; a.ph_hi = p + 1; hipLaunchKernelGGL(fwd_kernel, dim3(grid), dim3(NTHR), LDS_BYTES, stream, a); }
#else
    a.ph_lo = 0; a.ph_hi = NPHASE;
    hipLaunchKernelGGL(fwd_kernel, dim3(grid), dim3(NTHR), LDS_BYTES, stream, a);
#endif
}
```

```cpp
#include <hip/hip_runtime.h>
#include <cstdio>
#include <cstdint>

#ifndef PER_PHASE_LAUNCH
#define PER_PHASE_LAUNCH 0
#endif
#ifndef DBG_STOP
#define DBG_STOP 0
#endif

#define GAS __attribute__((address_space(1)))
#define LAS __attribute__((address_space(3)))
#define DI __device__ __forceinline__
typedef unsigned short bf16;
typedef unsigned v4u __attribute__((ext_vector_type(4)));
typedef unsigned v2u __attribute__((ext_vector_type(2)));
typedef float f32x4 __attribute__((ext_vector_type(4)));
typedef float f32x2 __attribute__((ext_vector_type(2)));
typedef short bf16x8 __attribute__((ext_vector_type(8)));
typedef __bf16 bfv2 __attribute__((ext_vector_type(2)));

constexpr int D = 1024, NB = 16, SEQ = 2048, CTXL = 256;
constexpr int NTOK = NB * SEQ;
constexpr int NCTX = NB * CTXL;
constexpr int MTOT = NTOK + NCTX;
constexpr int INC = 3584;
constexpr int NE = 256, TOPK = 8, DE = 256;
constexpr int LISTCAP = 32768;
constexpr float EPS = 1e-6f;
constexpr int NWAVES = 8, NTHR = 512;
constexpr int NSEQT = 36;

constexpr size_t MiB = 1u << 20;
constexpr size_t WS_CTL = 0, CTL_ZERO_BYTES = 1 * MiB;
constexpr size_t WS_MOD = 1 * MiB;
constexpr size_t WS_TAB = 2 * MiB;
constexpr size_t WS_WGT = 2 * MiB + 65536;
constexpr size_t WS_WIN = 3 * MiB;
constexpr size_t WS_WOUT = 10 * MiB;
constexpr size_t WS_WR = 12 * MiB;
constexpr size_t WS_SW13 = 12 * MiB + 512 * 1024;
constexpr size_t WS_SW2 = 13 * MiB + 512 * 1024;
constexpr size_t WS_DUMP = 2 * MiB + 16384;
constexpr size_t WS_SUMA = 14 * MiB;
constexpr size_t WS_SUMH = WS_SUMA + 2359296;
constexpr size_t WS_CIN = WS_SUMH + 2359296;
constexpr size_t WS_ROUTE = 21 * MiB;
constexpr size_t WS_HIST = 23 * MiB;
constexpr size_t WS_EW13 = 32 * MiB;
constexpr size_t WS_EW2 = 288 * MiB;
constexpr size_t WS_X1 = 416 * MiB;
constexpr size_t WS_HX2 = 544 * MiB;
constexpr size_t WS_LOGIT = 608 * MiB;
constexpr size_t WS_LIST = 1620 * MiB;
constexpr size_t WS_ACT = 674 * MiB;
constexpr size_t WS_YS = 850 * MiB;
constexpr size_t WS_P = 914 * MiB;
constexpr size_t WS_HX = 1166 * MiB;
constexpr size_t WS_OF = 1238 * MiB;
constexpr size_t WS_OB = 1270 * MiB;
constexpr size_t WS_YL = 1302 * MiB;
constexpr size_t WS_YE = 914 * MiB;
constexpr size_t WS_INV = 24 * MiB;
constexpr size_t WS_HX2F = 1684 * MiB;
constexpr size_t WS_END = 1716 * MiB;
constexpr int CW_BAR = 4096;
constexpr int CW_CNT = 16384;

constexpr int RING_BYTES = 131072;
constexpr int LDS_TS = RING_BYTES;
constexpr int LDS_CNT = LDS_TS + 1088;
constexpr int LDS_UT = LDS_CNT + 1024;
constexpr int LDS_IDX = LDS_UT + 192;
constexpr int LDS_MISC = LDS_IDX + 10 * 1024;
constexpr int LDS_BYTES = 155648;
static_assert(LDS_MISC + 64 <= LDS_BYTES, "lds map");

DI unsigned pk2(float lo, float hi) { f32x2 v = {lo, hi}; bfv2 b = __builtin_convertvector(v, bfv2); return __builtin_bit_cast(unsigned, b); }
DI float clamp448(float x) { return __builtin_amdgcn_fmed3f(x, -448.0f, 448.0f); }
DI unsigned pk4_f8(float a, float b, float c, float d) {
    int w = __builtin_amdgcn_cvt_pk_fp8_f32(clamp448(a), clamp448(b), 0, false); w = __builtin_amdgcn_cvt_pk_fp8_f32(clamp448(c), clamp448(d), w, true); return (unsigned)w; }
DI float bflo(unsigned w) { return __uint_as_float(w << 16); }
DI float bfhi(unsigned w) { return __uint_as_float(w & 0xffff0000u); }
DI float bf2f(bf16 h) { return __uint_as_float(((unsigned)h) << 16); }
DI bf16 f2bf(float f) { return (bf16)(pk2(f, 0.f) & 0xffffu); }
DI float rcpf_(float x) { return __builtin_amdgcn_rcpf(x); }
DI float ex2f_(float x) { return __builtin_amdgcn_exp2f(x); }
DI float expf_(float x) { return __builtin_amdgcn_exp2f(x * 1.4426950408889634f); }
DI float logf_(float x) { return __builtin_amdgcn_logf(x) * 0.6931471805599453f; }
DI float sigm(float x) { return rcpf_(1.0f + expf_(-x)); }
DI float wave_sum(float v) {
#pragma unroll
    for (int o = 1; o < 64; o <<= 1) v += __shfl_xor(v, o);
    return v;
}
#define LDS_WAIT() asm volatile("s_waitcnt lgkmcnt(0)" ::: "memory")

#define XB_TMO      128
#define XB_XCNT(j)  (256  + 64 * (j))
#define XB_XSUB(j)  (1280 + 64 * (j))
#define XB_XGEN(j)  (2304 + 64 * (j))
#define XB_TOP      3328
#define XB_TOPGEN   3392
#define XCD_BAR_WORDS 3456
#define XB_SPIN_CAP (1u << 18)
__device__ __forceinline__ unsigned xb_ld(unsigned* p)              { return __hip_atomic_load(p, __ATOMIC_RELAXED, __HIP_MEMORY_SCOPE_AGENT); }
__device__ __forceinline__ unsigned xb_add(unsigned* p, unsigned v) { return __hip_atomic_fetch_add(p, v, __ATOMIC_RELAXED, __HIP_MEMORY_SCOPE_AGENT); }
__device__ __forceinline__ unsigned xb_xcc_id() { return (unsigned)__builtin_amdgcn_s_getreg((3 << 11) | 20) & 0xFu; }
#define XB_SPIN(cond, bar) do { unsigned _sp = 0; while (cond) { __builtin_amdgcn_s_sleep(1); \
    if ((++_sp & 255u) == 0u) { if (xb_ld(&(bar)[XB_TMO])) break; if (_sp > XB_SPIN_CAP) { atomicAdd(&(bar)[XB_TMO], 1u); break; } } } } while (0)
struct XcdBarrier { unsigned* bar; unsigned x; volatile LAS unsigned* st; };
__device__ __forceinline__ XcdBarrier xcd_barrier_post(unsigned* bar, volatile LAS unsigned* st) {
    XcdBarrier b; b.bar = bar; b.x = xb_xcc_id(); b.st = st;
    if (threadIdx.x == 0) (void)xb_add(&bar[XB_XCNT(b.x)], 1u);
    return b;
}
__device__ __forceinline__ void xcd_barrier_complete(unsigned* bar, unsigned x, unsigned& nloc, unsigned& nx) {
    const unsigned G = gridDim.x * gridDim.y * gridDim.z;
    unsigned sum, cnt, mine, sp = 0u;
    for (;;) {
        sum = 0u; cnt = 0u; mine = 0u;
#pragma unroll
        for (unsigned j = 0; j < 16; ++j) { const unsigned c = xb_ld(&bar[XB_XCNT(j)]); sum += c; cnt += (c > 0u) ? 1u : 0u; mine = (j == x) ? c : mine; }
        if (sum == G) break;
        __builtin_amdgcn_s_sleep(1);
        if ((++sp & 255u) == 0u) { if (xb_ld(&bar[XB_TMO])) break; if (sp > XB_SPIN_CAP) { atomicAdd(&bar[XB_TMO], 1u); break; } }
    }
    nloc = mine > 0u ? mine : 1u; nx = cnt > 0u ? cnt : 1u;
}
__device__ __forceinline__ void xcd_barrier(const XcdBarrier& b) {
    asm volatile("s_waitcnt vmcnt(0)" ::: "memory");
    __syncthreads();
    if (threadIdx.x == 0) {
        unsigned* bar = b.bar;
        __builtin_amdgcn_s_waitcnt(0);
        unsigned nloc = b.st[0], nx = b.st[1];
        if (nloc == 0u) { xcd_barrier_complete(bar, b.x, nloc, nx); b.st[0] = nloc; b.st[1] = nx; }
        const unsigned old = xb_add(&bar[XB_XSUB(b.x)], 1u);
        const unsigned gen = old / nloc;
        if (old + 1u == (gen + 1u) * nloc) {
            __builtin_amdgcn_fence(__ATOMIC_RELEASE, "agent");
            asm volatile("s_waitcnt vmcnt(0)" ::: "memory");
            const unsigned og = xb_add(&bar[XB_TOP], 1u);
            const unsigned tg = og / nx;
            if (og + 1u == (tg + 1u) * nx) xb_add(&bar[XB_TOPGEN], 1u);
            else XB_SPIN(xb_ld(&bar[XB_TOPGEN]) == tg, bar);
            __builtin_amdgcn_fence(__ATOMIC_ACQUIRE, "agent");
            xb_add(&bar[XB_XGEN(b.x)], 1u);
            asm volatile("s_waitcnt vmcnt(0)" ::: "memory");
        } else {
            XB_SPIN(xb_ld(&bar[XB_XGEN(b.x)]) == gen, bar);
            __builtin_amdgcn_fence(__ATOMIC_ACQUIRE, "agent");
            asm volatile("s_waitcnt vmcnt(0)" ::: "memory");
        }
    }
    __syncthreads();
}

namespace pg8 {
constexpr int BM = 256, BK = 64, HALF = 128, HTB = HALF * BK * 2, NXCD = 8, WGM = 8;
DI int lds_byte(int r, int c) { const int st = (r >> 4) * 2 + (c >> 5), rr = r & 15, cc = c & 31, ob = rr * 64 + cc * 2; return st * 1024 + (ob ^ (((ob >> 9) & 1) << 5)); }
DI void stage_rc(int b, int& R, int& C) { const int st = b / 1024, sb = b % 1024, swz = sb ^ (((sb >> 9) & 1) << 5); R = (st >> 1) * 16 + swz / 64; C = (st & 1) * 32 + (swz % 64) / 2; }
DI int perm32(int rho) { const int n = rho >> 4, i = rho & 15; return 8 * (i >> 2) + 4 * n + (i & 3); }

struct Unit { int pm, pn, e, rt, ord, nrows; };

struct DenseOrder {
    const char* A; const char* Bt; int K, nM, nN, nwg, G, c;
    DI void init(const void* A_, const void* Bt_, int M, int N, int K_, int G_, int c_) { A = (const char*)A_; Bt = (const char*)Bt_; K = K_; nM = M / BM; nN = N / BM; nwg = nM * nN; G = G_; c = c_; }
    DI bool next(int i, Unit& u) const {
        const long L = (long)i * G + c; if (L >= nwg) return false;
        int wgid = (int)L; { const int q = nwg / NXCD, r = nwg % NXCD, xcd = wgid % NXCD, off = wgid / NXCD; wgid = (xcd < r ? xcd * (q + 1) : r * (q + 1) + (xcd - r) * q) + off; }
        const int nig = WGM * nN, gid = wgid / nig, fm = gid * WGM, gsz = (nM - fm) < WGM ? (nM - fm) : WGM;
        u.pm = fm + ((wgid % nig) % gsz); u.pn = (wgid % nig) / gsz; u.e = 0; u.rt = u.pm; u.ord = i; u.nrows = 256; return true;
    }
    DI const char* a_base(const Unit& u) const { return A + (size_t)u.pm * BM * K * 2; }
    DI const char* b_base(const Unit& u) const { return Bt + (size_t)u.pn * BM * K * 2; }
    static constexpr bool GATHER_A = false;
    DI void a_offs(const Unit&, int tid, unsigned (&v)[2][2]) const {
#pragma unroll
        for (int i = 0; i < 2; ++i) { int R, C; stage_rc(tid * 16 + i * 8192, R, C);
#pragma unroll
            for (int h = 0; h < 2; ++h) v[h][i] = (unsigned)((h * HALF + R) * K + C) * 2u; }
    }
};

template <bool GATHER> struct MoeOrder {
    const char* A; const char* Bt; const char* BtS; int K, ncol; size_t estride;
    const LAS int* ut; const LAS int* idx; int nunits, nfull;
    static constexpr bool GATHER_A = GATHER;
    DI bool next(int i, Unit& u) const {
        if (i >= nunits) return false;
        int j, pn;
        if (i < nfull) { j = i / ncol; pn = i - j * ncol; } else { j = nfull / ncol + (i - nfull); pn = -1; }
        const v4u t = *(const LAS v4u*)(ut + 4 * j);
        u.ord = j; u.e = (int)t.x; u.pm = (int)t.y; u.rt = (int)t.z; u.nrows = (int)(t.w & 0xffffu); u.pn = pn >= 0 ? pn : (int)(t.w >> 16);
        return true;
    }
    DI const char* a_base(const Unit& u) const { return GATHER ? A : A + (size_t)u.rt * BM * K * 2; }
    DI const char* b_base(const Unit& u) const { return (u.e < 256 ? Bt + (size_t)u.e * estride : BtS) + (size_t)u.pn * BM * K * 2; }
    DI void a_offs(const Unit& u, int tid, unsigned (&v)[2][2]) const {
#pragma unroll
        for (int i = 0; i < 2; ++i) { int R, C; stage_rc(tid * 16 + i * 8192, R, C);
#pragma unroll
            for (int h = 0; h < 2; ++h) {
                if (GATHER) v[h][i] = ((unsigned)idx[u.ord * 256 + h * HALF + R] * (unsigned)K + (unsigned)C) * 2u;
                else v[h][i] = (unsigned)((h * HALF + R) * K + C) * 2u; } }
    }
};

struct GProf { unsigned long long t_loop, t_epi, t_next; };
typedef int v8i __attribute__((ext_vector_type(8)));
template <class Epi, class Sched, bool PROF = false, bool F8 = false>
__device__ __forceinline__ void gemm_phase(LAS unsigned char* lds, const int K, const Sched& S, const Epi& E, GProf* prof = nullptr) {
    unsigned long long pt0 = 0, pt1 = 0, pt2 = 0, pt3 = 0;
    const int tid = threadIdx.x, wid = __builtin_amdgcn_readfirstlane(tid >> 6), lane = tid & 63, wr = wid >> 2, wc = wid & 3, fr = lane & 15, fq = lane >> 4;
    const int nt = K / BK;
    unsigned voffBh[2][2];
#pragma unroll
    for (int i = 0; i < 2; ++i) { int R, C; stage_rc(tid * 16 + i * 8192, R, C);
#pragma unroll
        for (int h = 0; h < 2; ++h) { int Rb;
            if (Epi::PERM == 2) Rb = 64 * ((R >> 5) & 3) + 16 * ((R >> 2) & 3) + 8 * h + 4 * ((R >> 4) & 1) + (R & 3);
            else Rb = HALF * h + (Epi::PERM == 1 ? ((R & ~31) + perm32(R & 31)) : R);
            voffBh[h][i] = (unsigned)(Rb * K + C) * 2u; } }
    const size_t kstep = (size_t)(BK * 2);
    const size_t hstep = (size_t)HALF * K * 2;
    const unsigned ldsw = (unsigned)wid * 1024u;
    const int aoff = F8 ? lds_byte(wr * 64 + fr, fq * 16) : lds_byte(wr * 64 + fr, fq * 8), boff = F8 ? lds_byte(wc * 32 + fr, fq * 16) : lds_byte(wc * 32 + fr, fq * 8);
#define PG8_SA(b, h) (((b) * 2 + (h)) * HTB)
#define PG8_SB(b, h) ((4 + (b) * 2 + (h)) * HTB)
#define PG8_STAGE(bufoff, gbase, voff) do { _Pragma("unroll") for (int _i = 0; _i < 2; ++_i) \
        __builtin_amdgcn_global_load_lds((const unsigned*)((const char*)(gbase) + (voff)[_i]), (LAS unsigned*)(lds + (bufoff) + ldsw + _i * 8192), 16, 0, 0); } while (0)
#define PG8_LD8(dst, off) do { const v4u _lo = *(const LAS v4u*)(lds + (off)), _hi = *(const LAS v4u*)(lds + (off) + 16); \
        dst[0] = (int)_lo.x; dst[1] = (int)_lo.y; dst[2] = (int)_lo.z; dst[3] = (int)_lo.w; dst[4] = (int)_hi.x; dst[5] = (int)_hi.y; dst[6] = (int)_hi.z; dst[7] = (int)_hi.w; } while (0)
#define PG8_LDA(dst, b, h) do { if (F8) { _Pragma("unroll") for (int m = 0; m < 4; ++m) PG8_LD8(dst##8[m], PG8_SA(b, h) + aoff + m * 2048); } \
        else { _Pragma("unroll") for (int m = 0; m < 4; ++m) _Pragma("unroll") for (int k = 0; k < 2; ++k) dst[m][k] = *(const LAS bf16x8*)(lds + PG8_SA(b, h) + aoff + m * 2048 + k * 1024); } } while (0)
#define PG8_LDB(dst, b, h) do { if (F8) { _Pragma("unroll") for (int n = 0; n < 2; ++n) PG8_LD8(dst##8[n], PG8_SB(b, h) + boff + n * 2048); } \
        else { _Pragma("unroll") for (int n = 0; n < 2; ++n) _Pragma("unroll") for (int k = 0; k < 2; ++k) dst[n][k] = *(const LAS bf16x8*)(lds + PG8_SB(b, h) + boff + n * 2048 + k * 1024); } } while (0)
#define PG8_MMA(ai, bj, At, Bt) do { __builtin_amdgcn_s_setprio(1); \
        if (F8) { _Pragma("unroll") for (int m = 0; m < 4; ++m) _Pragma("unroll") for (int n = 0; n < 2; ++n) \
            asm volatile("v_mfma_scale_f32_16x16x128_f8f6f4 %0, %1, %2, %0, %3, %3 op_sel_hi:[0,0,0]" : "+v"(acc[ai][bj][m][n]) : "v"(Bt##8[n]), "v"(At##8[m]), "v"(sc127)); } \
        else { _Pragma("unroll") for (int m = 0; m < 4; ++m) _Pragma("unroll") for (int n = 0; n < 2; ++n) _Pragma("unroll") for (int k = 0; k < 2; ++k) \
            acc[ai][bj][m][n] = __builtin_amdgcn_mfma_f32_16x16x32_bf16(Bt[n][k], At[m][k], acc[ai][bj][m][n], 0, 0, 0); } \
        __builtin_amdgcn_s_setprio(0); } while (0)
#define PG8_WAIT_V(n) asm volatile("s_waitcnt vmcnt(" #n ")" ::: "memory")
#define PG8_WAIT_L(n) asm volatile("s_waitcnt lgkmcnt(" #n ")" ::: "memory")
#define PG8_BAR __builtin_amdgcn_s_barrier()
#define PG8_SCHED __builtin_amdgcn_sched_barrier(0)
    Unit cur, nxt; int ui = 0;
    if (!S.next(0, cur)) return;
    f32x4 acc[2][2][4][2];
#pragma unroll
    for (int a = 0; a < 2; ++a)
#pragma unroll
        for (int b = 0; b < 2; ++b)
#pragma unroll
            for (int m = 0; m < 4; ++m)
#pragma unroll
                for (int n = 0; n < 2; ++n) acc[a][b][m][n] = (f32x4){0.f, 0.f, 0.f, 0.f};
    bf16x8 At[4][2], B0[2][2], B1[2][2];
    v8i At8[4], B08[2], B18[2];
    int sc127 = 127; asm volatile("" : "+v"(sc127));
    unsigned vC[2][2], vN[2][2];
    S.a_offs(cur, tid, vC);
    const char* cA = S.a_base(cur); const char* cB = S.b_base(cur);
    PG8_STAGE(PG8_SB(0, 0), cB, voffBh[0]); PG8_STAGE(PG8_SA(0, 0), cA, vC[0]); PG8_STAGE(PG8_SB(0, 1), cB, voffBh[1]); PG8_STAGE(PG8_SA(0, 1), cA, vC[1]);
    if (wr == 1) PG8_BAR;
    PG8_WAIT_V(4); PG8_BAR;
    PG8_STAGE(PG8_SB(1, 0), cB + kstep, voffBh[0]); PG8_STAGE(PG8_SA(1, 0), cA + kstep, vC[0]); PG8_STAGE(PG8_SB(1, 1), cB + kstep, voffBh[1]);
    PG8_WAIT_V(6); PG8_BAR;
    for (;;) {
        if (PROF) pt0 = __builtin_amdgcn_s_memrealtime();
        const bool has_next = S.next(ui + 1, nxt);
        const char* nA = has_next ? S.a_base(nxt) : cA; const char* nB = has_next ? S.b_base(nxt) : cB;
        if (Sched::GATHER_A) { if (has_next) S.a_offs(nxt, tid, vN); else { vN[0][0] = vC[0][0]; vN[0][1] = vC[0][1]; vN[1][0] = vC[1][0]; vN[1][1] = vC[1][1]; } }
        if (PROF) pt1 = __builtin_amdgcn_s_memrealtime();
#pragma unroll 1
        for (int t = 0; t < nt; t += 2) {
            const bool last = (t == nt - 2);
            const char* a1 = cA + (size_t)(t + 1) * kstep;
            const char* a2 = last ? nA : cA + (size_t)(t + 2) * kstep; const char* b2 = last ? nB : cB + (size_t)(t + 2) * kstep;
            const char* a3 = a2 + kstep; const char* b3 = b2 + kstep;
            unsigned x0[2], x1[2];
            if (Sched::GATHER_A) { x0[0] = last ? vN[0][0] : vC[0][0]; x0[1] = last ? vN[0][1] : vC[0][1]; x1[0] = last ? vN[1][0] : vC[1][0]; x1[1] = last ? vN[1][1] : vC[1][1]; }
            else { x0[0] = vC[0][0]; x0[1] = vC[0][1]; x1[0] = vC[1][0]; x1[1] = vC[1][1]; }
            PG8_LDB(B0, 0, 0); PG8_SCHED; PG8_LDA(At, 0, 0); PG8_STAGE(PG8_SA(1, 1), a1, vC[1]);
            PG8_WAIT_L(8); PG8_BAR; PG8_WAIT_L(0); PG8_MMA(0, 0, At, B0); PG8_BAR; PG8_SCHED;
            PG8_LDB(B1, 0, 1); PG8_STAGE(PG8_SB(0, 0), b2, voffBh[0]);
            PG8_BAR; PG8_WAIT_L(0); PG8_MMA(0, 1, At, B1); PG8_BAR;
            PG8_LDA(At, 0, 1); PG8_STAGE(PG8_SA(0, 0), a2, x0);
            PG8_BAR; PG8_WAIT_L(0); PG8_MMA(1, 0, At, B0); PG8_BAR; PG8_SCHED;
            PG8_STAGE(PG8_SB(0, 1), b2, voffBh[1]);
            PG8_WAIT_V(6); PG8_BAR; PG8_MMA(1, 1, At, B1); PG8_BAR;
            PG8_LDB(B0, 1, 0); PG8_SCHED; PG8_LDA(At, 1, 0); PG8_STAGE(PG8_SA(0, 1), a2, x1);
            PG8_WAIT_L(8); PG8_BAR; PG8_WAIT_L(0); PG8_MMA(0, 0, At, B0); PG8_BAR; PG8_SCHED;
            PG8_LDB(B1, 1, 1); PG8_STAGE(PG8_SB(1, 0), b3, voffBh[0]);
            PG8_BAR; PG8_WAIT_L(0); PG8_MMA(0, 1, At, B1); PG8_BAR;
            PG8_LDA(At, 1, 1); PG8_STAGE(PG8_SA(1, 0), a3, x0);
            PG8_BAR; PG8_WAIT_L(0); PG8_MMA(1, 0, At, B0); PG8_BAR; PG8_SCHED;
            PG8_STAGE(PG8_SB(1, 1), b3, voffBh[1]);
            PG8_WAIT_V(6); PG8_BAR; PG8_MMA(1, 1, At, B1); PG8_BAR;
        }
        if (PROF) pt2 = __builtin_amdgcn_s_memrealtime();
        if (F8) asm volatile("s_nop 15\n\ts_nop 15" ::: "memory");
        E(acc, cur, wr, wc, fr, fq);
        if (PROF) { asm volatile("s_waitcnt vmcnt(0)" ::: "memory"); pt3 = __builtin_amdgcn_s_memrealtime(); prof->t_next += pt1 - pt0; prof->t_loop += pt2 - pt1; prof->t_epi += pt3 - pt2; }
        if (!has_next) break;
#pragma unroll
        for (int a = 0; a < 2; ++a)
#pragma unroll
            for (int b = 0; b < 2; ++b)
#pragma unroll
                for (int m = 0; m < 4; ++m)
#pragma unroll
                    for (int n = 0; n < 2; ++n) acc[a][b][m][n] = (f32x4){0.f, 0.f, 0.f, 0.f};
        cur = nxt; cA = nA; cB = nB; ++ui;
        if (Sched::GATHER_A) { vC[0][0] = vN[0][0]; vC[0][1] = vN[0][1]; vC[1][0] = vN[1][0]; vC[1][1] = vN[1][1]; }
    }
    PG8_WAIT_V(0);
    if (wr == 0) PG8_BAR;
    PG8_BAR;
#undef PG8_SA
#undef PG8_SB
#undef PG8_STAGE
#undef PG8_LD8
#undef PG8_LDA
#undef PG8_LDB
#undef PG8_MMA
#undef PG8_WAIT_V
#undef PG8_WAIT_L
#undef PG8_BAR
#undef PG8_SCHED
}

DI float gelu_tanh(float x) { const float u = 1.5957691216f * (x + 0.044715f * x * x * x); return x * rcpf_(1.0f + expf_(-u)); }
DI float silu_f(float x) { return x * rcpf_(1.0f + expf_(-x)); }

struct EpiInProj {
    static constexpr int PERM = 1;
    bf16* P; const float* LB;
    DI void operator()(const f32x4 (&acc)[2][2][4][2], const Unit& u, int wr, int wc, int fr, int fq) const {
        const int row0 = u.pm * BM + wr * 64 + fr, col0 = u.pn * BM + wc * 32 + 8 * fq;
        const int pn = u.pn;
        const int kind = (pn == 2 || pn == 3) ? 1 : (pn >= 8 && pn < 12) ? 2 : (pn >= 12) ? 3 : 0;
        f32x4 lbv[2][2];
        { const int dir = (pn >> 1) & 1; const int cc = (pn & 1) * 256 + wc * 32 + 8 * fq;
#pragma unroll
            for (int bj = 0; bj < 2; ++bj)
#pragma unroll
                for (int n = 0; n < 2; ++n) lbv[bj][n] = *(const f32x4*)(LB + dir * 512 + cc + bj * HALF + 4 * n);
            asm volatile("" :: "v"(lbv[0][0]), "v"(lbv[0][1]), "v"(lbv[1][0]), "v"(lbv[1][1])); }
#pragma unroll
        for (int ai = 0; ai < 2; ++ai)
#pragma unroll
            for (int m = 0; m < 4; ++m) { bf16* rowp = P + (size_t)(row0 + ai * HALF + m * 16) * INC + col0;
#pragma unroll
                for (int bj = 0; bj < 2; ++bj) { f32x4 v0 = acc[ai][bj][m][0], v1 = acc[ai][bj][m][1];
                    if (kind == 1) {
#pragma unroll
                        for (int j = 0; j < 4; ++j) { v0[j] = gelu_tanh(v0[j]); v1[j] = gelu_tanh(v1[j]); } }
                    else if (kind == 2) {
#pragma unroll
                        for (int j = 0; j < 4; ++j) { const float l0 = lbv[bj][0][j], l1 = lbv[bj][1][j];
                            v0[j] = logf_(l0 + (1.0f - l0) * sigm(v0[j])); v1[j] = logf_(l1 + (1.0f - l1) * sigm(v1[j])); } }
                    else if (kind == 3) {
#pragma unroll
                        for (int j = 0; j < 4; ++j) { v0[j] = silu_f(v0[j]); v1[j] = silu_f(v1[j]); } }
                    v4u w; w.x = pk2(v0[0], v0[1]); w.y = pk2(v0[2], v0[3]); w.z = pk2(v1[0], v1[1]); w.w = pk2(v1[2], v1[3]);
                    *(v4u*)(rowp + bj * HALF) = w; } }
    }
};
struct EpiResid {
    static constexpr int PERM = 0;
    const float* x; const float* mod; float* X1;
    DI void operator()(const f32x4 (&acc)[2][2][4][2], const Unit& u, int wr, int wc, int fr, int fq) const {
        const int row0 = u.pm * BM + wr * 64 + fr, col0 = u.pn * BM + wc * 32 + 4 * fq;
        const int b = (u.pm * BM) >> 11;
        f32x4 gv[2][2];
#pragma unroll
        for (int bj = 0; bj < 2; ++bj)
#pragma unroll
            for (int n = 0; n < 2; ++n) gv[bj][n] = *(const f32x4*)(mod + (size_t)b * 6144 + 2048 + col0 + bj * HALF + n * 16);
#pragma unroll
        for (int ai = 0; ai < 2; ++ai)
#pragma unroll
            for (int m = 0; m < 4; ++m) { const size_t off = (size_t)(row0 + ai * HALF + m * 16) * D + col0;
#pragma unroll
                for (int bj = 0; bj < 2; ++bj)
#pragma unroll
                    for (int n = 0; n < 2; ++n) { const f32x4 xv = *(const f32x4*)(x + off + bj * HALF + n * 16);
                        *(f32x4*)(X1 + off + bj * HALF + n * 16) = xv + gv[bj][n] * acc[ai][bj][m][n]; } }
    }
};
struct EpiF32 {
    static constexpr int PERM = 0;
    float* C; int ldc;
    DI void operator()(const f32x4 (&acc)[2][2][4][2], const Unit& u, int wr, int wc, int fr, int fq) const {
        const int row0 = u.pm * BM + wr * 64 + fr, col0 = u.pn * BM + wc * 32 + 4 * fq;
#pragma unroll
        for (int ai = 0; ai < 2; ++ai)
#pragma unroll
            for (int m = 0; m < 4; ++m) { float* rowp = C + (size_t)(row0 + ai * HALF + m * 16) * ldc + col0;
#pragma unroll
                for (int bj = 0; bj < 2; ++bj)
#pragma unroll
                    for (int n = 0; n < 2; ++n) *(f32x4*)(rowp + bj * HALF + n * 16) = acc[ai][bj][m][n]; }
    }
};
struct EpiSwiGLU8 {
    static constexpr int PERM = 1;
    unsigned char* ACT;
    DI void operator()(const f32x4 (&acc)[2][2][4][2], const Unit& u, int wr, int wc, int fr, int fq) const {
        const unsigned off0 = ((unsigned)u.rt * 256u + (unsigned)(wr * 64 + fr)) * (unsigned)DE + (unsigned)(u.pn * 128 + wc * 32 + 8 * fq);
#pragma unroll
        for (int ai = 0; ai < 2; ++ai)
#pragma unroll
            for (int m = 0; m < 4; ++m) {
                f32x4 a0 = acc[ai][0][m][0] * 0.03125f, a1 = acc[ai][0][m][1] * 0.03125f; const f32x4 g0 = acc[ai][1][m][0] * 0.25f, g1 = acc[ai][1][m][1] * 0.25f;
#pragma unroll
                for (int j = 0; j < 4; ++j) { a0[j] = silu_f(a0[j]) * g0[j]; a1[j] = silu_f(a1[j]) * g1[j]; }
                v2u w; w.x = pk4_f8(a0[0], a0[1], a0[2], a0[3]); w.y = pk4_f8(a1[0], a1[1], a1[2], a1[3]);
                *(v2u*)(ACT + (off0 + (unsigned)((ai * HALF + m * 16) * DE))) = w; }
    }
};
struct EpiSwiGLU {
    static constexpr int PERM = 1;
    bf16* ACT;
    DI void operator()(const f32x4 (&acc)[2][2][4][2], const Unit& u, int wr, int wc, int fr, int fq) const {
        const int row0 = wr * 64 + fr, col0 = u.pn * 128 + wc * 32 + 8 * fq;
        bf16* base = ACT + (size_t)u.rt * 256 * DE;
#pragma unroll
        for (int ai = 0; ai < 2; ++ai)
#pragma unroll
            for (int m = 0; m < 4; ++m) { bf16* rowp = base + (size_t)(row0 + ai * HALF + m * 16) * DE + col0;
                f32x4 a0 = acc[ai][0][m][0], a1 = acc[ai][0][m][1]; const f32x4 g0 = acc[ai][1][m][0], g1 = acc[ai][1][m][1];
#pragma unroll
                for (int j = 0; j < 4; ++j) { a0[j] = silu_f(a0[j]) * g0[j]; a1[j] = silu_f(a1[j]) * g1[j]; }
                v4u w; w.x = pk2(a0[0], a0[1]); w.y = pk2(a0[2], a0[3]); w.z = pk2(a1[0], a1[1]); w.w = pk2(a1[2], a1[3]);
                *(v4u*)rowp = w; }
    }
};
struct EpiScatter {
    static constexpr int PERM = 2;
    unsigned char* YE; const LAS float* gate; float oscale;
    DI void operator()(const f32x4 (&acc)[2][2][4][2], const Unit& u, int wr, int wc, int fr, int fq) const {
        const unsigned col0 = (unsigned)(u.pn * BM + wc * 64 + 16 * fq);
        float gt[2][4];
#pragma unroll
        for (int ai = 0; ai < 2; ++ai)
#pragma unroll
            for (int m = 0; m < 4; ++m) gt[ai][m] = gate[u.ord * 256 + ai * HALF + wr * 64 + m * 16 + fr] * oscale;
#pragma unroll
        for (int ai = 0; ai < 2; ++ai)
#pragma unroll
            for (int m = 0; m < 4; ++m) { const int r = ai * HALF + wr * 64 + m * 16 + fr; const float g = gt[ai][m];
                const unsigned row = (r < u.nrows) ? (unsigned)u.rt * 256u + (unsigned)r : 360448u;
                const f32x4 v0 = acc[ai][0][m][0] * g, v1 = acc[ai][0][m][1] * g, v2 = acc[ai][1][m][0] * g, v3 = acc[ai][1][m][1] * g;
                v4u w; w.x = pk4_f8(v0[0], v0[1], v0[2], v0[3]); w.y = pk4_f8(v1[0], v1[1], v1[2], v1[3]); w.z = pk4_f8(v2[0], v2[1], v2[2], v2[3]); w.w = pk4_f8(v3[0], v3[1], v3[2], v3[3]);
                *(v4u*)(YE + (row * (unsigned)D + col0)) = w; }
    }
};
}

struct Args { const float* in[26]; float* out; unsigned char* ws; int ph_lo, ph_hi; };
enum { I_X = 0, I_C, I_CTX, I_CCTX, I_ADAW, I_ADAB, I_NMIX, I_NFFN, I_NFIN, I_WIN, I_WOUT, I_CONVW, I_CONVB, I_WA, I_BA, I_WX, I_BX, I_LAM,
       I_LBL, I_HNORM, I_RW, I_RB, I_EW13, I_EW2, I_SW13, I_SW2 };

struct Frame {
    LAS unsigned char* lds;
    int tid, lane, wave, G, vcu, bx;
    const float* const* in; float* out; unsigned char* ws;
};

DI void transpose_item(const float* W, int ldw, bf16* WT, int ldo, int k0, int n0, int orow0, LAS float* scr, int lane) {
    const int sub = lane >> 3, c4 = (lane & 7) * 4;
    f32x4 v[8];
#pragma unroll
    for (int i = 0; i < 8; ++i) v[i] = __builtin_nontemporal_load((const f32x4*)(W + (size_t)(k0 + 8 * i + sub) * ldw + n0 + c4));
#pragma unroll
    for (int i = 0; i < 8; ++i) { LAS float* d = scr + (8 * i + sub) * 33 + c4; d[0] = v[i].x; d[1] = v[i].y; d[2] = v[i].z; d[3] = v[i].w; }
    LDS_WAIT(); asm volatile("" ::: "memory");
    const int c = lane & 7;
#pragma unroll
    for (int j = 0; j < 4; ++j) { const int n = (lane >> 3) + 8 * j; const LAS float* s = scr + (8 * c) * 33 + n;
        v4u o; o.x = pk2(s[0 * 33], s[1 * 33]); o.y = pk2(s[2 * 33], s[3 * 33]); o.z = pk2(s[4 * 33], s[5 * 33]); o.w = pk2(s[6 * 33], s[7 * 33]);
        *(v4u*)(WT + (size_t)(orow0 + n) * ldo + k0 + 8 * c) = o; }
    LDS_WAIT(); asm volatile("" ::: "memory");
}
DI void transpose_item8(const float* W, int ldw, unsigned char* WT, int ldo, int k0, int n0, int orow0, float scale, LAS float* scr, int lane) {
    const int sub = lane >> 3, c4 = (lane & 7) * 4;
    f32x4 v[16];
#pragma unroll
    for (int i = 0; i < 16; ++i) v[i] = __builtin_nontemporal_load((const f32x4*)(W + (size_t)(k0 + 8 * i + sub) * ldw + n0 + c4));
#pragma unroll
    for (int i = 0; i < 16; ++i) { LAS float* d = scr + (8 * i + sub) * 33 + c4; d[0] = v[i].x; d[1] = v[i].y; d[2] = v[i].z; d[3] = v[i].w; }
    LDS_WAIT(); asm volatile("" ::: "memory");
    const int c = lane & 7;
#pragma unroll
    for (int j = 0; j < 4; ++j) { const int n = (lane >> 3) + 8 * j; const LAS float* sp = scr + (16 * c) * 33 + n;
        v4u o; o.x = pk4_f8(sp[0] * scale, sp[33] * scale, sp[66] * scale, sp[99] * scale); o.y = pk4_f8(sp[132] * scale, sp[165] * scale, sp[198] * scale, sp[231] * scale);
        o.z = pk4_f8(sp[264] * scale, sp[297] * scale, sp[330] * scale, sp[363] * scale); o.w = pk4_f8(sp[396] * scale, sp[429] * scale, sp[462] * scale, sp[495] * scale);
        *(v4u*)(WT + (size_t)(orow0 + n) * ldo + k0 + 16 * c) = o; }
    LDS_WAIT(); asm volatile("" ::: "memory");
}
DI int w13_row(int n) { const int half = n >> 8, idx = n & 255; return 256 * (idx >> 7) + 128 * half + (idx & 127); }

DI void phase_prologue(const Frame& F) {
    const float* const* in = F.in; unsigned char* ws = F.ws;
    {
        LAS float* sc = (LAS float*)F.lds;
        LAS float* red = (LAS float*)(F.lds + 17 * 1024 * 4);
        for (int i = F.tid; i < 17 * 1024; i += NTHR) { const int r = i >> 10, k = i & 1023; const float v = (r < 16) ? in[I_C][r * 1024 + k] : in[I_CCTX][k]; sc[i] = v / (1.0f + __expf(-v)); }
        __syncthreads();
        const float* aw = in[I_ADAW]; float* MOD = (float*)(ws + WS_MOD);
        for (int cg = F.bx; cg < 256; cg += F.G) {
            const int kg = F.tid >> 5, cl = F.tid & 31, col = cg * 24 + cl;
            float a[17];
#pragma unroll
            for (int r = 0; r < 17; ++r) a[r] = 0.f;
            if (cl < 24) {
                for (int kk = 0; kk < 64; ++kk) { const int k = kg * 64 + kk; const float w = aw[(size_t)k * 6144 + col];
#pragma unroll
                    for (int r = 0; r < 17; ++r) a[r] += sc[r * 1024 + k] * w; }
#pragma unroll
                for (int r = 0; r < 17; ++r) red[(kg * 17 + r) * 24 + cl] = a[r];
            }
            __syncthreads();
            if (F.tid < 17 * 24) { const int r = F.tid / 24, c2 = F.tid % 24; float s = 0.f;
                for (int g = 0; g < 16; ++g) s += red[(g * 17 + r) * 24 + c2];
                MOD[r * 6144 + cg * 24 + c2] = s + in[I_ADAB][cg * 24 + c2]; }
            __syncthreads();
        }
    }
    {
        float* LB = (float*)(ws + WS_TAB); float* SP = LB + 1024;
        const int gt = F.bx * NTHR + F.tid, GT = F.G * NTHR;
        for (int i = gt; i < 1024; i += GT) { const int d = i >> 9, c = i & 511;
            const float l0 = in[I_LBL][(d * 2 + 0) * 512 + c], l1 = in[I_LBL][(d * 2 + 1) * 512 + c];
            LB[i] = 1.0f / (1.0f + expf(l1 - l0));
            SP[i] = log1pf(expf(-in[I_LAM][i])); }
        bf16* WGT = (bf16*)(ws + WS_WGT);
        for (int i = gt; i < 2 * 2 * 8 * 64 * 64; i += GT) { const int ii = i & 63, j = (i >> 6) & 63, h = (i >> 12) & 7, g = (i >> 15) & 1, d = i >> 16;
            const float* src = g ? in[I_WX] : in[I_WA];
            WGT[i] = f2bf(src[((size_t)(d * 8 + h) * 64 + ii) * 64 + j]); }
    }
    {
        LAS float* scr = (LAS float*)(F.lds + F.wave * 16896);
        const int gw = F.vcu * NWAVES + F.wave, NGW = F.G * NWAVES;
        constexpr int IT_WIN = 16 * 112, IT_WOUT = 16 * 32, IT_WR = 16 * 8, IT_SW13 = 8 * 16, IT_SW2 = 2 * 32;
        LAS float* scr8 = (LAS float*)(F.lds + F.wave * 16896);
        constexpr int NIT = IT_WIN + IT_WOUT + IT_WR + IT_SW13 + IT_SW2;
        for (int it = gw; it < NIT; it += NGW) {
            int r = it;
            if (r < IT_WIN) { const int kb = r / 112, nb = r % 112; transpose_item(in[I_WIN], INC, (bf16*)(ws + WS_WIN), 1024, kb * 64, nb * 32, nb * 32, scr, F.lane); continue; } r -= IT_WIN;
            if (r < IT_WOUT) { const int kb = r / 32, nb = r % 32; transpose_item(in[I_WOUT], 1024, (bf16*)(ws + WS_WOUT), 1024, kb * 64, nb * 32, nb * 32, scr, F.lane); continue; } r -= IT_WOUT;
            if (r < IT_WR) { const int kb = r / 8, nb = r % 8; transpose_item(in[I_RW], 256, (bf16*)(ws + WS_WR), 1024, kb * 64, nb * 32, nb * 32, scr, F.lane); continue; } r -= IT_WR;
            if (r < IT_SW13) { const int kb = r / 16, nb = r % 16; transpose_item8(in[I_SW13], 512, ws + WS_SW13, 1024, kb * 128, nb * 32, w13_row(nb * 32), 32.0f, scr8, F.lane); continue; } r -= IT_SW13;
            { const int kb = r / 32, nb = r % 32; transpose_item8(in[I_SW2], 1024, ws + WS_SW2, 256, kb * 128, nb * 32, nb * 32, 16.0f, scr8, F.lane); }
        }
    }
}
DI void convert_experts(const Frame& F, int gw, int NGW) {
    const float* const* in = F.in; unsigned char* ws = F.ws;
    LAS float* scr = (LAS float*)(F.lds + F.wave * 16896);
    constexpr int IT_E13 = 256 * 128, IT_E2 = 256 * 64;
    for (int it = gw; it < IT_E13 + IT_E2; it += NGW) {
        int r = it;
        if (r < IT_E13) { const int e = r >> 7, q = r & 127, kb = q >> 4, nb = q & 15;
            transpose_item8(in[I_EW13] + (size_t)e * 1024 * 512, 512, ws + WS_EW13 + (size_t)e * 512 * 1024, 1024, kb * 128, nb * 32, w13_row(nb * 32), 32.0f, scr, F.lane); continue; } r -= IT_E13;
        { const int e = r >> 6, q = r & 63, kb = q >> 5, nb = q & 31;
            transpose_item8(in[I_EW2] + (size_t)e * 256 * 1024, 1024, ws + WS_EW2 + (size_t)e * 1024 * 256, 256, kb * 128, nb * 32, nb * 32, 16.0f, scr, F.lane); }
    }
}

DI void phase_norm_rows(const Frame& F, int mode) {
    const float* MOD = (const float*)(F.ws + WS_MOD);
    const int gw = F.bx * NWAVES + F.wave, NGW = F.G * NWAVES;
    const int nrows = mode == 0 ? MTOT : NTOK;
    const float* gain = mode == 0 ? F.in[I_NMIX] : F.in[I_NFFN];
    bf16* dst = (bf16*)(F.ws + (mode == 0 ? WS_HX : WS_HX2));
    const int sh_off = mode == 0 ? 0 : 3072, sc_off = mode == 0 ? 1024 : 4096;
    for (int m = gw; m < nrows; m += NGW) {
        const float* src; int mr;
        if (mode == 0) { if (m < NTOK) { src = F.in[I_X] + (size_t)m * D; mr = m >> 11; } else { src = F.in[I_CTX] + (size_t)(m - NTOK) * D; mr = 16; } }
        else { src = (const float*)(F.ws + WS_X1) + (size_t)m * D; mr = m >> 11; }
        f32x4 v[4]; float ss = 0.f;
#pragma unroll
        for (int j = 0; j < 4; ++j) { v[j] = *(const f32x4*)(src + 4 * F.lane + 256 * j); ss += (v[j].x * v[j].x + v[j].y * v[j].y) + (v[j].z * v[j].z + v[j].w * v[j].w); }
        const float rs = rsqrtf(wave_sum(ss) * (1.0f / D) + EPS);
#pragma unroll
        for (int j = 0; j < 4; ++j) { const int c = 4 * F.lane + 256 * j;
            const f32x4 gn = *(const f32x4*)(gain + c), sc = *(const f32x4*)(MOD + mr * 6144 + sc_off + c), sh = *(const f32x4*)(MOD + mr * 6144 + sh_off + c);
            const f32x4 y = (v[j] * rs) * gn * (sc + 1.0f) + sh;
            v2u w; w.x = pk2(y.x, y.y); w.y = pk2(y.z, y.w);
            *(v2u*)(dst + (size_t)m * D + c) = w;
            if (mode == 1) *(unsigned*)(F.ws + WS_HX2F + (size_t)m * D + c) = pk4_f8(y.x, y.y, y.z, y.w); }
    }
}

constexpr int LT_STR = 520;
constexpr int L_RT = 0;
constexpr int L_GT = 69888;
static_assert(L_GT + 64 * LT_STR * 2 <= LDS_MISC, "lru lds");
template <bool FINAL> DI void lru_tile(const Frame& F, int b, int s) {
    const bf16* P = (const bf16*)(F.ws + WS_P);
    const int h = F.wave, fr = F.lane & 15, fq = F.lane >> 4;
    int prow0, L, t0;
    if (s < 4) { prow0 = NTOK + b * CTXL + 64 * s; L = CTXL; t0 = 64 * s; } else { prow0 = b * SEQ + 64 * (s - 4); L = SEQ; t0 = 64 * (s - 4); }
    LAS bf16* RT = (LAS bf16*)(F.lds + L_RT); LAS bf16* GT = (LAS bf16*)(F.lds + L_GT);
#pragma unroll
    for (int it = 0; it < 9; ++it) { const int p = F.tid + it * NTHR;
        if (p < 67 * 64) { const int row = p >> 6, pc = p & 63, ts = t0 + row - 1;
            v4u v = {0u, 0u, 0u, 0u};
            if (ts >= 0 && ts < L) v = *(const v4u*)(P + (size_t)(prow0 + row - 1) * INC + 8 * pc);
            *(LAS v4u*)(RT + row * LT_STR + 8 * pc) = v; } }
    if (FINAL) {
#pragma unroll
        for (int it = 0; it < 8; ++it) { const int p = F.tid + it * NTHR; const int row = p >> 6, pc = p & 63;
            *(LAS v4u*)(GT + row * LT_STR + 8 * pc) = *(const v4u*)(P + (size_t)(prow0 + row) * INC + 512 + 8 * pc); } }
    __syncthreads();
    bf16x8 Af[4][2];
#pragma unroll
    for (int ks = 0; ks < 2; ++ks) {
        const int c0 = 64 * h + 32 * ks + 8 * fq;
        float cw[4][8], cb[8];
#pragma unroll
        for (int k = 0; k < 4; ++k) { const f32x4 w0 = *(const f32x4*)(F.in[I_CONVW] + k * 512 + c0), w1 = *(const f32x4*)(F.in[I_CONVW] + k * 512 + c0 + 4);
            cw[k][0] = w0.x; cw[k][1] = w0.y; cw[k][2] = w0.z; cw[k][3] = w0.w; cw[k][4] = w1.x; cw[k][5] = w1.y; cw[k][6] = w1.z; cw[k][7] = w1.w; }
        { const f32x4 w0 = *(const f32x4*)(F.in[I_CONVB] + c0), w1 = *(const f32x4*)(F.in[I_CONVB] + c0 + 4);
            cb[0] = w0.x; cb[1] = w0.y; cb[2] = w0.z; cb[3] = w0.w; cb[4] = w1.x; cb[5] = w1.y; cb[6] = w1.z; cb[7] = w1.w; }
        const LAS bf16* rbase = RT + fr * LT_STR + c0;
#pragma unroll
        for (int tt = 0; tt < 4; ++tt) {
            float u[8];
#pragma unroll
            for (int j = 0; j < 8; ++j) u[j] = cb[j];
#pragma unroll
            for (int k = 0; k < 4; ++k) { const v4u r8 = *(const LAS v4u*)(rbase + (16 * tt + k) * LT_STR);
                u[0] += cw[k][0] * bflo(r8.x); u[1] += cw[k][1] * bfhi(r8.x); u[2] += cw[k][2] * bflo(r8.y); u[3] += cw[k][3] * bfhi(r8.y);
                u[4] += cw[k][4] * bflo(r8.z); u[5] += cw[k][5] * bfhi(r8.z); u[6] += cw[k][6] * bflo(r8.w); u[7] += cw[k][7] * bfhi(r8.w); }
            v4u w; w.x = pk2(u[0], u[1]); w.y = pk2(u[2], u[3]); w.z = pk2(u[4], u[5]); w.w = pk2(u[6], u[7]);
            Af[tt][ks] = __builtin_bit_cast(bf16x8, w);
        }
    }
    const bf16* WGT = (const bf16*)(F.ws + WS_WGT);
    const float* SP = (const float*)(F.ws + WS_TAB) + 1024;
    LAS bf16* HL = RT;
    LAS bf16* hlb = HL + (4 * fq) * LT_STR + 64 * h + fr;
    LAS bf16* gtb = GT + (4 * fq) * LT_STR + 64 * h + fr;
#pragma unroll 1
    for (int dir = 0; dir < 2; ++dir) {
#pragma unroll 1
        for (int nt = 0; nt < 4; ++nt) {
            const int cj = 64 * h + 16 * nt + fr;
            bf16x8 Ba[2], Bx[2], Id[2];
#pragma unroll
            for (int ks = 0; ks < 2; ++ks) {
                Ba[ks] = *(const bf16x8*)(WGT + ((size_t)((dir * 2 + 0) * 8 + h) * 64 + 16 * nt + fr) * 64 + 32 * ks + 8 * fq);
                Bx[ks] = *(const bf16x8*)(WGT + ((size_t)((dir * 2 + 1) * 8 + h) * 64 + 16 * nt + fr) * 64 + 32 * ks + 8 * fq);
#pragma unroll
                for (int jj = 0; jj < 8; ++jj) Id[ks][jj] = (32 * ks + 8 * fq + jj == 16 * nt + fr) ? (short)0x3F80 : (short)0;
            }
            const float ba = F.in[I_BA][dir * 512 + cj], bx = F.in[I_BX][dir * 512 + cj], sp = SP[dir * 512 + cj];
            float cin = 0.f, ptot = 1.f;
            if (FINAL) cin = ((const float*)(F.ws + WS_CIN))[((size_t)(dir * NB + b) * NSEQT + s) * 512 + cj];
#pragma unroll
            for (int tti = 0; tti < 4; ++tti) {
                const int tt = dir ? 3 - tti : tti;
                const bf16x8 A0 = dir ? Af[3 - tti][0] : Af[tti][0], A1 = dir ? Af[3 - tti][1] : Af[tti][1];
                f32x4 pa = {0.f, 0.f, 0.f, 0.f}, px = {0.f, 0.f, 0.f, 0.f}, uc = {0.f, 0.f, 0.f, 0.f};
                pa = __builtin_amdgcn_mfma_f32_16x16x32_bf16(A0, Ba[0], pa, 0, 0, 0); pa = __builtin_amdgcn_mfma_f32_16x16x32_bf16(A1, Ba[1], pa, 0, 0, 0);
                px = __builtin_amdgcn_mfma_f32_16x16x32_bf16(A0, Bx[0], px, 0, 0, 0); px = __builtin_amdgcn_mfma_f32_16x16x32_bf16(A1, Bx[1], px, 0, 0, 0);
                uc = __builtin_amdgcn_mfma_f32_16x16x32_bf16(A0, Id[0], uc, 0, 0, 0); uc = __builtin_amdgcn_mfma_f32_16x16x32_bf16(A1, Id[1], uc, 0, 0, 0);
                float av[4], bv[4];
#pragma unroll
                for (int ri = 0; ri < 4; ++ri) { const float pav = dir ? pa[3 - ri] : pa[ri], pxv = dir ? px[3 - ri] : px[ri], ucv = dir ? uc[3 - ri] : uc[ri];
                    const float rg = sigm(pav + ba), ig = sigm(pxv + bx);
                    const float a = expf_(-8.0f * rg * sp); av[ri] = a; bv[ri] = __builtin_amdgcn_sqrtf(fmaxf(1.0f - a * a, 0.f)) * ig * ucv; }
                float pl = 1.f, hl = 0.f;
#pragma unroll
                for (int ri = 0; ri < 4; ++ri) { hl = av[ri] * hl + bv[ri]; pl *= av[ri]; }
                float pg[4], hg[4];
#pragma unroll
                for (int gi = 0; gi < 4; ++gi) { const int g = dir ? 3 - gi : gi; pg[gi] = __shfl(pl, fr + 16 * g); hg[gi] = __shfl(hl, fr + 16 * g); }
                const int myg = dir ? 3 - fq : fq;
                float mycin = cin, run = cin;
#pragma unroll
                for (int gi = 0; gi < 4; ++gi) { if (gi == myg) mycin = run; run = pg[gi] * run + hg[gi]; }
                if (FINAL) { float hc = mycin;
#pragma unroll
                    for (int ri = 0; ri < 4; ++ri) { const int r = dir ? 3 - ri : ri; hc = av[ri] * hc + bv[ri];
                        const int o = (16 * tt + r) * LT_STR + 16 * nt;
                        if (dir == 0) hlb[o] = f2bf(hc);
                        else gtb[o] = f2bf(bf2f(gtb[o]) * (bf2f(hlb[o]) + hc)); } }
                else ptot *= (pg[0] * pg[1]) * (pg[2] * pg[3]);
                cin = run;
            }
            if (!FINAL && fq == 0) { const size_t o = ((size_t)(dir * NB + b) * NSEQT + s) * 512 + cj;
                ((float*)(F.ws + WS_SUMA))[o] = ptot; ((float*)(F.ws + WS_SUMH))[o] = cin; }
        }
    }
    if (FINAL) {
        __syncthreads();
        bf16* YL = (bf16*)(F.ws + WS_YL);
#pragma unroll
        for (int it = 0; it < 8; ++it) { const int p = F.tid + it * NTHR; const int row = p >> 6, pc = p & 63;
            *(v4u*)(YL + (size_t)(prow0 + row) * D + 8 * pc) = *(const LAS v4u*)(GT + row * LT_STR + 8 * pc); } }
    __syncthreads();
}
DI void phase_lru_pass1(const Frame& F) {
    for (int it = F.bx; it < NB * NSEQT; it += F.G) lru_tile<false>(F, it / NSEQT, it % NSEQT);
}
DI void phase_lru_carry(const Frame& F) {
    if (F.wave != 0) return;
    const float* SA = (const float*)(F.ws + WS_SUMA); const float* SH = (const float*)(F.ws + WS_SUMH); float* CI = (float*)(F.ws + WS_CIN);
    for (int id = F.bx * 64 + F.lane; id < 2 * NB * 512; id += F.G * 64) {
        const int dir = id >> 13, b = (id >> 9) & 15, c = id & 511;
        float x = 0.f; const size_t o0 = (size_t)(dir * NB + b) * NSEQT * 512 + c;
#pragma unroll
        for (int hf = 0; hf < 2; ++hf) {
            float av[18], hv[18];
#pragma unroll
            for (int q = 0; q < 18; ++q) { const int st = 18 * hf + q, s = dir ? (st < 4 ? 3 - st : 39 - st) : st; av[q] = SA[o0 + (size_t)s * 512]; hv[q] = SH[o0 + (size_t)s * 512]; }
#pragma unroll
            for (int q = 0; q < 18; ++q) { const int st = 18 * hf + q, s = dir ? (st < 4 ? 3 - st : 39 - st) : st; CI[o0 + (size_t)s * 512] = x; x = av[q] * x + hv[q]; }
        }
    }
}
DI void phase_lru_pass2(const Frame& F) {
    for (int it = F.bx; it < NB * 32; it += F.G) lru_tile<true>(F, it >> 5, 4 + (it & 31));
}

constexpr int HS = 144, SCS = 40;
constexpr int H_Q = 0, H_LF = H_Q + 32 * HS * 2, H_V = H_LF + 32 * HS * 2, H_QT = H_V + 32 * HS * 2, H_KT = H_QT + 32 * HS * 2, H_KH = H_KT + 32 * HS * 2,
              H_SC = H_KH + 32 * HS * 2, H_DEC = H_SC + 32 * SCS * 2, H_SET = H_DEC + 512;
static_assert(2 * H_SET <= RING_BYTES, "hgrn lds");
typedef short s16x4 __attribute__((ext_vector_type(4)));
DI bf16x8 tr_frag(const LAS bf16* tile, int c0, int lane) {
    const int g = lane >> 4, q = (lane & 15) >> 2, p = lane & 3;
    const LAS bf16* a = tile + (8 * g + q) * HS + c0 + 4 * p;
    const s16x4 lo = __builtin_amdgcn_ds_read_tr16_b64_v4i16((LAS s16x4*)a), hi = __builtin_amdgcn_ds_read_tr16_b64_v4i16((LAS s16x4*)(a + 4 * HS));
    bf16x8 r; r[0] = lo[0]; r[1] = lo[1]; r[2] = lo[2]; r[3] = lo[3]; r[4] = hi[0]; r[5] = hi[1]; r[6] = hi[2]; r[7] = hi[3]; return r;
}
DI void hgrn_chain(const Frame& F, int item) {
    const int b = item >> 3, h = (item >> 1) & 3, dir = item & 1;
    const bf16* P = (const bf16*)(F.ws + WS_P);
    bf16* O = (bf16*)(F.ws + (dir ? WS_OB : WS_OF));
    const int w = F.wave, lane = F.lane, fr = lane & 15, g = lane >> 4;
    const int li = F.tid >> 4, lp = F.tid & 15;
    f32x4 S[8];
#pragma unroll
    for (int t = 0; t < 8; ++t) S[t] = (f32x4){0.f, 0.f, 0.f, 0.f};
    auto prow = [&](int c, int i) -> size_t {
        const int ii = dir ? 31 - i : i;
        if (c < 8) { const int cc = dir ? 7 - c : c; return (size_t)NTOK + b * CTXL + 32 * cc + ii; }
        const int col = dir ? 63 - (c - 8) : (c - 8); return (size_t)b * SEQ + ii * 64 + col; };
    const size_t coff = 128 * h + 8 * lp;
    v4u rqA, rlA, rvA, rqB, rlB, rvB;
    { const bf16* rp = P + prow(0, li) * INC + coff; rqA = *(const v4u*)(rp + 1024); rvA = *(const v4u*)(rp + 1536); rlA = *(const v4u*)(rp + 2048 + 512 * dir); }
    { const bf16* rp = P + prow(1, li) * INC + coff; rqB = *(const v4u*)(rp + 1024); rvB = *(const v4u*)(rp + 1536); rlB = *(const v4u*)(rp + 2048 + 512 * dir); }
    bf16x8 Tri[2];
#pragma unroll
    for (int it = 0; it < 2; ++it)
#pragma unroll
        for (int jj = 0; jj < 8; ++jj) Tri[it][jj] = (8 * g + jj <= 16 * it + fr) ? (short)0x3F80 : (short)0;
#define HG_BODY(c, RQ, RL, RV, SET) do { \
        LAS unsigned char* base = F.lds + (SET) * H_SET; \
        LAS bf16* Qr = (LAS bf16*)(base + H_Q); LAS bf16* LFr = (LAS bf16*)(base + H_LF); LAS bf16* Vr = (LAS bf16*)(base + H_V); \
        LAS bf16* QT = (LAS bf16*)(base + H_QT); LAS bf16* KT = (LAS bf16*)(base + H_KT); LAS bf16* KH = (LAS bf16*)(base + H_KH); \
        LAS bf16* SC = (LAS bf16*)(base + H_SC); LAS float* DEC = (LAS float*)(base + H_DEC); \
        const bool isctx = (c) < 8; \
        *(LAS v4u*)(Qr + li * HS + 8 * lp) = RQ; *(LAS v4u*)(LFr + li * HS + 8 * lp) = RL; *(LAS v4u*)(Vr + li * HS + 8 * lp) = RV; \
        if ((c) + 2 < 72) { const bf16* rp = P + prow((c) + 2, li) * INC + coff; RQ = *(const v4u*)(rp + 1024); RV = *(const v4u*)(rp + 1536); RL = *(const v4u*)(rp + 2048 + 512 * dir); } \
        __syncthreads(); \
        {   \
            const bf16x8 Al = tr_frag(LFr, 16 * w, lane); \
            f32x4 Gm[2]; \
            _Pragma("unroll") for (int it = 0; it < 2; ++it) Gm[it] = __builtin_amdgcn_mfma_f32_16x16x32_bf16(Al, Tri[it], (f32x4){0.f, 0.f, 0.f, 0.f}, 0, 0, 0); \
            f32x4 dec; \
            _Pragma("unroll") for (int r = 0; r < 4; ++r) dec[r] = expf_(__shfl(Gm[1][r], (lane & 48) | 15)); \
            if (fr == 0) *(LAS f32x4*)(DEC + 16 * w + 4 * g) = dec; \
            _Pragma("unroll") for (int it = 0; it < 2; ++it) { const int i = 16 * it + fr, d0 = 16 * w + 4 * g; \
                const v2u q4 = *(const LAS v2u*)(Qr + i * HS + d0), l4 = *(const LAS v2u*)(LFr + i * HS + d0); \
                const float qv[4] = {bflo(q4.x), bfhi(q4.x), bflo(q4.y), bfhi(q4.y)}, lv[4] = {bflo(l4.x), bfhi(l4.x), bflo(l4.y), bfhi(l4.y)}; \
                float qt[4], kt[4], kh[4]; \
                _Pragma("unroll") for (int r = 0; r < 4; ++r) { const float eg = expf_(Gm[it][r]), ieg = rcpf_(eg), kk = 1.0f - expf_(lv[r]); qt[r] = qv[r] * eg; kt[r] = kk * ieg; kh[r] = kk * dec[r] * ieg; } \
                *(LAS v2u*)(QT + i * HS + d0) = (v2u){pk2(qt[0], qt[1]), pk2(qt[2], qt[3])}; \
                *(LAS v2u*)(KT + i * HS + d0) = (v2u){pk2(kt[0], kt[1]), pk2(kt[2], kt[3])}; \
                *(LAS v2u*)(KH + i * HS + d0) = (v2u){pk2(kh[0], kh[1]), pk2(kh[2], kh[3])}; } \
        } \
        __syncthreads(); \
        f32x4 oacc[2]; oacc[0] = (f32x4){0.f, 0.f, 0.f, 0.f}; oacc[1] = (f32x4){0.f, 0.f, 0.f, 0.f}; \
        if (!isctx) { \
            if (w < 4) {   \
                const int it = w >> 1, jt = w & 1; f32x4 sc = {0.f, 0.f, 0.f, 0.f}; \
                _Pragma("unroll") for (int ks = 0; ks < 4; ++ks) { const bf16x8 ak = *(const LAS bf16x8*)(KT + (16 * jt + fr) * HS + 32 * ks + 8 * g), bq = *(const LAS bf16x8*)(QT + (16 * it + fr) * HS + 32 * ks + 8 * g); \
                    sc = __builtin_amdgcn_mfma_f32_16x16x32_bf16(ak, bq, sc, 0, 0, 0); } \
                const int i = 16 * it + fr, j0 = 16 * jt + 4 * g; \
                *(LAS v2u*)(SC + i * SCS + j0) = (v2u){pk2(j0 <= i ? sc[0] : 0.f, j0 + 1 <= i ? sc[1] : 0.f), pk2(j0 + 2 <= i ? sc[2] : 0.f, j0 + 3 <= i ? sc[3] : 0.f)}; } \
              \
            _Pragma("unroll") for (int ks = 0; ks < 4; ++ks) { \
                v4u sb; sb.x = pk2(S[2 * ks][0], S[2 * ks][1]); sb.y = pk2(S[2 * ks][2], S[2 * ks][3]); sb.z = pk2(S[2 * ks + 1][0], S[2 * ks + 1][1]); sb.w = pk2(S[2 * ks + 1][2], S[2 * ks + 1][3]); \
                const bf16x8 As = __builtin_bit_cast(bf16x8, sb); \
                _Pragma("unroll") for (int it = 0; it < 2; ++it) { const v2u a0 = *(const LAS v2u*)(QT + (16 * it + fr) * HS + 32 * ks + 4 * g), a1 = *(const LAS v2u*)(QT + (16 * it + fr) * HS + 32 * ks + 16 + 4 * g); \
                    v4u bv; bv.x = a0.x; bv.y = a0.y; bv.z = a1.x; bv.w = a1.y; \
                    oacc[it] = __builtin_amdgcn_mfma_f32_16x16x32_bf16(As, __builtin_bit_cast(bf16x8, bv), oacc[it], 0, 0, 0); } } \
        } \
          \
        const bf16x8 Vf = tr_frag(Vr, 16 * w, lane); \
        _Pragma("unroll") for (int t = 0; t < 8; ++t) { const f32x4 dv = *(const LAS f32x4*)(DEC + 16 * t + 4 * g); \
            const bf16x8 Kf = tr_frag(KH, 16 * t, lane); \
            S[t] = __builtin_amdgcn_mfma_f32_16x16x32_bf16(Kf, Vf, S[t] * dv, 0, 0, 0); } \
        if (!isctx) { \
            __syncthreads(); \
            const int col = dir ? 63 - ((c) - 8) : ((c) - 8); \
            _Pragma("unroll") for (int it = 0; it < 2; ++it) { const bf16x8 bs = *(const LAS bf16x8*)(SC + (16 * it + fr) * SCS + 8 * g); \
                oacc[it] = __builtin_amdgcn_mfma_f32_16x16x32_bf16(Vf, bs, oacc[it], 0, 0, 0); \
                const int i = 16 * it + fr, ii = dir ? 31 - i : i; \
                *(v2u*)(O + ((size_t)b * SEQ + ii * 64 + col) * 512 + 128 * h + 16 * w + 4 * g) = (v2u){pk2(oacc[it][0], oacc[it][1]), pk2(oacc[it][2], oacc[it][3])}; } \
        } \
    } while (0)
#pragma unroll 1
    for (int c = 0; c < 72; c += 2) {
        HG_BODY(c, rqA, rlA, rvA, 0);
        HG_BODY(c + 1, rqB, rlB, rvB, 1);
    }
#undef HG_BODY
    __syncthreads();
}
DI void phase_hgrn(const Frame& F) {
    for (int it = F.bx; it < NB * 4 * 2; it += F.G) hgrn_chain(F, it);
}
DI void phase_y2(const Frame& F) {
    const bf16* OFp = (const bf16*)(F.ws + WS_OF); const bf16* OBp = (const bf16*)(F.ws + WS_OB); const bf16* P = (const bf16*)(F.ws + WS_P); bf16* YL = (bf16*)(F.ws + WS_YL);
    const int gw = F.bx * NWAVES + F.wave, NGW = F.G * NWAVES;
    const int c = 8 * F.lane;
    const f32x4 g0 = *(const f32x4*)(F.in[I_HNORM] + c), g1 = *(const f32x4*)(F.in[I_HNORM] + c + 4);
    const float gn[8] = {g0.x, g0.y, g0.z, g0.w, g1.x, g1.y, g1.z, g1.w};
    for (int m = gw; m < NTOK; m += NGW) {
        const v4u a = *(const v4u*)(OFp + (size_t)m * 512 + c), bq = *(const v4u*)(OBp + (size_t)m * 512 + c), sg = *(const v4u*)(P + (size_t)m * INC + 3072 + c);
        float o[8] = {bflo(a.x) + bflo(bq.x), bfhi(a.x) + bfhi(bq.x), bflo(a.y) + bflo(bq.y), bfhi(a.y) + bfhi(bq.y), bflo(a.z) + bflo(bq.z), bfhi(a.z) + bfhi(bq.z), bflo(a.w) + bflo(bq.w), bfhi(a.w) + bfhi(bq.w)};
        const float sgv[8] = {bflo(sg.x), bfhi(sg.x), bflo(sg.y), bfhi(sg.y), bflo(sg.z), bfhi(sg.z), bflo(sg.w), bfhi(sg.w)};
        float ss = 0.f;
#pragma unroll
        for (int j = 0; j < 8; ++j) ss += o[j] * o[j];
        ss += __shfl_xor(ss, 1); ss += __shfl_xor(ss, 2); ss += __shfl_xor(ss, 4); ss += __shfl_xor(ss, 8);
        const float rs = rsqrtf(ss * (1.0f / 128.0f) + EPS);
#pragma unroll
        for (int j = 0; j < 8; ++j) o[j] = o[j] * rs * gn[j] * sgv[j];
        v4u wv; wv.x = pk2(o[0], o[1]); wv.y = pk2(o[2], o[3]); wv.z = pk2(o[4], o[5]); wv.w = pk2(o[6], o[7]);
        *(v4u*)(YL + (size_t)m * D + 512 + c) = wv;
    }
}

DI unsigned fkey(float f) { const unsigned u = __float_as_uint(f); return u ^ ((u >> 31) ? 0xFFFFFFFFu : 0x80000000u); }
template <int CTRL> DI unsigned dpp_u(unsigned v) { return (unsigned)__builtin_amdgcn_update_dpp(0, (int)v, CTRL, 0xf, 0xf, true); }
template <int CTRL> DI float dpp_f(float v) { return __uint_as_float(dpp_u<CTRL>(__float_as_uint(v))); }
DI unsigned umax_(unsigned a, unsigned b) { return a > b ? a : b; }
DI float readlane_f(float v, int lane) { return __uint_as_float((unsigned)__builtin_amdgcn_readlane((int)__float_as_uint(v), lane)); }
DI void phase_route(const Frame& F) {
    const float* LOGIT = (const float*)(F.ws + WS_LOGIT); const float* rb = F.in[I_RB];
    v2u* ROUTE = (v2u*)(F.ws + WS_ROUTE); int* HIST = (int*)(F.ws + WS_HIST);
    LAS unsigned* hist = (LAS unsigned*)F.lds;
    const int l = F.lane;
    const f32x4 rbv = *(const f32x4*)(rb + 4 * l);
    const float NEG = -__builtin_inff();
    for (int blk = F.bx; blk < NTOK / 128; blk += F.G) {
        if (F.tid < 256) hist[F.tid] = 0u;
        __syncthreads();
        const int tok0 = blk * 128 + F.wave * 16;
        f32x4 lg = *(const f32x4*)(LOGIT + (size_t)tok0 * NE + 4 * l);
#pragma unroll 1
        for (int ti = 0; ti < 16; ++ti) {
            const int tok = tok0 + ti;
            f32x4 lgn = {0.f, 0.f, 0.f, 0.f};
            if (ti + 1 < 16) lgn = *(const f32x4*)(LOGIT + (size_t)(tok + 1) * NE + 4 * l);
            float sc[4], bs[4];
#pragma unroll
            for (int k = 0; k < 4; ++k) { sc[k] = rcpf_(1.0f + expf_(-lg[k])); bs[k] = sc[k] + rbv[k]; }
            float m1 = NEG, m2 = NEG;
#pragma unroll
            for (int k = 0; k < 4; ++k) { const float v = bs[k]; if (v > m1) { m2 = m1; m1 = v; } else if (v > m2) m2 = v; }
            { float o1 = dpp_f<0xB1>(m1), o2 = dpp_f<0xB1>(m2); float n1 = fmaxf(m1, o1), n2 = fmaxf(fminf(m1, o1), fmaxf(m2, o2)); m1 = n1; m2 = n2;
              o1 = dpp_f<0x4E>(m1); o2 = dpp_f<0x4E>(m2); n1 = fmaxf(m1, o1); n2 = fmaxf(fminf(m1, o1), fmaxf(m2, o2)); m1 = n1; m2 = n2;
              const float a1 = dpp_f<0x104>(m1), a2 = dpp_f<0x104>(m2), c1 = dpp_f<0x114>(m1), c2 = dpp_f<0x114>(m2);
              o1 = (l & 4) ? c1 : a1; o2 = (l & 4) ? c2 : a2; n1 = fmaxf(m1, o1); n2 = fmaxf(fminf(m1, o1), fmaxf(m2, o2)); m1 = n1; m2 = n2; }
            const float gs = m1 + m2; const int g = l >> 3; int rank = 0;
#pragma unroll
            for (int gg = 0; gg < 8; ++gg) { const float og = readlane_f(gs, gg * 8); rank += (og > gs || (og == gs && gg < g)) ? 1 : 0; }
            const bool sel = rank < 4;
            unsigned cv[4];
#pragma unroll
            for (int k = 0; k < 4; ++k) cv[k] = sel ? fkey(bs[k]) : 0u;
            float sum = 0.f, mysc = 0.f; int myexp = 0;
#pragma unroll
            for (int r = 0; r < TOPK; ++r) {
                unsigned bvk = cv[0]; int bk = 0;
#pragma unroll
                for (int k = 1; k < 4; ++k) if (cv[k] > bvk) { bvk = cv[k]; bk = k; }
                const float bsc = bk == 0 ? sc[0] : bk == 1 ? sc[1] : bk == 2 ? sc[2] : sc[3];
                unsigned m = bvk;
                m = umax_(m, dpp_u<0xB1>(m)); m = umax_(m, dpp_u<0x4E>(m)); m = umax_(m, dpp_u<0x124>(m)); m = umax_(m, dpp_u<0x128>(m));
                const unsigned M = umax_(umax_((unsigned)__builtin_amdgcn_readlane((int)m, 0), (unsigned)__builtin_amdgcn_readlane((int)m, 16)),
                                         umax_((unsigned)__builtin_amdgcn_readlane((int)m, 32), (unsigned)__builtin_amdgcn_readlane((int)m, 48)));
                const unsigned long long bal = __ballot(bvk == M);
                const int L = __builtin_ctzll(bal);
                const int kL = __builtin_amdgcn_readlane(bk, L);
                const float se = readlane_f(bsc, L);
                const int e = 4 * L + kL;
                if (l == L) {
#pragma unroll
                    for (int k = 0; k < 4; ++k) if (k == bk) cv[k] = 0u; }
                sum += se; if (l == r) { myexp = e; mysc = se; }
            }
            if (l < TOPK) { ROUTE[(size_t)tok * TOPK + l] = (v2u){(unsigned)myexp, __float_as_uint(mysc * rcpf_(sum) * 2.5f)}; (void)__hip_atomic_fetch_add(hist + myexp, 1u, __ATOMIC_RELAXED, __HIP_MEMORY_SCOPE_WORKGROUP); }
            lg = lgn;
        }
        __syncthreads();
        if (F.tid < 256) HIST[blk * 256 + F.tid] = (int)hist[F.tid];
        __syncthreads();
    }
}
DI void phase_lists(const Frame& F) {
    const v2u* ROUTE = (const v2u*)(F.ws + WS_ROUTE); const int* HIST = (const int*)(F.ws + WS_HIST);
    unsigned* cnt = (unsigned*)(F.ws + WS_CTL) + CW_CNT; v2u* LIST = (v2u*)(F.ws + WS_LIST);
    LAS int* part = (LAS int*)F.lds;
    LAS int* lbase = part + 1024; LAS unsigned* lcnt = (LAS unsigned*)(lbase + 256); LAS int* ltot = lbase + 512; LAS int* lts = lbase + 768;
    int* INV = (int*)(F.ws + WS_INV);
    for (int blk = F.bx; blk < NTOK / 128; blk += F.G) {
        const int e = F.tid & 255, hf = F.tid >> 8;
        int below = 0, all = 0;
#pragma unroll 8
        for (int q = 0; q < 128; ++q) { const int row = hf * 128 + q; const int v = HIST[row * 256 + e]; all += v; below += (row < blk) ? v : 0; }
        part[hf * 512 + e] = below; part[hf * 512 + 256 + e] = all;
        __syncthreads();
        if (F.tid < 256) { lbase[e] = part[e] + part[512 + e]; lcnt[e] = 0u; const int tot = part[256 + e] + part[768 + e]; ltot[e] = tot; if (blk == 0) cnt[e] = (unsigned)tot; }
        __syncthreads();
        if (F.tid == 0) { int s2 = 0; for (int q = 0; q < 256; ++q) { lts[q] = s2; s2 += (ltot[q] + 255) >> 8; } }
        __syncthreads();
#pragma unroll
        for (int q = 0; q < 2; ++q) { const int a = F.tid + q * NTHR; const unsigned tk = (unsigned)(blk * 128 * TOPK + a);
            const v2u rt = ROUTE[tk]; const unsigned pos = (unsigned)lbase[rt.x] + __hip_atomic_fetch_add(lcnt + rt.x, 1u, __ATOMIC_RELAXED, __HIP_MEMORY_SCOPE_WORKGROUP);
            LIST[(size_t)rt.x * LISTCAP + pos] = (v2u){tk, rt.y}; INV[tk] = lts[rt.x] * 256 + (int)pos; }
        __syncthreads();
    }
}

template <bool GATHER> DI void moe_setup(const Frame& F, int ncol, int& nunits, int& nfull) {
    LAS int* ts = (LAS int*)(F.lds + LDS_TS); LAS int* cl = (LAS int*)(F.lds + LDS_CNT); LAS int* ut = (LAS int*)(F.lds + LDS_UT); LAS int* idx = (LAS int*)(F.lds + LDS_IDX);
    const unsigned* cnt = (const unsigned*)(F.ws + WS_CTL) + CW_CNT;
    if (F.tid < 256) cl[F.tid] = (int)__hip_atomic_load(cnt + F.tid, __ATOMIC_RELAXED, __HIP_MEMORY_SCOPE_AGENT);
    __syncthreads();
    if (F.tid == 0) { int s = 0; for (int e = 0; e < 256; ++e) { ts[e] = s; s += (cl[e] + 255) >> 8; } ts[256] = s; }
    __syncthreads();
    const int Te = ts[256], T = Te + NTOK / 256;
    const int Fr = T / F.G, R = T - Fr * F.G, LU = R * ncol;
    const int nleft = (LU > F.vcu) ? (LU - F.vcu + F.G - 1) / F.G : 0;
    nfull = Fr * ncol; nunits = nfull + nleft;
    const v2u* LIST = (const v2u*)(F.ws + WS_LIST);
    for (int j = 0; j < Fr + nleft && j < 10; ++j) {
        int rt, pnl = 0;
        if (j < Fr) rt = j * F.G + F.vcu; else { const int lu = (j - Fr) * F.G + F.vcu; rt = Fr * F.G + lu / ncol; pnl = lu % ncol; }
        int e, pm, nrows;
        if (rt >= Te) { e = 256; pm = rt - Te; nrows = 256; }
        else { int lo = 0, hi = 256; while (hi - lo > 1) { const int mid = (lo + hi) >> 1; if (ts[mid] <= rt) lo = mid; else hi = mid; }
            e = lo; pm = rt - ts[lo]; const int rem = cl[lo] - pm * 256; nrows = rem < 256 ? rem : 256; }
        if (F.tid == 0) *(LAS v4u*)(ut + 4 * j) = (v4u){(unsigned)e, (unsigned)pm, (unsigned)rt, (unsigned)nrows | ((unsigned)pnl << 16)};
        if (F.tid < 256) { const int r = F.tid;
            if (GATHER) idx[j * 256 + r] = (e == 256) ? pm * 256 + r : (r < nrows ? (int)(LIST[(size_t)e * LISTCAP + pm * 256 + r].x >> 3) : 0);
            else ((LAS float*)idx)[j * 256 + r] = (e == 256) ? 1.0f : (r < nrows ? __uint_as_float(LIST[(size_t)e * LISTCAP + pm * 256 + r].y) : 0.0f); } }
    __syncthreads();
}

DI void phase_combine(const Frame& F, int mode) {
    const float* MOD = (const float*)(F.ws + WS_MOD);
    const unsigned char* YE = F.ws + WS_YE; const int* INV = (const int*)(F.ws + WS_INV);
    int Te = 0; if (mode == 0) { const unsigned* cnt = (const unsigned*)(F.ws + WS_CTL) + CW_CNT; int t4 = 0;
#pragma unroll
        for (int q = 0; q < 4; ++q) t4 += (int)((cnt[F.lane + 64 * q] + 255u) >> 8);
#pragma unroll
        for (int o = 1; o < 64; o <<= 1) t4 += __shfl_xor(t4, o);
        Te = __builtin_amdgcn_readfirstlane(t4); }
    const int gw = F.bx * NWAVES + F.wave, NGW = F.G * NWAVES;
    const float* nf = F.in[I_NFIN];
    const int c = 16 * F.lane;
    for (int m = gw; m < NTOK; m += NGW) {
        const int b = m >> 11;
        float s[16];
#pragma unroll
        for (int q = 0; q < 16; ++q) s[q] = 0.f;
        const float* xsrc = mode == 2 ? F.in[I_X] : (const float*)(F.ws + WS_X1);
        if (mode == 0) {
#pragma unroll
            for (int k = 0; k < 9; ++k) { const int row = (k < 8) ? INV[m * TOPK + k] : Te * 256 + m; const v4u w = *(const v4u*)(YE + (size_t)row * D + c);
                const unsigned ww[4] = {w.x, w.y, w.z, w.w};
#pragma unroll
                for (int q = 0; q < 4; ++q) { const f32x2 lo = __builtin_amdgcn_cvt_pk_f32_fp8((int)ww[q], false), hi = __builtin_amdgcn_cvt_pk_f32_fp8((int)ww[q], true);
                    s[4 * q] += lo.x; s[4 * q + 1] += lo.y; s[4 * q + 2] += hi.x; s[4 * q + 3] += hi.y; } } }
        float x2[16]; float ss = 0.f;
#pragma unroll
        for (int q = 0; q < 4; ++q) { const f32x4 xa = *(const f32x4*)(xsrc + (size_t)m * D + c + 4 * q), ga = *(const f32x4*)(MOD + b * 6144 + 5120 + c + 4 * q);
#pragma unroll
            for (int j = 0; j < 4; ++j) { const float v = xa[j] + ga[j] * (s[4 * q + j] * 0.015625f); x2[4 * q + j] = v; ss += v * v; } }
        const float rs = rsqrtf(wave_sum(ss) * (1.0f / D) + EPS);
#pragma unroll
        for (int q = 0; q < 4; ++q) { const f32x4 na = *(const f32x4*)(nf + c + 4 * q);
            f32x4 oa = {x2[4 * q] * rs * na.x, x2[4 * q + 1] * rs * na.y, x2[4 * q + 2] * rs * na.z, x2[4 * q + 3] * rs * na.w};
            *(f32x4*)(F.out + (size_t)m * D + c + 4 * q) = oa; }
    }
}

constexpr int NPHASE = 14;
__global__ void __launch_bounds__(NTHR, 2) fwd_kernel(Args args) {
    extern __shared__ __attribute__((aligned(16))) unsigned char lds_raw[];
    Frame F;
    F.lds = (LAS unsigned char*)lds_raw;
    F.tid = threadIdx.x; F.lane = F.tid & 63; F.wave = __builtin_amdgcn_readfirstlane(F.tid >> 6);
    F.G = gridDim.x; F.bx = blockIdx.x; F.vcu = (F.G % 8 == 0) ? (F.bx % 8) * (F.G / 8) + F.bx / 8 : F.bx;
    F.in = args.in; F.out = args.out; F.ws = args.ws;
    volatile LAS unsigned* MISC = (volatile LAS unsigned*)(F.lds + LDS_MISC);
    if (F.tid < 16) MISC[F.tid] = 0u;
    __syncthreads();
    XcdBarrier bar; bar.bar = (unsigned*)(F.ws + WS_CTL) + CW_BAR; bar.x = 0; bar.st = nullptr;
#if !PER_PHASE_LAUNCH
    bar = xcd_barrier_post((unsigned*)(F.ws + WS_CTL) + CW_BAR, MISC + 8);
#define GRID_BAR() xcd_barrier(bar)
#else
#define GRID_BAR() do {} while (0)
#endif
    const int lo = args.ph_lo, hi = args.ph_hi;
#ifndef PH_MASK
#define PH_MASK 0xFFFF
#endif
#define IN(k) (((PH_MASK >> (k)) & 1) && lo <= (k) && (k) < hi)
#ifndef PROBE_PH
#define PROBE_PH -1
#endif
#ifndef PROBE_MULT
#define PROBE_MULT 4
#endif
    volatile LAS unsigned long long* PRT = (volatile LAS unsigned long long*)(F.lds + LDS_MISC);
    if (PROBE_PH == 0 && F.wave == 0) PRT[0] = __builtin_amdgcn_s_memrealtime();
#define SEAM(k) do { if (IN(k) && IN((k) + 1)) GRID_BAR(); \
        if (PROBE_PH >= 0 && F.wave == 0) { if ((k) == PROBE_PH - 1) PRT[0] = __builtin_amdgcn_s_memrealtime(); if ((k) == PROBE_PH) PRT[1] = __builtin_amdgcn_s_memrealtime(); } } while (0)
#ifndef REPEAT_MASK
#define REPEAT_MASK 0
#endif
#define REPS(k) (1 + ((REPEAT_MASK >> (k)) & 1))
    unsigned char* ws = F.ws;

    if (IN(0)) _Pragma("unroll 1") for (int rep = 0; rep < REPS(0); ++rep) { if (rep) GRID_BAR(); phase_prologue(F); } SEAM(0);
    if (IN(1)) _Pragma("unroll 1") for (int rep = 0; rep < REPS(1); ++rep) { if (rep) GRID_BAR(); phase_norm_rows(F, 0); } SEAM(1);
    if (IN(2)) _Pragma("unroll 1") for (int rep = 0; rep < REPS(2); ++rep) { if (rep) GRID_BAR();
        pg8::DenseOrder S; S.init(ws + WS_HX, ws + WS_WIN, MTOT, INC, D, F.G, F.bx);
        pg8::EpiInProj E{(bf16*)(ws + WS_P), (const float*)(ws + WS_TAB)};
        pg8::gemm_phase(F.lds, D, S, E);
    } SEAM(2);
    if (IN(3)) _Pragma("unroll 1") for (int rep = 0; rep < REPS(3); ++rep) { if (rep) GRID_BAR(); phase_lru_pass1(F); } SEAM(3);
    if (IN(4)) _Pragma("unroll 1") for (int rep = 0; rep < REPS(4); ++rep) { if (rep) GRID_BAR(); phase_lru_carry(F);
        if (F.G >= 256) { if (F.bx < 128) hgrn_chain(F, F.bx); else convert_experts(F, (F.bx - 128) * NWAVES + F.wave, (F.G - 128) * NWAVES); }
        else { phase_hgrn(F); convert_experts(F, F.bx * NWAVES + F.wave, F.G * NWAVES); } } SEAM(4);
    if (IN(5)) _Pragma("unroll 1") for (int rep = 0; rep < REPS(5); ++rep) { if (rep) GRID_BAR(); phase_lru_pass2(F); phase_y2(F); } SEAM(5);
    if (IN(6)) _Pragma("unroll 1") for (int rep = 0; rep < REPS(6); ++rep) { if (rep) GRID_BAR();
        pg8::DenseOrder S; S.init(ws + WS_YL, ws + WS_WOUT, NTOK, D, D, F.G, F.bx);
        pg8::EpiResid E{F.in[I_X], (const float*)(ws + WS_MOD), (float*)(ws + WS_X1)};
        pg8::gemm_phase(F.lds, D, S, E);
    } SEAM(6);
#if DBG_STOP == 1
    if (IN(7)) _Pragma("unroll 1") for (int rep = 0; rep < REPS(7); ++rep) { if (rep) GRID_BAR(); phase_combine(F, 1); }
#else
    if (IN(7)) _Pragma("unroll 1") for (int rep = 0; rep < REPS(7); ++rep) { if (rep) GRID_BAR(); phase_norm_rows(F, 1); } SEAM(7);
    if (IN(8)) _Pragma("unroll 1") for (int rep = 0; rep < REPS(8); ++rep) { if (rep) GRID_BAR();
        pg8::DenseOrder S; S.init(ws + WS_HX2, ws + WS_WR, NTOK, NE, D, F.G, F.bx);
        pg8::EpiF32 E{(float*)(ws + WS_LOGIT), NE};
        pg8::gemm_phase(F.lds, D, S, E);
    } SEAM(8);
    if (IN(9)) _Pragma("unroll 1") for (int rep = 0; rep < REPS(9); ++rep) { if (rep) GRID_BAR(); phase_route(F); } SEAM(9);
    if (IN(10)) _Pragma("unroll 1") for (int rep = 0; rep < REPS(10); ++rep) { if (rep) GRID_BAR(); phase_lists(F); } SEAM(10);
    if (IN(11)) _Pragma("unroll 1") for (int rep = 0; rep < REPS(11); ++rep) { if (rep) GRID_BAR();
        int total, nfull; moe_setup<true>(F, 2, total, nfull);
        pg8::MoeOrder<true> S; S.A = (const char*)(ws + WS_HX2F); S.Bt = (const char*)(ws + WS_EW13); S.BtS = (const char*)(ws + WS_SW13); S.K = D / 2; S.ncol = 2; S.estride = (size_t)512 * 1024;
        S.ut = (const LAS int*)(F.lds + LDS_UT); S.idx = (const LAS int*)(F.lds + LDS_IDX); S.nunits = total; S.nfull = nfull;
        pg8::EpiSwiGLU8 E{ws + WS_ACT};
        pg8::gemm_phase<pg8::EpiSwiGLU8, pg8::MoeOrder<true>, false, true>(F.lds, D / 2, S, E);
    } SEAM(11);
    if (IN(12)) _Pragma("unroll 1") for (int rep = 0; rep < REPS(12); ++rep) { if (rep) GRID_BAR();
        int total, nfull; moe_setup<false>(F, 4, total, nfull);
        pg8::MoeOrder<false> S; S.A = (const char*)(ws + WS_ACT); S.Bt = (const char*)(ws + WS_EW2); S.BtS = (const char*)(ws + WS_SW2); S.K = DE / 2; S.ncol = 4; S.estride = (size_t)1024 * 256;
        S.ut = (const LAS int*)(F.lds + LDS_UT); S.idx = (const LAS int*)(F.lds + LDS_IDX); S.nunits = total; S.nfull = nfull;
        pg8::EpiScatter E{ws + WS_YE, (const LAS float*)(F.lds + LDS_IDX), 0.5f};
#if defined(PROBE_GEMM)
        pg8::GProf gp{0ull, 0ull, 0ull};
        pg8::gemm_phase<pg8::EpiScatter, pg8::MoeOrder<false>, true, true>(F.lds, DE / 2, S, E, &gp);
        if (F.wave == 0) { PRT[0] = 0ull; PRT[1] = (PROBE_GEMM == 0) ? gp.t_loop : (PROBE_GEMM == 1) ? gp.t_epi : gp.t_next; }
#else
        pg8::gemm_phase<pg8::EpiScatter, pg8::MoeOrder<false>, false, true>(F.lds, DE / 2, S, E);
#endif
    } SEAM(12);
    if (IN(13)) _Pragma("unroll 1") for (int rep = 0; rep < REPS(13); ++rep) { if (rep) GRID_BAR(); phase_combine(F, 0); }
#endif
#if defined(PROBE_GEMM)
    if (F.bx == 0 && F.wave == 0) {
#else
    if (PROBE_PH >= 0 && F.bx == 0 && F.wave == 0) {
#endif
        const unsigned long long te = __builtin_amdgcn_s_memrealtime(); if (PROBE_PH == NPHASE - 1) PRT[1] = te;
        const unsigned long long target = (unsigned long long)PROBE_MULT * (PRT[1] - PRT[0]);
        while (__builtin_amdgcn_s_memrealtime() - te < target) __builtin_amdgcn_s_sleep(20);
    }
}

extern "C" void kernel_launch(void* const* d_in, const int* in_sizes, int n_in, void* d_out, int out_size, void* d_ws, size_t ws_size, hipStream_t stream) {
    static int grid = 0;
    if (grid == 0) {
        if (n_in != 26 || in_sizes[0] != NTOK * D || out_size != NTOK * D || ws_size < WS_END) { fprintf(stderr, "kernel_launch: unexpected shapes (n_in %d, ws %zu)\n", n_in, ws_size); grid = -1; return; }
        int dev = 0, cus = 0, per_cu = 0;
        if (hipGetDevice(&dev) != hipSuccess || hipDeviceGetAttribute(&cus, hipDeviceAttributeMultiprocessorCount, dev) != hipSuccess) { grid = -1; return; }
        if (hipFuncSetAttribute((const void*)fwd_kernel, hipFuncAttributeMaxDynamicSharedMemorySize, LDS_BYTES) != hipSuccess) { fprintf(stderr, "kernel_launch: hipFuncSetAttribute failed\n"); grid = -1; return; }
        if (hipOccupancyMaxActiveBlocksPerMultiprocessor(&per_cu, (const void*)fwd_kernel, NTHR, LDS_BYTES) != hipSuccess || per_cu < 1) { fprintf(stderr, "kernel_launch: occupancy query says %d\n", per_cu); }
        (void)hipGetLastError();
        grid = cus;
    }
    if (grid < 0) return;
    hipMemsetAsync((char*)d_ws + WS_CTL, 0, CTL_ZERO_BYTES, stream);
    Args a{};
    for (int i = 0; i < 26; ++i) a.in[i] = (const float*)d_in[i];
    a.out = (float*)d_out; a.ws = (unsigned char*)d_ws;
#if PER_PHASE_LAUNCH
    for (int p = 0; p < NPHASE; ++p) { a.ph_lo = p; a.ph_hi = p + 1; hipLaunchKernelGGL(fwd_kernel, dim3(grid), dim3(NTHR), LDS_BYTES, stream, a); }
#else
    a.ph_lo = 0; a.ph_hi = NPHASE;
    hipLaunchKernelGGL(fwd_kernel, dim3(grid), dim3(NTHR), LDS_BYTES, stream, a);
#endif
}
```

```cpp
#include <hip/hip_runtime.h>
#include <cstdio>
#include <cstdint>

#ifndef PER_PHASE_LAUNCH
#define PER_PHASE_LAUNCH 0
#endif
#ifndef DBG_STOP
#define DBG_STOP 0
#endif

#define GAS __attribute__((address_space(1)))
#define LAS __attribute__((address_space(3)))
#define DI __device__ __forceinline__
typedef unsigned short bf16;
typedef unsigned v4u __attribute__((ext_vector_type(4)));
typedef unsigned v2u __attribute__((ext_vector_type(2)));
typedef float f32x4 __attribute__((ext_vector_type(4)));
typedef float f32x2 __attribute__((ext_vector_type(2)));
typedef short bf16x8 __attribute__((ext_vector_type(8)));
typedef __bf16 bfv2 __attribute__((ext_vector_type(2)));

constexpr int D = 1024, NB = 16, SEQ = 2048, CTXL = 256;
constexpr int NTOK = NB * SEQ;
constexpr int NCTX = NB * CTXL;
constexpr int MTOT = NTOK + NCTX;
constexpr int INC = 3584;
constexpr int NE = 256, TOPK = 8, DE = 256;
constexpr int LISTCAP = 32768;
constexpr float EPS = 1e-6f;
constexpr int NWAVES = 8, NTHR = 512;
constexpr int NSEQT = 36;

constexpr size_t MiB = 1u << 20;
constexpr size_t WS_CTL = 0, CTL_ZERO_BYTES = 1 * MiB;
constexpr size_t WS_MOD = 1 * MiB;
constexpr size_t WS_TAB = 2 * MiB;
constexpr size_t WS_WGT = 2 * MiB + 65536;
constexpr size_t WS_WIN = 3 * MiB;
constexpr size_t WS_WOUT = 10 * MiB;
constexpr size_t WS_WR = 12 * MiB;
constexpr size_t WS_SW13 = 12 * MiB + 512 * 1024;
constexpr size_t WS_SW2 = 13 * MiB + 512 * 1024;
constexpr size_t WS_DUMP = 2 * MiB + 16384;
constexpr size_t WS_SUMA = 14 * MiB;
constexpr size_t WS_SUMH = WS_SUMA + 2359296;
constexpr size_t WS_CIN = WS_SUMH + 2359296;
constexpr size_t WS_ROUTE = 21 * MiB;
constexpr size_t WS_HIST = 23 * MiB;
constexpr size_t WS_EW13 = 32 * MiB;
constexpr size_t WS_EW2 = 288 * MiB;
constexpr size_t WS_X1 = 416 * MiB;
constexpr size_t WS_HX2 = 544 * MiB;
constexpr size_t WS_LOGIT = 608 * MiB;
constexpr size_t WS_LIST = 1620 * MiB;
constexpr size_t WS_ACT = 674 * MiB;
constexpr size_t WS_YS = 850 * MiB;
constexpr size_t WS_P = 914 * MiB;
constexpr size_t WS_HX = 1166 * MiB;
constexpr size_t WS_OF = 1238 * MiB;
constexpr size_t WS_OB = 1270 * MiB;
constexpr size_t WS_YL = 1302 * MiB;
constexpr size_t WS_YE = 914 * MiB;
constexpr size_t WS_INV = 24 * MiB;
constexpr size_t WS_HX2F = 1684 * MiB;
constexpr size_t WS_END = 1716 * MiB;
constexpr int CW_BAR = 4096;
constexpr int CW_CNT = 16384;

constexpr int RING_BYTES = 131072;
constexpr int LDS_TS = RING_BYTES;
constexpr int LDS_CNT = LDS_TS + 1088;
constexpr int LDS_UT = LDS_CNT + 1024;
constexpr int LDS_IDX = LDS_UT + 192;
constexpr int LDS_MISC = LDS_IDX + 10 * 1024;
constexpr int LDS_BYTES = 155648;
static_assert(LDS_MISC + 64 <= LDS_BYTES, "lds map");

DI unsigned pk2(float lo, float hi) { f32x2 v = {lo, hi}; bfv2 b = __builtin_convertvector(v, bfv2); return __builtin_bit_cast(unsigned, b); }
DI float clamp448(float x) { return __builtin_amdgcn_fmed3f(x, -448.0f, 448.0f); }
DI unsigned pk4_f8(float a, float b, float c, float d) {
    int w = __builtin_amdgcn_cvt_pk_fp8_f32(clamp448(a), clamp448(b), 0, false); w = __builtin_amdgcn_cvt_pk_fp8_f32(clamp448(c), clamp448(d), w, true); return (unsigned)w; }
DI float bflo(unsigned w) { return __uint_as_float(w << 16); }
DI float bfhi(unsigned w) { return __uint_as_float(w & 0xffff0000u); }
DI float bf2f(bf16 h) { return __uint_as_float(((unsigned)h) << 16); }
DI bf16 f2bf(float f) { return (bf16)(pk2(f, 0.f) & 0xffffu); }
DI float rcpf_(float x) { return __builtin_amdgcn_rcpf(x); }
DI float ex2f_(float x) { return __builtin_amdgcn_exp2f(x); }
DI float expf_(float x) { return __builtin_amdgcn_exp2f(x * 1.4426950408889634f); }
DI float logf_(float x) { return __builtin_amdgcn_logf(x) * 0.6931471805599453f; }
DI float sigm(float x) { return rcpf_(1.0f + expf_(-x)); }
DI float wave_sum(float v) {
#pragma unroll
    for (int o = 1; o < 64; o <<= 1) v += __shfl_xor(v, o);
    return v;
}
#define LDS_WAIT() asm volatile("s_waitcnt lgkmcnt(0)" ::: "memory")
template <int CTRL> DI float dpp_mov_f(float v) { return __uint_as_float((unsigned)__builtin_amdgcn_update_dpp(0, (int)__float_as_uint(v), CTRL, 0xf, 0xf, true)); }
DI float wave_sum_fast(float v) {
    v += dpp_mov_f<0xB1>(v); v += dpp_mov_f<0x4E>(v); v += dpp_mov_f<0x124>(v); v += dpp_mov_f<0x128>(v);
    const unsigned u = __float_as_uint(v);
    return (__uint_as_float((unsigned)__builtin_amdgcn_readlane((int)u, 0)) + __uint_as_float((unsigned)__builtin_amdgcn_readlane((int)u, 16)))
         + (__uint_as_float((unsigned)__builtin_amdgcn_readlane((int)u, 32)) + __uint_as_float((unsigned)__builtin_amdgcn_readlane((int)u, 48)));
}

#define XB_TMO      128
#define XB_XCNT(j)  (256  + 64 * (j))
#define XB_XSUB(j)  (1280 + 64 * (j))
#define XB_XGEN(j)  (2304 + 64 * (j))
#define XB_TOP      3328
#define XB_TOPGEN   3392
#define XCD_BAR_WORDS 3456
#define XB_SPIN_CAP (1u << 18)
__device__ __forceinline__ unsigned xb_ld(unsigned* p)              { return __hip_atomic_load(p, __ATOMIC_RELAXED, __HIP_MEMORY_SCOPE_AGENT); }
__device__ __forceinline__ unsigned xb_add(unsigned* p, unsigned v) { return __hip_atomic_fetch_add(p, v, __ATOMIC_RELAXED, __HIP_MEMORY_SCOPE_AGENT); }
__device__ __forceinline__ unsigned xb_xcc_id() { return (unsigned)__builtin_amdgcn_s_getreg((3 << 11) | 20) & 0xFu; }
#define XB_SPIN(cond, bar) do { unsigned _sp = 0; while (cond) { __builtin_amdgcn_s_sleep(1); \
    if ((++_sp & 255u) == 0u) { if (xb_ld(&(bar)[XB_TMO])) break; if (_sp > XB_SPIN_CAP) { atomicAdd(&(bar)[XB_TMO], 1u); break; } } } } while (0)
struct XcdBarrier { unsigned* bar; unsigned x; volatile LAS unsigned* st; };
__device__ __forceinline__ XcdBarrier xcd_barrier_post(unsigned* bar, volatile LAS unsigned* st) {
    XcdBarrier b; b.bar = bar; b.x = xb_xcc_id(); b.st = st;
    if (threadIdx.x == 0) (void)xb_add(&bar[XB_XCNT(b.x)], 1u);
    return b;
}
__device__ __forceinline__ void xcd_barrier_complete(unsigned* bar, unsigned x, unsigned& nloc, unsigned& nx) {
    const unsigned G = gridDim.x * gridDim.y * gridDim.z;
    unsigned sum, cnt, mine, sp = 0u;
    for (;;) {
        sum = 0u; cnt = 0u; mine = 0u;
#pragma unroll
        for (unsigned j = 0; j < 16; ++j) { const unsigned c = xb_ld(&bar[XB_XCNT(j)]); sum += c; cnt += (c > 0u) ? 1u : 0u; mine = (j == x) ? c : mine; }
        if (sum == G) break;
        __builtin_amdgcn_s_sleep(1);
        if ((++sp & 255u) == 0u) { if (xb_ld(&bar[XB_TMO])) break; if (sp > XB_SPIN_CAP) { atomicAdd(&bar[XB_TMO], 1u); break; } }
    }
    nloc = mine > 0u ? mine : 1u; nx = cnt > 0u ? cnt : 1u;
}
__device__ __forceinline__ void xcd_barrier(const XcdBarrier& b) {
    asm volatile("s_waitcnt vmcnt(0)" ::: "memory");
    __syncthreads();
    if (threadIdx.x == 0) {
        unsigned* bar = b.bar;
        __builtin_amdgcn_s_waitcnt(0);
        unsigned nloc = b.st[0], nx = b.st[1];
        if (nloc == 0u) { xcd_barrier_complete(bar, b.x, nloc, nx); b.st[0] = nloc; b.st[1] = nx; }
        const unsigned old = xb_add(&bar[XB_XSUB(b.x)], 1u);
        const unsigned gen = old / nloc;
        if (old + 1u == (gen + 1u) * nloc) {
            __builtin_amdgcn_fence(__ATOMIC_RELEASE, "agent");
            asm volatile("s_waitcnt vmcnt(0)" ::: "memory");
            const unsigned og = xb_add(&bar[XB_TOP], 1u);
            const unsigned tg = og / nx;
            if (og + 1u == (tg + 1u) * nx) xb_add(&bar[XB_TOPGEN], 1u);
            else XB_SPIN(xb_ld(&bar[XB_TOPGEN]) == tg, bar);
            __builtin_amdgcn_fence(__ATOMIC_ACQUIRE, "agent");
            xb_add(&bar[XB_XGEN(b.x)], 1u);
            asm volatile("s_waitcnt vmcnt(0)" ::: "memory");
        } else {
            XB_SPIN(xb_ld(&bar[XB_XGEN(b.x)]) == gen, bar);
            __builtin_amdgcn_fence(__ATOMIC_ACQUIRE, "agent");
            asm volatile("s_waitcnt vmcnt(0)" ::: "memory");
        }
    }
    __syncthreads();
}

namespace pg8 {
constexpr int BM = 256, BK = 64, HALF = 128, HTB = HALF * BK * 2, NXCD = 8, WGM = 8;
DI int lds_byte(int r, int c) { const int st = (r >> 4) * 2 + (c >> 5), rr = r & 15, cc = c & 31, ob = rr * 64 + cc * 2; return st * 1024 + (ob ^ (((ob >> 9) & 1) << 5)); }
DI void stage_rc(int b, int& R, int& C) { const int st = b / 1024, sb = b % 1024, swz = sb ^ (((sb >> 9) & 1) << 5); R = (st >> 1) * 16 + swz / 64; C = (st & 1) * 32 + (swz % 64) / 2; }
DI int perm32(int rho) { const int n = rho >> 4, i = rho & 15; return 8 * (i >> 2) + 4 * n + (i & 3); }

struct Unit { int pm, pn, e, rt, ord, nrows; };

struct DenseOrder {
    const char* A; const char* Bt; int K, nM, nN, nwg, G, c;
    DI void init(const void* A_, const void* Bt_, int M, int N, int K_, int G_, int c_) { A = (const char*)A_; Bt = (const char*)Bt_; K = K_; nM = M / BM; nN = N / BM; nwg = nM * nN; G = G_; c = c_; }
    DI bool next(int i, Unit& u) const {
        const long L = (long)i * G + c; if (L >= nwg) return false;
        int wgid = (int)L; { const int q = nwg / NXCD, r = nwg % NXCD, xcd = wgid % NXCD, off = wgid / NXCD; wgid = (xcd < r ? xcd * (q + 1) : r * (q + 1) + (xcd - r) * q) + off; }
        const int nig = WGM * nN, gid = wgid / nig, fm = gid * WGM, gsz = (nM - fm) < WGM ? (nM - fm) : WGM;
        u.pm = fm + ((wgid % nig) % gsz); u.pn = (wgid % nig) / gsz; u.e = 0; u.rt = u.pm; u.ord = i; u.nrows = 256; return true;
    }
    DI const char* a_base(const Unit& u) const { return A + (size_t)u.pm * BM * K * 2; }
    DI const char* b_base(const Unit& u) const { return Bt + (size_t)u.pn * BM * K * 2; }
    static constexpr bool GATHER_A = false;
    DI void a_offs(const Unit&, int tid, unsigned (&v)[2][2]) const {
#pragma unroll
        for (int i = 0; i < 2; ++i) { int R, C; stage_rc(tid * 16 + i * 8192, R, C);
#pragma unroll
            for (int h = 0; h < 2; ++h) v[h][i] = (unsigned)((h * HALF + R) * K + C) * 2u; }
    }
};

template <bool GATHER> struct MoeOrder {
    const char* A; const char* Bt; const char* BtS; int K, ncol; size_t estride;
    const LAS int* ut; const LAS int* idx; int nunits, nfull;
    static constexpr bool GATHER_A = GATHER;
    DI bool next(int i, Unit& u) const {
        if (i >= nunits) return false;
        int j, pn;
        if (i < nfull) { j = i / ncol; pn = i - j * ncol; } else { j = nfull / ncol + (i - nfull); pn = -1; }
        const v4u t = *(const LAS v4u*)(ut + 4 * j);
        u.ord = j; u.e = (int)t.x; u.pm = (int)t.y; u.rt = (int)t.z; u.nrows = (int)(t.w & 0xffffu); u.pn = pn >= 0 ? pn : (int)(t.w >> 16);
        return true;
    }
    DI const char* a_base(const Unit& u) const { return GATHER ? A : A + (size_t)u.rt * BM * K * 2; }
    DI const char* b_base(const Unit& u) const { return (u.e < 256 ? Bt + (size_t)u.e * estride : BtS) + (size_t)u.pn * BM * K * 2; }
    DI void a_offs(const Unit& u, int tid, unsigned (&v)[2][2]) const {
#pragma unroll
        for (int i = 0; i < 2; ++i) { int R, C; stage_rc(tid * 16 + i * 8192, R, C);
#pragma unroll
            for (int h = 0; h < 2; ++h) {
                if (GATHER) v[h][i] = ((unsigned)idx[u.ord * 256 + h * HALF + R] * (unsigned)K + (unsigned)C) * 2u;
                else v[h][i] = (unsigned)((h * HALF + R) * K + C) * 2u; } }
    }
};

struct GProf { unsigned long long t_loop, t_epi, t_next; };
typedef int v8i __attribute__((ext_vector_type(8)));
template <class Epi, class Sched, bool PROF = false, bool F8 = false>
__device__ __forceinline__ void gemm_phase(LAS unsigned char* lds, const int K, const Sched& S, const Epi& E, const int wid  , GProf* prof = nullptr) {
    unsigned long long pt0 = 0, pt1 = 0, pt2 = 0, pt3 = 0;
    const int tid = threadIdx.x, lane = tid & 63, wr = wid >> 2, wc = wid & 3, fr = lane & 15, fq = lane >> 4;
    const int nt = K / BK;
    unsigned voffBh[2][2];
#pragma unroll
    for (int i = 0; i < 2; ++i) { int R, C; stage_rc(tid * 16 + i * 8192, R, C);
#pragma unroll
        for (int h = 0; h < 2; ++h) { int Rb;
            if (Epi::PERM == 2) Rb = 64 * ((R >> 5) & 3) + 16 * ((R >> 2) & 3) + 8 * h + 4 * ((R >> 4) & 1) + (R & 3);
            else Rb = HALF * h + (Epi::PERM == 1 ? ((R & ~31) + perm32(R & 31)) : R);
            voffBh[h][i] = (unsigned)(Rb * K + C) * 2u; } }
    const size_t kstep = (size_t)(BK * 2);
    const size_t hstep = (size_t)HALF * K * 2;
    const unsigned ldsw = (unsigned)wid * 1024u;
    const int aoff = F8 ? lds_byte(wr * 64 + fr, fq * 16) : lds_byte(wr * 64 + fr, fq * 8), boff = F8 ? lds_byte(wc * 32 + fr, fq * 16) : lds_byte(wc * 32 + fr, fq * 8);
#define PG8_SA(b, h) (((b) * 2 + (h)) * HTB)
#define PG8_SB(b, h) ((4 + (b) * 2 + (h)) * HTB)
#define PG8_STAGE(bufoff, gbase, voff) do { _Pragma("unroll") for (int _i = 0; _i < 2; ++_i) \
        __builtin_amdgcn_global_load_lds((const unsigned*)((const char*)(gbase) + (voff)[_i]), (LAS unsigned*)(lds + (bufoff) + ldsw + _i * 8192), 16, 0, 0); } while (0)
#define PG8_LD8(dst, off) do { const v4u _lo = *(const LAS v4u*)(lds + (off)), _hi = *(const LAS v4u*)(lds + (off) + 16); \
        dst[0] = (int)_lo.x; dst[1] = (int)_lo.y; dst[2] = (int)_lo.z; dst[3] = (int)_lo.w; dst[4] = (int)_hi.x; dst[5] = (int)_hi.y; dst[6] = (int)_hi.z; dst[7] = (int)_hi.w; } while (0)
#define PG8_LDA(dst, b, h) do { if (F8) { _Pragma("unroll") for (int m = 0; m < 4; ++m) PG8_LD8(dst##8[m], PG8_SA(b, h) + aoff + m * 2048); } \
        else { _Pragma("unroll") for (int m = 0; m < 4; ++m) _Pragma("unroll") for (int k = 0; k < 2; ++k) dst[m][k] = *(const LAS bf16x8*)(lds + PG8_SA(b, h) + aoff + m * 2048 + k * 1024); } } while (0)
#define PG8_LDB(dst, b, h) do { if (F8) { _Pragma("unroll") for (int n = 0; n < 2; ++n) PG8_LD8(dst##8[n], PG8_SB(b, h) + boff + n * 2048); } \
        else { _Pragma("unroll") for (int n = 0; n < 2; ++n) _Pragma("unroll") for (int k = 0; k < 2; ++k) dst[n][k] = *(const LAS bf16x8*)(lds + PG8_SB(b, h) + boff + n * 2048 + k * 1024); } } while (0)
#define PG8_MMA(ai, bj, At, Bt) do { __builtin_amdgcn_s_setprio(1); \
        if (F8) { _Pragma("unroll") for (int m = 0; m < 4; ++m) _Pragma("unroll") for (int n = 0; n < 2; ++n) \
            asm volatile("v_mfma_scale_f32_16x16x128_f8f6f4 %0, %1, %2, %0, %3, %3 op_sel_hi:[0,0,0]" : "+v"(acc[ai][bj][m][n]) : "v"(Bt##8[n]), "v"(At##8[m]), "v"(sc127)); } \
        else { _Pragma("unroll") for (int m = 0; m < 4; ++m) _Pragma("unroll") for (int n = 0; n < 2; ++n) _Pragma("unroll") for (int k = 0; k < 2; ++k) \
            acc[ai][bj][m][n] = __builtin_amdgcn_mfma_f32_16x16x32_bf16(Bt[n][k], At[m][k], acc[ai][bj][m][n], 0, 0, 0); } \
        __builtin_amdgcn_s_setprio(0); } while (0)
#define PG8_WAIT_V(n) asm volatile("s_waitcnt vmcnt(" #n ")" ::: "memory")
#define PG8_WAIT_L(n) asm volatile("s_waitcnt lgkmcnt(" #n ")" ::: "memory")
#define PG8_BAR __builtin_amdgcn_s_barrier()
#define PG8_SCHED __builtin_amdgcn_sched_barrier(0)
    Unit cur, nxt; int ui = 0;
    if (!S.next(0, cur)) return;
    f32x4 acc[2][2][4][2];
#pragma unroll
    for (int a = 0; a < 2; ++a)
#pragma unroll
        for (int b = 0; b < 2; ++b)
#pragma unroll
            for (int m = 0; m < 4; ++m)
#pragma unroll
                for (int n = 0; n < 2; ++n) acc[a][b][m][n] = (f32x4){0.f, 0.f, 0.f, 0.f};
    bf16x8 At[4][2], B0[2][2], B1[2][2];
    v8i At8[4], B08[2], B18[2];
    int sc127 = 127; asm volatile("" : "+v"(sc127));
    unsigned vC[2][2], vN[2][2];
    S.a_offs(cur, tid, vC);
    const char* cA = S.a_base(cur); const char* cB = S.b_base(cur);
    PG8_STAGE(PG8_SB(0, 0), cB, voffBh[0]); PG8_STAGE(PG8_SA(0, 0), cA, vC[0]); PG8_STAGE(PG8_SB(0, 1), cB, voffBh[1]); PG8_STAGE(PG8_SA(0, 1), cA, vC[1]);
    if (wr == 1) PG8_BAR;
    PG8_WAIT_V(4); PG8_BAR;
    PG8_STAGE(PG8_SB(1, 0), cB + kstep, voffBh[0]); PG8_STAGE(PG8_SA(1, 0), cA + kstep, vC[0]); PG8_STAGE(PG8_SB(1, 1), cB + kstep, voffBh[1]);
    PG8_WAIT_V(6); PG8_BAR;
    for (;;) {
        if (PROF) pt0 = __builtin_amdgcn_s_memrealtime();
        const bool has_next = S.next(ui + 1, nxt);
        const char* nA = has_next ? S.a_base(nxt) : cA; const char* nB = has_next ? S.b_base(nxt) : cB;
        if (Sched::GATHER_A) { if (has_next) S.a_offs(nxt, tid, vN); else { vN[0][0] = vC[0][0]; vN[0][1] = vC[0][1]; vN[1][0] = vC[1][0]; vN[1][1] = vC[1][1]; } }
        if (PROF) pt1 = __builtin_amdgcn_s_memrealtime();
#pragma unroll 1
        for (int t = 0; t < nt; t += 2) {
            const bool last = (t == nt - 2);
            const char* a1 = cA + (size_t)(t + 1) * kstep;
            const char* a2 = last ? nA : cA + (size_t)(t + 2) * kstep; const char* b2 = last ? nB : cB + (size_t)(t + 2) * kstep;
            const char* a3 = a2 + kstep; const char* b3 = b2 + kstep;
            unsigned x0[2], x1[2];
            if (Sched::GATHER_A) { x0[0] = last ? vN[0][0] : vC[0][0]; x0[1] = last ? vN[0][1] : vC[0][1]; x1[0] = last ? vN[1][0] : vC[1][0]; x1[1] = last ? vN[1][1] : vC[1][1]; }
            else { x0[0] = vC[0][0]; x0[1] = vC[0][1]; x1[0] = vC[1][0]; x1[1] = vC[1][1]; }
            PG8_LDB(B0, 0, 0); PG8_SCHED; PG8_LDA(At, 0, 0); PG8_STAGE(PG8_SA(1, 1), a1, vC[1]);
            PG8_WAIT_L(8); PG8_BAR; PG8_WAIT_L(0); PG8_MMA(0, 0, At, B0); PG8_BAR; PG8_SCHED;
            PG8_LDB(B1, 0, 1); PG8_STAGE(PG8_SB(0, 0), b2, voffBh[0]);
            PG8_BAR; PG8_WAIT_L(0); PG8_MMA(0, 1, At, B1); PG8_BAR;
            PG8_LDA(At, 0, 1); PG8_STAGE(PG8_SA(0, 0), a2, x0);
            PG8_BAR; PG8_WAIT_L(0); PG8_MMA(1, 0, At, B0); PG8_BAR; PG8_SCHED;
            PG8_STAGE(PG8_SB(0, 1), b2, voffBh[1]);
            PG8_WAIT_V(6); PG8_BAR; PG8_MMA(1, 1, At, B1); PG8_BAR;
            PG8_LDB(B0, 1, 0); PG8_SCHED; PG8_LDA(At, 1, 0); PG8_STAGE(PG8_SA(0, 1), a2, x1);
            PG8_WAIT_L(8); PG8_BAR; PG8_WAIT_L(0); PG8_MMA(0, 0, At, B0); PG8_BAR; PG8_SCHED;
            PG8_LDB(B1, 1, 1); PG8_STAGE(PG8_SB(1, 0), b3, voffBh[0]);
            PG8_BAR; PG8_WAIT_L(0); PG8_MMA(0, 1, At, B1); PG8_BAR;
            PG8_LDA(At, 1, 1); PG8_STAGE(PG8_SA(1, 0), a3, x0);
            PG8_BAR; PG8_WAIT_L(0); PG8_MMA(1, 0, At, B0); PG8_BAR; PG8_SCHED;
            PG8_STAGE(PG8_SB(1, 1), b3, voffBh[1]);
            PG8_WAIT_V(6); PG8_BAR; PG8_MMA(1, 1, At, B1); PG8_BAR;
        }
        if (PROF) pt2 = __builtin_amdgcn_s_memrealtime();
        if (F8) asm volatile("s_nop 15\n\ts_nop 15" ::: "memory");
        E(acc, cur, wr, wc, fr, fq);
        if (PROF) { asm volatile("s_waitcnt vmcnt(0)" ::: "memory"); pt3 = __builtin_amdgcn_s_memrealtime(); prof->t_next += pt1 - pt0; prof->t_loop += pt2 - pt1; prof->t_epi += pt3 - pt2; }
        if (!has_next) break;
#pragma unroll
        for (int a = 0; a < 2; ++a)
#pragma unroll
            for (int b = 0; b < 2; ++b)
#pragma unroll
                for (int m = 0; m < 4; ++m)
#pragma unroll
                    for (int n = 0; n < 2; ++n) acc[a][b][m][n] = (f32x4){0.f, 0.f, 0.f, 0.f};
        cur = nxt; cA = nA; cB = nB; ++ui;
        if (Sched::GATHER_A) { vC[0][0] = vN[0][0]; vC[0][1] = vN[0][1]; vC[1][0] = vN[1][0]; vC[1][1] = vN[1][1]; }
    }
    PG8_WAIT_V(0);
    if (wr == 0) PG8_BAR;
    PG8_BAR;
#undef PG8_SA
#undef PG8_SB
#undef PG8_STAGE
#undef PG8_LD8
#undef PG8_LDA
#undef PG8_LDB
#undef PG8_MMA
#undef PG8_WAIT_V
#undef PG8_WAIT_L
#undef PG8_BAR
#undef PG8_SCHED
}

DI float gelu_tanh(float x) { const float u = 1.5957691216f * (x + 0.044715f * x * x * x); return x * rcpf_(1.0f + expf_(-u)); }
DI float silu_f(float x) { return x * rcpf_(1.0f + expf_(-x)); }

struct EpiInProj {
    static constexpr int PERM = 1;
    bf16* P; const float* LB;
    DI void operator()(const f32x4 (&acc)[2][2][4][2], const Unit& u, int wr, int wc, int fr, int fq) const {
        const int row0 = u.pm * BM + wr * 64 + fr, col0 = u.pn * BM + wc * 32 + 8 * fq;
        const int pn = u.pn;
        const int kind = (pn == 2 || pn == 3) ? 1 : (pn >= 8 && pn < 12) ? 2 : (pn >= 12) ? 3 : 0;
        f32x4 lbv[2][2];
        { const int dir = (pn >> 1) & 1; const int cc = (pn & 1) * 256 + wc * 32 + 8 * fq;
#pragma unroll
            for (int bj = 0; bj < 2; ++bj)
#pragma unroll
                for (int n = 0; n < 2; ++n) lbv[bj][n] = *(const f32x4*)(LB + dir * 512 + cc + bj * HALF + 4 * n);
            asm volatile("" :: "v"(lbv[0][0]), "v"(lbv[0][1]), "v"(lbv[1][0]), "v"(lbv[1][1])); }
#pragma unroll
        for (int ai = 0; ai < 2; ++ai)
#pragma unroll
            for (int m = 0; m < 4; ++m) { bf16* rowp = P + (size_t)(row0 + ai * HALF + m * 16) * INC + col0;
#pragma unroll
                for (int bj = 0; bj < 2; ++bj) { f32x4 v0 = acc[ai][bj][m][0], v1 = acc[ai][bj][m][1];
                    if (kind == 1) {
#pragma unroll
                        for (int j = 0; j < 4; ++j) { v0[j] = gelu_tanh(v0[j]); v1[j] = gelu_tanh(v1[j]); } }
                    else if (kind == 2) {
#pragma unroll
                        for (int j = 0; j < 4; ++j) { const float l0 = lbv[bj][0][j], l1 = lbv[bj][1][j];
                            v0[j] = logf_(l0 + (1.0f - l0) * sigm(v0[j])); v1[j] = logf_(l1 + (1.0f - l1) * sigm(v1[j])); } }
                    else if (kind == 3) {
#pragma unroll
                        for (int j = 0; j < 4; ++j) { v0[j] = silu_f(v0[j]); v1[j] = silu_f(v1[j]); } }
                    v4u w; w.x = pk2(v0[0], v0[1]); w.y = pk2(v0[2], v0[3]); w.z = pk2(v1[0], v1[1]); w.w = pk2(v1[2], v1[3]);
                    *(v4u*)(rowp + bj * HALF) = w; } }
    }
};
struct EpiResid {
    static constexpr int PERM = 0;
    const float* x; const float* mod; float* X1;
    DI void operator()(const f32x4 (&acc)[2][2][4][2], const Unit& u, int wr, int wc, int fr, int fq) const {
        const int row0 = u.pm * BM + wr * 64 + fr, col0 = u.pn * BM + wc * 32 + 4 * fq;
        const int b = (u.pm * BM) >> 11;
        f32x4 gv[2][2];
#pragma unroll
        for (int bj = 0; bj < 2; ++bj)
#pragma unroll
            for (int n = 0; n < 2; ++n) gv[bj][n] = *(const f32x4*)(mod + (size_t)b * 6144 + 2048 + col0 + bj * HALF + n * 16);
#pragma unroll
        for (int ai = 0; ai < 2; ++ai)
#pragma unroll
            for (int m = 0; m < 4; ++m) { const size_t off = (size_t)(row0 + ai * HALF + m * 16) * D + col0;
#pragma unroll
                for (int bj = 0; bj < 2; ++bj)
#pragma unroll
                    for (int n = 0; n < 2; ++n) { const f32x4 xv = *(const f32x4*)(x + off + bj * HALF + n * 16);
                        *(f32x4*)(X1 + off + bj * HALF + n * 16) = xv + gv[bj][n] * acc[ai][bj][m][n]; } }
    }
};
struct EpiF32 {
    static constexpr int PERM = 0;
    float* C; int ldc;
    DI void operator()(const f32x4 (&acc)[2][2][4][2], const Unit& u, int wr, int wc, int fr, int fq) const {
        const int row0 = u.pm * BM + wr * 64 + fr, col0 = u.pn * BM + wc * 32 + 4 * fq;
#pragma unroll
        for (int ai = 0; ai < 2; ++ai)
#pragma unroll
            for (int m = 0; m < 4; ++m) { float* rowp = C + (size_t)(row0 + ai * HALF + m * 16) * ldc + col0;
#pragma unroll
                for (int bj = 0; bj < 2; ++bj)
#pragma unroll
                    for (int n = 0; n < 2; ++n) *(f32x4*)(rowp + bj * HALF + n * 16) = acc[ai][bj][m][n]; }
    }
};
struct EpiSwiGLU8 {
    static constexpr int PERM = 1;
    unsigned char* ACT;
    DI void operator()(const f32x4 (&acc)[2][2][4][2], const Unit& u, int wr, int wc, int fr, int fq) const {
        const unsigned off0 = ((unsigned)u.rt * 256u + (unsigned)(wr * 64 + fr)) * (unsigned)DE + (unsigned)(u.pn * 128 + wc * 32 + 8 * fq);
#pragma unroll
        for (int ai = 0; ai < 2; ++ai)
#pragma unroll
            for (int m = 0; m < 4; ++m) {
                f32x4 a0 = acc[ai][0][m][0] * 0.03125f, a1 = acc[ai][0][m][1] * 0.03125f; const f32x4 g0 = acc[ai][1][m][0] * 0.25f, g1 = acc[ai][1][m][1] * 0.25f;
#pragma unroll
                for (int j = 0; j < 4; ++j) { a0[j] = silu_f(a0[j]) * g0[j]; a1[j] = silu_f(a1[j]) * g1[j]; }
                v2u w; w.x = pk4_f8(a0[0], a0[1], a0[2], a0[3]); w.y = pk4_f8(a1[0], a1[1], a1[2], a1[3]);
                *(v2u*)(ACT + (off0 + (unsigned)((ai * HALF + m * 16) * DE))) = w; }
    }
};
struct EpiSwiGLU {
    static constexpr int PERM = 1;
    bf16* ACT;
    DI void operator()(const f32x4 (&acc)[2][2][4][2], const Unit& u, int wr, int wc, int fr, int fq) const {
        const int row0 = wr * 64 + fr, col0 = u.pn * 128 + wc * 32 + 8 * fq;
        bf16* base = ACT + (size_t)u.rt * 256 * DE;
#pragma unroll
        for (int ai = 0; ai < 2; ++ai)
#pragma unroll
            for (int m = 0; m < 4; ++m) { bf16* rowp = base + (size_t)(row0 + ai * HALF + m * 16) * DE + col0;
                f32x4 a0 = acc[ai][0][m][0], a1 = acc[ai][0][m][1]; const f32x4 g0 = acc[ai][1][m][0], g1 = acc[ai][1][m][1];
#pragma unroll
                for (int j = 0; j < 4; ++j) { a0[j] = silu_f(a0[j]) * g0[j]; a1[j] = silu_f(a1[j]) * g1[j]; }
                v4u w; w.x = pk2(a0[0], a0[1]); w.y = pk2(a0[2], a0[3]); w.z = pk2(a1[0], a1[1]); w.w = pk2(a1[2], a1[3]);
                *(v4u*)rowp = w; }
    }
};
struct EpiScatter {
    static constexpr int PERM = 2;
    unsigned char* YE; const LAS float* gate; float oscale;
    DI void operator()(const f32x4 (&acc)[2][2][4][2], const Unit& u, int wr, int wc, int fr, int fq) const {
        const unsigned col0 = (unsigned)(u.pn * BM + wc * 64 + 16 * fq);
        float gt[2][4];
#pragma unroll
        for (int ai = 0; ai < 2; ++ai)
#pragma unroll
            for (int m = 0; m < 4; ++m) gt[ai][m] = gate[u.ord * 256 + ai * HALF + wr * 64 + m * 16 + fr] * oscale;
#pragma unroll
        for (int ai = 0; ai < 2; ++ai)
#pragma unroll
            for (int m = 0; m < 4; ++m) { const int r = ai * HALF + wr * 64 + m * 16 + fr; const float g = gt[ai][m];
                const unsigned row = (r < u.nrows) ? (unsigned)u.rt * 256u + (unsigned)r : 360448u;
                const f32x4 v0 = acc[ai][0][m][0] * g, v1 = acc[ai][0][m][1] * g, v2 = acc[ai][1][m][0] * g, v3 = acc[ai][1][m][1] * g;
                v4u w; w.x = pk4_f8(v0[0], v0[1], v0[2], v0[3]); w.y = pk4_f8(v1[0], v1[1], v1[2], v1[3]); w.z = pk4_f8(v2[0], v2[1], v2[2], v2[3]); w.w = pk4_f8(v3[0], v3[1], v3[2], v3[3]);
                *(v4u*)(YE + (row * (unsigned)D + col0)) = w; }
    }
};
}

struct Args { const float* in[26]; float* out; unsigned char* ws; int ph_lo, ph_hi; };
enum { I_X = 0, I_C, I_CTX, I_CCTX, I_ADAW, I_ADAB, I_NMIX, I_NFFN, I_NFIN, I_WIN, I_WOUT, I_CONVW, I_CONVB, I_WA, I_BA, I_WX, I_BX, I_LAM,
       I_LBL, I_HNORM, I_RW, I_RB, I_EW13, I_EW2, I_SW13, I_SW2 };

struct Frame {
    LAS unsigned char* lds;
    int tid, lane, wave, G, vcu, bx;
    const float* const* in; float* out; unsigned char* ws;
};

DI void transpose_item(const float* W, int ldw, bf16* WT, int ldo, int k0, int n0, int orow0, LAS float* scr, int lane) {
    const int sub = lane >> 3, c4 = (lane & 7) * 4;
    f32x4 v[8];
#pragma unroll
    for (int i = 0; i < 8; ++i) v[i] = __builtin_nontemporal_load((const f32x4*)(W + (size_t)(k0 + 8 * i + sub) * ldw + n0 + c4));
#pragma unroll
    for (int i = 0; i < 8; ++i) { LAS float* d = scr + (8 * i + sub) * 33 + c4; d[0] = v[i].x; d[1] = v[i].y; d[2] = v[i].z; d[3] = v[i].w; }
    LDS_WAIT(); asm volatile("" ::: "memory");
    const int c = lane & 7;
#pragma unroll
    for (int j = 0; j < 4; ++j) { const int n = (lane >> 3) + 8 * j; const LAS float* s = scr + (8 * c) * 33 + n;
        v4u o; o.x = pk2(s[0 * 33], s[1 * 33]); o.y = pk2(s[2 * 33], s[3 * 33]); o.z = pk2(s[4 * 33], s[5 * 33]); o.w = pk2(s[6 * 33], s[7 * 33]);
        *(v4u*)(WT + (size_t)(orow0 + n) * ldo + k0 + 8 * c) = o; }
    LDS_WAIT(); asm volatile("" ::: "memory");
}
DI void transpose_item8(const float* W, int ldw, unsigned char* WT, int ldo, int k0, int n0, int orow0, float scale, LAS float* scr, int lane) {
    const int sub = lane >> 3, c4 = (lane & 7) * 4;
    f32x4 v[16];
#pragma unroll
    for (int i = 0; i < 16; ++i) v[i] = __builtin_nontemporal_load((const f32x4*)(W + (size_t)(k0 + 8 * i + sub) * ldw + n0 + c4));
#pragma unroll
    for (int i = 0; i < 16; ++i) { LAS float* d = scr + (8 * i + sub) * 33 + c4; d[0] = v[i].x; d[1] = v[i].y; d[2] = v[i].z; d[3] = v[i].w; }
    LDS_WAIT(); asm volatile("" ::: "memory");
    const int c = lane & 7;
#pragma unroll
    for (int j = 0; j < 4; ++j) { const int n = (lane >> 3) + 8 * j; const LAS float* sp = scr + (16 * c) * 33 + n;
        v4u o; o.x = pk4_f8(sp[0] * scale, sp[33] * scale, sp[66] * scale, sp[99] * scale); o.y = pk4_f8(sp[132] * scale, sp[165] * scale, sp[198] * scale, sp[231] * scale);
        o.z = pk4_f8(sp[264] * scale, sp[297] * scale, sp[330] * scale, sp[363] * scale); o.w = pk4_f8(sp[396] * scale, sp[429] * scale, sp[462] * scale, sp[495] * scale);
        *(v4u*)(WT + (size_t)(orow0 + n) * ldo + k0 + 16 * c) = o; }
    LDS_WAIT(); asm volatile("" ::: "memory");
}
DI int w13_row(int n) { const int half = n >> 8, idx = n & 255; return 256 * (idx >> 7) + 128 * half + (idx & 127); }

DI void phase_prologue(const Frame& F) {
    const float* const* in = F.in; unsigned char* ws = F.ws;
    {
        LAS float* sc = (LAS float*)F.lds;
        LAS float* red = (LAS float*)(F.lds + 17 * 1024 * 4);
        for (int i = F.tid; i < 17 * 1024; i += NTHR) { const int r = i >> 10, k = i & 1023; const float v = (r < 16) ? in[I_C][r * 1024 + k] : in[I_CCTX][k]; sc[i] = v / (1.0f + __expf(-v)); }
        __syncthreads();
        const float* aw = in[I_ADAW]; float* MOD = (float*)(ws + WS_MOD);
        for (int cg = F.bx; cg < 256; cg += F.G) {
            const int kg = F.tid >> 5, cl = F.tid & 31, col = cg * 24 + cl;
            float a[17];
#pragma unroll
            for (int r = 0; r < 17; ++r) a[r] = 0.f;
            if (cl < 24) {
                for (int kk = 0; kk < 64; ++kk) { const int k = kg * 64 + kk; const float w = aw[(size_t)k * 6144 + col];
#pragma unroll
                    for (int r = 0; r < 17; ++r) a[r] += sc[r * 1024 + k] * w; }
#pragma unroll
                for (int r = 0; r < 17; ++r) red[(kg * 17 + r) * 24 + cl] = a[r];
            }
            __syncthreads();
            if (F.tid < 17 * 24) { const int r = F.tid / 24, c2 = F.tid % 24; float s = 0.f;
                for (int g = 0; g < 16; ++g) s += red[(g * 17 + r) * 24 + c2];
                MOD[r * 6144 + cg * 24 + c2] = s + in[I_ADAB][cg * 24 + c2]; }
            __syncthreads();
        }
    }
    {
        float* LB = (float*)(ws + WS_TAB); float* SP = LB + 1024;
        const int gt = F.bx * NTHR + F.tid, GT = F.G * NTHR;
        for (int i = gt; i < 1024; i += GT) { const int d = i >> 9, c = i & 511;
            const float l0 = in[I_LBL][(d * 2 + 0) * 512 + c], l1 = in[I_LBL][(d * 2 + 1) * 512 + c];
            LB[i] = 1.0f / (1.0f + expf(l1 - l0));
            SP[i] = log1pf(expf(-in[I_LAM][i])); }
        bf16* WGT = (bf16*)(ws + WS_WGT);
        for (int i = gt; i < 2 * 2 * 8 * 64 * 64; i += GT) { const int ii = i & 63, j = (i >> 6) & 63, h = (i >> 12) & 7, g = (i >> 15) & 1, d = i >> 16;
            const float* src = g ? in[I_WX] : in[I_WA];
            WGT[i] = f2bf(src[((size_t)(d * 8 + h) * 64 + ii) * 64 + j]); }
    }
    {
        LAS float* scr = (LAS float*)(F.lds + F.wave * 16896);
        const int gw = F.vcu * NWAVES + F.wave, NGW = F.G * NWAVES;
        constexpr int IT_WIN = 16 * 112, IT_WOUT = 16 * 32, IT_WR = 16 * 8, IT_SW13 = 8 * 16, IT_SW2 = 2 * 32;
        LAS float* scr8 = (LAS float*)(F.lds + F.wave * 16896);
        constexpr int NIT = IT_WIN + IT_WOUT + IT_WR + IT_SW13 + IT_SW2;
        for (int it = gw; it < NIT; it += NGW) {
            int r = it;
            if (r < IT_WIN) { const int kb = r / 112, nb = r % 112; transpose_item(in[I_WIN], INC, (bf16*)(ws + WS_WIN), 1024, kb * 64, nb * 32, nb * 32, scr, F.lane); continue; } r -= IT_WIN;
            if (r < IT_WOUT) { const int kb = r / 32, nb = r % 32; transpose_item(in[I_WOUT], 1024, (bf16*)(ws + WS_WOUT), 1024, kb * 64, nb * 32, nb * 32, scr, F.lane); continue; } r -= IT_WOUT;
            if (r < IT_WR) { const int kb = r / 8, nb = r % 8; transpose_item(in[I_RW], 256, (bf16*)(ws + WS_WR), 1024, kb * 64, nb * 32, nb * 32, scr, F.lane); continue; } r -= IT_WR;
            if (r < IT_SW13) { const int kb = r / 16, nb = r % 16; transpose_item8(in[I_SW13], 512, ws + WS_SW13, 1024, kb * 128, nb * 32, w13_row(nb * 32), 32.0f, scr8, F.lane); continue; } r -= IT_SW13;
            { const int kb = r / 32, nb = r % 32; transpose_item8(in[I_SW2], 1024, ws + WS_SW2, 256, kb * 128, nb * 32, nb * 32, 16.0f, scr8, F.lane); }
        }
    }
}
DI void convert_experts(const Frame& F, int gw, int NGW) {
    const float* const* in = F.in; unsigned char* ws = F.ws;
    LAS float* scr = (LAS float*)(F.lds + F.wave * 16896);
    constexpr int IT_E13 = 256 * 128, IT_E2 = 256 * 64;
    for (int it = gw; it < IT_E13 + IT_E2; it += NGW) {
        int r = it;
        if (r < IT_E13) { const int e = r >> 7, q = r & 127, kb = q >> 4, nb = q & 15;
            transpose_item8(in[I_EW13] + (size_t)e * 1024 * 512, 512, ws + WS_EW13 + (size_t)e * 512 * 1024, 1024, kb * 128, nb * 32, w13_row(nb * 32), 32.0f, scr, F.lane); continue; } r -= IT_E13;
        { const int e = r >> 6, q = r & 63, kb = q >> 5, nb = q & 31;
            transpose_item8(in[I_EW2] + (size_t)e * 256 * 1024, 1024, ws + WS_EW2 + (size_t)e * 1024 * 256, 256, kb * 128, nb * 32, nb * 32, 16.0f, scr, F.lane); }
    }
}

DI void phase_norm_rows(const Frame& F, int mode) {
    const float* MOD = (const float*)(F.ws + WS_MOD);
    const int gw = F.bx * NWAVES + F.wave, NGW = F.G * NWAVES;
    const int nrows = mode == 0 ? MTOT : NTOK;
    const float* gain = mode == 0 ? F.in[I_NMIX] : F.in[I_NFFN];
    bf16* dst = (bf16*)(F.ws + (mode == 0 ? WS_HX : WS_HX2));
    const int sh_off = mode == 0 ? 0 : 3072, sc_off = mode == 0 ? 1024 : 4096;
    const int per = (nrows + NGW - 1) / NGW, r0 = gw * per, r1 = (r0 + per < nrows) ? r0 + per : nrows;
    f32x4 gn[4];
#pragma unroll
    for (int j = 0; j < 4; ++j) gn[j] = *(const f32x4*)(gain + 4 * F.lane + 256 * j);
    auto rowsrc = [&](int m) -> const float* {
        if (mode == 0) return (m < NTOK) ? F.in[I_X] + (size_t)m * D : F.in[I_CTX] + (size_t)(m - NTOK) * D;
        return (const float*)(F.ws + WS_X1) + (size_t)m * D; };
    f32x4 va[4], vb[4], ga[4], sb4[4]; int cur_mr = -1;
#pragma unroll
    for (int j = 0; j < 4; ++j) { ga[j] = gn[j]; sb4[j] = gn[j]; }
    if (r0 < r1) {
#pragma unroll
        for (int j = 0; j < 4; ++j) va[j] = *(const f32x4*)(rowsrc(r0) + 4 * F.lane + 256 * j);
        const int mb = (r0 + 1 < r1) ? r0 + 1 : r0;
#pragma unroll
        for (int j = 0; j < 4; ++j) vb[j] = *(const f32x4*)(rowsrc(mb) + 4 * F.lane + 256 * j);
    }
#pragma unroll 1
    for (int m = r0; m < r1; m += 2) {
        f32x4 ca[4], cb[4];
#pragma unroll
        for (int j = 0; j < 4; ++j) { ca[j] = va[j]; cb[j] = vb[j]; }
        const bool hasb = (m + 1 < r1);
        { const int na = (m + 2 < r1) ? m + 2 : m, nb = (m + 3 < r1) ? m + 3 : na;
#pragma unroll
          for (int j = 0; j < 4; ++j) { va[j] = *(const f32x4*)(rowsrc(na) + 4 * F.lane + 256 * j); vb[j] = *(const f32x4*)(rowsrc(nb) + 4 * F.lane + 256 * j); } }
        float sa = 0.f, sb = 0.f;
#pragma unroll
        for (int j = 0; j < 4; ++j) { sa += (ca[j].x * ca[j].x + ca[j].y * ca[j].y) + (ca[j].z * ca[j].z + ca[j].w * ca[j].w); sb += (cb[j].x * cb[j].x + cb[j].y * cb[j].y) + (cb[j].z * cb[j].z + cb[j].w * cb[j].w); }
        const float rsa = rsqrtf(wave_sum_fast(sa) * (1.0f / D) + EPS), rsb = rsqrtf(wave_sum_fast(sb) * (1.0f / D) + EPS);
#pragma unroll
        for (int q = 0; q < 2; ++q) {
            if (q == 1 && !hasb) break;
            const int mm = m + q; const float rs = q ? rsb : rsa;
            const int mr = (mode == 0 && mm >= NTOK) ? 16 : (mm >> 11);
            if (mr != cur_mr) { cur_mr = mr;
#pragma unroll
                for (int j = 0; j < 4; ++j) { const int c = 4 * F.lane + 256 * j;
                    ga[j] = gn[j] * (*(const f32x4*)(MOD + mr * 6144 + sc_off + c) + 1.0f); sb4[j] = *(const f32x4*)(MOD + mr * 6144 + sh_off + c); } }
#pragma unroll
            for (int j = 0; j < 4; ++j) { const int c = 4 * F.lane + 256 * j;
                const f32x4 v = q ? cb[j] : ca[j];
                const f32x4 y = (v * rs) * ga[j] + sb4[j];
                v2u w; w.x = pk2(y.x, y.y); w.y = pk2(y.z, y.w);
                *(v2u*)(dst + (size_t)mm * D + c) = w;
                if (mode == 1) *(unsigned*)(F.ws + WS_HX2F + (size_t)mm * D + c) = pk4_f8(y.x, y.y, y.z, y.w); }
        }
    }
}

constexpr int LT_STR = 520;
constexpr int L_RT = 0;
constexpr int L_GT = 69888;
static_assert(L_GT + 64 * LT_STR * 2 <= LDS_MISC, "lru lds");
template <bool FINAL> DI void lru_tile(const Frame& F, int b, int s) {
    const bf16* P = (const bf16*)(F.ws + WS_P);
    const int h = F.wave, fr = F.lane & 15, fq = F.lane >> 4;
    int prow0, L, t0;
    if (s < 4) { prow0 = NTOK + b * CTXL + 64 * s; L = CTXL; t0 = 64 * s; } else { prow0 = b * SEQ + 64 * (s - 4); L = SEQ; t0 = 64 * (s - 4); }
    LAS bf16* RT = (LAS bf16*)(F.lds + L_RT); LAS bf16* GT = (LAS bf16*)(F.lds + L_GT);
#pragma unroll
    for (int it = 0; it < 9; ++it) { const int p = F.tid + it * NTHR;
        if (p < 67 * 64) { const int row = p >> 6, pc = p & 63, ts = t0 + row - 1;
            v4u v = {0u, 0u, 0u, 0u};
            if (ts >= 0 && ts < L) v = *(const v4u*)(P + (size_t)(prow0 + row - 1) * INC + 8 * pc);
            *(LAS v4u*)(RT + row * LT_STR + 8 * pc) = v; } }
    if (FINAL) {
#pragma unroll
        for (int it = 0; it < 8; ++it) { const int p = F.tid + it * NTHR; const int row = p >> 6, pc = p & 63;
            *(LAS v4u*)(GT + row * LT_STR + 8 * pc) = *(const v4u*)(P + (size_t)(prow0 + row) * INC + 512 + 8 * pc); } }
    __syncthreads();
    bf16x8 Af[4][2];
#pragma unroll
    for (int ks = 0; ks < 2; ++ks) {
        const int c0 = 64 * h + 32 * ks + 8 * fq;
        float cw[4][8], cb[8];
#pragma unroll
        for (int k = 0; k < 4; ++k) { const f32x4 w0 = *(const f32x4*)(F.in[I_CONVW] + k * 512 + c0), w1 = *(const f32x4*)(F.in[I_CONVW] + k * 512 + c0 + 4);
            cw[k][0] = w0.x; cw[k][1] = w0.y; cw[k][2] = w0.z; cw[k][3] = w0.w; cw[k][4] = w1.x; cw[k][5] = w1.y; cw[k][6] = w1.z; cw[k][7] = w1.w; }
        { const f32x4 w0 = *(const f32x4*)(F.in[I_CONVB] + c0), w1 = *(const f32x4*)(F.in[I_CONVB] + c0 + 4);
            cb[0] = w0.x; cb[1] = w0.y; cb[2] = w0.z; cb[3] = w0.w; cb[4] = w1.x; cb[5] = w1.y; cb[6] = w1.z; cb[7] = w1.w; }
        const LAS bf16* rbase = RT + fr * LT_STR + c0;
#pragma unroll
        for (int tt = 0; tt < 4; ++tt) {
            float u[8];
#pragma unroll
            for (int j = 0; j < 8; ++j) u[j] = cb[j];
#pragma unroll
            for (int k = 0; k < 4; ++k) { const v4u r8 = *(const LAS v4u*)(rbase + (16 * tt + k) * LT_STR);
                u[0] += cw[k][0] * bflo(r8.x); u[1] += cw[k][1] * bfhi(r8.x); u[2] += cw[k][2] * bflo(r8.y); u[3] += cw[k][3] * bfhi(r8.y);
                u[4] += cw[k][4] * bflo(r8.z); u[5] += cw[k][5] * bfhi(r8.z); u[6] += cw[k][6] * bflo(r8.w); u[7] += cw[k][7] * bfhi(r8.w); }
            v4u w; w.x = pk2(u[0], u[1]); w.y = pk2(u[2], u[3]); w.z = pk2(u[4], u[5]); w.w = pk2(u[6], u[7]);
            Af[tt][ks] = __builtin_bit_cast(bf16x8, w);
        }
    }
    const bf16* WGT = (const bf16*)(F.ws + WS_WGT);
    const float* SP = (const float*)(F.ws + WS_TAB) + 1024;
    LAS bf16* HL = RT;
    LAS bf16* hlb = HL + (4 * fq) * LT_STR + 64 * h + fr;
    LAS bf16* gtb = GT + (4 * fq) * LT_STR + 64 * h + fr;
#pragma unroll 1
    for (int dir = 0; dir < 2; ++dir) {
#pragma unroll 1
        for (int nt = 0; nt < 4; ++nt) {
            const int cj = 64 * h + 16 * nt + fr;
            bf16x8 Ba[2], Bx[2], Id[2];
#pragma unroll
            for (int ks = 0; ks < 2; ++ks) {
                Ba[ks] = *(const bf16x8*)(WGT + ((size_t)((dir * 2 + 0) * 8 + h) * 64 + 16 * nt + fr) * 64 + 32 * ks + 8 * fq);
                Bx[ks] = *(const bf16x8*)(WGT + ((size_t)((dir * 2 + 1) * 8 + h) * 64 + 16 * nt + fr) * 64 + 32 * ks + 8 * fq);
#pragma unroll
                for (int jj = 0; jj < 8; ++jj) Id[ks][jj] = (32 * ks + 8 * fq + jj == 16 * nt + fr) ? (short)0x3F80 : (short)0;
            }
            const float ba = F.in[I_BA][dir * 512 + cj], bx = F.in[I_BX][dir * 512 + cj], sp = SP[dir * 512 + cj];
            float cin = 0.f, ptot = 1.f;
            if (FINAL) cin = ((const float*)(F.ws + WS_CIN))[((size_t)(dir * NB + b) * NSEQT + s) * 512 + cj];
#pragma unroll
            for (int tti = 0; tti < 4; ++tti) {
                const int tt = dir ? 3 - tti : tti;
                const bf16x8 A0 = dir ? Af[3 - tti][0] : Af[tti][0], A1 = dir ? Af[3 - tti][1] : Af[tti][1];
                f32x4 pa = {0.f, 0.f, 0.f, 0.f}, px = {0.f, 0.f, 0.f, 0.f}, uc = {0.f, 0.f, 0.f, 0.f};
                pa = __builtin_amdgcn_mfma_f32_16x16x32_bf16(A0, Ba[0], pa, 0, 0, 0); pa = __builtin_amdgcn_mfma_f32_16x16x32_bf16(A1, Ba[1], pa, 0, 0, 0);
                px = __builtin_amdgcn_mfma_f32_16x16x32_bf16(A0, Bx[0], px, 0, 0, 0); px = __builtin_amdgcn_mfma_f32_16x16x32_bf16(A1, Bx[1], px, 0, 0, 0);
                uc = __builtin_amdgcn_mfma_f32_16x16x32_bf16(A0, Id[0], uc, 0, 0, 0); uc = __builtin_amdgcn_mfma_f32_16x16x32_bf16(A1, Id[1], uc, 0, 0, 0);
                float av[4], bv[4];
#pragma unroll
                for (int ri = 0; ri < 4; ++ri) { const float pav = dir ? pa[3 - ri] : pa[ri], pxv = dir ? px[3 - ri] : px[ri], ucv = dir ? uc[3 - ri] : uc[ri];
                    const float rg = sigm(pav + ba), ig = sigm(pxv + bx);
                    const float a = expf_(-8.0f * rg * sp); av[ri] = a; bv[ri] = __builtin_amdgcn_sqrtf(fmaxf(1.0f - a * a, 0.f)) * ig * ucv; }
                float pl = 1.f, hl = 0.f;
#pragma unroll
                for (int ri = 0; ri < 4; ++ri) { hl = av[ri] * hl + bv[ri]; pl *= av[ri]; }
                float pg[4], hg[4];
#pragma unroll
                for (int gi = 0; gi < 4; ++gi) { const int g = dir ? 3 - gi : gi; pg[gi] = __shfl(pl, fr + 16 * g); hg[gi] = __shfl(hl, fr + 16 * g); }
                const int myg = dir ? 3 - fq : fq;
                float mycin = cin, run = cin;
#pragma unroll
                for (int gi = 0; gi < 4; ++gi) { if (gi == myg) mycin = run; run = pg[gi] * run + hg[gi]; }
                if (FINAL) { float hc = mycin;
#pragma unroll
                    for (int ri = 0; ri < 4; ++ri) { const int r = dir ? 3 - ri : ri; hc = av[ri] * hc + bv[ri];
                        const int o = (16 * tt + r) * LT_STR + 16 * nt;
                        if (dir == 0) hlb[o] = f2bf(hc);
                        else gtb[o] = f2bf(bf2f(gtb[o]) * (bf2f(hlb[o]) + hc)); } }
                else ptot *= (pg[0] * pg[1]) * (pg[2] * pg[3]);
                cin = run;
            }
            if (!FINAL && fq == 0) { const size_t o = ((size_t)(dir * NB + b) * NSEQT + s) * 512 + cj;
                ((float*)(F.ws + WS_SUMA))[o] = ptot; ((float*)(F.ws + WS_SUMH))[o] = cin; }
        }
    }
    if (FINAL) {
        __syncthreads();
        bf16* YL = (bf16*)(F.ws + WS_YL);
#pragma unroll
        for (int it = 0; it < 8; ++it) { const int p = F.tid + it * NTHR; const int row = p >> 6, pc = p & 63;
            *(v4u*)(YL + (size_t)(prow0 + row) * D + 8 * pc) = *(const LAS v4u*)(GT + row * LT_STR + 8 * pc); } }
    __syncthreads();
}
DI void phase_lru_pass1(const Frame& F) {
    for (int it = F.bx; it < NB * NSEQT; it += F.G) lru_tile<false>(F, it / NSEQT, it % NSEQT);
}
DI void phase_lru_carry(const Frame& F) {
    if (F.wave != 0) return;
    const float* SA = (const float*)(F.ws + WS_SUMA); const float* SH = (const float*)(F.ws + WS_SUMH); float* CI = (float*)(F.ws + WS_CIN);
    for (int id = F.bx * 64 + F.lane; id < 2 * NB * 512; id += F.G * 64) {
        const int dir = id >> 13, b = (id >> 9) & 15, c = id & 511;
        float x = 0.f; const size_t o0 = (size_t)(dir * NB + b) * NSEQT * 512 + c;
#pragma unroll
        for (int hf = 0; hf < 2; ++hf) {
            float av[18], hv[18];
#pragma unroll
            for (int q = 0; q < 18; ++q) { const int st = 18 * hf + q, s = dir ? (st < 4 ? 3 - st : 39 - st) : st; av[q] = SA[o0 + (size_t)s * 512]; hv[q] = SH[o0 + (size_t)s * 512]; }
#pragma unroll
            for (int q = 0; q < 18; ++q) { const int st = 18 * hf + q, s = dir ? (st < 4 ? 3 - st : 39 - st) : st; CI[o0 + (size_t)s * 512] = x; x = av[q] * x + hv[q]; }
        }
    }
}
DI void phase_lru_pass2(const Frame& F) {
    for (int it = F.bx; it < NB * 32; it += F.G) lru_tile<true>(F, it >> 5, 4 + (it & 31));
}

constexpr int HS = 144, SCS = 40;
constexpr int H_Q = 0, H_LF = H_Q + 32 * HS * 2, H_V = H_LF + 32 * HS * 2, H_QT = H_V + 32 * HS * 2, H_KT = H_QT + 32 * HS * 2, H_KH = H_KT + 32 * HS * 2,
              H_SC = H_KH + 32 * HS * 2, H_DEC = H_SC + 32 * SCS * 2, H_SET = H_DEC + 512;
static_assert(2 * H_SET <= RING_BYTES, "hgrn lds");
typedef short s16x4 __attribute__((ext_vector_type(4)));
DI bf16x8 tr_frag(const LAS bf16* tile, int c0, int lane) {
    const int g = lane >> 4, q = (lane & 15) >> 2, p = lane & 3;
    const LAS bf16* a = tile + (8 * g + q) * HS + c0 + 4 * p;
    const s16x4 lo = __builtin_amdgcn_ds_read_tr16_b64_v4i16((LAS s16x4*)a), hi = __builtin_amdgcn_ds_read_tr16_b64_v4i16((LAS s16x4*)(a + 4 * HS));
    bf16x8 r; r[0] = lo[0]; r[1] = lo[1]; r[2] = lo[2]; r[3] = lo[3]; r[4] = hi[0]; r[5] = hi[1]; r[6] = hi[2]; r[7] = hi[3]; return r;
}
DI void hgrn_chain(const Frame& F, int item) {
    const int b = item >> 3, h = (item >> 1) & 3, dir = item & 1;
    const bf16* P = (const bf16*)(F.ws + WS_P);
    bf16* O = (bf16*)(F.ws + (dir ? WS_OB : WS_OF));
    const int w = F.wave, lane = F.lane, fr = lane & 15, g = lane >> 4;
    const int li = F.tid >> 4, lp = F.tid & 15;
    f32x4 S[8];
#pragma unroll
    for (int t = 0; t < 8; ++t) S[t] = (f32x4){0.f, 0.f, 0.f, 0.f};
    auto prow = [&](int c, int i) -> size_t {
        const int ii = dir ? 31 - i : i;
        if (c < 8) { const int cc = dir ? 7 - c : c; return (size_t)NTOK + b * CTXL + 32 * cc + ii; }
        const int col = dir ? 63 - (c - 8) : (c - 8); return (size_t)b * SEQ + ii * 64 + col; };
    const size_t coff = 128 * h + 8 * lp;
    v4u rqA, rlA, rvA, rqB, rlB, rvB;
    { const bf16* rp = P + prow(0, li) * INC + coff; rqA = *(const v4u*)(rp + 1024); rvA = *(const v4u*)(rp + 1536); rlA = *(const v4u*)(rp + 2048 + 512 * dir); }
    { const bf16* rp = P + prow(1, li) * INC + coff; rqB = *(const v4u*)(rp + 1024); rvB = *(const v4u*)(rp + 1536); rlB = *(const v4u*)(rp + 2048 + 512 * dir); }
    bf16x8 Tri[2];
#pragma unroll
    for (int it = 0; it < 2; ++it)
#pragma unroll
        for (int jj = 0; jj < 8; ++jj) Tri[it][jj] = (8 * g + jj <= 16 * it + fr) ? (short)0x3F80 : (short)0;
#define HG_BODY(c, RQ, RL, RV, SET) do { \
        LAS unsigned char* base = F.lds + (SET) * H_SET; \
        LAS bf16* Qr = (LAS bf16*)(base + H_Q); LAS bf16* LFr = (LAS bf16*)(base + H_LF); LAS bf16* Vr = (LAS bf16*)(base + H_V); \
        LAS bf16* QT = (LAS bf16*)(base + H_QT); LAS bf16* KT = (LAS bf16*)(base + H_KT); LAS bf16* KH = (LAS bf16*)(base + H_KH); \
        LAS bf16* SC = (LAS bf16*)(base + H_SC); LAS float* DEC = (LAS float*)(base + H_DEC); \
        const bool isctx = (c) < 8; \
        *(LAS v4u*)(Qr + li * HS + 8 * lp) = RQ; *(LAS v4u*)(LFr + li * HS + 8 * lp) = RL; *(LAS v4u*)(Vr + li * HS + 8 * lp) = RV; \
        if ((c) + 2 < 72) { const bf16* rp = P + prow((c) + 2, li) * INC + coff; RQ = *(const v4u*)(rp + 1024); RV = *(const v4u*)(rp + 1536); RL = *(const v4u*)(rp + 2048 + 512 * dir); } \
        __syncthreads(); \
        {   \
            const bf16x8 Al = tr_frag(LFr, 16 * w, lane); \
            f32x4 Gm[2]; \
            _Pragma("unroll") for (int it = 0; it < 2; ++it) Gm[it] = __builtin_amdgcn_mfma_f32_16x16x32_bf16(Al, Tri[it], (f32x4){0.f, 0.f, 0.f, 0.f}, 0, 0, 0); \
            f32x4 dec; \
            _Pragma("unroll") for (int r = 0; r < 4; ++r) dec[r] = expf_(__shfl(Gm[1][r], (lane & 48) | 15)); \
            if (fr == 0) *(LAS f32x4*)(DEC + 16 * w + 4 * g) = dec; \
            _Pragma("unroll") for (int it = 0; it < 2; ++it) { const int i = 16 * it + fr, d0 = 16 * w + 4 * g; \
                const v2u q4 = *(const LAS v2u*)(Qr + i * HS + d0), l4 = *(const LAS v2u*)(LFr + i * HS + d0); \
                const float qv[4] = {bflo(q4.x), bfhi(q4.x), bflo(q4.y), bfhi(q4.y)}, lv[4] = {bflo(l4.x), bfhi(l4.x), bflo(l4.y), bfhi(l4.y)}; \
                float qt[4], kt[4], kh[4]; \
                _Pragma("unroll") for (int r = 0; r < 4; ++r) { const float eg = expf_(Gm[it][r]), ieg = rcpf_(eg), kk = 1.0f - expf_(lv[r]); qt[r] = qv[r] * eg; kt[r] = kk * ieg; kh[r] = kk * dec[r] * ieg; } \
                *(LAS v2u*)(QT + i * HS + d0) = (v2u){pk2(qt[0], qt[1]), pk2(qt[2], qt[3])}; \
                *(LAS v2u*)(KT + i * HS + d0) = (v2u){pk2(kt[0], kt[1]), pk2(kt[2], kt[3])}; \
                *(LAS v2u*)(KH + i * HS + d0) = (v2u){pk2(kh[0], kh[1]), pk2(kh[2], kh[3])}; } \
        } \
        __syncthreads(); \
        f32x4 oacc[2]; oacc[0] = (f32x4){0.f, 0.f, 0.f, 0.f}; oacc[1] = (f32x4){0.f, 0.f, 0.f, 0.f}; \
        if (!isctx) { \
            if (w < 4) {   \
                const int it = w >> 1, jt = w & 1; f32x4 sc = {0.f, 0.f, 0.f, 0.f}; \
                _Pragma("unroll") for (int ks = 0; ks < 4; ++ks) { const bf16x8 ak = *(const LAS bf16x8*)(KT + (16 * jt + fr) * HS + 32 * ks + 8 * g), bq = *(const LAS bf16x8*)(QT + (16 * it + fr) * HS + 32 * ks + 8 * g); \
                    sc = __builtin_amdgcn_mfma_f32_16x16x32_bf16(ak, bq, sc, 0, 0, 0); } \
                const int i = 16 * it + fr, j0 = 16 * jt + 4 * g; \
                *(LAS v2u*)(SC + i * SCS + j0) = (v2u){pk2(j0 <= i ? sc[0] : 0.f, j0 + 1 <= i ? sc[1] : 0.f), pk2(j0 + 2 <= i ? sc[2] : 0.f, j0 + 3 <= i ? sc[3] : 0.f)}; } \
              \
            _Pragma("unroll") for (int ks = 0; ks < 4; ++ks) { \
                v4u sb; sb.x = pk2(S[2 * ks][0], S[2 * ks][1]); sb.y = pk2(S[2 * ks][2], S[2 * ks][3]); sb.z = pk2(S[2 * ks + 1][0], S[2 * ks + 1][1]); sb.w = pk2(S[2 * ks + 1][2], S[2 * ks + 1][3]); \
                const bf16x8 As = __builtin_bit_cast(bf16x8, sb); \
                _Pragma("unroll") for (int it = 0; it < 2; ++it) { const v2u a0 = *(const LAS v2u*)(QT + (16 * it + fr) * HS + 32 * ks + 4 * g), a1 = *(const LAS v2u*)(QT + (16 * it + fr) * HS + 32 * ks + 16 + 4 * g); \
                    v4u bv; bv.x = a0.x; bv.y = a0.y; bv.z = a1.x; bv.w = a1.y; \
                    oacc[it] = __builtin_amdgcn_mfma_f32_16x16x32_bf16(As, __builtin_bit_cast(bf16x8, bv), oacc[it], 0, 0, 0); } } \
        } \
          \
        const bf16x8 Vf = tr_frag(Vr, 16 * w, lane); \
        _Pragma("unroll") for (int t = 0; t < 8; ++t) { const f32x4 dv = *(const LAS f32x4*)(DEC + 16 * t + 4 * g); \
            const bf16x8 Kf = tr_frag(KH, 16 * t, lane); \
            S[t] = __builtin_amdgcn_mfma_f32_16x16x32_bf16(Kf, Vf, S[t] * dv, 0, 0, 0); } \
        if (!isctx) { \
            __syncthreads(); \
            const int col = dir ? 63 - ((c) - 8) : ((c) - 8); \
            _Pragma("unroll") for (int it = 0; it < 2; ++it) { const bf16x8 bs = *(const LAS bf16x8*)(SC + (16 * it + fr) * SCS + 8 * g); \
                oacc[it] = __builtin_amdgcn_mfma_f32_16x16x32_bf16(Vf, bs, oacc[it], 0, 0, 0); \
                const int i = 16 * it + fr, ii = dir ? 31 - i : i; \
                *(v2u*)(O + ((size_t)b * SEQ + ii * 64 + col) * 512 + 128 * h + 16 * w + 4 * g) = (v2u){pk2(oacc[it][0], oacc[it][1]), pk2(oacc[it][2], oacc[it][3])}; } \
        } \
    } while (0)
#pragma unroll 1
    for (int c = 0; c < 72; c += 2) {
        HG_BODY(c, rqA, rlA, rvA, 0);
        HG_BODY(c + 1, rqB, rlB, rvB, 1);
    }
#undef HG_BODY
    __syncthreads();
}
DI void phase_hgrn(const Frame& F) {
    for (int it = F.bx; it < NB * 4 * 2; it += F.G) hgrn_chain(F, it);
}
DI void phase_y2(const Frame& F) {
    const bf16* OFp = (const bf16*)(F.ws + WS_OF); const bf16* OBp = (const bf16*)(F.ws + WS_OB); const bf16* P = (const bf16*)(F.ws + WS_P); bf16* YL = (bf16*)(F.ws + WS_YL);
    const int gw = F.bx * NWAVES + F.wave, NGW = F.G * NWAVES;
    const int c = 8 * F.lane;
    const f32x4 g0 = *(const f32x4*)(F.in[I_HNORM] + c), g1 = *(const f32x4*)(F.in[I_HNORM] + c + 4);
    const float gn[8] = {g0.x, g0.y, g0.z, g0.w, g1.x, g1.y, g1.z, g1.w};
    for (int m = gw; m < NTOK; m += NGW) {
        const v4u a = *(const v4u*)(OFp + (size_t)m * 512 + c), bq = *(const v4u*)(OBp + (size_t)m * 512 + c), sg = *(const v4u*)(P + (size_t)m * INC + 3072 + c);
        float o[8] = {bflo(a.x) + bflo(bq.x), bfhi(a.x) + bfhi(bq.x), bflo(a.y) + bflo(bq.y), bfhi(a.y) + bfhi(bq.y), bflo(a.z) + bflo(bq.z), bfhi(a.z) + bfhi(bq.z), bflo(a.w) + bflo(bq.w), bfhi(a.w) + bfhi(bq.w)};
        const float sgv[8] = {bflo(sg.x), bfhi(sg.x), bflo(sg.y), bfhi(sg.y), bflo(sg.z), bfhi(sg.z), bflo(sg.w), bfhi(sg.w)};
        float ss = 0.f;
#pragma unroll
        for (int j = 0; j < 8; ++j) ss += o[j] * o[j];
        ss += __shfl_xor(ss, 1); ss += __shfl_xor(ss, 2); ss += __shfl_xor(ss, 4); ss += __shfl_xor(ss, 8);
        const float rs = rsqrtf(ss * (1.0f / 128.0f) + EPS);
#pragma unroll
        for (int j = 0; j < 8; ++j) o[j] = o[j] * rs * gn[j] * sgv[j];
        v4u wv; wv.x = pk2(o[0], o[1]); wv.y = pk2(o[2], o[3]); wv.z = pk2(o[4], o[5]); wv.w = pk2(o[6], o[7]);
        *(v4u*)(YL + (size_t)m * D + 512 + c) = wv;
    }
}

DI unsigned fkey(float f) { const unsigned u = __float_as_uint(f); return u ^ ((u >> 31) ? 0xFFFFFFFFu : 0x80000000u); }
template <int CTRL> DI unsigned dpp_u(unsigned v) { return (unsigned)__builtin_amdgcn_update_dpp(0, (int)v, CTRL, 0xf, 0xf, true); }
template <int CTRL> DI float dpp_f(float v) { return __uint_as_float(dpp_u<CTRL>(__float_as_uint(v))); }
DI unsigned umax_(unsigned a, unsigned b) { return a > b ? a : b; }
DI float readlane_f(float v, int lane) { return __uint_as_float((unsigned)__builtin_amdgcn_readlane((int)__float_as_uint(v), lane)); }
DI void phase_route(const Frame& F) {
    const float* LOGIT = (const float*)(F.ws + WS_LOGIT); const float* rb = F.in[I_RB];
    v2u* ROUTE = (v2u*)(F.ws + WS_ROUTE); int* HIST = (int*)(F.ws + WS_HIST);
    LAS unsigned* hist = (LAS unsigned*)F.lds;
    const int l = F.lane;
    const f32x4 rbv = *(const f32x4*)(rb + 4 * l);
    const float NEG = -__builtin_inff();
    for (int blk = F.bx; blk < NTOK / 128; blk += F.G) {
        if (F.tid < 256) hist[F.tid] = 0u;
        __syncthreads();
        const int tok0 = blk * 128 + F.wave * 16;
        f32x4 lg = *(const f32x4*)(LOGIT + (size_t)tok0 * NE + 4 * l);
#pragma unroll 1
        for (int ti = 0; ti < 16; ++ti) {
            const int tok = tok0 + ti;
            f32x4 lgn = {0.f, 0.f, 0.f, 0.f};
            if (ti + 1 < 16) lgn = *(const f32x4*)(LOGIT + (size_t)(tok + 1) * NE + 4 * l);
            float sc[4], bs[4];
#pragma unroll
            for (int k = 0; k < 4; ++k) { sc[k] = rcpf_(1.0f + expf_(-lg[k])); bs[k] = sc[k] + rbv[k]; }
            float m1 = NEG, m2 = NEG;
#pragma unroll
            for (int k = 0; k < 4; ++k) { const float v = bs[k]; if (v > m1) { m2 = m1; m1 = v; } else if (v > m2) m2 = v; }
            { float o1 = dpp_f<0xB1>(m1), o2 = dpp_f<0xB1>(m2); float n1 = fmaxf(m1, o1), n2 = fmaxf(fminf(m1, o1), fmaxf(m2, o2)); m1 = n1; m2 = n2;
              o1 = dpp_f<0x4E>(m1); o2 = dpp_f<0x4E>(m2); n1 = fmaxf(m1, o1); n2 = fmaxf(fminf(m1, o1), fmaxf(m2, o2)); m1 = n1; m2 = n2;
              const float a1 = dpp_f<0x104>(m1), a2 = dpp_f<0x104>(m2), c1 = dpp_f<0x114>(m1), c2 = dpp_f<0x114>(m2);
              o1 = (l & 4) ? c1 : a1; o2 = (l & 4) ? c2 : a2; n1 = fmaxf(m1, o1); n2 = fmaxf(fminf(m1, o1), fmaxf(m2, o2)); m1 = n1; m2 = n2; }
            const float gs = m1 + m2; const int g = l >> 3; int rank = 0;
#pragma unroll
            for (int gg = 0; gg < 8; ++gg) { const float og = readlane_f(gs, gg * 8); rank += (og > gs || (og == gs && gg < g)) ? 1 : 0; }
            const bool sel = rank < 4;
            unsigned cv[4];
#pragma unroll
            for (int k = 0; k < 4; ++k) cv[k] = sel ? fkey(bs[k]) : 0u;
            float sum = 0.f, mysc = 0.f; int myexp = 0;
#pragma unroll
            for (int r = 0; r < TOPK; ++r) {
                unsigned bvk = cv[0]; int bk = 0;
#pragma unroll
                for (int k = 1; k < 4; ++k) if (cv[k] > bvk) { bvk = cv[k]; bk = k; }
                const float bsc = bk == 0 ? sc[0] : bk == 1 ? sc[1] : bk == 2 ? sc[2] : sc[3];
                unsigned m = bvk;
                m = umax_(m, dpp_u<0xB1>(m)); m = umax_(m, dpp_u<0x4E>(m)); m = umax_(m, dpp_u<0x124>(m)); m = umax_(m, dpp_u<0x128>(m));
                const unsigned M = umax_(umax_((unsigned)__builtin_amdgcn_readlane((int)m, 0), (unsigned)__builtin_amdgcn_readlane((int)m, 16)),
                                         umax_((unsigned)__builtin_amdgcn_readlane((int)m, 32), (unsigned)__builtin_amdgcn_readlane((int)m, 48)));
                const unsigned long long bal = __ballot(bvk == M);
                const int L = __builtin_ctzll(bal);
                const int kL = __builtin_amdgcn_readlane(bk, L);
                const float se = readlane_f(bsc, L);
                const int e = 4 * L + kL;
                if (l == L) {
#pragma unroll
                    for (int k = 0; k < 4; ++k) if (k == bk) cv[k] = 0u; }
                sum += se; if (l == r) { myexp = e; mysc = se; }
            }
            if (l < TOPK) { ROUTE[(size_t)tok * TOPK + l] = (v2u){(unsigned)myexp, __float_as_uint(mysc * rcpf_(sum) * 2.5f)}; (void)__hip_atomic_fetch_add(hist + myexp, 1u, __ATOMIC_RELAXED, __HIP_MEMORY_SCOPE_WORKGROUP); }
            lg = lgn;
        }
        __syncthreads();
        if (F.tid < 256) HIST[blk * 256 + F.tid] = (int)hist[F.tid];
        __syncthreads();
    }
}
DI void phase_lists(const Frame& F) {
    const v2u* ROUTE = (const v2u*)(F.ws + WS_ROUTE); const int* HIST = (const int*)(F.ws + WS_HIST);
    unsigned* cnt = (unsigned*)(F.ws + WS_CTL) + CW_CNT; v2u* LIST = (v2u*)(F.ws + WS_LIST);
    LAS int* part = (LAS int*)F.lds;
    LAS int* lbase = part + 1024; LAS unsigned* lcnt = (LAS unsigned*)(lbase + 256); LAS int* ltot = lbase + 512; LAS int* lts = lbase + 768;
    int* INV = (int*)(F.ws + WS_INV);
    for (int blk = F.bx; blk < NTOK / 128; blk += F.G) {
        const int e = F.tid & 255, hf = F.tid >> 8;
        int below = 0, all = 0;
#pragma unroll 8
        for (int q = 0; q < 128; ++q) { const int row = hf * 128 + q; const int v = HIST[row * 256 + e]; all += v; below += (row < blk) ? v : 0; }
        part[hf * 512 + e] = below; part[hf * 512 + 256 + e] = all;
        __syncthreads();
        if (F.tid < 256) { lbase[e] = part[e] + part[512 + e]; lcnt[e] = 0u; const int tot = part[256 + e] + part[768 + e]; ltot[e] = tot; if (blk == 0) cnt[e] = (unsigned)tot; }
        __syncthreads();
        if (F.tid == 0) { int s2 = 0; for (int q = 0; q < 256; ++q) { lts[q] = s2; s2 += (ltot[q] + 255) >> 8; } }
        __syncthreads();
#pragma unroll
        for (int q = 0; q < 2; ++q) { const int a = F.tid + q * NTHR; const unsigned tk = (unsigned)(blk * 128 * TOPK + a);
            const v2u rt = ROUTE[tk]; const unsigned pos = (unsigned)lbase[rt.x] + __hip_atomic_fetch_add(lcnt + rt.x, 1u, __ATOMIC_RELAXED, __HIP_MEMORY_SCOPE_WORKGROUP);
            LIST[(size_t)rt.x * LISTCAP + pos] = (v2u){tk, rt.y}; INV[tk] = lts[rt.x] * 256 + (int)pos; }
        __syncthreads();
    }
}

template <bool GATHER> DI void moe_setup(const Frame& F, int ncol, int& nunits, int& nfull) {
    LAS int* ts = (LAS int*)(F.lds + LDS_TS); LAS int* cl = (LAS int*)(F.lds + LDS_CNT); LAS int* ut = (LAS int*)(F.lds + LDS_UT); LAS int* idx = (LAS int*)(F.lds + LDS_IDX);
    const unsigned* cnt = (const unsigned*)(F.ws + WS_CTL) + CW_CNT;
    if (F.tid < 256) cl[F.tid] = (int)__hip_atomic_load(cnt + F.tid, __ATOMIC_RELAXED, __HIP_MEMORY_SCOPE_AGENT);
    __syncthreads();
    if (F.tid == 0) { int s = 0; for (int e = 0; e < 256; ++e) { ts[e] = s; s += (cl[e] + 255) >> 8; } ts[256] = s; }
    __syncthreads();
    const int Te = ts[256], T = Te + NTOK / 256;
    const int Fr = T / F.G, R = T - Fr * F.G, LU = R * ncol;
    const int nleft = (LU > F.vcu) ? (LU - F.vcu + F.G - 1) / F.G : 0;
    nfull = Fr * ncol; nunits = nfull + nleft;
    const v2u* LIST = (const v2u*)(F.ws + WS_LIST);
    for (int j = 0; j < Fr + nleft && j < 10; ++j) {
        int rt, pnl = 0;
        if (j < Fr) rt = j * F.G + F.vcu; else { const int lu = (j - Fr) * F.G + F.vcu; rt = Fr * F.G + lu / ncol; pnl = lu % ncol; }
        int e, pm, nrows;
        if (rt >= Te) { e = 256; pm = rt - Te; nrows = 256; }
        else { int lo = 0, hi = 256; while (hi - lo > 1) { const int mid = (lo + hi) >> 1; if (ts[mid] <= rt) lo = mid; else hi = mid; }
            e = lo; pm = rt - ts[lo]; const int rem = cl[lo] - pm * 256; nrows = rem < 256 ? rem : 256; }
        if (F.tid == 0) *(LAS v4u*)(ut + 4 * j) = (v4u){(unsigned)e, (unsigned)pm, (unsigned)rt, (unsigned)nrows | ((unsigned)pnl << 16)};
        if (F.tid < 256) { const int r = F.tid;
            if (GATHER) idx[j * 256 + r] = (e == 256) ? pm * 256 + r : (r < nrows ? (int)(LIST[(size_t)e * LISTCAP + pm * 256 + r].x >> 3) : 0);
            else ((LAS float*)idx)[j * 256 + r] = (e == 256) ? 1.0f : (r < nrows ? __uint_as_float(LIST[(size_t)e * LISTCAP + pm * 256 + r].y) : 0.0f); } }
    __syncthreads();
}

DI void phase_combine(const Frame& F, int mode) {
    const float* MOD = (const float*)(F.ws + WS_MOD);
    const unsigned char* YE = F.ws + WS_YE; const int* INV = (const int*)(F.ws + WS_INV);
    int Te = 0; if (mode == 0) { const unsigned* cnt = (const unsigned*)(F.ws + WS_CTL) + CW_CNT; int t4 = 0;
#pragma unroll
        for (int q = 0; q < 4; ++q) t4 += (int)((cnt[F.lane + 64 * q] + 255u) >> 8);
#pragma unroll
        for (int o = 1; o < 64; o <<= 1) t4 += __shfl_xor(t4, o);
        Te = __builtin_amdgcn_readfirstlane(t4); }
    const int gw = F.bx * NWAVES + F.wave, NGW = F.G * NWAVES;
    const float* nf = F.in[I_NFIN];
    const int c = 16 * F.lane;
    for (int m = gw; m < NTOK; m += NGW) {
        const int b = m >> 11;
        float s[16];
#pragma unroll
        for (int q = 0; q < 16; ++q) s[q] = 0.f;
        const float* xsrc = mode == 2 ? F.in[I_X] : (const float*)(F.ws + WS_X1);
        if (mode == 0) {
#pragma unroll
            for (int k = 0; k < 9; ++k) { const int row = (k < 8) ? INV[m * TOPK + k] : Te * 256 + m; const v4u w = *(const v4u*)(YE + (size_t)row * D + c);
                const unsigned ww[4] = {w.x, w.y, w.z, w.w};
#pragma unroll
                for (int q = 0; q < 4; ++q) { const f32x2 lo = __builtin_amdgcn_cvt_pk_f32_fp8((int)ww[q], false), hi = __builtin_amdgcn_cvt_pk_f32_fp8((int)ww[q], true);
                    s[4 * q] += lo.x; s[4 * q + 1] += lo.y; s[4 * q + 2] += hi.x; s[4 * q + 3] += hi.y; } } }
        float x2[16]; float ss = 0.f;
#pragma unroll
        for (int q = 0; q < 4; ++q) { const f32x4 xa = *(const f32x4*)(xsrc + (size_t)m * D + c + 4 * q), ga = *(const f32x4*)(MOD + b * 6144 + 5120 + c + 4 * q);
#pragma unroll
            for (int j = 0; j < 4; ++j) { const float v = xa[j] + ga[j] * (s[4 * q + j] * 0.015625f); x2[4 * q + j] = v; ss += v * v; } }
        const float rs = rsqrtf(wave_sum(ss) * (1.0f / D) + EPS);
#pragma unroll
        for (int q = 0; q < 4; ++q) { const f32x4 na = *(const f32x4*)(nf + c + 4 * q);
            f32x4 oa = {x2[4 * q] * rs * na.x, x2[4 * q + 1] * rs * na.y, x2[4 * q + 2] * rs * na.z, x2[4 * q + 3] * rs * na.w};
            *(f32x4*)(F.out + (size_t)m * D + c + 4 * q) = oa; }
    }
}

constexpr int NPHASE = 14;
__global__ void __launch_bounds__(NTHR, 2) fwd_kernel(Args args) {
    extern __shared__ __attribute__((aligned(16))) unsigned char lds_raw[];
    Frame F;
    F.lds = (LAS unsigned char*)lds_raw;
    F.tid = threadIdx.x; F.lane = F.tid & 63; F.wave = __builtin_amdgcn_readfirstlane(F.tid >> 6);
    F.G = gridDim.x; F.bx = blockIdx.x; F.vcu = (F.G % 8 == 0) ? (F.bx % 8) * (F.G / 8) + F.bx / 8 : F.bx;
    F.in = args.in; F.out = args.out; F.ws = args.ws;
    volatile LAS unsigned* MISC = (volatile LAS unsigned*)(F.lds + LDS_MISC);
    if (F.tid < 16) MISC[F.tid] = 0u;
    __syncthreads();
    XcdBarrier bar; bar.bar = (unsigned*)(F.ws + WS_CTL) + CW_BAR; bar.x = 0; bar.st = nullptr;
#if !PER_PHASE_LAUNCH
    bar = xcd_barrier_post((unsigned*)(F.ws + WS_CTL) + CW_BAR, MISC + 8);
#define GRID_BAR() xcd_barrier(bar)
#else
#define GRID_BAR() do {} while (0)
#endif
    const int lo = args.ph_lo, hi = args.ph_hi;
#ifndef PH_MASK
#define PH_MASK 0xFFFF
#endif
#define IN(k) (((PH_MASK >> (k)) & 1) && lo <= (k) && (k) < hi)
#ifndef PROBE_PH
#define PROBE_PH -1
#endif
#ifndef PROBE_MULT
#define PROBE_MULT 4
#endif
    volatile LAS unsigned long long* PRT = (volatile LAS unsigned long long*)(F.lds + LDS_MISC);
    if (PROBE_PH == 0 && F.wave == 0) PRT[0] = __builtin_amdgcn_s_memrealtime();
#define SEAM(k) do { if (IN(k) && IN((k) + 1)) GRID_BAR(); \
        if (PROBE_PH >= 0 && F.wave == 0) { if ((k) == PROBE_PH - 1) PRT[0] = __builtin_amdgcn_s_memrealtime(); if ((k) == PROBE_PH) PRT[1] = __builtin_amdgcn_s_memrealtime(); } } while (0)
#ifndef REPEAT_MASK
#define REPEAT_MASK 0
#endif
#define REPS(k) (1 + ((REPEAT_MASK >> (k)) & 1))
    unsigned char* ws = F.ws;

    if (IN(0)) _Pragma("unroll 1") for (int rep = 0; rep < REPS(0); ++rep) { if (rep) GRID_BAR(); phase_prologue(F); } SEAM(0);
    if (IN(1)) _Pragma("unroll 1") for (int rep = 0; rep < REPS(1); ++rep) { if (rep) GRID_BAR(); phase_norm_rows(F, 0); } SEAM(1);
    if (IN(2)) _Pragma("unroll 1") for (int rep = 0; rep < REPS(2); ++rep) { if (rep) GRID_BAR();
        pg8::DenseOrder S; S.init(ws + WS_HX, ws + WS_WIN, MTOT, INC, D, F.G, F.bx);
        pg8::EpiInProj E{(bf16*)(ws + WS_P), (const float*)(ws + WS_TAB)};
        pg8::gemm_phase(F.lds, D, S, E, F.wave);
    } SEAM(2);
    if (IN(3)) _Pragma("unroll 1") for (int rep = 0; rep < REPS(3); ++rep) { if (rep) GRID_BAR(); phase_lru_pass1(F); } SEAM(3);
    if (IN(4)) _Pragma("unroll 1") for (int rep = 0; rep < REPS(4); ++rep) { if (rep) GRID_BAR(); phase_lru_carry(F);
        if (F.G >= 256) { if (F.bx < 128) hgrn_chain(F, F.bx); else convert_experts(F, (F.bx - 128) * NWAVES + F.wave, (F.G - 128) * NWAVES); }
        else { phase_hgrn(F); convert_experts(F, F.bx * NWAVES + F.wave, F.G * NWAVES); } } SEAM(4);
    if (IN(5)) _Pragma("unroll 1") for (int rep = 0; rep < REPS(5); ++rep) { if (rep) GRID_BAR(); phase_lru_pass2(F); phase_y2(F); } SEAM(5);
    if (IN(6)) _Pragma("unroll 1") for (int rep = 0; rep < REPS(6); ++rep) { if (rep) GRID_BAR();
        pg8::DenseOrder S; S.init(ws + WS_YL, ws + WS_WOUT, NTOK, D, D, F.G, F.bx);
        pg8::EpiResid E{F.in[I_X], (const float*)(ws + WS_MOD), (float*)(ws + WS_X1)};
        pg8::gemm_phase(F.lds, D, S, E, F.wave);
    } SEAM(6);
#if DBG_STOP == 1
    if (IN(7)) _Pragma("unroll 1") for (int rep = 0; rep < REPS(7); ++rep) { if (rep) GRID_BAR(); phase_combine(F, 1); }
#else
    if (IN(7)) _Pragma("unroll 1") for (int rep = 0; rep < REPS(7); ++rep) { if (rep) GRID_BAR(); phase_norm_rows(F, 1); } SEAM(7);
    if (IN(8)) _Pragma("unroll 1") for (int rep = 0; rep < REPS(8); ++rep) { if (rep) GRID_BAR();
        pg8::DenseOrder S; S.init(ws + WS_HX2, ws + WS_WR, NTOK, NE, D, F.G, F.bx);
        pg8::EpiF32 E{(float*)(ws + WS_LOGIT), NE};
        pg8::gemm_phase(F.lds, D, S, E, F.wave);
    } SEAM(8);
    if (IN(9)) _Pragma("unroll 1") for (int rep = 0; rep < REPS(9); ++rep) { if (rep) GRID_BAR(); phase_route(F); } SEAM(9);
    if (IN(10)) _Pragma("unroll 1") for (int rep = 0; rep < REPS(10); ++rep) { if (rep) GRID_BAR(); phase_lists(F); } SEAM(10);
    if (IN(11)) _Pragma("unroll 1") for (int rep = 0; rep < REPS(11); ++rep) { if (rep) GRID_BAR();
        int total, nfull; moe_setup<true>(F, 2, total, nfull);
        pg8::MoeOrder<true> S; S.A = (const char*)(ws + WS_HX2F); S.Bt = (const char*)(ws + WS_EW13); S.BtS = (const char*)(ws + WS_SW13); S.K = D / 2; S.ncol = 2; S.estride = (size_t)512 * 1024;
        S.ut = (const LAS int*)(F.lds + LDS_UT); S.idx = (const LAS int*)(F.lds + LDS_IDX); S.nunits = total; S.nfull = nfull;
        pg8::EpiSwiGLU8 E{ws + WS_ACT};
        pg8::gemm_phase<pg8::EpiSwiGLU8, pg8::MoeOrder<true>, false, true>(F.lds, D / 2, S, E, F.wave);
    } SEAM(11);
    if (IN(12)) _Pragma("unroll 1") for (int rep = 0; rep < REPS(12); ++rep) { if (rep) GRID_BAR();
        int total, nfull; moe_setup<false>(F, 4, total, nfull);
        pg8::MoeOrder<false> S; S.A = (const char*)(ws + WS_ACT); S.Bt = (const char*)(ws + WS_EW2); S.BtS = (const char*)(ws + WS_SW2); S.K = DE / 2; S.ncol = 4; S.estride = (size_t)1024 * 256;
        S.ut = (const LAS int*)(F.lds + LDS_UT); S.idx = (const LAS int*)(F.lds + LDS_IDX); S.nunits = total; S.nfull = nfull;
        pg8::EpiScatter E{ws + WS_YE, (const LAS float*)(F.lds + LDS_IDX), 0.5f};
#if defined(PROBE_GEMM)
        pg8::GProf gp{0ull, 0ull, 0ull};
        pg8::gemm_phase<pg8::EpiScatter, pg8::MoeOrder<false>, true, true>(F.lds, DE / 2, S, E, F.wave, &gp);
        if (F.wave == 0) { PRT[0] = 0ull; PRT[1] = (PROBE_GEMM == 0) ? gp.t_loop : (PROBE_GEMM == 1) ? gp.t_epi : gp.t_next; }
#else
        pg8::gemm_phase<pg8::EpiScatter, pg8::MoeOrder<false>, false, true>(F.lds, DE / 2, S, E, F.wave);
#endif
    } SEAM(12);
    if (IN(13)) _Pragma("unroll 1") for (int rep = 0; rep < REPS(13); ++rep) { if (rep) GRID_BAR(); phase_combine(F, 0); }
#endif
#if defined(PROBE_GEMM)
    if (F.bx == 0 && F.wave == 0) {
#else
    if (PROBE_PH >= 0 && F.bx == 0 && F.wave == 0) {
#endif
        const unsigned long long te = __builtin_amdgcn_s_memrealtime(); if (PROBE_PH == NPHASE - 1) PRT[1] = te;
        const unsigned long long target = (unsigned long long)PROBE_MULT * (PRT[1] - PRT[0]);
        while (__builtin_amdgcn_s_memrealtime() - te < target) __builtin_amdgcn_s_sleep(20);
    }
}

extern "C" void kernel_launch(void* const* d_in, const int* in_sizes, int n_in, void* d_out, int out_size, void* d_ws, size_t ws_size, hipStream_t stream) {
    static int grid = 0;
    if (grid == 0) {
        if (n_in != 26 || in_sizes[0] != NTOK * D || out_size != NTOK * D || ws_size < WS_END) { fprintf(stderr, "kernel_launch: unexpected shapes (n_in %d, ws %zu)\n", n_in, ws_size); grid = -1; return; }
        int dev = 0, cus = 0, per_cu = 0;
        if (hipGetDevice(&dev) != hipSuccess || hipDeviceGetAttribute(&cus, hipDeviceAttributeMultiprocessorCount, dev) != hipSuccess) { grid = -1; return; }
        if (hipFuncSetAttribute((const void*)fwd_kernel, hipFuncAttributeMaxDynamicSharedMemorySize, LDS_BYTES) != hipSuccess) { fprintf(stderr, "kernel_launch: hipFuncSetAttribute failed\n"); grid = -1; return; }
        if (hipOccupancyMaxActiveBlocksPerMultiprocessor(&per_cu, (const void*)fwd_kernel, NTHR, LDS_BYTES) != hipSuccess || per_cu < 1) { fprintf(stderr, "kernel_launch: occupancy query says %d\n", per_cu); }
        (void)hipGetLastError();
        grid = cus;
    }
    if (grid < 0) return;
    hipMemsetAsync((char*)d_ws + WS_CTL, 0, CTL_ZERO_BYTES, stream);
    Args a{};
    for (int i = 0; i < 26; ++i) a.in[i] = (const float*)d_in[i];
    a.out = (float*)d_out; a.ws = (unsigned char*)d_ws;
#if PER_PHASE_LAUNCH
    for (int p = 0; p < NPHASE; ++p) { a.ph_lo = p; a.ph_hi = p + 1; hipLaunchKernelGGL(fwd_kernel, dim3(grid), dim3(NTHR), LDS_BYTES, stream, a); }
#else
    a.ph_lo = 0; a.ph_hi = NPHASE;
    hipLaunchKernelGGL(fwd_kernel, dim3(grid), dim3(NTHR), LDS_BYTES, stream, a);
#endif
}
```

```cpp
#include <hip/hip_runtime.h>
#include <cstdio>
#include <cstdint>

#ifndef PER_PHASE_LAUNCH
#define PER_PHASE_LAUNCH 0
#endif
#ifndef DBG_STOP
#define DBG_STOP 0
#endif

#define GAS __attribute__((address_space(1)))
#define LAS __attribute__((address_space(3)))
#define DI __device__ __forceinline__
typedef unsigned short bf16;
typedef unsigned v4u __attribute__((ext_vector_type(4)));
typedef unsigned v2u __attribute__((ext_vector_type(2)));
typedef float f32x4 __attribute__((ext_vector_type(4)));
typedef float f32x2 __attribute__((ext_vector_type(2)));
typedef short bf16x8 __attribute__((ext_vector_type(8)));
typedef __bf16 bfv2 __attribute__((ext_vector_type(2)));

constexpr int D = 1024, NB = 16, SEQ = 2048, CTXL = 256;
constexpr int NTOK = NB * SEQ;
constexpr int NCTX = NB * CTXL;
constexpr int MTOT = NTOK + NCTX;
constexpr int INC = 3584;
constexpr int NE = 256, TOPK = 8, DE = 256;
constexpr int LISTCAP = 32768;
constexpr float EPS = 1e-6f;
constexpr int NWAVES = 8, NTHR = 512;
constexpr int NSEQT = 36;

constexpr size_t MiB = 1u << 20;
constexpr size_t WS_CTL = 0, CTL_ZERO_BYTES = 1 * MiB;
constexpr size_t WS_MOD = 1 * MiB;
constexpr size_t WS_TAB = 2 * MiB;
constexpr size_t WS_WGT = 2 * MiB + 65536;
constexpr size_t WS_WIN = 3 * MiB;
constexpr size_t WS_WOUT = 10 * MiB;
constexpr size_t WS_WR = 12 * MiB;
constexpr size_t WS_SW13 = 12 * MiB + 512 * 1024;
constexpr size_t WS_SW2 = 13 * MiB + 512 * 1024;
constexpr size_t WS_DUMP = 2 * MiB + 16384;
constexpr size_t WS_SUMA = 14 * MiB;
constexpr size_t WS_SUMH = WS_SUMA + 2359296;
constexpr size_t WS_CIN = WS_SUMH + 2359296;
constexpr size_t WS_ROUTE = 21 * MiB;
constexpr size_t WS_HIST = 23 * MiB;
constexpr size_t WS_EW13 = 32 * MiB;
constexpr size_t WS_EW2 = 288 * MiB;
constexpr size_t WS_X1 = 416 * MiB;
constexpr size_t WS_HX2 = 544 * MiB;
constexpr size_t WS_LOGIT = 608 * MiB;
constexpr size_t WS_LIST = 1620 * MiB;
constexpr size_t WS_ACT = 674 * MiB;
constexpr size_t WS_YS = 850 * MiB;
constexpr size_t WS_P = 914 * MiB;
constexpr size_t WS_HX = 1166 * MiB;
constexpr size_t WS_OF = 1238 * MiB;
constexpr size_t WS_OB = 1270 * MiB;
constexpr size_t WS_YL = 1302 * MiB;
constexpr size_t WS_YE = 914 * MiB;
constexpr size_t WS_INV = 24 * MiB;
constexpr size_t WS_HX2F = 1684 * MiB;
constexpr size_t WS_END = 1716 * MiB;
constexpr int CW_BAR = 4096;
constexpr int CW_CNT = 16384;
constexpr int CW_CONVQ = 20480;

constexpr int RING_BYTES = 131072;
constexpr int LDS_TS = RING_BYTES;
constexpr int LDS_CNT = LDS_TS + 1088;
constexpr int LDS_UT = LDS_CNT + 1024;
constexpr int LDS_IDX = LDS_UT + 192;
constexpr int LDS_MISC = LDS_IDX + 10 * 1024;
constexpr int LDS_BYTES = 155648;
static_assert(LDS_MISC + 64 <= LDS_BYTES, "lds map");

DI unsigned pk2(float lo, float hi) { f32x2 v = {lo, hi}; bfv2 b = __builtin_convertvector(v, bfv2); return __builtin_bit_cast(unsigned, b); }
DI float clamp448(float x) { return __builtin_amdgcn_fmed3f(x, -448.0f, 448.0f); }
DI unsigned pk4_f8(float a, float b, float c, float d) {
    int w = __builtin_amdgcn_cvt_pk_fp8_f32(clamp448(a), clamp448(b), 0, false); w = __builtin_amdgcn_cvt_pk_fp8_f32(clamp448(c), clamp448(d), w, true); return (unsigned)w; }
DI float bflo(unsigned w) { return __uint_as_float(w << 16); }
DI float bfhi(unsigned w) { return __uint_as_float(w & 0xffff0000u); }
DI float bf2f(bf16 h) { return __uint_as_float(((unsigned)h) << 16); }
DI bf16 f2bf(float f) { return (bf16)(pk2(f, 0.f) & 0xffffu); }
DI float rcpf_(float x) { return __builtin_amdgcn_rcpf(x); }
DI float ex2f_(float x) { return __builtin_amdgcn_exp2f(x); }
DI float expf_(float x) { return __builtin_amdgcn_exp2f(x * 1.4426950408889634f); }
DI float logf_(float x) { return __builtin_amdgcn_logf(x) * 0.6931471805599453f; }
DI float sigm(float x) { return rcpf_(1.0f + expf_(-x)); }
DI float wave_sum(float v) {
#pragma unroll
    for (int o = 1; o < 64; o <<= 1) v += __shfl_xor(v, o);
    return v;
}
#define LDS_WAIT() asm volatile("s_waitcnt lgkmcnt(0)" ::: "memory")
template <int CTRL> DI float dpp_mov_f(float v) { return __uint_as_float((unsigned)__builtin_amdgcn_update_dpp(0, (int)__float_as_uint(v), CTRL, 0xf, 0xf, true)); }
DI float wave_sum_fast(float v) {
    v += dpp_mov_f<0xB1>(v); v += dpp_mov_f<0x4E>(v); v += dpp_mov_f<0x124>(v); v += dpp_mov_f<0x128>(v);
    const unsigned u = __float_as_uint(v);
    return (__uint_as_float((unsigned)__builtin_amdgcn_readlane((int)u, 0)) + __uint_as_float((unsigned)__builtin_amdgcn_readlane((int)u, 16)))
         + (__uint_as_float((unsigned)__builtin_amdgcn_readlane((int)u, 32)) + __uint_as_float((unsigned)__builtin_amdgcn_readlane((int)u, 48)));
}

#define XB_TMO      128
#define XB_XCNT(j)  (256  + 64 * (j))
#define XB_XSUB(j)  (1280 + 64 * (j))
#define XB_XGEN(j)  (2304 + 64 * (j))
#define XB_TOP      3328
#define XB_TOPGEN   3392
#define XCD_BAR_WORDS 3456
#define XB_SPIN_CAP (1u << 18)
__device__ __forceinline__ unsigned xb_ld(unsigned* p)              { return __hip_atomic_load(p, __ATOMIC_RELAXED, __HIP_MEMORY_SCOPE_AGENT); }
__device__ __forceinline__ unsigned xb_add(unsigned* p, unsigned v) { return __hip_atomic_fetch_add(p, v, __ATOMIC_RELAXED, __HIP_MEMORY_SCOPE_AGENT); }
__device__ __forceinline__ unsigned xb_xcc_id() { return (unsigned)__builtin_amdgcn_s_getreg((3 << 11) | 20) & 0xFu; }
#define XB_SPIN(cond, bar) do { unsigned _sp = 0; while (cond) { __builtin_amdgcn_s_sleep(1); \
    if ((++_sp & 255u) == 0u) { if (xb_ld(&(bar)[XB_TMO])) break; if (_sp > XB_SPIN_CAP) { atomicAdd(&(bar)[XB_TMO], 1u); break; } } } } while (0)
struct XcdBarrier { unsigned* bar; unsigned x; volatile LAS unsigned* st; };
__device__ __forceinline__ XcdBarrier xcd_barrier_post(unsigned* bar, volatile LAS unsigned* st) {
    XcdBarrier b; b.bar = bar; b.x = xb_xcc_id(); b.st = st;
    if (threadIdx.x == 0) (void)xb_add(&bar[XB_XCNT(b.x)], 1u);
    return b;
}
__device__ __forceinline__ void xcd_barrier_complete(unsigned* bar, unsigned x, unsigned& nloc, unsigned& nx) {
    const unsigned G = gridDim.x * gridDim.y * gridDim.z;
    unsigned sum, cnt, mine, sp = 0u;
    for (;;) {
        sum = 0u; cnt = 0u; mine = 0u;
#pragma unroll
        for (unsigned j = 0; j < 16; ++j) { const unsigned c = xb_ld(&bar[XB_XCNT(j)]); sum += c; cnt += (c > 0u) ? 1u : 0u; mine = (j == x) ? c : mine; }
        if (sum == G) break;
        __builtin_amdgcn_s_sleep(1);
        if ((++sp & 255u) == 0u) { if (xb_ld(&bar[XB_TMO])) break; if (sp > XB_SPIN_CAP) { atomicAdd(&bar[XB_TMO], 1u); break; } }
    }
    nloc = mine > 0u ? mine : 1u; nx = cnt > 0u ? cnt : 1u;
}
__device__ __forceinline__ void xcd_barrier(const XcdBarrier& b) {
    asm volatile("s_waitcnt vmcnt(0)" ::: "memory");
    __syncthreads();
    if (threadIdx.x == 0) {
        unsigned* bar = b.bar;
        __builtin_amdgcn_s_waitcnt(0);
        unsigned nloc = b.st[0], nx = b.st[1];
        if (nloc == 0u) { xcd_barrier_complete(bar, b.x, nloc, nx); b.st[0] = nloc; b.st[1] = nx; }
        const unsigned old = xb_add(&bar[XB_XSUB(b.x)], 1u);
        const unsigned gen = old / nloc;
        if (old + 1u == (gen + 1u) * nloc) {
            __builtin_amdgcn_fence(__ATOMIC_RELEASE, "agent");
            asm volatile("s_waitcnt vmcnt(0)" ::: "memory");
            const unsigned og = xb_add(&bar[XB_TOP], 1u);
            const unsigned tg = og / nx;
            if (og + 1u == (tg + 1u) * nx) xb_add(&bar[XB_TOPGEN], 1u);
            else XB_SPIN(xb_ld(&bar[XB_TOPGEN]) == tg, bar);
            __builtin_amdgcn_fence(__ATOMIC_ACQUIRE, "agent");
            xb_add(&bar[XB_XGEN(b.x)], 1u);
            asm volatile("s_waitcnt vmcnt(0)" ::: "memory");
        } else {
            XB_SPIN(xb_ld(&bar[XB_XGEN(b.x)]) == gen, bar);
            __builtin_amdgcn_fence(__ATOMIC_ACQUIRE, "agent");
            asm volatile("s_waitcnt vmcnt(0)" ::: "memory");
        }
    }
    __syncthreads();
}

namespace pg8 {
constexpr int BM = 256, BK = 64, HALF = 128, HTB = HALF * BK * 2, NXCD = 8, WGM = 8;
DI int lds_byte(int r, int c) { const int st = (r >> 4) * 2 + (c >> 5), rr = r & 15, cc = c & 31, ob = rr * 64 + cc * 2; return st * 1024 + (ob ^ (((ob >> 9) & 1) << 5)); }
DI void stage_rc(int b, int& R, int& C) { const int st = b / 1024, sb = b % 1024, swz = sb ^ (((sb >> 9) & 1) << 5); R = (st >> 1) * 16 + swz / 64; C = (st & 1) * 32 + (swz % 64) / 2; }
DI int perm32(int rho) { const int n = rho >> 4, i = rho & 15; return 8 * (i >> 2) + 4 * n + (i & 3); }

struct Unit { int pm, pn, e, rt, ord, nrows; };

struct DenseOrder {
    const char* A; const char* Bt; int K, nM, nN, nwg, G, c;
    DI void init(const void* A_, const void* Bt_, int M, int N, int K_, int G_, int c_) { A = (const char*)A_; Bt = (const char*)Bt_; K = K_; nM = M / BM; nN = N / BM; nwg = nM * nN; G = G_; c = c_; }
    DI bool next(int i, Unit& u) const {
        const long L = (long)i * G + c; if (L >= nwg) return false;
        int wgid = (int)L; { const int q = nwg / NXCD, r = nwg % NXCD, xcd = wgid % NXCD, off = wgid / NXCD; wgid = (xcd < r ? xcd * (q + 1) : r * (q + 1) + (xcd - r) * q) + off; }
        const int nig = WGM * nN, gid = wgid / nig, fm = gid * WGM, gsz = (nM - fm) < WGM ? (nM - fm) : WGM;
        u.pm = fm + ((wgid % nig) % gsz); u.pn = (wgid % nig) / gsz; u.e = 0; u.rt = u.pm; u.ord = i; u.nrows = 256; return true;
    }
    DI const char* a_base(const Unit& u) const { return A + (size_t)u.pm * BM * K * 2; }
    DI const char* b_base(const Unit& u) const { return Bt + (size_t)u.pn * BM * K * 2; }
    static constexpr bool GATHER_A = false;
    DI void a_offs(const Unit&, int tid, unsigned (&v)[2][2]) const {
#pragma unroll
        for (int i = 0; i < 2; ++i) { int R, C; stage_rc(tid * 16 + i * 8192, R, C);
#pragma unroll
            for (int h = 0; h < 2; ++h) v[h][i] = (unsigned)((h * HALF + R) * K + C) * 2u; }
    }
};

template <bool GATHER> struct MoeOrder {
    const char* A; const char* Bt; const char* BtS; int K, ncol; size_t estride;
    const LAS int* ut; const LAS int* idx; int nunits, nfull;
    static constexpr bool GATHER_A = GATHER;
    DI bool next(int i, Unit& u) const {
        if (i >= nunits) return false;
        int j, pn;
        if (i < nfull) { j = i / ncol; pn = i - j * ncol; } else { j = nfull / ncol + (i - nfull); pn = -1; }
        const v4u t = *(const LAS v4u*)(ut + 4 * j);
        u.ord = j; u.e = (int)t.x; u.pm = (int)t.y; u.rt = (int)t.z; u.nrows = (int)(t.w & 0xffffu); u.pn = pn >= 0 ? pn : (int)(t.w >> 16);
        return true;
    }
    DI const char* a_base(const Unit& u) const { return GATHER ? A : A + (size_t)u.rt * BM * K * 2; }
    DI const char* b_base(const Unit& u) const { return (u.e < 256 ? Bt + (size_t)u.e * estride : BtS) + (size_t)u.pn * BM * K * 2; }
    DI void a_offs(const Unit& u, int tid, unsigned (&v)[2][2]) const {
#pragma unroll
        for (int i = 0; i < 2; ++i) { int R, C; stage_rc(tid * 16 + i * 8192, R, C);
#pragma unroll
            for (int h = 0; h < 2; ++h) {
                if (GATHER) v[h][i] = ((unsigned)idx[u.ord * 256 + h * HALF + R] * (unsigned)K + (unsigned)C) * 2u;
                else v[h][i] = (unsigned)((h * HALF + R) * K + C) * 2u; } }
    }
};

struct GProf { unsigned long long t_loop, t_epi, t_next; };
typedef int v8i __attribute__((ext_vector_type(8)));
template <class Epi, class Sched, bool PROF = false, bool F8 = false>
__device__ __forceinline__ void gemm_phase(LAS unsigned char* lds, const int K, const Sched& S, const Epi& E, const int wid  , GProf* prof = nullptr) {
    unsigned long long pt0 = 0, pt1 = 0, pt2 = 0, pt3 = 0;
    const int tid = threadIdx.x, lane = tid & 63, wr = wid >> 2, wc = wid & 3, fr = lane & 15, fq = lane >> 4;
    const int nt = K / BK;
    unsigned voffBh[2][2];
#pragma unroll
    for (int i = 0; i < 2; ++i) { int R, C; stage_rc(tid * 16 + i * 8192, R, C);
#pragma unroll
        for (int h = 0; h < 2; ++h) { int Rb;
            if (Epi::PERM == 2) Rb = 64 * ((R >> 5) & 3) + 16 * ((R >> 2) & 3) + 8 * h + 4 * ((R >> 4) & 1) + (R & 3);
            else Rb = HALF * h + (Epi::PERM == 1 ? ((R & ~31) + perm32(R & 31)) : R);
            voffBh[h][i] = (unsigned)(Rb * K + C) * 2u; } }
    const size_t kstep = (size_t)(BK * 2);
    const size_t hstep = (size_t)HALF * K * 2;
    const unsigned ldsw = (unsigned)wid * 1024u;
    const int aoff = F8 ? lds_byte(wr * 64 + fr, fq * 16) : lds_byte(wr * 64 + fr, fq * 8), boff = F8 ? lds_byte(wc * 32 + fr, fq * 16) : lds_byte(wc * 32 + fr, fq * 8);
#define PG8_SA(b, h) (((b) * 2 + (h)) * HTB)
#define PG8_SB(b, h) ((4 + (b) * 2 + (h)) * HTB)
#define PG8_STAGE(bufoff, gbase, voff) do { _Pragma("unroll") for (int _i = 0; _i < 2; ++_i) \
        __builtin_amdgcn_global_load_lds((const unsigned*)((const char*)(gbase) + (voff)[_i]), (LAS unsigned*)(lds + (bufoff) + ldsw + _i * 8192), 16, 0, 0); } while (0)
#define PG8_LD8(dst, off) do { const v4u _lo = *(const LAS v4u*)(lds + (off)), _hi = *(const LAS v4u*)(lds + (off) + 16); \
        dst[0] = (int)_lo.x; dst[1] = (int)_lo.y; dst[2] = (int)_lo.z; dst[3] = (int)_lo.w; dst[4] = (int)_hi.x; dst[5] = (int)_hi.y; dst[6] = (int)_hi.z; dst[7] = (int)_hi.w; } while (0)
#define PG8_LDA(dst, b, h) do { if (F8) { _Pragma("unroll") for (int m = 0; m < 4; ++m) PG8_LD8(dst##8[m], PG8_SA(b, h) + aoff + m * 2048); } \
        else { _Pragma("unroll") for (int m = 0; m < 4; ++m) _Pragma("unroll") for (int k = 0; k < 2; ++k) dst[m][k] = *(const LAS bf16x8*)(lds + PG8_SA(b, h) + aoff + m * 2048 + k * 1024); } } while (0)
#define PG8_LDB(dst, b, h) do { if (F8) { _Pragma("unroll") for (int n = 0; n < 2; ++n) PG8_LD8(dst##8[n], PG8_SB(b, h) + boff + n * 2048); } \
        else { _Pragma("unroll") for (int n = 0; n < 2; ++n) _Pragma("unroll") for (int k = 0; k < 2; ++k) dst[n][k] = *(const LAS bf16x8*)(lds + PG8_SB(b, h) + boff + n * 2048 + k * 1024); } } while (0)
#define PG8_MMA(ai, bj, At, Bt) do { __builtin_amdgcn_s_setprio(1); \
        if (F8) { _Pragma("unroll") for (int m = 0; m < 4; ++m) _Pragma("unroll") for (int n = 0; n < 2; ++n) \
            asm volatile("v_mfma_scale_f32_16x16x128_f8f6f4 %0, %1, %2, %0, %3, %3 op_sel_hi:[0,0,0]" : "+v"(acc[ai][bj][m][n]) : "v"(Bt##8[n]), "v"(At##8[m]), "v"(sc127)); } \
        else { _Pragma("unroll") for (int m = 0; m < 4; ++m) _Pragma("unroll") for (int n = 0; n < 2; ++n) _Pragma("unroll") for (int k = 0; k < 2; ++k) \
            acc[ai][bj][m][n] = __builtin_amdgcn_mfma_f32_16x16x32_bf16(Bt[n][k], At[m][k], acc[ai][bj][m][n], 0, 0, 0); } \
        __builtin_amdgcn_s_setprio(0); } while (0)
#define PG8_WAIT_V(n) asm volatile("s_waitcnt vmcnt(" #n ")" ::: "memory")
#define PG8_WAIT_L(n) asm volatile("s_waitcnt lgkmcnt(" #n ")" ::: "memory")
#define PG8_BAR __builtin_amdgcn_s_barrier()
#define PG8_SCHED __builtin_amdgcn_sched_barrier(0)
    Unit cur, nxt; int ui = 0;
    if (!S.next(0, cur)) return;
    f32x4 acc[2][2][4][2];
#pragma unroll
    for (int a = 0; a < 2; ++a)
#pragma unroll
        for (int b = 0; b < 2; ++b)
#pragma unroll
            for (int m = 0; m < 4; ++m)
#pragma unroll
                for (int n = 0; n < 2; ++n) acc[a][b][m][n] = (f32x4){0.f, 0.f, 0.f, 0.f};
    bf16x8 At[4][2], B0[2][2], B1[2][2];
    v8i At8[4], B08[2], B18[2];
    int sc127 = 127; asm volatile("" : "+v"(sc127));
    unsigned vC[2][2], vN[2][2];
    S.a_offs(cur, tid, vC);
    const char* cA = S.a_base(cur); const char* cB = S.b_base(cur);
    PG8_STAGE(PG8_SB(0, 0), cB, voffBh[0]); PG8_STAGE(PG8_SA(0, 0), cA, vC[0]); PG8_STAGE(PG8_SB(0, 1), cB, voffBh[1]); PG8_STAGE(PG8_SA(0, 1), cA, vC[1]);
    if (wr == 1) PG8_BAR;
    PG8_WAIT_V(4); PG8_BAR;
    PG8_STAGE(PG8_SB(1, 0), cB + kstep, voffBh[0]); PG8_STAGE(PG8_SA(1, 0), cA + kstep, vC[0]); PG8_STAGE(PG8_SB(1, 1), cB + kstep, voffBh[1]);
    PG8_WAIT_V(6); PG8_BAR;
    for (;;) {
        if (PROF) pt0 = __builtin_amdgcn_s_memrealtime();
        const bool has_next = S.next(ui + 1, nxt);
        const char* nA = has_next ? S.a_base(nxt) : cA; const char* nB = has_next ? S.b_base(nxt) : cB;
        if (Sched::GATHER_A) { if (has_next) S.a_offs(nxt, tid, vN); else { vN[0][0] = vC[0][0]; vN[0][1] = vC[0][1]; vN[1][0] = vC[1][0]; vN[1][1] = vC[1][1]; } }
        if (PROF) pt1 = __builtin_amdgcn_s_memrealtime();
#pragma unroll 1
        for (int t = 0; t < nt; t += 2) {
            const bool last = (t == nt - 2);
            const char* a1 = cA + (size_t)(t + 1) * kstep;
            const char* a2 = last ? nA : cA + (size_t)(t + 2) * kstep; const char* b2 = last ? nB : cB + (size_t)(t + 2) * kstep;
            const char* a3 = a2 + kstep; const char* b3 = b2 + kstep;
            unsigned x0[2], x1[2];
            if (Sched::GATHER_A) { x0[0] = last ? vN[0][0] : vC[0][0]; x0[1] = last ? vN[0][1] : vC[0][1]; x1[0] = last ? vN[1][0] : vC[1][0]; x1[1] = last ? vN[1][1] : vC[1][1]; }
            else { x0[0] = vC[0][0]; x0[1] = vC[0][1]; x1[0] = vC[1][0]; x1[1] = vC[1][1]; }
            PG8_LDB(B0, 0, 0); PG8_SCHED; PG8_LDA(At, 0, 0); PG8_STAGE(PG8_SA(1, 1), a1, vC[1]);
            PG8_WAIT_L(8); PG8_BAR; PG8_WAIT_L(0); PG8_MMA(0, 0, At, B0); PG8_BAR; PG8_SCHED;
            PG8_LDB(B1, 0, 1); PG8_STAGE(PG8_SB(0, 0), b2, voffBh[0]);
            PG8_BAR; PG8_WAIT_L(0); PG8_MMA(0, 1, At, B1); PG8_BAR;
            PG8_LDA(At, 0, 1); PG8_STAGE(PG8_SA(0, 0), a2, x0);
            PG8_BAR; PG8_WAIT_L(0); PG8_MMA(1, 0, At, B0); PG8_BAR; PG8_SCHED;
            PG8_STAGE(PG8_SB(0, 1), b2, voffBh[1]);
            PG8_WAIT_V(6); PG8_BAR; PG8_MMA(1, 1, At, B1); PG8_BAR;
            PG8_LDB(B0, 1, 0); PG8_SCHED; PG8_LDA(At, 1, 0); PG8_STAGE(PG8_SA(0, 1), a2, x1);
            PG8_WAIT_L(8); PG8_BAR; PG8_WAIT_L(0); PG8_MMA(0, 0, At, B0); PG8_BAR; PG8_SCHED;
            PG8_LDB(B1, 1, 1); PG8_STAGE(PG8_SB(1, 0), b3, voffBh[0]);
            PG8_BAR; PG8_WAIT_L(0); PG8_MMA(0, 1, At, B1); PG8_BAR;
            PG8_LDA(At, 1, 1); PG8_STAGE(PG8_SA(1, 0), a3, x0);
            PG8_BAR; PG8_WAIT_L(0); PG8_MMA(1, 0, At, B0); PG8_BAR; PG8_SCHED;
            PG8_STAGE(PG8_SB(1, 1), b3, voffBh[1]);
            PG8_WAIT_V(6); PG8_BAR; PG8_MMA(1, 1, At, B1); PG8_BAR;
        }
        if (PROF) pt2 = __builtin_amdgcn_s_memrealtime();
        if (F8) asm volatile("s_nop 15\n\ts_nop 15" ::: "memory");
        E(acc, cur, wr, wc, fr, fq);
        if (PROF) { asm volatile("s_waitcnt vmcnt(0)" ::: "memory"); pt3 = __builtin_amdgcn_s_memrealtime(); prof->t_next += pt1 - pt0; prof->t_loop += pt2 - pt1; prof->t_epi += pt3 - pt2; }
        if (!has_next) break;
#pragma unroll
        for (int a = 0; a < 2; ++a)
#pragma unroll
            for (int b = 0; b < 2; ++b)
#pragma unroll
                for (int m = 0; m < 4; ++m)
#pragma unroll
                    for (int n = 0; n < 2; ++n) acc[a][b][m][n] = (f32x4){0.f, 0.f, 0.f, 0.f};
        cur = nxt; cA = nA; cB = nB; ++ui;
        if (Sched::GATHER_A) { vC[0][0] = vN[0][0]; vC[0][1] = vN[0][1]; vC[1][0] = vN[1][0]; vC[1][1] = vN[1][1]; }
    }
    PG8_WAIT_V(0);
    if (wr == 0) PG8_BAR;
    PG8_BAR;
#undef PG8_SA
#undef PG8_SB
#undef PG8_STAGE
#undef PG8_LD8
#undef PG8_LDA
#undef PG8_LDB
#undef PG8_MMA
#undef PG8_WAIT_V
#undef PG8_WAIT_L
#undef PG8_BAR
#undef PG8_SCHED
}

DI float gelu_tanh(float x) { const float u = 1.5957691216f * (x + 0.044715f * x * x * x); return x * rcpf_(1.0f + expf_(-u)); }
DI float silu_f(float x) { return x * rcpf_(1.0f + expf_(-x)); }

struct EpiInProj {
    static constexpr int PERM = 1;
    bf16* P; const float* LB;
    DI void operator()(const f32x4 (&acc)[2][2][4][2], const Unit& u, int wr, int wc, int fr, int fq) const {
        const int row0 = u.pm * BM + wr * 64 + fr, col0 = u.pn * BM + wc * 32 + 8 * fq;
        const int pn = u.pn;
        const int kind = (pn == 2 || pn == 3) ? 1 : (pn >= 8 && pn < 12) ? 2 : (pn >= 12) ? 3 : 0;
        f32x4 lbv[2][2];
        { const int dir = (pn >> 1) & 1; const int cc = (pn & 1) * 256 + wc * 32 + 8 * fq;
#pragma unroll
            for (int bj = 0; bj < 2; ++bj)
#pragma unroll
                for (int n = 0; n < 2; ++n) lbv[bj][n] = *(const f32x4*)(LB + dir * 512 + cc + bj * HALF + 4 * n);
            asm volatile("" :: "v"(lbv[0][0]), "v"(lbv[0][1]), "v"(lbv[1][0]), "v"(lbv[1][1])); }
#pragma unroll
        for (int ai = 0; ai < 2; ++ai)
#pragma unroll
            for (int m = 0; m < 4; ++m) { bf16* rowp = P + (size_t)(row0 + ai * HALF + m * 16) * INC + col0;
#pragma unroll
                for (int bj = 0; bj < 2; ++bj) { f32x4 v0 = acc[ai][bj][m][0], v1 = acc[ai][bj][m][1];
                    if (kind == 1) {
#pragma unroll
                        for (int j = 0; j < 4; ++j) { v0[j] = gelu_tanh(v0[j]); v1[j] = gelu_tanh(v1[j]); } }
                    else if (kind == 2) {
#pragma unroll
                        for (int j = 0; j < 4; ++j) { const float l0 = lbv[bj][0][j], l1 = lbv[bj][1][j];
                            v0[j] = logf_(l0 + (1.0f - l0) * sigm(v0[j])); v1[j] = logf_(l1 + (1.0f - l1) * sigm(v1[j])); } }
                    else if (kind == 3) {
#pragma unroll
                        for (int j = 0; j < 4; ++j) { v0[j] = silu_f(v0[j]); v1[j] = silu_f(v1[j]); } }
                    v4u w; w.x = pk2(v0[0], v0[1]); w.y = pk2(v0[2], v0[3]); w.z = pk2(v1[0], v1[1]); w.w = pk2(v1[2], v1[3]);
                    *(v4u*)(rowp + bj * HALF) = w; } }
    }
};
struct EpiResid {
    static constexpr int PERM = 1;
    const float* x; const float* mod; bf16* X1;
    DI void operator()(const f32x4 (&acc)[2][2][4][2], const Unit& u, int wr, int wc, int fr, int fq) const {
        const int row0 = u.pm * BM + wr * 64 + fr, col0 = u.pn * BM + wc * 32 + 8 * fq;
        const int b = (u.pm * BM) >> 11;
        f32x4 gv[2][2];
#pragma unroll
        for (int bj = 0; bj < 2; ++bj)
#pragma unroll
            for (int n = 0; n < 2; ++n) gv[bj][n] = *(const f32x4*)(mod + (size_t)b * 6144 + 2048 + col0 + bj * HALF + 4 * n);
        asm volatile("" :: "v"(gv[0][0]), "v"(gv[0][1]), "v"(gv[1][0]), "v"(gv[1][1]));
#pragma unroll
        for (int ai = 0; ai < 2; ++ai)
#pragma unroll
            for (int m = 0; m < 4; ++m) { const size_t off = (size_t)(row0 + ai * HALF + m * 16) * D + col0;
#pragma unroll
                for (int bj = 0; bj < 2; ++bj) { const f32x4 x0 = *(const f32x4*)(x + off + bj * HALF), x1 = *(const f32x4*)(x + off + bj * HALF + 4);
                    const f32x4 v0 = x0 + gv[bj][0] * acc[ai][bj][m][0], v1 = x1 + gv[bj][1] * acc[ai][bj][m][1];
                    v4u w; w.x = pk2(v0[0], v0[1]); w.y = pk2(v0[2], v0[3]); w.z = pk2(v1[0], v1[1]); w.w = pk2(v1[2], v1[3]);
                    *(v4u*)(X1 + off + bj * HALF) = w; } }
    }
};
struct EpiF32 {
    static constexpr int PERM = 0;
    float* C; int ldc;
    DI void operator()(const f32x4 (&acc)[2][2][4][2], const Unit& u, int wr, int wc, int fr, int fq) const {
        const int row0 = u.pm * BM + wr * 64 + fr, col0 = u.pn * BM + wc * 32 + 4 * fq;
#pragma unroll
        for (int ai = 0; ai < 2; ++ai)
#pragma unroll
            for (int m = 0; m < 4; ++m) { float* rowp = C + (size_t)(row0 + ai * HALF + m * 16) * ldc + col0;
#pragma unroll
                for (int bj = 0; bj < 2; ++bj)
#pragma unroll
                    for (int n = 0; n < 2; ++n) *(f32x4*)(rowp + bj * HALF + n * 16) = acc[ai][bj][m][n]; }
    }
};
struct EpiSwiGLU8 {
    static constexpr int PERM = 1;
    unsigned char* ACT;
    DI void operator()(const f32x4 (&acc)[2][2][4][2], const Unit& u, int wr, int wc, int fr, int fq) const {
        const unsigned off0 = ((unsigned)u.rt * 256u + (unsigned)(wr * 64 + fr)) * (unsigned)DE + (unsigned)(u.pn * 128 + wc * 32 + 8 * fq);
#pragma unroll
        for (int ai = 0; ai < 2; ++ai)
#pragma unroll
            for (int m = 0; m < 4; ++m) {
                f32x4 a0 = acc[ai][0][m][0] * 0.03125f, a1 = acc[ai][0][m][1] * 0.03125f; const f32x4 g0 = acc[ai][1][m][0] * 0.25f, g1 = acc[ai][1][m][1] * 0.25f;
#pragma unroll
                for (int j = 0; j < 4; ++j) { a0[j] = silu_f(a0[j]) * g0[j]; a1[j] = silu_f(a1[j]) * g1[j]; }
                v2u w; w.x = pk4_f8(a0[0], a0[1], a0[2], a0[3]); w.y = pk4_f8(a1[0], a1[1], a1[2], a1[3]);
                *(v2u*)(ACT + (off0 + (unsigned)((ai * HALF + m * 16) * DE))) = w; }
    }
};
struct EpiSwiGLU {
    static constexpr int PERM = 1;
    bf16* ACT;
    DI void operator()(const f32x4 (&acc)[2][2][4][2], const Unit& u, int wr, int wc, int fr, int fq) const {
        const int row0 = wr * 64 + fr, col0 = u.pn * 128 + wc * 32 + 8 * fq;
        bf16* base = ACT + (size_t)u.rt * 256 * DE;
#pragma unroll
        for (int ai = 0; ai < 2; ++ai)
#pragma unroll
            for (int m = 0; m < 4; ++m) { bf16* rowp = base + (size_t)(row0 + ai * HALF + m * 16) * DE + col0;
                f32x4 a0 = acc[ai][0][m][0], a1 = acc[ai][0][m][1]; const f32x4 g0 = acc[ai][1][m][0], g1 = acc[ai][1][m][1];
#pragma unroll
                for (int j = 0; j < 4; ++j) { a0[j] = silu_f(a0[j]) * g0[j]; a1[j] = silu_f(a1[j]) * g1[j]; }
                v4u w; w.x = pk2(a0[0], a0[1]); w.y = pk2(a0[2], a0[3]); w.z = pk2(a1[0], a1[1]); w.w = pk2(a1[2], a1[3]);
                *(v4u*)rowp = w; }
    }
};
struct EpiScatter {
    static constexpr int PERM = 2;
    unsigned char* YE; const LAS float* gate; float oscale;
    DI void operator()(const f32x4 (&acc)[2][2][4][2], const Unit& u, int wr, int wc, int fr, int fq) const {
        const unsigned col0 = (unsigned)(u.pn * BM + wc * 64 + 16 * fq);
        float gt[2][4];
#pragma unroll
        for (int ai = 0; ai < 2; ++ai)
#pragma unroll
            for (int m = 0; m < 4; ++m) gt[ai][m] = gate[u.ord * 256 + ai * HALF + wr * 64 + m * 16 + fr] * oscale;
#pragma unroll
        for (int ai = 0; ai < 2; ++ai)
#pragma unroll
            for (int m = 0; m < 4; ++m) { const int r = ai * HALF + wr * 64 + m * 16 + fr; const float g = gt[ai][m];
                const unsigned row = (r < u.nrows) ? (unsigned)u.rt * 256u + (unsigned)r : 360448u;
                const f32x4 v0 = acc[ai][0][m][0] * g, v1 = acc[ai][0][m][1] * g, v2 = acc[ai][1][m][0] * g, v3 = acc[ai][1][m][1] * g;
                v4u w; w.x = pk4_f8(v0[0], v0[1], v0[2], v0[3]); w.y = pk4_f8(v1[0], v1[1], v1[2], v1[3]); w.z = pk4_f8(v2[0], v2[1], v2[2], v2[3]); w.w = pk4_f8(v3[0], v3[1], v3[2], v3[3]);
                *(v4u*)(YE + (row * (unsigned)D + col0)) = w; }
    }
};
}

struct Args { const float* in[26]; float* out; unsigned char* ws; int ph_lo, ph_hi; };
enum { I_X = 0, I_C, I_CTX, I_CCTX, I_ADAW, I_ADAB, I_NMIX, I_NFFN, I_NFIN, I_WIN, I_WOUT, I_CONVW, I_CONVB, I_WA, I_BA, I_WX, I_BX, I_LAM,
       I_LBL, I_HNORM, I_RW, I_RB, I_EW13, I_EW2, I_SW13, I_SW2 };

struct Frame {
    LAS unsigned char* lds;
    int tid, lane, wave, G, vcu, bx;
    const float* const* in; float* out; unsigned char* ws;
};

DI void transpose_item(const float* W, int ldw, bf16* WT, int ldo, int k0, int n0, int orow0, LAS float* scr, int lane) {
    const int sub = lane >> 3, c4 = (lane & 7) * 4;
    f32x4 v[8];
#pragma unroll
    for (int i = 0; i < 8; ++i) v[i] = __builtin_nontemporal_load((const f32x4*)(W + (size_t)(k0 + 8 * i + sub) * ldw + n0 + c4));
#pragma unroll
    for (int i = 0; i < 8; ++i) { LAS float* d = scr + (8 * i + sub) * 33 + c4; d[0] = v[i].x; d[1] = v[i].y; d[2] = v[i].z; d[3] = v[i].w; }
    LDS_WAIT(); asm volatile("" ::: "memory");
    const int c = lane & 7;
#pragma unroll
    for (int j = 0; j < 4; ++j) { const int n = (lane >> 3) + 8 * j; const LAS float* s = scr + (8 * c) * 33 + n;
        v4u o; o.x = pk2(s[0 * 33], s[1 * 33]); o.y = pk2(s[2 * 33], s[3 * 33]); o.z = pk2(s[4 * 33], s[5 * 33]); o.w = pk2(s[6 * 33], s[7 * 33]);
        *(v4u*)(WT + (size_t)(orow0 + n) * ldo + k0 + 8 * c) = o; }
    LDS_WAIT(); asm volatile("" ::: "memory");
}
DI void transpose_item8(const float* W, int ldw, unsigned char* WT, int ldo, int k0, int n0, int orow0, float scale, LAS float* scr, int lane) {
    const int sub = lane >> 3, c4 = (lane & 7) * 4;
    f32x4 v[16];
#pragma unroll
    for (int i = 0; i < 16; ++i) v[i] = __builtin_nontemporal_load((const f32x4*)(W + (size_t)(k0 + 8 * i + sub) * ldw + n0 + c4));
#pragma unroll
    for (int i = 0; i < 16; ++i) { LAS float* d = scr + (8 * i + sub) * 33 + c4; d[0] = v[i].x; d[1] = v[i].y; d[2] = v[i].z; d[3] = v[i].w; }
    LDS_WAIT(); asm volatile("" ::: "memory");
    const int c = lane & 7;
#pragma unroll
    for (int j = 0; j < 4; ++j) { const int n = (lane >> 3) + 8 * j; const LAS float* sp = scr + (16 * c) * 33 + n;
        v4u o; o.x = pk4_f8(sp[0] * scale, sp[33] * scale, sp[66] * scale, sp[99] * scale); o.y = pk4_f8(sp[132] * scale, sp[165] * scale, sp[198] * scale, sp[231] * scale);
        o.z = pk4_f8(sp[264] * scale, sp[297] * scale, sp[330] * scale, sp[363] * scale); o.w = pk4_f8(sp[396] * scale, sp[429] * scale, sp[462] * scale, sp[495] * scale);
        *(v4u*)(WT + (size_t)(orow0 + n) * ldo + k0 + 16 * c) = o; }
    LDS_WAIT(); asm volatile("" ::: "memory");
}
DI int w13_row(int n) { const int half = n >> 8, idx = n & 255; return 256 * (idx >> 7) + 128 * half + (idx & 127); }

DI void phase_prologue(const Frame& F) {
    const float* const* in = F.in; unsigned char* ws = F.ws;
    {
        LAS float* sc = (LAS float*)F.lds;
        LAS float* red = (LAS float*)(F.lds + 17 * 1024 * 4);
        for (int i = F.tid; i < 17 * 1024; i += NTHR) { const int r = i >> 10, k = i & 1023; const float v = (r < 16) ? in[I_C][r * 1024 + k] : in[I_CCTX][k]; sc[i] = v / (1.0f + __expf(-v)); }
        __syncthreads();
        const float* aw = in[I_ADAW]; float* MOD = (float*)(ws + WS_MOD);
        for (int cg = F.bx; cg < 256; cg += F.G) {
            const int kg = F.tid >> 5, cl = F.tid & 31, col = cg * 24 + cl;
            float a[17];
#pragma unroll
            for (int r = 0; r < 17; ++r) a[r] = 0.f;
            if (cl < 24) {
#pragma unroll 1
                for (int k8 = 0; k8 < 64; k8 += 16) { float w[16];
#pragma unroll
                    for (int q = 0; q < 16; ++q) w[q] = aw[(size_t)(kg * 64 + k8 + q) * 6144 + col];
#pragma unroll
                    for (int q = 0; q < 16; ++q) { const int k = kg * 64 + k8 + q;
#pragma unroll
                        for (int r = 0; r < 17; ++r) a[r] += sc[r * 1024 + k] * w[q]; } }
#pragma unroll
                for (int r = 0; r < 17; ++r) red[(kg * 17 + r) * 24 + cl] = a[r];
            }
            __syncthreads();
            if (F.tid < 17 * 24) { const int r = F.tid / 24, c2 = F.tid % 24; float s = 0.f;
                for (int g = 0; g < 16; ++g) s += red[(g * 17 + r) * 24 + c2];
                MOD[r * 6144 + cg * 24 + c2] = s + in[I_ADAB][cg * 24 + c2]; }
            __syncthreads();
        }
    }
    {
        float* LB = (float*)(ws + WS_TAB); float* SP = LB + 1024;
        const int gt = F.bx * NTHR + F.tid, GT = F.G * NTHR;
        for (int i = gt; i < 1024; i += GT) { const int d = i >> 9, c = i & 511;
            const float l0 = in[I_LBL][(d * 2 + 0) * 512 + c], l1 = in[I_LBL][(d * 2 + 1) * 512 + c];
            LB[i] = 1.0f / (1.0f + expf(l1 - l0));
            SP[i] = log1pf(expf(-in[I_LAM][i])); }
        bf16* WGT = (bf16*)(ws + WS_WGT);
        for (int i = gt; i < 2 * 2 * 8 * 64 * 64; i += GT) { const int ii = i & 63, j = (i >> 6) & 63, h = (i >> 12) & 7, g = (i >> 15) & 1, d = i >> 16;
            const float* src = g ? in[I_WX] : in[I_WA];
            WGT[i] = f2bf(src[((size_t)(d * 8 + h) * 64 + ii) * 64 + j]); }
    }
    {
        LAS float* scr = (LAS float*)(F.lds + F.wave * 16896);
        const int gw = F.vcu * NWAVES + F.wave, NGW = F.G * NWAVES;
        constexpr int IT_WIN = 16 * 112, IT_WOUT = 16 * 32, IT_WR = 16 * 8, IT_SW13 = 8 * 16, IT_SW2 = 2 * 32;
        LAS float* scr8 = (LAS float*)(F.lds + F.wave * 16896);
        constexpr int NIT = IT_WIN + IT_WOUT + IT_WR + IT_SW13 + IT_SW2;
        for (int it = gw; it < NIT; it += NGW) {
            int r = it;
            if (r < IT_WIN) { const int kb = r / 112, nb = r % 112; transpose_item(in[I_WIN], INC, (bf16*)(ws + WS_WIN), 1024, kb * 64, nb * 32, nb * 32, scr, F.lane); continue; } r -= IT_WIN;
            if (r < IT_WOUT) { const int kb = r / 32, nb = r % 32; transpose_item(in[I_WOUT], 1024, (bf16*)(ws + WS_WOUT), 1024, kb * 64, nb * 32, nb * 32, scr, F.lane); continue; } r -= IT_WOUT;
            if (r < IT_WR) { const int kb = r / 8, nb = r % 8; transpose_item(in[I_RW], 256, (bf16*)(ws + WS_WR), 1024, kb * 64, nb * 32, nb * 32, scr, F.lane); continue; } r -= IT_WR;
            if (r < IT_SW13) { const int kb = r / 16, nb = r % 16; transpose_item8(in[I_SW13], 512, ws + WS_SW13, 1024, kb * 128, nb * 32, w13_row(nb * 32), 32.0f, scr8, F.lane); continue; } r -= IT_SW13;
            { const int kb = r / 32, nb = r % 32; transpose_item8(in[I_SW2], 1024, ws + WS_SW2, 256, kb * 128, nb * 32, nb * 32, 16.0f, scr8, F.lane); }
        }
    }
}
constexpr int CV_STR = 129;
static_assert(256 * CV_STR * 4 <= LDS_MISC, "convert lds");
DI void convert_experts(const Frame& F, int, int) {
    const float* const* in = F.in; unsigned char* ws = F.ws;
    LAS float* scr = (LAS float*)F.lds;
    volatile LAS int* slot = (volatile LAS int*)(F.lds + LDS_MISC + 48);
    unsigned* qhead = (unsigned*)(ws + WS_CTL) + CW_CONVQ;
    constexpr int NB13 = 256 * 16, NB2 = 256 * 8;
    auto decode = [&](int blk, const float*& src, int& ldw, unsigned char*& dst, int& ldo, int& orow0, float& scale) {
        if (blk < NB13) { const int e = blk >> 4, q = blk & 15, kb = q >> 2, nb = q & 3;
            src = in[I_EW13] + (size_t)e * 1024 * 512 + (size_t)(kb * 256) * 512 + nb * 128; ldw = 512;
            dst = ws + WS_EW13 + (size_t)e * 512 * 1024 + kb * 256; ldo = 1024; orow0 = w13_row(nb * 128); scale = 32.0f; }
        else { const int r = blk - NB13, e = r >> 3, nb = r & 7;
            src = in[I_EW2] + (size_t)e * 256 * 1024 + nb * 128; ldw = 1024;
            dst = ws + WS_EW2 + (size_t)e * 1024 * 256; ldo = 256; orow0 = nb * 128; scale = 16.0f; } };
    auto claim = [&]() -> int { __syncthreads(); if (F.tid == 0) slot[0] = (int)__hip_atomic_fetch_add(qhead, 1u, __ATOMIC_RELAXED, __HIP_MEMORY_SCOPE_AGENT); __syncthreads(); return slot[0]; };
    f32x4 v[16];
    int blk = claim();
    const float* src = nullptr; int ldw = 0; unsigned char* dst = nullptr; int ldo = 0, orow0 = 0; float scale = 1.f;
    if (blk < NB13 + NB2) { decode(blk, src, ldw, dst, ldo, orow0, scale);
#pragma unroll
        for (int i = 0; i < 16; ++i) { const int p = F.tid + NTHR * i; v[i] = __builtin_nontemporal_load((const f32x4*)(src + (size_t)(p >> 5) * ldw + (p & 31) * 4)); } }
    while (blk < NB13 + NB2) {
        __syncthreads();
#pragma unroll
        for (int i = 0; i < 16; ++i) { const int p = F.tid + NTHR * i; LAS float* d = scr + (p >> 5) * CV_STR + (p & 31) * 4; d[0] = v[i].x; d[1] = v[i].y; d[2] = v[i].z; d[3] = v[i].w; }
        unsigned char* cdst = dst; const int cldo = ldo, corow0 = orow0; const float cscale = scale;
        blk = claim();
        if (blk < NB13 + NB2) { decode(blk, src, ldw, dst, ldo, orow0, scale);
#pragma unroll
            for (int i = 0; i < 16; ++i) { const int p = F.tid + NTHR * i; v[i] = __builtin_nontemporal_load((const f32x4*)(src + (size_t)(p >> 5) * ldw + (p & 31) * 4)); } }
#pragma unroll
        for (int i = 0; i < 4; ++i) { const int p = F.tid + NTHR * i; const int n = p >> 4, kc = (p & 15) * 16;
            const LAS float* sp = scr + kc * CV_STR + n;
            v4u o; o.x = pk4_f8(sp[0] * cscale, sp[CV_STR] * cscale, sp[2 * CV_STR] * cscale, sp[3 * CV_STR] * cscale);
            o.y = pk4_f8(sp[4 * CV_STR] * cscale, sp[5 * CV_STR] * cscale, sp[6 * CV_STR] * cscale, sp[7 * CV_STR] * cscale);
            o.z = pk4_f8(sp[8 * CV_STR] * cscale, sp[9 * CV_STR] * cscale, sp[10 * CV_STR] * cscale, sp[11 * CV_STR] * cscale);
            o.w = pk4_f8(sp[12 * CV_STR] * cscale, sp[13 * CV_STR] * cscale, sp[14 * CV_STR] * cscale, sp[15 * CV_STR] * cscale);
            *(v4u*)(cdst + (size_t)(corow0 + n) * cldo + kc) = o; }
    }
    __syncthreads();
}

DI void phase_norm_rows(const Frame& F, int mode) {
    const float* MOD = (const float*)(F.ws + WS_MOD);
    const int gw = F.bx * NWAVES + F.wave, NGW = F.G * NWAVES;
    const int nrows = mode == 0 ? MTOT : NTOK;
    const float* gain = mode == 0 ? F.in[I_NMIX] : F.in[I_NFFN];
    bf16* dst = (bf16*)(F.ws + (mode == 0 ? WS_HX : WS_HX2));
    const int sh_off = mode == 0 ? 0 : 3072, sc_off = mode == 0 ? 1024 : 4096;
    const int per = (nrows + NGW - 1) / NGW, r0 = gw * per, r1 = (r0 + per < nrows) ? r0 + per : nrows;
    f32x4 gn[4];
#pragma unroll
    for (int j = 0; j < 4; ++j) gn[j] = *(const f32x4*)(gain + 4 * F.lane + 256 * j);
    auto rowsrc = [&](int m) -> const float* {
        return (m < NTOK) ? F.in[I_X] + (size_t)m * D : F.in[I_CTX] + (size_t)(m - NTOK) * D; };
    const bf16* X1b = (const bf16*)(F.ws + WS_X1);
    auto ldrow = [&](int m, f32x4 (&v)[4]) {
        if (mode == 0) {
#pragma unroll
            for (int j = 0; j < 4; ++j) v[j] = *(const f32x4*)(rowsrc(m) + 4 * F.lane + 256 * j); }
        else {
#pragma unroll
            for (int j = 0; j < 4; ++j) { const v2u t = *(const v2u*)(X1b + (size_t)m * D + 4 * F.lane + 256 * j); v[j] = (f32x4){bflo(t.x), bfhi(t.x), bflo(t.y), bfhi(t.y)}; } } };
    f32x4 va[4], vb[4], ga[4], sb4[4]; int cur_mr = -1;
#pragma unroll
    for (int j = 0; j < 4; ++j) { ga[j] = gn[j]; sb4[j] = gn[j]; }
    if (r0 < r1) { ldrow(r0, va); ldrow((r0 + 1 < r1) ? r0 + 1 : r0, vb); }
#pragma unroll 1
    for (int m = r0; m < r1; m += 2) {
        f32x4 ca[4], cb[4];
#pragma unroll
        for (int j = 0; j < 4; ++j) { ca[j] = va[j]; cb[j] = vb[j]; }
        const bool hasb = (m + 1 < r1);
        { const int na = (m + 2 < r1) ? m + 2 : m, nb = (m + 3 < r1) ? m + 3 : na; ldrow(na, va); ldrow(nb, vb); }
        float sa = 0.f, sb = 0.f;
#pragma unroll
        for (int j = 0; j < 4; ++j) { sa += (ca[j].x * ca[j].x + ca[j].y * ca[j].y) + (ca[j].z * ca[j].z + ca[j].w * ca[j].w); sb += (cb[j].x * cb[j].x + cb[j].y * cb[j].y) + (cb[j].z * cb[j].z + cb[j].w * cb[j].w); }
        const float rsa = rsqrtf(wave_sum_fast(sa) * (1.0f / D) + EPS), rsb = rsqrtf(wave_sum_fast(sb) * (1.0f / D) + EPS);
#pragma unroll
        for (int q = 0; q < 2; ++q) {
            if (q == 1 && !hasb) break;
            const int mm = m + q; const float rs = q ? rsb : rsa;
            const int mr = (mode == 0 && mm >= NTOK) ? 16 : (mm >> 11);
            if (mr != cur_mr) { cur_mr = mr;
#pragma unroll
                for (int j = 0; j < 4; ++j) { const int c = 4 * F.lane + 256 * j;
                    ga[j] = gn[j] * (*(const f32x4*)(MOD + mr * 6144 + sc_off + c) + 1.0f); sb4[j] = *(const f32x4*)(MOD + mr * 6144 + sh_off + c); } }
#pragma unroll
            for (int j = 0; j < 4; ++j) { const int c = 4 * F.lane + 256 * j;
                const f32x4 v = q ? cb[j] : ca[j];
                const f32x4 y = (v * rs) * ga[j] + sb4[j];
                v2u w; w.x = pk2(y.x, y.y); w.y = pk2(y.z, y.w);
                *(v2u*)(dst + (size_t)mm * D + c) = w;
                if (mode == 1) *(unsigned*)(F.ws + WS_HX2F + (size_t)mm * D + c) = pk4_f8(y.x, y.y, y.z, y.w); }
        }
    }
}

constexpr int LT_STR = 520;
constexpr int L_RT = 0;
constexpr int L_GT = 69888;
static_assert(L_GT + 64 * LT_STR * 2 <= LDS_MISC, "lru lds");
template <bool FINAL> DI void lru_tile(const Frame& F, int b, int s) {
    const bf16* P = (const bf16*)(F.ws + WS_P);
    const int h = F.wave, fr = F.lane & 15, fq = F.lane >> 4;
    int prow0, L, t0;
    if (s < 4) { prow0 = NTOK + b * CTXL + 64 * s; L = CTXL; t0 = 64 * s; } else { prow0 = b * SEQ + 64 * (s - 4); L = SEQ; t0 = 64 * (s - 4); }
    LAS bf16* RT = (LAS bf16*)(F.lds + L_RT); LAS bf16* GT = (LAS bf16*)(F.lds + L_GT);
#pragma unroll
    for (int it = 0; it < 9; ++it) { const int p = F.tid + it * NTHR;
        if (p < 67 * 64) { const int row = p >> 6, pc = p & 63, ts = t0 + row - 1;
            v4u v = {0u, 0u, 0u, 0u};
            if (ts >= 0 && ts < L) v = *(const v4u*)(P + (size_t)(prow0 + row - 1) * INC + 8 * pc);
            *(LAS v4u*)(RT + row * LT_STR + 8 * pc) = v; } }
    if (FINAL) {
#pragma unroll
        for (int it = 0; it < 8; ++it) { const int p = F.tid + it * NTHR; const int row = p >> 6, pc = p & 63;
            *(LAS v4u*)(GT + row * LT_STR + 8 * pc) = *(const v4u*)(P + (size_t)(prow0 + row) * INC + 512 + 8 * pc); } }
    __syncthreads();
    bf16x8 Af[4][2];
#pragma unroll
    for (int ks = 0; ks < 2; ++ks) {
        const int c0 = 64 * h + 32 * ks + 8 * fq;
        float cw[4][8], cb[8];
#pragma unroll
        for (int k = 0; k < 4; ++k) { const f32x4 w0 = *(const f32x4*)(F.in[I_CONVW] + k * 512 + c0), w1 = *(const f32x4*)(F.in[I_CONVW] + k * 512 + c0 + 4);
            cw[k][0] = w0.x; cw[k][1] = w0.y; cw[k][2] = w0.z; cw[k][3] = w0.w; cw[k][4] = w1.x; cw[k][5] = w1.y; cw[k][6] = w1.z; cw[k][7] = w1.w; }
        { const f32x4 w0 = *(const f32x4*)(F.in[I_CONVB] + c0), w1 = *(const f32x4*)(F.in[I_CONVB] + c0 + 4);
            cb[0] = w0.x; cb[1] = w0.y; cb[2] = w0.z; cb[3] = w0.w; cb[4] = w1.x; cb[5] = w1.y; cb[6] = w1.z; cb[7] = w1.w; }
        const LAS bf16* rbase = RT + fr * LT_STR + c0;
#pragma unroll
        for (int tt = 0; tt < 4; ++tt) {
            float u[8];
#pragma unroll
            for (int j = 0; j < 8; ++j) u[j] = cb[j];
#pragma unroll
            for (int k = 0; k < 4; ++k) { const v4u r8 = *(const LAS v4u*)(rbase + (16 * tt + k) * LT_STR);
                u[0] += cw[k][0] * bflo(r8.x); u[1] += cw[k][1] * bfhi(r8.x); u[2] += cw[k][2] * bflo(r8.y); u[3] += cw[k][3] * bfhi(r8.y);
                u[4] += cw[k][4] * bflo(r8.z); u[5] += cw[k][5] * bfhi(r8.z); u[6] += cw[k][6] * bflo(r8.w); u[7] += cw[k][7] * bfhi(r8.w); }
            v4u w; w.x = pk2(u[0], u[1]); w.y = pk2(u[2], u[3]); w.z = pk2(u[4], u[5]); w.w = pk2(u[6], u[7]);
            Af[tt][ks] = __builtin_bit_cast(bf16x8, w);
        }
    }
    const bf16* WGT = (const bf16*)(F.ws + WS_WGT);
    const float* SP = (const float*)(F.ws + WS_TAB) + 1024;
    LAS bf16* HL = RT;
    LAS bf16* hlb = HL + (4 * fq) * LT_STR + 64 * h + fr;
    LAS bf16* gtb = GT + (4 * fq) * LT_STR + 64 * h + fr;
#pragma unroll 1
    for (int dir = 0; dir < 2; ++dir) {
#pragma unroll 1
        for (int nt = 0; nt < 4; ++nt) {
            const int cj = 64 * h + 16 * nt + fr;
            bf16x8 Ba[2], Bx[2], Id[2];
#pragma unroll
            for (int ks = 0; ks < 2; ++ks) {
                Ba[ks] = *(const bf16x8*)(WGT + ((size_t)((dir * 2 + 0) * 8 + h) * 64 + 16 * nt + fr) * 64 + 32 * ks + 8 * fq);
                Bx[ks] = *(const bf16x8*)(WGT + ((size_t)((dir * 2 + 1) * 8 + h) * 64 + 16 * nt + fr) * 64 + 32 * ks + 8 * fq);
#pragma unroll
                for (int jj = 0; jj < 8; ++jj) Id[ks][jj] = (32 * ks + 8 * fq + jj == 16 * nt + fr) ? (short)0x3F80 : (short)0;
            }
            const float ba = F.in[I_BA][dir * 512 + cj], bx = F.in[I_BX][dir * 512 + cj], sp = SP[dir * 512 + cj];
            float cin = 0.f, ptot = 1.f;
            if (FINAL) cin = ((const float*)(F.ws + WS_CIN))[((size_t)(dir * NB + b) * NSEQT + s) * 512 + cj];
#pragma unroll
            for (int tti = 0; tti < 4; ++tti) {
                const int tt = dir ? 3 - tti : tti;
                const bf16x8 A0 = dir ? Af[3 - tti][0] : Af[tti][0], A1 = dir ? Af[3 - tti][1] : Af[tti][1];
                f32x4 pa = {0.f, 0.f, 0.f, 0.f}, px = {0.f, 0.f, 0.f, 0.f}, uc = {0.f, 0.f, 0.f, 0.f};
                pa = __builtin_amdgcn_mfma_f32_16x16x32_bf16(A0, Ba[0], pa, 0, 0, 0); pa = __builtin_amdgcn_mfma_f32_16x16x32_bf16(A1, Ba[1], pa, 0, 0, 0);
                px = __builtin_amdgcn_mfma_f32_16x16x32_bf16(A0, Bx[0], px, 0, 0, 0); px = __builtin_amdgcn_mfma_f32_16x16x32_bf16(A1, Bx[1], px, 0, 0, 0);
                uc = __builtin_amdgcn_mfma_f32_16x16x32_bf16(A0, Id[0], uc, 0, 0, 0); uc = __builtin_amdgcn_mfma_f32_16x16x32_bf16(A1, Id[1], uc, 0, 0, 0);
                float av[4], bv[4];
#pragma unroll
                for (int ri = 0; ri < 4; ++ri) { const float pav = dir ? pa[3 - ri] : pa[ri], pxv = dir ? px[3 - ri] : px[ri], ucv = dir ? uc[3 - ri] : uc[ri];
                    const float rg = sigm(pav + ba), ig = sigm(pxv + bx);
                    const float a = expf_(-8.0f * rg * sp); av[ri] = a; bv[ri] = __builtin_amdgcn_sqrtf(fmaxf(1.0f - a * a, 0.f)) * ig * ucv; }
                float pl = 1.f, hl = 0.f;
#pragma unroll
                for (int ri = 0; ri < 4; ++ri) { hl = av[ri] * hl + bv[ri]; pl *= av[ri]; }
                float pg[4], hg[4];
#pragma unroll
                for (int gi = 0; gi < 4; ++gi) { const int g = dir ? 3 - gi : gi; pg[gi] = __shfl(pl, fr + 16 * g); hg[gi] = __shfl(hl, fr + 16 * g); }
                const int myg = dir ? 3 - fq : fq;
                float mycin = cin, run = cin;
#pragma unroll
                for (int gi = 0; gi < 4; ++gi) { if (gi == myg) mycin = run; run = pg[gi] * run + hg[gi]; }
                if (FINAL) { float hc = mycin;
#pragma unroll
                    for (int ri = 0; ri < 4; ++ri) { const int r = dir ? 3 - ri : ri; hc = av[ri] * hc + bv[ri];
                        const int o = (16 * tt + r) * LT_STR + 16 * nt;
                        if (dir == 0) hlb[o] = f2bf(hc);
                        else gtb[o] = f2bf(bf2f(gtb[o]) * (bf2f(hlb[o]) + hc)); } }
                else ptot *= (pg[0] * pg[1]) * (pg[2] * pg[3]);
                cin = run;
            }
            if (!FINAL && fq == 0) { const size_t o = ((size_t)(dir * NB + b) * NSEQT + s) * 512 + cj;
                ((float*)(F.ws + WS_SUMA))[o] = ptot; ((float*)(F.ws + WS_SUMH))[o] = cin; }
        }
    }
    if (FINAL) {
        __syncthreads();
        bf16* YL = (bf16*)(F.ws + WS_YL);
#pragma unroll
        for (int it = 0; it < 8; ++it) { const int p = F.tid + it * NTHR; const int row = p >> 6, pc = p & 63;
            *(v4u*)(YL + (size_t)(prow0 + row) * D + 8 * pc) = *(const LAS v4u*)(GT + row * LT_STR + 8 * pc); } }
    __syncthreads();
}
DI void phase_lru_pass1(const Frame& F) {
    for (int it = F.bx; it < NB * NSEQT; it += F.G) lru_tile<false>(F, it / NSEQT, it % NSEQT);
}
DI void phase_lru_carry(const Frame& F) {
    if (F.wave != 0) return;
    const float* SA = (const float*)(F.ws + WS_SUMA); const float* SH = (const float*)(F.ws + WS_SUMH); float* CI = (float*)(F.ws + WS_CIN);
    for (int id = F.bx * 64 + F.lane; id < 2 * NB * 512; id += F.G * 64) {
        const int dir = id >> 13, b = (id >> 9) & 15, c = id & 511;
        float x = 0.f; const size_t o0 = (size_t)(dir * NB + b) * NSEQT * 512 + c;
#pragma unroll
        for (int hf = 0; hf < 2; ++hf) {
            float av[18], hv[18];
#pragma unroll
            for (int q = 0; q < 18; ++q) { const int st = 18 * hf + q, s = dir ? (st < 4 ? 3 - st : 39 - st) : st; av[q] = SA[o0 + (size_t)s * 512]; hv[q] = SH[o0 + (size_t)s * 512]; }
#pragma unroll
            for (int q = 0; q < 18; ++q) { const int st = 18 * hf + q, s = dir ? (st < 4 ? 3 - st : 39 - st) : st; CI[o0 + (size_t)s * 512] = x; x = av[q] * x + hv[q]; }
        }
    }
}
DI void phase_lru_pass2(const Frame& F) {
    for (int it = F.bx; it < NB * 32; it += F.G) lru_tile<true>(F, it >> 5, 4 + (it & 31));
}

constexpr int HS = 144, SCS = 40;
constexpr int H_Q = 0, H_LF = H_Q + 32 * HS * 2, H_V = H_LF + 32 * HS * 2, H_QT = H_V + 32 * HS * 2, H_KT = H_QT + 32 * HS * 2, H_KH = H_KT + 32 * HS * 2,
              H_SC = H_KH + 32 * HS * 2, H_DEC = H_SC + 32 * SCS * 2, H_SET = H_DEC + 512;
static_assert(2 * H_SET <= RING_BYTES, "hgrn lds");
typedef short s16x4 __attribute__((ext_vector_type(4)));
DI bf16x8 tr_frag(const LAS bf16* tile, int c0, int lane) {
    const int g = lane >> 4, q = (lane & 15) >> 2, p = lane & 3;
    const LAS bf16* a = tile + (8 * g + q) * HS + c0 + 4 * p;
    const s16x4 lo = __builtin_amdgcn_ds_read_tr16_b64_v4i16((LAS s16x4*)a), hi = __builtin_amdgcn_ds_read_tr16_b64_v4i16((LAS s16x4*)(a + 4 * HS));
    bf16x8 r; r[0] = lo[0]; r[1] = lo[1]; r[2] = lo[2]; r[3] = lo[3]; r[4] = hi[0]; r[5] = hi[1]; r[6] = hi[2]; r[7] = hi[3]; return r;
}
constexpr int P_QR = 0, P_LR = P_QR + 2 * 9216, P_VR = P_LR + 2 * 9216, P_QT = P_VR + 4 * 9216, P_KT = P_QT + 2 * 9216, P_KH = P_KT + 2 * 9216, P_SC = P_KH + 2 * 9216, P_DEC = P_SC + 2 * 2560, P_END = P_DEC + 2 * 512;
static_assert(P_END <= LDS_MISC, "hgrn pipelined lds");
DI void hgrn_chain2(const Frame& F, int item) {
    const int b = item >> 3, h = (item >> 1) & 3, dir = item & 1;
    const bf16* P = (const bf16*)(F.ws + WS_P);
    bf16* O = (bf16*)(F.ws + (dir ? WS_OB : WS_OF));
    const int w = F.wave, lane = F.lane, fr = lane & 15, g = lane >> 4;
    const int li = F.tid >> 4, lp = F.tid & 15;
    auto prow = [&](int c, int i) -> size_t {
        const int ii = dir ? 31 - i : i;
        if (c < 8) { const int cc = dir ? 7 - c : c; return (size_t)NTOK + b * CTXL + 32 * cc + ii; }
        const int col = dir ? 63 - (c - 8) : (c - 8); return (size_t)b * SEQ + ii * 64 + col; };
    const size_t coff = 128 * h + 8 * lp;
    v4u rqA, rlA, rvA, rqB, rlB, rvB;
    { const bf16* rp = P + prow(0, li) * INC + coff; rqA = *(const v4u*)(rp + 1024); rvA = *(const v4u*)(rp + 1536); rlA = *(const v4u*)(rp + 2048 + 512 * dir); }
    { const bf16* rp = P + prow(1, li) * INC + coff; rqB = *(const v4u*)(rp + 1024); rvB = *(const v4u*)(rp + 1536); rlB = *(const v4u*)(rp + 2048 + 512 * dir); }
    LAS unsigned char* L = F.lds;
#define HG2_W(k, U, RQ, RL, RV) do { \
        const int i = (k) - 2, wch = (k), pch = (k) - 1; (void)i; (void)pch; \
        if (wch < 72) {   \
            *(LAS v4u*)((LAS bf16*)(L + P_QR + ((U) & 1) * 9216) + li * HS + 8 * lp) = RQ; *(LAS v4u*)((LAS bf16*)(L + P_LR + ((U) & 1) * 9216) + li * HS + 8 * lp) = RL; \
            *(LAS v4u*)((LAS bf16*)(L + P_VR + (U) * 9216) + li * HS + 8 * lp) = RV; \
            if (wch + 2 < 72) { const bf16* rp = P + prow(wch + 2, li) * INC + coff; RQ = *(const v4u*)(rp + 1024); RV = *(const v4u*)(rp + 1536); RL = *(const v4u*)(rp + 2048 + 512 * dir); } } \
    } while (0)
#define HG2_PREP(k, U) do { \
        const int i = (k) - 2, wch = (k), pch = (k) - 1; (void)i; (void)pch; \
        const int pw = w - 4; \
            if (pch >= 0 && pch < 72) {   \
                const LAS bf16* Qr = (const LAS bf16*)(L + P_QR + (((U) + 1) & 1) * 9216); const LAS bf16* LFr = (const LAS bf16*)(L + P_LR + (((U) + 1) & 1) * 9216); \
                LAS bf16* QT = (LAS bf16*)(L + P_QT + (((U) + 1) & 1) * 9216); LAS bf16* KT = (LAS bf16*)(L + P_KT + (((U) + 1) & 1) * 9216); LAS bf16* KH = (LAS bf16*)(L + P_KH + (((U) + 1) & 1) * 9216); \
                LAS float* DEC = (LAS float*)(L + P_DEC + (((U) + 1) & 1) * 512); \
                _Pragma("unroll") for (int db = 0; db < 2; ++db) { const int dblk = 16 * (2 * pw + db); \
                    const bf16x8 Al = tr_frag(LFr, dblk, lane); \
                    f32x4 Gm[2]; \
                    _Pragma("unroll") for (int it = 0; it < 2; ++it) Gm[it] = __builtin_amdgcn_mfma_f32_16x16x32_bf16(Al, Tri[it], (f32x4){0.f, 0.f, 0.f, 0.f}, 0, 0, 0); \
                    f32x4 dec; \
                    _Pragma("unroll") for (int r = 0; r < 4; ++r) dec[r] = expf_(__shfl(Gm[1][r], (lane & 48) | 15)); \
                    if (fr == 0) *(LAS f32x4*)(DEC + dblk + 4 * g) = dec; \
                    _Pragma("unroll") for (int it = 0; it < 2; ++it) { const int ii = 16 * it + fr, d0 = dblk + 4 * g; \
                        const v2u q4 = *(const LAS v2u*)(Qr + ii * HS + d0), l4 = *(const LAS v2u*)(LFr + ii * HS + d0); \
                        const float qv[4] = {bflo(q4.x), bfhi(q4.x), bflo(q4.y), bfhi(q4.y)}, lv[4] = {bflo(l4.x), bfhi(l4.x), bflo(l4.y), bfhi(l4.y)}; \
                        float qt[4], kt[4], kh[4]; \
                        _Pragma("unroll") for (int r = 0; r < 4; ++r) { const float eg = expf_(Gm[it][r]), ieg = rcpf_(eg), kk = 1.0f - expf_(lv[r]); qt[r] = qv[r] * eg; kt[r] = kk * ieg; kh[r] = kk * dec[r] * ieg; } \
                        *(LAS v2u*)(QT + ii * HS + d0) = (v2u){pk2(qt[0], qt[1]), pk2(qt[2], qt[3])}; \
                        *(LAS v2u*)(KT + ii * HS + d0) = (v2u){pk2(kt[0], kt[1]), pk2(kt[2], kt[3])}; \
                        *(LAS v2u*)(KH + ii * HS + d0) = (v2u){pk2(kh[0], kh[1]), pk2(kh[2], kh[3])}; } } } \
            if (i >= 8 && i < 72) {   \
                const LAS bf16* QT = (const LAS bf16*)(L + P_QT + ((U) & 1) * 9216); const LAS bf16* KT = (const LAS bf16*)(L + P_KT + ((U) & 1) * 9216); LAS bf16* SC = (LAS bf16*)(L + P_SC + ((U) & 1) * 2560); \
                const int it = pw >> 1, jt = pw & 1; f32x4 sc = {0.f, 0.f, 0.f, 0.f}; \
                _Pragma("unroll") for (int ks = 0; ks < 4; ++ks) { const bf16x8 ak = *(const LAS bf16x8*)(KT + (16 * jt + fr) * HS + 32 * ks + 8 * g), bq = *(const LAS bf16x8*)(QT + (16 * it + fr) * HS + 32 * ks + 8 * g); \
                    sc = __builtin_amdgcn_mfma_f32_16x16x32_bf16(ak, bq, sc, 0, 0, 0); } \
                const int ii = 16 * it + fr, j0 = 16 * jt + 4 * g; \
                *(LAS v2u*)(SC + ii * SCS + j0) = (v2u){pk2(j0 <= ii ? sc[0] : 0.f, j0 + 1 <= ii ? sc[1] : 0.f), pk2(j0 + 2 <= ii ? sc[2] : 0.f, j0 + 3 <= ii ? sc[3] : 0.f)}; } \
    } while (0)
#define HG2_CORE(k, U) do { \
        const int i = (k) - 2, wch = (k), pch = (k) - 1; (void)i; (void)pch; \
            f32x4 onew[2][2]; \
            _Pragma("unroll") for (int eb = 0; eb < 2; ++eb) { onew[eb][0] = (f32x4){0.f, 0.f, 0.f, 0.f}; onew[eb][1] = (f32x4){0.f, 0.f, 0.f, 0.f}; } \
            bf16x8 Vf[2]; _Pragma("unroll") for (int eb = 0; eb < 2; ++eb) Vf[eb] = Vprev[eb]; \
            if (i >= 0 && i < 72) {   \
                const LAS bf16* QT = (const LAS bf16*)(L + P_QT + ((U) & 1) * 9216); const LAS bf16* KH = (const LAS bf16*)(L + P_KH + ((U) & 1) * 9216); \
                const LAS float* DEC = (const LAS float*)(L + P_DEC + ((U) & 1) * 512); const LAS bf16* Vr = (const LAS bf16*)(L + P_VR + (((U) + 2) & 3) * 9216); \
                if (i >= 8) {   \
                    _Pragma("unroll") for (int ks = 0; ks < 4; ++ks) { bf16x8 Bq[2]; \
                        _Pragma("unroll") for (int it = 0; it < 2; ++it) { const v2u a0 = *(const LAS v2u*)(QT + (16 * it + fr) * HS + 32 * ks + 4 * g), a1 = *(const LAS v2u*)(QT + (16 * it + fr) * HS + 32 * ks + 16 + 4 * g); \
                            v4u bv; bv.x = a0.x; bv.y = a0.y; bv.z = a1.x; bv.w = a1.y; Bq[it] = __builtin_bit_cast(bf16x8, bv); } \
                        _Pragma("unroll") for (int eb = 0; eb < 2; ++eb) { \
                            v4u sb; sb.x = pk2(S[eb][2 * ks][0], S[eb][2 * ks][1]); sb.y = pk2(S[eb][2 * ks][2], S[eb][2 * ks][3]); sb.z = pk2(S[eb][2 * ks + 1][0], S[eb][2 * ks + 1][1]); sb.w = pk2(S[eb][2 * ks + 1][2], S[eb][2 * ks + 1][3]); \
                            const bf16x8 As = __builtin_bit_cast(bf16x8, sb); \
                            _Pragma("unroll") for (int it = 0; it < 2; ++it) onew[eb][it] = __builtin_amdgcn_mfma_f32_16x16x32_bf16(As, Bq[it], onew[eb][it], 0, 0, 0); } } } \
                  \
                _Pragma("unroll") for (int eb = 0; eb < 2; ++eb) Vf[eb] = tr_frag(Vr, 16 * (2 * w + eb), lane); \
                _Pragma("unroll") for (int t = 0; t < 8; ++t) { const f32x4 dv = *(const LAS f32x4*)(DEC + 16 * t + 4 * g); const bf16x8 Kf = tr_frag(KH, 16 * t, lane); \
                    _Pragma("unroll") for (int eb = 0; eb < 2; ++eb) S[eb][t] = __builtin_amdgcn_mfma_f32_16x16x32_bf16(Kf, Vf[eb], S[eb][t] * dv, 0, 0, 0); } } \
            if (i - 1 >= 8 && i - 1 < 72) {   \
                const LAS bf16* SC = (const LAS bf16*)(L + P_SC + (((U) + 1) & 1) * 2560); \
                const int col = dir ? 63 - (i - 9) : (i - 9); \
                _Pragma("unroll") for (int it = 0; it < 2; ++it) { const bf16x8 bs = *(const LAS bf16x8*)(SC + (16 * it + fr) * SCS + 8 * g); \
                    const int ip = 16 * it + fr, ii = dir ? 31 - ip : ip; \
                    _Pragma("unroll") for (int eb = 0; eb < 2; ++eb) { const f32x4 o = __builtin_amdgcn_mfma_f32_16x16x32_bf16(Vprev[eb], bs, oprev[eb][it], 0, 0, 0); \
                        *(v2u*)(O + ((size_t)b * SEQ + ii * 64 + col) * 512 + 128 * h + 16 * (2 * w + eb) + 4 * g) = (v2u){pk2(o[0], o[1]), pk2(o[2], o[3])}; } } } \
            _Pragma("unroll") for (int eb = 0; eb < 2; ++eb) { oprev[eb][0] = onew[eb][0]; oprev[eb][1] = onew[eb][1]; Vprev[eb] = Vf[eb]; } \
    } while (0)
    if (w >= 4) {
        bf16x8 Tri[2];
#pragma unroll
        for (int it = 0; it < 2; ++it)
#pragma unroll
            for (int jj = 0; jj < 8; ++jj) Tri[it][jj] = (8 * g + jj <= 16 * it + fr) ? (short)0x3F80 : (short)0;
#pragma unroll 1
        for (int k = 0; k < 76; k += 4) {
            HG2_W(k, 0, rqA, rlA, rvA); HG2_PREP(k, 0); __syncthreads();
            HG2_W(k + 1, 1, rqB, rlB, rvB); HG2_PREP(k + 1, 1); __syncthreads();
            HG2_W(k + 2, 2, rqA, rlA, rvA); HG2_PREP(k + 2, 2); __syncthreads();
            HG2_W(k + 3, 3, rqB, rlB, rvB); HG2_PREP(k + 3, 3); __syncthreads();
        }
    } else {
        f32x4 S[2][8], oprev[2][2]; bf16x8 Vprev[2];
#pragma unroll
        for (int eb = 0; eb < 2; ++eb) {
#pragma unroll
            for (int t = 0; t < 8; ++t) S[eb][t] = (f32x4){0.f, 0.f, 0.f, 0.f};
            oprev[eb][0] = (f32x4){0.f, 0.f, 0.f, 0.f}; oprev[eb][1] = (f32x4){0.f, 0.f, 0.f, 0.f};
#pragma unroll
            for (int jj = 0; jj < 8; ++jj) Vprev[eb][jj] = 0; }
#pragma unroll 1
        for (int k = 0; k < 76; k += 4) {
            HG2_W(k, 0, rqA, rlA, rvA); HG2_CORE(k, 0); __syncthreads();
            HG2_W(k + 1, 1, rqB, rlB, rvB); HG2_CORE(k + 1, 1); __syncthreads();
            HG2_W(k + 2, 2, rqA, rlA, rvA); HG2_CORE(k + 2, 2); __syncthreads();
            HG2_W(k + 3, 3, rqB, rlB, rvB); HG2_CORE(k + 3, 3); __syncthreads();
        }
    }
#undef HG2_W
#undef HG2_PREP
#undef HG2_CORE
}
DI void phase_y2(const Frame& F) {
    const bf16* OFp = (const bf16*)(F.ws + WS_OF); const bf16* OBp = (const bf16*)(F.ws + WS_OB); const bf16* P = (const bf16*)(F.ws + WS_P); bf16* YL = (bf16*)(F.ws + WS_YL);
    const int gw = F.bx * NWAVES + F.wave, NGW = F.G * NWAVES;
    const int c = 8 * F.lane;
    const f32x4 g0 = *(const f32x4*)(F.in[I_HNORM] + c), g1 = *(const f32x4*)(F.in[I_HNORM] + c + 4);
    const float gn[8] = {g0.x, g0.y, g0.z, g0.w, g1.x, g1.y, g1.z, g1.w};
    for (int m = gw; m < NTOK; m += NGW) {
        const v4u a = *(const v4u*)(OFp + (size_t)m * 512 + c), bq = *(const v4u*)(OBp + (size_t)m * 512 + c), sg = *(const v4u*)(P + (size_t)m * INC + 3072 + c);
        float o[8] = {bflo(a.x) + bflo(bq.x), bfhi(a.x) + bfhi(bq.x), bflo(a.y) + bflo(bq.y), bfhi(a.y) + bfhi(bq.y), bflo(a.z) + bflo(bq.z), bfhi(a.z) + bfhi(bq.z), bflo(a.w) + bflo(bq.w), bfhi(a.w) + bfhi(bq.w)};
        const float sgv[8] = {bflo(sg.x), bfhi(sg.x), bflo(sg.y), bfhi(sg.y), bflo(sg.z), bfhi(sg.z), bflo(sg.w), bfhi(sg.w)};
        float ss = 0.f;
#pragma unroll
        for (int j = 0; j < 8; ++j) ss += o[j] * o[j];
        ss += __shfl_xor(ss, 1); ss += __shfl_xor(ss, 2); ss += __shfl_xor(ss, 4); ss += __shfl_xor(ss, 8);
        const float rs = rsqrtf(ss * (1.0f / 128.0f) + EPS);
#pragma unroll
        for (int j = 0; j < 8; ++j) o[j] = o[j] * rs * gn[j] * sgv[j];
        v4u wv; wv.x = pk2(o[0], o[1]); wv.y = pk2(o[2], o[3]); wv.z = pk2(o[4], o[5]); wv.w = pk2(o[6], o[7]);
        *(v4u*)(YL + (size_t)m * D + 512 + c) = wv;
    }
}

DI unsigned fkey(float f) { const unsigned u = __float_as_uint(f); return u ^ ((u >> 31) ? 0xFFFFFFFFu : 0x80000000u); }
template <int CTRL> DI unsigned dpp_u(unsigned v) { return (unsigned)__builtin_amdgcn_update_dpp(0, (int)v, CTRL, 0xf, 0xf, true); }
template <int CTRL> DI float dpp_f(float v) { return __uint_as_float(dpp_u<CTRL>(__float_as_uint(v))); }
DI unsigned umax_(unsigned a, unsigned b) { return a > b ? a : b; }
DI float readlane_f(float v, int lane) { return __uint_as_float((unsigned)__builtin_amdgcn_readlane((int)__float_as_uint(v), lane)); }
DI void phase_route(const Frame& F) {
    const float* LOGIT = (const float*)(F.ws + WS_LOGIT); const float* rb = F.in[I_RB];
    v2u* ROUTE = (v2u*)(F.ws + WS_ROUTE); int* HIST = (int*)(F.ws + WS_HIST);
    LAS unsigned* hist = (LAS unsigned*)F.lds;
    const int l = F.lane;
    const f32x4 rbv = *(const f32x4*)(rb + 4 * l);
    const float NEG = -__builtin_inff();
    for (int blk = F.bx; blk < NTOK / 128; blk += F.G) {
        if (F.tid < 256) hist[F.tid] = 0u;
        __syncthreads();
        const int tok0 = blk * 128 + F.wave * 16;
        f32x4 lg = *(const f32x4*)(LOGIT + (size_t)tok0 * NE + 4 * l);
#pragma unroll 1
        for (int ti = 0; ti < 16; ++ti) {
            const int tok = tok0 + ti;
            f32x4 lgn = {0.f, 0.f, 0.f, 0.f};
            if (ti + 1 < 16) lgn = *(const f32x4*)(LOGIT + (size_t)(tok + 1) * NE + 4 * l);
            float sc[4], bs[4];
#pragma unroll
            for (int k = 0; k < 4; ++k) { sc[k] = rcpf_(1.0f + expf_(-lg[k])); bs[k] = sc[k] + rbv[k]; }
            float m1 = NEG, m2 = NEG;
#pragma unroll
            for (int k = 0; k < 4; ++k) { const float v = bs[k]; if (v > m1) { m2 = m1; m1 = v; } else if (v > m2) m2 = v; }
            { float o1 = dpp_f<0xB1>(m1), o2 = dpp_f<0xB1>(m2); float n1 = fmaxf(m1, o1), n2 = fmaxf(fminf(m1, o1), fmaxf(m2, o2)); m1 = n1; m2 = n2;
              o1 = dpp_f<0x4E>(m1); o2 = dpp_f<0x4E>(m2); n1 = fmaxf(m1, o1); n2 = fmaxf(fminf(m1, o1), fmaxf(m2, o2)); m1 = n1; m2 = n2;
              const float a1 = dpp_f<0x104>(m1), a2 = dpp_f<0x104>(m2), c1 = dpp_f<0x114>(m1), c2 = dpp_f<0x114>(m2);
              o1 = (l & 4) ? c1 : a1; o2 = (l & 4) ? c2 : a2; n1 = fmaxf(m1, o1); n2 = fmaxf(fminf(m1, o1), fmaxf(m2, o2)); m1 = n1; m2 = n2; }
            const float gs = m1 + m2; const int g = l >> 3; int rank = 0;
#pragma unroll
            for (int gg = 0; gg < 8; ++gg) { const float og = readlane_f(gs, gg * 8); rank += (og > gs || (og == gs && gg < g)) ? 1 : 0; }
            const bool sel = rank < 4;
            unsigned cv[4];
#pragma unroll
            for (int k = 0; k < 4; ++k) cv[k] = sel ? fkey(bs[k]) : 0u;
            float sum = 0.f, mysc = 0.f; int myexp = 0;
#pragma unroll
            for (int r = 0; r < TOPK; ++r) {
                unsigned bvk = cv[0]; int bk = 0;
#pragma unroll
                for (int k = 1; k < 4; ++k) if (cv[k] > bvk) { bvk = cv[k]; bk = k; }
                const float bsc = bk == 0 ? sc[0] : bk == 1 ? sc[1] : bk == 2 ? sc[2] : sc[3];
                unsigned m = bvk;
                m = umax_(m, dpp_u<0xB1>(m)); m = umax_(m, dpp_u<0x4E>(m)); m = umax_(m, dpp_u<0x124>(m)); m = umax_(m, dpp_u<0x128>(m));
                const unsigned M = umax_(umax_((unsigned)__builtin_amdgcn_readlane((int)m, 0), (unsigned)__builtin_amdgcn_readlane((int)m, 16)),
                                         umax_((unsigned)__builtin_amdgcn_readlane((int)m, 32), (unsigned)__builtin_amdgcn_readlane((int)m, 48)));
                const unsigned long long bal = __ballot(bvk == M);
                const int L = __builtin_ctzll(bal);
                const int kL = __builtin_amdgcn_readlane(bk, L);
                const float se = readlane_f(bsc, L);
                const int e = 4 * L + kL;
                if (l == L) {
#pragma unroll
                    for (int k = 0; k < 4; ++k) if (k == bk) cv[k] = 0u; }
                sum += se; if (l == r) { myexp = e; mysc = se; }
            }
            if (l < TOPK) { ROUTE[(size_t)tok * TOPK + l] = (v2u){(unsigned)myexp, __float_as_uint(mysc * rcpf_(sum) * 2.5f)}; (void)__hip_atomic_fetch_add(hist + myexp, 1u, __ATOMIC_RELAXED, __HIP_MEMORY_SCOPE_WORKGROUP); }
            lg = lgn;
        }
        __syncthreads();
        if (F.tid < 256) HIST[blk * 256 + F.tid] = (int)hist[F.tid];
        __syncthreads();
    }
}
DI void phase_lists(const Frame& F) {
    const v2u* ROUTE = (const v2u*)(F.ws + WS_ROUTE); const int* HIST = (const int*)(F.ws + WS_HIST);
    unsigned* cnt = (unsigned*)(F.ws + WS_CTL) + CW_CNT; v2u* LIST = (v2u*)(F.ws + WS_LIST);
    LAS int* part = (LAS int*)F.lds;
    LAS int* lbase = part + 1024; LAS unsigned* lcnt = (LAS unsigned*)(lbase + 256); LAS int* ltot = lbase + 512; LAS int* lts = lbase + 768;
    int* INV = (int*)(F.ws + WS_INV);
    for (int blk = F.bx; blk < NTOK / 128; blk += F.G) {
        const int e = F.tid & 255, hf = F.tid >> 8;
        int below = 0, all = 0;
#pragma unroll 8
        for (int q = 0; q < 128; ++q) { const int row = hf * 128 + q; const int v = HIST[row * 256 + e]; all += v; below += (row < blk) ? v : 0; }
        part[hf * 512 + e] = below; part[hf * 512 + 256 + e] = all;
        __syncthreads();
        if (F.tid < 256) { lbase[e] = part[e] + part[512 + e]; lcnt[e] = 0u; const int tot = part[256 + e] + part[768 + e]; ltot[e] = tot; if (blk == 0) cnt[e] = (unsigned)tot; }
        __syncthreads();
        if (F.tid == 0) { int s2 = 0; for (int q = 0; q < 256; ++q) { lts[q] = s2; s2 += (ltot[q] + 255) >> 8; } }
        __syncthreads();
#pragma unroll
        for (int q = 0; q < 2; ++q) { const int a = F.tid + q * NTHR; const unsigned tk = (unsigned)(blk * 128 * TOPK + a);
            const v2u rt = ROUTE[tk]; const unsigned pos = (unsigned)lbase[rt.x] + __hip_atomic_fetch_add(lcnt + rt.x, 1u, __ATOMIC_RELAXED, __HIP_MEMORY_SCOPE_WORKGROUP);
            LIST[(size_t)rt.x * LISTCAP + pos] = (v2u){tk, rt.y}; INV[tk] = lts[rt.x] * 256 + (int)pos; }
        __syncthreads();
    }
}

template <bool GATHER> DI void moe_setup(const Frame& F, int ncol, int& nunits, int& nfull) {
    LAS int* ts = (LAS int*)(F.lds + LDS_TS); LAS int* cl = (LAS int*)(F.lds + LDS_CNT); LAS int* ut = (LAS int*)(F.lds + LDS_UT); LAS int* idx = (LAS int*)(F.lds + LDS_IDX);
    const unsigned* cnt = (const unsigned*)(F.ws + WS_CTL) + CW_CNT;
    if (F.tid < 256) cl[F.tid] = (int)__hip_atomic_load(cnt + F.tid, __ATOMIC_RELAXED, __HIP_MEMORY_SCOPE_AGENT);
    __syncthreads();
    if (F.tid == 0) { int s = 0; for (int e = 0; e < 256; ++e) { ts[e] = s; s += (cl[e] + 255) >> 8; } ts[256] = s; }
    __syncthreads();
    const int Te = ts[256], T = Te + NTOK / 256;
    const int Fr = T / F.G, R = T - Fr * F.G, LU = R * ncol;
    const int nleft = (LU > F.vcu) ? (LU - F.vcu + F.G - 1) / F.G : 0;
    nfull = Fr * ncol; nunits = nfull + nleft;
    const v2u* LIST = (const v2u*)(F.ws + WS_LIST);
    for (int j = 0; j < Fr + nleft && j < 10; ++j) {
        int rt, pnl = 0;
        if (j < Fr) rt = j * F.G + F.vcu; else { const int lu = (j - Fr) * F.G + F.vcu; rt = Fr * F.G + lu / ncol; pnl = lu % ncol; }
        int e, pm, nrows;
        if (rt >= Te) { e = 256; pm = rt - Te; nrows = 256; }
        else { int lo = 0, hi = 256; while (hi - lo > 1) { const int mid = (lo + hi) >> 1; if (ts[mid] <= rt) lo = mid; else hi = mid; }
            e = lo; pm = rt - ts[lo]; const int rem = cl[lo] - pm * 256; nrows = rem < 256 ? rem : 256; }
        if (F.tid == 0) *(LAS v4u*)(ut + 4 * j) = (v4u){(unsigned)e, (unsigned)pm, (unsigned)rt, (unsigned)nrows | ((unsigned)pnl << 16)};
        if (F.tid < 256) { const int r = F.tid;
            if (GATHER) idx[j * 256 + r] = (e == 256) ? pm * 256 + r : (r < nrows ? (int)(LIST[(size_t)e * LISTCAP + pm * 256 + r].x >> 3) : 0);
            else ((LAS float*)idx)[j * 256 + r] = (e == 256) ? 1.0f : (r < nrows ? __uint_as_float(LIST[(size_t)e * LISTCAP + pm * 256 + r].y) : 0.0f); } }
    __syncthreads();
}

DI void phase_combine(const Frame& F, int mode) {
    const float* MOD = (const float*)(F.ws + WS_MOD);
    const unsigned char* YE = F.ws + WS_YE; const int* INV = (const int*)(F.ws + WS_INV);
    int Te = 0; if (mode == 0) { const unsigned* cnt = (const unsigned*)(F.ws + WS_CTL) + CW_CNT; int t4 = 0;
#pragma unroll
        for (int q = 0; q < 4; ++q) t4 += (int)((cnt[F.lane + 64 * q] + 255u) >> 8);
#pragma unroll
        for (int o = 1; o < 64; o <<= 1) t4 += __shfl_xor(t4, o);
        Te = __builtin_amdgcn_readfirstlane(t4); }
    const int gw = F.bx * NWAVES + F.wave, NGW = F.G * NWAVES;
    const float* nf = F.in[I_NFIN];
    const int c = 16 * F.lane;
    for (int m = gw; m < NTOK; m += NGW) {
        const int b = m >> 11;
        float s[16];
#pragma unroll
        for (int q = 0; q < 16; ++q) s[q] = 0.f;
        const bf16* xsrc = (const bf16*)(F.ws + WS_X1);
        if (mode == 0) {
#pragma unroll
            for (int k = 0; k < 9; ++k) { const int row = (k < 8) ? INV[m * TOPK + k] : Te * 256 + m; const v4u w = *(const v4u*)(YE + (size_t)row * D + c);
                const unsigned ww[4] = {w.x, w.y, w.z, w.w};
#pragma unroll
                for (int q = 0; q < 4; ++q) { const f32x2 lo = __builtin_amdgcn_cvt_pk_f32_fp8((int)ww[q], false), hi = __builtin_amdgcn_cvt_pk_f32_fp8((int)ww[q], true);
                    s[4 * q] += lo.x; s[4 * q + 1] += lo.y; s[4 * q + 2] += hi.x; s[4 * q + 3] += hi.y; } } }
        float x2[16]; float ss = 0.f;
#pragma unroll
        for (int q = 0; q < 4; ++q) { const v2u xt = *(const v2u*)(xsrc + (size_t)m * D + c + 4 * q); const f32x4 xa = {bflo(xt.x), bfhi(xt.x), bflo(xt.y), bfhi(xt.y)}, ga = *(const f32x4*)(MOD + b * 6144 + 5120 + c + 4 * q);
#pragma unroll
            for (int j = 0; j < 4; ++j) { const float v = xa[j] + ga[j] * (s[4 * q + j] * 0.015625f); x2[4 * q + j] = v; ss += v * v; } }
        const float rs = rsqrtf(wave_sum(ss) * (1.0f / D) + EPS);
#pragma unroll
        for (int q = 0; q < 4; ++q) { const f32x4 na = *(const f32x4*)(nf + c + 4 * q);
            f32x4 oa = {x2[4 * q] * rs * na.x, x2[4 * q + 1] * rs * na.y, x2[4 * q + 2] * rs * na.z, x2[4 * q + 3] * rs * na.w};
            *(f32x4*)(F.out + (size_t)m * D + c + 4 * q) = oa; }
    }
}

constexpr int NPHASE = 14;
__global__ void __launch_bounds__(NTHR, 2) fwd_kernel(Args args) {
    extern __shared__ __attribute__((aligned(16))) unsigned char lds_raw[];
    Frame F;
    F.lds = (LAS unsigned char*)lds_raw;
    F.tid = threadIdx.x; F.lane = F.tid & 63; F.wave = __builtin_amdgcn_readfirstlane(F.tid >> 6);
    F.G = gridDim.x; F.bx = blockIdx.x; F.vcu = (F.G % 8 == 0) ? (F.bx % 8) * (F.G / 8) + F.bx / 8 : F.bx;
    F.in = args.in; F.out = args.out; F.ws = args.ws;
    volatile LAS unsigned* MISC = (volatile LAS unsigned*)(F.lds + LDS_MISC);
    if (F.tid < 16) MISC[F.tid] = 0u;
    __syncthreads();
    XcdBarrier bar; bar.bar = (unsigned*)(F.ws + WS_CTL) + CW_BAR; bar.x = 0; bar.st = nullptr;
#if !PER_PHASE_LAUNCH
    bar = xcd_barrier_post((unsigned*)(F.ws + WS_CTL) + CW_BAR, MISC + 8);
#define GRID_BAR() xcd_barrier(bar)
#else
#define GRID_BAR() do {} while (0)
#endif
    const int lo = args.ph_lo, hi = args.ph_hi;
#ifndef PH_MASK
#define PH_MASK 0xFFFF
#endif
#define IN(k) (((PH_MASK >> (k)) & 1) && lo <= (k) && (k) < hi)
#ifndef PROBE_PH
#define PROBE_PH -1
#endif
#ifndef PROBE_MULT
#define PROBE_MULT 4
#endif
    volatile LAS unsigned long long* PRT = (volatile LAS unsigned long long*)(F.lds + LDS_MISC);
    if (PROBE_PH == 0 && F.wave == 0) PRT[0] = __builtin_amdgcn_s_memrealtime();
#define SEAM(k) do { if (IN(k) && IN((k) + 1)) GRID_BAR(); \
        if (PROBE_PH >= 0 && F.wave == 0) { if ((k) == PROBE_PH - 1) PRT[0] = __builtin_amdgcn_s_memrealtime(); if ((k) == PROBE_PH) PRT[1] = __builtin_amdgcn_s_memrealtime(); } } while (0)
#ifndef REPEAT_MASK
#define REPEAT_MASK 0
#endif
#define REPS(k) (1 + ((REPEAT_MASK >> (k)) & 1))
    unsigned char* ws = F.ws;

    if (IN(0)) _Pragma("unroll 1") for (int rep = 0; rep < REPS(0); ++rep) { if (rep) GRID_BAR(); phase_prologue(F); } SEAM(0);
    if (IN(1)) _Pragma("unroll 1") for (int rep = 0; rep < REPS(1); ++rep) { if (rep) GRID_BAR(); phase_norm_rows(F, 0); } SEAM(1);
    if (IN(2)) _Pragma("unroll 1") for (int rep = 0; rep < REPS(2); ++rep) { if (rep) GRID_BAR();
        pg8::DenseOrder S; S.init(ws + WS_HX, ws + WS_WIN, MTOT, INC, D, F.G, F.bx);
        pg8::EpiInProj E{(bf16*)(ws + WS_P), (const float*)(ws + WS_TAB)};
        pg8::gemm_phase(F.lds, D, S, E, F.wave);
    } SEAM(2);
    if (IN(3)) _Pragma("unroll 1") for (int rep = 0; rep < REPS(3); ++rep) { if (rep) GRID_BAR(); phase_lru_pass1(F); } SEAM(3);
    if (IN(4)) _Pragma("unroll 1") for (int rep = 0; rep < REPS(4); ++rep) { if (rep) GRID_BAR(); phase_lru_carry(F);
        if (F.bx < NB * 4 * 2) hgrn_chain2(F, F.bx);
        convert_experts(F, 0, 0); } SEAM(4);
    if (IN(5)) _Pragma("unroll 1") for (int rep = 0; rep < REPS(5); ++rep) { if (rep) GRID_BAR(); phase_lru_pass2(F); phase_y2(F); } SEAM(5);
    if (IN(6)) _Pragma("unroll 1") for (int rep = 0; rep < REPS(6); ++rep) { if (rep) GRID_BAR();
        pg8::DenseOrder S; S.init(ws + WS_YL, ws + WS_WOUT, NTOK, D, D, F.G, F.bx);
        pg8::EpiResid E{F.in[I_X], (const float*)(ws + WS_MOD), (bf16*)(ws + WS_X1)};
        pg8::gemm_phase(F.lds, D, S, E, F.wave);
    } SEAM(6);
#if DBG_STOP == 1
    if (IN(7)) _Pragma("unroll 1") for (int rep = 0; rep < REPS(7); ++rep) { if (rep) GRID_BAR(); phase_combine(F, 1); }
#else
    if (IN(7)) _Pragma("unroll 1") for (int rep = 0; rep < REPS(7); ++rep) { if (rep) GRID_BAR(); phase_norm_rows(F, 1); } SEAM(7);
    if (IN(8)) _Pragma("unroll 1") for (int rep = 0; rep < REPS(8); ++rep) { if (rep) GRID_BAR();
        pg8::DenseOrder S; S.init(ws + WS_HX2, ws + WS_WR, NTOK, NE, D, F.G, F.bx);
        pg8::EpiF32 E{(float*)(ws + WS_LOGIT), NE};
        pg8::gemm_phase(F.lds, D, S, E, F.wave);
    } SEAM(8);
    if (IN(9)) _Pragma("unroll 1") for (int rep = 0; rep < REPS(9); ++rep) { if (rep) GRID_BAR(); phase_route(F); } SEAM(9);
    if (IN(10)) _Pragma("unroll 1") for (int rep = 0; rep < REPS(10); ++rep) { if (rep) GRID_BAR(); phase_lists(F); } SEAM(10);
    if (IN(11)) _Pragma("unroll 1") for (int rep = 0; rep < REPS(11); ++rep) { if (rep) GRID_BAR();
        int total, nfull; moe_setup<true>(F, 2, total, nfull);
        pg8::MoeOrder<true> S; S.A = (const char*)(ws + WS_HX2F); S.Bt = (const char*)(ws + WS_EW13); S.BtS = (const char*)(ws + WS_SW13); S.K = D / 2; S.ncol = 2; S.estride = (size_t)512 * 1024;
        S.ut = (const LAS int*)(F.lds + LDS_UT); S.idx = (const LAS int*)(F.lds + LDS_IDX); S.nunits = total; S.nfull = nfull;
        pg8::EpiSwiGLU8 E{ws + WS_ACT};
        pg8::gemm_phase<pg8::EpiSwiGLU8, pg8::MoeOrder<true>, false, true>(F.lds, D / 2, S, E, F.wave);
    } SEAM(11);
    if (IN(12)) _Pragma("unroll 1") for (int rep = 0; rep < REPS(12); ++rep) { if (rep) GRID_BAR();
        int total, nfull; moe_setup<false>(F, 4, total, nfull);
        pg8::MoeOrder<false> S; S.A = (const char*)(ws + WS_ACT); S.Bt = (const char*)(ws + WS_EW2); S.BtS = (const char*)(ws + WS_SW2); S.K = DE / 2; S.ncol = 4; S.estride = (size_t)1024 * 256;
        S.ut = (const LAS int*)(F.lds + LDS_UT); S.idx = (const LAS int*)(F.lds + LDS_IDX); S.nunits = total; S.nfull = nfull;
        pg8::EpiScatter E{ws + WS_YE, (const LAS float*)(F.lds + LDS_IDX), 0.5f};
#if defined(PROBE_GEMM)
        pg8::GProf gp{0ull, 0ull, 0ull};
        pg8::gemm_phase<pg8::EpiScatter, pg8::MoeOrder<false>, true, true>(F.lds, DE / 2, S, E, F.wave, &gp);
        if (F.wave == 0) { PRT[0] = 0ull; PRT[1] = (PROBE_GEMM == 0) ? gp.t_loop : (PROBE_GEMM == 1) ? gp.t_epi : gp.t_next; }
#else
        pg8::gemm_phase<pg8::EpiScatter, pg8::MoeOrder<false>, false, true>(F.lds, DE / 2, S, E, F.wave);
#endif
    } SEAM(12);
    if (IN(13)) _Pragma("unroll 1") for (int rep = 0; rep < REPS(13); ++rep) { if (rep) GRID_BAR(); phase_combine(F, 0); }
#endif
#if defined(PROBE_GEMM)
    if (F.bx == 0 && F.wave == 0) {
#else
    if (PROBE_PH >= 0 && F.bx == 0 && F.wave == 0) {
#endif
        const unsigned long long te = __builtin_amdgcn_s_memrealtime(); if (PROBE_PH == NPHASE - 1) PRT[1] = te;
        const unsigned long long target = (unsigned long long)PROBE_MULT * (PRT[1] - PRT[0]);
        while (__builtin_amdgcn_s_memrealtime() - te < target) __builtin_amdgcn_s_sleep(20);
    }
}

extern "C" void kernel_launch(void* const* d_in, const int* in_sizes, int n_in, void* d_out, int out_size, void* d_ws, size_t ws_size, hipStream_t stream) {
    static int grid = 0;
    if (grid == 0) {
        if (n_in != 26 || in_sizes[0] != NTOK * D || out_size != NTOK * D || ws_size < WS_END) { fprintf(stderr, "kernel_launch: unexpected shapes (n_in %d, ws %zu)\n", n_in, ws_size); grid = -1; return; }
        int dev = 0, cus = 0, per_cu = 0;
        if (hipGetDevice(&dev) != hipSuccess || hipDeviceGetAttribute(&cus, hipDeviceAttributeMultiprocessorCount, dev) != hipSuccess) { grid = -1; return; }
        if (hipFuncSetAttribute((const void*)fwd_kernel, hipFuncAttributeMaxDynamicSharedMemorySize, LDS_BYTES) != hipSuccess) { fprintf(stderr, "kernel_launch: hipFuncSetAttribute failed\n"); grid = -1; return; }
        if (hipOccupancyMaxActiveBlocksPerMultiprocessor(&per_cu, (const void*)fwd_kernel, NTHR, LDS_BYTES) != hipSuccess || per_cu < 1) { fprintf(stderr, "kernel_launch: occupancy query says %d\n", per_cu); }
        (void)hipGetLastError();
        grid = cus;
        if (grid < 128) { fprintf(stderr, "kernel_launch: needs >= 128 CUs (HGRN2 chains run one per workgroup)\n"); grid = -1; return; }
    }
    if (grid < 0) return;
    hipMemsetAsync((char*)d_ws + WS_CTL, 0, CTL_ZERO_BYTES, stream);
    Args a{};
    for (int i = 0; i < 26; ++i) a.in[i] = (const float*)d_in[i];
    a.out = (float*)d_out; a.ws = (unsigned char*)d_ws;
#if PER_PHASE_LAUNCH
    for (int p = 0; p < NPHASE; ++p) { a.ph_lo = p; a.ph_hi = p + 1; hipLaunchKernelGGL(fwd_kernel, dim3(grid), dim3(NTHR), LDS_BYTES, stream, a); }
#else
    a.ph_lo = 0; a.ph_hi = NPHASE;
    hipLaunchKernelGGL(fwd_kernel, dim3(grid), dim3(NTHR), LDS_BYTES, stream, a);
#endif
}
```

```cpp
#include <hip/hip_runtime.h>
#include <cstdio>
#include <cstdint>

#ifndef PER_PHASE_LAUNCH
#define PER_PHASE_LAUNCH 0
#endif
#ifndef DBG_STOP
#define DBG_STOP 0
#endif

#define GAS __attribute__((address_space(1)))
#define LAS __attribute__((address_space(3)))
#define DI __device__ __forceinline__
typedef unsigned short bf16;
typedef unsigned v4u __attribute__((ext_vector_type(4)));
typedef unsigned v2u __attribute__((ext_vector_type(2)));
typedef float f32x4 __attribute__((ext_vector_type(4)));
typedef float f32x2 __attribute__((ext_vector_type(2)));
typedef short bf16x8 __attribute__((ext_vector_type(8)));
typedef __bf16 bfv2 __attribute__((ext_vector_type(2)));

constexpr int D = 1024, NB = 16, SEQ = 2048, CTXL = 256;
constexpr int NTOK = NB * SEQ;
constexpr int NCTX = NB * CTXL;
constexpr int MTOT = NTOK + NCTX;
constexpr int INC = 3584;
constexpr int NE = 256, TOPK = 8, DE = 256;
constexpr int LISTCAP = 32768;
constexpr float EPS = 1e-6f;
constexpr int NWAVES = 8, NTHR = 512;
constexpr int NSEQT = 36;

constexpr size_t MiB = 1u << 20;
constexpr size_t WS_CTL = 0, CTL_ZERO_BYTES = 1 * MiB;
constexpr size_t WS_MOD = 1 * MiB;
constexpr size_t WS_TAB = 2 * MiB;
constexpr size_t WS_WGT = 2 * MiB + 65536;
constexpr size_t WS_WIN = 3 * MiB;
constexpr size_t WS_WOUT = 10 * MiB;
constexpr size_t WS_WR = 12 * MiB;
constexpr size_t WS_SW13 = 12 * MiB + 512 * 1024;
constexpr size_t WS_SW2 = 13 * MiB + 512 * 1024;
constexpr size_t WS_DUMP = 2 * MiB + 16384;
constexpr size_t WS_SUMA = 14 * MiB;
constexpr size_t WS_SUMH = WS_SUMA + 2359296;
constexpr size_t WS_CIN = WS_SUMH + 2359296;
constexpr size_t WS_ROUTE = 21 * MiB;
constexpr size_t WS_HIST = 23 * MiB;
constexpr size_t WS_EW13 = 32 * MiB;
constexpr size_t WS_EW2 = 288 * MiB;
constexpr size_t WS_X1 = 416 * MiB;
constexpr size_t WS_HX2 = 544 * MiB;
constexpr size_t WS_LOGIT = 608 * MiB;
constexpr size_t WS_LIST = 1620 * MiB;
constexpr size_t WS_LHS = 674 * MiB, WS_LPF = 706 * MiB, WS_LPB = 738 * MiB;
constexpr size_t WS_ACT = 674 * MiB;
constexpr size_t WS_YS = 850 * MiB;
constexpr size_t WS_P = 914 * MiB;
constexpr size_t WS_HX = 1166 * MiB;
constexpr size_t WS_OF = 1238 * MiB;
constexpr size_t WS_OB = 1270 * MiB;
constexpr size_t WS_YL = 1302 * MiB;
constexpr size_t WS_YE = 914 * MiB;
constexpr size_t WS_INV = 24 * MiB;
constexpr size_t WS_HX2F = 1684 * MiB;
constexpr size_t WS_END = 1716 * MiB;
constexpr int CW_BAR = 4096;
constexpr int CW_CNT = 16384;
constexpr int CW_CONVQ = 20480;
constexpr int CW_LRUDONE = 20544;

constexpr int RING_BYTES = 131072;
constexpr int LDS_TS = RING_BYTES;
constexpr int LDS_CNT = LDS_TS + 1088;
constexpr int LDS_UT = LDS_CNT + 1024;
constexpr int LDS_IDX = LDS_UT + 192;
constexpr int LDS_MISC = LDS_IDX + 10 * 1024;
constexpr int LDS_BYTES = 155648;
static_assert(LDS_MISC + 64 <= LDS_BYTES, "lds map");

DI unsigned pk2(float lo, float hi) { f32x2 v = {lo, hi}; bfv2 b = __builtin_convertvector(v, bfv2); return __builtin_bit_cast(unsigned, b); }
DI float clamp448(float x) { return __builtin_amdgcn_fmed3f(x, -448.0f, 448.0f); }
DI unsigned pk4_f8(float a, float b, float c, float d) {
    int w = __builtin_amdgcn_cvt_pk_fp8_f32(clamp448(a), clamp448(b), 0, false); w = __builtin_amdgcn_cvt_pk_fp8_f32(clamp448(c), clamp448(d), w, true); return (unsigned)w; }
DI float bflo(unsigned w) { return __uint_as_float(w << 16); }
DI float bfhi(unsigned w) { return __uint_as_float(w & 0xffff0000u); }
DI float bf2f(bf16 h) { return __uint_as_float(((unsigned)h) << 16); }
DI bf16 f2bf(float f) { return (bf16)(pk2(f, 0.f) & 0xffffu); }
DI float rcpf_(float x) { return __builtin_amdgcn_rcpf(x); }
DI float ex2f_(float x) { return __builtin_amdgcn_exp2f(x); }
DI float expf_(float x) { return __builtin_amdgcn_exp2f(x * 1.4426950408889634f); }
DI float logf_(float x) { return __builtin_amdgcn_logf(x) * 0.6931471805599453f; }
DI float sigm(float x) { return rcpf_(1.0f + expf_(-x)); }
DI float wave_sum(float v) {
#pragma unroll
    for (int o = 1; o < 64; o <<= 1) v += __shfl_xor(v, o);
    return v;
}
#define LDS_WAIT() asm volatile("s_waitcnt lgkmcnt(0)" ::: "memory")
template <int CTRL> DI float dpp_mov_f(float v) { return __uint_as_float((unsigned)__builtin_amdgcn_update_dpp(0, (int)__float_as_uint(v), CTRL, 0xf, 0xf, true)); }
DI float wave_sum_fast(float v) {
    v += dpp_mov_f<0xB1>(v); v += dpp_mov_f<0x4E>(v); v += dpp_mov_f<0x124>(v); v += dpp_mov_f<0x128>(v);
    const unsigned u = __float_as_uint(v);
    return (__uint_as_float((unsigned)__builtin_amdgcn_readlane((int)u, 0)) + __uint_as_float((unsigned)__builtin_amdgcn_readlane((int)u, 16)))
         + (__uint_as_float((unsigned)__builtin_amdgcn_readlane((int)u, 32)) + __uint_as_float((unsigned)__builtin_amdgcn_readlane((int)u, 48)));
}

#define XB_TMO      128
#define XB_XCNT(j)  (256  + 64 * (j))
#define XB_XSUB(j)  (1280 + 64 * (j))
#define XB_XGEN(j)  (2304 + 64 * (j))
#define XB_TOP      3328
#define XB_TOPGEN   3392
#define XCD_BAR_WORDS 3456
#define XB_SPIN_CAP (1u << 18)
__device__ __forceinline__ unsigned xb_ld(unsigned* p)              { return __hip_atomic_load(p, __ATOMIC_RELAXED, __HIP_MEMORY_SCOPE_AGENT); }
__device__ __forceinline__ unsigned xb_add(unsigned* p, unsigned v) { return __hip_atomic_fetch_add(p, v, __ATOMIC_RELAXED, __HIP_MEMORY_SCOPE_AGENT); }
__device__ __forceinline__ unsigned xb_xcc_id() { return (unsigned)__builtin_amdgcn_s_getreg((3 << 11) | 20) & 0xFu; }
#define XB_SPIN(cond, bar) do { unsigned _sp = 0; while (cond) { __builtin_amdgcn_s_sleep(1); \
    if ((++_sp & 255u) == 0u) { if (xb_ld(&(bar)[XB_TMO])) break; if (_sp > XB_SPIN_CAP) { atomicAdd(&(bar)[XB_TMO], 1u); break; } } } } while (0)
struct XcdBarrier { unsigned* bar; unsigned x; volatile LAS unsigned* st; };
__device__ __forceinline__ XcdBarrier xcd_barrier_post(unsigned* bar, volatile LAS unsigned* st) {
    XcdBarrier b; b.bar = bar; b.x = xb_xcc_id(); b.st = st;
    if (threadIdx.x == 0) (void)xb_add(&bar[XB_XCNT(b.x)], 1u);
    return b;
}
__device__ __forceinline__ void xcd_barrier_complete(unsigned* bar, unsigned x, unsigned& nloc, unsigned& nx) {
    const unsigned G = gridDim.x * gridDim.y * gridDim.z;
    unsigned sum, cnt, mine, sp = 0u;
    for (;;) {
        sum = 0u; cnt = 0u; mine = 0u;
#pragma unroll
        for (unsigned j = 0; j < 16; ++j) { const unsigned c = xb_ld(&bar[XB_XCNT(j)]); sum += c; cnt += (c > 0u) ? 1u : 0u; mine = (j == x) ? c : mine; }
        if (sum == G) break;
        __builtin_amdgcn_s_sleep(1);
        if ((++sp & 255u) == 0u) { if (xb_ld(&bar[XB_TMO])) break; if (sp > XB_SPIN_CAP) { atomicAdd(&bar[XB_TMO], 1u); break; } }
    }
    nloc = mine > 0u ? mine : 1u; nx = cnt > 0u ? cnt : 1u;
}
__device__ __forceinline__ void xcd_barrier(const XcdBarrier& b) {
    asm volatile("s_waitcnt vmcnt(0)" ::: "memory");
    __syncthreads();
    if (threadIdx.x == 0) {
        unsigned* bar = b.bar;
        __builtin_amdgcn_s_waitcnt(0);
        unsigned nloc = b.st[0], nx = b.st[1];
        if (nloc == 0u) { xcd_barrier_complete(bar, b.x, nloc, nx); b.st[0] = nloc; b.st[1] = nx; }
        const unsigned old = xb_add(&bar[XB_XSUB(b.x)], 1u);
        const unsigned gen = old / nloc;
        if (old + 1u == (gen + 1u) * nloc) {
            __builtin_amdgcn_fence(__ATOMIC_RELEASE, "agent");
            asm volatile("s_waitcnt vmcnt(0)" ::: "memory");
            const unsigned og = xb_add(&bar[XB_TOP], 1u);
            const unsigned tg = og / nx;
            if (og + 1u == (tg + 1u) * nx) xb_add(&bar[XB_TOPGEN], 1u);
            else XB_SPIN(xb_ld(&bar[XB_TOPGEN]) == tg, bar);
            __builtin_amdgcn_fence(__ATOMIC_ACQUIRE, "agent");
            xb_add(&bar[XB_XGEN(b.x)], 1u);
            asm volatile("s_waitcnt vmcnt(0)" ::: "memory");
        } else {
            XB_SPIN(xb_ld(&bar[XB_XGEN(b.x)]) == gen, bar);
            __builtin_amdgcn_fence(__ATOMIC_ACQUIRE, "agent");
            asm volatile("s_waitcnt vmcnt(0)" ::: "memory");
        }
    }
    __syncthreads();
}

namespace pg8 {
constexpr int BM = 256, BK = 64, HALF = 128, HTB = HALF * BK * 2, NXCD = 8, WGM = 8;
DI int lds_byte(int r, int c) { const int st = (r >> 4) * 2 + (c >> 5), rr = r & 15, cc = c & 31, ob = rr * 64 + cc * 2; return st * 1024 + (ob ^ (((ob >> 9) & 1) << 5)); }
DI void stage_rc(int b, int& R, int& C) { const int st = b / 1024, sb = b % 1024, swz = sb ^ (((sb >> 9) & 1) << 5); R = (st >> 1) * 16 + swz / 64; C = (st & 1) * 32 + (swz % 64) / 2; }
DI int perm32(int rho) { const int n = rho >> 4, i = rho & 15; return 8 * (i >> 2) + 4 * n + (i & 3); }

struct Unit { int pm, pn, e, rt, ord, nrows; };

struct DenseOrder {
    const char* A; const char* Bt; int K, nM, nN, nwg, G, c;
    DI void init(const void* A_, const void* Bt_, int M, int N, int K_, int G_, int c_) { A = (const char*)A_; Bt = (const char*)Bt_; K = K_; nM = M / BM; nN = N / BM; nwg = nM * nN; G = G_; c = c_; }
    DI bool next(int i, Unit& u) const {
        const long L = (long)i * G + c; if (L >= nwg) return false;
        int wgid = (int)L; { const int q = nwg / NXCD, r = nwg % NXCD, xcd = wgid % NXCD, off = wgid / NXCD; wgid = (xcd < r ? xcd * (q + 1) : r * (q + 1) + (xcd - r) * q) + off; }
        const int nig = WGM * nN, gid = wgid / nig, fm = gid * WGM, gsz = (nM - fm) < WGM ? (nM - fm) : WGM;
        u.pm = fm + ((wgid % nig) % gsz); u.pn = (wgid % nig) / gsz; u.e = 0; u.rt = u.pm; u.ord = i; u.nrows = 256; return true;
    }
    DI const char* a_base(const Unit& u) const { return A + (size_t)u.pm * BM * K * 2; }
    DI const char* b_base(const Unit& u) const { return Bt + (size_t)u.pn * BM * K * 2; }
    static constexpr bool GATHER_A = false;
    DI void a_offs(const Unit&, int tid, unsigned (&v)[2][2]) const {
#pragma unroll
        for (int i = 0; i < 2; ++i) { int R, C; stage_rc(tid * 16 + i * 8192, R, C);
#pragma unroll
            for (int h = 0; h < 2; ++h) v[h][i] = (unsigned)((h * HALF + R) * K + C) * 2u; }
    }
};

template <bool GATHER> struct MoeOrder {
    const char* A; const char* Bt; const char* BtS; int K, ncol; size_t estride;
    const LAS int* ut; const LAS int* idx; int nunits, nfull;
    static constexpr bool GATHER_A = GATHER;
    DI bool next(int i, Unit& u) const {
        if (i >= nunits) return false;
        int j, pn;
        if (i < nfull) { j = i / ncol; pn = i - j * ncol; } else { j = nfull / ncol + (i - nfull); pn = -1; }
        const v4u t = *(const LAS v4u*)(ut + 4 * j);
        u.ord = j; u.e = (int)t.x; u.pm = (int)t.y; u.rt = (int)t.z; u.nrows = (int)(t.w & 0xffffu); u.pn = pn >= 0 ? pn : (int)(t.w >> 16);
        return true;
    }
    DI const char* a_base(const Unit& u) const { return GATHER ? A : A + (size_t)u.rt * BM * K * 2; }
    DI const char* b_base(const Unit& u) const { return (u.e < 256 ? Bt + (size_t)u.e * estride : BtS) + (size_t)u.pn * BM * K * 2; }
    DI void a_offs(const Unit& u, int tid, unsigned (&v)[2][2]) const {
#pragma unroll
        for (int i = 0; i < 2; ++i) { int R, C; stage_rc(tid * 16 + i * 8192, R, C);
#pragma unroll
            for (int h = 0; h < 2; ++h) {
                if (GATHER) v[h][i] = ((unsigned)idx[u.ord * 256 + h * HALF + R] * (unsigned)K + (unsigned)C) * 2u;
                else v[h][i] = (unsigned)((h * HALF + R) * K + C) * 2u; } }
    }
};

struct GProf { unsigned long long t_loop, t_epi, t_next; };
typedef int v8i __attribute__((ext_vector_type(8)));
template <class Epi, class Sched, bool PROF = false, bool F8 = false>
__device__ __forceinline__ void gemm_phase(LAS unsigned char* lds, const int K, const Sched& S, const Epi& E, const int wid  , GProf* prof = nullptr) {
    unsigned long long pt0 = 0, pt1 = 0, pt2 = 0, pt3 = 0;
    const int tid = threadIdx.x, lane = tid & 63, wr = wid >> 2, wc = wid & 3, fr = lane & 15, fq = lane >> 4;
    const int nt = K / BK;
    unsigned voffBh[2][2];
#pragma unroll
    for (int i = 0; i < 2; ++i) { int R, C; stage_rc(tid * 16 + i * 8192, R, C);
#pragma unroll
        for (int h = 0; h < 2; ++h) { int Rb;
            if (Epi::PERM == 2) Rb = 64 * ((R >> 5) & 3) + 16 * ((R >> 2) & 3) + 8 * h + 4 * ((R >> 4) & 1) + (R & 3);
            else Rb = HALF * h + (Epi::PERM == 1 ? ((R & ~31) + perm32(R & 31)) : R);
            voffBh[h][i] = (unsigned)(Rb * K + C) * 2u; } }
    const size_t kstep = (size_t)(BK * 2);
    const size_t hstep = (size_t)HALF * K * 2;
    const unsigned ldsw = (unsigned)wid * 1024u;
    const int aoff = F8 ? lds_byte(wr * 64 + fr, fq * 16) : lds_byte(wr * 64 + fr, fq * 8), boff = F8 ? lds_byte(wc * 32 + fr, fq * 16) : lds_byte(wc * 32 + fr, fq * 8);
#define PG8_SA(b, h) (((b) * 2 + (h)) * HTB)
#define PG8_SB(b, h) ((4 + (b) * 2 + (h)) * HTB)
#define PG8_STAGE(bufoff, gbase, voff) do { _Pragma("unroll") for (int _i = 0; _i < 2; ++_i) \
        __builtin_amdgcn_global_load_lds((const unsigned*)((const char*)(gbase) + (voff)[_i]), (LAS unsigned*)(lds + (bufoff) + ldsw + _i * 8192), 16, 0, 0); } while (0)
#define PG8_LD8(dst, off) do { const v4u _lo = *(const LAS v4u*)(lds + (off)), _hi = *(const LAS v4u*)(lds + (off) + 16); \
        dst[0] = (int)_lo.x; dst[1] = (int)_lo.y; dst[2] = (int)_lo.z; dst[3] = (int)_lo.w; dst[4] = (int)_hi.x; dst[5] = (int)_hi.y; dst[6] = (int)_hi.z; dst[7] = (int)_hi.w; } while (0)
#define PG8_LDA(dst, b, h) do { if (F8) { _Pragma("unroll") for (int m = 0; m < 4; ++m) PG8_LD8(dst##8[m], PG8_SA(b, h) + aoff + m * 2048); } \
        else { _Pragma("unroll") for (int m = 0; m < 4; ++m) _Pragma("unroll") for (int k = 0; k < 2; ++k) dst[m][k] = *(const LAS bf16x8*)(lds + PG8_SA(b, h) + aoff + m * 2048 + k * 1024); } } while (0)
#define PG8_LDB(dst, b, h) do { if (F8) { _Pragma("unroll") for (int n = 0; n < 2; ++n) PG8_LD8(dst##8[n], PG8_SB(b, h) + boff + n * 2048); } \
        else { _Pragma("unroll") for (int n = 0; n < 2; ++n) _Pragma("unroll") for (int k = 0; k < 2; ++k) dst[n][k] = *(const LAS bf16x8*)(lds + PG8_SB(b, h) + boff + n * 2048 + k * 1024); } } while (0)
#define PG8_MMA(ai, bj, At, Bt) do { __builtin_amdgcn_s_setprio(1); \
        if (F8) { _Pragma("unroll") for (int m = 0; m < 4; ++m) _Pragma("unroll") for (int n = 0; n < 2; ++n) \
            asm volatile("v_mfma_scale_f32_16x16x128_f8f6f4 %0, %1, %2, %0, %3, %3 op_sel_hi:[0,0,0]" : "+v"(acc[ai][bj][m][n]) : "v"(Bt##8[n]), "v"(At##8[m]), "v"(sc127)); } \
        else { _Pragma("unroll") for (int m = 0; m < 4; ++m) _Pragma("unroll") for (int n = 0; n < 2; ++n) _Pragma("unroll") for (int k = 0; k < 2; ++k) \
            acc[ai][bj][m][n] = __builtin_amdgcn_mfma_f32_16x16x32_bf16(Bt[n][k], At[m][k], acc[ai][bj][m][n], 0, 0, 0); } \
        __builtin_amdgcn_s_setprio(0); } while (0)
#define PG8_WAIT_V(n) asm volatile("s_waitcnt vmcnt(" #n ")" ::: "memory")
#define PG8_WAIT_L(n) asm volatile("s_waitcnt lgkmcnt(" #n ")" ::: "memory")
#define PG8_BAR __builtin_amdgcn_s_barrier()
#define PG8_SCHED __builtin_amdgcn_sched_barrier(0)
    Unit cur, nxt; int ui = 0;
    if (!S.next(0, cur)) return;
    f32x4 acc[2][2][4][2];
#pragma unroll
    for (int a = 0; a < 2; ++a)
#pragma unroll
        for (int b = 0; b < 2; ++b)
#pragma unroll
            for (int m = 0; m < 4; ++m)
#pragma unroll
                for (int n = 0; n < 2; ++n) acc[a][b][m][n] = (f32x4){0.f, 0.f, 0.f, 0.f};
    bf16x8 At[4][2], B0[2][2], B1[2][2];
    v8i At8[4], B08[2], B18[2];
    int sc127 = 127; asm volatile("" : "+v"(sc127));
    unsigned vC[2][2], vN[2][2];
    S.a_offs(cur, tid, vC);
    const char* cA = S.a_base(cur); const char* cB = S.b_base(cur);
    PG8_STAGE(PG8_SB(0, 0), cB, voffBh[0]); PG8_STAGE(PG8_SA(0, 0), cA, vC[0]); PG8_STAGE(PG8_SB(0, 1), cB, voffBh[1]); PG8_STAGE(PG8_SA(0, 1), cA, vC[1]);
    if (wr == 1) PG8_BAR;
    PG8_WAIT_V(4); PG8_BAR;
    PG8_STAGE(PG8_SB(1, 0), cB + kstep, voffBh[0]); PG8_STAGE(PG8_SA(1, 0), cA + kstep, vC[0]); PG8_STAGE(PG8_SB(1, 1), cB + kstep, voffBh[1]);
    PG8_WAIT_V(6); PG8_BAR;
    for (;;) {
        if (PROF) pt0 = __builtin_amdgcn_s_memrealtime();
        const bool has_next = S.next(ui + 1, nxt);
        const char* nA = has_next ? S.a_base(nxt) : cA; const char* nB = has_next ? S.b_base(nxt) : cB;
        if (Sched::GATHER_A) { if (has_next) S.a_offs(nxt, tid, vN); else { vN[0][0] = vC[0][0]; vN[0][1] = vC[0][1]; vN[1][0] = vC[1][0]; vN[1][1] = vC[1][1]; } }
        if (PROF) pt1 = __builtin_amdgcn_s_memrealtime();
#pragma unroll 1
        for (int t = 0; t < nt; t += 2) {
            const bool last = (t == nt - 2);
            const char* a1 = cA + (size_t)(t + 1) * kstep;
            const char* a2 = last ? nA : cA + (size_t)(t + 2) * kstep; const char* b2 = last ? nB : cB + (size_t)(t + 2) * kstep;
            const char* a3 = a2 + kstep; const char* b3 = b2 + kstep;
            unsigned x0[2], x1[2];
            if (Sched::GATHER_A) { x0[0] = last ? vN[0][0] : vC[0][0]; x0[1] = last ? vN[0][1] : vC[0][1]; x1[0] = last ? vN[1][0] : vC[1][0]; x1[1] = last ? vN[1][1] : vC[1][1]; }
            else { x0[0] = vC[0][0]; x0[1] = vC[0][1]; x1[0] = vC[1][0]; x1[1] = vC[1][1]; }
            PG8_LDB(B0, 0, 0); PG8_SCHED; PG8_LDA(At, 0, 0); PG8_STAGE(PG8_SA(1, 1), a1, vC[1]);
            PG8_WAIT_L(8); PG8_BAR; PG8_WAIT_L(0); PG8_MMA(0, 0, At, B0); PG8_BAR; PG8_SCHED;
            PG8_LDB(B1, 0, 1); PG8_STAGE(PG8_SB(0, 0), b2, voffBh[0]);
            PG8_BAR; PG8_WAIT_L(0); PG8_MMA(0, 1, At, B1); PG8_BAR;
            PG8_LDA(At, 0, 1); PG8_STAGE(PG8_SA(0, 0), a2, x0);
            PG8_BAR; PG8_WAIT_L(0); PG8_MMA(1, 0, At, B0); PG8_BAR; PG8_SCHED;
            PG8_STAGE(PG8_SB(0, 1), b2, voffBh[1]);
            PG8_WAIT_V(6); PG8_BAR; PG8_MMA(1, 1, At, B1); PG8_BAR;
            PG8_LDB(B0, 1, 0); PG8_SCHED; PG8_LDA(At, 1, 0); PG8_STAGE(PG8_SA(0, 1), a2, x1);
            PG8_WAIT_L(8); PG8_BAR; PG8_WAIT_L(0); PG8_MMA(0, 0, At, B0); PG8_BAR; PG8_SCHED;
            PG8_LDB(B1, 1, 1); PG8_STAGE(PG8_SB(1, 0), b3, voffBh[0]);
            PG8_BAR; PG8_WAIT_L(0); PG8_MMA(0, 1, At, B1); PG8_BAR;
            PG8_LDA(At, 1, 1); PG8_STAGE(PG8_SA(1, 0), a3, x0);
            PG8_BAR; PG8_WAIT_L(0); PG8_MMA(1, 0, At, B0); PG8_BAR; PG8_SCHED;
            PG8_STAGE(PG8_SB(1, 1), b3, voffBh[1]);
            PG8_WAIT_V(6); PG8_BAR; PG8_MMA(1, 1, At, B1); PG8_BAR;
        }
        if (PROF) pt2 = __builtin_amdgcn_s_memrealtime();
        if (F8) asm volatile("s_nop 15\n\ts_nop 15" ::: "memory");
        E(acc, cur, wr, wc, fr, fq);
        if (PROF) { asm volatile("s_waitcnt vmcnt(0)" ::: "memory"); pt3 = __builtin_amdgcn_s_memrealtime(); prof->t_next += pt1 - pt0; prof->t_loop += pt2 - pt1; prof->t_epi += pt3 - pt2; }
        if (!has_next) break;
#pragma unroll
        for (int a = 0; a < 2; ++a)
#pragma unroll
            for (int b = 0; b < 2; ++b)
#pragma unroll
                for (int m = 0; m < 4; ++m)
#pragma unroll
                    for (int n = 0; n < 2; ++n) acc[a][b][m][n] = (f32x4){0.f, 0.f, 0.f, 0.f};
        cur = nxt; cA = nA; cB = nB; ++ui;
        if (Sched::GATHER_A) { vC[0][0] = vN[0][0]; vC[0][1] = vN[0][1]; vC[1][0] = vN[1][0]; vC[1][1] = vN[1][1]; }
    }
    PG8_WAIT_V(0);
    if (wr == 0) PG8_BAR;
    PG8_BAR;
#undef PG8_SA
#undef PG8_SB
#undef PG8_STAGE
#undef PG8_LD8
#undef PG8_LDA
#undef PG8_LDB
#undef PG8_MMA
#undef PG8_WAIT_V
#undef PG8_WAIT_L
#undef PG8_BAR
#undef PG8_SCHED
}

DI float gelu_tanh(float x) { const float u = 1.5957691216f * (x + 0.044715f * x * x * x); return x * rcpf_(1.0f + expf_(-u)); }
DI float silu_f(float x) { return x * rcpf_(1.0f + expf_(-x)); }

struct EpiInProj {
    static constexpr int PERM = 1;
    bf16* P; const float* LB;
    DI void operator()(const f32x4 (&acc)[2][2][4][2], const Unit& u, int wr, int wc, int fr, int fq) const {
        const int row0 = u.pm * BM + wr * 64 + fr, col0 = u.pn * BM + wc * 32 + 8 * fq;
        const int pn = u.pn;
        const int kind = (pn == 2 || pn == 3) ? 1 : (pn >= 8 && pn < 12) ? 2 : (pn >= 12) ? 3 : 0;
        f32x4 lbv[2][2];
        { const int dir = (pn >> 1) & 1; const int cc = (pn & 1) * 256 + wc * 32 + 8 * fq;
#pragma unroll
            for (int bj = 0; bj < 2; ++bj)
#pragma unroll
                for (int n = 0; n < 2; ++n) lbv[bj][n] = *(const f32x4*)(LB + dir * 512 + cc + bj * HALF + 4 * n);
            asm volatile("" :: "v"(lbv[0][0]), "v"(lbv[0][1]), "v"(lbv[1][0]), "v"(lbv[1][1])); }
#pragma unroll
        for (int ai = 0; ai < 2; ++ai)
#pragma unroll
            for (int m = 0; m < 4; ++m) { bf16* rowp = P + (size_t)(row0 + ai * HALF + m * 16) * INC + col0;
#pragma unroll
                for (int bj = 0; bj < 2; ++bj) { f32x4 v0 = acc[ai][bj][m][0], v1 = acc[ai][bj][m][1];
                    if (kind == 1) {
#pragma unroll
                        for (int j = 0; j < 4; ++j) { v0[j] = gelu_tanh(v0[j]); v1[j] = gelu_tanh(v1[j]); } }
                    else if (kind == 2) {
#pragma unroll
                        for (int j = 0; j < 4; ++j) { const float l0 = lbv[bj][0][j], l1 = lbv[bj][1][j];
                            v0[j] = logf_(l0 + (1.0f - l0) * sigm(v0[j])); v1[j] = logf_(l1 + (1.0f - l1) * sigm(v1[j])); } }
                    else if (kind == 3) {
#pragma unroll
                        for (int j = 0; j < 4; ++j) { v0[j] = silu_f(v0[j]); v1[j] = silu_f(v1[j]); } }
                    v4u w; w.x = pk2(v0[0], v0[1]); w.y = pk2(v0[2], v0[3]); w.z = pk2(v1[0], v1[1]); w.w = pk2(v1[2], v1[3]);
                    *(v4u*)(rowp + bj * HALF) = w; } }
    }
};
struct EpiResid {
    static constexpr int PERM = 1;
    const float* x; const float* mod; bf16* X1;
    DI void operator()(const f32x4 (&acc)[2][2][4][2], const Unit& u, int wr, int wc, int fr, int fq) const {
        const int row0 = u.pm * BM + wr * 64 + fr, col0 = u.pn * BM + wc * 32 + 8 * fq;
        const int b = (u.pm * BM) >> 11;
        f32x4 gv[2][2];
#pragma unroll
        for (int bj = 0; bj < 2; ++bj)
#pragma unroll
            for (int n = 0; n < 2; ++n) gv[bj][n] = *(const f32x4*)(mod + (size_t)b * 6144 + 2048 + col0 + bj * HALF + 4 * n);
        asm volatile("" :: "v"(gv[0][0]), "v"(gv[0][1]), "v"(gv[1][0]), "v"(gv[1][1]));
#pragma unroll
        for (int ai = 0; ai < 2; ++ai)
#pragma unroll
            for (int m = 0; m < 4; ++m) { const size_t off = (size_t)(row0 + ai * HALF + m * 16) * D + col0;
#pragma unroll
                for (int bj = 0; bj < 2; ++bj) { const f32x4 x0 = *(const f32x4*)(x + off + bj * HALF), x1 = *(const f32x4*)(x + off + bj * HALF + 4);
                    const f32x4 v0 = x0 + gv[bj][0] * acc[ai][bj][m][0], v1 = x1 + gv[bj][1] * acc[ai][bj][m][1];
                    v4u w; w.x = pk2(v0[0], v0[1]); w.y = pk2(v0[2], v0[3]); w.z = pk2(v1[0], v1[1]); w.w = pk2(v1[2], v1[3]);
                    *(v4u*)(X1 + off + bj * HALF) = w; } }
    }
};
struct EpiF32 {
    static constexpr int PERM = 0;
    float* C; int ldc;
    DI void operator()(const f32x4 (&acc)[2][2][4][2], const Unit& u, int wr, int wc, int fr, int fq) const {
        const int row0 = u.pm * BM + wr * 64 + fr, col0 = u.pn * BM + wc * 32 + 4 * fq;
#pragma unroll
        for (int ai = 0; ai < 2; ++ai)
#pragma unroll
            for (int m = 0; m < 4; ++m) { float* rowp = C + (size_t)(row0 + ai * HALF + m * 16) * ldc + col0;
#pragma unroll
                for (int bj = 0; bj < 2; ++bj)
#pragma unroll
                    for (int n = 0; n < 2; ++n) *(f32x4*)(rowp + bj * HALF + n * 16) = acc[ai][bj][m][n]; }
    }
};
struct EpiSwiGLU8 {
    static constexpr int PERM = 1;
    unsigned char* ACT;
    DI void operator()(const f32x4 (&acc)[2][2][4][2], const Unit& u, int wr, int wc, int fr, int fq) const {
        const unsigned off0 = ((unsigned)u.rt * 256u + (unsigned)(wr * 64 + fr)) * (unsigned)DE + (unsigned)(u.pn * 128 + wc * 32 + 8 * fq);
#pragma unroll
        for (int ai = 0; ai < 2; ++ai)
#pragma unroll
            for (int m = 0; m < 4; ++m) {
                f32x4 a0 = acc[ai][0][m][0] * 0.03125f, a1 = acc[ai][0][m][1] * 0.03125f; const f32x4 g0 = acc[ai][1][m][0] * 0.25f, g1 = acc[ai][1][m][1] * 0.25f;
#pragma unroll
                for (int j = 0; j < 4; ++j) { a0[j] = silu_f(a0[j]) * g0[j]; a1[j] = silu_f(a1[j]) * g1[j]; }
                v2u w; w.x = pk4_f8(a0[0], a0[1], a0[2], a0[3]); w.y = pk4_f8(a1[0], a1[1], a1[2], a1[3]);
                *(v2u*)(ACT + (off0 + (unsigned)((ai * HALF + m * 16) * DE))) = w; }
    }
};
struct EpiSwiGLU {
    static constexpr int PERM = 1;
    bf16* ACT;
    DI void operator()(const f32x4 (&acc)[2][2][4][2], const Unit& u, int wr, int wc, int fr, int fq) const {
        const int row0 = wr * 64 + fr, col0 = u.pn * 128 + wc * 32 + 8 * fq;
        bf16* base = ACT + (size_t)u.rt * 256 * DE;
#pragma unroll
        for (int ai = 0; ai < 2; ++ai)
#pragma unroll
            for (int m = 0; m < 4; ++m) { bf16* rowp = base + (size_t)(row0 + ai * HALF + m * 16) * DE + col0;
                f32x4 a0 = acc[ai][0][m][0], a1 = acc[ai][0][m][1]; const f32x4 g0 = acc[ai][1][m][0], g1 = acc[ai][1][m][1];
#pragma unroll
                for (int j = 0; j < 4; ++j) { a0[j] = silu_f(a0[j]) * g0[j]; a1[j] = silu_f(a1[j]) * g1[j]; }
                v4u w; w.x = pk2(a0[0], a0[1]); w.y = pk2(a0[2], a0[3]); w.z = pk2(a1[0], a1[1]); w.w = pk2(a1[2], a1[3]);
                *(v4u*)rowp = w; }
    }
};
struct EpiScatter {
    static constexpr int PERM = 2;
    unsigned char* YE; const LAS float* gate; float oscale;
    DI void operator()(const f32x4 (&acc)[2][2][4][2], const Unit& u, int wr, int wc, int fr, int fq) const {
        const unsigned col0 = (unsigned)(u.pn * BM + wc * 64 + 16 * fq);
        float gt[2][4];
#pragma unroll
        for (int ai = 0; ai < 2; ++ai)
#pragma unroll
            for (int m = 0; m < 4; ++m) gt[ai][m] = gate[u.ord * 256 + ai * HALF + wr * 64 + m * 16 + fr] * oscale;
#pragma unroll
        for (int ai = 0; ai < 2; ++ai)
#pragma unroll
            for (int m = 0; m < 4; ++m) { const int r = ai * HALF + wr * 64 + m * 16 + fr; const float g = gt[ai][m];
                const unsigned row = (r < u.nrows) ? (unsigned)u.rt * 256u + (unsigned)r : 360448u;
                const f32x4 v0 = acc[ai][0][m][0] * g, v1 = acc[ai][0][m][1] * g, v2 = acc[ai][1][m][0] * g, v3 = acc[ai][1][m][1] * g;
                v4u w; w.x = pk4_f8(v0[0], v0[1], v0[2], v0[3]); w.y = pk4_f8(v1[0], v1[1], v1[2], v1[3]); w.z = pk4_f8(v2[0], v2[1], v2[2], v2[3]); w.w = pk4_f8(v3[0], v3[1], v3[2], v3[3]);
                *(v4u*)(YE + (row * (unsigned)D + col0)) = w; }
    }
};
}

struct Args { const float* in[26]; float* out; unsigned char* ws; int ph_lo, ph_hi; };
enum { I_X = 0, I_C, I_CTX, I_CCTX, I_ADAW, I_ADAB, I_NMIX, I_NFFN, I_NFIN, I_WIN, I_WOUT, I_CONVW, I_CONVB, I_WA, I_BA, I_WX, I_BX, I_LAM,
       I_LBL, I_HNORM, I_RW, I_RB, I_EW13, I_EW2, I_SW13, I_SW2 };

struct Frame {
    LAS unsigned char* lds;
    int tid, lane, wave, G, vcu, bx;
    const float* const* in; float* out; unsigned char* ws;
};

DI void transpose_item(const float* W, int ldw, bf16* WT, int ldo, int k0, int n0, int orow0, LAS float* scr, int lane) {
    const int sub = lane >> 3, c4 = (lane & 7) * 4;
    f32x4 v[8];
#pragma unroll
    for (int i = 0; i < 8; ++i) v[i] = __builtin_nontemporal_load((const f32x4*)(W + (size_t)(k0 + 8 * i + sub) * ldw + n0 + c4));
#pragma unroll
    for (int i = 0; i < 8; ++i) { LAS float* d = scr + (8 * i + sub) * 33 + c4; d[0] = v[i].x; d[1] = v[i].y; d[2] = v[i].z; d[3] = v[i].w; }
    LDS_WAIT(); asm volatile("" ::: "memory");
    const int c = lane & 7;
#pragma unroll
    for (int j = 0; j < 4; ++j) { const int n = (lane >> 3) + 8 * j; const LAS float* s = scr + (8 * c) * 33 + n;
        v4u o; o.x = pk2(s[0 * 33], s[1 * 33]); o.y = pk2(s[2 * 33], s[3 * 33]); o.z = pk2(s[4 * 33], s[5 * 33]); o.w = pk2(s[6 * 33], s[7 * 33]);
        *(v4u*)(WT + (size_t)(orow0 + n) * ldo + k0 + 8 * c) = o; }
    LDS_WAIT(); asm volatile("" ::: "memory");
}
DI void transpose_item8(const float* W, int ldw, unsigned char* WT, int ldo, int k0, int n0, int orow0, float scale, LAS float* scr, int lane) {
    const int sub = lane >> 3, c4 = (lane & 7) * 4;
    f32x4 v[16];
#pragma unroll
    for (int i = 0; i < 16; ++i) v[i] = __builtin_nontemporal_load((const f32x4*)(W + (size_t)(k0 + 8 * i + sub) * ldw + n0 + c4));
#pragma unroll
    for (int i = 0; i < 16; ++i) { LAS float* d = scr + (8 * i + sub) * 33 + c4; d[0] = v[i].x; d[1] = v[i].y; d[2] = v[i].z; d[3] = v[i].w; }
    LDS_WAIT(); asm volatile("" ::: "memory");
    const int c = lane & 7;
#pragma unroll
    for (int j = 0; j < 4; ++j) { const int n = (lane >> 3) + 8 * j; const LAS float* sp = scr + (16 * c) * 33 + n;
        v4u o; o.x = pk4_f8(sp[0] * scale, sp[33] * scale, sp[66] * scale, sp[99] * scale); o.y = pk4_f8(sp[132] * scale, sp[165] * scale, sp[198] * scale, sp[231] * scale);
        o.z = pk4_f8(sp[264] * scale, sp[297] * scale, sp[330] * scale, sp[363] * scale); o.w = pk4_f8(sp[396] * scale, sp[429] * scale, sp[462] * scale, sp[495] * scale);
        *(v4u*)(WT + (size_t)(orow0 + n) * ldo + k0 + 16 * c) = o; }
    LDS_WAIT(); asm volatile("" ::: "memory");
}
DI int w13_row(int n) { const int half = n >> 8, idx = n & 255; return 256 * (idx >> 7) + 128 * half + (idx & 127); }

DI void phase_prologue(const Frame& F) {
    const float* const* in = F.in; unsigned char* ws = F.ws;
    {
        LAS float* sc = (LAS float*)F.lds;
        LAS float* red = (LAS float*)(F.lds + 17 * 1024 * 4);
        for (int i = F.tid; i < 17 * 1024; i += NTHR) { const int r = i >> 10, k = i & 1023; const float v = (r < 16) ? in[I_C][r * 1024 + k] : in[I_CCTX][k]; sc[i] = v / (1.0f + __expf(-v)); }
        __syncthreads();
        const float* aw = in[I_ADAW]; float* MOD = (float*)(ws + WS_MOD);
        for (int cg = F.bx; cg < 256; cg += F.G) {
            const int kg = F.tid >> 5, cl = F.tid & 31, col = cg * 24 + cl;
            float a[17];
#pragma unroll
            for (int r = 0; r < 17; ++r) a[r] = 0.f;
            if (cl < 24) {
#pragma unroll 1
                for (int k8 = 0; k8 < 64; k8 += 16) { float w[16];
#pragma unroll
                    for (int q = 0; q < 16; ++q) w[q] = aw[(size_t)(kg * 64 + k8 + q) * 6144 + col];
#pragma unroll
                    for (int q = 0; q < 16; ++q) { const int k = kg * 64 + k8 + q;
#pragma unroll
                        for (int r = 0; r < 17; ++r) a[r] += sc[r * 1024 + k] * w[q]; } }
#pragma unroll
                for (int r = 0; r < 17; ++r) red[(kg * 17 + r) * 24 + cl] = a[r];
            }
            __syncthreads();
            if (F.tid < 17 * 24) { const int r = F.tid / 24, c2 = F.tid % 24; float s = 0.f;
                for (int g = 0; g < 16; ++g) s += red[(g * 17 + r) * 24 + c2];
                MOD[r * 6144 + cg * 24 + c2] = s + in[I_ADAB][cg * 24 + c2]; }
            __syncthreads();
        }
    }
    {
        float* LB = (float*)(ws + WS_TAB); float* SP = LB + 1024;
        const int gt = F.bx * NTHR + F.tid, GT = F.G * NTHR;
        for (int i = gt; i < 1024; i += GT) { const int d = i >> 9, c = i & 511;
            const float l0 = in[I_LBL][(d * 2 + 0) * 512 + c], l1 = in[I_LBL][(d * 2 + 1) * 512 + c];
            LB[i] = 1.0f / (1.0f + expf(l1 - l0));
            SP[i] = log1pf(expf(-in[I_LAM][i])); }
        bf16* WGT = (bf16*)(ws + WS_WGT);
        for (int i = gt; i < 2 * 2 * 8 * 64 * 64; i += GT) { const int ii = i & 63, j = (i >> 6) & 63, h = (i >> 12) & 7, g = (i >> 15) & 1, d = i >> 16;
            const float* src = g ? in[I_WX] : in[I_WA];
            WGT[i] = f2bf(src[((size_t)(d * 8 + h) * 64 + ii) * 64 + j]); }
    }
    {
        LAS float* scr = (LAS float*)(F.lds + F.wave * 16896);
        const int gw = F.vcu * NWAVES + F.wave, NGW = F.G * NWAVES;
        constexpr int IT_WIN = 16 * 112, IT_WOUT = 16 * 32, IT_WR = 16 * 8, IT_SW13 = 8 * 16, IT_SW2 = 2 * 32;
        LAS float* scr8 = (LAS float*)(F.lds + F.wave * 16896);
        constexpr int NIT = IT_WIN + IT_WOUT + IT_WR + IT_SW13 + IT_SW2;
        for (int it = gw; it < NIT; it += NGW) {
            int r = it;
            if (r < IT_WIN) { const int kb = r / 112, nb = r % 112; transpose_item(in[I_WIN], INC, (bf16*)(ws + WS_WIN), 1024, kb * 64, nb * 32, nb * 32, scr, F.lane); continue; } r -= IT_WIN;
            if (r < IT_WOUT) { const int kb = r / 32, nb = r % 32; transpose_item(in[I_WOUT], 1024, (bf16*)(ws + WS_WOUT), 1024, kb * 64, nb * 32, nb * 32, scr, F.lane); continue; } r -= IT_WOUT;
            if (r < IT_WR) { const int kb = r / 8, nb = r % 8; transpose_item(in[I_RW], 256, (bf16*)(ws + WS_WR), 1024, kb * 64, nb * 32, nb * 32, scr, F.lane); continue; } r -= IT_WR;
            if (r < IT_SW13) { const int kb = r / 16, nb = r % 16; transpose_item8(in[I_SW13], 512, ws + WS_SW13, 1024, kb * 128, nb * 32, w13_row(nb * 32), 32.0f, scr8, F.lane); continue; } r -= IT_SW13;
            { const int kb = r / 32, nb = r % 32; transpose_item8(in[I_SW2], 1024, ws + WS_SW2, 256, kb * 128, nb * 32, nb * 32, 16.0f, scr8, F.lane); }
        }
    }
}
constexpr int CV_STR = 129, CV_B = 128 * CV_STR * 4, CV_STR2 = 144;
static_assert(CV_B + 128 * CV_STR2 <= LDS_MISC, "convert lds");
DI void convert_experts(const Frame& F, const unsigned* stop_ctr, unsigned stop_val) {
    const float* const* in = F.in; unsigned char* ws = F.ws;
    LAS float* scr = (LAS float*)F.lds; LAS unsigned char* img = F.lds + CV_B;
    volatile LAS int* slot = (volatile LAS int*)(F.lds + LDS_MISC + 48);
    unsigned* qhead = (unsigned*)(ws + WS_CTL) + CW_CONVQ;
    constexpr int NB13 = 256 * 32, NB2 = 256 * 16;
    auto decode = [&](int blk, const float*& src, int& ldw, unsigned char*& dst, int& ldo, int& orow0, float& scale) {
        if (blk < NB13) { const int e = blk >> 5, q = blk & 31, nb = q >> 3, kb = q & 7;
            src = in[I_EW13] + (size_t)e * 1024 * 512 + (size_t)(kb * 128) * 512 + nb * 128; ldw = 512;
            dst = ws + WS_EW13 + (size_t)e * 512 * 1024 + kb * 128; ldo = 1024; orow0 = w13_row(nb * 128); scale = 32.0f; }
        else { const int r = blk - NB13, e = r >> 4, q = r & 15, nb = q >> 1, kb = q & 1;
            src = in[I_EW2] + (size_t)e * 256 * 1024 + (size_t)(kb * 128) * 1024 + nb * 128; ldw = 1024;
            dst = ws + WS_EW2 + (size_t)e * 1024 * 256 + kb * 128; ldo = 256; orow0 = nb * 128; scale = 16.0f; } };
    auto claim = [&]() -> int { __syncthreads();
        if (F.tid == 0) { int v = 0x7fffffff;
            if (!stop_ctr || __hip_atomic_load(stop_ctr, __ATOMIC_RELAXED, __HIP_MEMORY_SCOPE_AGENT) < stop_val) v = (int)__hip_atomic_fetch_add(qhead, 1u, __ATOMIC_RELAXED, __HIP_MEMORY_SCOPE_AGENT);
            slot[0] = v; }
        __syncthreads(); return slot[0]; };
    f32x4 v[8];
    int blk = claim();
    const float* src = nullptr; int ldw = 0; unsigned char* dst = nullptr; int ldo = 0, orow0 = 0; float scale = 1.f;
    if (blk < NB13 + NB2) { decode(blk, src, ldw, dst, ldo, orow0, scale);
#pragma unroll
        for (int i = 0; i < 8; ++i) { const int p = F.tid + NTHR * i; v[i] = *(const f32x4*)(src + (size_t)(p >> 5) * ldw + (p & 31) * 4); } }
    while (blk < NB13 + NB2) {
#pragma unroll
        for (int i = 0; i < 8; ++i) { const int p = F.tid + NTHR * i; LAS float* d = scr + (p >> 5) * CV_STR + (p & 31) * 4; d[0] = v[i].x; d[1] = v[i].y; d[2] = v[i].z; d[3] = v[i].w; }
        unsigned char* cdst = dst; const int cldo = ldo, corow0 = orow0; const float cscale = scale;
        blk = claim();
        if (blk < NB13 + NB2) { decode(blk, src, ldw, dst, ldo, orow0, scale);
#pragma unroll
            for (int i = 0; i < 8; ++i) { const int p = F.tid + NTHR * i; v[i] = *(const f32x4*)(src + (size_t)(p >> 5) * ldw + (p & 31) * 4); } }
#pragma unroll
        for (int i = 0; i < 2; ++i) { const int n = F.tid & 127, kc = ((F.tid >> 7) + 4 * i) * 16;
            const LAS float* sp = scr + kc * CV_STR + n;
            v4u o; o.x = pk4_f8(sp[0] * cscale, sp[CV_STR] * cscale, sp[2 * CV_STR] * cscale, sp[3 * CV_STR] * cscale);
            o.y = pk4_f8(sp[4 * CV_STR] * cscale, sp[5 * CV_STR] * cscale, sp[6 * CV_STR] * cscale, sp[7 * CV_STR] * cscale);
            o.z = pk4_f8(sp[8 * CV_STR] * cscale, sp[9 * CV_STR] * cscale, sp[10 * CV_STR] * cscale, sp[11 * CV_STR] * cscale);
            o.w = pk4_f8(sp[12 * CV_STR] * cscale, sp[13 * CV_STR] * cscale, sp[14 * CV_STR] * cscale, sp[15 * CV_STR] * cscale);
            *(LAS v4u*)(img + n * CV_STR2 + kc) = o; }
        __syncthreads();
#pragma unroll
        for (int i = 0; i < 2; ++i) { const int p = F.tid + NTHR * i; const int n = p >> 3, pc = (p & 7) * 16;
            *(v4u*)(cdst + (size_t)(corow0 + n) * cldo + pc) = *(const LAS v4u*)(img + n * CV_STR2 + pc); }
    }
    __syncthreads();
}

DI void phase_norm_rows(const Frame& F, int mode) {
    const float* MOD = (const float*)(F.ws + WS_MOD);
    const int gw = F.bx * NWAVES + F.wave, NGW = F.G * NWAVES;
    const int nrows = mode == 0 ? MTOT : NTOK;
    const float* gain = mode == 0 ? F.in[I_NMIX] : F.in[I_NFFN];
    bf16* dst = (bf16*)(F.ws + (mode == 0 ? WS_HX : WS_HX2));
    const int sh_off = mode == 0 ? 0 : 3072, sc_off = mode == 0 ? 1024 : 4096;
    const int per = (nrows + NGW - 1) / NGW, r0 = gw * per, r1 = (r0 + per < nrows) ? r0 + per : nrows;
    f32x4 gn[4];
#pragma unroll
    for (int j = 0; j < 4; ++j) gn[j] = *(const f32x4*)(gain + 4 * F.lane + 256 * j);
    auto rowsrc = [&](int m) -> const float* {
        return (m < NTOK) ? F.in[I_X] + (size_t)m * D : F.in[I_CTX] + (size_t)(m - NTOK) * D; };
    const bf16* X1b = (const bf16*)(F.ws + WS_X1);
    auto ldrow = [&](int m, f32x4 (&v)[4]) {
        if (mode == 0) {
#pragma unroll
            for (int j = 0; j < 4; ++j) v[j] = *(const f32x4*)(rowsrc(m) + 4 * F.lane + 256 * j); }
        else {
#pragma unroll
            for (int j = 0; j < 4; ++j) { const v2u t = *(const v2u*)(X1b + (size_t)m * D + 4 * F.lane + 256 * j); v[j] = (f32x4){bflo(t.x), bfhi(t.x), bflo(t.y), bfhi(t.y)}; } } };
    f32x4 va[4], vb[4], ga[4], sb4[4]; int cur_mr = -1;
#pragma unroll
    for (int j = 0; j < 4; ++j) { ga[j] = gn[j]; sb4[j] = gn[j]; }
    if (r0 < r1) { ldrow(r0, va); ldrow((r0 + 1 < r1) ? r0 + 1 : r0, vb); }
#pragma unroll 1
    for (int m = r0; m < r1; m += 2) {
        f32x4 ca[4], cb[4];
#pragma unroll
        for (int j = 0; j < 4; ++j) { ca[j] = va[j]; cb[j] = vb[j]; }
        const bool hasb = (m + 1 < r1);
        { const int na = (m + 2 < r1) ? m + 2 : m, nb = (m + 3 < r1) ? m + 3 : na; ldrow(na, va); ldrow(nb, vb); }
        float sa = 0.f, sb = 0.f;
#pragma unroll
        for (int j = 0; j < 4; ++j) { sa += (ca[j].x * ca[j].x + ca[j].y * ca[j].y) + (ca[j].z * ca[j].z + ca[j].w * ca[j].w); sb += (cb[j].x * cb[j].x + cb[j].y * cb[j].y) + (cb[j].z * cb[j].z + cb[j].w * cb[j].w); }
        const float rsa = rsqrtf(wave_sum_fast(sa) * (1.0f / D) + EPS), rsb = rsqrtf(wave_sum_fast(sb) * (1.0f / D) + EPS);
#pragma unroll
        for (int q = 0; q < 2; ++q) {
            if (q == 1 && !hasb) break;
            const int mm = m + q; const float rs = q ? rsb : rsa;
            const int mr = (mode == 0 && mm >= NTOK) ? 16 : (mm >> 11);
            if (mr != cur_mr) { cur_mr = mr;
#pragma unroll
                for (int j = 0; j < 4; ++j) { const int c = 4 * F.lane + 256 * j;
                    ga[j] = gn[j] * (*(const f32x4*)(MOD + mr * 6144 + sc_off + c) + 1.0f); sb4[j] = *(const f32x4*)(MOD + mr * 6144 + sh_off + c); } }
#pragma unroll
            for (int j = 0; j < 4; ++j) { const int c = 4 * F.lane + 256 * j;
                const f32x4 v = q ? cb[j] : ca[j];
                const f32x4 y = (v * rs) * ga[j] + sb4[j];
                v2u w; w.x = pk2(y.x, y.y); w.y = pk2(y.z, y.w);
                *(v2u*)(dst + (size_t)mm * D + c) = w;
                if (mode == 1) *(unsigned*)(F.ws + WS_HX2F + (size_t)mm * D + c) = pk4_f8(y.x, y.y, y.z, y.w); }
        }
    }
}

constexpr int LT_STR = 520;
constexpr int L_RT = 0;
constexpr int L_GT = 69888;
static_assert(L_GT + 64 * LT_STR * 2 <= LDS_MISC, "lru lds");
template <int MODE> DI void lru_tile(const Frame& F, int b, int s) {
    const bf16* P = (const bf16*)(F.ws + WS_P);
    const int h = F.wave, fr = F.lane & 15, fq = F.lane >> 4;
    int prow0, L, t0;
    if (s < 4) { prow0 = NTOK + b * CTXL + 64 * s; L = CTXL; t0 = 64 * s; } else { prow0 = b * SEQ + 64 * (s - 4); L = SEQ; t0 = 64 * (s - 4); }
    LAS bf16* RT = (LAS bf16*)(F.lds + L_RT); LAS bf16* GT = (LAS bf16*)(F.lds + L_GT);
#pragma unroll
    for (int it = 0; it < 9; ++it) { const int p = F.tid + it * NTHR;
        if (p < 67 * 64) { const int row = p >> 6, pc = p & 63, ts = t0 + row - 1;
            v4u v = {0u, 0u, 0u, 0u};
            if (ts >= 0 && ts < L) v = *(const v4u*)(P + (size_t)(prow0 + row - 1) * INC + 8 * pc);
            *(LAS v4u*)(RT + row * LT_STR + 8 * pc) = v; } }
    __syncthreads();
    bf16x8 Af[4][2];
#pragma unroll
    for (int ks = 0; ks < 2; ++ks) {
        const int c0 = 64 * h + 32 * ks + 8 * fq;
        float cw[4][8], cb[8];
#pragma unroll
        for (int k = 0; k < 4; ++k) { const f32x4 w0 = *(const f32x4*)(F.in[I_CONVW] + k * 512 + c0), w1 = *(const f32x4*)(F.in[I_CONVW] + k * 512 + c0 + 4);
            cw[k][0] = w0.x; cw[k][1] = w0.y; cw[k][2] = w0.z; cw[k][3] = w0.w; cw[k][4] = w1.x; cw[k][5] = w1.y; cw[k][6] = w1.z; cw[k][7] = w1.w; }
        { const f32x4 w0 = *(const f32x4*)(F.in[I_CONVB] + c0), w1 = *(const f32x4*)(F.in[I_CONVB] + c0 + 4);
            cb[0] = w0.x; cb[1] = w0.y; cb[2] = w0.z; cb[3] = w0.w; cb[4] = w1.x; cb[5] = w1.y; cb[6] = w1.z; cb[7] = w1.w; }
        const LAS bf16* rbase = RT + fr * LT_STR + c0;
#pragma unroll
        for (int tt = 0; tt < 4; ++tt) {
            float u[8];
#pragma unroll
            for (int j = 0; j < 8; ++j) u[j] = cb[j];
#pragma unroll
            for (int k = 0; k < 4; ++k) { const v4u r8 = *(const LAS v4u*)(rbase + (16 * tt + k) * LT_STR);
                u[0] += cw[k][0] * bflo(r8.x); u[1] += cw[k][1] * bfhi(r8.x); u[2] += cw[k][2] * bflo(r8.y); u[3] += cw[k][3] * bfhi(r8.y);
                u[4] += cw[k][4] * bflo(r8.z); u[5] += cw[k][5] * bfhi(r8.z); u[6] += cw[k][6] * bflo(r8.w); u[7] += cw[k][7] * bfhi(r8.w); }
            v4u w; w.x = pk2(u[0], u[1]); w.y = pk2(u[2], u[3]); w.z = pk2(u[4], u[5]); w.w = pk2(u[6], u[7]);
            Af[tt][ks] = __builtin_bit_cast(bf16x8, w);
        }
    }
    const bf16* WGT = (const bf16*)(F.ws + WS_WGT);
    const float* SP = (const float*)(F.ws + WS_TAB) + 1024;
    LAS bf16* HL = RT;
    LAS bf16* hlb = HL + (4 * fq) * LT_STR + 64 * h + fr;
    LAS bf16* gtb = GT + (4 * fq) * LT_STR + 64 * h + fr;
#pragma unroll 1
    for (int dir = 0; dir < 2; ++dir) {
#pragma unroll 1
        for (int nt = 0; nt < 4; ++nt) {
            const int cj = 64 * h + 16 * nt + fr;
            bf16x8 Ba[2], Bx[2], Id[2];
#pragma unroll
            for (int ks = 0; ks < 2; ++ks) {
                Ba[ks] = *(const bf16x8*)(WGT + ((size_t)((dir * 2 + 0) * 8 + h) * 64 + 16 * nt + fr) * 64 + 32 * ks + 8 * fq);
                Bx[ks] = *(const bf16x8*)(WGT + ((size_t)((dir * 2 + 1) * 8 + h) * 64 + 16 * nt + fr) * 64 + 32 * ks + 8 * fq);
#pragma unroll
                for (int jj = 0; jj < 8; ++jj) Id[ks][jj] = (32 * ks + 8 * fq + jj == 16 * nt + fr) ? (short)0x3F80 : (short)0;
            }
            const float ba = F.in[I_BA][dir * 512 + cj], bx = F.in[I_BX][dir * 512 + cj], sp = SP[dir * 512 + cj];
            float cin = 0.f, ptot = 1.f;
#pragma unroll
            for (int tti = 0; tti < 4; ++tti) {
                const int tt = dir ? 3 - tti : tti;
                const bf16x8 A0 = dir ? Af[3 - tti][0] : Af[tti][0], A1 = dir ? Af[3 - tti][1] : Af[tti][1];
                f32x4 pa = {0.f, 0.f, 0.f, 0.f}, px = {0.f, 0.f, 0.f, 0.f}, uc = {0.f, 0.f, 0.f, 0.f};
                pa = __builtin_amdgcn_mfma_f32_16x16x32_bf16(A0, Ba[0], pa, 0, 0, 0); pa = __builtin_amdgcn_mfma_f32_16x16x32_bf16(A1, Ba[1], pa, 0, 0, 0);
                px = __builtin_amdgcn_mfma_f32_16x16x32_bf16(A0, Bx[0], px, 0, 0, 0); px = __builtin_amdgcn_mfma_f32_16x16x32_bf16(A1, Bx[1], px, 0, 0, 0);
                uc = __builtin_amdgcn_mfma_f32_16x16x32_bf16(A0, Id[0], uc, 0, 0, 0); uc = __builtin_amdgcn_mfma_f32_16x16x32_bf16(A1, Id[1], uc, 0, 0, 0);
                float av[4], bv[4];
#pragma unroll
                for (int ri = 0; ri < 4; ++ri) { const float pav = dir ? pa[3 - ri] : pa[ri], pxv = dir ? px[3 - ri] : px[ri], ucv = dir ? uc[3 - ri] : uc[ri];
                    const float rg = sigm(pav + ba), ig = sigm(pxv + bx);
                    const float a = expf_(-8.0f * rg * sp); av[ri] = a; bv[ri] = __builtin_amdgcn_sqrtf(fmaxf(1.0f - a * a, 0.f)) * ig * ucv; }
                float pl = 1.f, hl = 0.f;
#pragma unroll
                for (int ri = 0; ri < 4; ++ri) { hl = av[ri] * hl + bv[ri]; pl *= av[ri]; }
                float pg[4], hg[4];
#pragma unroll
                for (int gi = 0; gi < 4; ++gi) { const int g = dir ? 3 - gi : gi; pg[gi] = __shfl(pl, fr + 16 * g); hg[gi] = __shfl(hl, fr + 16 * g); }
                const int myg = dir ? 3 - fq : fq;
                float mycin = cin, run = cin, myp = ptot, prun = ptot;
#pragma unroll
                for (int gi = 0; gi < 4; ++gi) { if (gi == myg) { mycin = run; myp = prun; } run = pg[gi] * run + hg[gi]; prun *= pg[gi]; }
                if (MODE == 1) { float hc = mycin, pc = myp;
#pragma unroll
                    for (int ri = 0; ri < 4; ++ri) { const int r = dir ? 3 - ri : ri; hc = av[ri] * hc + bv[ri]; pc *= av[ri];
                        const int o = (16 * tt + r) * LT_STR + 16 * nt;
                        hlb[o] = f2bf(dir == 0 ? hc : bf2f(hlb[o]) + hc); gtb[o] = f2bf(pc); } }
                ptot = prun;
                cin = run;
            }
            if (fq == 0) { const size_t o = ((size_t)(dir * NB + b) * NSEQT + s) * 512 + cj;
                ((float*)(F.ws + WS_SUMA))[o] = ptot; ((float*)(F.ws + WS_SUMH))[o] = cin; }
        }
        if (MODE == 1) {
            __syncthreads();
            bf16* PD = (bf16*)(F.ws + (dir ? WS_LPB : WS_LPF)); bf16* HSg = (bf16*)(F.ws + WS_LHS);
#pragma unroll
            for (int it = 0; it < 8; ++it) { const int p = F.tid + it * NTHR; const int row = p >> 6, pc = p & 63;
                *(v4u*)(PD + (size_t)(prow0 + row) * 512 + 8 * pc) = *(const LAS v4u*)(GT + row * LT_STR + 8 * pc);
                if (dir == 1) *(v4u*)(HSg + (size_t)(prow0 + row) * 512 + 8 * pc) = *(const LAS v4u*)(HL + row * LT_STR + 8 * pc); }
            __syncthreads();
        }
    }
    __syncthreads();
}
DI void phase_lru_pass1(const Frame& F) {
    unsigned* done = (unsigned*)(F.ws + WS_CTL) + CW_LRUDONE;
    const int NL = (F.G >= 256) ? 192 : F.G;
    if (F.bx < NL) {
        for (int it = F.bx; it < NB * NSEQT; it += NL) { { const int bb = it / NSEQT, ss = it % NSEQT; if (ss < 4) lru_tile<0>(F, bb, ss); else lru_tile<1>(F, bb, ss); }
            if (F.tid == 0) __hip_atomic_fetch_add(done, 1u, __ATOMIC_RELAXED, __HIP_MEMORY_SCOPE_AGENT); }
    }
    if (F.G >= 256) convert_experts(F, done, (unsigned)(NB * NSEQT));
}
DI void phase_lru_carry(const Frame& F) {
    if (F.wave != 0) return;
    const float* SA = (const float*)(F.ws + WS_SUMA); const float* SH = (const float*)(F.ws + WS_SUMH); float* CI = (float*)(F.ws + WS_CIN);
    for (int id = F.bx * 64 + F.lane; id < 2 * NB * 512; id += F.G * 64) {
        const int dir = id >> 13, b = (id >> 9) & 15, c = id & 511;
        float x = 0.f; const size_t o0 = (size_t)(dir * NB + b) * NSEQT * 512 + c;
#pragma unroll
        for (int hf = 0; hf < 2; ++hf) {
            float av[18], hv[18];
#pragma unroll
            for (int q = 0; q < 18; ++q) { const int st = 18 * hf + q, s = dir ? (st < 4 ? 3 - st : 39 - st) : st; av[q] = SA[o0 + (size_t)s * 512]; hv[q] = SH[o0 + (size_t)s * 512]; }
#pragma unroll
            for (int q = 0; q < 18; ++q) { const int st = 18 * hf + q, s = dir ? (st < 4 ? 3 - st : 39 - st) : st; CI[o0 + (size_t)s * 512] = x; x = av[q] * x + hv[q]; }
        }
    }
}

constexpr int HS = 144, SCS = 40;
constexpr int H_Q = 0, H_LF = H_Q + 32 * HS * 2, H_V = H_LF + 32 * HS * 2, H_QT = H_V + 32 * HS * 2, H_KT = H_QT + 32 * HS * 2, H_KH = H_KT + 32 * HS * 2,
              H_SC = H_KH + 32 * HS * 2, H_DEC = H_SC + 32 * SCS * 2, H_SET = H_DEC + 512;
static_assert(2 * H_SET <= RING_BYTES, "hgrn lds");
typedef short s16x4 __attribute__((ext_vector_type(4)));
DI bf16x8 tr_frag(const LAS bf16* tile, int c0, int lane) {
    const int g = lane >> 4, q = (lane & 15) >> 2, p = lane & 3;
    const LAS bf16* a = tile + (8 * g + q) * HS + c0 + 4 * p;
    const s16x4 lo = __builtin_amdgcn_ds_read_tr16_b64_v4i16((LAS s16x4*)a), hi = __builtin_amdgcn_ds_read_tr16_b64_v4i16((LAS s16x4*)(a + 4 * HS));
    bf16x8 r; r[0] = lo[0]; r[1] = lo[1]; r[2] = lo[2]; r[3] = lo[3]; r[4] = hi[0]; r[5] = hi[1]; r[6] = hi[2]; r[7] = hi[3]; return r;
}
constexpr int P_QR = 0, P_LR = P_QR + 2 * 9216, P_VR = P_LR + 2 * 9216, P_QT = P_VR + 4 * 9216, P_KT = P_QT + 2 * 9216, P_KH = P_KT + 2 * 9216, P_SC = P_KH + 2 * 9216, P_DEC = P_SC + 2 * 2560, P_END = P_DEC + 2 * 512;
static_assert(P_END <= LDS_MISC, "hgrn pipelined lds");
DI void hgrn_chain2(const Frame& F, int item) {
    const int b = item >> 3, h = (item >> 1) & 3, dir = item & 1;
    const bf16* P = (const bf16*)(F.ws + WS_P);
    bf16* O = (bf16*)(F.ws + (dir ? WS_OB : WS_OF));
    const int w = F.wave, lane = F.lane, fr = lane & 15, g = lane >> 4;
    const int li = F.tid >> 4, lp = F.tid & 15;
    auto prow = [&](int c, int i) -> size_t {
        const int ii = dir ? 31 - i : i;
        if (c < 8) { const int cc = dir ? 7 - c : c; return (size_t)NTOK + b * CTXL + 32 * cc + ii; }
        const int col = dir ? 63 - (c - 8) : (c - 8); return (size_t)b * SEQ + ii * 64 + col; };
    const size_t coff = 128 * h + 8 * lp;
    v4u rqA, rlA, rvA, rqB, rlB, rvB;
    { const bf16* rp = P + prow(0, li) * INC + coff; rqA = *(const v4u*)(rp + 1024); rvA = *(const v4u*)(rp + 1536); rlA = *(const v4u*)(rp + 2048 + 512 * dir); }
    { const bf16* rp = P + prow(1, li) * INC + coff; rqB = *(const v4u*)(rp + 1024); rvB = *(const v4u*)(rp + 1536); rlB = *(const v4u*)(rp + 2048 + 512 * dir); }
    LAS unsigned char* L = F.lds;
#define HG2_W(k, U, RQ, RL, RV) do { \
        const int i = (k) - 2, wch = (k), pch = (k) - 1; (void)i; (void)pch; \
        if (wch < 72) {   \
            *(LAS v4u*)((LAS bf16*)(L + P_QR + ((U) & 1) * 9216) + li * HS + 8 * lp) = RQ; *(LAS v4u*)((LAS bf16*)(L + P_LR + ((U) & 1) * 9216) + li * HS + 8 * lp) = RL; \
            *(LAS v4u*)((LAS bf16*)(L + P_VR + (U) * 9216) + li * HS + 8 * lp) = RV; \
            if (wch + 2 < 72) { const bf16* rp = P + prow(wch + 2, li) * INC + coff; RQ = *(const v4u*)(rp + 1024); RV = *(const v4u*)(rp + 1536); RL = *(const v4u*)(rp + 2048 + 512 * dir); } } \
    } while (0)
#define HG2_PREP(k, U) do { \
        const int i = (k) - 2, wch = (k), pch = (k) - 1; (void)i; (void)pch; \
        const int pw = w - 4; \
            if (pch >= 0 && pch < 72) {   \
                const LAS bf16* Qr = (const LAS bf16*)(L + P_QR + (((U) + 1) & 1) * 9216); const LAS bf16* LFr = (const LAS bf16*)(L + P_LR + (((U) + 1) & 1) * 9216); \
                LAS bf16* QT = (LAS bf16*)(L + P_QT + (((U) + 1) & 1) * 9216); LAS bf16* KT = (LAS bf16*)(L + P_KT + (((U) + 1) & 1) * 9216); LAS bf16* KH = (LAS bf16*)(L + P_KH + (((U) + 1) & 1) * 9216); \
                LAS float* DEC = (LAS float*)(L + P_DEC + (((U) + 1) & 1) * 512); \
                _Pragma("unroll") for (int db = 0; db < 2; ++db) { const int dblk = 16 * (2 * pw + db); \
                    const bf16x8 Al = tr_frag(LFr, dblk, lane); \
                    f32x4 Gm[2]; \
                    _Pragma("unroll") for (int it = 0; it < 2; ++it) Gm[it] = __builtin_amdgcn_mfma_f32_16x16x32_bf16(Al, Tri[it], (f32x4){0.f, 0.f, 0.f, 0.f}, 0, 0, 0); \
                    f32x4 dec; \
                    _Pragma("unroll") for (int r = 0; r < 4; ++r) dec[r] = expf_(__shfl(Gm[1][r], (lane & 48) | 15)); \
                    if (fr == 0) *(LAS f32x4*)(DEC + dblk + 4 * g) = dec; \
                    _Pragma("unroll") for (int it = 0; it < 2; ++it) { const int ii = 16 * it + fr, d0 = dblk + 4 * g; \
                        const v2u q4 = *(const LAS v2u*)(Qr + ii * HS + d0), l4 = *(const LAS v2u*)(LFr + ii * HS + d0); \
                        const float qv[4] = {bflo(q4.x), bfhi(q4.x), bflo(q4.y), bfhi(q4.y)}, lv[4] = {bflo(l4.x), bfhi(l4.x), bflo(l4.y), bfhi(l4.y)}; \
                        float qt[4], kt[4], kh[4]; \
                        _Pragma("unroll") for (int r = 0; r < 4; ++r) { const float eg = expf_(Gm[it][r]), ieg = rcpf_(eg), kk = 1.0f - expf_(lv[r]); qt[r] = qv[r] * eg; kt[r] = kk * ieg; kh[r] = kk * dec[r] * ieg; } \
                        *(LAS v2u*)(QT + ii * HS + d0) = (v2u){pk2(qt[0], qt[1]), pk2(qt[2], qt[3])}; \
                        *(LAS v2u*)(KT + ii * HS + d0) = (v2u){pk2(kt[0], kt[1]), pk2(kt[2], kt[3])}; \
                        *(LAS v2u*)(KH + ii * HS + d0) = (v2u){pk2(kh[0], kh[1]), pk2(kh[2], kh[3])}; } } } \
            if (i >= 8 && i < 72) {   \
                const LAS bf16* QT = (const LAS bf16*)(L + P_QT + ((U) & 1) * 9216); const LAS bf16* KT = (const LAS bf16*)(L + P_KT + ((U) & 1) * 9216); LAS bf16* SC = (LAS bf16*)(L + P_SC + ((U) & 1) * 2560); \
                const int it = pw >> 1, jt = pw & 1; f32x4 sc = {0.f, 0.f, 0.f, 0.f}; \
                _Pragma("unroll") for (int ks = 0; ks < 4; ++ks) { const bf16x8 ak = *(const LAS bf16x8*)(KT + (16 * jt + fr) * HS + 32 * ks + 8 * g), bq = *(const LAS bf16x8*)(QT + (16 * it + fr) * HS + 32 * ks + 8 * g); \
                    sc = __builtin_amdgcn_mfma_f32_16x16x32_bf16(ak, bq, sc, 0, 0, 0); } \
                const int ii = 16 * it + fr, j0 = 16 * jt + 4 * g; \
                *(LAS v2u*)(SC + ii * SCS + j0) = (v2u){pk2(j0 <= ii ? sc[0] : 0.f, j0 + 1 <= ii ? sc[1] : 0.f), pk2(j0 + 2 <= ii ? sc[2] : 0.f, j0 + 3 <= ii ? sc[3] : 0.f)}; } \
    } while (0)
#define HG2_CORE(k, U) do { \
        const int i = (k) - 2, wch = (k), pch = (k) - 1; (void)i; (void)pch; \
            f32x4 onew[2][2]; \
            _Pragma("unroll") for (int eb = 0; eb < 2; ++eb) { onew[eb][0] = (f32x4){0.f, 0.f, 0.f, 0.f}; onew[eb][1] = (f32x4){0.f, 0.f, 0.f, 0.f}; } \
            bf16x8 Vf[2]; _Pragma("unroll") for (int eb = 0; eb < 2; ++eb) Vf[eb] = Vprev[eb]; \
            if (i >= 0 && i < 72) {   \
                const LAS bf16* QT = (const LAS bf16*)(L + P_QT + ((U) & 1) * 9216); const LAS bf16* KH = (const LAS bf16*)(L + P_KH + ((U) & 1) * 9216); \
                const LAS float* DEC = (const LAS float*)(L + P_DEC + ((U) & 1) * 512); const LAS bf16* Vr = (const LAS bf16*)(L + P_VR + (((U) + 2) & 3) * 9216); \
                if (i >= 8) {   \
                    _Pragma("unroll") for (int ks = 0; ks < 4; ++ks) { bf16x8 Bq[2]; \
                        _Pragma("unroll") for (int it = 0; it < 2; ++it) { const v2u a0 = *(const LAS v2u*)(QT + (16 * it + fr) * HS + 32 * ks + 4 * g), a1 = *(const LAS v2u*)(QT + (16 * it + fr) * HS + 32 * ks + 16 + 4 * g); \
                            v4u bv; bv.x = a0.x; bv.y = a0.y; bv.z = a1.x; bv.w = a1.y; Bq[it] = __builtin_bit_cast(bf16x8, bv); } \
                        _Pragma("unroll") for (int eb = 0; eb < 2; ++eb) { \
                            v4u sb; sb.x = pk2(S[eb][2 * ks][0], S[eb][2 * ks][1]); sb.y = pk2(S[eb][2 * ks][2], S[eb][2 * ks][3]); sb.z = pk2(S[eb][2 * ks + 1][0], S[eb][2 * ks + 1][1]); sb.w = pk2(S[eb][2 * ks + 1][2], S[eb][2 * ks + 1][3]); \
                            const bf16x8 As = __builtin_bit_cast(bf16x8, sb); \
                            _Pragma("unroll") for (int it = 0; it < 2; ++it) onew[eb][it] = __builtin_amdgcn_mfma_f32_16x16x32_bf16(As, Bq[it], onew[eb][it], 0, 0, 0); } } } \
                  \
                _Pragma("unroll") for (int eb = 0; eb < 2; ++eb) Vf[eb] = tr_frag(Vr, 16 * (2 * w + eb), lane); \
                _Pragma("unroll") for (int t = 0; t < 8; ++t) { const f32x4 dv = *(const LAS f32x4*)(DEC + 16 * t + 4 * g); const bf16x8 Kf = tr_frag(KH, 16 * t, lane); \
                    _Pragma("unroll") for (int eb = 0; eb < 2; ++eb) S[eb][t] = __builtin_amdgcn_mfma_f32_16x16x32_bf16(Kf, Vf[eb], S[eb][t] * dv, 0, 0, 0); } } \
            if (i - 1 >= 8 && i - 1 < 72) {   \
                const LAS bf16* SC = (const LAS bf16*)(L + P_SC + (((U) + 1) & 1) * 2560); \
                const int col = dir ? 63 - (i - 9) : (i - 9); \
                _Pragma("unroll") for (int it = 0; it < 2; ++it) { const bf16x8 bs = *(const LAS bf16x8*)(SC + (16 * it + fr) * SCS + 8 * g); \
                    const int ip = 16 * it + fr, ii = dir ? 31 - ip : ip; \
                    _Pragma("unroll") for (int eb = 0; eb < 2; ++eb) { const f32x4 o = __builtin_amdgcn_mfma_f32_16x16x32_bf16(Vprev[eb], bs, oprev[eb][it], 0, 0, 0); \
                        *(v2u*)(O + ((size_t)b * SEQ + ii * 64 + col) * 512 + 128 * h + 16 * (2 * w + eb) + 4 * g) = (v2u){pk2(o[0], o[1]), pk2(o[2], o[3])}; } } } \
            _Pragma("unroll") for (int eb = 0; eb < 2; ++eb) { oprev[eb][0] = onew[eb][0]; oprev[eb][1] = onew[eb][1]; Vprev[eb] = Vf[eb]; } \
    } while (0)
    if (w >= 4) {
        bf16x8 Tri[2];
#pragma unroll
        for (int it = 0; it < 2; ++it)
#pragma unroll
            for (int jj = 0; jj < 8; ++jj) Tri[it][jj] = (8 * g + jj <= 16 * it + fr) ? (short)0x3F80 : (short)0;
#pragma unroll 1
        for (int k = 0; k < 76; k += 4) {
            HG2_W(k, 0, rqA, rlA, rvA); HG2_PREP(k, 0); __syncthreads();
            HG2_W(k + 1, 1, rqB, rlB, rvB); HG2_PREP(k + 1, 1); __syncthreads();
            HG2_W(k + 2, 2, rqA, rlA, rvA); HG2_PREP(k + 2, 2); __syncthreads();
            HG2_W(k + 3, 3, rqB, rlB, rvB); HG2_PREP(k + 3, 3); __syncthreads();
        }
    } else {
        f32x4 S[2][8], oprev[2][2]; bf16x8 Vprev[2];
#pragma unroll
        for (int eb = 0; eb < 2; ++eb) {
#pragma unroll
            for (int t = 0; t < 8; ++t) S[eb][t] = (f32x4){0.f, 0.f, 0.f, 0.f};
            oprev[eb][0] = (f32x4){0.f, 0.f, 0.f, 0.f}; oprev[eb][1] = (f32x4){0.f, 0.f, 0.f, 0.f};
#pragma unroll
            for (int jj = 0; jj < 8; ++jj) Vprev[eb][jj] = 0; }
#pragma unroll 1
        for (int k = 0; k < 76; k += 4) {
            HG2_W(k, 0, rqA, rlA, rvA); HG2_CORE(k, 0); __syncthreads();
            HG2_W(k + 1, 1, rqB, rlB, rvB); HG2_CORE(k + 1, 1); __syncthreads();
            HG2_W(k + 2, 2, rqA, rlA, rvA); HG2_CORE(k + 2, 2); __syncthreads();
            HG2_W(k + 3, 3, rqB, rlB, rvB); HG2_CORE(k + 3, 3); __syncthreads();
        }
    }
#undef HG2_W
#undef HG2_PREP
#undef HG2_CORE
}
DI void phase_y2(const Frame& F) {
    const bf16* OFp = (const bf16*)(F.ws + WS_OF); const bf16* OBp = (const bf16*)(F.ws + WS_OB); const bf16* P = (const bf16*)(F.ws + WS_P); bf16* YL = (bf16*)(F.ws + WS_YL);
    const bf16* HS = (const bf16*)(F.ws + WS_LHS); const bf16* PF = (const bf16*)(F.ws + WS_LPF); const bf16* PB = (const bf16*)(F.ws + WS_LPB); const float* CIN = (const float*)(F.ws + WS_CIN);
    const int gw = F.bx * NWAVES + F.wave, NGW = F.G * NWAVES;
    const int c = 8 * F.lane;
    const f32x4 g0 = *(const f32x4*)(F.in[I_HNORM] + c), g1 = *(const f32x4*)(F.in[I_HNORM] + c + 4);
    const float gn[8] = {g0.x, g0.y, g0.z, g0.w, g1.x, g1.y, g1.z, g1.w};
    for (int m0 = gw * 16; m0 < NTOK; m0 += NGW * 16) {
        const int bb = m0 >> 11, ss = 4 + ((m0 & 2047) >> 6);
        const size_t cf = ((size_t)(0 * NB + bb) * NSEQT + ss) * 512 + c, cbk = ((size_t)(1 * NB + bb) * NSEQT + ss) * 512 + c;
        const f32x4 f0 = *(const f32x4*)(CIN + cf), f1 = *(const f32x4*)(CIN + cf + 4), b0 = *(const f32x4*)(CIN + cbk), b1 = *(const f32x4*)(CIN + cbk + 4);
        const float cfv[8] = {f0.x, f0.y, f0.z, f0.w, f1.x, f1.y, f1.z, f1.w}, cbv[8] = {b0.x, b0.y, b0.z, b0.w, b1.x, b1.y, b1.z, b1.w};
#pragma unroll 2
        for (int m = m0; m < m0 + 16; ++m) {
            const v4u hs = *(const v4u*)(HS + (size_t)m * 512 + c), pf = *(const v4u*)(PF + (size_t)m * 512 + c), pb = *(const v4u*)(PB + (size_t)m * 512 + c), rg = *(const v4u*)(P + (size_t)m * INC + 512 + c);
            const v4u a = *(const v4u*)(OFp + (size_t)m * 512 + c), bq = *(const v4u*)(OBp + (size_t)m * 512 + c), sg = *(const v4u*)(P + (size_t)m * INC + 3072 + c);
            { const unsigned hw[4] = {hs.x, hs.y, hs.z, hs.w}, fw[4] = {pf.x, pf.y, pf.z, pf.w}, bw[4] = {pb.x, pb.y, pb.z, pb.w}, rw[4] = {rg.x, rg.y, rg.z, rg.w};
                unsigned ow[4];
#pragma unroll
                for (int q = 0; q < 4; ++q) { const float lo = bflo(rw[q]) * (bflo(hw[q]) + bflo(fw[q]) * cfv[2 * q] + bflo(bw[q]) * cbv[2 * q]);
                    const float hi = bfhi(rw[q]) * (bfhi(hw[q]) + bfhi(fw[q]) * cfv[2 * q + 1] + bfhi(bw[q]) * cbv[2 * q + 1]); ow[q] = pk2(lo, hi); }
                *(v4u*)(YL + (size_t)m * D + c) = (v4u){ow[0], ow[1], ow[2], ow[3]}; }
            float o[8] = {bflo(a.x) + bflo(bq.x), bfhi(a.x) + bfhi(bq.x), bflo(a.y) + bflo(bq.y), bfhi(a.y) + bfhi(bq.y), bflo(a.z) + bflo(bq.z), bfhi(a.z) + bfhi(bq.z), bflo(a.w) + bflo(bq.w), bfhi(a.w) + bfhi(bq.w)};
            const float sgv[8] = {bflo(sg.x), bfhi(sg.x), bflo(sg.y), bfhi(sg.y), bflo(sg.z), bfhi(sg.z), bflo(sg.w), bfhi(sg.w)};
            float ssq = 0.f;
#pragma unroll
            for (int j = 0; j < 8; ++j) ssq += o[j] * o[j];
            ssq += dpp_mov_f<0xB1>(ssq); ssq += dpp_mov_f<0x4E>(ssq); ssq += dpp_mov_f<0x124>(ssq); ssq += dpp_mov_f<0x128>(ssq);
            const float rs = rsqrtf(ssq * (1.0f / 128.0f) + EPS);
#pragma unroll
            for (int j = 0; j < 8; ++j) o[j] = o[j] * rs * gn[j] * sgv[j];
            v4u wv; wv.x = pk2(o[0], o[1]); wv.y = pk2(o[2], o[3]); wv.z = pk2(o[4], o[5]); wv.w = pk2(o[6], o[7]);
            *(v4u*)(YL + (size_t)m * D + 512 + c) = wv;
        }
    }
}

DI unsigned fkey(float f) { const unsigned u = __float_as_uint(f); return u ^ ((u >> 31) ? 0xFFFFFFFFu : 0x80000000u); }
template <int CTRL> DI unsigned dpp_u(unsigned v) { return (unsigned)__builtin_amdgcn_update_dpp(0, (int)v, CTRL, 0xf, 0xf, true); }
template <int CTRL> DI float dpp_f(float v) { return __uint_as_float(dpp_u<CTRL>(__float_as_uint(v))); }
DI unsigned umax_(unsigned a, unsigned b) { return a > b ? a : b; }
DI float readlane_f(float v, int lane) { return __uint_as_float((unsigned)__builtin_amdgcn_readlane((int)__float_as_uint(v), lane)); }
DI void phase_route(const Frame& F) {
    const float* LOGIT = (const float*)(F.ws + WS_LOGIT); const float* rb = F.in[I_RB];
    v2u* ROUTE = (v2u*)(F.ws + WS_ROUTE); int* HIST = (int*)(F.ws + WS_HIST);
    LAS unsigned* hist = (LAS unsigned*)F.lds;
    const int l = F.lane;
    const f32x4 rbv = *(const f32x4*)(rb + 4 * l);
    const float NEG = -__builtin_inff();
    for (int blk = F.bx; blk < NTOK / 128; blk += F.G) {
        if (F.tid < 256) hist[F.tid] = 0u;
        __syncthreads();
        const int tok0 = blk * 128 + F.wave * 16;
        f32x4 lg = *(const f32x4*)(LOGIT + (size_t)tok0 * NE + 4 * l);
#pragma unroll 1
        for (int ti = 0; ti < 16; ++ti) {
            const int tok = tok0 + ti;
            f32x4 lgn = {0.f, 0.f, 0.f, 0.f};
            if (ti + 1 < 16) lgn = *(const f32x4*)(LOGIT + (size_t)(tok + 1) * NE + 4 * l);
            float sc[4], bs[4];
#pragma unroll
            for (int k = 0; k < 4; ++k) { sc[k] = rcpf_(1.0f + expf_(-lg[k])); bs[k] = sc[k] + rbv[k]; }
            float m1 = NEG, m2 = NEG;
#pragma unroll
            for (int k = 0; k < 4; ++k) { const float v = bs[k]; if (v > m1) { m2 = m1; m1 = v; } else if (v > m2) m2 = v; }
            { float o1 = dpp_f<0xB1>(m1), o2 = dpp_f<0xB1>(m2); float n1 = fmaxf(m1, o1), n2 = fmaxf(fminf(m1, o1), fmaxf(m2, o2)); m1 = n1; m2 = n2;
              o1 = dpp_f<0x4E>(m1); o2 = dpp_f<0x4E>(m2); n1 = fmaxf(m1, o1); n2 = fmaxf(fminf(m1, o1), fmaxf(m2, o2)); m1 = n1; m2 = n2;
              const float a1 = dpp_f<0x104>(m1), a2 = dpp_f<0x104>(m2), c1 = dpp_f<0x114>(m1), c2 = dpp_f<0x114>(m2);
              o1 = (l & 4) ? c1 : a1; o2 = (l & 4) ? c2 : a2; n1 = fmaxf(m1, o1); n2 = fmaxf(fminf(m1, o1), fmaxf(m2, o2)); m1 = n1; m2 = n2; }
            const float gs = m1 + m2; const int g = l >> 3; int rank = 0;
#pragma unroll
            for (int gg = 0; gg < 8; ++gg) { const float og = readlane_f(gs, gg * 8); rank += (og > gs || (og == gs && gg < g)) ? 1 : 0; }
            const bool sel = rank < 4;
            unsigned cv[4];
#pragma unroll
            for (int k = 0; k < 4; ++k) cv[k] = sel ? fkey(bs[k]) : 0u;
            float sum = 0.f, mysc = 0.f; int myexp = 0;
#pragma unroll
            for (int r = 0; r < TOPK; ++r) {
                unsigned bvk = cv[0]; int bk = 0;
#pragma unroll
                for (int k = 1; k < 4; ++k) if (cv[k] > bvk) { bvk = cv[k]; bk = k; }
                const float bsc = bk == 0 ? sc[0] : bk == 1 ? sc[1] : bk == 2 ? sc[2] : sc[3];
                unsigned m = bvk;
                m = umax_(m, dpp_u<0xB1>(m)); m = umax_(m, dpp_u<0x4E>(m)); m = umax_(m, dpp_u<0x124>(m)); m = umax_(m, dpp_u<0x128>(m));
                const unsigned M = umax_(umax_((unsigned)__builtin_amdgcn_readlane((int)m, 0), (unsigned)__builtin_amdgcn_readlane((int)m, 16)),
                                         umax_((unsigned)__builtin_amdgcn_readlane((int)m, 32), (unsigned)__builtin_amdgcn_readlane((int)m, 48)));
                const unsigned long long bal = __ballot(bvk == M);
                const int L = __builtin_ctzll(bal);
                const int kL = __builtin_amdgcn_readlane(bk, L);
                const float se = readlane_f(bsc, L);
                const int e = 4 * L + kL;
                if (l == L) {
#pragma unroll
                    for (int k = 0; k < 4; ++k) if (k == bk) cv[k] = 0u; }
                sum += se; if (l == r) { myexp = e; mysc = se; }
            }
            if (l < TOPK) { ROUTE[(size_t)tok * TOPK + l] = (v2u){(unsigned)myexp, __float_as_uint(mysc * rcpf_(sum) * 2.5f)}; (void)__hip_atomic_fetch_add(hist + myexp, 1u, __ATOMIC_RELAXED, __HIP_MEMORY_SCOPE_WORKGROUP); }
            lg = lgn;
        }
        __syncthreads();
        if (F.tid < 256) HIST[blk * 256 + F.tid] = (int)hist[F.tid];
        __syncthreads();
    }
}
DI void phase_lists(const Frame& F) {
    const v2u* ROUTE = (const v2u*)(F.ws + WS_ROUTE); const int* HIST = (const int*)(F.ws + WS_HIST);
    unsigned* cnt = (unsigned*)(F.ws + WS_CTL) + CW_CNT; v2u* LIST = (v2u*)(F.ws + WS_LIST);
    LAS int* part = (LAS int*)F.lds;
    LAS int* lbase = part + 1024; LAS unsigned* lcnt = (LAS unsigned*)(lbase + 256); LAS int* ltot = lbase + 512; LAS int* lts = lbase + 768;
    int* INV = (int*)(F.ws + WS_INV);
    for (int blk = F.bx; blk < NTOK / 128; blk += F.G) {
        const int e = F.tid & 255, hf = F.tid >> 8;
        int below = 0, all = 0;
#pragma unroll 8
        for (int q = 0; q < 128; ++q) { const int row = hf * 128 + q; const int v = HIST[row * 256 + e]; all += v; below += (row < blk) ? v : 0; }
        part[hf * 512 + e] = below; part[hf * 512 + 256 + e] = all;
        __syncthreads();
        if (F.tid < 256) { lbase[e] = part[e] + part[512 + e]; lcnt[e] = 0u; const int tot = part[256 + e] + part[768 + e]; ltot[e] = tot; if (blk == 0) cnt[e] = (unsigned)tot; }
        __syncthreads();
        if (F.tid == 0) { int s2 = 0; for (int q = 0; q < 256; ++q) { lts[q] = s2; s2 += (ltot[q] + 255) >> 8; } }
        __syncthreads();
#pragma unroll
        for (int q = 0; q < 2; ++q) { const int a = F.tid + q * NTHR; const unsigned tk = (unsigned)(blk * 128 * TOPK + a);
            const v2u rt = ROUTE[tk]; const unsigned pos = (unsigned)lbase[rt.x] + __hip_atomic_fetch_add(lcnt + rt.x, 1u, __ATOMIC_RELAXED, __HIP_MEMORY_SCOPE_WORKGROUP);
            LIST[(size_t)rt.x * LISTCAP + pos] = (v2u){tk, rt.y}; INV[tk] = lts[rt.x] * 256 + (int)pos; }
        __syncthreads();
    }
}

template <bool GATHER> DI void moe_setup(const Frame& F, int ncol, int& nunits, int& nfull) {
    LAS int* ts = (LAS int*)(F.lds + LDS_TS); LAS int* cl = (LAS int*)(F.lds + LDS_CNT); LAS int* ut = (LAS int*)(F.lds + LDS_UT); LAS int* idx = (LAS int*)(F.lds + LDS_IDX);
    const unsigned* cnt = (const unsigned*)(F.ws + WS_CTL) + CW_CNT;
    if (F.tid < 256) cl[F.tid] = (int)__hip_atomic_load(cnt + F.tid, __ATOMIC_RELAXED, __HIP_MEMORY_SCOPE_AGENT);
    __syncthreads();
    if (F.tid == 0) { int s = 0; for (int e = 0; e < 256; ++e) { ts[e] = s; s += (cl[e] + 255) >> 8; } ts[256] = s; }
    __syncthreads();
    const int Te = ts[256], T = Te + NTOK / 256;
    const int Fr = T / F.G, R = T - Fr * F.G, LU = R * ncol;
    const int nleft = (LU > F.vcu) ? (LU - F.vcu + F.G - 1) / F.G : 0;
    nfull = Fr * ncol; nunits = nfull + nleft;
    const v2u* LIST = (const v2u*)(F.ws + WS_LIST);
    for (int j = 0; j < Fr + nleft && j < 10; ++j) {
        int rt, pnl = 0;
        if (j < Fr) rt = j * F.G + F.vcu; else { const int lu = (j - Fr) * F.G + F.vcu; rt = Fr * F.G + lu / ncol; pnl = lu % ncol; }
        int e, pm, nrows;
        if (rt >= Te) { e = 256; pm = rt - Te; nrows = 256; }
        else { int lo = 0, hi = 256; while (hi - lo > 1) { const int mid = (lo + hi) >> 1; if (ts[mid] <= rt) lo = mid; else hi = mid; }
            e = lo; pm = rt - ts[lo]; const int rem = cl[lo] - pm * 256; nrows = rem < 256 ? rem : 256; }
        if (F.tid == 0) *(LAS v4u*)(ut + 4 * j) = (v4u){(unsigned)e, (unsigned)pm, (unsigned)rt, (unsigned)nrows | ((unsigned)pnl << 16)};
        if (F.tid < 256) { const int r = F.tid;
            if (GATHER) idx[j * 256 + r] = (e == 256) ? pm * 256 + r : (r < nrows ? (int)(LIST[(size_t)e * LISTCAP + pm * 256 + r].x >> 3) : 0);
            else ((LAS float*)idx)[j * 256 + r] = (e == 256) ? 1.0f : (r < nrows ? __uint_as_float(LIST[(size_t)e * LISTCAP + pm * 256 + r].y) : 0.0f); } }
    __syncthreads();
}

DI void phase_combine(const Frame& F, int mode) {
    const float* MOD = (const float*)(F.ws + WS_MOD);
    const unsigned char* YE = F.ws + WS_YE; const int* INV = (const int*)(F.ws + WS_INV);
    int Te = 0; if (mode == 0) { const unsigned* cnt = (const unsigned*)(F.ws + WS_CTL) + CW_CNT; int t4 = 0;
#pragma unroll
        for (int q = 0; q < 4; ++q) t4 += (int)((cnt[F.lane + 64 * q] + 255u) >> 8);
#pragma unroll
        for (int o = 1; o < 64; o <<= 1) t4 += __shfl_xor(t4, o);
        Te = __builtin_amdgcn_readfirstlane(t4); }
    const int gw = F.bx * NWAVES + F.wave, NGW = F.G * NWAVES;
    const float* nf = F.in[I_NFIN];
    const int c = 16 * F.lane;
    for (int m = gw; m < NTOK; m += NGW) {
        const int b = m >> 11;
        float s[16];
#pragma unroll
        for (int q = 0; q < 16; ++q) s[q] = 0.f;
        const bf16* xsrc = (const bf16*)(F.ws + WS_X1);
        if (mode == 0) {
#pragma unroll
            for (int k = 0; k < 9; ++k) { const int row = (k < 8) ? INV[m * TOPK + k] : Te * 256 + m; const v4u w = *(const v4u*)(YE + (size_t)row * D + c);
                const unsigned ww[4] = {w.x, w.y, w.z, w.w};
#pragma unroll
                for (int q = 0; q < 4; ++q) { const f32x2 lo = __builtin_amdgcn_cvt_pk_f32_fp8((int)ww[q], false), hi = __builtin_amdgcn_cvt_pk_f32_fp8((int)ww[q], true);
                    s[4 * q] += lo.x; s[4 * q + 1] += lo.y; s[4 * q + 2] += hi.x; s[4 * q + 3] += hi.y; } } }
        float x2[16]; float ss = 0.f;
#pragma unroll
        for (int q = 0; q < 4; ++q) { const v2u xt = *(const v2u*)(xsrc + (size_t)m * D + c + 4 * q); const f32x4 xa = {bflo(xt.x), bfhi(xt.x), bflo(xt.y), bfhi(xt.y)}, ga = *(const f32x4*)(MOD + b * 6144 + 5120 + c + 4 * q);
#pragma unroll
            for (int j = 0; j < 4; ++j) { const float v = xa[j] + ga[j] * (s[4 * q + j] * 0.015625f); x2[4 * q + j] = v; ss += v * v; } }
        const float rs = rsqrtf(wave_sum(ss) * (1.0f / D) + EPS);
#pragma unroll
        for (int q = 0; q < 4; ++q) { const f32x4 na = *(const f32x4*)(nf + c + 4 * q);
            f32x4 oa = {x2[4 * q] * rs * na.x, x2[4 * q + 1] * rs * na.y, x2[4 * q + 2] * rs * na.z, x2[4 * q + 3] * rs * na.w};
            *(f32x4*)(F.out + (size_t)m * D + c + 4 * q) = oa; }
    }
}

constexpr int NPHASE = 14;
__global__ void __launch_bounds__(NTHR, 2) fwd_kernel(Args args) {
    extern __shared__ __attribute__((aligned(16))) unsigned char lds_raw[];
    Frame F;
    F.lds = (LAS unsigned char*)lds_raw;
    F.tid = threadIdx.x; F.lane = F.tid & 63; F.wave = __builtin_amdgcn_readfirstlane(F.tid >> 6);
    F.G = gridDim.x; F.bx = blockIdx.x; F.vcu = (F.G % 8 == 0) ? (F.bx % 8) * (F.G / 8) + F.bx / 8 : F.bx;
    F.in = args.in; F.out = args.out; F.ws = args.ws;
    volatile LAS unsigned* MISC = (volatile LAS unsigned*)(F.lds + LDS_MISC);
    if (F.tid < 16) MISC[F.tid] = 0u;
    __syncthreads();
    XcdBarrier bar; bar.bar = (unsigned*)(F.ws + WS_CTL) + CW_BAR; bar.x = 0; bar.st = nullptr;
#if !PER_PHASE_LAUNCH
    bar = xcd_barrier_post((unsigned*)(F.ws + WS_CTL) + CW_BAR, MISC + 8);
#define GRID_BAR() xcd_barrier(bar)
#else
#define GRID_BAR() do {} while (0)
#endif
    const int lo = args.ph_lo, hi = args.ph_hi;
#ifndef PH_MASK
#define PH_MASK 0xFFFF
#endif
#define IN(k) (((PH_MASK >> (k)) & 1) && lo <= (k) && (k) < hi)
#ifndef PROBE_PH
#define PROBE_PH -1
#endif
#ifndef PROBE_MULT
#define PROBE_MULT 4
#endif
    volatile LAS unsigned long long* PRT = (volatile LAS unsigned long long*)(F.lds + LDS_MISC);
    if (PROBE_PH == 0 && F.wave == 0) PRT[0] = __builtin_amdgcn_s_memrealtime();
#define SEAM(k) do { if (IN(k) && IN((k) + 1)) GRID_BAR(); \
        if (PROBE_PH >= 0 && F.wave == 0) { if ((k) == PROBE_PH - 1) PRT[0] = __builtin_amdgcn_s_memrealtime(); if ((k) == PROBE_PH) PRT[1] = __builtin_amdgcn_s_memrealtime(); } } while (0)
#ifndef REPEAT_MASK
#define REPEAT_MASK 0
#endif
#define REPS(k) (1 + ((REPEAT_MASK >> (k)) & 1))
    unsigned char* ws = F.ws;

    if (IN(0)) _Pragma("unroll 1") for (int rep = 0; rep < REPS(0); ++rep) { if (rep) GRID_BAR(); phase_prologue(F); } SEAM(0);
    if (IN(1)) _Pragma("unroll 1") for (int rep = 0; rep < REPS(1); ++rep) { if (rep) GRID_BAR(); phase_norm_rows(F, 0); } SEAM(1);
    if (IN(2)) _Pragma("unroll 1") for (int rep = 0; rep < REPS(2); ++rep) { if (rep) GRID_BAR();
        pg8::DenseOrder S; S.init(ws + WS_HX, ws + WS_WIN, MTOT, INC, D, F.G, F.bx);
        pg8::EpiInProj E{(bf16*)(ws + WS_P), (const float*)(ws + WS_TAB)};
        pg8::gemm_phase(F.lds, D, S, E, F.wave);
    } SEAM(2);
    if (IN(3)) _Pragma("unroll 1") for (int rep = 0; rep < REPS(3); ++rep) { if (rep) GRID_BAR(); phase_lru_pass1(F); } SEAM(3);
    if (IN(4)) _Pragma("unroll 1") for (int rep = 0; rep < REPS(4); ++rep) { if (rep) GRID_BAR(); phase_lru_carry(F);
#if defined(PROBE_SUB)
        if (F.wave == 0 && PROBE_SUB == 0) PRT[0] = __builtin_amdgcn_s_memrealtime();
#endif
        if (F.bx < NB * 4 * 2) hgrn_chain2(F, F.bx);
#if defined(PROBE_SUB)
        if (F.wave == 0) { if (PROBE_SUB == 0) PRT[1] = __builtin_amdgcn_s_memrealtime(); else PRT[0] = __builtin_amdgcn_s_memrealtime(); }
#endif
        convert_experts(F, nullptr, 0u);
#if defined(PROBE_SUB)
        if (F.wave == 0 && PROBE_SUB == 1) PRT[1] = __builtin_amdgcn_s_memrealtime();
#endif
        } SEAM(4);
    if (IN(5)) _Pragma("unroll 1") for (int rep = 0; rep < REPS(5); ++rep) { if (rep) GRID_BAR(); phase_y2(F); } SEAM(5);
    if (IN(6)) _Pragma("unroll 1") for (int rep = 0; rep < REPS(6); ++rep) { if (rep) GRID_BAR();
        pg8::DenseOrder S; S.init(ws + WS_YL, ws + WS_WOUT, NTOK, D, D, F.G, F.bx);
        pg8::EpiResid E{F.in[I_X], (const float*)(ws + WS_MOD), (bf16*)(ws + WS_X1)};
        pg8::gemm_phase(F.lds, D, S, E, F.wave);
    } SEAM(6);
#if DBG_STOP == 1
    if (IN(7)) _Pragma("unroll 1") for (int rep = 0; rep < REPS(7); ++rep) { if (rep) GRID_BAR(); phase_combine(F, 1); }
#else
    if (IN(7)) _Pragma("unroll 1") for (int rep = 0; rep < REPS(7); ++rep) { if (rep) GRID_BAR(); phase_norm_rows(F, 1); } SEAM(7);
    if (IN(8)) _Pragma("unroll 1") for (int rep = 0; rep < REPS(8); ++rep) { if (rep) GRID_BAR();
        pg8::DenseOrder S; S.init(ws + WS_HX2, ws + WS_WR, NTOK, NE, D, F.G, F.bx);
        pg8::EpiF32 E{(float*)(ws + WS_LOGIT), NE};
        pg8::gemm_phase(F.lds, D, S, E, F.wave);
    } SEAM(8);
    if (IN(9)) _Pragma("unroll 1") for (int rep = 0; rep < REPS(9); ++rep) { if (rep) GRID_BAR(); phase_route(F); } SEAM(9);
    if (IN(10)) _Pragma("unroll 1") for (int rep = 0; rep < REPS(10); ++rep) { if (rep) GRID_BAR(); phase_lists(F); } SEAM(10);
    if (IN(11)) _Pragma("unroll 1") for (int rep = 0; rep < REPS(11); ++rep) { if (rep) GRID_BAR();
        int total, nfull; moe_setup<true>(F, 2, total, nfull);
        pg8::MoeOrder<true> S; S.A = (const char*)(ws + WS_HX2F); S.Bt = (const char*)(ws + WS_EW13); S.BtS = (const char*)(ws + WS_SW13); S.K = D / 2; S.ncol = 2; S.estride = (size_t)512 * 1024;
        S.ut = (const LAS int*)(F.lds + LDS_UT); S.idx = (const LAS int*)(F.lds + LDS_IDX); S.nunits = total; S.nfull = nfull;
        pg8::EpiSwiGLU8 E{ws + WS_ACT};
        pg8::gemm_phase<pg8::EpiSwiGLU8, pg8::MoeOrder<true>, false, true>(F.lds, D / 2, S, E, F.wave);
    } SEAM(11);
    if (IN(12)) _Pragma("unroll 1") for (int rep = 0; rep < REPS(12); ++rep) { if (rep) GRID_BAR();
        int total, nfull; moe_setup<false>(F, 4, total, nfull);
        pg8::MoeOrder<false> S; S.A = (const char*)(ws + WS_ACT); S.Bt = (const char*)(ws + WS_EW2); S.BtS = (const char*)(ws + WS_SW2); S.K = DE / 2; S.ncol = 4; S.estride = (size_t)1024 * 256;
        S.ut = (const LAS int*)(F.lds + LDS_UT); S.idx = (const LAS int*)(F.lds + LDS_IDX); S.nunits = total; S.nfull = nfull;
        pg8::EpiScatter E{ws + WS_YE, (const LAS float*)(F.lds + LDS_IDX), 0.5f};
#if defined(PROBE_GEMM)
        pg8::GProf gp{0ull, 0ull, 0ull};
        pg8::gemm_phase<pg8::EpiScatter, pg8::MoeOrder<false>, true, true>(F.lds, DE / 2, S, E, F.wave, &gp);
        if (F.wave == 0) { PRT[0] = 0ull; PRT[1] = (PROBE_GEMM == 0) ? gp.t_loop : (PROBE_GEMM == 1) ? gp.t_epi : gp.t_next; }
#else
        pg8::gemm_phase<pg8::EpiScatter, pg8::MoeOrder<false>, false, true>(F.lds, DE / 2, S, E, F.wave);
#endif
    } SEAM(12);
    if (IN(13)) _Pragma("unroll 1") for (int rep = 0; rep < REPS(13); ++rep) { if (rep) GRID_BAR(); phase_combine(F, 0); }
#endif
#if defined(PROBE_GEMM) || defined(PROBE_SUB)
    if (F.bx == 0 && F.wave == 0) {
#else
    if (PROBE_PH >= 0 && F.bx == 0 && F.wave == 0) {
#endif
        const unsigned long long te = __builtin_amdgcn_s_memrealtime(); if (PROBE_PH == NPHASE - 1) PRT[1] = te;
        const unsigned long long target = (unsigned long long)PROBE_MULT * (PRT[1] - PRT[0]);
        while (__builtin_amdgcn_s_memrealtime() - te < target) __builtin_amdgcn_s_sleep(20);
    }
}

extern "C" void kernel_launch(void* const* d_in, const int* in_sizes, int n_in, void* d_out, int out_size, void* d_ws, size_t ws_size, hipStream_t stream) {
    static int grid = 0;
    if (grid == 0) {
        if (n_in != 26 || in_sizes[0] != NTOK * D || out_size != NTOK * D || ws_size < WS_END) { fprintf(stderr, "kernel_launch: unexpected shapes (n_in %d, ws %zu)\n", n_in, ws_size); grid = -1; return; }
        int dev = 0, cus = 0, per_cu = 0;
        if (hipGetDevice(&dev) != hipSuccess || hipDeviceGetAttribute(&cus, hipDeviceAttributeMultiprocessorCount, dev) != hipSuccess) { grid = -1; return; }
        if (hipFuncSetAttribute((const void*)fwd_kernel, hipFuncAttributeMaxDynamicSharedMemorySize, LDS_BYTES) != hipSuccess) { fprintf(stderr, "kernel_launch: hipFuncSetAttribute failed\n"); grid = -1; return; }
        if (hipOccupancyMaxActiveBlocksPerMultiprocessor(&per_cu, (const void*)fwd_kernel, NTHR, LDS_BYTES) != hipSuccess || per_cu < 1) { fprintf(stderr, "kernel_launch: occupancy query says %d\n", per_cu); }
        (void)hipGetLastError();
        grid = cus;
        if (grid < 128) { fprintf(stderr, "kernel_launch: needs >= 128 CUs (HGRN2 chains run one per workgroup)\n"); grid = -1; return; }
    }
    if (grid < 0) return;
    hipMemsetAsync((char*)d_ws + WS_CTL, 0, CTL_ZERO_BYTES, stream);
    Args a{};
    for (int i = 0; i < 26; ++i) a.in[i] = (const float*)d_in[i];
    a.out = (float*)d_out; a.ws = (unsigned char*)d_ws;
#if PER_PHASE_LAUNCH
    for (int p = 0; p < NPHASE; ++p) { a.ph_lo = p; a.ph_hi = p + 1; hipLaunchKernelGGL(fwd_kernel, dim3(grid), dim3(NTHR), LDS_BYTES, stream, a); }
#else
    a.ph_lo = 0; a.ph_hi = NPHASE;
    hipLaunchKernelGGL(fwd_kernel, dim3(grid), dim3(NTHR), LDS_BYTES, stream, a);
#endif
}
```

```cpp
#include <hip/hip_runtime.h>
#include <cstdio>
#include <cstdint>

#ifndef PER_PHASE_LAUNCH
#define PER_PHASE_LAUNCH 0
#endif
#ifndef DBG_STOP
#define DBG_STOP 0
#endif

#define GAS __attribute__((address_space(1)))
#define LAS __attribute__((address_space(3)))
#define DI __device__ __forceinline__
typedef unsigned short bf16;
typedef unsigned v4u __attribute__((ext_vector_type(4)));
typedef unsigned v2u __attribute__((ext_vector_type(2)));
typedef float f32x4 __attribute__((ext_vector_type(4)));
typedef float f32x2 __attribute__((ext_vector_type(2)));
typedef short bf16x8 __attribute__((ext_vector_type(8)));
typedef __bf16 bfv2 __attribute__((ext_vector_type(2)));

constexpr int D = 1024, NB = 16, SEQ = 2048, CTXL = 256;
constexpr int NTOK = NB * SEQ;
constexpr int NCTX = NB * CTXL;
constexpr int MTOT = NTOK + NCTX;
constexpr int INC = 3584;
constexpr int NE = 256, TOPK = 8, DE = 256;
constexpr int LISTCAP = 32768;
constexpr float EPS = 1e-6f;
constexpr int NWAVES = 8, NTHR = 512;
constexpr int NSEQT = 36;

constexpr size_t MiB = 1u << 20;
constexpr size_t WS_CTL = 0, CTL_ZERO_BYTES = 1 * MiB;
constexpr size_t WS_MOD = 1 * MiB;
constexpr size_t WS_TAB = 2 * MiB;
constexpr size_t WS_WGT = 2 * MiB + 65536;
constexpr size_t WS_WIN = 3 * MiB;
constexpr size_t WS_WOUT = 10 * MiB;
constexpr size_t WS_WR = 12 * MiB;
constexpr size_t WS_SW13 = 12 * MiB + 512 * 1024;
constexpr size_t WS_SW2 = 13 * MiB + 512 * 1024;
constexpr size_t WS_DUMP = 2 * MiB + 16384;
constexpr size_t WS_SUMA = 14 * MiB;
constexpr size_t WS_SUMH = WS_SUMA + 2359296;
constexpr size_t WS_CIN = WS_SUMH + 2359296;
constexpr size_t WS_ROUTE = 21 * MiB;
constexpr size_t WS_HIST = 23 * MiB;
constexpr size_t WS_EW13 = 32 * MiB;
constexpr size_t WS_EW2 = 288 * MiB;
constexpr size_t WS_X1 = 416 * MiB;
constexpr size_t WS_HX2 = 544 * MiB;
constexpr size_t WS_LOGIT = 608 * MiB;
constexpr size_t WS_LIST = 1620 * MiB;
constexpr size_t WS_LHS = 674 * MiB, WS_LPF = 706 * MiB, WS_LPB = 738 * MiB;
constexpr size_t WS_ACT = 674 * MiB;
constexpr size_t WS_YS = 850 * MiB;
constexpr size_t WS_P = 914 * MiB;
constexpr size_t WS_HX = 1166 * MiB;
constexpr size_t WS_OF = 1238 * MiB;
constexpr size_t WS_OB = 1270 * MiB;
constexpr size_t WS_YL = 1302 * MiB;
constexpr size_t WS_YE = 914 * MiB;
constexpr size_t WS_INV = 24 * MiB;
constexpr size_t WS_HX2F = 1684 * MiB;
constexpr size_t WS_END = 1716 * MiB;
constexpr int CW_BAR = 4096;
constexpr int CW_CNT = 16384;
constexpr int CW_CONVQ = 20480;
constexpr int CW_LRUDONE = 20544;

constexpr int RING_BYTES = 131072;
constexpr int LDS_TS = RING_BYTES;
constexpr int LDS_CNT = LDS_TS + 1088;
constexpr int LDS_UT = LDS_CNT + 1024;
constexpr int LDS_IDX = LDS_UT + 192;
constexpr int LDS_MISC = LDS_IDX + 10 * 1024;
constexpr int LDS_BYTES = 155648;
static_assert(LDS_MISC + 64 <= LDS_BYTES, "lds map");

DI unsigned pk2(float lo, float hi) { f32x2 v = {lo, hi}; bfv2 b = __builtin_convertvector(v, bfv2); return __builtin_bit_cast(unsigned, b); }
DI float clamp448(float x) { return __builtin_amdgcn_fmed3f(x, -448.0f, 448.0f); }
DI unsigned pk4_f8(float a, float b, float c, float d) {
    int w = __builtin_amdgcn_cvt_pk_fp8_f32(clamp448(a), clamp448(b), 0, false); w = __builtin_amdgcn_cvt_pk_fp8_f32(clamp448(c), clamp448(d), w, true); return (unsigned)w; }
DI float bflo(unsigned w) { return __uint_as_float(w << 16); }
DI float bfhi(unsigned w) { return __uint_as_float(w & 0xffff0000u); }
DI float bf2f(bf16 h) { return __uint_as_float(((unsigned)h) << 16); }
DI bf16 f2bf(float f) { return (bf16)(pk2(f, 0.f) & 0xffffu); }
DI float rcpf_(float x) { return __builtin_amdgcn_rcpf(x); }
DI float ex2f_(float x) { return __builtin_amdgcn_exp2f(x); }
DI float expf_(float x) { return __builtin_amdgcn_exp2f(x * 1.4426950408889634f); }
DI float logf_(float x) { return __builtin_amdgcn_logf(x) * 0.6931471805599453f; }
DI float sigm(float x) { return rcpf_(1.0f + expf_(-x)); }
DI float wave_sum(float v) {
#pragma unroll
    for (int o = 1; o < 64; o <<= 1) v += __shfl_xor(v, o);
    return v;
}
#define LDS_WAIT() asm volatile("s_waitcnt lgkmcnt(0)" ::: "memory")
template <int CTRL> DI float dpp_mov_f(float v) { return __uint_as_float((unsigned)__builtin_amdgcn_update_dpp(0, (int)__float_as_uint(v), CTRL, 0xf, 0xf, true)); }
DI float wave_sum_fast(float v) {
    v += dpp_mov_f<0xB1>(v); v += dpp_mov_f<0x4E>(v); v += dpp_mov_f<0x124>(v); v += dpp_mov_f<0x128>(v);
    const unsigned u = __float_as_uint(v);
    return (__uint_as_float((unsigned)__builtin_amdgcn_readlane((int)u, 0)) + __uint_as_float((unsigned)__builtin_amdgcn_readlane((int)u, 16)))
         + (__uint_as_float((unsigned)__builtin_amdgcn_readlane((int)u, 32)) + __uint_as_float((unsigned)__builtin_amdgcn_readlane((int)u, 48)));
}

#define XB_TMO      128
#define XB_XCNT(j)  (256  + 64 * (j))
#define XB_XSUB(j)  (1280 + 64 * (j))
#define XB_XGEN(j)  (2304 + 64 * (j))
#define XB_TOP      3328
#define XB_TOPGEN   3392
#define XCD_BAR_WORDS 3456
#define XB_SPIN_CAP (1u << 18)
__device__ __forceinline__ unsigned xb_ld(unsigned* p)              { return __hip_atomic_load(p, __ATOMIC_RELAXED, __HIP_MEMORY_SCOPE_AGENT); }
__device__ __forceinline__ unsigned xb_add(unsigned* p, unsigned v) { return __hip_atomic_fetch_add(p, v, __ATOMIC_RELAXED, __HIP_MEMORY_SCOPE_AGENT); }
__device__ __forceinline__ unsigned xb_xcc_id() { return (unsigned)__builtin_amdgcn_s_getreg((3 << 11) | 20) & 0xFu; }
#define XB_SPIN(cond, bar) do { unsigned _sp = 0; while (cond) { __builtin_amdgcn_s_sleep(1); \
    if ((++_sp & 255u) == 0u) { if (xb_ld(&(bar)[XB_TMO])) break; if (_sp > XB_SPIN_CAP) { atomicAdd(&(bar)[XB_TMO], 1u); break; } } } } while (0)
struct XcdBarrier { unsigned* bar; unsigned x; volatile LAS unsigned* st; };
__device__ __forceinline__ XcdBarrier xcd_barrier_post(unsigned* bar, volatile LAS unsigned* st) {
    XcdBarrier b; b.bar = bar; b.x = xb_xcc_id(); b.st = st;
    if (threadIdx.x == 0) (void)xb_add(&bar[XB_XCNT(b.x)], 1u);
    return b;
}
__device__ __forceinline__ void xcd_barrier_complete(unsigned* bar, unsigned x, unsigned& nloc, unsigned& nx) {
    const unsigned G = gridDim.x * gridDim.y * gridDim.z;
    unsigned sum, cnt, mine, sp = 0u;
    for (;;) {
        sum = 0u; cnt = 0u; mine = 0u;
#pragma unroll
        for (unsigned j = 0; j < 16; ++j) { const unsigned c = xb_ld(&bar[XB_XCNT(j)]); sum += c; cnt += (c > 0u) ? 1u : 0u; mine = (j == x) ? c : mine; }
        if (sum == G) break;
        __builtin_amdgcn_s_sleep(1);
        if ((++sp & 255u) == 0u) { if (xb_ld(&bar[XB_TMO])) break; if (sp > XB_SPIN_CAP) { atomicAdd(&bar[XB_TMO], 1u); break; } }
    }
    nloc = mine > 0u ? mine : 1u; nx = cnt > 0u ? cnt : 1u;
}
__device__ __forceinline__ void xcd_barrier(const XcdBarrier& b) {
    asm volatile("s_waitcnt vmcnt(0)" ::: "memory");
    __syncthreads();
    if (threadIdx.x == 0) {
        unsigned* bar = b.bar;
        __builtin_amdgcn_s_waitcnt(0);
        unsigned nloc = b.st[0], nx = b.st[1];
        if (nloc == 0u) { xcd_barrier_complete(bar, b.x, nloc, nx); b.st[0] = nloc; b.st[1] = nx; }
        const unsigned old = xb_add(&bar[XB_XSUB(b.x)], 1u);
        const unsigned gen = old / nloc;
        if (old + 1u == (gen + 1u) * nloc) {
            __builtin_amdgcn_fence(__ATOMIC_RELEASE, "agent");
            asm volatile("s_waitcnt vmcnt(0)" ::: "memory");
            const unsigned og = xb_add(&bar[XB_TOP], 1u);
            const unsigned tg = og / nx;
            if (og + 1u == (tg + 1u) * nx) xb_add(&bar[XB_TOPGEN], 1u);
            else XB_SPIN(xb_ld(&bar[XB_TOPGEN]) == tg, bar);
            __builtin_amdgcn_fence(__ATOMIC_ACQUIRE, "agent");
            xb_add(&bar[XB_XGEN(b.x)], 1u);
            asm volatile("s_waitcnt vmcnt(0)" ::: "memory");
        } else {
            XB_SPIN(xb_ld(&bar[XB_XGEN(b.x)]) == gen, bar);
            __builtin_amdgcn_fence(__ATOMIC_ACQUIRE, "agent");
            asm volatile("s_waitcnt vmcnt(0)" ::: "memory");
        }
    }
    __syncthreads();
}

namespace pg8 {
constexpr int BM = 256, BK = 64, HALF = 128, HTB = HALF * BK * 2, NXCD = 8, WGM = 8;
DI int lds_byte(int r, int c) { const int st = (r >> 4) * 2 + (c >> 5), rr = r & 15, cc = c & 31, ob = rr * 64 + cc * 2; return st * 1024 + (ob ^ (((ob >> 9) & 1) << 5)); }
DI void stage_rc(int b, int& R, int& C) { const int st = b / 1024, sb = b % 1024, swz = sb ^ (((sb >> 9) & 1) << 5); R = (st >> 1) * 16 + swz / 64; C = (st & 1) * 32 + (swz % 64) / 2; }
DI int perm32(int rho) { const int n = rho >> 4, i = rho & 15; return 8 * (i >> 2) + 4 * n + (i & 3); }

struct Unit { int pm, pn, e, rt, ord, nrows; };

struct DenseOrder {
    const char* A; const char* Bt; int K, nM, nN, nwg, G, c;
    DI void init(const void* A_, const void* Bt_, int M, int N, int K_, int G_, int c_) { A = (const char*)A_; Bt = (const char*)Bt_; K = K_; nM = M / BM; nN = N / BM; nwg = nM * nN; G = G_; c = c_; }
    DI bool next(int i, Unit& u) const {
        const long L = (long)i * G + c; if (L >= nwg) return false;
        int wgid = (int)L; { const int q = nwg / NXCD, r = nwg % NXCD, xcd = wgid % NXCD, off = wgid / NXCD; wgid = (xcd < r ? xcd * (q + 1) : r * (q + 1) + (xcd - r) * q) + off; }
        const int nig = WGM * nN, gid = wgid / nig, fm = gid * WGM, gsz = (nM - fm) < WGM ? (nM - fm) : WGM;
        u.pm = fm + ((wgid % nig) % gsz); u.pn = (wgid % nig) / gsz; u.e = 0; u.rt = u.pm; u.ord = i; u.nrows = 256; return true;
    }
    DI const char* a_base(const Unit& u) const { return A + (size_t)u.pm * BM * K * 2; }
    DI const char* b_base(const Unit& u) const { return Bt + (size_t)u.pn * BM * K * 2; }
    static constexpr bool GATHER_A = false;
    DI void a_offs(const Unit&, int tid, unsigned (&v)[2][2]) const {
#pragma unroll
        for (int i = 0; i < 2; ++i) { int R, C; stage_rc(tid * 16 + i * 8192, R, C);
#pragma unroll
            for (int h = 0; h < 2; ++h) v[h][i] = (unsigned)((h * HALF + R) * K + C) * 2u; }
    }
};

template <bool GATHER> struct MoeOrder {
    const char* A; const char* Bt; const char* BtS; int K, ncol; size_t estride;
    const LAS int* ut; const LAS int* idx; int nunits, nfull;
    static constexpr bool GATHER_A = GATHER;
    DI bool next(int i, Unit& u) const {
        if (i >= nunits) return false;
        int j, pn;
        if (i < nfull) { j = i / ncol; pn = i - j * ncol; } else { j = nfull / ncol + (i - nfull); pn = -1; }
        const v4u t = *(const LAS v4u*)(ut + 4 * j);
        u.ord = j; u.e = (int)t.x; u.pm = (int)t.y; u.rt = (int)t.z; u.nrows = (int)(t.w & 0xffffu); u.pn = pn >= 0 ? pn : (int)(t.w >> 16);
        return true;
    }
    DI const char* a_base(const Unit& u) const { return GATHER ? A : A + (size_t)u.rt * BM * K * 2; }
    DI const char* b_base(const Unit& u) const { return (u.e < 256 ? Bt + (size_t)u.e * estride : BtS) + (size_t)u.pn * BM * K * 2; }
    DI void a_offs(const Unit& u, int tid, unsigned (&v)[2][2]) const {
#pragma unroll
        for (int i = 0; i < 2; ++i) { int R, C; stage_rc(tid * 16 + i * 8192, R, C);
#pragma unroll
            for (int h = 0; h < 2; ++h) {
                if (GATHER) v[h][i] = ((unsigned)idx[u.ord * 256 + h * HALF + R] * (unsigned)K + (unsigned)C) * 2u;
                else v[h][i] = (unsigned)((h * HALF + R) * K + C) * 2u; } }
    }
};

struct GProf { unsigned long long t_loop, t_epi, t_next; };
typedef int v8i __attribute__((ext_vector_type(8)));
template <class Epi, class Sched, bool PROF = false, bool F8 = false>
__device__ __forceinline__ void gemm_phase(LAS unsigned char* lds, const int K, const Sched& S, const Epi& E, const int wid  , GProf* prof = nullptr) {
    unsigned long long pt0 = 0, pt1 = 0, pt2 = 0, pt3 = 0;
    const int tid = threadIdx.x, lane = tid & 63, wr = wid >> 2, wc = wid & 3, fr = lane & 15, fq = lane >> 4;
    const int nt = K / BK;
    unsigned voffBh[2][2];
#pragma unroll
    for (int i = 0; i < 2; ++i) { int R, C; stage_rc(tid * 16 + i * 8192, R, C);
#pragma unroll
        for (int h = 0; h < 2; ++h) { int Rb;
            if (Epi::PERM == 2) Rb = 64 * ((R >> 5) & 3) + 16 * ((R >> 2) & 3) + 8 * h + 4 * ((R >> 4) & 1) + (R & 3);
            else Rb = HALF * h + (Epi::PERM == 1 ? ((R & ~31) + perm32(R & 31)) : R);
            voffBh[h][i] = (unsigned)(Rb * K + C) * 2u; } }
    const size_t kstep = (size_t)(BK * 2);
    const size_t hstep = (size_t)HALF * K * 2;
    const unsigned ldsw = (unsigned)wid * 1024u;
    const int aoff = F8 ? lds_byte(wr * 64 + fr, fq * 16) : lds_byte(wr * 64 + fr, fq * 8), boff = F8 ? lds_byte(wc * 32 + fr, fq * 16) : lds_byte(wc * 32 + fr, fq * 8);
#define PG8_SA(b, h) (((b) * 2 + (h)) * HTB)
#define PG8_SB(b, h) ((4 + (b) * 2 + (h)) * HTB)
#define PG8_STAGE(bufoff, gbase, voff) do { _Pragma("unroll") for (int _i = 0; _i < 2; ++_i) \
        __builtin_amdgcn_global_load_lds((const unsigned*)((const char*)(gbase) + (voff)[_i]), (LAS unsigned*)(lds + (bufoff) + ldsw + _i * 8192), 16, 0, 0); } while (0)
#define PG8_LD8(dst, off) do { const v4u _lo = *(const LAS v4u*)(lds + (off)), _hi = *(const LAS v4u*)(lds + (off) + 16); \
        dst[0] = (int)_lo.x; dst[1] = (int)_lo.y; dst[2] = (int)_lo.z; dst[3] = (int)_lo.w; dst[4] = (int)_hi.x; dst[5] = (int)_hi.y; dst[6] = (int)_hi.z; dst[7] = (int)_hi.w; } while (0)
#define PG8_LDA(dst, b, h) do { if (F8) { _Pragma("unroll") for (int m = 0; m < 4; ++m) PG8_LD8(dst##8[m], PG8_SA(b, h) + aoff + m * 2048); } \
        else { _Pragma("unroll") for (int m = 0; m < 4; ++m) _Pragma("unroll") for (int k = 0; k < 2; ++k) dst[m][k] = *(const LAS bf16x8*)(lds + PG8_SA(b, h) + aoff + m * 2048 + k * 1024); } } while (0)
#define PG8_LDB(dst, b, h) do { if (F8) { _Pragma("unroll") for (int n = 0; n < 2; ++n) PG8_LD8(dst##8[n], PG8_SB(b, h) + boff + n * 2048); } \
        else { _Pragma("unroll") for (int n = 0; n < 2; ++n) _Pragma("unroll") for (int k = 0; k < 2; ++k) dst[n][k] = *(const LAS bf16x8*)(lds + PG8_SB(b, h) + boff + n * 2048 + k * 1024); } } while (0)
#define PG8_MMA(ai, bj, At, Bt) do { __builtin_amdgcn_s_setprio(1); \
        if (F8) { _Pragma("unroll") for (int m = 0; m < 4; ++m) _Pragma("unroll") for (int n = 0; n < 2; ++n) \
            asm volatile("v_mfma_scale_f32_16x16x128_f8f6f4 %0, %1, %2, %0, %3, %3 op_sel_hi:[0,0,0]" : "+v"(acc[ai][bj][m][n]) : "v"(Bt##8[n]), "v"(At##8[m]), "v"(sc127)); } \
        else { _Pragma("unroll") for (int m = 0; m < 4; ++m) _Pragma("unroll") for (int n = 0; n < 2; ++n) _Pragma("unroll") for (int k = 0; k < 2; ++k) \
            acc[ai][bj][m][n] = __builtin_amdgcn_mfma_f32_16x16x32_bf16(Bt[n][k], At[m][k], acc[ai][bj][m][n], 0, 0, 0); } \
        __builtin_amdgcn_s_setprio(0); } while (0)
#define PG8_WAIT_V(n) asm volatile("s_waitcnt vmcnt(" #n ")" ::: "memory")
#define PG8_WAIT_L(n) asm volatile("s_waitcnt lgkmcnt(" #n ")" ::: "memory")
#define PG8_BAR __builtin_amdgcn_s_barrier()
#define PG8_SCHED __builtin_amdgcn_sched_barrier(0)
    Unit cur, nxt; int ui = 0;
    if (!S.next(0, cur)) return;
    f32x4 acc[2][2][4][2];
#pragma unroll
    for (int a = 0; a < 2; ++a)
#pragma unroll
        for (int b = 0; b < 2; ++b)
#pragma unroll
            for (int m = 0; m < 4; ++m)
#pragma unroll
                for (int n = 0; n < 2; ++n) acc[a][b][m][n] = (f32x4){0.f, 0.f, 0.f, 0.f};
    bf16x8 At[4][2], B0[2][2], B1[2][2];
    v8i At8[4], B08[2], B18[2];
    int sc127 = 127; asm volatile("" : "+v"(sc127));
    unsigned vC[2][2], vN[2][2];
    S.a_offs(cur, tid, vC);
    const char* cA = S.a_base(cur); const char* cB = S.b_base(cur);
    PG8_STAGE(PG8_SB(0, 0), cB, voffBh[0]); PG8_STAGE(PG8_SA(0, 0), cA, vC[0]); PG8_STAGE(PG8_SB(0, 1), cB, voffBh[1]); PG8_STAGE(PG8_SA(0, 1), cA, vC[1]);
    if (wr == 1) PG8_BAR;
    PG8_WAIT_V(4); PG8_BAR;
    PG8_STAGE(PG8_SB(1, 0), cB + kstep, voffBh[0]); PG8_STAGE(PG8_SA(1, 0), cA + kstep, vC[0]); PG8_STAGE(PG8_SB(1, 1), cB + kstep, voffBh[1]);
    PG8_WAIT_V(6); PG8_BAR;
    for (;;) {
        if (PROF) pt0 = __builtin_amdgcn_s_memrealtime();
        const bool has_next = S.next(ui + 1, nxt);
        const char* nA = has_next ? S.a_base(nxt) : cA; const char* nB = has_next ? S.b_base(nxt) : cB;
        if (Sched::GATHER_A) { if (has_next) S.a_offs(nxt, tid, vN); else { vN[0][0] = vC[0][0]; vN[0][1] = vC[0][1]; vN[1][0] = vC[1][0]; vN[1][1] = vC[1][1]; } }
        if (PROF) pt1 = __builtin_amdgcn_s_memrealtime();
#pragma unroll 1
        for (int t = 0; t < nt; t += 2) {
            const bool last = (t == nt - 2);
            const char* a1 = cA + (size_t)(t + 1) * kstep;
            const char* a2 = last ? nA : cA + (size_t)(t + 2) * kstep; const char* b2 = last ? nB : cB + (size_t)(t + 2) * kstep;
            const char* a3 = a2 + kstep; const char* b3 = b2 + kstep;
            unsigned x0[2], x1[2];
            if (Sched::GATHER_A) { x0[0] = last ? vN[0][0] : vC[0][0]; x0[1] = last ? vN[0][1] : vC[0][1]; x1[0] = last ? vN[1][0] : vC[1][0]; x1[1] = last ? vN[1][1] : vC[1][1]; }
            else { x0[0] = vC[0][0]; x0[1] = vC[0][1]; x1[0] = vC[1][0]; x1[1] = vC[1][1]; }
            PG8_LDB(B0, 0, 0); PG8_SCHED; PG8_LDA(At, 0, 0); PG8_STAGE(PG8_SA(1, 1), a1, vC[1]);
            PG8_WAIT_L(8); PG8_BAR; PG8_WAIT_L(0); PG8_MMA(0, 0, At, B0); PG8_BAR; PG8_SCHED;
            PG8_LDB(B1, 0, 1); PG8_STAGE(PG8_SB(0, 0), b2, voffBh[0]);
            PG8_BAR; PG8_WAIT_L(0); PG8_MMA(0, 1, At, B1); PG8_BAR;
            PG8_LDA(At, 0, 1); PG8_STAGE(PG8_SA(0, 0), a2, x0);
            PG8_BAR; PG8_WAIT_L(0); PG8_MMA(1, 0, At, B0); PG8_BAR; PG8_SCHED;
            PG8_STAGE(PG8_SB(0, 1), b2, voffBh[1]);
            PG8_WAIT_V(6); PG8_BAR; PG8_MMA(1, 1, At, B1); PG8_BAR;
            PG8_LDB(B0, 1, 0); PG8_SCHED; PG8_LDA(At, 1, 0); PG8_STAGE(PG8_SA(0, 1), a2, x1);
            PG8_WAIT_L(8); PG8_BAR; PG8_WAIT_L(0); PG8_MMA(0, 0, At, B0); PG8_BAR; PG8_SCHED;
            PG8_LDB(B1, 1, 1); PG8_STAGE(PG8_SB(1, 0), b3, voffBh[0]);
            PG8_BAR; PG8_WAIT_L(0); PG8_MMA(0, 1, At, B1); PG8_BAR;
            PG8_LDA(At, 1, 1); PG8_STAGE(PG8_SA(1, 0), a3, x0);
            PG8_BAR; PG8_WAIT_L(0); PG8_MMA(1, 0, At, B0); PG8_BAR; PG8_SCHED;
            PG8_STAGE(PG8_SB(1, 1), b3, voffBh[1]);
            PG8_WAIT_V(6); PG8_BAR; PG8_MMA(1, 1, At, B1); PG8_BAR;
        }
        if (PROF) pt2 = __builtin_amdgcn_s_memrealtime();
        if (F8) asm volatile("s_nop 15\n\ts_nop 15" ::: "memory");
        E(acc, cur, wr, wc, fr, fq);
        if (PROF) { asm volatile("s_waitcnt vmcnt(0)" ::: "memory"); pt3 = __builtin_amdgcn_s_memrealtime(); prof->t_next += pt1 - pt0; prof->t_loop += pt2 - pt1; prof->t_epi += pt3 - pt2; }
        if (!has_next) break;
#pragma unroll
        for (int a = 0; a < 2; ++a)
#pragma unroll
            for (int b = 0; b < 2; ++b)
#pragma unroll
                for (int m = 0; m < 4; ++m)
#pragma unroll
                    for (int n = 0; n < 2; ++n) acc[a][b][m][n] = (f32x4){0.f, 0.f, 0.f, 0.f};
        cur = nxt; cA = nA; cB = nB; ++ui;
        if (Sched::GATHER_A) { vC[0][0] = vN[0][0]; vC[0][1] = vN[0][1]; vC[1][0] = vN[1][0]; vC[1][1] = vN[1][1]; }
    }
    PG8_WAIT_V(0);
    if (wr == 0) PG8_BAR;
    PG8_BAR;
#undef PG8_SA
#undef PG8_SB
#undef PG8_STAGE
#undef PG8_LD8
#undef PG8_LDA
#undef PG8_LDB
#undef PG8_MMA
#undef PG8_WAIT_V
#undef PG8_WAIT_L
#undef PG8_BAR
#undef PG8_SCHED
}

DI float gelu_tanh(float x) { const float u = 1.5957691216f * (x + 0.044715f * x * x * x); return x * rcpf_(1.0f + expf_(-u)); }
DI float silu_f(float x) { return x * rcpf_(1.0f + expf_(-x)); }

struct EpiInProj {
    static constexpr int PERM = 1;
    bf16* P; const float* LB;
    DI void operator()(const f32x4 (&acc)[2][2][4][2], const Unit& u, int wr, int wc, int fr, int fq) const {
        const int row0 = u.pm * BM + wr * 64 + fr, col0 = u.pn * BM + wc * 32 + 8 * fq;
        const int pn = u.pn;
        const int kind = (pn == 2 || pn == 3) ? 1 : (pn >= 8 && pn < 12) ? 2 : (pn >= 12) ? 3 : 0;
        f32x4 lbv[2][2];
        { const int dir = (pn >> 1) & 1; const int cc = (pn & 1) * 256 + wc * 32 + 8 * fq;
#pragma unroll
            for (int bj = 0; bj < 2; ++bj)
#pragma unroll
                for (int n = 0; n < 2; ++n) lbv[bj][n] = *(const f32x4*)(LB + dir * 512 + cc + bj * HALF + 4 * n);
            asm volatile("" :: "v"(lbv[0][0]), "v"(lbv[0][1]), "v"(lbv[1][0]), "v"(lbv[1][1])); }
#pragma unroll
        for (int ai = 0; ai < 2; ++ai)
#pragma unroll
            for (int m = 0; m < 4; ++m) { bf16* rowp = P + (size_t)(row0 + ai * HALF + m * 16) * INC + col0;
#pragma unroll
                for (int bj = 0; bj < 2; ++bj) { f32x4 v0 = acc[ai][bj][m][0], v1 = acc[ai][bj][m][1];
                    if (kind == 1) {
#pragma unroll
                        for (int j = 0; j < 4; ++j) { v0[j] = gelu_tanh(v0[j]); v1[j] = gelu_tanh(v1[j]); } }
                    else if (kind == 2) {
#pragma unroll
                        for (int j = 0; j < 4; ++j) { const float l0 = lbv[bj][0][j], l1 = lbv[bj][1][j];
                            v0[j] = logf_(l0 + (1.0f - l0) * sigm(v0[j])); v1[j] = logf_(l1 + (1.0f - l1) * sigm(v1[j])); } }
                    else if (kind == 3) {
#pragma unroll
                        for (int j = 0; j < 4; ++j) { v0[j] = silu_f(v0[j]); v1[j] = silu_f(v1[j]); } }
                    v4u w; w.x = pk2(v0[0], v0[1]); w.y = pk2(v0[2], v0[3]); w.z = pk2(v1[0], v1[1]); w.w = pk2(v1[2], v1[3]);
                    *(v4u*)(rowp + bj * HALF) = w; } }
    }
};
struct EpiResid {
    static constexpr int PERM = 1;
    const float* x; const float* mod; bf16* X1;
    DI void operator()(const f32x4 (&acc)[2][2][4][2], const Unit& u, int wr, int wc, int fr, int fq) const {
        const int row0 = u.pm * BM + wr * 64 + fr, col0 = u.pn * BM + wc * 32 + 8 * fq;
        const int b = (u.pm * BM) >> 11;
        f32x4 gv[2][2];
#pragma unroll
        for (int bj = 0; bj < 2; ++bj)
#pragma unroll
            for (int n = 0; n < 2; ++n) gv[bj][n] = *(const f32x4*)(mod + (size_t)b * 6144 + 2048 + col0 + bj * HALF + 4 * n);
        asm volatile("" :: "v"(gv[0][0]), "v"(gv[0][1]), "v"(gv[1][0]), "v"(gv[1][1]));
#pragma unroll
        for (int ai = 0; ai < 2; ++ai)
#pragma unroll
            for (int m = 0; m < 4; ++m) { const size_t off = (size_t)(row0 + ai * HALF + m * 16) * D + col0;
#pragma unroll
                for (int bj = 0; bj < 2; ++bj) { const f32x4 x0 = *(const f32x4*)(x + off + bj * HALF), x1 = *(const f32x4*)(x + off + bj * HALF + 4);
                    const f32x4 v0 = x0 + gv[bj][0] * acc[ai][bj][m][0], v1 = x1 + gv[bj][1] * acc[ai][bj][m][1];
                    v4u w; w.x = pk2(v0[0], v0[1]); w.y = pk2(v0[2], v0[3]); w.z = pk2(v1[0], v1[1]); w.w = pk2(v1[2], v1[3]);
                    *(v4u*)(X1 + off + bj * HALF) = w; } }
    }
};
struct EpiF32 {
    static constexpr int PERM = 0;
    float* C; int ldc;
    DI void operator()(const f32x4 (&acc)[2][2][4][2], const Unit& u, int wr, int wc, int fr, int fq) const {
        const int row0 = u.pm * BM + wr * 64 + fr, col0 = u.pn * BM + wc * 32 + 4 * fq;
#pragma unroll
        for (int ai = 0; ai < 2; ++ai)
#pragma unroll
            for (int m = 0; m < 4; ++m) { float* rowp = C + (size_t)(row0 + ai * HALF + m * 16) * ldc + col0;
#pragma unroll
                for (int bj = 0; bj < 2; ++bj)
#pragma unroll
                    for (int n = 0; n < 2; ++n) *(f32x4*)(rowp + bj * HALF + n * 16) = acc[ai][bj][m][n]; }
    }
};
struct EpiSwiGLU8 {
    static constexpr int PERM = 1;
    unsigned char* ACT;
    DI void operator()(const f32x4 (&acc)[2][2][4][2], const Unit& u, int wr, int wc, int fr, int fq) const {
        const unsigned off0 = ((unsigned)u.rt * 256u + (unsigned)(wr * 64 + fr)) * (unsigned)DE + (unsigned)(u.pn * 128 + wc * 32 + 8 * fq);
#pragma unroll
        for (int ai = 0; ai < 2; ++ai)
#pragma unroll
            for (int m = 0; m < 4; ++m) {
                f32x4 a0 = acc[ai][0][m][0] * 0.03125f, a1 = acc[ai][0][m][1] * 0.03125f; const f32x4 g0 = acc[ai][1][m][0] * 0.25f, g1 = acc[ai][1][m][1] * 0.25f;
#pragma unroll
                for (int j = 0; j < 4; ++j) { a0[j] = silu_f(a0[j]) * g0[j]; a1[j] = silu_f(a1[j]) * g1[j]; }
                v2u w; w.x = pk4_f8(a0[0], a0[1], a0[2], a0[3]); w.y = pk4_f8(a1[0], a1[1], a1[2], a1[3]);
                *(v2u*)(ACT + (off0 + (unsigned)((ai * HALF + m * 16) * DE))) = w; }
    }
};
struct EpiSwiGLU {
    static constexpr int PERM = 1;
    bf16* ACT;
    DI void operator()(const f32x4 (&acc)[2][2][4][2], const Unit& u, int wr, int wc, int fr, int fq) const {
        const int row0 = wr * 64 + fr, col0 = u.pn * 128 + wc * 32 + 8 * fq;
        bf16* base = ACT + (size_t)u.rt * 256 * DE;
#pragma unroll
        for (int ai = 0; ai < 2; ++ai)
#pragma unroll
            for (int m = 0; m < 4; ++m) { bf16* rowp = base + (size_t)(row0 + ai * HALF + m * 16) * DE + col0;
                f32x4 a0 = acc[ai][0][m][0], a1 = acc[ai][0][m][1]; const f32x4 g0 = acc[ai][1][m][0], g1 = acc[ai][1][m][1];
#pragma unroll
                for (int j = 0; j < 4; ++j) { a0[j] = silu_f(a0[j]) * g0[j]; a1[j] = silu_f(a1[j]) * g1[j]; }
                v4u w; w.x = pk2(a0[0], a0[1]); w.y = pk2(a0[2], a0[3]); w.z = pk2(a1[0], a1[1]); w.w = pk2(a1[2], a1[3]);
                *(v4u*)rowp = w; }
    }
};
struct EpiScatter {
    static constexpr int PERM = 2;
    unsigned char* YE; const LAS float* gate; float oscale;
    DI void operator()(const f32x4 (&acc)[2][2][4][2], const Unit& u, int wr, int wc, int fr, int fq) const {
        const unsigned col0 = (unsigned)(u.pn * BM + wc * 64 + 16 * fq);
        float gt[2][4];
#pragma unroll
        for (int ai = 0; ai < 2; ++ai)
#pragma unroll
            for (int m = 0; m < 4; ++m) gt[ai][m] = gate[u.ord * 256 + ai * HALF + wr * 64 + m * 16 + fr] * oscale;
#pragma unroll
        for (int ai = 0; ai < 2; ++ai)
#pragma unroll
            for (int m = 0; m < 4; ++m) { const int r = ai * HALF + wr * 64 + m * 16 + fr; const float g = gt[ai][m];
                const unsigned row = (r < u.nrows) ? (unsigned)u.rt * 256u + (unsigned)r : 360448u;
                const f32x4 v0 = acc[ai][0][m][0] * g, v1 = acc[ai][0][m][1] * g, v2 = acc[ai][1][m][0] * g, v3 = acc[ai][1][m][1] * g;
                v4u w; w.x = pk4_f8(v0[0], v0[1], v0[2], v0[3]); w.y = pk4_f8(v1[0], v1[1], v1[2], v1[3]); w.z = pk4_f8(v2[0], v2[1], v2[2], v2[3]); w.w = pk4_f8(v3[0], v3[1], v3[2], v3[3]);
                *(v4u*)(YE + (row * (unsigned)D + col0)) = w; }
    }
};
}

struct Args { const float* in[26]; float* out; unsigned char* ws; int ph_lo, ph_hi; };
enum { I_X = 0, I_C, I_CTX, I_CCTX, I_ADAW, I_ADAB, I_NMIX, I_NFFN, I_NFIN, I_WIN, I_WOUT, I_CONVW, I_CONVB, I_WA, I_BA, I_WX, I_BX, I_LAM,
       I_LBL, I_HNORM, I_RW, I_RB, I_EW13, I_EW2, I_SW13, I_SW2 };

struct Frame {
    LAS unsigned char* lds;
    int tid, lane, wave, G, vcu, bx;
    const float* const* in; float* out; unsigned char* ws;
};

DI void transpose_item(const float* W, int ldw, bf16* WT, int ldo, int k0, int n0, int orow0, LAS float* scr, int lane) {
    const int sub = lane >> 3, c4 = (lane & 7) * 4;
    f32x4 v[8];
#pragma unroll
    for (int i = 0; i < 8; ++i) v[i] = __builtin_nontemporal_load((const f32x4*)(W + (size_t)(k0 + 8 * i + sub) * ldw + n0 + c4));
#pragma unroll
    for (int i = 0; i < 8; ++i) { LAS float* d = scr + (8 * i + sub) * 33 + c4; d[0] = v[i].x; d[1] = v[i].y; d[2] = v[i].z; d[3] = v[i].w; }
    LDS_WAIT(); asm volatile("" ::: "memory");
    const int c = lane & 7;
#pragma unroll
    for (int j = 0; j < 4; ++j) { const int n = (lane >> 3) + 8 * j; const LAS float* s = scr + (8 * c) * 33 + n;
        v4u o; o.x = pk2(s[0 * 33], s[1 * 33]); o.y = pk2(s[2 * 33], s[3 * 33]); o.z = pk2(s[4 * 33], s[5 * 33]); o.w = pk2(s[6 * 33], s[7 * 33]);
        *(v4u*)(WT + (size_t)(orow0 + n) * ldo + k0 + 8 * c) = o; }
    LDS_WAIT(); asm volatile("" ::: "memory");
}
DI void transpose_item8(const float* W, int ldw, unsigned char* WT, int ldo, int k0, int n0, int orow0, float scale, LAS float* scr, int lane) {
    const int sub = lane >> 3, c4 = (lane & 7) * 4;
    f32x4 v[16];
#pragma unroll
    for (int i = 0; i < 16; ++i) v[i] = __builtin_nontemporal_load((const f32x4*)(W + (size_t)(k0 + 8 * i + sub) * ldw + n0 + c4));
#pragma unroll
    for (int i = 0; i < 16; ++i) { LAS float* d = scr + (8 * i + sub) * 33 + c4; d[0] = v[i].x; d[1] = v[i].y; d[2] = v[i].z; d[3] = v[i].w; }
    LDS_WAIT(); asm volatile("" ::: "memory");
    const int c = lane & 7;
#pragma unroll
    for (int j = 0; j < 4; ++j) { const int n = (lane >> 3) + 8 * j; const LAS float* sp = scr + (16 * c) * 33 + n;
        v4u o; o.x = pk4_f8(sp[0] * scale, sp[33] * scale, sp[66] * scale, sp[99] * scale); o.y = pk4_f8(sp[132] * scale, sp[165] * scale, sp[198] * scale, sp[231] * scale);
        o.z = pk4_f8(sp[264] * scale, sp[297] * scale, sp[330] * scale, sp[363] * scale); o.w = pk4_f8(sp[396] * scale, sp[429] * scale, sp[462] * scale, sp[495] * scale);
        *(v4u*)(WT + (size_t)(orow0 + n) * ldo + k0 + 16 * c) = o; }
    LDS_WAIT(); asm volatile("" ::: "memory");
}
DI int w13_row(int n) { const int half = n >> 8, idx = n & 255; return 256 * (idx >> 7) + 128 * half + (idx & 127); }

DI void phase_prologue(const Frame& F) {
    const float* const* in = F.in; unsigned char* ws = F.ws;
    {
        LAS float* sc = (LAS float*)F.lds;
        LAS float* red = (LAS float*)(F.lds + 17 * 1024 * 4);
        for (int i = F.tid; i < 17 * 1024; i += NTHR) { const int r = i >> 10, k = i & 1023; const float v = (r < 16) ? in[I_C][r * 1024 + k] : in[I_CCTX][k]; sc[i] = v / (1.0f + __expf(-v)); }
        __syncthreads();
        const float* aw = in[I_ADAW]; float* MOD = (float*)(ws + WS_MOD);
        for (int cg = F.bx; cg < 256; cg += F.G) {
            const int kg = F.tid >> 5, cl = F.tid & 31, col = cg * 24 + cl;
            float a[17];
#pragma unroll
            for (int r = 0; r < 17; ++r) a[r] = 0.f;
            if (cl < 24) {
#pragma unroll 1
                for (int k8 = 0; k8 < 64; k8 += 16) { float w[16];
#pragma unroll
                    for (int q = 0; q < 16; ++q) w[q] = aw[(size_t)(kg * 64 + k8 + q) * 6144 + col];
#pragma unroll
                    for (int q = 0; q < 16; ++q) { const int k = kg * 64 + k8 + q;
#pragma unroll
                        for (int r = 0; r < 17; ++r) a[r] += sc[r * 1024 + k] * w[q]; } }
#pragma unroll
                for (int r = 0; r < 17; ++r) red[(kg * 17 + r) * 24 + cl] = a[r];
            }
            __syncthreads();
            if (F.tid < 17 * 24) { const int r = F.tid / 24, c2 = F.tid % 24; float s = 0.f;
                for (int g = 0; g < 16; ++g) s += red[(g * 17 + r) * 24 + c2];
                MOD[r * 6144 + cg * 24 + c2] = s + in[I_ADAB][cg * 24 + c2]; }
            __syncthreads();
        }
    }
    {
        float* LB = (float*)(ws + WS_TAB); float* SP = LB + 1024;
        const int gt = F.bx * NTHR + F.tid, GT = F.G * NTHR;
        for (int i = gt; i < 1024; i += GT) { const int d = i >> 9, c = i & 511;
            const float l0 = in[I_LBL][(d * 2 + 0) * 512 + c], l1 = in[I_LBL][(d * 2 + 1) * 512 + c];
            LB[i] = 1.0f / (1.0f + expf(l1 - l0));
            SP[i] = log1pf(expf(-in[I_LAM][i])); }
        bf16* WGT = (bf16*)(ws + WS_WGT);
        for (int i = gt; i < 2 * 2 * 8 * 64 * 64; i += GT) { const int ii = i & 63, j = (i >> 6) & 63, h = (i >> 12) & 7, g = (i >> 15) & 1, d = i >> 16;
            const float* src = g ? in[I_WX] : in[I_WA];
            WGT[i] = f2bf(src[((size_t)(d * 8 + h) * 64 + ii) * 64 + j]); }
    }
    {
        LAS float* scr = (LAS float*)(F.lds + F.wave * 16896);
        const int gw = F.vcu * NWAVES + F.wave, NGW = F.G * NWAVES;
        constexpr int IT_WIN = 16 * 112, IT_WOUT = 16 * 32, IT_WR = 16 * 8, IT_SW13 = 8 * 16, IT_SW2 = 2 * 32;
        LAS float* scr8 = (LAS float*)(F.lds + F.wave * 16896);
        constexpr int NIT = IT_WIN + IT_WOUT + IT_WR + IT_SW13 + IT_SW2;
        for (int it = gw; it < NIT; it += NGW) {
            int r = it;
            if (r < IT_WIN) { const int kb = r / 112, nb = r % 112; transpose_item(in[I_WIN], INC, (bf16*)(ws + WS_WIN), 1024, kb * 64, nb * 32, nb * 32, scr, F.lane); continue; } r -= IT_WIN;
            if (r < IT_WOUT) { const int kb = r / 32, nb = r % 32; transpose_item(in[I_WOUT], 1024, (bf16*)(ws + WS_WOUT), 1024, kb * 64, nb * 32, nb * 32, scr, F.lane); continue; } r -= IT_WOUT;
            if (r < IT_WR) { const int kb = r / 8, nb = r % 8; transpose_item(in[I_RW], 256, (bf16*)(ws + WS_WR), 1024, kb * 64, nb * 32, nb * 32, scr, F.lane); continue; } r -= IT_WR;
            if (r < IT_SW13) { const int kb = r / 16, nb = r % 16; transpose_item8(in[I_SW13], 512, ws + WS_SW13, 1024, kb * 128, nb * 32, w13_row(nb * 32), 32.0f, scr8, F.lane); continue; } r -= IT_SW13;
            { const int kb = r / 32, nb = r % 32; transpose_item8(in[I_SW2], 1024, ws + WS_SW2, 256, kb * 128, nb * 32, nb * 32, 16.0f, scr8, F.lane); }
        }
    }
}
constexpr int CV_STR = 129, CV_B = 128 * CV_STR * 4, CV_STR2 = 144;
static_assert(CV_B + 128 * CV_STR2 <= LDS_MISC, "convert lds");
DI void convert_experts(const Frame& F, const unsigned* stop_ctr, unsigned stop_val) {
    const float* const* in = F.in; unsigned char* ws = F.ws;
    LAS float* scr = (LAS float*)F.lds; LAS unsigned char* img = F.lds + CV_B;
    volatile LAS int* slot = (volatile LAS int*)(F.lds + LDS_MISC + 48);
    unsigned* qhead = (unsigned*)(ws + WS_CTL) + CW_CONVQ;
    constexpr int NB13 = 256 * 32, NB2 = 256 * 16;
    auto decode = [&](int blk, const float*& src, int& ldw, unsigned char*& dst, int& ldo, int& orow0, float& scale) {
        if (blk < NB13) { const int e = blk >> 5, q = blk & 31, nb = q >> 3, kb = q & 7;
            src = in[I_EW13] + (size_t)e * 1024 * 512 + (size_t)(kb * 128) * 512 + nb * 128; ldw = 512;
            dst = ws + WS_EW13 + (size_t)e * 512 * 1024 + kb * 128; ldo = 1024; orow0 = w13_row(nb * 128); scale = 32.0f; }
        else { const int r = blk - NB13, e = r >> 4, q = r & 15, nb = q >> 1, kb = q & 1;
            src = in[I_EW2] + (size_t)e * 256 * 1024 + (size_t)(kb * 128) * 1024 + nb * 128; ldw = 1024;
            dst = ws + WS_EW2 + (size_t)e * 1024 * 256 + kb * 128; ldo = 256; orow0 = nb * 128; scale = 16.0f; } };
    auto claim = [&]() -> int { __syncthreads();
        if (F.tid == 0) { int v = 0x7fffffff;
            if (!stop_ctr || __hip_atomic_load(stop_ctr, __ATOMIC_RELAXED, __HIP_MEMORY_SCOPE_AGENT) < stop_val) v = (int)__hip_atomic_fetch_add(qhead, 1u, __ATOMIC_RELAXED, __HIP_MEMORY_SCOPE_AGENT);
            slot[0] = v; }
        __syncthreads(); return slot[0]; };
    f32x4 v[8];
    int blk = claim();
    const float* src = nullptr; int ldw = 0; unsigned char* dst = nullptr; int ldo = 0, orow0 = 0; float scale = 1.f;
    if (blk < NB13 + NB2) { decode(blk, src, ldw, dst, ldo, orow0, scale);
#pragma unroll
        for (int i = 0; i < 8; ++i) { const int p = F.tid + NTHR * i; v[i] = *(const f32x4*)(src + (size_t)(p >> 5) * ldw + (p & 31) * 4); } }
    while (blk < NB13 + NB2) {
#pragma unroll
        for (int i = 0; i < 8; ++i) { const int p = F.tid + NTHR * i; LAS float* d = scr + (p >> 5) * CV_STR + (p & 31) * 4; d[0] = v[i].x; d[1] = v[i].y; d[2] = v[i].z; d[3] = v[i].w; }
        unsigned char* cdst = dst; const int cldo = ldo, corow0 = orow0; const float cscale = scale;
        blk = claim();
        if (blk < NB13 + NB2) { decode(blk, src, ldw, dst, ldo, orow0, scale);
#pragma unroll
            for (int i = 0; i < 8; ++i) { const int p = F.tid + NTHR * i; v[i] = *(const f32x4*)(src + (size_t)(p >> 5) * ldw + (p & 31) * 4); } }
#pragma unroll
        for (int i = 0; i < 2; ++i) { const int n = F.tid & 127, kc = ((F.tid >> 7) + 4 * i) * 16;
            const LAS float* sp = scr + kc * CV_STR + n;
            v4u o; o.x = pk4_f8(sp[0] * cscale, sp[CV_STR] * cscale, sp[2 * CV_STR] * cscale, sp[3 * CV_STR] * cscale);
            o.y = pk4_f8(sp[4 * CV_STR] * cscale, sp[5 * CV_STR] * cscale, sp[6 * CV_STR] * cscale, sp[7 * CV_STR] * cscale);
            o.z = pk4_f8(sp[8 * CV_STR] * cscale, sp[9 * CV_STR] * cscale, sp[10 * CV_STR] * cscale, sp[11 * CV_STR] * cscale);
            o.w = pk4_f8(sp[12 * CV_STR] * cscale, sp[13 * CV_STR] * cscale, sp[14 * CV_STR] * cscale, sp[15 * CV_STR] * cscale);
            *(LAS v4u*)(img + n * CV_STR2 + kc) = o; }
        __syncthreads();
#pragma unroll
        for (int i = 0; i < 2; ++i) { const int p = F.tid + NTHR * i; const int n = p >> 3, pc = (p & 7) * 16;
            *(v4u*)(cdst + (size_t)(corow0 + n) * cldo + pc) = *(const LAS v4u*)(img + n * CV_STR2 + pc); }
    }
    __syncthreads();
}

DI void phase_norm_rows(const Frame& F, int mode) {
    const float* MOD = (const float*)(F.ws + WS_MOD);
    const int gw = F.bx * NWAVES + F.wave, NGW = F.G * NWAVES;
    const int nrows = mode == 0 ? MTOT : NTOK;
    const float* gain = mode == 0 ? F.in[I_NMIX] : F.in[I_NFFN];
    bf16* dst = (bf16*)(F.ws + (mode == 0 ? WS_HX : WS_HX2));
    const int sh_off = mode == 0 ? 0 : 3072, sc_off = mode == 0 ? 1024 : 4096;
    const int per = (nrows + NGW - 1) / NGW, r0 = gw * per, r1 = (r0 + per < nrows) ? r0 + per : nrows;
    f32x4 gn[4];
#pragma unroll
    for (int j = 0; j < 4; ++j) gn[j] = *(const f32x4*)(gain + 4 * F.lane + 256 * j);
    auto rowsrc = [&](int m) -> const float* {
        return (m < NTOK) ? F.in[I_X] + (size_t)m * D : F.in[I_CTX] + (size_t)(m - NTOK) * D; };
    const bf16* X1b = (const bf16*)(F.ws + WS_X1);
    auto ldrow = [&](int m, f32x4 (&v)[4]) {
        if (mode == 0) {
#pragma unroll
            for (int j = 0; j < 4; ++j) v[j] = *(const f32x4*)(rowsrc(m) + 4 * F.lane + 256 * j); }
        else {
#pragma unroll
            for (int j = 0; j < 4; ++j) { const v2u t = *(const v2u*)(X1b + (size_t)m * D + 4 * F.lane + 256 * j); v[j] = (f32x4){bflo(t.x), bfhi(t.x), bflo(t.y), bfhi(t.y)}; } } };
    f32x4 va[4], vb[4], ga[4], sb4[4]; int cur_mr = -1;
#pragma unroll
    for (int j = 0; j < 4; ++j) { ga[j] = gn[j]; sb4[j] = gn[j]; }
    if (r0 < r1) { ldrow(r0, va); ldrow((r0 + 1 < r1) ? r0 + 1 : r0, vb); }
#pragma unroll 1
    for (int m = r0; m < r1; m += 2) {
        f32x4 ca[4], cb[4];
#pragma unroll
        for (int j = 0; j < 4; ++j) { ca[j] = va[j]; cb[j] = vb[j]; }
        const bool hasb = (m + 1 < r1);
        { const int na = (m + 2 < r1) ? m + 2 : m, nb = (m + 3 < r1) ? m + 3 : na; ldrow(na, va); ldrow(nb, vb); }
        float sa = 0.f, sb = 0.f;
#pragma unroll
        for (int j = 0; j < 4; ++j) { sa += (ca[j].x * ca[j].x + ca[j].y * ca[j].y) + (ca[j].z * ca[j].z + ca[j].w * ca[j].w); sb += (cb[j].x * cb[j].x + cb[j].y * cb[j].y) + (cb[j].z * cb[j].z + cb[j].w * cb[j].w); }
        const float rsa = rsqrtf(wave_sum_fast(sa) * (1.0f / D) + EPS), rsb = rsqrtf(wave_sum_fast(sb) * (1.0f / D) + EPS);
#pragma unroll
        for (int q = 0; q < 2; ++q) {
            if (q == 1 && !hasb) break;
            const int mm = m + q; const float rs = q ? rsb : rsa;
            const int mr = (mode == 0 && mm >= NTOK) ? 16 : (mm >> 11);
            if (mr != cur_mr) { cur_mr = mr;
#pragma unroll
                for (int j = 0; j < 4; ++j) { const int c = 4 * F.lane + 256 * j;
                    ga[j] = gn[j] * (*(const f32x4*)(MOD + mr * 6144 + sc_off + c) + 1.0f); sb4[j] = *(const f32x4*)(MOD + mr * 6144 + sh_off + c); } }
#pragma unroll
            for (int j = 0; j < 4; ++j) { const int c = 4 * F.lane + 256 * j;
                const f32x4 v = q ? cb[j] : ca[j];
                const f32x4 y = (v * rs) * ga[j] + sb4[j];
                v2u w; w.x = pk2(y.x, y.y); w.y = pk2(y.z, y.w);
                *(v2u*)(dst + (size_t)mm * D + c) = w;
                if (mode == 1) *(unsigned*)(F.ws + WS_HX2F + (size_t)mm * D + c) = pk4_f8(y.x, y.y, y.z, y.w); }
        }
    }
}

constexpr int LT_STR = 520;
constexpr int L_RT = 0;
constexpr int L_GT = 69888;
static_assert(L_GT + 64 * LT_STR * 2 <= LDS_MISC, "lru lds");
template <int MODE> DI void lru_tile(const Frame& F, int b, int s) {
    const bf16* P = (const bf16*)(F.ws + WS_P);
    const int h = F.wave, fr = F.lane & 15, fq = F.lane >> 4;
    int prow0, L, t0;
    if (s < 4) { prow0 = NTOK + b * CTXL + 64 * s; L = CTXL; t0 = 64 * s; } else { prow0 = b * SEQ + 64 * (s - 4); L = SEQ; t0 = 64 * (s - 4); }
    LAS bf16* RT = (LAS bf16*)(F.lds + L_RT); LAS bf16* GT = (LAS bf16*)(F.lds + L_GT);
#pragma unroll
    for (int it = 0; it < 9; ++it) { const int p = F.tid + it * NTHR;
        if (p < 67 * 64) { const int row = p >> 6, pc = p & 63, ts = t0 + row - 1;
            v4u v = {0u, 0u, 0u, 0u};
            if (ts >= 0 && ts < L) v = *(const v4u*)(P + (size_t)(prow0 + row - 1) * INC + 8 * pc);
            *(LAS v4u*)(RT + row * LT_STR + 8 * pc) = v; } }
    __syncthreads();
    bf16x8 Af[4][2];
#pragma unroll
    for (int ks = 0; ks < 2; ++ks) {
        const int c0 = 64 * h + 32 * ks + 8 * fq;
        float cw[4][8], cb[8];
#pragma unroll
        for (int k = 0; k < 4; ++k) { const f32x4 w0 = *(const f32x4*)(F.in[I_CONVW] + k * 512 + c0), w1 = *(const f32x4*)(F.in[I_CONVW] + k * 512 + c0 + 4);
            cw[k][0] = w0.x; cw[k][1] = w0.y; cw[k][2] = w0.z; cw[k][3] = w0.w; cw[k][4] = w1.x; cw[k][5] = w1.y; cw[k][6] = w1.z; cw[k][7] = w1.w; }
        { const f32x4 w0 = *(const f32x4*)(F.in[I_CONVB] + c0), w1 = *(const f32x4*)(F.in[I_CONVB] + c0 + 4);
            cb[0] = w0.x; cb[1] = w0.y; cb[2] = w0.z; cb[3] = w0.w; cb[4] = w1.x; cb[5] = w1.y; cb[6] = w1.z; cb[7] = w1.w; }
        const LAS bf16* rbase = RT + fr * LT_STR + c0;
#pragma unroll
        for (int tt = 0; tt < 4; ++tt) {
            float u[8];
#pragma unroll
            for (int j = 0; j < 8; ++j) u[j] = cb[j];
#pragma unroll
            for (int k = 0; k < 4; ++k) { const v4u r8 = *(const LAS v4u*)(rbase + (16 * tt + k) * LT_STR);
                u[0] += cw[k][0] * bflo(r8.x); u[1] += cw[k][1] * bfhi(r8.x); u[2] += cw[k][2] * bflo(r8.y); u[3] += cw[k][3] * bfhi(r8.y);
                u[4] += cw[k][4] * bflo(r8.z); u[5] += cw[k][5] * bfhi(r8.z); u[6] += cw[k][6] * bflo(r8.w); u[7] += cw[k][7] * bfhi(r8.w); }
            v4u w; w.x = pk2(u[0], u[1]); w.y = pk2(u[2], u[3]); w.z = pk2(u[4], u[5]); w.w = pk2(u[6], u[7]);
            Af[tt][ks] = __builtin_bit_cast(bf16x8, w);
        }
    }
    const bf16* WGT = (const bf16*)(F.ws + WS_WGT);
    const float* SP = (const float*)(F.ws + WS_TAB) + 1024;
    LAS bf16* HL = RT;
    LAS bf16* hlb = HL + (4 * fq) * LT_STR + 64 * h + fr;
    LAS bf16* gtb = GT + (4 * fq) * LT_STR + 64 * h + fr;
#pragma unroll 1
    for (int dir = 0; dir < 2; ++dir) {
#pragma unroll 1
        for (int nt = 0; nt < 4; ++nt) {
            const int cj = 64 * h + 16 * nt + fr;
            bf16x8 Ba[2], Bx[2], Id[2];
#pragma unroll
            for (int ks = 0; ks < 2; ++ks) {
                Ba[ks] = *(const bf16x8*)(WGT + ((size_t)((dir * 2 + 0) * 8 + h) * 64 + 16 * nt + fr) * 64 + 32 * ks + 8 * fq);
                Bx[ks] = *(const bf16x8*)(WGT + ((size_t)((dir * 2 + 1) * 8 + h) * 64 + 16 * nt + fr) * 64 + 32 * ks + 8 * fq);
#pragma unroll
                for (int jj = 0; jj < 8; ++jj) Id[ks][jj] = (32 * ks + 8 * fq + jj == 16 * nt + fr) ? (short)0x3F80 : (short)0;
            }
            const float ba = F.in[I_BA][dir * 512 + cj], bx = F.in[I_BX][dir * 512 + cj], sp = SP[dir * 512 + cj];
            float cin = 0.f, ptot = 1.f;
#pragma unroll
            for (int tti = 0; tti < 4; ++tti) {
                const int tt = dir ? 3 - tti : tti;
                const bf16x8 A0 = dir ? Af[3 - tti][0] : Af[tti][0], A1 = dir ? Af[3 - tti][1] : Af[tti][1];
                f32x4 pa = {0.f, 0.f, 0.f, 0.f}, px = {0.f, 0.f, 0.f, 0.f}, uc = {0.f, 0.f, 0.f, 0.f};
                pa = __builtin_amdgcn_mfma_f32_16x16x32_bf16(A0, Ba[0], pa, 0, 0, 0); pa = __builtin_amdgcn_mfma_f32_16x16x32_bf16(A1, Ba[1], pa, 0, 0, 0);
                px = __builtin_amdgcn_mfma_f32_16x16x32_bf16(A0, Bx[0], px, 0, 0, 0); px = __builtin_amdgcn_mfma_f32_16x16x32_bf16(A1, Bx[1], px, 0, 0, 0);
                uc = __builtin_amdgcn_mfma_f32_16x16x32_bf16(A0, Id[0], uc, 0, 0, 0); uc = __builtin_amdgcn_mfma_f32_16x16x32_bf16(A1, Id[1], uc, 0, 0, 0);
                float av[4], bv[4];
#pragma unroll
                for (int ri = 0; ri < 4; ++ri) { const float pav = dir ? pa[3 - ri] : pa[ri], pxv = dir ? px[3 - ri] : px[ri], ucv = dir ? uc[3 - ri] : uc[ri];
                    const float rg = sigm(pav + ba), ig = sigm(pxv + bx);
                    const float a = expf_(-8.0f * rg * sp); av[ri] = a; bv[ri] = __builtin_amdgcn_sqrtf(fmaxf(1.0f - a * a, 0.f)) * ig * ucv; }
                float pl = 1.f, hl = 0.f;
#pragma unroll
                for (int ri = 0; ri < 4; ++ri) { hl = av[ri] * hl + bv[ri]; pl *= av[ri]; }
                float pg[4], hg[4];
#pragma unroll
                for (int gi = 0; gi < 4; ++gi) { const int g = dir ? 3 - gi : gi; pg[gi] = __shfl(pl, fr + 16 * g); hg[gi] = __shfl(hl, fr + 16 * g); }
                const int myg = dir ? 3 - fq : fq;
                float mycin = cin, run = cin, myp = ptot, prun = ptot;
#pragma unroll
                for (int gi = 0; gi < 4; ++gi) { if (gi == myg) { mycin = run; myp = prun; } run = pg[gi] * run + hg[gi]; prun *= pg[gi]; }
                if (MODE == 1) { float hc = mycin, pc = myp;
#pragma unroll
                    for (int ri = 0; ri < 4; ++ri) { const int r = dir ? 3 - ri : ri; hc = av[ri] * hc + bv[ri]; pc *= av[ri];
                        const int o = (16 * tt + r) * LT_STR + 16 * nt;
                        hlb[o] = f2bf(dir == 0 ? hc : bf2f(hlb[o]) + hc); gtb[o] = f2bf(pc); } }
                ptot = prun;
                cin = run;
            }
            if (fq == 0) { const size_t o = ((size_t)(dir * NB + b) * NSEQT + s) * 512 + cj;
                ((float*)(F.ws + WS_SUMA))[o] = ptot; ((float*)(F.ws + WS_SUMH))[o] = cin; }
        }
        if (MODE == 1) {
            __syncthreads();
            bf16* PD = (bf16*)(F.ws + (dir ? WS_LPB : WS_LPF)); bf16* HSg = (bf16*)(F.ws + WS_LHS);
#pragma unroll
            for (int it = 0; it < 8; ++it) { const int p = F.tid + it * NTHR; const int row = p >> 6, pc = p & 63;
                *(v4u*)(PD + (size_t)(prow0 + row) * 512 + 8 * pc) = *(const LAS v4u*)(GT + row * LT_STR + 8 * pc);
                if (dir == 1) *(v4u*)(HSg + (size_t)(prow0 + row) * 512 + 8 * pc) = *(const LAS v4u*)(HL + row * LT_STR + 8 * pc); }
            __syncthreads();
        }
    }
    __syncthreads();
}
DI void phase_lru_pass1(const Frame& F) {
    unsigned* done = (unsigned*)(F.ws + WS_CTL) + CW_LRUDONE;
    const int NL = (F.G >= 256) ? 192 : F.G;
    if (F.bx < NL) {
        for (int it = F.bx; it < NB * NSEQT; it += NL) { { const int bb = it / NSEQT, ss = it % NSEQT; if (ss < 4) lru_tile<0>(F, bb, ss); else lru_tile<1>(F, bb, ss); }
            if (F.tid == 0) __hip_atomic_fetch_add(done, 1u, __ATOMIC_RELAXED, __HIP_MEMORY_SCOPE_AGENT); }
    }
    if (F.G >= 256) convert_experts(F, done, (unsigned)(NB * NSEQT));
}
DI void phase_lru_carry(const Frame& F) {
    if (F.wave != 0) return;
    const float* SA = (const float*)(F.ws + WS_SUMA); const float* SH = (const float*)(F.ws + WS_SUMH); float* CI = (float*)(F.ws + WS_CIN);
    for (int id = F.bx * 64 + F.lane; id < 2 * NB * 512; id += F.G * 64) {
        const int dir = id >> 13, b = (id >> 9) & 15, c = id & 511;
        float x = 0.f; const size_t o0 = (size_t)(dir * NB + b) * NSEQT * 512 + c;
#pragma unroll
        for (int hf = 0; hf < 2; ++hf) {
            float av[18], hv[18];
#pragma unroll
            for (int q = 0; q < 18; ++q) { const int st = 18 * hf + q, s = dir ? (st < 4 ? 3 - st : 39 - st) : st; av[q] = SA[o0 + (size_t)s * 512]; hv[q] = SH[o0 + (size_t)s * 512]; }
#pragma unroll
            for (int q = 0; q < 18; ++q) { const int st = 18 * hf + q, s = dir ? (st < 4 ? 3 - st : 39 - st) : st; CI[o0 + (size_t)s * 512] = x; x = av[q] * x + hv[q]; }
        }
    }
}

constexpr int HS = 144, SCS = 40;
constexpr int H_Q = 0, H_LF = H_Q + 32 * HS * 2, H_V = H_LF + 32 * HS * 2, H_QT = H_V + 32 * HS * 2, H_KT = H_QT + 32 * HS * 2, H_KH = H_KT + 32 * HS * 2,
              H_SC = H_KH + 32 * HS * 2, H_DEC = H_SC + 32 * SCS * 2, H_SET = H_DEC + 512;
static_assert(2 * H_SET <= RING_BYTES, "hgrn lds");
typedef short s16x4 __attribute__((ext_vector_type(4)));
DI bf16x8 tr_frag(const LAS bf16* tile, int c0, int lane) {
    const int g = lane >> 4, q = (lane & 15) >> 2, p = lane & 3;
    const LAS bf16* a = tile + (8 * g + q) * HS + c0 + 4 * p;
    const s16x4 lo = __builtin_amdgcn_ds_read_tr16_b64_v4i16((LAS s16x4*)a), hi = __builtin_amdgcn_ds_read_tr16_b64_v4i16((LAS s16x4*)(a + 4 * HS));
    bf16x8 r; r[0] = lo[0]; r[1] = lo[1]; r[2] = lo[2]; r[3] = lo[3]; r[4] = hi[0]; r[5] = hi[1]; r[6] = hi[2]; r[7] = hi[3]; return r;
}
constexpr int P_QR = 0, P_LR = P_QR + 2 * 9216, P_VR = P_LR + 2 * 9216, P_QT = P_VR + 4 * 9216, P_KT = P_QT + 2 * 9216, P_KH = P_KT + 2 * 9216, P_SC = P_KH + 2 * 9216, P_DEC = P_SC + 2 * 2560, P_END = P_DEC + 2 * 512;
static_assert(P_END <= LDS_MISC, "hgrn pipelined lds");
DI void hgrn_chain2(const Frame& F, int item) {
    const int b = item >> 3, h = (item >> 1) & 3, dir = item & 1;
    const bf16* P = (const bf16*)(F.ws + WS_P);
    bf16* O = (bf16*)(F.ws + (dir ? WS_OB : WS_OF));
    const int w = F.wave, lane = F.lane, fr = lane & 15, g = lane >> 4;
    const int li = F.tid >> 4, lp = F.tid & 15;
    auto prow = [&](int c, int i) -> size_t {
        const int ii = dir ? 31 - i : i;
        if (c < 8) { const int cc = dir ? 7 - c : c; return (size_t)NTOK + b * CTXL + 32 * cc + ii; }
        const int col = dir ? 63 - (c - 8) : (c - 8); return (size_t)b * SEQ + ii * 64 + col; };
    const size_t coff = 128 * h + 8 * lp;
    v4u rqA, rlA, rvA, rqB, rlB, rvB;
    { const bf16* rp = P + prow(0, li) * INC + coff; rqA = *(const v4u*)(rp + 1024); rvA = *(const v4u*)(rp + 1536); rlA = *(const v4u*)(rp + 2048 + 512 * dir); }
    { const bf16* rp = P + prow(1, li) * INC + coff; rqB = *(const v4u*)(rp + 1024); rvB = *(const v4u*)(rp + 1536); rlB = *(const v4u*)(rp + 2048 + 512 * dir); }
    LAS unsigned char* L = F.lds;
#define HG2_W(k, U, RQ, RL, RV) do { \
        const int i = (k) - 2, wch = (k), pch = (k) - 1; (void)i; (void)pch; \
        if (wch < 72) {   \
            *(LAS v4u*)((LAS bf16*)(L + P_QR + ((U) & 1) * 9216) + li * HS + 8 * lp) = RQ; *(LAS v4u*)((LAS bf16*)(L + P_LR + ((U) & 1) * 9216) + li * HS + 8 * lp) = RL; \
            *(LAS v4u*)((LAS bf16*)(L + P_VR + (U) * 9216) + li * HS + 8 * lp) = RV; \
            if (wch + 2 < 72) { const bf16* rp = P + prow(wch + 2, li) * INC + coff; RQ = *(const v4u*)(rp + 1024); RV = *(const v4u*)(rp + 1536); RL = *(const v4u*)(rp + 2048 + 512 * dir); } } \
    } while (0)
#define HG2_PREP(k, U) do { \
        const int i = (k) - 2, wch = (k), pch = (k) - 1; (void)i; (void)pch; \
        const int pw = w - 4; \
            if (pch >= 0 && pch < 72) {   \
                const LAS bf16* Qr = (const LAS bf16*)(L + P_QR + (((U) + 1) & 1) * 9216); const LAS bf16* LFr = (const LAS bf16*)(L + P_LR + (((U) + 1) & 1) * 9216); \
                LAS bf16* QT = (LAS bf16*)(L + P_QT + (((U) + 1) & 1) * 9216); LAS bf16* KT = (LAS bf16*)(L + P_KT + (((U) + 1) & 1) * 9216); LAS bf16* KH = (LAS bf16*)(L + P_KH + (((U) + 1) & 1) * 9216); \
                LAS float* DEC = (LAS float*)(L + P_DEC + (((U) + 1) & 1) * 512); \
                _Pragma("unroll") for (int db = 0; db < 2; ++db) { const int dblk = 16 * (2 * pw + db); \
                    const bf16x8 Al = tr_frag(LFr, dblk, lane); \
                    f32x4 Gm[2]; \
                    _Pragma("unroll") for (int it = 0; it < 2; ++it) Gm[it] = __builtin_amdgcn_mfma_f32_16x16x32_bf16(Al, Tri[it], (f32x4){0.f, 0.f, 0.f, 0.f}, 0, 0, 0); \
                    f32x4 dec; \
                    _Pragma("unroll") for (int r = 0; r < 4; ++r) dec[r] = expf_(__shfl(Gm[1][r], (lane & 48) | 15)); \
                    if (fr == 0) *(LAS f32x4*)(DEC + dblk + 4 * g) = dec; \
                    _Pragma("unroll") for (int it = 0; it < 2; ++it) { const int ii = 16 * it + fr, d0 = dblk + 4 * g; \
                        const v2u q4 = *(const LAS v2u*)(Qr + ii * HS + d0), l4 = *(const LAS v2u*)(LFr + ii * HS + d0); \
                        const float qv[4] = {bflo(q4.x), bfhi(q4.x), bflo(q4.y), bfhi(q4.y)}, lv[4] = {bflo(l4.x), bfhi(l4.x), bflo(l4.y), bfhi(l4.y)}; \
                        float qt[4], kt[4], kh[4]; \
                        _Pragma("unroll") for (int r = 0; r < 4; ++r) { const float eg = expf_(Gm[it][r]), ieg = rcpf_(eg), kk = 1.0f - expf_(lv[r]); qt[r] = qv[r] * eg; kt[r] = kk * ieg; kh[r] = kk * dec[r] * ieg; } \
                        *(LAS v2u*)(QT + ii * HS + d0) = (v2u){pk2(qt[0], qt[1]), pk2(qt[2], qt[3])}; \
                        *(LAS v2u*)(KT + ii * HS + d0) = (v2u){pk2(kt[0], kt[1]), pk2(kt[2], kt[3])}; \
                        *(LAS v2u*)(KH + ii * HS + d0) = (v2u){pk2(kh[0], kh[1]), pk2(kh[2], kh[3])}; } } } \
            if (i >= 8 && i < 72) {   \
                const LAS bf16* QT = (const LAS bf16*)(L + P_QT + ((U) & 1) * 9216); const LAS bf16* KT = (const LAS bf16*)(L + P_KT + ((U) & 1) * 9216); LAS bf16* SC = (LAS bf16*)(L + P_SC + ((U) & 1) * 2560); \
                const int it = pw >> 1, jt = pw & 1; f32x4 sc = {0.f, 0.f, 0.f, 0.f}; \
                _Pragma("unroll") for (int ks = 0; ks < 4; ++ks) { const bf16x8 ak = *(const LAS bf16x8*)(KT + (16 * jt + fr) * HS + 32 * ks + 8 * g), bq = *(const LAS bf16x8*)(QT + (16 * it + fr) * HS + 32 * ks + 8 * g); \
                    sc = __builtin_amdgcn_mfma_f32_16x16x32_bf16(ak, bq, sc, 0, 0, 0); } \
                const int ii = 16 * it + fr, j0 = 16 * jt + 4 * g; \
                *(LAS v2u*)(SC + ii * SCS + j0) = (v2u){pk2(j0 <= ii ? sc[0] : 0.f, j0 + 1 <= ii ? sc[1] : 0.f), pk2(j0 + 2 <= ii ? sc[2] : 0.f, j0 + 3 <= ii ? sc[3] : 0.f)}; } \
    } while (0)
#define HG2_CORE(k, U) do { \
        const int i = (k) - 2, wch = (k), pch = (k) - 1; (void)i; (void)pch; \
            f32x4 onew[2][2]; \
            _Pragma("unroll") for (int eb = 0; eb < 2; ++eb) { onew[eb][0] = (f32x4){0.f, 0.f, 0.f, 0.f}; onew[eb][1] = (f32x4){0.f, 0.f, 0.f, 0.f}; } \
            bf16x8 Vf[2]; _Pragma("unroll") for (int eb = 0; eb < 2; ++eb) Vf[eb] = Vprev[eb]; \
            if (i >= 0 && i < 72) {   \
                const LAS bf16* QT = (const LAS bf16*)(L + P_QT + ((U) & 1) * 9216); const LAS bf16* KH = (const LAS bf16*)(L + P_KH + ((U) & 1) * 9216); \
                const LAS float* DEC = (const LAS float*)(L + P_DEC + ((U) & 1) * 512); const LAS bf16* Vr = (const LAS bf16*)(L + P_VR + (((U) + 2) & 3) * 9216); \
                if (i >= 8) {   \
                    _Pragma("unroll") for (int ks = 0; ks < 4; ++ks) { bf16x8 Bq[2]; \
                        _Pragma("unroll") for (int it = 0; it < 2; ++it) { const v2u a0 = *(const LAS v2u*)(QT + (16 * it + fr) * HS + 32 * ks + 4 * g), a1 = *(const LAS v2u*)(QT + (16 * it + fr) * HS + 32 * ks + 16 + 4 * g); \
                            v4u bv; bv.x = a0.x; bv.y = a0.y; bv.z = a1.x; bv.w = a1.y; Bq[it] = __builtin_bit_cast(bf16x8, bv); } \
                        _Pragma("unroll") for (int eb = 0; eb < 2; ++eb) { \
                            v4u sb; sb.x = pk2(S[eb][2 * ks][0], S[eb][2 * ks][1]); sb.y = pk2(S[eb][2 * ks][2], S[eb][2 * ks][3]); sb.z = pk2(S[eb][2 * ks + 1][0], S[eb][2 * ks + 1][1]); sb.w = pk2(S[eb][2 * ks + 1][2], S[eb][2 * ks + 1][3]); \
                            const bf16x8 As = __builtin_bit_cast(bf16x8, sb); \
                            _Pragma("unroll") for (int it = 0; it < 2; ++it) onew[eb][it] = __builtin_amdgcn_mfma_f32_16x16x32_bf16(As, Bq[it], onew[eb][it], 0, 0, 0); } } } \
                  \
                _Pragma("unroll") for (int eb = 0; eb < 2; ++eb) Vf[eb] = tr_frag(Vr, 16 * (2 * w + eb), lane); \
                _Pragma("unroll") for (int t = 0; t < 8; ++t) { const f32x4 dv = *(const LAS f32x4*)(DEC + 16 * t + 4 * g); const bf16x8 Kf = tr_frag(KH, 16 * t, lane); \
                    _Pragma("unroll") for (int eb = 0; eb < 2; ++eb) S[eb][t] = __builtin_amdgcn_mfma_f32_16x16x32_bf16(Kf, Vf[eb], S[eb][t] * dv, 0, 0, 0); } } \
            if (i - 1 >= 8 && i - 1 < 72) {   \
                const LAS bf16* SC = (const LAS bf16*)(L + P_SC + (((U) + 1) & 1) * 2560); \
                const int col = dir ? 63 - (i - 9) : (i - 9); \
                _Pragma("unroll") for (int it = 0; it < 2; ++it) { const bf16x8 bs = *(const LAS bf16x8*)(SC + (16 * it + fr) * SCS + 8 * g); \
                    const int ip = 16 * it + fr, ii = dir ? 31 - ip : ip; \
                    _Pragma("unroll") for (int eb = 0; eb < 2; ++eb) { const f32x4 o = __builtin_amdgcn_mfma_f32_16x16x32_bf16(Vprev[eb], bs, oprev[eb][it], 0, 0, 0); \
                        *(v2u*)(O + ((size_t)b * SEQ + ii * 64 + col) * 512 + 128 * h + 16 * (2 * w + eb) + 4 * g) = (v2u){pk2(o[0], o[1]), pk2(o[2], o[3])}; } } } \
            _Pragma("unroll") for (int eb = 0; eb < 2; ++eb) { oprev[eb][0] = onew[eb][0]; oprev[eb][1] = onew[eb][1]; Vprev[eb] = Vf[eb]; } \
    } while (0)
    if (w >= 4) {
        bf16x8 Tri[2];
#pragma unroll
        for (int it = 0; it < 2; ++it)
#pragma unroll
            for (int jj = 0; jj < 8; ++jj) Tri[it][jj] = (8 * g + jj <= 16 * it + fr) ? (short)0x3F80 : (short)0;
#pragma unroll 1
        for (int k = 0; k < 76; k += 4) {
            HG2_W(k, 0, rqA, rlA, rvA); HG2_PREP(k, 0); __syncthreads();
            HG2_W(k + 1, 1, rqB, rlB, rvB); HG2_PREP(k + 1, 1); __syncthreads();
            HG2_W(k + 2, 2, rqA, rlA, rvA); HG2_PREP(k + 2, 2); __syncthreads();
            HG2_W(k + 3, 3, rqB, rlB, rvB); HG2_PREP(k + 3, 3); __syncthreads();
        }
    } else {
        f32x4 S[2][8], oprev[2][2]; bf16x8 Vprev[2];
#pragma unroll
        for (int eb = 0; eb < 2; ++eb) {
#pragma unroll
            for (int t = 0; t < 8; ++t) S[eb][t] = (f32x4){0.f, 0.f, 0.f, 0.f};
            oprev[eb][0] = (f32x4){0.f, 0.f, 0.f, 0.f}; oprev[eb][1] = (f32x4){0.f, 0.f, 0.f, 0.f};
#pragma unroll
            for (int jj = 0; jj < 8; ++jj) Vprev[eb][jj] = 0; }
#pragma unroll 1
        for (int k = 0; k < 76; k += 4) {
            HG2_W(k, 0, rqA, rlA, rvA); HG2_CORE(k, 0); __syncthreads();
            HG2_W(k + 1, 1, rqB, rlB, rvB); HG2_CORE(k + 1, 1); __syncthreads();
            HG2_W(k + 2, 2, rqA, rlA, rvA); HG2_CORE(k + 2, 2); __syncthreads();
            HG2_W(k + 3, 3, rqB, rlB, rvB); HG2_CORE(k + 3, 3); __syncthreads();
        }
    }
#undef HG2_W
#undef HG2_PREP
#undef HG2_CORE
}
DI void phase_y2(const Frame& F) {
    const bf16* OFp = (const bf16*)(F.ws + WS_OF); const bf16* OBp = (const bf16*)(F.ws + WS_OB); const bf16* P = (const bf16*)(F.ws + WS_P); bf16* YL = (bf16*)(F.ws + WS_YL);
    const bf16* HS = (const bf16*)(F.ws + WS_LHS); const bf16* PF = (const bf16*)(F.ws + WS_LPF); const bf16* PB = (const bf16*)(F.ws + WS_LPB); const float* CIN = (const float*)(F.ws + WS_CIN);
    const int gw = F.bx * NWAVES + F.wave, NGW = F.G * NWAVES;
    const int c = 8 * F.lane;
    const f32x4 g0 = *(const f32x4*)(F.in[I_HNORM] + c), g1 = *(const f32x4*)(F.in[I_HNORM] + c + 4);
    const float gn[8] = {g0.x, g0.y, g0.z, g0.w, g1.x, g1.y, g1.z, g1.w};
    for (int m0 = gw * 16; m0 < NTOK; m0 += NGW * 16) {
        const int bb = m0 >> 11, ss = 4 + ((m0 & 2047) >> 6);
        const size_t cf = ((size_t)(0 * NB + bb) * NSEQT + ss) * 512 + c, cbk = ((size_t)(1 * NB + bb) * NSEQT + ss) * 512 + c;
        const f32x4 f0 = *(const f32x4*)(CIN + cf), f1 = *(const f32x4*)(CIN + cf + 4), b0 = *(const f32x4*)(CIN + cbk), b1 = *(const f32x4*)(CIN + cbk + 4);
        const float cfv[8] = {f0.x, f0.y, f0.z, f0.w, f1.x, f1.y, f1.z, f1.w}, cbv[8] = {b0.x, b0.y, b0.z, b0.w, b1.x, b1.y, b1.z, b1.w};
#pragma unroll 2
        for (int m = m0; m < m0 + 16; ++m) {
            const v4u hs = *(const v4u*)(HS + (size_t)m * 512 + c), pf = *(const v4u*)(PF + (size_t)m * 512 + c), pb = *(const v4u*)(PB + (size_t)m * 512 + c), rg = *(const v4u*)(P + (size_t)m * INC + 512 + c);
            const v4u a = *(const v4u*)(OFp + (size_t)m * 512 + c), bq = *(const v4u*)(OBp + (size_t)m * 512 + c), sg = *(const v4u*)(P + (size_t)m * INC + 3072 + c);
            { const unsigned hw[4] = {hs.x, hs.y, hs.z, hs.w}, fw[4] = {pf.x, pf.y, pf.z, pf.w}, bw[4] = {pb.x, pb.y, pb.z, pb.w}, rw[4] = {rg.x, rg.y, rg.z, rg.w};
                unsigned ow[4];
#pragma unroll
                for (int q = 0; q < 4; ++q) { const float lo = bflo(rw[q]) * (bflo(hw[q]) + bflo(fw[q]) * cfv[2 * q] + bflo(bw[q]) * cbv[2 * q]);
                    const float hi = bfhi(rw[q]) * (bfhi(hw[q]) + bfhi(fw[q]) * cfv[2 * q + 1] + bfhi(bw[q]) * cbv[2 * q + 1]); ow[q] = pk2(lo, hi); }
                *(v4u*)(YL + (size_t)m * D + c) = (v4u){ow[0], ow[1], ow[2], ow[3]}; }
            float o[8] = {bflo(a.x) + bflo(bq.x), bfhi(a.x) + bfhi(bq.x), bflo(a.y) + bflo(bq.y), bfhi(a.y) + bfhi(bq.y), bflo(a.z) + bflo(bq.z), bfhi(a.z) + bfhi(bq.z), bflo(a.w) + bflo(bq.w), bfhi(a.w) + bfhi(bq.w)};
            const float sgv[8] = {bflo(sg.x), bfhi(sg.x), bflo(sg.y), bfhi(sg.y), bflo(sg.z), bfhi(sg.z), bflo(sg.w), bfhi(sg.w)};
            float ssq = 0.f;
#pragma unroll
            for (int j = 0; j < 8; ++j) ssq += o[j] * o[j];
            ssq += dpp_mov_f<0xB1>(ssq); ssq += dpp_mov_f<0x4E>(ssq); ssq += dpp_mov_f<0x124>(ssq); ssq += dpp_mov_f<0x128>(ssq);
            const float rs = rsqrtf(ssq * (1.0f / 128.0f) + EPS);
#pragma unroll
            for (int j = 0; j < 8; ++j) o[j] = o[j] * rs * gn[j] * sgv[j];
            v4u wv; wv.x = pk2(o[0], o[1]); wv.y = pk2(o[2], o[3]); wv.z = pk2(o[4], o[5]); wv.w = pk2(o[6], o[7]);
            *(v4u*)(YL + (size_t)m * D + 512 + c) = wv;
        }
    }
}

DI unsigned fkey(float f) { const unsigned u = __float_as_uint(f); return u ^ ((u >> 31) ? 0xFFFFFFFFu : 0x80000000u); }
template <int CTRL> DI unsigned dpp_u(unsigned v) { return (unsigned)__builtin_amdgcn_update_dpp(0, (int)v, CTRL, 0xf, 0xf, true); }
template <int CTRL> DI float dpp_f(float v) { return __uint_as_float(dpp_u<CTRL>(__float_as_uint(v))); }
DI unsigned umax_(unsigned a, unsigned b) { return a > b ? a : b; }
DI float readlane_f(float v, int lane) { return __uint_as_float((unsigned)__builtin_amdgcn_readlane((int)__float_as_uint(v), lane)); }
DI void route_token(const f32x4 lg, const f32x4 rbv, const int l, int& myexp, float& gate) {
    const float NEG = -__builtin_inff();
    float sc[4], bs[4];
#pragma unroll
    for (int k = 0; k < 4; ++k) { sc[k] = rcpf_(1.0f + expf_(-lg[k])); bs[k] = sc[k] + rbv[k]; }
    float m1 = NEG, m2 = NEG;
#pragma unroll
    for (int k = 0; k < 4; ++k) { const float v = bs[k]; if (v > m1) { m2 = m1; m1 = v; } else if (v > m2) m2 = v; }
    { float o1 = dpp_f<0xB1>(m1), o2 = dpp_f<0xB1>(m2); float n1 = fmaxf(m1, o1), n2 = fmaxf(fminf(m1, o1), fmaxf(m2, o2)); m1 = n1; m2 = n2;
      o1 = dpp_f<0x4E>(m1); o2 = dpp_f<0x4E>(m2); n1 = fmaxf(m1, o1); n2 = fmaxf(fminf(m1, o1), fmaxf(m2, o2)); m1 = n1; m2 = n2;
      const float a1 = dpp_f<0x104>(m1), a2 = dpp_f<0x104>(m2), c1 = dpp_f<0x114>(m1), c2 = dpp_f<0x114>(m2);
      o1 = (l & 4) ? c1 : a1; o2 = (l & 4) ? c2 : a2; n1 = fmaxf(m1, o1); n2 = fmaxf(fminf(m1, o1), fmaxf(m2, o2)); m1 = n1; m2 = n2; }
    const float gs = m1 + m2; const int g = l >> 3; int rank = 0;
#pragma unroll
    for (int gg = 0; gg < 8; ++gg) { const float og = readlane_f(gs, gg * 8); rank += (og > gs || (og == gs && gg < g)) ? 1 : 0; }
    const bool sel = rank < 4;
    unsigned cv[4];
#pragma unroll
    for (int k = 0; k < 4; ++k) cv[k] = sel ? fkey(bs[k]) : 0u;
    float sum = 0.f, mysc = 0.f; myexp = 0;
#pragma unroll
    for (int r = 0; r < TOPK; ++r) {
        unsigned bvk = cv[0]; int bk = 0;
#pragma unroll
        for (int k = 1; k < 4; ++k) if (cv[k] > bvk) { bvk = cv[k]; bk = k; }
        const float bsc = bk == 0 ? sc[0] : bk == 1 ? sc[1] : bk == 2 ? sc[2] : sc[3];
        unsigned m = bvk;
        m = umax_(m, dpp_u<0xB1>(m)); m = umax_(m, dpp_u<0x4E>(m)); m = umax_(m, dpp_u<0x124>(m)); m = umax_(m, dpp_u<0x128>(m));
        const unsigned M = umax_(umax_((unsigned)__builtin_amdgcn_readlane((int)m, 0), (unsigned)__builtin_amdgcn_readlane((int)m, 16)),
                                 umax_((unsigned)__builtin_amdgcn_readlane((int)m, 32), (unsigned)__builtin_amdgcn_readlane((int)m, 48)));
        const unsigned long long bal = __ballot(bvk == M);
        const int L = __builtin_ctzll(bal);
        const int kL = __builtin_amdgcn_readlane(bk, L);
        const float se = readlane_f(bsc, L);
        const int e = 4 * L + kL;
        if (l == L) {
#pragma unroll
            for (int k = 0; k < 4; ++k) if (k == bk) cv[k] = 0u; }
        sum += se; if (l == r) { myexp = e; mysc = se; }
    }
    gate = mysc * rcpf_(sum) * 2.5f;
}
constexpr int NR_XS = 1032, NR_LS = 260, NR_HIST = 133120;
static_assert(64 * NR_XS * 2 <= NR_HIST && 64 * NR_LS * 4 <= NR_HIST && NR_HIST + 1024 <= LDS_MISC, "norm/route lds");
DI void phase_norm_route(const Frame& F) {
    const float* MOD = (const float*)(F.ws + WS_MOD); const float* gain = F.in[I_NFFN];
    const bf16* X1b = (const bf16*)(F.ws + WS_X1); const bf16* WR = (const bf16*)(F.ws + WS_WR);
    v2u* ROUTE = (v2u*)(F.ws + WS_ROUTE); int* HIST = (int*)(F.ws + WS_HIST);
    LAS bf16* XT = (LAS bf16*)F.lds; LAS float* LG = (LAS float*)F.lds; LAS unsigned* hist = (LAS unsigned*)(F.lds + NR_HIST);
    const int l = F.lane, w = F.wave, fr = l & 15, g = l >> 4;
    const f32x4 rbv = *(const f32x4*)(F.in[I_RB] + 4 * l);
    for (int blk = F.bx; blk < NTOK / 128; blk += F.G) {
        if (F.tid < 256) hist[F.tid] = 0u;
        const int b = (blk * 128) >> 11;
        f32x4 ga[4], sb4[4];
#pragma unroll
        for (int j = 0; j < 4; ++j) { const int c = 4 * l + 256 * j; ga[j] = *(const f32x4*)(gain + c) * (*(const f32x4*)(MOD + b * 6144 + 4096 + c) + 1.0f); sb4[j] = *(const f32x4*)(MOD + b * 6144 + 3072 + c); }
#pragma unroll 1
        for (int half = 0; half < 2; ++half) {
            const int tok0 = blk * 128 + half * 64;
            v2u xr[4];
#pragma unroll
            for (int j = 0; j < 4; ++j) xr[j] = *(const v2u*)(X1b + (size_t)(tok0 + 8 * w) * D + 4 * l + 256 * j);
#pragma unroll 1
            for (int rr = 0; rr < 8; ++rr) { const int row = 8 * w + rr; const size_t m = (size_t)(tok0 + row);
                f32x4 v[4]; float ss = 0.f;
#pragma unroll
                for (int j = 0; j < 4; ++j) { v[j] = (f32x4){bflo(xr[j].x), bfhi(xr[j].x), bflo(xr[j].y), bfhi(xr[j].y)}; ss += (v[j].x * v[j].x + v[j].y * v[j].y) + (v[j].z * v[j].z + v[j].w * v[j].w); }
                if (rr + 1 < 8) {
#pragma unroll
                    for (int j = 0; j < 4; ++j) xr[j] = *(const v2u*)(X1b + (m + 1) * D + 4 * l + 256 * j); }
                const float rs = rsqrtf(wave_sum_fast(ss) * (1.0f / D) + EPS);
#pragma unroll
                for (int j = 0; j < 4; ++j) { const int c = 4 * l + 256 * j; const f32x4 y = (v[j] * rs) * ga[j] + sb4[j];
                    *(LAS v2u*)(XT + row * NR_XS + c) = (v2u){pk2(y.x, y.y), pk2(y.z, y.w)};
                    *(unsigned*)(F.ws + WS_HX2F + m * D + c) = pk4_f8(y.x, y.y, y.z, y.w); } }
            __syncthreads();
            f32x4 acc[4][2];
#pragma unroll
            for (int tt = 0; tt < 4; ++tt) { acc[tt][0] = (f32x4){0.f, 0.f, 0.f, 0.f}; acc[tt][1] = (f32x4){0.f, 0.f, 0.f, 0.f}; }
            const bf16* wb0 = WR + (size_t)(32 * w + fr) * D + 8 * g; const bf16* wb1 = wb0 + (size_t)16 * D;
            bf16x8 Bc[4][2], Bn[4][2];
#pragma unroll
            for (int q = 0; q < 4; ++q) { Bc[q][0] = *(const bf16x8*)(wb0 + 32 * q); Bc[q][1] = *(const bf16x8*)(wb1 + 32 * q); }
#pragma unroll 1
            for (int kc = 0; kc < 8; ++kc) {
                const int kn = (kc + 1 < 8) ? kc + 1 : kc;
#pragma unroll
                for (int q = 0; q < 4; ++q) { Bn[q][0] = *(const bf16x8*)(wb0 + 32 * (4 * kn + q)); Bn[q][1] = *(const bf16x8*)(wb1 + 32 * (4 * kn + q)); }
#pragma unroll
                for (int q = 0; q < 4; ++q)
#pragma unroll
                    for (int tt = 0; tt < 4; ++tt) { const bf16x8 A = *(const LAS bf16x8*)(XT + (16 * tt + fr) * NR_XS + 32 * (4 * kc + q) + 8 * g);
                        acc[tt][0] = __builtin_amdgcn_mfma_f32_16x16x32_bf16(A, Bc[q][0], acc[tt][0], 0, 0, 0); acc[tt][1] = __builtin_amdgcn_mfma_f32_16x16x32_bf16(A, Bc[q][1], acc[tt][1], 0, 0, 0); }
#pragma unroll
                for (int q = 0; q < 4; ++q) { Bc[q][0] = Bn[q][0]; Bc[q][1] = Bn[q][1]; }
            }
            __syncthreads();
#pragma unroll
            for (int tt = 0; tt < 4; ++tt)
#pragma unroll
                for (int eb = 0; eb < 2; ++eb)
#pragma unroll
                    for (int r = 0; r < 4; ++r) LG[(16 * tt + 4 * g + r) * NR_LS + 32 * w + 16 * eb + fr] = acc[tt][eb][r];
            __syncthreads();
#pragma unroll 1
            for (int ti = 0; ti < 8; ti += 2) { const int row = 8 * w + ti, tok = tok0 + row;
                const f32x4 lgA = *(const LAS f32x4*)(LG + row * NR_LS + 4 * l), lgB = *(const LAS f32x4*)(LG + (row + 1) * NR_LS + 4 * l);
                int eA, eB; float gA, gB; route_token(lgA, rbv, l, eA, gA); route_token(lgB, rbv, l, eB, gB);
                if (l < TOPK) { ROUTE[(size_t)tok * TOPK + l] = (v2u){(unsigned)eA, __float_as_uint(gA)}; ROUTE[(size_t)(tok + 1) * TOPK + l] = (v2u){(unsigned)eB, __float_as_uint(gB)};
                    (void)__hip_atomic_fetch_add(hist + eA, 1u, __ATOMIC_RELAXED, __HIP_MEMORY_SCOPE_WORKGROUP); (void)__hip_atomic_fetch_add(hist + eB, 1u, __ATOMIC_RELAXED, __HIP_MEMORY_SCOPE_WORKGROUP); } }
            __syncthreads();
        }
        if (F.tid < 256) HIST[blk * 256 + F.tid] = (int)hist[F.tid];
        __syncthreads();
    }
}
DI void phase_lists(const Frame& F) {
    const v2u* ROUTE = (const v2u*)(F.ws + WS_ROUTE); const int* HIST = (const int*)(F.ws + WS_HIST);
    unsigned* cnt = (unsigned*)(F.ws + WS_CTL) + CW_CNT; v2u* LIST = (v2u*)(F.ws + WS_LIST);
    LAS int* part = (LAS int*)F.lds;
    LAS int* lbase = part + 1024; LAS unsigned* lcnt = (LAS unsigned*)(lbase + 256); LAS int* ltot = lbase + 512; LAS int* lts = lbase + 768;
    int* INV = (int*)(F.ws + WS_INV);
    for (int blk = F.bx; blk < NTOK / 128; blk += F.G) {
        const int e = F.tid & 255, hf = F.tid >> 8;
        int below = 0, all = 0;
#pragma unroll 8
        for (int q = 0; q < 128; ++q) { const int row = hf * 128 + q; const int v = HIST[row * 256 + e]; all += v; below += (row < blk) ? v : 0; }
        part[hf * 512 + e] = below; part[hf * 512 + 256 + e] = all;
        __syncthreads();
        if (F.tid < 256) { lbase[e] = part[e] + part[512 + e]; lcnt[e] = 0u; const int tot = part[256 + e] + part[768 + e]; ltot[e] = tot; if (blk == 0) cnt[e] = (unsigned)tot; }
        __syncthreads();
        if (F.tid == 0) { int s2 = 0; for (int q = 0; q < 256; ++q) { lts[q] = s2; s2 += (ltot[q] + 255) >> 8; } }
        __syncthreads();
#pragma unroll
        for (int q = 0; q < 2; ++q) { const int a = F.tid + q * NTHR; const unsigned tk = (unsigned)(blk * 128 * TOPK + a);
            const v2u rt = ROUTE[tk]; const unsigned pos = (unsigned)lbase[rt.x] + __hip_atomic_fetch_add(lcnt + rt.x, 1u, __ATOMIC_RELAXED, __HIP_MEMORY_SCOPE_WORKGROUP);
            LIST[(size_t)rt.x * LISTCAP + pos] = (v2u){tk, rt.y}; INV[tk] = lts[rt.x] * 256 + (int)pos; }
        __syncthreads();
    }
}

template <bool GATHER> DI void moe_setup(const Frame& F, int ncol, int& nunits, int& nfull) {
    LAS int* ts = (LAS int*)(F.lds + LDS_TS); LAS int* cl = (LAS int*)(F.lds + LDS_CNT); LAS int* ut = (LAS int*)(F.lds + LDS_UT); LAS int* idx = (LAS int*)(F.lds + LDS_IDX);
    const unsigned* cnt = (const unsigned*)(F.ws + WS_CTL) + CW_CNT;
    if (F.tid < 256) cl[F.tid] = (int)__hip_atomic_load(cnt + F.tid, __ATOMIC_RELAXED, __HIP_MEMORY_SCOPE_AGENT);
    __syncthreads();
    if (F.tid == 0) { int s = 0; for (int e = 0; e < 256; ++e) { ts[e] = s; s += (cl[e] + 255) >> 8; } ts[256] = s; }
    __syncthreads();
    const int Te = ts[256], T = Te + NTOK / 256;
    const int Fr = T / F.G, R = T - Fr * F.G, LU = R * ncol;
    const int nleft = (LU > F.vcu) ? (LU - F.vcu + F.G - 1) / F.G : 0;
    nfull = Fr * ncol; nunits = nfull + nleft;
    const v2u* LIST = (const v2u*)(F.ws + WS_LIST);
    for (int j = 0; j < Fr + nleft && j < 10; ++j) {
        int rt, pnl = 0;
        if (j < Fr) rt = j * F.G + F.vcu; else { const int lu = (j - Fr) * F.G + F.vcu; rt = Fr * F.G + lu / ncol; pnl = lu % ncol; }
        int e, pm, nrows;
        if (rt >= Te) { e = 256; pm = rt - Te; nrows = 256; }
        else { int lo = 0, hi = 256; while (hi - lo > 1) { const int mid = (lo + hi) >> 1; if (ts[mid] <= rt) lo = mid; else hi = mid; }
            e = lo; pm = rt - ts[lo]; const int rem = cl[lo] - pm * 256; nrows = rem < 256 ? rem : 256; }
        if (F.tid == 0) *(LAS v4u*)(ut + 4 * j) = (v4u){(unsigned)e, (unsigned)pm, (unsigned)rt, (unsigned)nrows | ((unsigned)pnl << 16)};
        if (F.tid < 256) { const int r = F.tid;
            if (GATHER) idx[j * 256 + r] = (e == 256) ? pm * 256 + r : (r < nrows ? (int)(LIST[(size_t)e * LISTCAP + pm * 256 + r].x >> 3) : 0);
            else ((LAS float*)idx)[j * 256 + r] = (e == 256) ? 1.0f : (r < nrows ? __uint_as_float(LIST[(size_t)e * LISTCAP + pm * 256 + r].y) : 0.0f); } }
    __syncthreads();
}

DI void phase_combine(const Frame& F, int mode) {
    const float* MOD = (const float*)(F.ws + WS_MOD);
    const unsigned char* YE = F.ws + WS_YE; const int* INV = (const int*)(F.ws + WS_INV);
    int Te = 0; if (mode == 0) { const unsigned* cnt = (const unsigned*)(F.ws + WS_CTL) + CW_CNT; int t4 = 0;
#pragma unroll
        for (int q = 0; q < 4; ++q) t4 += (int)((cnt[F.lane + 64 * q] + 255u) >> 8);
#pragma unroll
        for (int o = 1; o < 64; o <<= 1) t4 += __shfl_xor(t4, o);
        Te = __builtin_amdgcn_readfirstlane(t4); }
    const int gw = F.bx * NWAVES + F.wave, NGW = F.G * NWAVES;
    const float* nf = F.in[I_NFIN];
    const int c = 16 * F.lane;
    for (int m = gw; m < NTOK; m += NGW) {
        const int b = m >> 11;
        float s[16];
#pragma unroll
        for (int q = 0; q < 16; ++q) s[q] = 0.f;
        const bf16* xsrc = (const bf16*)(F.ws + WS_X1);
        if (mode == 0) {
#pragma unroll
            for (int k = 0; k < 9; ++k) { const int row = (k < 8) ? INV[m * TOPK + k] : Te * 256 + m; const v4u w = *(const v4u*)(YE + (size_t)row * D + c);
                const unsigned ww[4] = {w.x, w.y, w.z, w.w};
#pragma unroll
                for (int q = 0; q < 4; ++q) { const f32x2 lo = __builtin_amdgcn_cvt_pk_f32_fp8((int)ww[q], false), hi = __builtin_amdgcn_cvt_pk_f32_fp8((int)ww[q], true);
                    s[4 * q] += lo.x; s[4 * q + 1] += lo.y; s[4 * q + 2] += hi.x; s[4 * q + 3] += hi.y; } } }
        float x2[16]; float ss = 0.f;
#pragma unroll
        for (int q = 0; q < 4; ++q) { const v2u xt = *(const v2u*)(xsrc + (size_t)m * D + c + 4 * q); const f32x4 xa = {bflo(xt.x), bfhi(xt.x), bflo(xt.y), bfhi(xt.y)}, ga = *(const f32x4*)(MOD + b * 6144 + 5120 + c + 4 * q);
#pragma unroll
            for (int j = 0; j < 4; ++j) { const float v = xa[j] + ga[j] * (s[4 * q + j] * 0.015625f); x2[4 * q + j] = v; ss += v * v; } }
        const float rs = rsqrtf(wave_sum(ss) * (1.0f / D) + EPS);
#pragma unroll
        for (int q = 0; q < 4; ++q) { const f32x4 na = *(const f32x4*)(nf + c + 4 * q);
            f32x4 oa = {x2[4 * q] * rs * na.x, x2[4 * q + 1] * rs * na.y, x2[4 * q + 2] * rs * na.z, x2[4 * q + 3] * rs * na.w};
            *(f32x4*)(F.out + (size_t)m * D + c + 4 * q) = oa; }
    }
}

constexpr int NPHASE = 12;
__global__ void __launch_bounds__(NTHR, 2) fwd_kernel(Args args) {
    extern __shared__ __attribute__((aligned(16))) unsigned char lds_raw[];
    Frame F;
    F.lds = (LAS unsigned char*)lds_raw;
    F.tid = threadIdx.x; F.lane = F.tid & 63; F.wave = __builtin_amdgcn_readfirstlane(F.tid >> 6);
    F.G = gridDim.x; F.bx = blockIdx.x; F.vcu = (F.G % 8 == 0) ? (F.bx % 8) * (F.G / 8) + F.bx / 8 : F.bx;
    F.in = args.in; F.out = args.out; F.ws = args.ws;
    volatile LAS unsigned* MISC = (volatile LAS unsigned*)(F.lds + LDS_MISC);
    if (F.tid < 16) MISC[F.tid] = 0u;
    __syncthreads();
    XcdBarrier bar; bar.bar = (unsigned*)(F.ws + WS_CTL) + CW_BAR; bar.x = 0; bar.st = nullptr;
#if !PER_PHASE_LAUNCH
    bar = xcd_barrier_post((unsigned*)(F.ws + WS_CTL) + CW_BAR, MISC + 8);
#define GRID_BAR() xcd_barrier(bar)
#else
#define GRID_BAR() do {} while (0)
#endif
    const int lo = args.ph_lo, hi = args.ph_hi;
#ifndef PH_MASK
#define PH_MASK 0xFFFF
#endif
#define IN(k) (((PH_MASK >> (k)) & 1) && lo <= (k) && (k) < hi)
#ifndef PROBE_PH
#define PROBE_PH -1
#endif
#ifndef PROBE_MULT
#define PROBE_MULT 4
#endif
    volatile LAS unsigned long long* PRT = (volatile LAS unsigned long long*)(F.lds + LDS_MISC);
    if (PROBE_PH == 0 && F.wave == 0) PRT[0] = __builtin_amdgcn_s_memrealtime();
#define SEAM(k) do { if (IN(k) && IN((k) + 1)) GRID_BAR(); \
        if (PROBE_PH >= 0 && F.wave == 0) { if ((k) == PROBE_PH - 1) PRT[0] = __builtin_amdgcn_s_memrealtime(); if ((k) == PROBE_PH) PRT[1] = __builtin_amdgcn_s_memrealtime(); } } while (0)
#ifndef REPEAT_MASK
#define REPEAT_MASK 0
#endif
#define REPS(k) (1 + ((REPEAT_MASK >> (k)) & 1))
    unsigned char* ws = F.ws;

    if (IN(0)) _Pragma("unroll 1") for (int rep = 0; rep < REPS(0); ++rep) { if (rep) GRID_BAR(); phase_prologue(F); } SEAM(0);
    if (IN(1)) _Pragma("unroll 1") for (int rep = 0; rep < REPS(1); ++rep) { if (rep) GRID_BAR(); phase_norm_rows(F, 0); } SEAM(1);
    if (IN(2)) _Pragma("unroll 1") for (int rep = 0; rep < REPS(2); ++rep) { if (rep) GRID_BAR();
        pg8::DenseOrder S; S.init(ws + WS_HX, ws + WS_WIN, MTOT, INC, D, F.G, F.bx);
        pg8::EpiInProj E{(bf16*)(ws + WS_P), (const float*)(ws + WS_TAB)};
        pg8::gemm_phase(F.lds, D, S, E, F.wave);
    } SEAM(2);
    if (IN(3)) _Pragma("unroll 1") for (int rep = 0; rep < REPS(3); ++rep) { if (rep) GRID_BAR(); phase_lru_pass1(F); } SEAM(3);
    if (IN(4)) _Pragma("unroll 1") for (int rep = 0; rep < REPS(4); ++rep) { if (rep) GRID_BAR(); phase_lru_carry(F);
#if defined(PROBE_SUB)
        if (F.wave == 0 && PROBE_SUB == 0) PRT[0] = __builtin_amdgcn_s_memrealtime();
#endif
        if (F.bx < NB * 4 * 2) hgrn_chain2(F, F.bx);
#if defined(PROBE_SUB)
        if (F.wave == 0) { if (PROBE_SUB == 0) PRT[1] = __builtin_amdgcn_s_memrealtime(); else PRT[0] = __builtin_amdgcn_s_memrealtime(); }
#endif
        convert_experts(F, nullptr, 0u);
#if defined(PROBE_SUB)
        if (F.wave == 0 && PROBE_SUB == 1) PRT[1] = __builtin_amdgcn_s_memrealtime();
#endif
        } SEAM(4);
    if (IN(5)) _Pragma("unroll 1") for (int rep = 0; rep < REPS(5); ++rep) { if (rep) GRID_BAR(); phase_y2(F); } SEAM(5);
    if (IN(6)) _Pragma("unroll 1") for (int rep = 0; rep < REPS(6); ++rep) { if (rep) GRID_BAR();
        pg8::DenseOrder S; S.init(ws + WS_YL, ws + WS_WOUT, NTOK, D, D, F.G, F.bx);
        pg8::EpiResid E{F.in[I_X], (const float*)(ws + WS_MOD), (bf16*)(ws + WS_X1)};
        pg8::gemm_phase(F.lds, D, S, E, F.wave);
    } SEAM(6);
    if (IN(7)) _Pragma("unroll 1") for (int rep = 0; rep < REPS(7); ++rep) { if (rep) GRID_BAR(); phase_norm_route(F); } SEAM(7);
    if (IN(8)) _Pragma("unroll 1") for (int rep = 0; rep < REPS(8); ++rep) { if (rep) GRID_BAR(); phase_lists(F); } SEAM(8);
    if (IN(9)) _Pragma("unroll 1") for (int rep = 0; rep < REPS(9); ++rep) { if (rep) GRID_BAR();
        int total, nfull; moe_setup<true>(F, 2, total, nfull);
        pg8::MoeOrder<true> S; S.A = (const char*)(ws + WS_HX2F); S.Bt = (const char*)(ws + WS_EW13); S.BtS = (const char*)(ws + WS_SW13); S.K = D / 2; S.ncol = 2; S.estride = (size_t)512 * 1024;
        S.ut = (const LAS int*)(F.lds + LDS_UT); S.idx = (const LAS int*)(F.lds + LDS_IDX); S.nunits = total; S.nfull = nfull;
        pg8::EpiSwiGLU8 E{ws + WS_ACT};
        pg8::gemm_phase<pg8::EpiSwiGLU8, pg8::MoeOrder<true>, false, true>(F.lds, D / 2, S, E, F.wave);
    } SEAM(9);
    if (IN(10)) _Pragma("unroll 1") for (int rep = 0; rep < REPS(10); ++rep) { if (rep) GRID_BAR();
        int total, nfull; moe_setup<false>(F, 4, total, nfull);
        pg8::MoeOrder<false> S; S.A = (const char*)(ws + WS_ACT); S.Bt = (const char*)(ws + WS_EW2); S.BtS = (const char*)(ws + WS_SW2); S.K = DE / 2; S.ncol = 4; S.estride = (size_t)1024 * 256;
        S.ut = (const LAS int*)(F.lds + LDS_UT); S.idx = (const LAS int*)(F.lds + LDS_IDX); S.nunits = total; S.nfull = nfull;
        pg8::EpiScatter E{ws + WS_YE, (const LAS float*)(F.lds + LDS_IDX), 0.5f};
#if defined(PROBE_GEMM)
        pg8::GProf gp{0ull, 0ull, 0ull};
        pg8::gemm_phase<pg8::EpiScatter, pg8::MoeOrder<false>, true, true>(F.lds, DE / 2, S, E, F.wave, &gp);
        if (F.wave == 0) { PRT[0] = 0ull; PRT[1] = (PROBE_GEMM == 0) ? gp.t_loop : (PROBE_GEMM == 1) ? gp.t_epi : gp.t_next; }
#else
        pg8::gemm_phase<pg8::EpiScatter, pg8::MoeOrder<false>, false, true>(F.lds, DE / 2, S, E, F.wave);
#endif
    } SEAM(10);
    if (IN(11)) _Pragma("unroll 1") for (int rep = 0; rep < REPS(11); ++rep) { if (rep) GRID_BAR(); phase_combine(F, 0); }
#if defined(PROBE_GEMM) || defined(PROBE_SUB)
    if (F.bx == 0 && F.wave == 0) {
#else
    if (PROBE_PH >= 0 && F.bx == 0 && F.wave == 0) {
#endif
        const unsigned long long te = __builtin_amdgcn_s_memrealtime(); if (PROBE_PH == NPHASE - 1) PRT[1] = te;
        const unsigned long long target = (unsigned long long)PROBE_MULT * (PRT[1] - PRT[0]);
        while (__builtin_amdgcn_s_memrealtime() - te < target) __builtin_amdgcn_s_sleep(20);
    }
}

extern "C" void kernel_launch(void* const* d_in, const int* in_sizes, int n_in, void* d_out, int out_size, void* d_ws, size_t ws_size, hipStream_t stream) {
    static int grid = 0;
    if (grid == 0) {
        if (n_in != 26 || in_sizes[0] != NTOK * D || out_size != NTOK * D || ws_size < WS_END) { fprintf(stderr, "kernel_launch: unexpected shapes (n_in %d, ws %zu)\n", n_in, ws_size); grid = -1; return; }
        int dev = 0, cus = 0, per_cu = 0;
        if (hipGetDevice(&dev) != hipSuccess || hipDeviceGetAttribute(&cus, hipDeviceAttributeMultiprocessorCount, dev) != hipSuccess) { grid = -1; return; }
        if (hipFuncSetAttribute((const void*)fwd_kernel, hipFuncAttributeMaxDynamicSharedMemorySize, LDS_BYTES) != hipSuccess) { fprintf(stderr, "kernel_launch: hipFuncSetAttribute failed\n"); grid = -1; return; }
        if (hipOccupancyMaxActiveBlocksPerMultiprocessor(&per_cu, (const void*)fwd_kernel, NTHR, LDS_BYTES) != hipSuccess || per_cu < 1) { fprintf(stderr, "kernel_launch: occupancy query says %d\n", per_cu); }
        (void)hipGetLastError();
        grid = cus;
        if (grid < 128) { fprintf(stderr, "kernel_launch: needs >= 128 CUs (HGRN2 chains run one per workgroup)\n"); grid = -1; return; }
    }
    if (grid < 0) return;
    hipMemsetAsync((char*)d_ws + WS_CTL, 0, CTL_ZERO_BYTES, stream);
    Args a{};
    for (int i = 0; i < 26; ++i) a.in[i] = (const float*)d_in[i];
    a.out = (float*)d_out; a.ws = (unsigned char*)d_ws;
#if PER_PHASE_LAUNCH
    for (int p = 0; p < NPHASE; ++p) { a.ph_lo = p; a.ph_hi = p + 1; hipLaunchKernelGGL(fwd_kernel, dim3(grid), dim3(NTHR), LDS_BYTES, stream, a); }
#else
    a.ph_lo = 0; a.ph_hi = NPHASE;
    hipLaunchKernelGGL(fwd_kernel, dim3(grid), dim3(NTHR), LDS_BYTES, stream, a);
#endif
}
```

```cpp
#include <hip/hip_runtime.h>
#include <cstdio>
#include <cstdint>

#ifndef PER_PHASE_LAUNCH
#define PER_PHASE_LAUNCH 0
#endif
#ifndef DBG_STOP
#define DBG_STOP 0
#endif

#define GAS __attribute__((address_space(1)))
#define LAS __attribute__((address_space(3)))
#define DI __device__ __forceinline__
typedef unsigned short bf16;
typedef unsigned v4u __attribute__((ext_vector_type(4)));
typedef unsigned v2u __attribute__((ext_vector_type(2)));
typedef float f32x4 __attribute__((ext_vector_type(4)));
typedef float f32x2 __attribute__((ext_vector_type(2)));
typedef short bf16x8 __attribute__((ext_vector_type(8)));
typedef __bf16 bfv2 __attribute__((ext_vector_type(2)));

constexpr int D = 1024, NB = 16, SEQ = 2048, CTXL = 256;
constexpr int NTOK = NB * SEQ;
constexpr int NCTX = NB * CTXL;
constexpr int MTOT = NTOK + NCTX;
constexpr int INC = 3584;
constexpr int NE = 256, TOPK = 8, DE = 256;
constexpr int LISTCAP = 32768;
constexpr float EPS = 1e-6f;
constexpr int NWAVES = 8, NTHR = 512;
constexpr int NSEQT = 36;

constexpr size_t MiB = 1u << 20;
constexpr size_t WS_CTL = 0, CTL_ZERO_BYTES = 1 * MiB;
constexpr size_t WS_MOD = 1 * MiB;
constexpr size_t WS_TAB = 2 * MiB;
constexpr size_t WS_WGT = 2 * MiB + 65536;
constexpr size_t WS_WIN = 3 * MiB;
constexpr size_t WS_WOUT = 10 * MiB;
constexpr size_t WS_WR = 12 * MiB;
constexpr size_t WS_SW13 = 12 * MiB + 512 * 1024;
constexpr size_t WS_SW2 = 13 * MiB + 512 * 1024;
constexpr size_t WS_DUMP = 2 * MiB + 16384;
constexpr size_t WS_SUMA = 14 * MiB;
constexpr size_t WS_SUMH = WS_SUMA + 2359296;
constexpr size_t WS_CIN = WS_SUMH + 2359296;
constexpr size_t WS_ROUTE = 21 * MiB;
constexpr size_t WS_HIST = 23 * MiB;
constexpr size_t WS_EW13 = 32 * MiB;
constexpr size_t WS_EW2 = 288 * MiB;
constexpr size_t WS_X1 = 416 * MiB;
constexpr size_t WS_HX2 = 544 * MiB;
constexpr size_t WS_LOGIT = 608 * MiB;
constexpr size_t WS_LIST = 1620 * MiB;
constexpr size_t WS_LHS = 674 * MiB, WS_LPF = 706 * MiB, WS_LPB = 738 * MiB;
constexpr size_t WS_ACT = 674 * MiB;
constexpr size_t WS_YS = 850 * MiB;
constexpr size_t WS_P = 914 * MiB;
constexpr size_t WS_HX = 1166 * MiB;
constexpr size_t WS_OF = 1238 * MiB;
constexpr size_t WS_OB = 1270 * MiB;
constexpr size_t WS_YL = 1302 * MiB;
constexpr size_t WS_YE = 914 * MiB;
constexpr size_t WS_INV = 24 * MiB;
constexpr size_t WS_HX2F = 1684 * MiB;
constexpr size_t WS_END = 1716 * MiB;
constexpr int CW_BAR = 4096;
constexpr int CW_CNT = 16384;
constexpr int CW_CONVQ = 20480;
constexpr int CW_LRUDONE = 20544;

constexpr int RING_BYTES = 131072;
constexpr int LDS_TS = RING_BYTES;
constexpr int LDS_CNT = LDS_TS + 1088;
constexpr int LDS_UT = LDS_CNT + 1024;
constexpr int LDS_IDX = LDS_UT + 192;
constexpr int LDS_MISC = LDS_IDX + 10 * 1024;
constexpr int LDS_BYTES = 155648;
static_assert(LDS_MISC + 64 <= LDS_BYTES, "lds map");

DI unsigned pk2(float lo, float hi) { f32x2 v = {lo, hi}; bfv2 b = __builtin_convertvector(v, bfv2); return __builtin_bit_cast(unsigned, b); }
DI float clamp448(float x) { return __builtin_amdgcn_fmed3f(x, -448.0f, 448.0f); }
DI unsigned pk4_f8(float a, float b, float c, float d) {
    int w = __builtin_amdgcn_cvt_pk_fp8_f32(clamp448(a), clamp448(b), 0, false); w = __builtin_amdgcn_cvt_pk_fp8_f32(clamp448(c), clamp448(d), w, true); return (unsigned)w; }
DI float bflo(unsigned w) { return __uint_as_float(w << 16); }
DI float bfhi(unsigned w) { return __uint_as_float(w & 0xffff0000u); }
DI float bf2f(bf16 h) { return __uint_as_float(((unsigned)h) << 16); }
DI bf16 f2bf(float f) { return (bf16)(pk2(f, 0.f) & 0xffffu); }
DI float rcpf_(float x) { return __builtin_amdgcn_rcpf(x); }
DI float ex2f_(float x) { return __builtin_amdgcn_exp2f(x); }
DI float expf_(float x) { return __builtin_amdgcn_exp2f(x * 1.4426950408889634f); }
DI float logf_(float x) { return __builtin_amdgcn_logf(x) * 0.6931471805599453f; }
DI float sigm(float x) { return rcpf_(1.0f + expf_(-x)); }
DI float wave_sum(float v) {
#pragma unroll
    for (int o = 1; o < 64; o <<= 1) v += __shfl_xor(v, o);
    return v;
}
#define LDS_WAIT() asm volatile("s_waitcnt lgkmcnt(0)" ::: "memory")
template <int CTRL> DI float dpp_mov_f(float v) { return __uint_as_float((unsigned)__builtin_amdgcn_update_dpp(0, (int)__float_as_uint(v), CTRL, 0xf, 0xf, true)); }
DI float wave_sum_fast(float v) {
    v += dpp_mov_f<0xB1>(v); v += dpp_mov_f<0x4E>(v); v += dpp_mov_f<0x124>(v); v += dpp_mov_f<0x128>(v);
    const unsigned u = __float_as_uint(v);
    return (__uint_as_float((unsigned)__builtin_amdgcn_readlane((int)u, 0)) + __uint_as_float((unsigned)__builtin_amdgcn_readlane((int)u, 16)))
         + (__uint_as_float((unsigned)__builtin_amdgcn_readlane((int)u, 32)) + __uint_as_float((unsigned)__builtin_amdgcn_readlane((int)u, 48)));
}

#define XB_TMO      128
#define XB_XCNT(j)  (256  + 64 * (j))
#define XB_XSUB(j)  (1280 + 64 * (j))
#define XB_XGEN(j)  (2304 + 64 * (j))
#define XB_TOP      3328
#define XB_TOPGEN   3392
#define XCD_BAR_WORDS 3456
#define XB_SPIN_CAP (1u << 18)
__device__ __forceinline__ unsigned xb_ld(unsigned* p)              { return __hip_atomic_load(p, __ATOMIC_RELAXED, __HIP_MEMORY_SCOPE_AGENT); }
__device__ __forceinline__ unsigned xb_add(unsigned* p, unsigned v) { return __hip_atomic_fetch_add(p, v, __ATOMIC_RELAXED, __HIP_MEMORY_SCOPE_AGENT); }
__device__ __forceinline__ unsigned xb_xcc_id() { return (unsigned)__builtin_amdgcn_s_getreg((3 << 11) | 20) & 0xFu; }
#define XB_SPIN(cond, bar) do { unsigned _sp = 0; while (cond) { __builtin_amdgcn_s_sleep(1); \
    if ((++_sp & 255u) == 0u) { if (xb_ld(&(bar)[XB_TMO])) break; if (_sp > XB_SPIN_CAP) { atomicAdd(&(bar)[XB_TMO], 1u); break; } } } } while (0)
struct XcdBarrier { unsigned* bar; unsigned x; volatile LAS unsigned* st; };
__device__ __forceinline__ XcdBarrier xcd_barrier_post(unsigned* bar, volatile LAS unsigned* st) {
    XcdBarrier b; b.bar = bar; b.x = xb_xcc_id(); b.st = st;
    if (threadIdx.x == 0) (void)xb_add(&bar[XB_XCNT(b.x)], 1u);
    return b;
}
__device__ __forceinline__ void xcd_barrier_complete(unsigned* bar, unsigned x, unsigned& nloc, unsigned& nx) {
    const unsigned G = gridDim.x * gridDim.y * gridDim.z;
    unsigned sum, cnt, mine, sp = 0u;
    for (;;) {
        sum = 0u; cnt = 0u; mine = 0u;
#pragma unroll
        for (unsigned j = 0; j < 16; ++j) { const unsigned c = xb_ld(&bar[XB_XCNT(j)]); sum += c; cnt += (c > 0u) ? 1u : 0u; mine = (j == x) ? c : mine; }
        if (sum == G) break;
        __builtin_amdgcn_s_sleep(1);
        if ((++sp & 255u) == 0u) { if (xb_ld(&bar[XB_TMO])) break; if (sp > XB_SPIN_CAP) { atomicAdd(&bar[XB_TMO], 1u); break; } }
    }
    nloc = mine > 0u ? mine : 1u; nx = cnt > 0u ? cnt : 1u;
}
__device__ __forceinline__ void xcd_barrier(const XcdBarrier& b) {
    asm volatile("s_waitcnt vmcnt(0)" ::: "memory");
    __syncthreads();
    if (threadIdx.x == 0) {
        unsigned* bar = b.bar;
        __builtin_amdgcn_s_waitcnt(0);
        unsigned nloc = b.st[0], nx = b.st[1];
        if (nloc == 0u) { xcd_barrier_complete(bar, b.x, nloc, nx); b.st[0] = nloc; b.st[1] = nx; }
        const unsigned old = xb_add(&bar[XB_XSUB(b.x)], 1u);
        const unsigned gen = old / nloc;
        if (old + 1u == (gen + 1u) * nloc) {
            __builtin_amdgcn_fence(__ATOMIC_RELEASE, "agent");
            asm volatile("s_waitcnt vmcnt(0)" ::: "memory");
            const unsigned og = xb_add(&bar[XB_TOP], 1u);
            const unsigned tg = og / nx;
            if (og + 1u == (tg + 1u) * nx) xb_add(&bar[XB_TOPGEN], 1u);
            else XB_SPIN(xb_ld(&bar[XB_TOPGEN]) == tg, bar);
            __builtin_amdgcn_fence(__ATOMIC_ACQUIRE, "agent");
            xb_add(&bar[XB_XGEN(b.x)], 1u);
            asm volatile("s_waitcnt vmcnt(0)" ::: "memory");
        } else {
            XB_SPIN(xb_ld(&bar[XB_XGEN(b.x)]) == gen, bar);
            __builtin_amdgcn_fence(__ATOMIC_ACQUIRE, "agent");
            asm volatile("s_waitcnt vmcnt(0)" ::: "memory");
        }
    }
    __syncthreads();
}

namespace pg8 {
constexpr int BM = 256, BK = 64, HALF = 128, HTB = HALF * BK * 2, NXCD = 8, WGM = 8;
DI int lds_byte(int r, int c) { const int st = (r >> 4) * 2 + (c >> 5), rr = r & 15, cc = c & 31, ob = rr * 64 + cc * 2; return st * 1024 + (ob ^ (((ob >> 9) & 1) << 5)); }
DI void stage_rc(int b, int& R, int& C) { const int st = b / 1024, sb = b % 1024, swz = sb ^ (((sb >> 9) & 1) << 5); R = (st >> 1) * 16 + swz / 64; C = (st & 1) * 32 + (swz % 64) / 2; }
DI int perm32(int rho) { const int n = rho >> 4, i = rho & 15; return 8 * (i >> 2) + 4 * n + (i & 3); }

struct Unit { int pm, pn, e, rt, ord, nrows; };

struct DenseOrder {
    const char* A; const char* Bt; int K, nM, nN, nwg, G, c;
    DI void init(const void* A_, const void* Bt_, int M, int N, int K_, int G_, int c_) { A = (const char*)A_; Bt = (const char*)Bt_; K = K_; nM = M / BM; nN = N / BM; nwg = nM * nN; G = G_; c = c_; }
    DI bool next(int i, Unit& u) const {
        const long L = (long)i * G + c; if (L >= nwg) return false;
        int wgid = (int)L; { const int q = nwg / NXCD, r = nwg % NXCD, xcd = wgid % NXCD, off = wgid / NXCD; wgid = (xcd < r ? xcd * (q + 1) : r * (q + 1) + (xcd - r) * q) + off; }
        const int nig = WGM * nN, gid = wgid / nig, fm = gid * WGM, gsz = (nM - fm) < WGM ? (nM - fm) : WGM;
        u.pm = fm + ((wgid % nig) % gsz); u.pn = (wgid % nig) / gsz; u.e = 0; u.rt = u.pm; u.ord = i; u.nrows = 256; return true;
    }
    DI const char* a_base(const Unit& u) const { return A + (size_t)u.pm * BM * K * 2; }
    DI const char* b_base(const Unit& u) const { return Bt + (size_t)u.pn * BM * K * 2; }
    static constexpr bool GATHER_A = false;
    DI void a_offs(const Unit&, int tid, unsigned (&v)[2][2]) const {
#pragma unroll
        for (int i = 0; i < 2; ++i) { int R, C; stage_rc(tid * 16 + i * 8192, R, C);
#pragma unroll
            for (int h = 0; h < 2; ++h) v[h][i] = (unsigned)((h * HALF + R) * K + C) * 2u; }
    }
};

template <bool GATHER> struct MoeOrder {
    const char* A; const char* Bt; const char* BtS; int K, ncol; size_t estride;
    const LAS int* ut; const LAS int* idx; int nunits, nfull;
    static constexpr bool GATHER_A = GATHER;
    DI bool next(int i, Unit& u) const {
        if (i >= nunits) return false;
        int j, pn;
        if (i < nfull) { j = i / ncol; pn = i - j * ncol; } else { j = nfull / ncol + (i - nfull); pn = -1; }
        const v4u t = *(const LAS v4u*)(ut + 4 * j);
        u.ord = j; u.e = (int)t.x; u.pm = (int)t.y; u.rt = (int)t.z; u.nrows = (int)(t.w & 0xffffu); u.pn = pn >= 0 ? pn : (int)(t.w >> 16);
        return true;
    }
    DI const char* a_base(const Unit& u) const { return GATHER ? A : A + (size_t)u.rt * BM * K * 2; }
    DI const char* b_base(const Unit& u) const { return (u.e < 256 ? Bt + (size_t)u.e * estride : BtS) + (size_t)u.pn * BM * K * 2; }
    DI void a_offs(const Unit& u, int tid, unsigned (&v)[2][2]) const {
#pragma unroll
        for (int i = 0; i < 2; ++i) { int R, C; stage_rc(tid * 16 + i * 8192, R, C);
#pragma unroll
            for (int h = 0; h < 2; ++h) {
                if (GATHER) v[h][i] = ((unsigned)idx[u.ord * 256 + h * HALF + R] * (unsigned)K + (unsigned)C) * 2u;
                else v[h][i] = (unsigned)((h * HALF + R) * K + C) * 2u; } }
    }
};

struct GProf { unsigned long long t_loop, t_epi, t_next; };
typedef int v8i __attribute__((ext_vector_type(8)));
template <class Epi, class Sched, bool PROF = false, bool F8 = false>
__device__ __forceinline__ void gemm_phase(LAS unsigned char* lds, const int K, const Sched& S, const Epi& E, const int wid  , GProf* prof = nullptr) {
    unsigned long long pt0 = 0, pt1 = 0, pt2 = 0, pt3 = 0;
    const int tid = threadIdx.x, lane = tid & 63, wr = wid >> 2, wc = wid & 3, fr = lane & 15, fq = lane >> 4;
    const int nt = K / BK;
    unsigned voffBh[2][2];
#pragma unroll
    for (int i = 0; i < 2; ++i) { int R, C; stage_rc(tid * 16 + i * 8192, R, C);
#pragma unroll
        for (int h = 0; h < 2; ++h) { int Rb;
            if (Epi::PERM == 2) Rb = 64 * ((R >> 5) & 3) + 16 * ((R >> 2) & 3) + 8 * h + 4 * ((R >> 4) & 1) + (R & 3);
            else Rb = HALF * h + (Epi::PERM == 1 ? ((R & ~31) + perm32(R & 31)) : R);
            voffBh[h][i] = (unsigned)(Rb * K + C) * 2u; } }
    const size_t kstep = (size_t)(BK * 2);
    const size_t hstep = (size_t)HALF * K * 2;
    const unsigned ldsw = (unsigned)wid * 1024u;
    const int aoff = F8 ? lds_byte(wr * 64 + fr, fq * 16) : lds_byte(wr * 64 + fr, fq * 8), boff = F8 ? lds_byte(wc * 32 + fr, fq * 16) : lds_byte(wc * 32 + fr, fq * 8);
#define PG8_SA(b, h) (((b) * 2 + (h)) * HTB)
#define PG8_SB(b, h) ((4 + (b) * 2 + (h)) * HTB)
#define PG8_STAGE(bufoff, gbase, voff) do { _Pragma("unroll") for (int _i = 0; _i < 2; ++_i) \
        __builtin_amdgcn_global_load_lds((const unsigned*)((const char*)(gbase) + (voff)[_i]), (LAS unsigned*)(lds + (bufoff) + ldsw + _i * 8192), 16, 0, 0); } while (0)
#define PG8_LD8(dst, off) do { const v4u _lo = *(const LAS v4u*)(lds + (off)), _hi = *(const LAS v4u*)(lds + (off) + 16); \
        dst[0] = (int)_lo.x; dst[1] = (int)_lo.y; dst[2] = (int)_lo.z; dst[3] = (int)_lo.w; dst[4] = (int)_hi.x; dst[5] = (int)_hi.y; dst[6] = (int)_hi.z; dst[7] = (int)_hi.w; } while (0)
#define PG8_LDA(dst, b, h) do { if (F8) { _Pragma("unroll") for (int m = 0; m < 4; ++m) PG8_LD8(dst##8[m], PG8_SA(b, h) + aoff + m * 2048); } \
        else { _Pragma("unroll") for (int m = 0; m < 4; ++m) _Pragma("unroll") for (int k = 0; k < 2; ++k) dst[m][k] = *(const LAS bf16x8*)(lds + PG8_SA(b, h) + aoff + m * 2048 + k * 1024); } } while (0)
#define PG8_LDB(dst, b, h) do { if (F8) { _Pragma("unroll") for (int n = 0; n < 2; ++n) PG8_LD8(dst##8[n], PG8_SB(b, h) + boff + n * 2048); } \
        else { _Pragma("unroll") for (int n = 0; n < 2; ++n) _Pragma("unroll") for (int k = 0; k < 2; ++k) dst[n][k] = *(const LAS bf16x8*)(lds + PG8_SB(b, h) + boff + n * 2048 + k * 1024); } } while (0)
#define PG8_MMA(ai, bj, At, Bt) do { __builtin_amdgcn_s_setprio(1); \
        if (F8) { _Pragma("unroll") for (int m = 0; m < 4; ++m) _Pragma("unroll") for (int n = 0; n < 2; ++n) \
            asm volatile("v_mfma_scale_f32_16x16x128_f8f6f4 %0, %1, %2, %0, %3, %3 op_sel_hi:[0,0,0]" : "+v"(acc[ai][bj][m][n]) : "v"(Bt##8[n]), "v"(At##8[m]), "v"(sc127)); } \
        else { _Pragma("unroll") for (int m = 0; m < 4; ++m) _Pragma("unroll") for (int n = 0; n < 2; ++n) _Pragma("unroll") for (int k = 0; k < 2; ++k) \
            acc[ai][bj][m][n] = __builtin_amdgcn_mfma_f32_16x16x32_bf16(Bt[n][k], At[m][k], acc[ai][bj][m][n], 0, 0, 0); } \
        __builtin_amdgcn_s_setprio(0); } while (0)
#define PG8_WAIT_V(n) asm volatile("s_waitcnt vmcnt(" #n ")" ::: "memory")
#define PG8_WAIT_L(n) asm volatile("s_waitcnt lgkmcnt(" #n ")" ::: "memory")
#define PG8_BAR __builtin_amdgcn_s_barrier()
#define PG8_SCHED __builtin_amdgcn_sched_barrier(0)
    Unit cur, nxt; int ui = 0;
    if (!S.next(0, cur)) return;
    f32x4 acc[2][2][4][2];
#pragma unroll
    for (int a = 0; a < 2; ++a)
#pragma unroll
        for (int b = 0; b < 2; ++b)
#pragma unroll
            for (int m = 0; m < 4; ++m)
#pragma unroll
                for (int n = 0; n < 2; ++n) acc[a][b][m][n] = (f32x4){0.f, 0.f, 0.f, 0.f};
    bf16x8 At[4][2], B0[2][2], B1[2][2];
    v8i At8[4], B08[2], B18[2];
    int sc127 = 127; asm volatile("" : "+v"(sc127));
    unsigned vC[2][2], vN[2][2];
    S.a_offs(cur, tid, vC);
    const char* cA = S.a_base(cur); const char* cB = S.b_base(cur);
    PG8_STAGE(PG8_SB(0, 0), cB, voffBh[0]); PG8_STAGE(PG8_SA(0, 0), cA, vC[0]); PG8_STAGE(PG8_SB(0, 1), cB, voffBh[1]); PG8_STAGE(PG8_SA(0, 1), cA, vC[1]);
    if (wr == 1) PG8_BAR;
    PG8_WAIT_V(4); PG8_BAR;
    PG8_STAGE(PG8_SB(1, 0), cB + kstep, voffBh[0]); PG8_STAGE(PG8_SA(1, 0), cA + kstep, vC[0]); PG8_STAGE(PG8_SB(1, 1), cB + kstep, voffBh[1]);
    PG8_WAIT_V(6); PG8_BAR;
    for (;;) {
        if (PROF) pt0 = __builtin_amdgcn_s_memrealtime();
        const bool has_next = S.next(ui + 1, nxt);
        const char* nA = has_next ? S.a_base(nxt) : cA; const char* nB = has_next ? S.b_base(nxt) : cB;
        if (Sched::GATHER_A) { if (has_next) S.a_offs(nxt, tid, vN); else { vN[0][0] = vC[0][0]; vN[0][1] = vC[0][1]; vN[1][0] = vC[1][0]; vN[1][1] = vC[1][1]; } }
        if (PROF) pt1 = __builtin_amdgcn_s_memrealtime();
#pragma unroll 1
        for (int t = 0; t < nt; t += 2) {
            const bool last = (t == nt - 2);
            const char* a1 = cA + (size_t)(t + 1) * kstep;
            const char* a2 = last ? nA : cA + (size_t)(t + 2) * kstep; const char* b2 = last ? nB : cB + (size_t)(t + 2) * kstep;
            const char* a3 = a2 + kstep; const char* b3 = b2 + kstep;
            unsigned x0[2], x1[2];
            if (Sched::GATHER_A) { x0[0] = last ? vN[0][0] : vC[0][0]; x0[1] = last ? vN[0][1] : vC[0][1]; x1[0] = last ? vN[1][0] : vC[1][0]; x1[1] = last ? vN[1][1] : vC[1][1]; }
            else { x0[0] = vC[0][0]; x0[1] = vC[0][1]; x1[0] = vC[1][0]; x1[1] = vC[1][1]; }
            PG8_LDB(B0, 0, 0); PG8_SCHED; PG8_LDA(At, 0, 0); PG8_STAGE(PG8_SA(1, 1), a1, vC[1]);
            PG8_WAIT_L(8); PG8_BAR; PG8_WAIT_L(0); PG8_MMA(0, 0, At, B0); PG8_BAR; PG8_SCHED;
            PG8_LDB(B1, 0, 1); PG8_STAGE(PG8_SB(0, 0), b2, voffBh[0]);
            PG8_BAR; PG8_WAIT_L(0); PG8_MMA(0, 1, At, B1); PG8_BAR;
            PG8_LDA(At, 0, 1); PG8_STAGE(PG8_SA(0, 0), a2, x0);
            PG8_BAR; PG8_WAIT_L(0); PG8_MMA(1, 0, At, B0); PG8_BAR; PG8_SCHED;
            PG8_STAGE(PG8_SB(0, 1), b2, voffBh[1]);
            PG8_WAIT_V(6); PG8_BAR; PG8_MMA(1, 1, At, B1); PG8_BAR;
            PG8_LDB(B0, 1, 0); PG8_SCHED; PG8_LDA(At, 1, 0); PG8_STAGE(PG8_SA(0, 1), a2, x1);
            PG8_WAIT_L(8); PG8_BAR; PG8_WAIT_L(0); PG8_MMA(0, 0, At, B0); PG8_BAR; PG8_SCHED;
            PG8_LDB(B1, 1, 1); PG8_STAGE(PG8_SB(1, 0), b3, voffBh[0]);
            PG8_BAR; PG8_WAIT_L(0); PG8_MMA(0, 1, At, B1); PG8_BAR;
            PG8_LDA(At, 1, 1); PG8_STAGE(PG8_SA(1, 0), a3, x0);
            PG8_BAR; PG8_WAIT_L(0); PG8_MMA(1, 0, At, B0); PG8_BAR; PG8_SCHED;
            PG8_STAGE(PG8_SB(1, 1), b3, voffBh[1]);
            PG8_WAIT_V(6); PG8_BAR; PG8_MMA(1, 1, At, B1); PG8_BAR;
        }
        if (PROF) pt2 = __builtin_amdgcn_s_memrealtime();
        if (F8) asm volatile("s_nop 15\n\ts_nop 15" ::: "memory");
        E(acc, cur, wr, wc, fr, fq);
        if (PROF) { asm volatile("s_waitcnt vmcnt(0)" ::: "memory"); pt3 = __builtin_amdgcn_s_memrealtime(); prof->t_next += pt1 - pt0; prof->t_loop += pt2 - pt1; prof->t_epi += pt3 - pt2; }
        if (!has_next) break;
#pragma unroll
        for (int a = 0; a < 2; ++a)
#pragma unroll
            for (int b = 0; b < 2; ++b)
#pragma unroll
                for (int m = 0; m < 4; ++m)
#pragma unroll
                    for (int n = 0; n < 2; ++n) acc[a][b][m][n] = (f32x4){0.f, 0.f, 0.f, 0.f};
        cur = nxt; cA = nA; cB = nB; ++ui;
        if (Sched::GATHER_A) { vC[0][0] = vN[0][0]; vC[0][1] = vN[0][1]; vC[1][0] = vN[1][0]; vC[1][1] = vN[1][1]; }
    }
    PG8_WAIT_V(0);
    if (wr == 0) PG8_BAR;
    PG8_BAR;
#undef PG8_SA
#undef PG8_SB
#undef PG8_STAGE
#undef PG8_LD8
#undef PG8_LDA
#undef PG8_LDB
#undef PG8_MMA
#undef PG8_WAIT_V
#undef PG8_WAIT_L
#undef PG8_BAR
#undef PG8_SCHED
}

DI float gelu_tanh(float x) { const float u = 1.5957691216f * (x + 0.044715f * x * x * x); return x * rcpf_(1.0f + expf_(-u)); }
DI float silu_f(float x) { return x * rcpf_(1.0f + expf_(-x)); }

struct EpiInProj {
    static constexpr int PERM = 1;
    bf16* P; const float* LB;
    DI void operator()(const f32x4 (&acc)[2][2][4][2], const Unit& u, int wr, int wc, int fr, int fq) const {
        const int row0 = u.pm * BM + wr * 64 + fr, col0 = u.pn * BM + wc * 32 + 8 * fq;
        const int pn = u.pn;
        const int kind = (pn == 2 || pn == 3) ? 1 : (pn >= 8 && pn < 12) ? 2 : (pn >= 12) ? 3 : 0;
        f32x4 lbv[2][2];
        { const int dir = (pn >> 1) & 1; const int cc = (pn & 1) * 256 + wc * 32 + 8 * fq;
#pragma unroll
            for (int bj = 0; bj < 2; ++bj)
#pragma unroll
                for (int n = 0; n < 2; ++n) lbv[bj][n] = *(const f32x4*)(LB + dir * 512 + cc + bj * HALF + 4 * n);
            asm volatile("" :: "v"(lbv[0][0]), "v"(lbv[0][1]), "v"(lbv[1][0]), "v"(lbv[1][1])); }
#pragma unroll
        for (int ai = 0; ai < 2; ++ai)
#pragma unroll
            for (int m = 0; m < 4; ++m) { bf16* rowp = P + (size_t)(row0 + ai * HALF + m * 16) * INC + col0;
#pragma unroll
                for (int bj = 0; bj < 2; ++bj) { f32x4 v0 = acc[ai][bj][m][0], v1 = acc[ai][bj][m][1];
                    if (kind == 1) {
#pragma unroll
                        for (int j = 0; j < 4; ++j) { v0[j] = gelu_tanh(v0[j]); v1[j] = gelu_tanh(v1[j]); } }
                    else if (kind == 2) {
#pragma unroll
                        for (int j = 0; j < 4; ++j) { const float l0 = lbv[bj][0][j], l1 = lbv[bj][1][j];
                            v0[j] = logf_(l0 + (1.0f - l0) * sigm(v0[j])); v1[j] = logf_(l1 + (1.0f - l1) * sigm(v1[j])); } }
                    else if (kind == 3) {
#pragma unroll
                        for (int j = 0; j < 4; ++j) { v0[j] = silu_f(v0[j]); v1[j] = silu_f(v1[j]); } }
                    v4u w; w.x = pk2(v0[0], v0[1]); w.y = pk2(v0[2], v0[3]); w.z = pk2(v1[0], v1[1]); w.w = pk2(v1[2], v1[3]);
                    *(v4u*)(rowp + bj * HALF) = w; } }
    }
};
struct EpiResid {
    static constexpr int PERM = 1;
    const float* x; const float* mod; bf16* X1;
    DI void operator()(const f32x4 (&acc)[2][2][4][2], const Unit& u, int wr, int wc, int fr, int fq) const {
        const int row0 = u.pm * BM + wr * 64 + fr, col0 = u.pn * BM + wc * 32 + 8 * fq;
        const int b = (u.pm * BM) >> 11;
        f32x4 gv[2][2];
#pragma unroll
        for (int bj = 0; bj < 2; ++bj)
#pragma unroll
            for (int n = 0; n < 2; ++n) gv[bj][n] = *(const f32x4*)(mod + (size_t)b * 6144 + 2048 + col0 + bj * HALF + 4 * n);
        asm volatile("" :: "v"(gv[0][0]), "v"(gv[0][1]), "v"(gv[1][0]), "v"(gv[1][1]));
#pragma unroll
        for (int ai = 0; ai < 2; ++ai)
#pragma unroll
            for (int m = 0; m < 4; ++m) { const size_t off = (size_t)(row0 + ai * HALF + m * 16) * D + col0;
#pragma unroll
                for (int bj = 0; bj < 2; ++bj) { const f32x4 x0 = *(const f32x4*)(x + off + bj * HALF), x1 = *(const f32x4*)(x + off + bj * HALF + 4);
                    const f32x4 v0 = x0 + gv[bj][0] * acc[ai][bj][m][0], v1 = x1 + gv[bj][1] * acc[ai][bj][m][1];
                    v4u w; w.x = pk2(v0[0], v0[1]); w.y = pk2(v0[2], v0[3]); w.z = pk2(v1[0], v1[1]); w.w = pk2(v1[2], v1[3]);
                    *(v4u*)(X1 + off + bj * HALF) = w; } }
    }
};
struct EpiF32 {
    static constexpr int PERM = 0;
    float* C; int ldc;
    DI void operator()(const f32x4 (&acc)[2][2][4][2], const Unit& u, int wr, int wc, int fr, int fq) const {
        const int row0 = u.pm * BM + wr * 64 + fr, col0 = u.pn * BM + wc * 32 + 4 * fq;
#pragma unroll
        for (int ai = 0; ai < 2; ++ai)
#pragma unroll
            for (int m = 0; m < 4; ++m) { float* rowp = C + (size_t)(row0 + ai * HALF + m * 16) * ldc + col0;
#pragma unroll
                for (int bj = 0; bj < 2; ++bj)
#pragma unroll
                    for (int n = 0; n < 2; ++n) *(f32x4*)(rowp + bj * HALF + n * 16) = acc[ai][bj][m][n]; }
    }
};
struct EpiSwiGLU8 {
    static constexpr int PERM = 1;
    unsigned char* ACT;
    DI void operator()(const f32x4 (&acc)[2][2][4][2], const Unit& u, int wr, int wc, int fr, int fq) const {
        const unsigned off0 = ((unsigned)u.rt * 256u + (unsigned)(wr * 64 + fr)) * (unsigned)DE + (unsigned)(u.pn * 128 + wc * 32 + 8 * fq);
#pragma unroll
        for (int ai = 0; ai < 2; ++ai)
#pragma unroll
            for (int m = 0; m < 4; ++m) {
                f32x4 a0 = acc[ai][0][m][0] * 0.03125f, a1 = acc[ai][0][m][1] * 0.03125f; const f32x4 g0 = acc[ai][1][m][0] * 0.25f, g1 = acc[ai][1][m][1] * 0.25f;
#pragma unroll
                for (int j = 0; j < 4; ++j) { a0[j] = silu_f(a0[j]) * g0[j]; a1[j] = silu_f(a1[j]) * g1[j]; }
                v2u w; w.x = pk4_f8(a0[0], a0[1], a0[2], a0[3]); w.y = pk4_f8(a1[0], a1[1], a1[2], a1[3]);
                *(v2u*)(ACT + (off0 + (unsigned)((ai * HALF + m * 16) * DE))) = w; }
    }
};
struct EpiSwiGLU {
    static constexpr int PERM = 1;
    bf16* ACT;
    DI void operator()(const f32x4 (&acc)[2][2][4][2], const Unit& u, int wr, int wc, int fr, int fq) const {
        const int row0 = wr * 64 + fr, col0 = u.pn * 128 + wc * 32 + 8 * fq;
        bf16* base = ACT + (size_t)u.rt * 256 * DE;
#pragma unroll
        for (int ai = 0; ai < 2; ++ai)
#pragma unroll
            for (int m = 0; m < 4; ++m) { bf16* rowp = base + (size_t)(row0 + ai * HALF + m * 16) * DE + col0;
                f32x4 a0 = acc[ai][0][m][0], a1 = acc[ai][0][m][1]; const f32x4 g0 = acc[ai][1][m][0], g1 = acc[ai][1][m][1];
#pragma unroll
                for (int j = 0; j < 4; ++j) { a0[j] = silu_f(a0[j]) * g0[j]; a1[j] = silu_f(a1[j]) * g1[j]; }
                v4u w; w.x = pk2(a0[0], a0[1]); w.y = pk2(a0[2], a0[3]); w.z = pk2(a1[0], a1[1]); w.w = pk2(a1[2], a1[3]);
                *(v4u*)rowp = w; }
    }
};
struct EpiScatter {
    static constexpr int PERM = 2;
    unsigned char* YE; const LAS float* gate; float oscale;
    DI void operator()(const f32x4 (&acc)[2][2][4][2], const Unit& u, int wr, int wc, int fr, int fq) const {
        const unsigned col0 = (unsigned)(u.pn * BM + wc * 64 + 16 * fq);
        float gt[2][4];
#pragma unroll
        for (int ai = 0; ai < 2; ++ai)
#pragma unroll
            for (int m = 0; m < 4; ++m) gt[ai][m] = gate[u.ord * 256 + ai * HALF + wr * 64 + m * 16 + fr] * oscale;
#pragma unroll
        for (int ai = 0; ai < 2; ++ai)
#pragma unroll
            for (int m = 0; m < 4; ++m) { const int r = ai * HALF + wr * 64 + m * 16 + fr; const float g = gt[ai][m];
                const unsigned row = (r < u.nrows) ? (unsigned)u.rt * 256u + (unsigned)r : 360448u;
                const f32x4 v0 = acc[ai][0][m][0] * g, v1 = acc[ai][0][m][1] * g, v2 = acc[ai][1][m][0] * g, v3 = acc[ai][1][m][1] * g;
                v4u w; w.x = pk4_f8(v0[0], v0[1], v0[2], v0[3]); w.y = pk4_f8(v1[0], v1[1], v1[2], v1[3]); w.z = pk4_f8(v2[0], v2[1], v2[2], v2[3]); w.w = pk4_f8(v3[0], v3[1], v3[2], v3[3]);
                *(v4u*)(YE + (row * (unsigned)D + col0)) = w; }
    }
};
}

struct Args { const float* in[26]; float* out; unsigned char* ws; int ph_lo, ph_hi; };
enum { I_X = 0, I_C, I_CTX, I_CCTX, I_ADAW, I_ADAB, I_NMIX, I_NFFN, I_NFIN, I_WIN, I_WOUT, I_CONVW, I_CONVB, I_WA, I_BA, I_WX, I_BX, I_LAM,
       I_LBL, I_HNORM, I_RW, I_RB, I_EW13, I_EW2, I_SW13, I_SW2 };

struct Frame {
    LAS unsigned char* lds;
    int tid, lane, wave, G, vcu, bx;
    const float* const* in; float* out; unsigned char* ws;
};

DI void transpose_item(const float* W, int ldw, bf16* WT, int ldo, int k0, int n0, int orow0, LAS float* scr, int lane) {
    const int sub = lane >> 3, c4 = (lane & 7) * 4;
    f32x4 v[8];
#pragma unroll
    for (int i = 0; i < 8; ++i) v[i] = __builtin_nontemporal_load((const f32x4*)(W + (size_t)(k0 + 8 * i + sub) * ldw + n0 + c4));
#pragma unroll
    for (int i = 0; i < 8; ++i) { LAS float* d = scr + (8 * i + sub) * 33 + c4; d[0] = v[i].x; d[1] = v[i].y; d[2] = v[i].z; d[3] = v[i].w; }
    LDS_WAIT(); asm volatile("" ::: "memory");
    const int c = lane & 7;
#pragma unroll
    for (int j = 0; j < 4; ++j) { const int n = (lane >> 3) + 8 * j; const LAS float* s = scr + (8 * c) * 33 + n;
        v4u o; o.x = pk2(s[0 * 33], s[1 * 33]); o.y = pk2(s[2 * 33], s[3 * 33]); o.z = pk2(s[4 * 33], s[5 * 33]); o.w = pk2(s[6 * 33], s[7 * 33]);
        *(v4u*)(WT + (size_t)(orow0 + n) * ldo + k0 + 8 * c) = o; }
    LDS_WAIT(); asm volatile("" ::: "memory");
}
DI void transpose_item8(const float* W, int ldw, unsigned char* WT, int ldo, int k0, int n0, int orow0, float scale, LAS float* scr, int lane) {
    const int sub = lane >> 3, c4 = (lane & 7) * 4;
    f32x4 v[16];
#pragma unroll
    for (int i = 0; i < 16; ++i) v[i] = __builtin_nontemporal_load((const f32x4*)(W + (size_t)(k0 + 8 * i + sub) * ldw + n0 + c4));
#pragma unroll
    for (int i = 0; i < 16; ++i) { LAS float* d = scr + (8 * i + sub) * 33 + c4; d[0] = v[i].x; d[1] = v[i].y; d[2] = v[i].z; d[3] = v[i].w; }
    LDS_WAIT(); asm volatile("" ::: "memory");
    const int c = lane & 7;
#pragma unroll
    for (int j = 0; j < 4; ++j) { const int n = (lane >> 3) + 8 * j; const LAS float* sp = scr + (16 * c) * 33 + n;
        v4u o; o.x = pk4_f8(sp[0] * scale, sp[33] * scale, sp[66] * scale, sp[99] * scale); o.y = pk4_f8(sp[132] * scale, sp[165] * scale, sp[198] * scale, sp[231] * scale);
        o.z = pk4_f8(sp[264] * scale, sp[297] * scale, sp[330] * scale, sp[363] * scale); o.w = pk4_f8(sp[396] * scale, sp[429] * scale, sp[462] * scale, sp[495] * scale);
        *(v4u*)(WT + (size_t)(orow0 + n) * ldo + k0 + 16 * c) = o; }
    LDS_WAIT(); asm volatile("" ::: "memory");
}
DI int w13_row(int n) { const int half = n >> 8, idx = n & 255; return 256 * (idx >> 7) + 128 * half + (idx & 127); }

DI void phase_prologue(const Frame& F) {
    const float* const* in = F.in; unsigned char* ws = F.ws;
    {
        LAS float* sc = (LAS float*)F.lds;
        LAS float* red = (LAS float*)(F.lds + 17 * 1024 * 4);
        for (int i = F.tid; i < 17 * 1024; i += NTHR) { const int r = i >> 10, k = i & 1023; const float v = (r < 16) ? in[I_C][r * 1024 + k] : in[I_CCTX][k]; sc[i] = v / (1.0f + __expf(-v)); }
        __syncthreads();
        const float* aw = in[I_ADAW]; float* MOD = (float*)(ws + WS_MOD);
        for (int cg = F.bx; cg < 256; cg += F.G) {
            const int kg = F.tid >> 5, cl = F.tid & 31, col = cg * 24 + cl;
            float a[17];
#pragma unroll
            for (int r = 0; r < 17; ++r) a[r] = 0.f;
            if (cl < 24) {
#pragma unroll 1
                for (int k8 = 0; k8 < 64; k8 += 16) { float w[16];
#pragma unroll
                    for (int q = 0; q < 16; ++q) w[q] = aw[(size_t)(kg * 64 + k8 + q) * 6144 + col];
#pragma unroll
                    for (int q = 0; q < 16; ++q) { const int k = kg * 64 + k8 + q;
#pragma unroll
                        for (int r = 0; r < 17; ++r) a[r] += sc[r * 1024 + k] * w[q]; } }
#pragma unroll
                for (int r = 0; r < 17; ++r) red[(kg * 17 + r) * 24 + cl] = a[r];
            }
            __syncthreads();
            if (F.tid < 17 * 24) { const int r = F.tid / 24, c2 = F.tid % 24; float s = 0.f;
                for (int g = 0; g < 16; ++g) s += red[(g * 17 + r) * 24 + c2];
                MOD[r * 6144 + cg * 24 + c2] = s + in[I_ADAB][cg * 24 + c2]; }
            __syncthreads();
        }
    }
    {
        float* LB = (float*)(ws + WS_TAB); float* SP = LB + 1024;
        const int gt = F.bx * NTHR + F.tid, GT = F.G * NTHR;
        for (int i = gt; i < 1024; i += GT) { const int d = i >> 9, c = i & 511;
            const float l0 = in[I_LBL][(d * 2 + 0) * 512 + c], l1 = in[I_LBL][(d * 2 + 1) * 512 + c];
            LB[i] = 1.0f / (1.0f + expf(l1 - l0));
            SP[i] = log1pf(expf(-in[I_LAM][i])); }
        bf16* WGT = (bf16*)(ws + WS_WGT);
        for (int i = gt; i < 2 * 2 * 8 * 64 * 64; i += GT) { const int ii = i & 63, j = (i >> 6) & 63, h = (i >> 12) & 7, g = (i >> 15) & 1, d = i >> 16;
            const float* src = g ? in[I_WX] : in[I_WA];
            WGT[i] = f2bf(src[((size_t)(d * 8 + h) * 64 + ii) * 64 + j]); }
    }
    {
        LAS float* scr = (LAS float*)(F.lds + F.wave * 16896);
        const int gw = F.vcu * NWAVES + F.wave, NGW = F.G * NWAVES;
        constexpr int IT_WIN = 16 * 112, IT_WOUT = 16 * 32, IT_WR = 16 * 8, IT_SW13 = 8 * 16, IT_SW2 = 2 * 32;
        LAS float* scr8 = (LAS float*)(F.lds + F.wave * 16896);
        constexpr int NIT = IT_WIN + IT_WOUT + IT_WR + IT_SW13 + IT_SW2;
        for (int it = gw; it < NIT; it += NGW) {
            int r = it;
            if (r < IT_WIN) { const int kb = r / 112, nb = r % 112; transpose_item(in[I_WIN], INC, (bf16*)(ws + WS_WIN), 1024, kb * 64, nb * 32, nb * 32, scr, F.lane); continue; } r -= IT_WIN;
            if (r < IT_WOUT) { const int kb = r / 32, nb = r % 32; transpose_item(in[I_WOUT], 1024, (bf16*)(ws + WS_WOUT), 1024, kb * 64, nb * 32, nb * 32, scr, F.lane); continue; } r -= IT_WOUT;
            if (r < IT_WR) { const int kb = r / 8, nb = r % 8; transpose_item(in[I_RW], 256, (bf16*)(ws + WS_WR), 1024, kb * 64, nb * 32, nb * 32, scr, F.lane); continue; } r -= IT_WR;
            if (r < IT_SW13) { const int kb = r / 16, nb = r % 16; transpose_item8(in[I_SW13], 512, ws + WS_SW13, 1024, kb * 128, nb * 32, w13_row(nb * 32), 32.0f, scr8, F.lane); continue; } r -= IT_SW13;
            { const int kb = r / 32, nb = r % 32; transpose_item8(in[I_SW2], 1024, ws + WS_SW2, 256, kb * 128, nb * 32, nb * 32, 16.0f, scr8, F.lane); }
        }
    }
}
constexpr int CV_STR = 132, CV_B = 128 * CV_STR * 4, CV_STR2 = 144;
static_assert(CV_B + 128 * CV_STR2 <= LDS_MISC, "convert lds");
DI void convert_experts(const Frame& F, const unsigned* stop_ctr, unsigned stop_val) {
    const float* const* in = F.in; unsigned char* ws = F.ws;
    LAS float* scr = (LAS float*)F.lds; LAS unsigned char* img = F.lds + CV_B;
    volatile LAS int* slot = (volatile LAS int*)(F.lds + LDS_MISC + 48);
    unsigned* qhead = (unsigned*)(ws + WS_CTL) + CW_CONVQ;
    constexpr int NB13 = 256 * 32, NB2 = 256 * 16;
    auto decode = [&](int blk, const float*& src, int& ldw, unsigned char*& dst, int& ldo, int& orow0, float& scale) {
        if (blk < NB13) { const int e = blk >> 5, q = blk & 31, nb = q >> 3, kb = q & 7;
            src = in[I_EW13] + (size_t)e * 1024 * 512 + (size_t)(kb * 128) * 512 + nb * 128; ldw = 512;
            dst = ws + WS_EW13 + (size_t)e * 512 * 1024 + kb * 128; ldo = 1024; orow0 = w13_row(nb * 128); scale = 32.0f; }
        else { const int r = blk - NB13, e = r >> 4, q = r & 15, nb = q >> 1, kb = q & 1;
            src = in[I_EW2] + (size_t)e * 256 * 1024 + (size_t)(kb * 128) * 1024 + nb * 128; ldw = 1024;
            dst = ws + WS_EW2 + (size_t)e * 1024 * 256 + kb * 128; ldo = 256; orow0 = nb * 128; scale = 16.0f; } };
    int ch_next = 0, ch_left = 0;
    auto claim = [&]() -> int {
        if (ch_left == 0) { __syncthreads();
            if (F.tid == 0) { int v = 0x7fffffff;
                if (!stop_ctr || __hip_atomic_load(stop_ctr, __ATOMIC_RELAXED, __HIP_MEMORY_SCOPE_AGENT) < stop_val) v = (int)__hip_atomic_fetch_add(qhead, 4u, __ATOMIC_RELAXED, __HIP_MEMORY_SCOPE_AGENT);
                slot[0] = v; }
            __syncthreads(); ch_next = slot[0]; ch_left = 4; }
        const int r = ch_next; if (ch_next < 0x7ffffff0) ++ch_next; --ch_left; return r; };
    f32x4 v[8];
    int blk = claim();
    const float* src = nullptr; int ldw = 0; unsigned char* dst = nullptr; int ldo = 0, orow0 = 0; float scale = 1.f;
    if (blk < NB13 + NB2) { decode(blk, src, ldw, dst, ldo, orow0, scale);
#pragma unroll
        for (int i = 0; i < 8; ++i) { const int p = F.tid + NTHR * i; v[i] = *(const f32x4*)(src + (size_t)(p >> 5) * ldw + (p & 31) * 4); } }
    while (blk < NB13 + NB2) {
#pragma unroll
        for (int i = 0; i < 8; ++i) { const int p = F.tid + NTHR * i; *(LAS f32x4*)(scr + (p >> 5) * CV_STR + (p & 31) * 4) = v[i]; }
        unsigned char* cdst = dst; const int cldo = ldo, corow0 = orow0; const float cscale = scale;
        blk = claim();
        if (blk < NB13 + NB2) { decode(blk, src, ldw, dst, ldo, orow0, scale);
#pragma unroll
            for (int i = 0; i < 8; ++i) { const int p = F.tid + NTHR * i; v[i] = *(const f32x4*)(src + (size_t)(p >> 5) * ldw + (p & 31) * 4); } }
        __syncthreads();
#pragma unroll
        for (int i = 0; i < 2; ++i) { const int n = F.tid & 127, kc = ((F.tid >> 7) + 4 * i) * 16;
            const LAS float* sp = scr + kc * CV_STR + n;
            v4u o; o.x = pk4_f8(sp[0] * cscale, sp[CV_STR] * cscale, sp[2 * CV_STR] * cscale, sp[3 * CV_STR] * cscale);
            o.y = pk4_f8(sp[4 * CV_STR] * cscale, sp[5 * CV_STR] * cscale, sp[6 * CV_STR] * cscale, sp[7 * CV_STR] * cscale);
            o.z = pk4_f8(sp[8 * CV_STR] * cscale, sp[9 * CV_STR] * cscale, sp[10 * CV_STR] * cscale, sp[11 * CV_STR] * cscale);
            o.w = pk4_f8(sp[12 * CV_STR] * cscale, sp[13 * CV_STR] * cscale, sp[14 * CV_STR] * cscale, sp[15 * CV_STR] * cscale);
            *(LAS v4u*)(img + n * CV_STR2 + kc) = o; }
        __syncthreads();
#pragma unroll
        for (int i = 0; i < 2; ++i) { const int p = F.tid + NTHR * i; const int n = p >> 3, pc = (p & 7) * 16;
            *(v4u*)(cdst + (size_t)(corow0 + n) * cldo + pc) = *(const LAS v4u*)(img + n * CV_STR2 + pc); }
    }
    __syncthreads();
}

DI void phase_norm_rows(const Frame& F, int mode) {
    const float* MOD = (const float*)(F.ws + WS_MOD);
    const int gw = F.bx * NWAVES + F.wave, NGW = F.G * NWAVES;
    const int nrows = mode == 0 ? MTOT : NTOK;
    const float* gain = mode == 0 ? F.in[I_NMIX] : F.in[I_NFFN];
    bf16* dst = (bf16*)(F.ws + (mode == 0 ? WS_HX : WS_HX2));
    const int sh_off = mode == 0 ? 0 : 3072, sc_off = mode == 0 ? 1024 : 4096;
    const int per = (nrows + NGW - 1) / NGW, r0 = gw * per, r1 = (r0 + per < nrows) ? r0 + per : nrows;
    f32x4 gn[4];
#pragma unroll
    for (int j = 0; j < 4; ++j) gn[j] = *(const f32x4*)(gain + 4 * F.lane + 256 * j);
    auto rowsrc = [&](int m) -> const float* {
        return (m < NTOK) ? F.in[I_X] + (size_t)m * D : F.in[I_CTX] + (size_t)(m - NTOK) * D; };
    const bf16* X1b = (const bf16*)(F.ws + WS_X1);
    auto ldrow = [&](int m, f32x4 (&v)[4]) {
        if (mode == 0) {
#pragma unroll
            for (int j = 0; j < 4; ++j) v[j] = *(const f32x4*)(rowsrc(m) + 4 * F.lane + 256 * j); }
        else {
#pragma unroll
            for (int j = 0; j < 4; ++j) { const v2u t = *(const v2u*)(X1b + (size_t)m * D + 4 * F.lane + 256 * j); v[j] = (f32x4){bflo(t.x), bfhi(t.x), bflo(t.y), bfhi(t.y)}; } } };
    f32x4 va[4], vb[4], ga[4], sb4[4]; int cur_mr = -1;
#pragma unroll
    for (int j = 0; j < 4; ++j) { ga[j] = gn[j]; sb4[j] = gn[j]; }
    if (r0 < r1) { ldrow(r0, va); ldrow((r0 + 1 < r1) ? r0 + 1 : r0, vb); }
#pragma unroll 1
    for (int m = r0; m < r1; m += 2) {
        f32x4 ca[4], cb[4];
#pragma unroll
        for (int j = 0; j < 4; ++j) { ca[j] = va[j]; cb[j] = vb[j]; }
        const bool hasb = (m + 1 < r1);
        { const int na = (m + 2 < r1) ? m + 2 : m, nb = (m + 3 < r1) ? m + 3 : na; ldrow(na, va); ldrow(nb, vb); }
        float sa = 0.f, sb = 0.f;
#pragma unroll
        for (int j = 0; j < 4; ++j) { sa += (ca[j].x * ca[j].x + ca[j].y * ca[j].y) + (ca[j].z * ca[j].z + ca[j].w * ca[j].w); sb += (cb[j].x * cb[j].x + cb[j].y * cb[j].y) + (cb[j].z * cb[j].z + cb[j].w * cb[j].w); }
        const float rsa = rsqrtf(wave_sum_fast(sa) * (1.0f / D) + EPS), rsb = rsqrtf(wave_sum_fast(sb) * (1.0f / D) + EPS);
#pragma unroll
        for (int q = 0; q < 2; ++q) {
            if (q == 1 && !hasb) break;
            const int mm = m + q; const float rs = q ? rsb : rsa;
            const int mr = (mode == 0 && mm >= NTOK) ? 16 : (mm >> 11);
            if (mr != cur_mr) { cur_mr = mr;
#pragma unroll
                for (int j = 0; j < 4; ++j) { const int c = 4 * F.lane + 256 * j;
                    ga[j] = gn[j] * (*(const f32x4*)(MOD + mr * 6144 + sc_off + c) + 1.0f); sb4[j] = *(const f32x4*)(MOD + mr * 6144 + sh_off + c); } }
#pragma unroll
            for (int j = 0; j < 4; ++j) { const int c = 4 * F.lane + 256 * j;
                const f32x4 v = q ? cb[j] : ca[j];
                const f32x4 y = (v * rs) * ga[j] + sb4[j];
                v2u w; w.x = pk2(y.x, y.y); w.y = pk2(y.z, y.w);
                *(v2u*)(dst + (size_t)mm * D + c) = w;
                if (mode == 1) *(unsigned*)(F.ws + WS_HX2F + (size_t)mm * D + c) = pk4_f8(y.x, y.y, y.z, y.w); }
        }
    }
}

constexpr int LT_STR = 520;
constexpr int L_RT = 0;
constexpr int L_GT = 69888;
static_assert(L_GT + 64 * LT_STR * 2 <= LDS_MISC, "lru lds");
template <int MODE, int dir> DI void lru_dir(const Frame& F, const int b, const int s, const int h, const int fr, const int fq, const int prow0, const bf16x8 (&Af)[4][2],
                                            const bf16* WGT, const float* SP, LAS bf16* hlb, LAS bf16* gtb, LAS bf16* GT, LAS bf16* HL) {
#pragma unroll 1
        for (int nt = 0; nt < 4; ++nt) {
            const int cj = 64 * h + 16 * nt + fr;
            bf16x8 Ba[2], Bx[2], Id[2];
#pragma unroll
            for (int ks = 0; ks < 2; ++ks) {
                Ba[ks] = *(const bf16x8*)(WGT + ((size_t)((dir * 2 + 0) * 8 + h) * 64 + 16 * nt + fr) * 64 + 32 * ks + 8 * fq);
                Bx[ks] = *(const bf16x8*)(WGT + ((size_t)((dir * 2 + 1) * 8 + h) * 64 + 16 * nt + fr) * 64 + 32 * ks + 8 * fq);
#pragma unroll
                for (int jj = 0; jj < 8; ++jj) Id[ks][jj] = (32 * ks + 8 * fq + jj == 16 * nt + fr) ? (short)0x3F80 : (short)0;
            }
            const float ba = F.in[I_BA][dir * 512 + cj], bx = F.in[I_BX][dir * 512 + cj], sp = SP[dir * 512 + cj];
            float cin = 0.f, ptot = 1.f;
#pragma unroll
            for (int tti = 0; tti < 4; ++tti) {
                const int tt = dir ? 3 - tti : tti;
                const bf16x8 A0 = dir ? Af[3 - tti][0] : Af[tti][0], A1 = dir ? Af[3 - tti][1] : Af[tti][1];
                f32x4 pa = {0.f, 0.f, 0.f, 0.f}, px = {0.f, 0.f, 0.f, 0.f}, uc = {0.f, 0.f, 0.f, 0.f};
                pa = __builtin_amdgcn_mfma_f32_16x16x32_bf16(A0, Ba[0], pa, 0, 0, 0); pa = __builtin_amdgcn_mfma_f32_16x16x32_bf16(A1, Ba[1], pa, 0, 0, 0);
                px = __builtin_amdgcn_mfma_f32_16x16x32_bf16(A0, Bx[0], px, 0, 0, 0); px = __builtin_amdgcn_mfma_f32_16x16x32_bf16(A1, Bx[1], px, 0, 0, 0);
                uc = __builtin_amdgcn_mfma_f32_16x16x32_bf16(A0, Id[0], uc, 0, 0, 0); uc = __builtin_amdgcn_mfma_f32_16x16x32_bf16(A1, Id[1], uc, 0, 0, 0);
                float av[4], bv[4];
#pragma unroll
                for (int ri = 0; ri < 4; ++ri) { const float pav = dir ? pa[3 - ri] : pa[ri], pxv = dir ? px[3 - ri] : px[ri], ucv = dir ? uc[3 - ri] : uc[ri];
                    const float rg = sigm(pav + ba), ig = sigm(pxv + bx);
                    const float a = expf_(-8.0f * rg * sp); av[ri] = a; bv[ri] = __builtin_amdgcn_sqrtf(fmaxf(1.0f - a * a, 0.f)) * ig * ucv; }
                float pl = 1.f, hl = 0.f;
#pragma unroll
                for (int ri = 0; ri < 4; ++ri) { hl = av[ri] * hl + bv[ri]; pl *= av[ri]; }
                float pg[4], hg[4];
#pragma unroll
                for (int gi = 0; gi < 4; ++gi) { const int g = dir ? 3 - gi : gi; pg[gi] = __shfl(pl, fr + 16 * g); hg[gi] = __shfl(hl, fr + 16 * g); }
                const int myg = dir ? 3 - fq : fq;
                float mycin = cin, run = cin, myp = ptot, prun = ptot;
#pragma unroll
                for (int gi = 0; gi < 4; ++gi) { if (gi == myg) { mycin = run; myp = prun; } run = pg[gi] * run + hg[gi]; prun *= pg[gi]; }
                if (MODE == 1) { float hc = mycin, pc = myp;
#pragma unroll
                    for (int ri = 0; ri < 4; ++ri) { const int r = dir ? 3 - ri : ri; hc = av[ri] * hc + bv[ri]; pc *= av[ri];
                        const int o = (16 * tt + r) * LT_STR + 16 * nt;
                        hlb[o] = f2bf(dir == 0 ? hc : bf2f(hlb[o]) + hc); gtb[o] = f2bf(pc); } }
                ptot = prun;
                cin = run;
            }
            if (fq == 0) { const size_t o = ((size_t)(dir * NB + b) * NSEQT + s) * 512 + cj;
                ((float*)(F.ws + WS_SUMA))[o] = ptot; ((float*)(F.ws + WS_SUMH))[o] = cin; }
        }
        if (MODE == 1) {
            __syncthreads();
            bf16* PD = (bf16*)(F.ws + (dir ? WS_LPB : WS_LPF)); bf16* HSg = (bf16*)(F.ws + WS_LHS);
#pragma unroll
            for (int it = 0; it < 8; ++it) { const int p = F.tid + it * NTHR; const int row = p >> 6, pc = p & 63;
                *(v4u*)(PD + (size_t)(prow0 + row) * 512 + 8 * pc) = *(const LAS v4u*)(GT + row * LT_STR + 8 * pc);
                if (dir == 1) *(v4u*)(HSg + (size_t)(prow0 + row) * 512 + 8 * pc) = *(const LAS v4u*)(HL + row * LT_STR + 8 * pc); }
            __syncthreads();
        }
}
template <int MODE> DI void lru_tile(const Frame& F, int b, int s) {
    const bf16* P = (const bf16*)(F.ws + WS_P);
    const int h = F.wave, fr = F.lane & 15, fq = F.lane >> 4;
    int prow0, L, t0;
    if (s < 4) { prow0 = NTOK + b * CTXL + 64 * s; L = CTXL; t0 = 64 * s; } else { prow0 = b * SEQ + 64 * (s - 4); L = SEQ; t0 = 64 * (s - 4); }
    LAS bf16* RT = (LAS bf16*)(F.lds + L_RT); LAS bf16* GT = (LAS bf16*)(F.lds + L_GT);
#pragma unroll
    for (int it = 0; it < 9; ++it) { const int p = F.tid + it * NTHR;
        if (p < 67 * 64) { const int row = p >> 6, pc = p & 63, ts = t0 + row - 1;
            v4u v = {0u, 0u, 0u, 0u};
            if (ts >= 0 && ts < L) v = *(const v4u*)(P + (size_t)(prow0 + row - 1) * INC + 8 * pc);
            *(LAS v4u*)(RT + row * LT_STR + 8 * pc) = v; } }
    __syncthreads();
    bf16x8 Af[4][2];
#pragma unroll
    for (int ks = 0; ks < 2; ++ks) {
        const int c0 = 64 * h + 32 * ks + 8 * fq;
        float cw[4][8], cb[8];
#pragma unroll
        for (int k = 0; k < 4; ++k) { const f32x4 w0 = *(const f32x4*)(F.in[I_CONVW] + k * 512 + c0), w1 = *(const f32x4*)(F.in[I_CONVW] + k * 512 + c0 + 4);
            cw[k][0] = w0.x; cw[k][1] = w0.y; cw[k][2] = w0.z; cw[k][3] = w0.w; cw[k][4] = w1.x; cw[k][5] = w1.y; cw[k][6] = w1.z; cw[k][7] = w1.w; }
        { const f32x4 w0 = *(const f32x4*)(F.in[I_CONVB] + c0), w1 = *(const f32x4*)(F.in[I_CONVB] + c0 + 4);
            cb[0] = w0.x; cb[1] = w0.y; cb[2] = w0.z; cb[3] = w0.w; cb[4] = w1.x; cb[5] = w1.y; cb[6] = w1.z; cb[7] = w1.w; }
        const LAS bf16* rbase = RT + fr * LT_STR + c0;
#pragma unroll
        for (int tt = 0; tt < 4; ++tt) {
            float u[8];
#pragma unroll
            for (int j = 0; j < 8; ++j) u[j] = cb[j];
#pragma unroll
            for (int k = 0; k < 4; ++k) { const v4u r8 = *(const LAS v4u*)(rbase + (16 * tt + k) * LT_STR);
                u[0] += cw[k][0] * bflo(r8.x); u[1] += cw[k][1] * bfhi(r8.x); u[2] += cw[k][2] * bflo(r8.y); u[3] += cw[k][3] * bfhi(r8.y);
                u[4] += cw[k][4] * bflo(r8.z); u[5] += cw[k][5] * bfhi(r8.z); u[6] += cw[k][6] * bflo(r8.w); u[7] += cw[k][7] * bfhi(r8.w); }
            v4u w; w.x = pk2(u[0], u[1]); w.y = pk2(u[2], u[3]); w.z = pk2(u[4], u[5]); w.w = pk2(u[6], u[7]);
            Af[tt][ks] = __builtin_bit_cast(bf16x8, w);
        }
    }
    const bf16* WGT = (const bf16*)(F.ws + WS_WGT);
    const float* SP = (const float*)(F.ws + WS_TAB) + 1024;
    LAS bf16* HL = RT;
    LAS bf16* hlb = HL + (4 * fq) * LT_STR + 64 * h + fr;
    LAS bf16* gtb = GT + (4 * fq) * LT_STR + 64 * h + fr;
    lru_dir<MODE, 0>(F, b, s, h, fr, fq, prow0, Af, WGT, SP, hlb, gtb, GT, HL);
    lru_dir<MODE, 1>(F, b, s, h, fr, fq, prow0, Af, WGT, SP, hlb, gtb, GT, HL);
    __syncthreads();
}
DI void phase_lru_pass1(const Frame& F) {
    unsigned* done = (unsigned*)(F.ws + WS_CTL) + CW_LRUDONE;
    const int NL = (F.G >= 256) ? 192 : F.G;
#if defined(PROBE_SUB)
    __syncthreads(); asm volatile("" ::: "memory"); if (F.wave == 0 && PROBE_SUB == 2) ((volatile LAS unsigned long long*)(F.lds + LDS_MISC))[0] = __builtin_amdgcn_s_memrealtime(); asm volatile("" ::: "memory");
#endif
    if (F.bx < NL) {
        for (int it = F.bx; it < NB * NSEQT; it += NL) { { const int bb = it / NSEQT, ss = it % NSEQT; if (ss < 4) lru_tile<0>(F, bb, ss); else lru_tile<1>(F, bb, ss); }
            if (F.tid == 0) __hip_atomic_fetch_add(done, 1u, __ATOMIC_RELAXED, __HIP_MEMORY_SCOPE_AGENT); }
    }
#if defined(PROBE_SUB)
    __syncthreads(); asm volatile("" ::: "memory"); if (F.wave == 0 && PROBE_SUB == 2) ((volatile LAS unsigned long long*)(F.lds + LDS_MISC))[1] = __builtin_amdgcn_s_memrealtime(); asm volatile("" ::: "memory");
#endif
    if (F.G >= 256) convert_experts(F, done, (unsigned)(NB * NSEQT));
}
DI void phase_lru_carry(const Frame& F) {
    if (F.wave != 0) return;
    const float* SA = (const float*)(F.ws + WS_SUMA); const float* SH = (const float*)(F.ws + WS_SUMH); float* CI = (float*)(F.ws + WS_CIN);
    for (int id = F.bx * 64 + F.lane; id < 2 * NB * 512; id += F.G * 64) {
        const int dir = id >> 13, b = (id >> 9) & 15, c = id & 511;
        float x = 0.f; const size_t o0 = (size_t)(dir * NB + b) * NSEQT * 512 + c;
#pragma unroll
        for (int hf = 0; hf < 2; ++hf) {
            float av[18], hv[18];
#pragma unroll
            for (int q = 0; q < 18; ++q) { const int st = 18 * hf + q, s = dir ? (st < 4 ? 3 - st : 39 - st) : st; av[q] = SA[o0 + (size_t)s * 512]; hv[q] = SH[o0 + (size_t)s * 512]; }
#pragma unroll
            for (int q = 0; q < 18; ++q) { const int st = 18 * hf + q, s = dir ? (st < 4 ? 3 - st : 39 - st) : st; CI[o0 + (size_t)s * 512] = x; x = av[q] * x + hv[q]; }
        }
    }
}

constexpr int HS = 144, SCS = 40;
constexpr int H_Q = 0, H_LF = H_Q + 32 * HS * 2, H_V = H_LF + 32 * HS * 2, H_QT = H_V + 32 * HS * 2, H_KT = H_QT + 32 * HS * 2, H_KH = H_KT + 32 * HS * 2,
              H_SC = H_KH + 32 * HS * 2, H_DEC = H_SC + 32 * SCS * 2, H_SET = H_DEC + 512;
static_assert(2 * H_SET <= RING_BYTES, "hgrn lds");
typedef short s16x4 __attribute__((ext_vector_type(4)));
DI bf16x8 tr_frag(const LAS bf16* tile, int c0, int lane) {
    const int g = lane >> 4, q = (lane & 15) >> 2, p = lane & 3;
    const LAS bf16* a = tile + (8 * g + q) * HS + c0 + 4 * p;
    const s16x4 lo = __builtin_amdgcn_ds_read_tr16_b64_v4i16((LAS s16x4*)a), hi = __builtin_amdgcn_ds_read_tr16_b64_v4i16((LAS s16x4*)(a + 4 * HS));
    bf16x8 r; r[0] = lo[0]; r[1] = lo[1]; r[2] = lo[2]; r[3] = lo[3]; r[4] = hi[0]; r[5] = hi[1]; r[6] = hi[2]; r[7] = hi[3]; return r;
}
constexpr int P_QR = 0, P_LR = P_QR + 2 * 9216, P_VR = P_LR + 2 * 9216, P_QT = P_VR + 4 * 9216, P_KT = P_QT + 2 * 9216, P_KH = P_KT + 2 * 9216, P_SC = P_KH + 2 * 9216, P_DEC = P_SC + 2 * 2560, P_END = P_DEC + 2 * 512;
static_assert(P_END <= LDS_MISC, "hgrn pipelined lds");
DI void hgrn_chain2(const Frame& F, int item) {
    const int b = item >> 3, h = (item >> 1) & 3, dir = item & 1;
    const bf16* P = (const bf16*)(F.ws + WS_P);
    bf16* O = (bf16*)(F.ws + (dir ? WS_OB : WS_OF));
    const int w = F.wave, lane = F.lane, fr = lane & 15, g = lane >> 4;
    const int li = F.tid >> 4, lp = F.tid & 15;
    auto prow = [&](int c, int i) -> size_t {
        const int ii = dir ? 31 - i : i;
        if (c < 8) { const int cc = dir ? 7 - c : c; return (size_t)NTOK + b * CTXL + 32 * cc + ii; }
        const int col = dir ? 63 - (c - 8) : (c - 8); return (size_t)b * SEQ + ii * 64 + col; };
    const size_t coff = 128 * h + 8 * lp;
    v4u rqA, rlA, rvA, rqB, rlB, rvB;
    { const bf16* rp = P + prow(0, li) * INC + coff; rqA = *(const v4u*)(rp + 1024); rvA = *(const v4u*)(rp + 1536); rlA = *(const v4u*)(rp + 2048 + 512 * dir); }
    { const bf16* rp = P + prow(1, li) * INC + coff; rqB = *(const v4u*)(rp + 1024); rvB = *(const v4u*)(rp + 1536); rlB = *(const v4u*)(rp + 2048 + 512 * dir); }
    LAS unsigned char* L = F.lds;
#define HG2_W(k, U, RQ, RL, RV) do { \
        const int i = (k) - 2, wch = (k), pch = (k) - 1; (void)i; (void)pch; \
        if (wch < 72) {   \
            *(LAS v4u*)((LAS bf16*)(L + P_QR + ((U) & 1) * 9216) + li * HS + 8 * lp) = RQ; *(LAS v4u*)((LAS bf16*)(L + P_LR + ((U) & 1) * 9216) + li * HS + 8 * lp) = RL; \
            *(LAS v4u*)((LAS bf16*)(L + P_VR + (U) * 9216) + li * HS + 8 * lp) = RV; \
            if (wch + 2 < 72) { const bf16* rp = P + prow(wch + 2, li) * INC + coff; RQ = *(const v4u*)(rp + 1024); RV = *(const v4u*)(rp + 1536); RL = *(const v4u*)(rp + 2048 + 512 * dir); } } \
    } while (0)
#define HG2_PREP(k, U) do { \
        const int i = (k) - 2, wch = (k), pch = (k) - 1; (void)i; (void)pch; \
        const int pw = w - 4; \
            if (pch >= 0 && pch < 72) {   \
                const LAS bf16* Qr = (const LAS bf16*)(L + P_QR + (((U) + 1) & 1) * 9216); const LAS bf16* LFr = (const LAS bf16*)(L + P_LR + (((U) + 1) & 1) * 9216); \
                LAS bf16* QT = (LAS bf16*)(L + P_QT + (((U) + 1) & 1) * 9216); LAS bf16* KT = (LAS bf16*)(L + P_KT + (((U) + 1) & 1) * 9216); LAS bf16* KH = (LAS bf16*)(L + P_KH + (((U) + 1) & 1) * 9216); \
                LAS float* DEC = (LAS float*)(L + P_DEC + (((U) + 1) & 1) * 512); \
                _Pragma("unroll") for (int db = 0; db < 2; ++db) { const int dblk = 16 * (2 * pw + db); \
                    const bf16x8 Al = tr_frag(LFr, dblk, lane); \
                    f32x4 Gm[2]; \
                    _Pragma("unroll") for (int it = 0; it < 2; ++it) Gm[it] = __builtin_amdgcn_mfma_f32_16x16x32_bf16(Al, Tri[it], (f32x4){0.f, 0.f, 0.f, 0.f}, 0, 0, 0); \
                    f32x4 dec; \
                    _Pragma("unroll") for (int r = 0; r < 4; ++r) dec[r] = expf_(__shfl(Gm[1][r], (lane & 48) | 15)); \
                    if (fr == 0) *(LAS f32x4*)(DEC + dblk + 4 * g) = dec; \
                    _Pragma("unroll") for (int it = 0; it < 2; ++it) { const int ii = 16 * it + fr, d0 = dblk + 4 * g; \
                        const v2u q4 = *(const LAS v2u*)(Qr + ii * HS + d0), l4 = *(const LAS v2u*)(LFr + ii * HS + d0); \
                        const float qv[4] = {bflo(q4.x), bfhi(q4.x), bflo(q4.y), bfhi(q4.y)}, lv[4] = {bflo(l4.x), bfhi(l4.x), bflo(l4.y), bfhi(l4.y)}; \
                        float qt[4], kt[4], kh[4]; \
                        _Pragma("unroll") for (int r = 0; r < 4; ++r) { const float eg = expf_(Gm[it][r]), ieg = rcpf_(eg), kk = 1.0f - expf_(lv[r]); qt[r] = qv[r] * eg; kt[r] = kk * ieg; kh[r] = kk * dec[r] * ieg; } \
                        *(LAS v2u*)(QT + ii * HS + d0) = (v2u){pk2(qt[0], qt[1]), pk2(qt[2], qt[3])}; \
                        *(LAS v2u*)(KT + ii * HS + d0) = (v2u){pk2(kt[0], kt[1]), pk2(kt[2], kt[3])}; \
                        *(LAS v2u*)(KH + ii * HS + d0) = (v2u){pk2(kh[0], kh[1]), pk2(kh[2], kh[3])}; } } } \
            if (i >= 8 && i < 72) {   \
                const LAS bf16* QT = (const LAS bf16*)(L + P_QT + ((U) & 1) * 9216); const LAS bf16* KT = (const LAS bf16*)(L + P_KT + ((U) & 1) * 9216); LAS bf16* SC = (LAS bf16*)(L + P_SC + ((U) & 1) * 2560); \
                const int it = pw >> 1, jt = pw & 1; f32x4 sc = {0.f, 0.f, 0.f, 0.f}; \
                _Pragma("unroll") for (int ks = 0; ks < 4; ++ks) { const bf16x8 ak = *(const LAS bf16x8*)(KT + (16 * jt + fr) * HS + 32 * ks + 8 * g), bq = *(const LAS bf16x8*)(QT + (16 * it + fr) * HS + 32 * ks + 8 * g); \
                    sc = __builtin_amdgcn_mfma_f32_16x16x32_bf16(ak, bq, sc, 0, 0, 0); } \
                const int ii = 16 * it + fr, j0 = 16 * jt + 4 * g; \
                *(LAS v2u*)(SC + ii * SCS + j0) = (v2u){pk2(j0 <= ii ? sc[0] : 0.f, j0 + 1 <= ii ? sc[1] : 0.f), pk2(j0 + 2 <= ii ? sc[2] : 0.f, j0 + 3 <= ii ? sc[3] : 0.f)}; } \
    } while (0)
#define HG2_CORE(k, U) do { \
        const int i = (k) - 2, wch = (k), pch = (k) - 1; (void)i; (void)pch; \
            f32x4 onew[2][2]; \
            _Pragma("unroll") for (int eb = 0; eb < 2; ++eb) { onew[eb][0] = (f32x4){0.f, 0.f, 0.f, 0.f}; onew[eb][1] = (f32x4){0.f, 0.f, 0.f, 0.f}; } \
            bf16x8 Vf[2]; _Pragma("unroll") for (int eb = 0; eb < 2; ++eb) Vf[eb] = Vprev[eb]; \
            if (i >= 0 && i < 72) {   \
                const LAS bf16* QT = (const LAS bf16*)(L + P_QT + ((U) & 1) * 9216); const LAS bf16* KH = (const LAS bf16*)(L + P_KH + ((U) & 1) * 9216); \
                const LAS float* DEC = (const LAS float*)(L + P_DEC + ((U) & 1) * 512); const LAS bf16* Vr = (const LAS bf16*)(L + P_VR + (((U) + 2) & 3) * 9216); \
                if (i >= 8) {   \
                    _Pragma("unroll") for (int ks = 0; ks < 4; ++ks) { bf16x8 Bq[2]; \
                        _Pragma("unroll") for (int it = 0; it < 2; ++it) { const v2u a0 = *(const LAS v2u*)(QT + (16 * it + fr) * HS + 32 * ks + 4 * g), a1 = *(const LAS v2u*)(QT + (16 * it + fr) * HS + 32 * ks + 16 + 4 * g); \
                            v4u bv; bv.x = a0.x; bv.y = a0.y; bv.z = a1.x; bv.w = a1.y; Bq[it] = __builtin_bit_cast(bf16x8, bv); } \
                        _Pragma("unroll") for (int eb = 0; eb < 2; ++eb) { \
                            v4u sb; sb.x = pk2(S[eb][2 * ks][0], S[eb][2 * ks][1]); sb.y = pk2(S[eb][2 * ks][2], S[eb][2 * ks][3]); sb.z = pk2(S[eb][2 * ks + 1][0], S[eb][2 * ks + 1][1]); sb.w = pk2(S[eb][2 * ks + 1][2], S[eb][2 * ks + 1][3]); \
                            const bf16x8 As = __builtin_bit_cast(bf16x8, sb); \
                            _Pragma("unroll") for (int it = 0; it < 2; ++it) onew[eb][it] = __builtin_amdgcn_mfma_f32_16x16x32_bf16(As, Bq[it], onew[eb][it], 0, 0, 0); } } } \
                  \
                _Pragma("unroll") for (int eb = 0; eb < 2; ++eb) Vf[eb] = tr_frag(Vr, 16 * (2 * w + eb), lane); \
                _Pragma("unroll") for (int t = 0; t < 8; ++t) { const f32x4 dv = *(const LAS f32x4*)(DEC + 16 * t + 4 * g); const bf16x8 Kf = tr_frag(KH, 16 * t, lane); \
                    _Pragma("unroll") for (int eb = 0; eb < 2; ++eb) S[eb][t] = __builtin_amdgcn_mfma_f32_16x16x32_bf16(Kf, Vf[eb], S[eb][t] * dv, 0, 0, 0); } } \
            if (i - 1 >= 8 && i - 1 < 72) {   \
                const LAS bf16* SC = (const LAS bf16*)(L + P_SC + (((U) + 1) & 1) * 2560); \
                const int col = dir ? 63 - (i - 9) : (i - 9); \
                _Pragma("unroll") for (int it = 0; it < 2; ++it) { const bf16x8 bs = *(const LAS bf16x8*)(SC + (16 * it + fr) * SCS + 8 * g); \
                    const int ip = 16 * it + fr, ii = dir ? 31 - ip : ip; \
                    _Pragma("unroll") for (int eb = 0; eb < 2; ++eb) { const f32x4 o = __builtin_amdgcn_mfma_f32_16x16x32_bf16(Vprev[eb], bs, oprev[eb][it], 0, 0, 0); \
                        *(v2u*)(O + ((size_t)b * SEQ + ii * 64 + col) * 512 + 128 * h + 16 * (2 * w + eb) + 4 * g) = (v2u){pk2(o[0], o[1]), pk2(o[2], o[3])}; } } } \
            _Pragma("unroll") for (int eb = 0; eb < 2; ++eb) { oprev[eb][0] = onew[eb][0]; oprev[eb][1] = onew[eb][1]; Vprev[eb] = Vf[eb]; } \
    } while (0)
    if (w >= 4) {
        bf16x8 Tri[2];
#pragma unroll
        for (int it = 0; it < 2; ++it)
#pragma unroll
            for (int jj = 0; jj < 8; ++jj) Tri[it][jj] = (8 * g + jj <= 16 * it + fr) ? (short)0x3F80 : (short)0;
#pragma unroll 1
        for (int k = 0; k < 76; k += 4) {
            HG2_W(k, 0, rqA, rlA, rvA); HG2_PREP(k, 0); __syncthreads();
            HG2_W(k + 1, 1, rqB, rlB, rvB); HG2_PREP(k + 1, 1); __syncthreads();
            HG2_W(k + 2, 2, rqA, rlA, rvA); HG2_PREP(k + 2, 2); __syncthreads();
            HG2_W(k + 3, 3, rqB, rlB, rvB); HG2_PREP(k + 3, 3); __syncthreads();
        }
    } else {
        f32x4 S[2][8], oprev[2][2]; bf16x8 Vprev[2];
#pragma unroll
        for (int eb = 0; eb < 2; ++eb) {
#pragma unroll
            for (int t = 0; t < 8; ++t) S[eb][t] = (f32x4){0.f, 0.f, 0.f, 0.f};
            oprev[eb][0] = (f32x4){0.f, 0.f, 0.f, 0.f}; oprev[eb][1] = (f32x4){0.f, 0.f, 0.f, 0.f};
#pragma unroll
            for (int jj = 0; jj < 8; ++jj) Vprev[eb][jj] = 0; }
#pragma unroll 1
        for (int k = 0; k < 76; k += 4) {
            HG2_W(k, 0, rqA, rlA, rvA); HG2_CORE(k, 0); __syncthreads();
            HG2_W(k + 1, 1, rqB, rlB, rvB); HG2_CORE(k + 1, 1); __syncthreads();
            HG2_W(k + 2, 2, rqA, rlA, rvA); HG2_CORE(k + 2, 2); __syncthreads();
            HG2_W(k + 3, 3, rqB, rlB, rvB); HG2_CORE(k + 3, 3); __syncthreads();
        }
    }
#undef HG2_W
#undef HG2_PREP
#undef HG2_CORE
}
DI void phase_y2(const Frame& F) {
    const bf16* OFp = (const bf16*)(F.ws + WS_OF); const bf16* OBp = (const bf16*)(F.ws + WS_OB); const bf16* P = (const bf16*)(F.ws + WS_P); bf16* YL = (bf16*)(F.ws + WS_YL);
    const bf16* HS = (const bf16*)(F.ws + WS_LHS); const bf16* PF = (const bf16*)(F.ws + WS_LPF); const bf16* PB = (const bf16*)(F.ws + WS_LPB); const float* CIN = (const float*)(F.ws + WS_CIN);
    const int gw = F.bx * NWAVES + F.wave, NGW = F.G * NWAVES;
    const int c = 8 * F.lane;
    const f32x4 g0 = *(const f32x4*)(F.in[I_HNORM] + c), g1 = *(const f32x4*)(F.in[I_HNORM] + c + 4);
    const float gn[8] = {g0.x, g0.y, g0.z, g0.w, g1.x, g1.y, g1.z, g1.w};
    for (int m0 = gw * 16; m0 < NTOK; m0 += NGW * 16) {
        const int bb = m0 >> 11, ss = 4 + ((m0 & 2047) >> 6);
        const size_t cf = ((size_t)(0 * NB + bb) * NSEQT + ss) * 512 + c, cbk = ((size_t)(1 * NB + bb) * NSEQT + ss) * 512 + c;
        const f32x4 f0 = *(const f32x4*)(CIN + cf), f1 = *(const f32x4*)(CIN + cf + 4), b0 = *(const f32x4*)(CIN + cbk), b1 = *(const f32x4*)(CIN + cbk + 4);
        const float cfv[8] = {f0.x, f0.y, f0.z, f0.w, f1.x, f1.y, f1.z, f1.w}, cbv[8] = {b0.x, b0.y, b0.z, b0.w, b1.x, b1.y, b1.z, b1.w};
#pragma unroll 2
        for (int m = m0; m < m0 + 16; ++m) {
            const v4u hs = *(const v4u*)(HS + (size_t)m * 512 + c), pf = *(const v4u*)(PF + (size_t)m * 512 + c), pb = *(const v4u*)(PB + (size_t)m * 512 + c), rg = *(const v4u*)(P + (size_t)m * INC + 512 + c);
            const v4u a = *(const v4u*)(OFp + (size_t)m * 512 + c), bq = *(const v4u*)(OBp + (size_t)m * 512 + c), sg = *(const v4u*)(P + (size_t)m * INC + 3072 + c);
            { const unsigned hw[4] = {hs.x, hs.y, hs.z, hs.w}, fw[4] = {pf.x, pf.y, pf.z, pf.w}, bw[4] = {pb.x, pb.y, pb.z, pb.w}, rw[4] = {rg.x, rg.y, rg.z, rg.w};
                unsigned ow[4];
#pragma unroll
                for (int q = 0; q < 4; ++q) { const float lo = bflo(rw[q]) * (bflo(hw[q]) + bflo(fw[q]) * cfv[2 * q] + bflo(bw[q]) * cbv[2 * q]);
                    const float hi = bfhi(rw[q]) * (bfhi(hw[q]) + bfhi(fw[q]) * cfv[2 * q + 1] + bfhi(bw[q]) * cbv[2 * q + 1]); ow[q] = pk2(lo, hi); }
                *(v4u*)(YL + (size_t)m * D + c) = (v4u){ow[0], ow[1], ow[2], ow[3]}; }
            float o[8] = {bflo(a.x) + bflo(bq.x), bfhi(a.x) + bfhi(bq.x), bflo(a.y) + bflo(bq.y), bfhi(a.y) + bfhi(bq.y), bflo(a.z) + bflo(bq.z), bfhi(a.z) + bfhi(bq.z), bflo(a.w) + bflo(bq.w), bfhi(a.w) + bfhi(bq.w)};
            const float sgv[8] = {bflo(sg.x), bfhi(sg.x), bflo(sg.y), bfhi(sg.y), bflo(sg.z), bfhi(sg.z), bflo(sg.w), bfhi(sg.w)};
            float ssq = 0.f;
#pragma unroll
            for (int j = 0; j < 8; ++j) ssq += o[j] * o[j];
            ssq += dpp_mov_f<0xB1>(ssq); ssq += dpp_mov_f<0x4E>(ssq); ssq += dpp_mov_f<0x124>(ssq); ssq += dpp_mov_f<0x128>(ssq);
            const float rs = rsqrtf(ssq * (1.0f / 128.0f) + EPS);
#pragma unroll
            for (int j = 0; j < 8; ++j) o[j] = o[j] * rs * gn[j] * sgv[j];
            v4u wv; wv.x = pk2(o[0], o[1]); wv.y = pk2(o[2], o[3]); wv.z = pk2(o[4], o[5]); wv.w = pk2(o[6], o[7]);
            *(v4u*)(YL + (size_t)m * D + 512 + c) = wv;
        }
    }
}

DI unsigned fkey(float f) { const unsigned u = __float_as_uint(f); return u ^ ((u >> 31) ? 0xFFFFFFFFu : 0x80000000u); }
template <int CTRL> DI unsigned dpp_u(unsigned v) { return (unsigned)__builtin_amdgcn_update_dpp(0, (int)v, CTRL, 0xf, 0xf, true); }
template <int CTRL> DI float dpp_f(float v) { return __uint_as_float(dpp_u<CTRL>(__float_as_uint(v))); }
DI unsigned umax_(unsigned a, unsigned b) { return a > b ? a : b; }
DI float readlane_f(float v, int lane) { return __uint_as_float((unsigned)__builtin_amdgcn_readlane((int)__float_as_uint(v), lane)); }
DI void route_token(const f32x4 lg, const f32x4 rbv, const int l, int& myexp, float& gate) {
    const float NEG = -__builtin_inff();
    float sc[4], bs[4];
#pragma unroll
    for (int k = 0; k < 4; ++k) { sc[k] = rcpf_(1.0f + expf_(-lg[k])); bs[k] = sc[k] + rbv[k]; }
    float m1 = NEG, m2 = NEG;
#pragma unroll
    for (int k = 0; k < 4; ++k) { const float v = bs[k]; if (v > m1) { m2 = m1; m1 = v; } else if (v > m2) m2 = v; }
    { float o1 = dpp_f<0xB1>(m1), o2 = dpp_f<0xB1>(m2); float n1 = fmaxf(m1, o1), n2 = fmaxf(fminf(m1, o1), fmaxf(m2, o2)); m1 = n1; m2 = n2;
      o1 = dpp_f<0x4E>(m1); o2 = dpp_f<0x4E>(m2); n1 = fmaxf(m1, o1); n2 = fmaxf(fminf(m1, o1), fmaxf(m2, o2)); m1 = n1; m2 = n2;
      const float a1 = dpp_f<0x104>(m1), a2 = dpp_f<0x104>(m2), c1 = dpp_f<0x114>(m1), c2 = dpp_f<0x114>(m2);
      o1 = (l & 4) ? c1 : a1; o2 = (l & 4) ? c2 : a2; n1 = fmaxf(m1, o1); n2 = fmaxf(fminf(m1, o1), fmaxf(m2, o2)); m1 = n1; m2 = n2; }
    const float gs = m1 + m2; const int g = l >> 3; int rank = 0;
#pragma unroll
    for (int gg = 0; gg < 8; ++gg) { const float og = readlane_f(gs, gg * 8); rank += (og > gs || (og == gs && gg < g)) ? 1 : 0; }
    const bool sel = rank < 4;
    unsigned cv[4];
#pragma unroll
    for (int k = 0; k < 4; ++k) cv[k] = sel ? fkey(bs[k]) : 0u;
    float sum = 0.f, mysc = 0.f; myexp = 0;
#pragma unroll
    for (int r = 0; r < TOPK; ++r) {
        unsigned bvk = cv[0]; int bk = 0;
#pragma unroll
        for (int k = 1; k < 4; ++k) if (cv[k] > bvk) { bvk = cv[k]; bk = k; }
        const float bsc = bk == 0 ? sc[0] : bk == 1 ? sc[1] : bk == 2 ? sc[2] : sc[3];
        unsigned m = bvk;
        m = umax_(m, dpp_u<0xB1>(m)); m = umax_(m, dpp_u<0x4E>(m)); m = umax_(m, dpp_u<0x124>(m)); m = umax_(m, dpp_u<0x128>(m));
        const unsigned M = umax_(umax_((unsigned)__builtin_amdgcn_readlane((int)m, 0), (unsigned)__builtin_amdgcn_readlane((int)m, 16)),
                                 umax_((unsigned)__builtin_amdgcn_readlane((int)m, 32), (unsigned)__builtin_amdgcn_readlane((int)m, 48)));
        const unsigned long long bal = __ballot(bvk == M);
        const int L = __builtin_ctzll(bal);
        const int kL = __builtin_amdgcn_readlane(bk, L);
        const float se = readlane_f(bsc, L);
        const int e = 4 * L + kL;
        if (l == L) {
#pragma unroll
            for (int k = 0; k < 4; ++k) if (k == bk) cv[k] = 0u; }
        sum += se; if (l == r) { myexp = e; mysc = se; }
    }
    gate = mysc * rcpf_(sum) * 2.5f;
}
constexpr int NR_XS = 1032, NR_LS = 260, NR_HIST = 133120;
static_assert(64 * NR_XS * 2 <= NR_HIST && 64 * NR_LS * 4 <= NR_HIST && NR_HIST + 1024 <= LDS_MISC, "norm/route lds");
DI void phase_norm_route(const Frame& F) {
    const float* MOD = (const float*)(F.ws + WS_MOD); const float* gain = F.in[I_NFFN];
    const bf16* X1b = (const bf16*)(F.ws + WS_X1); const bf16* WR = (const bf16*)(F.ws + WS_WR);
    v2u* ROUTE = (v2u*)(F.ws + WS_ROUTE); int* HIST = (int*)(F.ws + WS_HIST);
    LAS bf16* XT = (LAS bf16*)F.lds; LAS float* LG = (LAS float*)F.lds; LAS unsigned* hist = (LAS unsigned*)(F.lds + NR_HIST);
    const int l = F.lane, w = F.wave, fr = l & 15, g = l >> 4;
    const f32x4 rbv = *(const f32x4*)(F.in[I_RB] + 4 * l);
    for (int blk = F.bx; blk < NTOK / 128; blk += F.G) {
        if (F.tid < 256) hist[F.tid] = 0u;
        const int b = (blk * 128) >> 11;
        f32x4 ga[4], sb4[4];
#pragma unroll
        for (int j = 0; j < 4; ++j) { const int c = 4 * l + 256 * j; ga[j] = *(const f32x4*)(gain + c) * (*(const f32x4*)(MOD + b * 6144 + 4096 + c) + 1.0f); sb4[j] = *(const f32x4*)(MOD + b * 6144 + 3072 + c); }
#pragma unroll 1
        for (int half = 0; half < 2; ++half) {
            const int tok0 = blk * 128 + half * 64;
            v2u xr[4];
#pragma unroll
            for (int j = 0; j < 4; ++j) xr[j] = *(const v2u*)(X1b + (size_t)(tok0 + 8 * w) * D + 4 * l + 256 * j);
#pragma unroll 1
            for (int rr = 0; rr < 8; ++rr) { const int row = 8 * w + rr; const size_t m = (size_t)(tok0 + row);
                f32x4 v[4]; float ss = 0.f;
#pragma unroll
                for (int j = 0; j < 4; ++j) { v[j] = (f32x4){bflo(xr[j].x), bfhi(xr[j].x), bflo(xr[j].y), bfhi(xr[j].y)}; ss += (v[j].x * v[j].x + v[j].y * v[j].y) + (v[j].z * v[j].z + v[j].w * v[j].w); }
                if (rr + 1 < 8) {
#pragma unroll
                    for (int j = 0; j < 4; ++j) xr[j] = *(const v2u*)(X1b + (m + 1) * D + 4 * l + 256 * j); }
                const float rs = rsqrtf(wave_sum_fast(ss) * (1.0f / D) + EPS);
#pragma unroll
                for (int j = 0; j < 4; ++j) { const int c = 4 * l + 256 * j; const f32x4 y = (v[j] * rs) * ga[j] + sb4[j];
                    *(LAS v2u*)(XT + row * NR_XS + c) = (v2u){pk2(y.x, y.y), pk2(y.z, y.w)};
                    *(unsigned*)(F.ws + WS_HX2F + m * D + c) = pk4_f8(y.x, y.y, y.z, y.w); } }
            __syncthreads();
            f32x4 acc[4][2];
#pragma unroll
            for (int tt = 0; tt < 4; ++tt) { acc[tt][0] = (f32x4){0.f, 0.f, 0.f, 0.f}; acc[tt][1] = (f32x4){0.f, 0.f, 0.f, 0.f}; }
            const bf16* wb0 = WR + (size_t)(32 * w + fr) * D + 8 * g; const bf16* wb1 = wb0 + (size_t)16 * D;
            bf16x8 Bc[4][2], Bn[4][2];
#pragma unroll
            for (int q = 0; q < 4; ++q) { Bc[q][0] = *(const bf16x8*)(wb0 + 32 * q); Bc[q][1] = *(const bf16x8*)(wb1 + 32 * q); }
#pragma unroll 1
            for (int kc = 0; kc < 8; ++kc) {
                const int kn = (kc + 1 < 8) ? kc + 1 : kc;
#pragma unroll
                for (int q = 0; q < 4; ++q) { Bn[q][0] = *(const bf16x8*)(wb0 + 32 * (4 * kn + q)); Bn[q][1] = *(const bf16x8*)(wb1 + 32 * (4 * kn + q)); }
#pragma unroll
                for (int q = 0; q < 4; ++q)
#pragma unroll
                    for (int tt = 0; tt < 4; ++tt) { const bf16x8 A = *(const LAS bf16x8*)(XT + (16 * tt + fr) * NR_XS + 32 * (4 * kc + q) + 8 * g);
                        acc[tt][0] = __builtin_amdgcn_mfma_f32_16x16x32_bf16(A, Bc[q][0], acc[tt][0], 0, 0, 0); acc[tt][1] = __builtin_amdgcn_mfma_f32_16x16x32_bf16(A, Bc[q][1], acc[tt][1], 0, 0, 0); }
#pragma unroll
                for (int q = 0; q < 4; ++q) { Bc[q][0] = Bn[q][0]; Bc[q][1] = Bn[q][1]; }
            }
            __syncthreads();
#pragma unroll
            for (int tt = 0; tt < 4; ++tt)
#pragma unroll
                for (int eb = 0; eb < 2; ++eb)
#pragma unroll
                    for (int r = 0; r < 4; ++r) LG[(16 * tt + 4 * g + r) * NR_LS + 32 * w + 16 * eb + fr] = acc[tt][eb][r];
            __syncthreads();
#pragma unroll 1
            for (int ti = 0; ti < 8; ti += 2) { const int row = 8 * w + ti, tok = tok0 + row;
                const f32x4 lgA = *(const LAS f32x4*)(LG + row * NR_LS + 4 * l), lgB = *(const LAS f32x4*)(LG + (row + 1) * NR_LS + 4 * l);
                int eA, eB; float gA, gB; route_token(lgA, rbv, l, eA, gA); route_token(lgB, rbv, l, eB, gB);
                if (l < TOPK) { ROUTE[(size_t)tok * TOPK + l] = (v2u){(unsigned)eA, __float_as_uint(gA)}; ROUTE[(size_t)(tok + 1) * TOPK + l] = (v2u){(unsigned)eB, __float_as_uint(gB)};
                    (void)__hip_atomic_fetch_add(hist + eA, 1u, __ATOMIC_RELAXED, __HIP_MEMORY_SCOPE_WORKGROUP); (void)__hip_atomic_fetch_add(hist + eB, 1u, __ATOMIC_RELAXED, __HIP_MEMORY_SCOPE_WORKGROUP); } }
            __syncthreads();
        }
        if (F.tid < 256) HIST[blk * 256 + F.tid] = (int)hist[F.tid];
        __syncthreads();
    }
}
DI void phase_lists(const Frame& F) {
    const v2u* ROUTE = (const v2u*)(F.ws + WS_ROUTE); const int* HIST = (const int*)(F.ws + WS_HIST);
    unsigned* cnt = (unsigned*)(F.ws + WS_CTL) + CW_CNT; v2u* LIST = (v2u*)(F.ws + WS_LIST);
    LAS int* part = (LAS int*)F.lds;
    LAS int* lbase = part + 1024; LAS unsigned* lcnt = (LAS unsigned*)(lbase + 256); LAS int* ltot = lbase + 512; LAS int* lts = lbase + 768;
    int* INV = (int*)(F.ws + WS_INV);
    for (int blk = F.bx; blk < NTOK / 128; blk += F.G) {
        const int e = F.tid & 255, hf = F.tid >> 8;
        int below = 0, all = 0;
#pragma unroll 8
        for (int q = 0; q < 128; ++q) { const int row = hf * 128 + q; const int v = HIST[row * 256 + e]; all += v; below += (row < blk) ? v : 0; }
        part[hf * 512 + e] = below; part[hf * 512 + 256 + e] = all;
        __syncthreads();
        if (F.tid < 256) { lbase[e] = part[e] + part[512 + e]; lcnt[e] = 0u; const int tot = part[256 + e] + part[768 + e]; ltot[e] = tot; if (blk == 0) cnt[e] = (unsigned)tot; }
        __syncthreads();
        if (F.tid == 0) { int s2 = 0; for (int q = 0; q < 256; ++q) { lts[q] = s2; s2 += (ltot[q] + 255) >> 8; } }
        __syncthreads();
#pragma unroll
        for (int q = 0; q < 2; ++q) { const int a = F.tid + q * NTHR; const unsigned tk = (unsigned)(blk * 128 * TOPK + a);
            const v2u rt = ROUTE[tk]; const unsigned pos = (unsigned)lbase[rt.x] + __hip_atomic_fetch_add(lcnt + rt.x, 1u, __ATOMIC_RELAXED, __HIP_MEMORY_SCOPE_WORKGROUP);
            LIST[(size_t)rt.x * LISTCAP + pos] = (v2u){tk, rt.y}; INV[tk] = lts[rt.x] * 256 + (int)pos; }
        __syncthreads();
    }
}

template <bool GATHER> DI void moe_setup(const Frame& F, int ncol, int& nunits, int& nfull) {
    LAS int* ts = (LAS int*)(F.lds + LDS_TS); LAS int* cl = (LAS int*)(F.lds + LDS_CNT); LAS int* ut = (LAS int*)(F.lds + LDS_UT); LAS int* idx = (LAS int*)(F.lds + LDS_IDX);
    const unsigned* cnt = (const unsigned*)(F.ws + WS_CTL) + CW_CNT;
    if (F.tid < 256) cl[F.tid] = (int)__hip_atomic_load(cnt + F.tid, __ATOMIC_RELAXED, __HIP_MEMORY_SCOPE_AGENT);
    __syncthreads();
    if (F.tid == 0) { int s = 0; for (int e = 0; e < 256; ++e) { ts[e] = s; s += (cl[e] + 255) >> 8; } ts[256] = s; }
    __syncthreads();
    const int Te = ts[256], T = Te + NTOK / 256;
    const int Fr = T / F.G, R = T - Fr * F.G, LU = R * ncol;
    const int nleft = (LU > F.vcu) ? (LU - F.vcu + F.G - 1) / F.G : 0;
    nfull = Fr * ncol; nunits = nfull + nleft;
    const v2u* LIST = (const v2u*)(F.ws + WS_LIST);
    for (int j = 0; j < Fr + nleft && j < 10; ++j) {
        int rt, pnl = 0;
        if (j < Fr) rt = j * F.G + F.vcu; else { const int lu = (j - Fr) * F.G + F.vcu; rt = Fr * F.G + lu / ncol; pnl = lu % ncol; }
        int e, pm, nrows;
        if (rt >= Te) { e = 256; pm = rt - Te; nrows = 256; }
        else { int lo = 0, hi = 256; while (hi - lo > 1) { const int mid = (lo + hi) >> 1; if (ts[mid] <= rt) lo = mid; else hi = mid; }
            e = lo; pm = rt - ts[lo]; const int rem = cl[lo] - pm * 256; nrows = rem < 256 ? rem : 256; }
        if (F.tid == 0) *(LAS v4u*)(ut + 4 * j) = (v4u){(unsigned)e, (unsigned)pm, (unsigned)rt, (unsigned)nrows | ((unsigned)pnl << 16)};
        if (F.tid < 256) { const int r = F.tid;
            if (GATHER) idx[j * 256 + r] = (e == 256) ? pm * 256 + r : (r < nrows ? (int)(LIST[(size_t)e * LISTCAP + pm * 256 + r].x >> 3) : 0);
            else ((LAS float*)idx)[j * 256 + r] = (e == 256) ? 1.0f : (r < nrows ? __uint_as_float(LIST[(size_t)e * LISTCAP + pm * 256 + r].y) : 0.0f); } }
    __syncthreads();
}

DI void phase_combine(const Frame& F, int mode) {
    const float* MOD = (const float*)(F.ws + WS_MOD);
    const unsigned char* YE = F.ws + WS_YE; const int* INV = (const int*)(F.ws + WS_INV);
    int Te = 0; if (mode == 0) { const unsigned* cnt = (const unsigned*)(F.ws + WS_CTL) + CW_CNT; int t4 = 0;
#pragma unroll
        for (int q = 0; q < 4; ++q) t4 += (int)((cnt[F.lane + 64 * q] + 255u) >> 8);
#pragma unroll
        for (int o = 1; o < 64; o <<= 1) t4 += __shfl_xor(t4, o);
        Te = __builtin_amdgcn_readfirstlane(t4); }
    const int gw = F.bx * NWAVES + F.wave, NGW = F.G * NWAVES;
    const float* nf = F.in[I_NFIN];
    const int c = 16 * F.lane;
    for (int m = gw; m < NTOK; m += NGW) {
        const int b = m >> 11;
        float s[16];
#pragma unroll
        for (int q = 0; q < 16; ++q) s[q] = 0.f;
        const bf16* xsrc = (const bf16*)(F.ws + WS_X1);
        if (mode == 0) {
#pragma unroll
            for (int k = 0; k < 9; ++k) { const int row = (k < 8) ? INV[m * TOPK + k] : Te * 256 + m; const v4u w = *(const v4u*)(YE + (size_t)row * D + c);
                const unsigned ww[4] = {w.x, w.y, w.z, w.w};
#pragma unroll
                for (int q = 0; q < 4; ++q) { const f32x2 lo = __builtin_amdgcn_cvt_pk_f32_fp8((int)ww[q], false), hi = __builtin_amdgcn_cvt_pk_f32_fp8((int)ww[q], true);
                    s[4 * q] += lo.x; s[4 * q + 1] += lo.y; s[4 * q + 2] += hi.x; s[4 * q + 3] += hi.y; } } }
        float x2[16]; float ss = 0.f;
#pragma unroll
        for (int q = 0; q < 4; ++q) { const v2u xt = *(const v2u*)(xsrc + (size_t)m * D + c + 4 * q); const f32x4 xa = {bflo(xt.x), bfhi(xt.x), bflo(xt.y), bfhi(xt.y)}, ga = *(const f32x4*)(MOD + b * 6144 + 5120 + c + 4 * q);
#pragma unroll
            for (int j = 0; j < 4; ++j) { const float v = xa[j] + ga[j] * (s[4 * q + j] * 0.015625f); x2[4 * q + j] = v; ss += v * v; } }
        const float rs = rsqrtf(wave_sum(ss) * (1.0f / D) + EPS);
#pragma unroll
        for (int q = 0; q < 4; ++q) { const f32x4 na = *(const f32x4*)(nf + c + 4 * q);
            f32x4 oa = {x2[4 * q] * rs * na.x, x2[4 * q + 1] * rs * na.y, x2[4 * q + 2] * rs * na.z, x2[4 * q + 3] * rs * na.w};
            *(f32x4*)(F.out + (size_t)m * D + c + 4 * q) = oa; }
    }
}

constexpr int NPHASE = 12;
__global__ void __launch_bounds__(NTHR, 2) fwd_kernel(Args args) {
    extern __shared__ __attribute__((aligned(16))) unsigned char lds_raw[];
    Frame F;
    F.lds = (LAS unsigned char*)lds_raw;
    F.tid = threadIdx.x; F.lane = F.tid & 63; F.wave = __builtin_amdgcn_readfirstlane(F.tid >> 6);
    F.G = gridDim.x; F.bx = blockIdx.x; F.vcu = (F.G % 8 == 0) ? (F.bx % 8) * (F.G / 8) + F.bx / 8 : F.bx;
    F.in = args.in; F.out = args.out; F.ws = args.ws;
    volatile LAS unsigned* MISC = (volatile LAS unsigned*)(F.lds + LDS_MISC);
    if (F.tid < 16) MISC[F.tid] = 0u;
    __syncthreads();
    XcdBarrier bar; bar.bar = (unsigned*)(F.ws + WS_CTL) + CW_BAR; bar.x = 0; bar.st = nullptr;
#if !PER_PHASE_LAUNCH
    bar = xcd_barrier_post((unsigned*)(F.ws + WS_CTL) + CW_BAR, MISC + 8);
#define GRID_BAR() xcd_barrier(bar)
#else
#define GRID_BAR() do {} while (0)
#endif
    const int lo = args.ph_lo, hi = args.ph_hi;
#ifndef PH_MASK
#define PH_MASK 0xFFFF
#endif
#define IN(k) (((PH_MASK >> (k)) & 1) && lo <= (k) && (k) < hi)
#ifndef PROBE_PH
#define PROBE_PH -1
#endif
#ifndef PROBE_MULT
#define PROBE_MULT 4
#endif
    volatile LAS unsigned long long* PRT = (volatile LAS unsigned long long*)(F.lds + LDS_MISC);
    if (PROBE_PH == 0 && F.wave == 0) PRT[0] = __builtin_amdgcn_s_memrealtime();
#define SEAM(k) do { if (IN(k) && IN((k) + 1)) GRID_BAR(); \
        if (PROBE_PH >= 0 && F.wave == 0) { if ((k) == PROBE_PH - 1) PRT[0] = __builtin_amdgcn_s_memrealtime(); if ((k) == PROBE_PH) PRT[1] = __builtin_amdgcn_s_memrealtime(); } } while (0)
#ifndef REPEAT_MASK
#define REPEAT_MASK 0
#endif
#define REPS(k) (1 + ((REPEAT_MASK >> (k)) & 1))
    unsigned char* ws = F.ws;

    if (IN(0)) _Pragma("unroll 1") for (int rep = 0; rep < REPS(0); ++rep) { if (rep) GRID_BAR(); phase_prologue(F); } SEAM(0);
    if (IN(1)) _Pragma("unroll 1") for (int rep = 0; rep < REPS(1); ++rep) { if (rep) GRID_BAR(); phase_norm_rows(F, 0); } SEAM(1);
    if (IN(2)) _Pragma("unroll 1") for (int rep = 0; rep < REPS(2); ++rep) { if (rep) GRID_BAR();
        pg8::DenseOrder S; S.init(ws + WS_HX, ws + WS_WIN, MTOT, INC, D, F.G, F.bx);
        pg8::EpiInProj E{(bf16*)(ws + WS_P), (const float*)(ws + WS_TAB)};
        pg8::gemm_phase(F.lds, D, S, E, F.wave);
    } SEAM(2);
    if (IN(3)) _Pragma("unroll 1") for (int rep = 0; rep < REPS(3); ++rep) { if (rep) GRID_BAR(); phase_lru_pass1(F); } SEAM(3);
    if (IN(4)) _Pragma("unroll 1") for (int rep = 0; rep < REPS(4); ++rep) { if (rep) GRID_BAR(); phase_lru_carry(F);
#if defined(PROBE_SUB)
        if (F.wave == 0 && PROBE_SUB == 0) PRT[0] = __builtin_amdgcn_s_memrealtime();
#endif
        if (F.bx < NB * 4 * 2) hgrn_chain2(F, F.bx);
#if defined(PROBE_SUB)
        if (F.wave == 0) { if (PROBE_SUB == 0) PRT[1] = __builtin_amdgcn_s_memrealtime(); else if (PROBE_SUB == 1) PRT[0] = __builtin_amdgcn_s_memrealtime(); }
#endif
        convert_experts(F, nullptr, 0u);
#if defined(PROBE_SUB)
        if (F.wave == 0 && PROBE_SUB == 1) PRT[1] = __builtin_amdgcn_s_memrealtime();
#endif
        } SEAM(4);
    if (IN(5)) _Pragma("unroll 1") for (int rep = 0; rep < REPS(5); ++rep) { if (rep) GRID_BAR(); phase_y2(F); } SEAM(5);
    if (IN(6)) _Pragma("unroll 1") for (int rep = 0; rep < REPS(6); ++rep) { if (rep) GRID_BAR();
        pg8::DenseOrder S; S.init(ws + WS_YL, ws + WS_WOUT, NTOK, D, D, F.G, F.bx);
        pg8::EpiResid E{F.in[I_X], (const float*)(ws + WS_MOD), (bf16*)(ws + WS_X1)};
        pg8::gemm_phase(F.lds, D, S, E, F.wave);
    } SEAM(6);
    if (IN(7)) _Pragma("unroll 1") for (int rep = 0; rep < REPS(7); ++rep) { if (rep) GRID_BAR(); phase_norm_route(F); } SEAM(7);
    if (IN(8)) _Pragma("unroll 1") for (int rep = 0; rep < REPS(8); ++rep) { if (rep) GRID_BAR(); phase_lists(F); } SEAM(8);
    if (IN(9)) _Pragma("unroll 1") for (int rep = 0; rep < REPS(9); ++rep) { if (rep) GRID_BAR();
        int total, nfull; moe_setup<true>(F, 2, total, nfull);
        pg8::MoeOrder<true> S; S.A = (const char*)(ws + WS_HX2F); S.Bt = (const char*)(ws + WS_EW13); S.BtS = (const char*)(ws + WS_SW13); S.K = D / 2; S.ncol = 2; S.estride = (size_t)512 * 1024;
        S.ut = (const LAS int*)(F.lds + LDS_UT); S.idx = (const LAS int*)(F.lds + LDS_IDX); S.nunits = total; S.nfull = nfull;
        pg8::EpiSwiGLU8 E{ws + WS_ACT};
        pg8::gemm_phase<pg8::EpiSwiGLU8, pg8::MoeOrder<true>, false, true>(F.lds, D / 2, S, E, F.wave);
    } SEAM(9);
    if (IN(10)) _Pragma("unroll 1") for (int rep = 0; rep < REPS(10); ++rep) { if (rep) GRID_BAR();
        int total, nfull; moe_setup<false>(F, 4, total, nfull);
        pg8::MoeOrder<false> S; S.A = (const char*)(ws + WS_ACT); S.Bt = (const char*)(ws + WS_EW2); S.BtS = (const char*)(ws + WS_SW2); S.K = DE / 2; S.ncol = 4; S.estride = (size_t)1024 * 256;
        S.ut = (const LAS int*)(F.lds + LDS_UT); S.idx = (const LAS int*)(F.lds + LDS_IDX); S.nunits = total; S.nfull = nfull;
        pg8::EpiScatter E{ws + WS_YE, (const LAS float*)(F.lds + LDS_IDX), 0.5f};
#if defined(PROBE_GEMM)
        pg8::GProf gp{0ull, 0ull, 0ull};
        pg8::gemm_phase<pg8::EpiScatter, pg8::MoeOrder<false>, true, true>(F.lds, DE / 2, S, E, F.wave, &gp);
        if (F.wave == 0) { PRT[0] = 0ull; PRT[1] = (PROBE_GEMM == 0) ? gp.t_loop : (PROBE_GEMM == 1) ? gp.t_epi : gp.t_next; }
#else
        pg8::gemm_phase<pg8::EpiScatter, pg8::MoeOrder<false>, false, true>(F.lds, DE / 2, S, E, F.wave);
#endif
    } SEAM(10);
    if (IN(11)) _Pragma("unroll 1") for (int rep = 0; rep < REPS(11); ++rep) { if (rep) GRID_BAR(); phase_combine(F, 0); }
#if defined(PROBE_GEMM) || defined(PROBE_SUB)
    if (F.bx == 0 && F.wave == 0) {
#else
    if (PROBE_PH >= 0 && F.bx == 0 && F.wave == 0) {
#endif
        const unsigned long long te = __builtin_amdgcn_s_memrealtime(); if (PROBE_PH == NPHASE - 1) PRT[1] = te;
        const unsigned long long target = (unsigned long long)PROBE_MULT * (PRT[1] - PRT[0]);
        while (__builtin_amdgcn_s_memrealtime() - te < target) __builtin_amdgcn_s_sleep(20);
    }
}

extern "C" void kernel_launch(void* const* d_in, const int* in_sizes, int n_in, void* d_out, int out_size, void* d_ws, size_t ws_size, hipStream_t stream) {
    static int grid = 0;
    if (grid == 0) {
        if (n_in != 26 || in_sizes[0] != NTOK * D || out_size != NTOK * D || ws_size < WS_END) { fprintf(stderr, "kernel_launch: unexpected shapes (n_in %d, ws %zu)\n", n_in, ws_size); grid = -1; return; }
        int dev = 0, cus = 0, per_cu = 0;
        if (hipGetDevice(&dev) != hipSuccess || hipDeviceGetAttribute(&cus, hipDeviceAttributeMultiprocessorCount, dev) != hipSuccess) { grid = -1; return; }
        if (hipFuncSetAttribute((const void*)fwd_kernel, hipFuncAttributeMaxDynamicSharedMemorySize, LDS_BYTES) != hipSuccess) { fprintf(stderr, "kernel_launch: hipFuncSetAttribute failed\n"); grid = -1; return; }
        if (hipOccupancyMaxActiveBlocksPerMultiprocessor(&per_cu, (const void*)fwd_kernel, NTHR, LDS_BYTES) != hipSuccess || per_cu < 1) { fprintf(stderr, "kernel_launch: occupancy query says %d\n", per_cu); }
        (void)hipGetLastError();
        grid = cus;
        if (grid < 128) { fprintf(stderr, "kernel_launch: needs >= 128 CUs (HGRN2 chains run one per workgroup)\n"); grid = -1; return; }
    }
    if (grid < 0) return;
    hipMemsetAsync((char*)d_ws + WS_CTL, 0, CTL_ZERO_BYTES, stream);
    Args a{};
    for (int i = 0; i < 26; ++i) a.in[i] = (const float*)d_in[i];
    a.out = (float*)d_out; a.ws = (unsigned char*)d_ws;
#if PER_PHASE_LAUNCH
    for (int p = 0; p < NPHASE; ++p) { a.ph_lo = p; a.ph_hi = p + 1; hipLaunchKernelGGL(fwd_kernel, dim3(grid), dim3(NTHR), LDS_BYTES, stream, a); }
#else
    a.ph_lo = 0; a.ph_hi = NPHASE;
    hipLaunchKernelGGL(fwd_kernel, dim3(grid), dim3(NTHR), LDS_BYTES, stream, a);
#endif
}
```

```cpp
#include <hip/hip_runtime.h>
#include <cstdio>
#include <cstdint>

#ifndef PER_PHASE_LAUNCH
#define PER_PHASE_LAUNCH 0
#endif
#ifndef DBG_STOP
#define DBG_STOP 0
#endif

#define GAS __attribute__((address_space(1)))
#define LAS __attribute__((address_space(3)))
#define DI __device__ __forceinline__
typedef unsigned short bf16;
typedef unsigned v4u __attribute__((ext_vector_type(4)));
typedef unsigned v2u __attribute__((ext_vector_type(2)));
typedef float f32x4 __attribute__((ext_vector_type(4)));
typedef float f32x2 __attribute__((ext_vector_type(2)));
typedef short bf16x8 __attribute__((ext_vector_type(8)));
typedef __bf16 bfv2 __attribute__((ext_vector_type(2)));

constexpr int D = 1024, NB = 16, SEQ = 2048, CTXL = 256;
constexpr int NTOK = NB * SEQ;
constexpr int NCTX = NB * CTXL;
constexpr int MTOT = NTOK + NCTX;
constexpr int INC = 3584;
constexpr int NE = 256, TOPK = 8, DE = 256;
constexpr int LISTCAP = 32768;
constexpr float EPS = 1e-6f;
constexpr int NWAVES = 8, NTHR = 512;
constexpr int NSEQT = 36;

constexpr size_t MiB = 1u << 20;
constexpr size_t WS_CTL = 0, CTL_ZERO_BYTES = 1 * MiB;
constexpr size_t WS_MOD = 1 * MiB;
constexpr size_t WS_TAB = 2 * MiB;
constexpr size_t WS_WGT = 2 * MiB + 65536;
constexpr size_t WS_WIN = 3 * MiB;
constexpr size_t WS_WOUT = 10 * MiB;
constexpr size_t WS_WR = 12 * MiB;
constexpr size_t WS_SW13 = 12 * MiB + 512 * 1024;
constexpr size_t WS_SW2 = 13 * MiB + 512 * 1024;
constexpr size_t WS_DUMP = 2 * MiB + 16384;
constexpr size_t WS_SUMA = 14 * MiB;
constexpr size_t WS_SUMH = WS_SUMA + 2359296;
constexpr size_t WS_CIN = WS_SUMH + 2359296;
constexpr size_t WS_ROUTE = 21 * MiB;
constexpr size_t WS_HIST = 23 * MiB;
constexpr size_t WS_EW13 = 32 * MiB;
constexpr size_t WS_EW2 = 288 * MiB;
constexpr size_t WS_X1 = 416 * MiB;
constexpr size_t WS_HX2 = 544 * MiB;
constexpr size_t WS_LOGIT = 608 * MiB;
constexpr size_t WS_LIST = 1620 * MiB;
constexpr size_t WS_LHS = 674 * MiB, WS_LPF = 706 * MiB, WS_LPB = 738 * MiB;
constexpr size_t WS_ACT = 674 * MiB;
constexpr size_t WS_YS = 850 * MiB;
constexpr size_t WS_P = 914 * MiB;
constexpr size_t WS_HX = 1166 * MiB;
constexpr size_t WS_OF = 1238 * MiB;
constexpr size_t WS_OB = 1270 * MiB;
constexpr size_t WS_YL = 1302 * MiB;
constexpr size_t WS_YE = 914 * MiB;
constexpr size_t WS_INV = 24 * MiB;
constexpr size_t WS_HX2F = 1684 * MiB;
constexpr size_t WS_END = 1716 * MiB;
constexpr int CW_BAR = 4096;
constexpr int CW_CNT = 16384;
constexpr int CW_CONVQ = 20480;
constexpr int CW_P2DONE = 20608;
constexpr int CW_LRUDONE = 20544;

constexpr int RING_BYTES = 131072;
constexpr int LDS_TS = RING_BYTES;
constexpr int LDS_CNT = LDS_TS + 1088;
constexpr int LDS_UT = LDS_CNT + 1024;
constexpr int LDS_IDX = LDS_UT + 192;
constexpr int LDS_MISC = LDS_IDX + 10 * 1024;
constexpr int LDS_BYTES = 155648;
static_assert(LDS_MISC + 64 <= LDS_BYTES, "lds map");

DI unsigned pk2(float lo, float hi) { f32x2 v = {lo, hi}; bfv2 b = __builtin_convertvector(v, bfv2); return __builtin_bit_cast(unsigned, b); }
DI float clamp448(float x) { return __builtin_amdgcn_fmed3f(x, -448.0f, 448.0f); }
DI unsigned pk4_f8(float a, float b, float c, float d) {
    int w = __builtin_amdgcn_cvt_pk_fp8_f32(clamp448(a), clamp448(b), 0, false); w = __builtin_amdgcn_cvt_pk_fp8_f32(clamp448(c), clamp448(d), w, true); return (unsigned)w; }
DI float bflo(unsigned w) { return __uint_as_float(w << 16); }
DI float bfhi(unsigned w) { return __uint_as_float(w & 0xffff0000u); }
DI float bf2f(bf16 h) { return __uint_as_float(((unsigned)h) << 16); }
DI bf16 f2bf(float f) { return (bf16)(pk2(f, 0.f) & 0xffffu); }
DI float rcpf_(float x) { return __builtin_amdgcn_rcpf(x); }
DI float ex2f_(float x) { return __builtin_amdgcn_exp2f(x); }
DI float expf_(float x) { return __builtin_amdgcn_exp2f(x * 1.4426950408889634f); }
DI float logf_(float x) { return __builtin_amdgcn_logf(x) * 0.6931471805599453f; }
DI float sigm(float x) { return rcpf_(1.0f + expf_(-x)); }
DI float wave_sum(float v) {
#pragma unroll
    for (int o = 1; o < 64; o <<= 1) v += __shfl_xor(v, o);
    return v;
}
#define LDS_WAIT() asm volatile("s_waitcnt lgkmcnt(0)" ::: "memory")
template <int CTRL> DI float dpp_mov_f(float v) { return __uint_as_float((unsigned)__builtin_amdgcn_update_dpp(0, (int)__float_as_uint(v), CTRL, 0xf, 0xf, true)); }
DI float wave_sum_fast(float v) {
    v += dpp_mov_f<0xB1>(v); v += dpp_mov_f<0x4E>(v); v += dpp_mov_f<0x124>(v); v += dpp_mov_f<0x128>(v);
    const unsigned u = __float_as_uint(v);
    return (__uint_as_float((unsigned)__builtin_amdgcn_readlane((int)u, 0)) + __uint_as_float((unsigned)__builtin_amdgcn_readlane((int)u, 16)))
         + (__uint_as_float((unsigned)__builtin_amdgcn_readlane((int)u, 32)) + __uint_as_float((unsigned)__builtin_amdgcn_readlane((int)u, 48)));
}

#define XB_TMO      128
#define XB_XCNT(j)  (256  + 64 * (j))
#define XB_XSUB(j)  (1280 + 64 * (j))
#define XB_XGEN(j)  (2304 + 64 * (j))
#define XB_TOP      3328
#define XB_TOPGEN   3392
#define XCD_BAR_WORDS 3456
#define XB_SPIN_CAP (1u << 18)
__device__ __forceinline__ unsigned xb_ld(unsigned* p)              { return __hip_atomic_load(p, __ATOMIC_RELAXED, __HIP_MEMORY_SCOPE_AGENT); }
__device__ __forceinline__ unsigned xb_add(unsigned* p, unsigned v) { return __hip_atomic_fetch_add(p, v, __ATOMIC_RELAXED, __HIP_MEMORY_SCOPE_AGENT); }
__device__ __forceinline__ unsigned xb_xcc_id() { return (unsigned)__builtin_amdgcn_s_getreg((3 << 11) | 20) & 0xFu; }
#define XB_SPIN(cond, bar) do { unsigned _sp = 0; while (cond) { __builtin_amdgcn_s_sleep(1); \
    if ((++_sp & 255u) == 0u) { if (xb_ld(&(bar)[XB_TMO])) break; if (_sp > XB_SPIN_CAP) { atomicAdd(&(bar)[XB_TMO], 1u); break; } } } } while (0)
struct XcdBarrier { unsigned* bar; unsigned x; volatile LAS unsigned* st; };
__device__ __forceinline__ XcdBarrier xcd_barrier_post(unsigned* bar, volatile LAS unsigned* st) {
    XcdBarrier b; b.bar = bar; b.x = xb_xcc_id(); b.st = st;
    if (threadIdx.x == 0) (void)xb_add(&bar[XB_XCNT(b.x)], 1u);
    return b;
}
__device__ __forceinline__ void xcd_barrier_complete(unsigned* bar, unsigned x, unsigned& nloc, unsigned& nx) {
    const unsigned G = gridDim.x * gridDim.y * gridDim.z;
    unsigned sum, cnt, mine, sp = 0u;
    for (;;) {
        sum = 0u; cnt = 0u; mine = 0u;
#pragma unroll
        for (unsigned j = 0; j < 16; ++j) { const unsigned c = xb_ld(&bar[XB_XCNT(j)]); sum += c; cnt += (c > 0u) ? 1u : 0u; mine = (j == x) ? c : mine; }
        if (sum == G) break;
        __builtin_amdgcn_s_sleep(1);
        if ((++sp & 255u) == 0u) { if (xb_ld(&bar[XB_TMO])) break; if (sp > XB_SPIN_CAP) { atomicAdd(&bar[XB_TMO], 1u); break; } }
    }
    nloc = mine > 0u ? mine : 1u; nx = cnt > 0u ? cnt : 1u;
}
__device__ __forceinline__ void xcd_barrier(const XcdBarrier& b) {
    asm volatile("s_waitcnt vmcnt(0)" ::: "memory");
    __syncthreads();
    if (threadIdx.x == 0) {
        unsigned* bar = b.bar;
        __builtin_amdgcn_s_waitcnt(0);
        unsigned nloc = b.st[0], nx = b.st[1];
        if (nloc == 0u) { xcd_barrier_complete(bar, b.x, nloc, nx); b.st[0] = nloc; b.st[1] = nx; }
        const unsigned old = xb_add(&bar[XB_XSUB(b.x)], 1u);
        const unsigned gen = old / nloc;
        if (old + 1u == (gen + 1u) * nloc) {
            __builtin_amdgcn_fence(__ATOMIC_RELEASE, "agent");
            asm volatile("s_waitcnt vmcnt(0)" ::: "memory");
            const unsigned og = xb_add(&bar[XB_TOP], 1u);
            const unsigned tg = og / nx;
            if (og + 1u == (tg + 1u) * nx) xb_add(&bar[XB_TOPGEN], 1u);
            else XB_SPIN(xb_ld(&bar[XB_TOPGEN]) == tg, bar);
            __builtin_amdgcn_fence(__ATOMIC_ACQUIRE, "agent");
            xb_add(&bar[XB_XGEN(b.x)], 1u);
            asm volatile("s_waitcnt vmcnt(0)" ::: "memory");
        } else {
            XB_SPIN(xb_ld(&bar[XB_XGEN(b.x)]) == gen, bar);
            __builtin_amdgcn_fence(__ATOMIC_ACQUIRE, "agent");
            asm volatile("s_waitcnt vmcnt(0)" ::: "memory");
        }
    }
    __syncthreads();
}

namespace pg8 {
constexpr int BM = 256, BK = 64, HALF = 128, HTB = HALF * BK * 2, NXCD = 8, WGM = 8;
DI int lds_byte(int r, int c) { const int st = (r >> 4) * 2 + (c >> 5), rr = r & 15, cc = c & 31, ob = rr * 64 + cc * 2; return st * 1024 + (ob ^ (((ob >> 9) & 1) << 5)); }
DI void stage_rc(int b, int& R, int& C) { const int st = b / 1024, sb = b % 1024, swz = sb ^ (((sb >> 9) & 1) << 5); R = (st >> 1) * 16 + swz / 64; C = (st & 1) * 32 + (swz % 64) / 2; }
DI int perm32(int rho) { const int n = rho >> 4, i = rho & 15; return 8 * (i >> 2) + 4 * n + (i & 3); }

struct Unit { int pm, pn, e, rt, ord, nrows; };

struct DenseOrder {
    const char* A; const char* Bt; int K, nM, nN, nwg, G, c;
    DI void init(const void* A_, const void* Bt_, int M, int N, int K_, int G_, int c_) { A = (const char*)A_; Bt = (const char*)Bt_; K = K_; nM = M / BM; nN = N / BM; nwg = nM * nN; G = G_; c = c_; }
    DI bool next(int i, Unit& u) const {
        const long L = (long)i * G + c; if (L >= nwg) return false;
        int wgid = (int)L; { const int q = nwg / NXCD, r = nwg % NXCD, xcd = wgid % NXCD, off = wgid / NXCD; wgid = (xcd < r ? xcd * (q + 1) : r * (q + 1) + (xcd - r) * q) + off; }
        const int nig = WGM * nN, gid = wgid / nig, fm = gid * WGM, gsz = (nM - fm) < WGM ? (nM - fm) : WGM;
        u.pm = fm + ((wgid % nig) % gsz); u.pn = (wgid % nig) / gsz; u.e = 0; u.rt = u.pm; u.ord = i; u.nrows = 256; return true;
    }
    DI const char* a_base(const Unit& u) const { return A + (size_t)u.pm * BM * K * 2; }
    DI const char* b_base(const Unit& u) const { return Bt + (size_t)u.pn * BM * K * 2; }
    static constexpr bool GATHER_A = false;
    DI void a_offs(const Unit&, int tid, unsigned (&v)[2][2]) const {
#pragma unroll
        for (int i = 0; i < 2; ++i) { int R, C; stage_rc(tid * 16 + i * 8192, R, C);
#pragma unroll
            for (int h = 0; h < 2; ++h) v[h][i] = (unsigned)((h * HALF + R) * K + C) * 2u; }
    }
};

template <bool GATHER> struct MoeOrder {
    const char* A; const char* Bt; const char* BtS; int K, ncol; size_t estride; const char* dump;
    const LAS int* ut; const LAS int* idx; int nunits, nfull;
    static constexpr bool GATHER_A = GATHER;
    DI bool next(int i, Unit& u) const {
        if (i >= nunits) return false;
        int j, pn;
        if (i < nfull) { j = i / ncol; pn = i - j * ncol; } else { j = nfull / ncol + (i - nfull); pn = -1; }
        const v4u t = *(const LAS v4u*)(ut + 4 * j);
        u.ord = j; u.e = (int)t.x; u.pm = (int)t.y; u.rt = (int)t.z; u.nrows = (int)(t.w & 0xffffu); u.pn = pn >= 0 ? pn : (int)(t.w >> 16);
        return true;
    }
    DI const char* a_base(const Unit& u) const { return GATHER ? A : A + (size_t)u.rt * BM * K * 2; }
    DI const char* b_base(const Unit& u) const { return (u.e < 256 ? Bt + (size_t)u.e * estride : BtS) + (size_t)u.pn * BM * K * 2; }
    DI void a_offs(const Unit& u, int tid, unsigned (&v)[2][2]) const {
#pragma unroll
        for (int i = 0; i < 2; ++i) { int R, C; stage_rc(tid * 16 + i * 8192, R, C);
#pragma unroll
            for (int h = 0; h < 2; ++h) {
                if (GATHER) v[h][i] = ((unsigned)idx[u.ord * 256 + h * HALF + R] * (unsigned)K + (unsigned)C) * 2u;
                else v[h][i] = (unsigned)((h * HALF + R) * K + C) * 2u; } }
    }
};

struct GProf { unsigned long long t_loop, t_epi, t_next; };
typedef int v8i __attribute__((ext_vector_type(8)));
template <class Epi, class Sched, bool PROF = false, bool F8 = false, bool AKEEP = false>
__device__ __forceinline__ void gemm_phase(LAS unsigned char* lds, const int K, const Sched& S, const Epi& E, const int wid  , GProf* prof = nullptr) {
    unsigned long long pt0 = 0, pt1 = 0, pt2 = 0, pt3 = 0;
    const int tid = threadIdx.x, lane = tid & 63, wr = wid >> 2, wc = wid & 3, fr = lane & 15, fq = lane >> 4;
    const int nt = K / BK;
    unsigned voffBh[2][2];
#pragma unroll
    for (int i = 0; i < 2; ++i) { int R, C; stage_rc(tid * 16 + i * 8192, R, C);
#pragma unroll
        for (int h = 0; h < 2; ++h) { int Rb;
            if (Epi::PERM == 2) Rb = 64 * ((R >> 5) & 3) + 16 * ((R >> 2) & 3) + 8 * h + 4 * ((R >> 4) & 1) + (R & 3);
            else Rb = HALF * h + (Epi::PERM == 1 ? ((R & ~31) + perm32(R & 31)) : R);
            voffBh[h][i] = (unsigned)(Rb * K + C) * 2u; } }
    const size_t kstep = (size_t)(BK * 2);
    const size_t hstep = (size_t)HALF * K * 2;
    const unsigned ldsw = (unsigned)wid * 1024u;
    const int aoff = F8 ? lds_byte(wr * 64 + fr, fq * 16) : lds_byte(wr * 64 + fr, fq * 8), boff = F8 ? lds_byte(wc * 32 + fr, fq * 16) : lds_byte(wc * 32 + fr, fq * 8);
#define PG8_SA(b, h) (((b) * 2 + (h)) * HTB)
#define PG8_SB(b, h) ((4 + (b) * 2 + (h)) * HTB)
#define PG8_STAGE(bufoff, gbase, voff) do { _Pragma("unroll") for (int _i = 0; _i < 2; ++_i) \
        __builtin_amdgcn_global_load_lds((const unsigned*)((const char*)(gbase) + (voff)[_i]), (LAS unsigned*)(lds + (bufoff) + ldsw + _i * 8192), 16, 0, 0); } while (0)
#define PG8_STAGE_A(bufoff, gbase, voff, skip) do { if (AKEEP && (skip)) { if constexpr (AKEEP) asm volatile("global_store_byte %0, %0, %1\n\tglobal_store_byte %0, %0, %1" :: "v"(sc127), "s"(S.dump) : "memory"); } \
        else PG8_STAGE(bufoff, gbase, voff); } while (0)
#define PG8_LD8(dst, off) do { const v4u _lo = *(const LAS v4u*)(lds + (off)), _hi = *(const LAS v4u*)(lds + (off) + 16); \
        dst[0] = (int)_lo.x; dst[1] = (int)_lo.y; dst[2] = (int)_lo.z; dst[3] = (int)_lo.w; dst[4] = (int)_hi.x; dst[5] = (int)_hi.y; dst[6] = (int)_hi.z; dst[7] = (int)_hi.w; } while (0)
#define PG8_LDA(dst, b, h) do { if (F8) { _Pragma("unroll") for (int m = 0; m < 4; ++m) PG8_LD8(dst##8[m], PG8_SA(b, h) + aoff + m * 2048); } \
        else { _Pragma("unroll") for (int m = 0; m < 4; ++m) _Pragma("unroll") for (int k = 0; k < 2; ++k) dst[m][k] = *(const LAS bf16x8*)(lds + PG8_SA(b, h) + aoff + m * 2048 + k * 1024); } } while (0)
#define PG8_LDB(dst, b, h) do { if (F8) { _Pragma("unroll") for (int n = 0; n < 2; ++n) PG8_LD8(dst##8[n], PG8_SB(b, h) + boff + n * 2048); } \
        else { _Pragma("unroll") for (int n = 0; n < 2; ++n) _Pragma("unroll") for (int k = 0; k < 2; ++k) dst[n][k] = *(const LAS bf16x8*)(lds + PG8_SB(b, h) + boff + n * 2048 + k * 1024); } } while (0)
#define PG8_MMA(ai, bj, At, Bt) do { __builtin_amdgcn_s_setprio(1); \
        if (F8) { _Pragma("unroll") for (int m = 0; m < 4; ++m) _Pragma("unroll") for (int n = 0; n < 2; ++n) \
            asm volatile("v_mfma_scale_f32_16x16x128_f8f6f4 %0, %1, %2, %0, %3, %3 op_sel_hi:[0,0,0]" : "+v"(acc[ai][bj][m][n]) : "v"(Bt##8[n]), "v"(At##8[m]), "v"(sc127)); } \
        else { _Pragma("unroll") for (int m = 0; m < 4; ++m) _Pragma("unroll") for (int n = 0; n < 2; ++n) _Pragma("unroll") for (int k = 0; k < 2; ++k) \
            acc[ai][bj][m][n] = __builtin_amdgcn_mfma_f32_16x16x32_bf16(Bt[n][k], At[m][k], acc[ai][bj][m][n], 0, 0, 0); } \
        __builtin_amdgcn_s_setprio(0); } while (0)
#define PG8_WAIT_V(n) asm volatile("s_waitcnt vmcnt(" #n ")" ::: "memory")
#define PG8_WAIT_L(n) asm volatile("s_waitcnt lgkmcnt(" #n ")" ::: "memory")
#define PG8_BAR __builtin_amdgcn_s_barrier()
#define PG8_SCHED __builtin_amdgcn_sched_barrier(0)
    Unit cur, nxt; int ui = 0;
    if (!S.next(0, cur)) return;
    f32x4 acc[2][2][4][2];
#pragma unroll
    for (int a = 0; a < 2; ++a)
#pragma unroll
        for (int b = 0; b < 2; ++b)
#pragma unroll
            for (int m = 0; m < 4; ++m)
#pragma unroll
                for (int n = 0; n < 2; ++n) acc[a][b][m][n] = (f32x4){0.f, 0.f, 0.f, 0.f};
    bf16x8 At[4][2], B0[2][2], B1[2][2];
    v8i At8[4], B08[2], B18[2];
    int sc127 = 127; asm volatile("" : "+v"(sc127));
    unsigned vC[2][2], vN[2][2];
    const bool keep_ok = AKEEP && nt == 2; bool sC = false;
    S.a_offs(cur, tid, vC);
    const char* cA = S.a_base(cur); const char* cB = S.b_base(cur);
    PG8_STAGE(PG8_SB(0, 0), cB, voffBh[0]); PG8_STAGE(PG8_SA(0, 0), cA, vC[0]); PG8_STAGE(PG8_SB(0, 1), cB, voffBh[1]); PG8_STAGE(PG8_SA(0, 1), cA, vC[1]);
    if (wr == 1) PG8_BAR;
    PG8_WAIT_V(4); PG8_BAR;
    PG8_STAGE(PG8_SB(1, 0), cB + kstep, voffBh[0]); PG8_STAGE(PG8_SA(1, 0), cA + kstep, vC[0]); PG8_STAGE(PG8_SB(1, 1), cB + kstep, voffBh[1]);
    PG8_WAIT_V(6); PG8_BAR;
    for (;;) {
        if (PROF) pt0 = __builtin_amdgcn_s_memrealtime();
        const bool has_next = S.next(ui + 1, nxt);
        const char* nA = has_next ? S.a_base(nxt) : cA; const char* nB = has_next ? S.b_base(nxt) : cB;
        if (Sched::GATHER_A) { if (has_next) S.a_offs(nxt, tid, vN); else { vN[0][0] = vC[0][0]; vN[0][1] = vC[0][1]; vN[1][0] = vC[1][0]; vN[1][1] = vC[1][1]; } }
        const bool sN = keep_ok && (!has_next || nxt.ord == cur.ord);
        if (PROF) pt1 = __builtin_amdgcn_s_memrealtime();
#pragma unroll 1
        for (int t = 0; t < nt; t += 2) {
            const bool last = (t == nt - 2);
            const char* a1 = cA + (size_t)(t + 1) * kstep;
            const char* a2 = last ? nA : cA + (size_t)(t + 2) * kstep; const char* b2 = last ? nB : cB + (size_t)(t + 2) * kstep;
            const char* a3 = a2 + kstep; const char* b3 = b2 + kstep;
            unsigned x0[2], x1[2];
            if (Sched::GATHER_A) { x0[0] = last ? vN[0][0] : vC[0][0]; x0[1] = last ? vN[0][1] : vC[0][1]; x1[0] = last ? vN[1][0] : vC[1][0]; x1[1] = last ? vN[1][1] : vC[1][1]; }
            else { x0[0] = vC[0][0]; x0[1] = vC[0][1]; x1[0] = vC[1][0]; x1[1] = vC[1][1]; }
            PG8_LDB(B0, 0, 0); PG8_SCHED; PG8_LDA(At, 0, 0); PG8_STAGE_A(PG8_SA(1, 1), a1, vC[1], sC);
            PG8_WAIT_L(8); PG8_BAR; PG8_WAIT_L(0); PG8_MMA(0, 0, At, B0); PG8_WAIT_V(10); PG8_BAR; PG8_SCHED;
            PG8_LDB(B1, 0, 1); PG8_STAGE(PG8_SB(0, 0), b2, voffBh[0]);
            PG8_BAR; PG8_WAIT_L(0); PG8_MMA(0, 1, At, B1); PG8_WAIT_V(10); PG8_BAR;
            PG8_LDA(At, 0, 1); PG8_STAGE_A(PG8_SA(0, 0), a2, x0, sN);
            PG8_BAR; PG8_WAIT_L(0); PG8_MMA(1, 0, At, B0); PG8_BAR; PG8_SCHED;
            PG8_STAGE(PG8_SB(0, 1), b2, voffBh[1]);
            PG8_BAR; PG8_MMA(1, 1, At, B1); PG8_WAIT_V(10); PG8_BAR;
            PG8_LDB(B0, 1, 0); PG8_SCHED; PG8_LDA(At, 1, 0); PG8_STAGE_A(PG8_SA(0, 1), a2, x1, sN);
            PG8_WAIT_L(8); PG8_BAR; PG8_WAIT_L(0); PG8_MMA(0, 0, At, B0); PG8_WAIT_V(10); PG8_BAR; PG8_SCHED;
            PG8_LDB(B1, 1, 1); PG8_STAGE(PG8_SB(1, 0), b3, voffBh[0]);
            PG8_BAR; PG8_WAIT_L(0); PG8_MMA(0, 1, At, B1); PG8_WAIT_V(10); PG8_BAR;
            PG8_LDA(At, 1, 1); PG8_STAGE_A(PG8_SA(1, 0), a3, x0, sN);
            PG8_BAR; PG8_WAIT_L(0); PG8_MMA(1, 0, At, B0); PG8_BAR; PG8_SCHED;
            PG8_STAGE(PG8_SB(1, 1), b3, voffBh[1]);
            PG8_BAR; PG8_MMA(1, 1, At, B1); PG8_WAIT_V(10); PG8_BAR;
        }
        if (PROF) pt2 = __builtin_amdgcn_s_memrealtime();
        if (F8) asm volatile("s_nop 15\n\ts_nop 15" ::: "memory");
        E(acc, cur, wr, wc, fr, fq);
        if (PROF) { asm volatile("s_waitcnt vmcnt(0)" ::: "memory"); pt3 = __builtin_amdgcn_s_memrealtime(); prof->t_next += pt1 - pt0; prof->t_loop += pt2 - pt1; prof->t_epi += pt3 - pt2; }
        if (!has_next) break;
#pragma unroll
        for (int a = 0; a < 2; ++a)
#pragma unroll
            for (int b = 0; b < 2; ++b)
#pragma unroll
                for (int m = 0; m < 4; ++m)
#pragma unroll
                    for (int n = 0; n < 2; ++n) acc[a][b][m][n] = (f32x4){0.f, 0.f, 0.f, 0.f};
        cur = nxt; cA = nA; cB = nB; ++ui; sC = sN;
        if (Sched::GATHER_A) { vC[0][0] = vN[0][0]; vC[0][1] = vN[0][1]; vC[1][0] = vN[1][0]; vC[1][1] = vN[1][1]; }
    }
    PG8_WAIT_V(0);
    if (wr == 0) PG8_BAR;
    PG8_BAR;
#undef PG8_SA
#undef PG8_SB
#undef PG8_STAGE
#undef PG8_STAGE_A
#undef PG8_LD8
#undef PG8_LDA
#undef PG8_LDB
#undef PG8_MMA
#undef PG8_WAIT_V
#undef PG8_WAIT_L
#undef PG8_BAR
#undef PG8_SCHED
}

DI float gelu_tanh(float x) { const float u = 1.5957691216f * (x + 0.044715f * x * x * x); return x * rcpf_(1.0f + expf_(-u)); }
DI float silu_f(float x) { return x * rcpf_(1.0f + expf_(-x)); }

struct EpiInProj {
    static constexpr int PERM = 2;
    bf16* P; const float* LB;
    DI void operator()(const f32x4 (&acc)[2][2][4][2], const Unit& u, int wr, int wc, int fr, int fq) const {
        const int row0 = u.pm * BM + wr * 64 + fr, col0 = u.pn * BM + wc * 64 + 16 * fq;
        const int pn = u.pn;
        const int kind = (pn == 2 || pn == 3) ? 1 : (pn >= 8 && pn < 12) ? 2 : (pn >= 12) ? 3 : 0;
        f32x4 lbv[2][2];
        { const int dir = (pn >> 1) & 1; const int cc = (pn & 1) * 256 + wc * 64 + 16 * fq;
#pragma unroll
            for (int bj = 0; bj < 2; ++bj)
#pragma unroll
                for (int n = 0; n < 2; ++n) lbv[bj][n] = *(const f32x4*)(LB + dir * 512 + cc + 8 * bj + 4 * n);
            asm volatile("" :: "v"(lbv[0][0]), "v"(lbv[0][1]), "v"(lbv[1][0]), "v"(lbv[1][1])); }
#pragma unroll
        for (int ai = 0; ai < 2; ++ai)
#pragma unroll
            for (int m = 0; m < 4; ++m) { bf16* rowp = P + (size_t)(row0 + ai * HALF + m * 16) * INC + col0;
#pragma unroll
                for (int bj = 0; bj < 2; ++bj) { f32x4 v0 = acc[ai][bj][m][0], v1 = acc[ai][bj][m][1];
                    if (kind == 1) {
#pragma unroll
                        for (int j = 0; j < 4; ++j) { v0[j] = gelu_tanh(v0[j]); v1[j] = gelu_tanh(v1[j]); } }
                    else if (kind == 2) {
#pragma unroll
                        for (int j = 0; j < 4; ++j) { const float l0 = lbv[bj][0][j], l1 = lbv[bj][1][j];
                            v0[j] = logf_(l0 + (1.0f - l0) * sigm(v0[j])); v1[j] = logf_(l1 + (1.0f - l1) * sigm(v1[j])); } }
                    else if (kind == 3) {
#pragma unroll
                        for (int j = 0; j < 4; ++j) { v0[j] = silu_f(v0[j]); v1[j] = silu_f(v1[j]); } }
                    v4u w; w.x = pk2(v0[0], v0[1]); w.y = pk2(v0[2], v0[3]); w.z = pk2(v1[0], v1[1]); w.w = pk2(v1[2], v1[3]);
                    *(v4u*)(rowp + 8 * bj) = w; } }
    }
};
struct EpiResid {
    static constexpr int PERM = 2;
    const float* x; const float* mod; bf16* X1;
    DI void operator()(const f32x4 (&acc)[2][2][4][2], const Unit& u, int wr, int wc, int fr, int fq) const {
        const int row0 = u.pm * BM + wr * 64 + fr, col0 = u.pn * BM + wc * 64 + 16 * fq;
        const int b = (u.pm * BM) >> 11;
        f32x4 gv[2][2];
#pragma unroll
        for (int bj = 0; bj < 2; ++bj)
#pragma unroll
            for (int n = 0; n < 2; ++n) gv[bj][n] = *(const f32x4*)(mod + (size_t)b * 6144 + 2048 + col0 + 8 * bj + 4 * n);
        asm volatile("" :: "v"(gv[0][0]), "v"(gv[0][1]), "v"(gv[1][0]), "v"(gv[1][1]));
#pragma unroll
        for (int ai = 0; ai < 2; ++ai)
#pragma unroll
            for (int m = 0; m < 4; ++m) { const size_t off = (size_t)(row0 + ai * HALF + m * 16) * D + col0;
#pragma unroll
                for (int bj = 0; bj < 2; ++bj) { const f32x4 x0 = *(const f32x4*)(x + off + 8 * bj), x1 = *(const f32x4*)(x + off + 8 * bj + 4);
                    const f32x4 v0 = x0 + gv[bj][0] * acc[ai][bj][m][0], v1 = x1 + gv[bj][1] * acc[ai][bj][m][1];
                    v4u w; w.x = pk2(v0[0], v0[1]); w.y = pk2(v0[2], v0[3]); w.z = pk2(v1[0], v1[1]); w.w = pk2(v1[2], v1[3]);
                    *(v4u*)(X1 + off + 8 * bj) = w; } }
    }
};
struct EpiF32 {
    static constexpr int PERM = 0;
    float* C; int ldc;
    DI void operator()(const f32x4 (&acc)[2][2][4][2], const Unit& u, int wr, int wc, int fr, int fq) const {
        const int row0 = u.pm * BM + wr * 64 + fr, col0 = u.pn * BM + wc * 32 + 4 * fq;
#pragma unroll
        for (int ai = 0; ai < 2; ++ai)
#pragma unroll
            for (int m = 0; m < 4; ++m) { float* rowp = C + (size_t)(row0 + ai * HALF + m * 16) * ldc + col0;
#pragma unroll
                for (int bj = 0; bj < 2; ++bj)
#pragma unroll
                    for (int n = 0; n < 2; ++n) *(f32x4*)(rowp + bj * HALF + n * 16) = acc[ai][bj][m][n]; }
    }
};
struct EpiSwiGLU8 {
    static constexpr int PERM = 1;
    unsigned char* ACT;
    DI void operator()(const f32x4 (&acc)[2][2][4][2], const Unit& u, int wr, int wc, int fr, int fq) const {
        const unsigned off0 = ((unsigned)u.rt * 256u + (unsigned)(wr * 64 + fr)) * (unsigned)DE + (unsigned)(u.pn * 128 + wc * 32 + 8 * fq);
#pragma unroll
        for (int ai = 0; ai < 2; ++ai)
#pragma unroll
            for (int m = 0; m < 4; ++m) {
                f32x4 a0 = acc[ai][0][m][0] * 0.03125f, a1 = acc[ai][0][m][1] * 0.03125f; const f32x4 g0 = acc[ai][1][m][0] * 0.25f, g1 = acc[ai][1][m][1] * 0.25f;
#pragma unroll
                for (int j = 0; j < 4; ++j) { a0[j] = silu_f(a0[j]) * g0[j]; a1[j] = silu_f(a1[j]) * g1[j]; }
                v2u w; w.x = pk4_f8(a0[0], a0[1], a0[2], a0[3]); w.y = pk4_f8(a1[0], a1[1], a1[2], a1[3]);
                *(v2u*)(ACT + (off0 + (unsigned)((ai * HALF + m * 16) * DE))) = w; }
    }
};
struct EpiSwiGLU {
    static constexpr int PERM = 1;
    bf16* ACT;
    DI void operator()(const f32x4 (&acc)[2][2][4][2], const Unit& u, int wr, int wc, int fr, int fq) const {
        const int row0 = wr * 64 + fr, col0 = u.pn * 128 + wc * 32 + 8 * fq;
        bf16* base = ACT + (size_t)u.rt * 256 * DE;
#pragma unroll
        for (int ai = 0; ai < 2; ++ai)
#pragma unroll
            for (int m = 0; m < 4; ++m) { bf16* rowp = base + (size_t)(row0 + ai * HALF + m * 16) * DE + col0;
                f32x4 a0 = acc[ai][0][m][0], a1 = acc[ai][0][m][1]; const f32x4 g0 = acc[ai][1][m][0], g1 = acc[ai][1][m][1];
#pragma unroll
                for (int j = 0; j < 4; ++j) { a0[j] = silu_f(a0[j]) * g0[j]; a1[j] = silu_f(a1[j]) * g1[j]; }
                v4u w; w.x = pk2(a0[0], a0[1]); w.y = pk2(a0[2], a0[3]); w.z = pk2(a1[0], a1[1]); w.w = pk2(a1[2], a1[3]);
                *(v4u*)rowp = w; }
    }
};
struct EpiScatter {
    static constexpr int PERM = 2;
    unsigned char* YE; const LAS float* gate; float oscale;
    DI void operator()(const f32x4 (&acc)[2][2][4][2], const Unit& u, int wr, int wc, int fr, int fq) const {
        const unsigned col0 = (unsigned)(u.pn * BM + wc * 64 + 16 * fq);
        float gt[2][4];
#pragma unroll
        for (int ai = 0; ai < 2; ++ai)
#pragma unroll
            for (int m = 0; m < 4; ++m) gt[ai][m] = gate[u.ord * 256 + ai * HALF + wr * 64 + m * 16 + fr] * oscale;
#pragma unroll
        for (int ai = 0; ai < 2; ++ai)
#pragma unroll
            for (int m = 0; m < 4; ++m) { const int r = ai * HALF + wr * 64 + m * 16 + fr; const float g = gt[ai][m];
                const unsigned row = (r < u.nrows) ? (unsigned)u.rt * 256u + (unsigned)r : 360448u;
                const f32x4 v0 = acc[ai][0][m][0] * g, v1 = acc[ai][0][m][1] * g, v2 = acc[ai][1][m][0] * g, v3 = acc[ai][1][m][1] * g;
                v4u w; w.x = pk4_f8(v0[0], v0[1], v0[2], v0[3]); w.y = pk4_f8(v1[0], v1[1], v1[2], v1[3]); w.z = pk4_f8(v2[0], v2[1], v2[2], v2[3]); w.w = pk4_f8(v3[0], v3[1], v3[2], v3[3]);
                *(v4u*)(YE + (row * (unsigned)D + col0)) = w; }
    }
};
}

struct Args { const float* in[26]; float* out; unsigned char* ws; int ph_lo, ph_hi; };
enum { I_X = 0, I_C, I_CTX, I_CCTX, I_ADAW, I_ADAB, I_NMIX, I_NFFN, I_NFIN, I_WIN, I_WOUT, I_CONVW, I_CONVB, I_WA, I_BA, I_WX, I_BX, I_LAM,
       I_LBL, I_HNORM, I_RW, I_RB, I_EW13, I_EW2, I_SW13, I_SW2 };

struct Frame {
    LAS unsigned char* lds;
    int tid, lane, wave, G, vcu, bx;
    const float* const* in; float* out; unsigned char* ws;
};

DI void transpose_item(const float* W, int ldw, bf16* WT, int ldo, int k0, int n0, int orow0, LAS float* scr, int lane) {
    const int sub = lane >> 3, c4 = (lane & 7) * 4;
    f32x4 v[8];
#pragma unroll
    for (int i = 0; i < 8; ++i) v[i] = __builtin_nontemporal_load((const f32x4*)(W + (size_t)(k0 + 8 * i + sub) * ldw + n0 + c4));
#pragma unroll
    for (int i = 0; i < 8; ++i) { LAS float* d = scr + (8 * i + sub) * 33 + c4; d[0] = v[i].x; d[1] = v[i].y; d[2] = v[i].z; d[3] = v[i].w; }
    LDS_WAIT(); asm volatile("" ::: "memory");
    const int c = lane & 7;
#pragma unroll
    for (int j = 0; j < 4; ++j) { const int n = (lane >> 3) + 8 * j; const LAS float* s = scr + (8 * c) * 33 + n;
        v4u o; o.x = pk2(s[0 * 33], s[1 * 33]); o.y = pk2(s[2 * 33], s[3 * 33]); o.z = pk2(s[4 * 33], s[5 * 33]); o.w = pk2(s[6 * 33], s[7 * 33]);
        *(v4u*)(WT + (size_t)(orow0 + n) * ldo + k0 + 8 * c) = o; }
    LDS_WAIT(); asm volatile("" ::: "memory");
}
DI void transpose_item8(const float* W, int ldw, unsigned char* WT, int ldo, int k0, int n0, int orow0, float scale, LAS float* scr, int lane) {
    const int sub = lane >> 3, c4 = (lane & 7) * 4;
    f32x4 v[16];
#pragma unroll
    for (int i = 0; i < 16; ++i) v[i] = __builtin_nontemporal_load((const f32x4*)(W + (size_t)(k0 + 8 * i + sub) * ldw + n0 + c4));
#pragma unroll
    for (int i = 0; i < 16; ++i) { LAS float* d = scr + (8 * i + sub) * 33 + c4; d[0] = v[i].x; d[1] = v[i].y; d[2] = v[i].z; d[3] = v[i].w; }
    LDS_WAIT(); asm volatile("" ::: "memory");
    const int c = lane & 7;
#pragma unroll
    for (int j = 0; j < 4; ++j) { const int n = (lane >> 3) + 8 * j; const LAS float* sp = scr + (16 * c) * 33 + n;
        v4u o; o.x = pk4_f8(sp[0] * scale, sp[33] * scale, sp[66] * scale, sp[99] * scale); o.y = pk4_f8(sp[132] * scale, sp[165] * scale, sp[198] * scale, sp[231] * scale);
        o.z = pk4_f8(sp[264] * scale, sp[297] * scale, sp[330] * scale, sp[363] * scale); o.w = pk4_f8(sp[396] * scale, sp[429] * scale, sp[462] * scale, sp[495] * scale);
        *(v4u*)(WT + (size_t)(orow0 + n) * ldo + k0 + 16 * c) = o; }
    LDS_WAIT(); asm volatile("" ::: "memory");
}
DI int w13_row(int n) { const int half = n >> 8, idx = n & 255; return 256 * (idx >> 7) + 128 * half + (idx & 127); }

DI void phase_prologue(const Frame& F) {
    const float* const* in = F.in; unsigned char* ws = F.ws;
    {
        LAS float* sc = (LAS float*)F.lds;
        LAS float* red = (LAS float*)(F.lds + 17 * 1024 * 4);
        for (int i = F.tid; i < 17 * 1024; i += NTHR) { const int r = i >> 10, k = i & 1023; const float v = (r < 16) ? in[I_C][r * 1024 + k] : in[I_CCTX][k]; sc[i] = v / (1.0f + __expf(-v)); }
        __syncthreads();
        const float* aw = in[I_ADAW]; float* MOD = (float*)(ws + WS_MOD);
        for (int cg = F.bx; cg < 256; cg += F.G) {
            const int kg = F.tid >> 5, cl = F.tid & 31, col = cg * 24 + cl;
            float a[17];
#pragma unroll
            for (int r = 0; r < 17; ++r) a[r] = 0.f;
            if (cl < 24) {
#pragma unroll 1
                for (int k8 = 0; k8 < 64; k8 += 16) { float w[16];
#pragma unroll
                    for (int q = 0; q < 16; ++q) w[q] = aw[(size_t)(kg * 64 + k8 + q) * 6144 + col];
#pragma unroll
                    for (int q = 0; q < 16; ++q) { const int k = kg * 64 + k8 + q;
#pragma unroll
                        for (int r = 0; r < 17; ++r) a[r] += sc[r * 1024 + k] * w[q]; } }
#pragma unroll
                for (int r = 0; r < 17; ++r) red[(kg * 17 + r) * 24 + cl] = a[r];
            }
            __syncthreads();
            if (F.tid < 17 * 24) { const int r = F.tid / 24, c2 = F.tid % 24; float s = 0.f;
                for (int g = 0; g < 16; ++g) s += red[(g * 17 + r) * 24 + c2];
                MOD[r * 6144 + cg * 24 + c2] = s + in[I_ADAB][cg * 24 + c2]; }
            __syncthreads();
        }
    }
    {
        float* LB = (float*)(ws + WS_TAB); float* SP = LB + 1024;
        const int gt = F.bx * NTHR + F.tid, GT = F.G * NTHR;
        for (int i = gt; i < 1024; i += GT) { const int d = i >> 9, c = i & 511;
            const float l0 = in[I_LBL][(d * 2 + 0) * 512 + c], l1 = in[I_LBL][(d * 2 + 1) * 512 + c];
            LB[i] = 1.0f / (1.0f + expf(l1 - l0));
            SP[i] = -8.0f * 1.4426950408889634f * log1pf(expf(-in[I_LAM][i])); }
        bf16* WGT = (bf16*)(ws + WS_WGT);
        for (int i = gt; i < 2 * 2 * 8 * 64 * 64; i += GT) { const int ii = i & 63, j = (i >> 6) & 63, h = (i >> 12) & 7, g = (i >> 15) & 1, d = i >> 16;
            const float* src = g ? in[I_WX] : in[I_WA];
            WGT[i] = f2bf(-1.4426950408889634f * src[((size_t)(d * 8 + h) * 64 + ii) * 64 + j]); }
    }
    {
        LAS float* scr = (LAS float*)(F.lds + F.wave * 16896);
        const int gw = F.vcu * NWAVES + F.wave, NGW = F.G * NWAVES;
        constexpr int IT_WIN = 16 * 112, IT_WOUT = 16 * 32, IT_WR = 16 * 8, IT_SW13 = 8 * 16, IT_SW2 = 2 * 32;
        LAS float* scr8 = (LAS float*)(F.lds + F.wave * 16896);
        constexpr int NIT = IT_WIN + IT_WOUT + IT_WR + IT_SW13 + IT_SW2;
        for (int it = gw; it < NIT; it += NGW) {
            int r = it;
            if (r < IT_WIN) { const int kb = r / 112, nb = r % 112; transpose_item(in[I_WIN], INC, (bf16*)(ws + WS_WIN), 1024, kb * 64, nb * 32, nb * 32, scr, F.lane); continue; } r -= IT_WIN;
            if (r < IT_WOUT) { const int kb = r / 32, nb = r % 32; transpose_item(in[I_WOUT], 1024, (bf16*)(ws + WS_WOUT), 1024, kb * 64, nb * 32, nb * 32, scr, F.lane); continue; } r -= IT_WOUT;
            if (r < IT_WR) { const int kb = r / 8, nb = r % 8; transpose_item(in[I_RW], 256, (bf16*)(ws + WS_WR), 1024, kb * 64, nb * 32, nb * 32, scr, F.lane); continue; } r -= IT_WR;
            if (r < IT_SW13) { const int kb = r / 16, nb = r % 16; transpose_item8(in[I_SW13], 512, ws + WS_SW13, 1024, kb * 128, nb * 32, w13_row(nb * 32), 32.0f, scr8, F.lane); continue; } r -= IT_SW13;
            { const int kb = r / 32, nb = r % 32; transpose_item8(in[I_SW2], 1024, ws + WS_SW2, 256, kb * 128, nb * 32, nb * 32, 16.0f, scr8, F.lane); }
        }
    }
}
constexpr int CV_STR = 132, CV_B = 128 * CV_STR * 4, CV_STR2 = 144;
static_assert(CV_B + 128 * CV_STR2 <= LDS_MISC, "convert lds");
DI void convert_experts(const Frame& F, const unsigned* stop_ctr, unsigned stop_val) {
    const float* const* in = F.in; unsigned char* ws = F.ws;
    LAS float* scr = (LAS float*)F.lds; LAS unsigned char* img = F.lds + CV_B;
    volatile LAS int* slot = (volatile LAS int*)(F.lds + LDS_MISC + 48);
    unsigned* qhead = (unsigned*)(ws + WS_CTL) + CW_CONVQ;
    constexpr int NB13 = 256 * 32, NB2 = 256 * 16;
    auto decode = [&](int blk, const float*& src, int& ldw, unsigned char*& dst, int& ldo, int& orow0, float& scale) {
        if (blk < NB13) { const int e = blk >> 5, q = blk & 31, nb = q >> 3, kb = q & 7;
            src = in[I_EW13] + (size_t)e * 1024 * 512 + (size_t)(kb * 128) * 512 + nb * 128; ldw = 512;
            dst = ws + WS_EW13 + (size_t)e * 512 * 1024 + kb * 128; ldo = 1024; orow0 = w13_row(nb * 128); scale = 32.0f; }
        else { const int r = blk - NB13, e = r >> 4, q = r & 15, nb = q >> 1, kb = q & 1;
            src = in[I_EW2] + (size_t)e * 256 * 1024 + (size_t)(kb * 128) * 1024 + nb * 128; ldw = 1024;
            dst = ws + WS_EW2 + (size_t)e * 1024 * 256 + kb * 128; ldo = 256; orow0 = nb * 128; scale = 16.0f; } };
    int ch_next = 0, ch_left = 0;
    auto claim = [&]() -> int {
        if (ch_left == 0) { __syncthreads();
            if (F.tid == 0) { int v = 0x7fffffff;
                if (!stop_ctr || __hip_atomic_load(stop_ctr, __ATOMIC_RELAXED, __HIP_MEMORY_SCOPE_AGENT) < stop_val) v = (int)__hip_atomic_fetch_add(qhead, 4u, __ATOMIC_RELAXED, __HIP_MEMORY_SCOPE_AGENT);
                slot[0] = v; }
            __syncthreads(); ch_next = slot[0]; ch_left = 4; }
        const int r = ch_next; if (ch_next < 0x7ffffff0) ++ch_next; --ch_left; return r; };
    f32x4 v[8];
    int blk = claim();
    const float* src = nullptr; int ldw = 0; unsigned char* dst = nullptr; int ldo = 0, orow0 = 0; float scale = 1.f;
    if (blk < NB13 + NB2) { decode(blk, src, ldw, dst, ldo, orow0, scale);
#pragma unroll
        for (int i = 0; i < 8; ++i) { const int p = F.tid + NTHR * i; v[i] = *(const f32x4*)(src + (size_t)(p >> 5) * ldw + (p & 31) * 4); } }
    while (blk < NB13 + NB2) {
#pragma unroll
        for (int i = 0; i < 8; ++i) { const int p = F.tid + NTHR * i; *(LAS f32x4*)(scr + (p >> 5) * CV_STR + (p & 31) * 4) = v[i]; }
        unsigned char* cdst = dst; const int cldo = ldo, corow0 = orow0; const float cscale = scale;
        blk = claim();
        if (blk < NB13 + NB2) { decode(blk, src, ldw, dst, ldo, orow0, scale);
#pragma unroll
            for (int i = 0; i < 8; ++i) { const int p = F.tid + NTHR * i; v[i] = *(const f32x4*)(src + (size_t)(p >> 5) * ldw + (p & 31) * 4); } }
        __syncthreads();
#pragma unroll
        for (int i = 0; i < 2; ++i) { const int n = F.tid & 127, kc = ((F.tid >> 7) + 4 * i) * 16;
            const LAS float* sp = scr + kc * CV_STR + n;
            v4u o; o.x = pk4_f8(sp[0] * cscale, sp[CV_STR] * cscale, sp[2 * CV_STR] * cscale, sp[3 * CV_STR] * cscale);
            o.y = pk4_f8(sp[4 * CV_STR] * cscale, sp[5 * CV_STR] * cscale, sp[6 * CV_STR] * cscale, sp[7 * CV_STR] * cscale);
            o.z = pk4_f8(sp[8 * CV_STR] * cscale, sp[9 * CV_STR] * cscale, sp[10 * CV_STR] * cscale, sp[11 * CV_STR] * cscale);
            o.w = pk4_f8(sp[12 * CV_STR] * cscale, sp[13 * CV_STR] * cscale, sp[14 * CV_STR] * cscale, sp[15 * CV_STR] * cscale);
            *(LAS v4u*)(img + n * CV_STR2 + kc) = o; }
        __syncthreads();
#pragma unroll
        for (int i = 0; i < 2; ++i) { const int p = F.tid + NTHR * i; const int n = p >> 3, pc = (p & 7) * 16;
            *(v4u*)(cdst + (size_t)(corow0 + n) * cldo + pc) = *(const LAS v4u*)(img + n * CV_STR2 + pc); }
    }
    __syncthreads();
}

DI void phase_norm_rows(const Frame& F, int mode) {
    const float* MOD = (const float*)(F.ws + WS_MOD);
    const int gw = F.bx * NWAVES + F.wave, NGW = F.G * NWAVES;
    const int nrows = mode == 0 ? MTOT : NTOK;
    const float* gain = mode == 0 ? F.in[I_NMIX] : F.in[I_NFFN];
    bf16* dst = (bf16*)(F.ws + (mode == 0 ? WS_HX : WS_HX2));
    const int sh_off = mode == 0 ? 0 : 3072, sc_off = mode == 0 ? 1024 : 4096;
    const int per = (nrows + NGW - 1) / NGW, r0 = gw * per, r1 = (r0 + per < nrows) ? r0 + per : nrows;
    f32x4 gn[4];
#pragma unroll
    for (int j = 0; j < 4; ++j) gn[j] = *(const f32x4*)(gain + 4 * F.lane + 256 * j);
    auto rowsrc = [&](int m) -> const float* {
        return (m < NTOK) ? F.in[I_X] + (size_t)m * D : F.in[I_CTX] + (size_t)(m - NTOK) * D; };
    const bf16* X1b = (const bf16*)(F.ws + WS_X1);
    auto ldrow = [&](int m, f32x4 (&v)[4]) {
        if (mode == 0) {
#pragma unroll
            for (int j = 0; j < 4; ++j) v[j] = *(const f32x4*)(rowsrc(m) + 4 * F.lane + 256 * j); }
        else {
#pragma unroll
            for (int j = 0; j < 4; ++j) { const v2u t = *(const v2u*)(X1b + (size_t)m * D + 4 * F.lane + 256 * j); v[j] = (f32x4){bflo(t.x), bfhi(t.x), bflo(t.y), bfhi(t.y)}; } } };
    f32x4 va[4], vb[4], ga[4], sb4[4]; int cur_mr = -1;
#pragma unroll
    for (int j = 0; j < 4; ++j) { ga[j] = gn[j]; sb4[j] = gn[j]; }
    if (r0 < r1) { ldrow(r0, va); ldrow((r0 + 1 < r1) ? r0 + 1 : r0, vb); }
#pragma unroll 1
    for (int m = r0; m < r1; m += 2) {
        f32x4 ca[4], cb[4];
#pragma unroll
        for (int j = 0; j < 4; ++j) { ca[j] = va[j]; cb[j] = vb[j]; }
        const bool hasb = (m + 1 < r1);
        { const int na = (m + 2 < r1) ? m + 2 : m, nb = (m + 3 < r1) ? m + 3 : na; ldrow(na, va); ldrow(nb, vb); }
        float sa = 0.f, sb = 0.f;
#pragma unroll
        for (int j = 0; j < 4; ++j) { sa += (ca[j].x * ca[j].x + ca[j].y * ca[j].y) + (ca[j].z * ca[j].z + ca[j].w * ca[j].w); sb += (cb[j].x * cb[j].x + cb[j].y * cb[j].y) + (cb[j].z * cb[j].z + cb[j].w * cb[j].w); }
        const float rsa = rsqrtf(wave_sum_fast(sa) * (1.0f / D) + EPS), rsb = rsqrtf(wave_sum_fast(sb) * (1.0f / D) + EPS);
#pragma unroll
        for (int q = 0; q < 2; ++q) {
            if (q == 1 && !hasb) break;
            const int mm = m + q; const float rs = q ? rsb : rsa;
            const int mr = (mode == 0 && mm >= NTOK) ? 16 : (mm >> 11);
            if (mr != cur_mr) { cur_mr = mr;
#pragma unroll
                for (int j = 0; j < 4; ++j) { const int c = 4 * F.lane + 256 * j;
                    ga[j] = gn[j] * (*(const f32x4*)(MOD + mr * 6144 + sc_off + c) + 1.0f); sb4[j] = *(const f32x4*)(MOD + mr * 6144 + sh_off + c); } }
#pragma unroll
            for (int j = 0; j < 4; ++j) { const int c = 4 * F.lane + 256 * j;
                const f32x4 v = q ? cb[j] : ca[j];
                const f32x4 y = (v * rs) * ga[j] + sb4[j];
                v2u w; w.x = pk2(y.x, y.y); w.y = pk2(y.z, y.w);
                *(v2u*)(dst + (size_t)mm * D + c) = w;
                if (mode == 1) *(unsigned*)(F.ws + WS_HX2F + (size_t)mm * D + c) = pk4_f8(y.x, y.y, y.z, y.w); }
        }
    }
}

constexpr int LT_STR = 520;
constexpr int L_RT = 0;
constexpr int L_GT = 69888;
static_assert(L_GT + 64 * LT_STR * 2 <= LDS_MISC, "lru lds");
template <int MODE, int dir> DI void lru_dir(const Frame& F, const int b, const int s, const int h, const int fr, const int fq, const int prow0, const bf16x8 (&Af)[4][2],
                                            const bf16* WGT, const float* SP, LAS bf16* hlb, LAS bf16* gtb, LAS bf16* GT, LAS bf16* HL) {
#pragma unroll 1
        for (int nt = 0; nt < 4; ++nt) {
            const int cj = 64 * h + 16 * nt + fr;
            bf16x8 Ba[2], Bx[2], Id[2];
#pragma unroll
            for (int ks = 0; ks < 2; ++ks) {
                Ba[ks] = *(const bf16x8*)(WGT + ((size_t)((dir * 2 + 0) * 8 + h) * 64 + 16 * nt + fr) * 64 + 32 * ks + 8 * fq);
                Bx[ks] = *(const bf16x8*)(WGT + ((size_t)((dir * 2 + 1) * 8 + h) * 64 + 16 * nt + fr) * 64 + 32 * ks + 8 * fq);
#pragma unroll
                for (int jj = 0; jj < 8; ++jj) Id[ks][jj] = (32 * ks + 8 * fq + jj == 16 * nt + fr) ? (short)0x3F80 : (short)0;
            }
            const float ba = -1.4426950408889634f * F.in[I_BA][dir * 512 + cj], bx = -1.4426950408889634f * F.in[I_BX][dir * 512 + cj], sp = SP[dir * 512 + cj];
            float cin = 0.f, ptot = 1.f;
#pragma unroll
            for (int tti = 0; tti < 4; ++tti) {
                const int tt = dir ? 3 - tti : tti;
                const bf16x8 A0 = dir ? Af[3 - tti][0] : Af[tti][0], A1 = dir ? Af[3 - tti][1] : Af[tti][1];
                f32x4 pa = {0.f, 0.f, 0.f, 0.f}, px = {0.f, 0.f, 0.f, 0.f}, uc = {0.f, 0.f, 0.f, 0.f};
                pa = __builtin_amdgcn_mfma_f32_16x16x32_bf16(A0, Ba[0], pa, 0, 0, 0); pa = __builtin_amdgcn_mfma_f32_16x16x32_bf16(A1, Ba[1], pa, 0, 0, 0);
                px = __builtin_amdgcn_mfma_f32_16x16x32_bf16(A0, Bx[0], px, 0, 0, 0); px = __builtin_amdgcn_mfma_f32_16x16x32_bf16(A1, Bx[1], px, 0, 0, 0);
                uc = __builtin_amdgcn_mfma_f32_16x16x32_bf16(A0, Id[0], uc, 0, 0, 0); uc = __builtin_amdgcn_mfma_f32_16x16x32_bf16(A1, Id[1], uc, 0, 0, 0);
                float av[4], bv[4];
#pragma unroll
                for (int ri = 0; ri < 4; ++ri) { const float pav = dir ? pa[3 - ri] : pa[ri], pxv = dir ? px[3 - ri] : px[ri], ucv = dir ? uc[3 - ri] : uc[ri];
                    const float rg = rcpf_(1.0f + ex2f_(pav + ba)), ig = rcpf_(1.0f + ex2f_(pxv + bx));
                    const float a = ex2f_(rg * sp); av[ri] = a; bv[ri] = __builtin_amdgcn_sqrtf(__builtin_fmaf(-a, a, 1.0f)) * (ig * ucv); }
                float pl = 1.f, hl = 0.f;
#pragma unroll
                for (int ri = 0; ri < 4; ++ri) { hl = av[ri] * hl + bv[ri]; pl *= av[ri]; }
                float pg[4], hg[4];
#pragma unroll
                for (int gi = 0; gi < 4; ++gi) { const int g = dir ? 3 - gi : gi; pg[gi] = __shfl(pl, fr + 16 * g); hg[gi] = __shfl(hl, fr + 16 * g); }
                const int myg = dir ? 3 - fq : fq;
                float mycin = cin, run = cin, myp = ptot, prun = ptot;
#pragma unroll
                for (int gi = 0; gi < 4; ++gi) { if (gi == myg) { mycin = run; myp = prun; } run = pg[gi] * run + hg[gi]; prun *= pg[gi]; }
                if (MODE == 1) { float hc = mycin, pc = myp;
#pragma unroll
                    for (int ri = 0; ri < 4; ++ri) { const int r = dir ? 3 - ri : ri; hc = av[ri] * hc + bv[ri]; pc *= av[ri];
                        const int o = (16 * tt + r) * LT_STR + 16 * nt;
                        hlb[o] = f2bf(dir == 0 ? hc : bf2f(hlb[o]) + hc); gtb[o] = f2bf(pc); } }
                ptot = prun;
                cin = run;
            }
            if (fq == 0) { const size_t o = ((size_t)(dir * NB + b) * NSEQT + s) * 512 + cj;
                ((float*)(F.ws + WS_SUMA))[o] = ptot; ((float*)(F.ws + WS_SUMH))[o] = cin; }
        }
        if (MODE == 1) {
            __syncthreads();
            bf16* PD = (bf16*)(F.ws + (dir ? WS_LPB : WS_LPF)); bf16* HSg = (bf16*)(F.ws + WS_LHS);
#pragma unroll
            for (int it = 0; it < 8; ++it) { const int p = F.tid + it * NTHR; const int row = p >> 6, pc = p & 63;
                *(v4u*)(PD + (size_t)(prow0 + row) * 512 + 8 * pc) = *(const LAS v4u*)(GT + row * LT_STR + 8 * pc);
                if (dir == 1) *(v4u*)(HSg + (size_t)(prow0 + row) * 512 + 8 * pc) = *(const LAS v4u*)(HL + row * LT_STR + 8 * pc); }
            __syncthreads();
        }
}
template <int MODE> DI void lru_tile(const Frame& F, int b, int s) {
    const bf16* P = (const bf16*)(F.ws + WS_P);
    const int h = F.wave, fr = F.lane & 15, fq = F.lane >> 4;
    int prow0, L, t0;
    if (s < 4) { prow0 = NTOK + b * CTXL + 64 * s; L = CTXL; t0 = 64 * s; } else { prow0 = b * SEQ + 64 * (s - 4); L = SEQ; t0 = 64 * (s - 4); }
    LAS bf16* RT = (LAS bf16*)(F.lds + L_RT); LAS bf16* GT = (LAS bf16*)(F.lds + L_GT);
#pragma unroll
    for (int it = 0; it < 9; ++it) { const int p = F.tid + it * NTHR;
        if (p < 67 * 64) { const int row = p >> 6, pc = p & 63, ts = t0 + row - 1;
            v4u v = {0u, 0u, 0u, 0u};
            if (ts >= 0 && ts < L) v = *(const v4u*)(P + (size_t)(prow0 + row - 1) * INC + 8 * pc);
            *(LAS v4u*)(RT + row * LT_STR + 8 * pc) = v; } }
    __syncthreads();
    bf16x8 Af[4][2];
#pragma unroll
    for (int ks = 0; ks < 2; ++ks) {
        const int c0 = 64 * h + 32 * ks + 8 * fq;
        float cw[4][8], cb[8];
#pragma unroll
        for (int k = 0; k < 4; ++k) { const f32x4 w0 = *(const f32x4*)(F.in[I_CONVW] + k * 512 + c0), w1 = *(const f32x4*)(F.in[I_CONVW] + k * 512 + c0 + 4);
            cw[k][0] = w0.x; cw[k][1] = w0.y; cw[k][2] = w0.z; cw[k][3] = w0.w; cw[k][4] = w1.x; cw[k][5] = w1.y; cw[k][6] = w1.z; cw[k][7] = w1.w; }
        { const f32x4 w0 = *(const f32x4*)(F.in[I_CONVB] + c0), w1 = *(const f32x4*)(F.in[I_CONVB] + c0 + 4);
            cb[0] = w0.x; cb[1] = w0.y; cb[2] = w0.z; cb[3] = w0.w; cb[4] = w1.x; cb[5] = w1.y; cb[6] = w1.z; cb[7] = w1.w; }
        const LAS bf16* rbase = RT + fr * LT_STR + c0;
#pragma unroll
        for (int tt = 0; tt < 4; ++tt) {
            float u[8];
#pragma unroll
            for (int j = 0; j < 8; ++j) u[j] = cb[j];
#pragma unroll
            for (int k = 0; k < 4; ++k) { const v4u r8 = *(const LAS v4u*)(rbase + (16 * tt + k) * LT_STR);
                u[0] += cw[k][0] * bflo(r8.x); u[1] += cw[k][1] * bfhi(r8.x); u[2] += cw[k][2] * bflo(r8.y); u[3] += cw[k][3] * bfhi(r8.y);
                u[4] += cw[k][4] * bflo(r8.z); u[5] += cw[k][5] * bfhi(r8.z); u[6] += cw[k][6] * bflo(r8.w); u[7] += cw[k][7] * bfhi(r8.w); }
            v4u w; w.x = pk2(u[0], u[1]); w.y = pk2(u[2], u[3]); w.z = pk2(u[4], u[5]); w.w = pk2(u[6], u[7]);
            Af[tt][ks] = __builtin_bit_cast(bf16x8, w);
        }
    }
    const bf16* WGT = (const bf16*)(F.ws + WS_WGT);
    const float* SP = (const float*)(F.ws + WS_TAB) + 1024;
    LAS bf16* HL = RT;
    LAS bf16* hlb = HL + (4 * fq) * LT_STR + 64 * h + fr;
    LAS bf16* gtb = GT + (4 * fq) * LT_STR + 64 * h + fr;
    lru_dir<MODE, 0>(F, b, s, h, fr, fq, prow0, Af, WGT, SP, hlb, gtb, GT, HL);
    lru_dir<MODE, 1>(F, b, s, h, fr, fq, prow0, Af, WGT, SP, hlb, gtb, GT, HL);
    __syncthreads();
}
DI void phase_lru_pass1(const Frame& F) {
    unsigned* done = (unsigned*)(F.ws + WS_CTL) + CW_LRUDONE;
    const int NL = (F.G >= 256) ? 192 : F.G;
#if defined(PROBE_SUB)
    __syncthreads(); asm volatile("" ::: "memory"); if (F.wave == 0 && PROBE_SUB == 2) ((volatile LAS unsigned long long*)(F.lds + LDS_MISC))[0] = __builtin_amdgcn_s_memrealtime(); asm volatile("" ::: "memory");
#endif
    if (F.bx < NL) {
        for (int it = F.bx; it < NB * NSEQT; it += NL) { { const int bb = it / NSEQT, ss = it % NSEQT; if (ss < 4) lru_tile<0>(F, bb, ss); else lru_tile<1>(F, bb, ss); }
            if (F.tid == 0) __hip_atomic_fetch_add(done, 1u, __ATOMIC_RELAXED, __HIP_MEMORY_SCOPE_AGENT); }
    }
#if defined(PROBE_SUB)
    __syncthreads(); asm volatile("" ::: "memory"); if (F.wave == 0 && PROBE_SUB == 2) ((volatile LAS unsigned long long*)(F.lds + LDS_MISC))[1] = __builtin_amdgcn_s_memrealtime(); asm volatile("" ::: "memory");
#endif
    if (F.G >= 256) convert_experts(F, done, (unsigned)(NB * NSEQT));
}
DI void phase_lru_carry(const Frame& F) {
    if (F.wave != 0) return;
    const float* SA = (const float*)(F.ws + WS_SUMA); const float* SH = (const float*)(F.ws + WS_SUMH); float* CI = (float*)(F.ws + WS_CIN);
    for (int id = F.bx * 64 + F.lane; id < 2 * NB * 512; id += F.G * 64) {
        const int dir = id >> 13, b = (id >> 9) & 15, c = id & 511;
        float x = 0.f; const size_t o0 = (size_t)(dir * NB + b) * NSEQT * 512 + c;
#pragma unroll
        for (int hf = 0; hf < 2; ++hf) {
            float av[18], hv[18];
#pragma unroll
            for (int q = 0; q < 18; ++q) { const int st = 18 * hf + q, s = dir ? (st < 4 ? 3 - st : 39 - st) : st; av[q] = SA[o0 + (size_t)s * 512]; hv[q] = SH[o0 + (size_t)s * 512]; }
#pragma unroll
            for (int q = 0; q < 18; ++q) { const int st = 18 * hf + q, s = dir ? (st < 4 ? 3 - st : 39 - st) : st; CI[o0 + (size_t)s * 512] = x; x = av[q] * x + hv[q]; }
        }
    }
}

constexpr int HS = 144, SCS = 40;
constexpr int H_Q = 0, H_LF = H_Q + 32 * HS * 2, H_V = H_LF + 32 * HS * 2, H_QT = H_V + 32 * HS * 2, H_KT = H_QT + 32 * HS * 2, H_KH = H_KT + 32 * HS * 2,
              H_SC = H_KH + 32 * HS * 2, H_DEC = H_SC + 32 * SCS * 2, H_SET = H_DEC + 512;
static_assert(2 * H_SET <= RING_BYTES, "hgrn lds");
typedef short s16x4 __attribute__((ext_vector_type(4)));
DI bf16x8 tr_frag(const LAS bf16* tile, int c0, int lane) {
    const int g = lane >> 4, q = (lane & 15) >> 2, p = lane & 3;
    const LAS bf16* a = tile + (8 * g + q) * HS + c0 + 4 * p;
    const s16x4 lo = __builtin_amdgcn_ds_read_tr16_b64_v4i16((LAS s16x4*)a), hi = __builtin_amdgcn_ds_read_tr16_b64_v4i16((LAS s16x4*)(a + 4 * HS));
    bf16x8 r; r[0] = lo[0]; r[1] = lo[1]; r[2] = lo[2]; r[3] = lo[3]; r[4] = hi[0]; r[5] = hi[1]; r[6] = hi[2]; r[7] = hi[3]; return r;
}
constexpr int P_QR = 0, P_LR = P_QR + 2 * 9216, P_VR = P_LR + 2 * 9216, P_QT = P_VR + 4 * 9216, P_KT = P_QT + 2 * 9216, P_KH = P_KT + 2 * 9216, P_SC = P_KH + 2 * 9216, P_DEC = P_SC + 2 * 2560, P_END = P_DEC + 2 * 512;
static_assert(P_END <= LDS_MISC, "hgrn pipelined lds");
DI void hgrn_chain2(const Frame& F, int item) {
    const int b = item >> 3, h = (item >> 1) & 3, dir = item & 1;
    const bf16* P = (const bf16*)(F.ws + WS_P);
    bf16* O = (bf16*)(F.ws + (dir ? WS_OB : WS_OF));
    const int w = F.wave, lane = F.lane, fr = lane & 15, g = lane >> 4;
    const int li = F.tid >> 4, lp = F.tid & 15;
    auto prow = [&](int c, int i) -> size_t {
        const int ii = dir ? 31 - i : i;
        if (c < 8) { const int cc = dir ? 7 - c : c; return (size_t)NTOK + b * CTXL + 32 * cc + ii; }
        const int col = dir ? 63 - (c - 8) : (c - 8); return (size_t)b * SEQ + ii * 64 + col; };
    const size_t coff = 128 * h + 8 * lp;
    v4u rqA, rlA, rvA, rqB, rlB, rvB;
    { const bf16* rp = P + prow(0, li) * INC + coff; rqA = *(const v4u*)(rp + 1024); rvA = *(const v4u*)(rp + 1536); rlA = *(const v4u*)(rp + 2048 + 512 * dir); }
    { const bf16* rp = P + prow(1, li) * INC + coff; rqB = *(const v4u*)(rp + 1024); rvB = *(const v4u*)(rp + 1536); rlB = *(const v4u*)(rp + 2048 + 512 * dir); }
    LAS unsigned char* L = F.lds;
#define HG2_W(k, U, RQ, RL, RV) do { \
        const int i = (k) - 2, wch = (k), pch = (k) - 1; (void)i; (void)pch; \
        if (wch < 72) {   \
            *(LAS v4u*)((LAS bf16*)(L + P_QR + ((U) & 1) * 9216) + li * HS + 8 * lp) = RQ; *(LAS v4u*)((LAS bf16*)(L + P_LR + ((U) & 1) * 9216) + li * HS + 8 * lp) = RL; \
            *(LAS v4u*)((LAS bf16*)(L + P_VR + (U) * 9216) + li * HS + 8 * lp) = RV; \
            if (wch + 2 < 72) { const bf16* rp = P + prow(wch + 2, li) * INC + coff; RQ = *(const v4u*)(rp + 1024); RV = *(const v4u*)(rp + 1536); RL = *(const v4u*)(rp + 2048 + 512 * dir); } } \
    } while (0)
#define HG2_PREP(k, U) do { \
        const int i = (k) - 2, wch = (k), pch = (k) - 1; (void)i; (void)pch; \
        const int pw = w - 4; \
            if (pch >= 0 && pch < 72) {   \
                const LAS bf16* Qr = (const LAS bf16*)(L + P_QR + (((U) + 1) & 1) * 9216); const LAS bf16* LFr = (const LAS bf16*)(L + P_LR + (((U) + 1) & 1) * 9216); \
                LAS bf16* QT = (LAS bf16*)(L + P_QT + (((U) + 1) & 1) * 9216); LAS bf16* KT = (LAS bf16*)(L + P_KT + (((U) + 1) & 1) * 9216); LAS bf16* KH = (LAS bf16*)(L + P_KH + (((U) + 1) & 1) * 9216); \
                LAS float* DEC = (LAS float*)(L + P_DEC + (((U) + 1) & 1) * 512); \
                _Pragma("unroll") for (int db = 0; db < 2; ++db) { const int dblk = 16 * (2 * pw + db); \
                    const bf16x8 Al = tr_frag(LFr, dblk, lane); \
                    f32x4 Gm[2]; \
                    _Pragma("unroll") for (int it = 0; it < 2; ++it) Gm[it] = __builtin_amdgcn_mfma_f32_16x16x32_bf16(Al, Tri[it], (f32x4){0.f, 0.f, 0.f, 0.f}, 0, 0, 0); \
                    f32x4 dec; \
                    _Pragma("unroll") for (int r = 0; r < 4; ++r) dec[r] = expf_(__shfl(Gm[1][r], (lane & 48) | 15)); \
                    if (fr == 0) *(LAS f32x4*)(DEC + dblk + 4 * g) = dec; \
                    _Pragma("unroll") for (int it = 0; it < 2; ++it) { const int ii = 16 * it + fr, d0 = dblk + 4 * g; \
                        const v2u q4 = *(const LAS v2u*)(Qr + ii * HS + d0), l4 = *(const LAS v2u*)(LFr + ii * HS + d0); \
                        const float qv[4] = {bflo(q4.x), bfhi(q4.x), bflo(q4.y), bfhi(q4.y)}, lv[4] = {bflo(l4.x), bfhi(l4.x), bflo(l4.y), bfhi(l4.y)}; \
                        float qt[4], kt[4], kh[4]; \
                        _Pragma("unroll") for (int r = 0; r < 4; ++r) { const float eg = expf_(Gm[it][r]), ieg = rcpf_(eg), kk = 1.0f - expf_(lv[r]); qt[r] = qv[r] * eg; kt[r] = kk * ieg; kh[r] = kk * dec[r] * ieg; } \
                        *(LAS v2u*)(QT + ii * HS + d0) = (v2u){pk2(qt[0], qt[1]), pk2(qt[2], qt[3])}; \
                        *(LAS v2u*)(KT + ii * HS + d0) = (v2u){pk2(kt[0], kt[1]), pk2(kt[2], kt[3])}; \
                        *(LAS v2u*)(KH + ii * HS + d0) = (v2u){pk2(kh[0], kh[1]), pk2(kh[2], kh[3])}; } } } \
            if (i >= 8 && i < 72) {   \
                const LAS bf16* QT = (const LAS bf16*)(L + P_QT + ((U) & 1) * 9216); const LAS bf16* KT = (const LAS bf16*)(L + P_KT + ((U) & 1) * 9216); LAS bf16* SC = (LAS bf16*)(L + P_SC + ((U) & 1) * 2560); \
                const int it = pw >> 1, jt = pw & 1; f32x4 sc = {0.f, 0.f, 0.f, 0.f}; \
                _Pragma("unroll") for (int ks = 0; ks < 4; ++ks) { const bf16x8 ak = *(const LAS bf16x8*)(KT + (16 * jt + fr) * HS + 32 * ks + 8 * g), bq = *(const LAS bf16x8*)(QT + (16 * it + fr) * HS + 32 * ks + 8 * g); \
                    sc = __builtin_amdgcn_mfma_f32_16x16x32_bf16(ak, bq, sc, 0, 0, 0); } \
                const int ii = 16 * it + fr, j0 = 16 * jt + 4 * g; \
                *(LAS v2u*)(SC + ii * SCS + j0) = (v2u){pk2(j0 <= ii ? sc[0] : 0.f, j0 + 1 <= ii ? sc[1] : 0.f), pk2(j0 + 2 <= ii ? sc[2] : 0.f, j0 + 3 <= ii ? sc[3] : 0.f)}; } \
    } while (0)
#define HG2_CORE(k, U) do { \
        const int i = (k) - 2, wch = (k), pch = (k) - 1; (void)i; (void)pch; \
            f32x4 onew[2][2]; \
            _Pragma("unroll") for (int eb = 0; eb < 2; ++eb) { onew[eb][0] = (f32x4){0.f, 0.f, 0.f, 0.f}; onew[eb][1] = (f32x4){0.f, 0.f, 0.f, 0.f}; } \
            bf16x8 Vf[2]; _Pragma("unroll") for (int eb = 0; eb < 2; ++eb) Vf[eb] = Vprev[eb]; \
            if (i >= 0 && i < 72) {   \
                const LAS bf16* QT = (const LAS bf16*)(L + P_QT + ((U) & 1) * 9216); const LAS bf16* KH = (const LAS bf16*)(L + P_KH + ((U) & 1) * 9216); \
                const LAS float* DEC = (const LAS float*)(L + P_DEC + ((U) & 1) * 512); const LAS bf16* Vr = (const LAS bf16*)(L + P_VR + (((U) + 2) & 3) * 9216); \
                if (i >= 8) {   \
                    _Pragma("unroll") for (int ks = 0; ks < 4; ++ks) { bf16x8 Bq[2]; \
                        _Pragma("unroll") for (int it = 0; it < 2; ++it) { const v2u a0 = *(const LAS v2u*)(QT + (16 * it + fr) * HS + 32 * ks + 4 * g), a1 = *(const LAS v2u*)(QT + (16 * it + fr) * HS + 32 * ks + 16 + 4 * g); \
                            v4u bv; bv.x = a0.x; bv.y = a0.y; bv.z = a1.x; bv.w = a1.y; Bq[it] = __builtin_bit_cast(bf16x8, bv); } \
                        _Pragma("unroll") for (int eb = 0; eb < 2; ++eb) { \
                            v4u sb; sb.x = pk2(S[eb][2 * ks][0], S[eb][2 * ks][1]); sb.y = pk2(S[eb][2 * ks][2], S[eb][2 * ks][3]); sb.z = pk2(S[eb][2 * ks + 1][0], S[eb][2 * ks + 1][1]); sb.w = pk2(S[eb][2 * ks + 1][2], S[eb][2 * ks + 1][3]); \
                            const bf16x8 As = __builtin_bit_cast(bf16x8, sb); \
                            _Pragma("unroll") for (int it = 0; it < 2; ++it) onew[eb][it] = __builtin_amdgcn_mfma_f32_16x16x32_bf16(As, Bq[it], onew[eb][it], 0, 0, 0); } } } \
                  \
                _Pragma("unroll") for (int eb = 0; eb < 2; ++eb) Vf[eb] = tr_frag(Vr, 16 * (2 * w + eb), lane); \
                _Pragma("unroll") for (int t = 0; t < 8; ++t) { const f32x4 dv = *(const LAS f32x4*)(DEC + 16 * t + 4 * g); const bf16x8 Kf = tr_frag(KH, 16 * t, lane); \
                    _Pragma("unroll") for (int eb = 0; eb < 2; ++eb) S[eb][t] = __builtin_amdgcn_mfma_f32_16x16x32_bf16(Kf, Vf[eb], S[eb][t] * dv, 0, 0, 0); } } \
            if (i - 1 >= 8 && i - 1 < 72) {   \
                const LAS bf16* SC = (const LAS bf16*)(L + P_SC + (((U) + 1) & 1) * 2560); \
                const int col = dir ? 63 - (i - 9) : (i - 9); \
                _Pragma("unroll") for (int it = 0; it < 2; ++it) { const bf16x8 bs = *(const LAS bf16x8*)(SC + (16 * it + fr) * SCS + 8 * g); \
                    const int ip = 16 * it + fr, ii = dir ? 31 - ip : ip; \
                    _Pragma("unroll") for (int eb = 0; eb < 2; ++eb) { const f32x4 o = __builtin_amdgcn_mfma_f32_16x16x32_bf16(Vprev[eb], bs, oprev[eb][it], 0, 0, 0); \
                        *(v2u*)(O + ((size_t)b * SEQ + ii * 64 + col) * 512 + 128 * h + 16 * (2 * w + eb) + 4 * g) = (v2u){pk2(o[0], o[1]), pk2(o[2], o[3])}; } } } \
            _Pragma("unroll") for (int eb = 0; eb < 2; ++eb) { oprev[eb][0] = onew[eb][0]; oprev[eb][1] = onew[eb][1]; Vprev[eb] = Vf[eb]; } \
    } while (0)
    if (w >= 4) {
        bf16x8 Tri[2];
#pragma unroll
        for (int it = 0; it < 2; ++it)
#pragma unroll
            for (int jj = 0; jj < 8; ++jj) Tri[it][jj] = (8 * g + jj <= 16 * it + fr) ? (short)0x3F80 : (short)0;
#pragma unroll 1
        for (int k = 0; k < 76; k += 4) {
            HG2_W(k, 0, rqA, rlA, rvA); HG2_PREP(k, 0); __syncthreads();
            HG2_W(k + 1, 1, rqB, rlB, rvB); HG2_PREP(k + 1, 1); __syncthreads();
            HG2_W(k + 2, 2, rqA, rlA, rvA); HG2_PREP(k + 2, 2); __syncthreads();
            HG2_W(k + 3, 3, rqB, rlB, rvB); HG2_PREP(k + 3, 3); __syncthreads();
        }
    } else {
        f32x4 S[2][8], oprev[2][2]; bf16x8 Vprev[2];
#pragma unroll
        for (int eb = 0; eb < 2; ++eb) {
#pragma unroll
            for (int t = 0; t < 8; ++t) S[eb][t] = (f32x4){0.f, 0.f, 0.f, 0.f};
            oprev[eb][0] = (f32x4){0.f, 0.f, 0.f, 0.f}; oprev[eb][1] = (f32x4){0.f, 0.f, 0.f, 0.f};
#pragma unroll
            for (int jj = 0; jj < 8; ++jj) Vprev[eb][jj] = 0; }
#pragma unroll 1
        for (int k = 0; k < 76; k += 4) {
            HG2_W(k, 0, rqA, rlA, rvA); HG2_CORE(k, 0); __syncthreads();
            HG2_W(k + 1, 1, rqB, rlB, rvB); HG2_CORE(k + 1, 1); __syncthreads();
            HG2_W(k + 2, 2, rqA, rlA, rvA); HG2_CORE(k + 2, 2); __syncthreads();
            HG2_W(k + 3, 3, rqB, rlB, rvB); HG2_CORE(k + 3, 3); __syncthreads();
        }
    }
#undef HG2_W
#undef HG2_PREP
#undef HG2_CORE
}
DI void phase_y2(const Frame& F) {
    const bf16* OFp = (const bf16*)(F.ws + WS_OF); const bf16* OBp = (const bf16*)(F.ws + WS_OB); const bf16* P = (const bf16*)(F.ws + WS_P); bf16* YL = (bf16*)(F.ws + WS_YL);
    const bf16* HS = (const bf16*)(F.ws + WS_LHS); const bf16* PF = (const bf16*)(F.ws + WS_LPF); const bf16* PB = (const bf16*)(F.ws + WS_LPB); const float* CIN = (const float*)(F.ws + WS_CIN);
    const int gw = F.bx * NWAVES + F.wave, NGW = F.G * NWAVES;
    const int c = 8 * F.lane;
    const f32x4 g0 = *(const f32x4*)(F.in[I_HNORM] + c), g1 = *(const f32x4*)(F.in[I_HNORM] + c + 4);
    const float gn[8] = {g0.x, g0.y, g0.z, g0.w, g1.x, g1.y, g1.z, g1.w};
    for (int m0 = gw * 16; m0 < NTOK; m0 += NGW * 16) {
        const int bb = m0 >> 11, ss = 4 + ((m0 & 2047) >> 6);
        const size_t cf = ((size_t)(0 * NB + bb) * NSEQT + ss) * 512 + c, cbk = ((size_t)(1 * NB + bb) * NSEQT + ss) * 512 + c;
        const f32x4 f0 = *(const f32x4*)(CIN + cf), f1 = *(const f32x4*)(CIN + cf + 4), b0 = *(const f32x4*)(CIN + cbk), b1 = *(const f32x4*)(CIN + cbk + 4);
        const float cfv[8] = {f0.x, f0.y, f0.z, f0.w, f1.x, f1.y, f1.z, f1.w}, cbv[8] = {b0.x, b0.y, b0.z, b0.w, b1.x, b1.y, b1.z, b1.w};
#pragma unroll 2
        for (int m = m0; m < m0 + 16; ++m) {
            const v4u hs = *(const v4u*)(HS + (size_t)m * 512 + c), pf = *(const v4u*)(PF + (size_t)m * 512 + c), pb = *(const v4u*)(PB + (size_t)m * 512 + c), rg = *(const v4u*)(P + (size_t)m * INC + 512 + c);
            const v4u a = *(const v4u*)(OFp + (size_t)m * 512 + c), bq = *(const v4u*)(OBp + (size_t)m * 512 + c), sg = *(const v4u*)(P + (size_t)m * INC + 3072 + c);
            { const unsigned hw[4] = {hs.x, hs.y, hs.z, hs.w}, fw[4] = {pf.x, pf.y, pf.z, pf.w}, bw[4] = {pb.x, pb.y, pb.z, pb.w}, rw[4] = {rg.x, rg.y, rg.z, rg.w};
                unsigned ow[4];
#pragma unroll
                for (int q = 0; q < 4; ++q) { const float lo = bflo(rw[q]) * (bflo(hw[q]) + bflo(fw[q]) * cfv[2 * q] + bflo(bw[q]) * cbv[2 * q]);
                    const float hi = bfhi(rw[q]) * (bfhi(hw[q]) + bfhi(fw[q]) * cfv[2 * q + 1] + bfhi(bw[q]) * cbv[2 * q + 1]); ow[q] = pk2(lo, hi); }
                *(v4u*)(YL + (size_t)m * D + c) = (v4u){ow[0], ow[1], ow[2], ow[3]}; }
            float o[8] = {bflo(a.x) + bflo(bq.x), bfhi(a.x) + bfhi(bq.x), bflo(a.y) + bflo(bq.y), bfhi(a.y) + bfhi(bq.y), bflo(a.z) + bflo(bq.z), bfhi(a.z) + bfhi(bq.z), bflo(a.w) + bflo(bq.w), bfhi(a.w) + bfhi(bq.w)};
            const float sgv[8] = {bflo(sg.x), bfhi(sg.x), bflo(sg.y), bfhi(sg.y), bflo(sg.z), bfhi(sg.z), bflo(sg.w), bfhi(sg.w)};
            float ssq = 0.f;
#pragma unroll
            for (int j = 0; j < 8; ++j) ssq += o[j] * o[j];
            ssq += dpp_mov_f<0xB1>(ssq); ssq += dpp_mov_f<0x4E>(ssq); ssq += dpp_mov_f<0x124>(ssq); ssq += dpp_mov_f<0x128>(ssq);
            const float rs = rsqrtf(ssq * (1.0f / 128.0f) + EPS);
#pragma unroll
            for (int j = 0; j < 8; ++j) o[j] = o[j] * rs * gn[j] * sgv[j];
            v4u wv; wv.x = pk2(o[0], o[1]); wv.y = pk2(o[2], o[3]); wv.z = pk2(o[4], o[5]); wv.w = pk2(o[6], o[7]);
            *(v4u*)(YL + (size_t)m * D + 512 + c) = wv;
        }
    }
}

DI unsigned fkey(float f) { const unsigned u = __float_as_uint(f); return u ^ ((u >> 31) ? 0xFFFFFFFFu : 0x80000000u); }
template <int CTRL> DI unsigned dpp_u(unsigned v) { return (unsigned)__builtin_amdgcn_update_dpp(0, (int)v, CTRL, 0xf, 0xf, true); }
template <int CTRL> DI float dpp_f(float v) { return __uint_as_float(dpp_u<CTRL>(__float_as_uint(v))); }
DI unsigned umax_(unsigned a, unsigned b) { return a > b ? a : b; }
DI float readlane_f(float v, int lane) { return __uint_as_float((unsigned)__builtin_amdgcn_readlane((int)__float_as_uint(v), lane)); }
DI void route_token(const f32x4 lg, const f32x4 rbv, const int l, int& myexp, float& gate) {
    const float NEG = -__builtin_inff();
    float sc[4], bs[4];
#pragma unroll
    for (int k = 0; k < 4; ++k) { sc[k] = rcpf_(1.0f + expf_(-lg[k])); bs[k] = sc[k] + rbv[k]; }
    float m1 = NEG, m2 = NEG;
#pragma unroll
    for (int k = 0; k < 4; ++k) { const float v = bs[k]; if (v > m1) { m2 = m1; m1 = v; } else if (v > m2) m2 = v; }
    { float o1 = dpp_f<0xB1>(m1), o2 = dpp_f<0xB1>(m2); float n1 = fmaxf(m1, o1), n2 = fmaxf(fminf(m1, o1), fmaxf(m2, o2)); m1 = n1; m2 = n2;
      o1 = dpp_f<0x4E>(m1); o2 = dpp_f<0x4E>(m2); n1 = fmaxf(m1, o1); n2 = fmaxf(fminf(m1, o1), fmaxf(m2, o2)); m1 = n1; m2 = n2;
      const float a1 = dpp_f<0x104>(m1), a2 = dpp_f<0x104>(m2), c1 = dpp_f<0x114>(m1), c2 = dpp_f<0x114>(m2);
      o1 = (l & 4) ? c1 : a1; o2 = (l & 4) ? c2 : a2; n1 = fmaxf(m1, o1); n2 = fmaxf(fminf(m1, o1), fmaxf(m2, o2)); m1 = n1; m2 = n2; }
    const float gs = m1 + m2; const int g = l >> 3; int rank = 0;
#pragma unroll
    for (int gg = 0; gg < 8; ++gg) { const float og = readlane_f(gs, gg * 8); rank += (og > gs || (og == gs && gg < g)) ? 1 : 0; }
    const bool sel = rank < 4;
    unsigned cv[4];
#pragma unroll
    for (int k = 0; k < 4; ++k) cv[k] = sel ? fkey(bs[k]) : 0u;
    float sum = 0.f, mysc = 0.f; myexp = 0;
#pragma unroll
    for (int r = 0; r < TOPK; ++r) {
        unsigned bvk = cv[0]; int bk = 0;
#pragma unroll
        for (int k = 1; k < 4; ++k) if (cv[k] > bvk) { bvk = cv[k]; bk = k; }
        const float bsc = bk == 0 ? sc[0] : bk == 1 ? sc[1] : bk == 2 ? sc[2] : sc[3];
        unsigned m = bvk;
        m = umax_(m, dpp_u<0xB1>(m)); m = umax_(m, dpp_u<0x4E>(m)); m = umax_(m, dpp_u<0x124>(m)); m = umax_(m, dpp_u<0x128>(m));
        const unsigned M = umax_(umax_((unsigned)__builtin_amdgcn_readlane((int)m, 0), (unsigned)__builtin_amdgcn_readlane((int)m, 16)),
                                 umax_((unsigned)__builtin_amdgcn_readlane((int)m, 32), (unsigned)__builtin_amdgcn_readlane((int)m, 48)));
        const unsigned long long bal = __ballot(bvk == M);
        const int L = __builtin_ctzll(bal);
        const int kL = __builtin_amdgcn_readlane(bk, L);
        const float se = readlane_f(bsc, L);
        const int e = 4 * L + kL;
        if (l == L) {
#pragma unroll
            for (int k = 0; k < 4; ++k) if (k == bk) cv[k] = 0u; }
        sum += se; if (l == r) { myexp = e; mysc = se; }
    }
    gate = mysc * rcpf_(sum) * 2.5f;
}
constexpr int NR_XS = 1032, NR_LS = 260, NR_HIST = 133120;
static_assert(64 * NR_XS * 2 <= NR_HIST && 64 * NR_LS * 4 <= NR_HIST && NR_HIST + 1024 <= LDS_MISC, "norm/route lds");
DI void phase_norm_route(const Frame& F) {
    const float* MOD = (const float*)(F.ws + WS_MOD); const float* gain = F.in[I_NFFN];
    const bf16* X1b = (const bf16*)(F.ws + WS_X1); const bf16* WR = (const bf16*)(F.ws + WS_WR);
    v2u* ROUTE = (v2u*)(F.ws + WS_ROUTE); int* HIST = (int*)(F.ws + WS_HIST);
    LAS bf16* XT = (LAS bf16*)F.lds; LAS float* LG = (LAS float*)F.lds; LAS unsigned* hist = (LAS unsigned*)(F.lds + NR_HIST);
    const int l = F.lane, w = F.wave, fr = l & 15, g = l >> 4;
    const f32x4 rbv = *(const f32x4*)(F.in[I_RB] + 4 * l);
    for (int blk = F.bx; blk < NTOK / 128; blk += F.G) {
        if (F.tid < 256) hist[F.tid] = 0u;
        const int b = (blk * 128) >> 11;
        f32x4 ga[4], sb4[4];
#pragma unroll
        for (int j = 0; j < 4; ++j) { const int c = 4 * l + 256 * j; ga[j] = *(const f32x4*)(gain + c) * (*(const f32x4*)(MOD + b * 6144 + 4096 + c) + 1.0f); sb4[j] = *(const f32x4*)(MOD + b * 6144 + 3072 + c); }
#pragma unroll 1
        for (int half = 0; half < 2; ++half) {
            const int tok0 = blk * 128 + half * 64;
            v2u xr[4];
#pragma unroll
            for (int j = 0; j < 4; ++j) xr[j] = *(const v2u*)(X1b + (size_t)(tok0 + 8 * w) * D + 4 * l + 256 * j);
#pragma unroll 1
            for (int rr = 0; rr < 8; ++rr) { const int row = 8 * w + rr; const size_t m = (size_t)(tok0 + row);
                f32x4 v[4]; float ss = 0.f;
#pragma unroll
                for (int j = 0; j < 4; ++j) { v[j] = (f32x4){bflo(xr[j].x), bfhi(xr[j].x), bflo(xr[j].y), bfhi(xr[j].y)}; ss += (v[j].x * v[j].x + v[j].y * v[j].y) + (v[j].z * v[j].z + v[j].w * v[j].w); }
                if (rr + 1 < 8) {
#pragma unroll
                    for (int j = 0; j < 4; ++j) xr[j] = *(const v2u*)(X1b + (m + 1) * D + 4 * l + 256 * j); }
                const float rs = rsqrtf(wave_sum_fast(ss) * (1.0f / D) + EPS);
#pragma unroll
                for (int j = 0; j < 4; ++j) { const int c = 4 * l + 256 * j; const f32x4 y = (v[j] * rs) * ga[j] + sb4[j];
                    *(LAS v2u*)(XT + row * NR_XS + c) = (v2u){pk2(y.x, y.y), pk2(y.z, y.w)};
                    *(unsigned*)(F.ws + WS_HX2F + m * D + c) = pk4_f8(y.x, y.y, y.z, y.w); } }
            __syncthreads();
            f32x4 acc[4][2];
#pragma unroll
            for (int tt = 0; tt < 4; ++tt) { acc[tt][0] = (f32x4){0.f, 0.f, 0.f, 0.f}; acc[tt][1] = (f32x4){0.f, 0.f, 0.f, 0.f}; }
            const bf16* wb0 = WR + (size_t)(32 * w + fr) * D + 8 * g; const bf16* wb1 = wb0 + (size_t)16 * D;
            bf16x8 Bq[4][4][2];
#define NR_LOAD(SET, CH) do { _Pragma("unroll") for (int q = 0; q < 4; ++q) { Bq[SET][q][0] = *(const bf16x8*)(wb0 + 32 * (4 * (CH) + q)); Bq[SET][q][1] = *(const bf16x8*)(wb1 + 32 * (4 * (CH) + q)); } } while (0)
#define NR_COMP(SET, CH) do { _Pragma("unroll") for (int q = 0; q < 4; ++q) _Pragma("unroll") for (int tt = 0; tt < 4; ++tt) { \
                const bf16x8 A = *(const LAS bf16x8*)(XT + (16 * tt + fr) * NR_XS + 32 * (4 * (CH) + q) + 8 * g); \
                acc[tt][0] = __builtin_amdgcn_mfma_f32_16x16x32_bf16(A, Bq[SET][q][0], acc[tt][0], 0, 0, 0); acc[tt][1] = __builtin_amdgcn_mfma_f32_16x16x32_bf16(A, Bq[SET][q][1], acc[tt][1], 0, 0, 0); } } while (0)
            NR_LOAD(0, 0); NR_LOAD(1, 1); NR_LOAD(2, 2);
            NR_LOAD(3, 3); NR_COMP(0, 0);
            NR_LOAD(0, 4); NR_COMP(1, 1);
            NR_LOAD(1, 5); NR_COMP(2, 2);
            NR_LOAD(2, 6); NR_COMP(3, 3);
            NR_LOAD(3, 7); NR_COMP(0, 4);
            NR_COMP(1, 5); NR_COMP(2, 6); NR_COMP(3, 7);
#undef NR_LOAD
#undef NR_COMP
            __syncthreads();
#pragma unroll
            for (int tt = 0; tt < 4; ++tt)
#pragma unroll
                for (int eb = 0; eb < 2; ++eb)
#pragma unroll
                    for (int r = 0; r < 4; ++r) LG[(16 * tt + 4 * g + r) * NR_LS + 32 * w + 16 * eb + fr] = acc[tt][eb][r];
            __syncthreads();
#pragma unroll 1
            for (int ti = 0; ti < 8; ti += 2) { const int row = 8 * w + ti, tok = tok0 + row;
                const f32x4 lgA = *(const LAS f32x4*)(LG + row * NR_LS + 4 * l), lgB = *(const LAS f32x4*)(LG + (row + 1) * NR_LS + 4 * l);
                int eA, eB; float gA, gB; route_token(lgA, rbv, l, eA, gA); route_token(lgB, rbv, l, eB, gB);
                if (l < TOPK) { ROUTE[(size_t)tok * TOPK + l] = (v2u){(unsigned)eA, __float_as_uint(gA)}; ROUTE[(size_t)(tok + 1) * TOPK + l] = (v2u){(unsigned)eB, __float_as_uint(gB)};
                    (void)__hip_atomic_fetch_add(hist + eA, 1u, __ATOMIC_RELAXED, __HIP_MEMORY_SCOPE_WORKGROUP); (void)__hip_atomic_fetch_add(hist + eB, 1u, __ATOMIC_RELAXED, __HIP_MEMORY_SCOPE_WORKGROUP); } }
            __syncthreads();
        }
        if (F.tid < 256) HIST[blk * 256 + F.tid] = (int)hist[F.tid];
        __syncthreads();
    }
}
DI void tile_starts(const Frame& F, int c, LAS int* ts) {
    const int own = (c + 255) >> 8; int incl = own;
    if (F.tid < 256) {
#pragma unroll
        for (int o = 1; o < 64; o <<= 1) { const int v = __shfl_up(incl, o); if (F.lane >= o) incl += v; }
        if (F.lane == 63) ts[257 + F.wave] = incl;
    }
    __syncthreads();
    if (F.tid < 256) { int off = 0;
#pragma unroll
        for (int w = 0; w < 3; ++w) off += (w < F.wave) ? ts[257 + w] : 0;
        ts[F.tid] = off + incl - own;
        if (F.tid == 255) ts[256] = off + incl; }
    __syncthreads();
}
DI void phase_lists(const Frame& F0) {
    Frame F = F0; asm volatile("" : "+v"(F.tid)); F.lane = F.tid & 63;
    const v2u* ROUTE = (const v2u*)(F.ws + WS_ROUTE); const int* HIST = (const int*)(F.ws + WS_HIST);
    unsigned* cnt = (unsigned*)(F.ws + WS_CTL) + CW_CNT; v2u* LIST = (v2u*)(F.ws + WS_LIST);
    LAS int* part = (LAS int*)F.lds;
    LAS int* lbase = part + 4096; LAS unsigned* lcnt = (LAS unsigned*)(lbase + 256); LAS int* lts = lbase + 768;
    int* INV = (int*)(F.ws + WS_INV);
    typedef int v4i_ __attribute__((ext_vector_type(4)));
    for (int blk = F.bx; blk < NTOK / 128; blk += F.G) {
        const int e = F.tid & 255, e4 = (F.tid & 63) * 4, g = F.tid >> 6;
        v4i_ below = (v4i_){0, 0, 0, 0}, all = (v4i_){0, 0, 0, 0};
#pragma unroll 8
        for (int q = 0; q < 32; ++q) { const int row = g * 32 + q; const v4i_ v = *(const v4i_*)(HIST + row * 256 + e4); all += v; if (row < blk) below += v; }
        *(LAS v4i_*)(part + g * 512 + e4) = below; *(LAS v4i_*)(part + g * 512 + 256 + e4) = all;
        __syncthreads();
        int tot = 0;
        if (F.tid < 256) { int b = 0;
#pragma unroll
            for (int q = 0; q < 8; ++q) { b += part[q * 512 + e]; tot += part[q * 512 + 256 + e]; }
            lbase[e] = b; lcnt[e] = 0u; if (blk == 0) cnt[e] = (unsigned)tot; }
        tile_starts(F, tot, lts);
#pragma unroll
        for (int q = 0; q < 2; ++q) { const int a = F.tid + q * NTHR; const unsigned tk = (unsigned)(blk * 128 * TOPK + a);
            const v2u rt = ROUTE[tk]; const unsigned pos = (unsigned)lbase[rt.x] + __hip_atomic_fetch_add(lcnt + rt.x, 1u, __ATOMIC_RELAXED, __HIP_MEMORY_SCOPE_WORKGROUP);
            LIST[(size_t)rt.x * LISTCAP + pos] = (v2u){tk, rt.y}; INV[tk] = lts[rt.x] * 256 + (int)pos; }
        __syncthreads();
    }
}

template <bool GATHER> DI void moe_setup(const Frame& F0, int ncol, int& nunits, int& nfull) {
    Frame F = F0; asm volatile("" : "+v"(F.tid)); F.lane = F.tid & 63;
    LAS int* ts = (LAS int*)(F.lds + LDS_TS); LAS int* cl = (LAS int*)(F.lds + LDS_CNT); LAS int* ut = (LAS int*)(F.lds + LDS_UT); LAS int* idx = (LAS int*)(F.lds + LDS_IDX);
    const unsigned* cnt = (const unsigned*)(F.ws + WS_CTL) + CW_CNT;
    int c = 0; if (F.tid < 256) { c = (int)__hip_atomic_load(cnt + F.tid, __ATOMIC_RELAXED, __HIP_MEMORY_SCOPE_AGENT); cl[F.tid] = c; }
    tile_starts(F, c, ts);
    const int Te = ts[256], T = Te + NTOK / 256;
    const int Fr = T / F.G, R = T - Fr * F.G, LU = R * ncol;
    const int nleft = (LU > F.vcu) ? (LU - F.vcu + F.G - 1) / F.G : 0;
    nfull = Fr * ncol; nunits = nfull + nleft;
    const int nj = (Fr + nleft) < 10 ? (Fr + nleft) : 10;
    if (F.tid < nj) { const int j = F.tid;
        int rt, pnl = 0;
        if (j < Fr) rt = j * F.G + F.vcu; else { const int lu = (j - Fr) * F.G + F.vcu; rt = Fr * F.G + lu / ncol; pnl = lu % ncol; }
        int e, pm, nrows;
        if (rt >= Te) { e = 256; pm = rt - Te; nrows = 256; }
        else { int lo = 0, hi = 256; while (hi - lo > 1) { const int mid = (lo + hi) >> 1; if (ts[mid] <= rt) lo = mid; else hi = mid; }
            e = lo; pm = rt - ts[lo]; const int rem = cl[lo] - pm * 256; nrows = rem < 256 ? rem : 256; }
        *(LAS v4u*)(ut + 4 * j) = (v4u){(unsigned)e, (unsigned)pm, (unsigned)rt, (unsigned)nrows | ((unsigned)pnl << 16)}; }
    __syncthreads();
    const v2u* LIST = (const v2u*)(F.ws + WS_LIST);
    v2u lv[5];
#pragma unroll
    for (int q = 0; q < 5; ++q) { const int j = 2 * q + (F.tid >> 8), r = F.tid & 255; const int jc = j < nj ? j : 0;
        const v4u t = *(const LAS v4u*)(ut + 4 * jc); const int e = (int)t.x, pm = (int)t.y, nrows = (int)(t.w & 0xffffu);
        lv[q] = LIST[(size_t)(e & 255) * LISTCAP + pm * 256 + (r < nrows ? r : 0)]; }
#pragma unroll
    for (int q = 0; q < 5; ++q) { const int j = 2 * q + (F.tid >> 8), r = F.tid & 255;
        if (j < nj) { const v4u t = *(const LAS v4u*)(ut + 4 * j); const int e = (int)t.x, pm = (int)t.y, nrows = (int)(t.w & 0xffffu);
            if (GATHER) idx[j * 256 + r] = (e == 256) ? pm * 256 + r : (r < nrows ? (int)(lv[q].x >> 3) : 0);
            else ((LAS float*)idx)[j * 256 + r] = (e == 256) ? 1.0f : (r < nrows ? __uint_as_float(lv[q].y) : 0.0f); } }
    __syncthreads();
}

DI void phase_combine(const Frame& F0, int mode) {
    Frame F = F0; F.lane = (int)__builtin_amdgcn_mbcnt_hi(~0u, __builtin_amdgcn_mbcnt_lo(~0u, 0u)); asm volatile("" : "+v"(F.lane));
    const float* MOD = (const float*)(F.ws + WS_MOD);
    const unsigned char* YE = F.ws + WS_YE; const int* INV = (const int*)(F.ws + WS_INV);
    int Te = 0; if (mode == 0) { const unsigned* cnt = (const unsigned*)(F.ws + WS_CTL) + CW_CNT; int t4 = 0;
#pragma unroll
        for (int q = 0; q < 4; ++q) t4 += (int)((cnt[F.lane + 64 * q] + 255u) >> 8);
#pragma unroll
        for (int o = 1; o < 64; o <<= 1) t4 += __shfl_xor(t4, o);
        Te = __builtin_amdgcn_readfirstlane(t4); }
    const int gw = F.bx * NWAVES + F.wave, NGW = F.G * NWAVES;
    const float* nf = F.in[I_NFIN];
    const int c = 16 * F.lane;
    int inv = (mode == 0 && gw < NTOK) ? INV[gw * TOPK + (F.lane & 7)] : 0;
    for (int m = gw; m < NTOK; m += NGW) {
        const int b = m >> 11;
        float s[16];
#pragma unroll
        for (int q = 0; q < 16; ++q) s[q] = 0.f;
        const bf16* xsrc = (const bf16*)(F.ws + WS_X1);
        if (mode == 0) {
            const int invc = inv; { const int mn = (m + NGW < NTOK) ? m + NGW : m; inv = INV[mn * TOPK + (F.lane & 7)]; }
#pragma unroll
            for (int k = 0; k < 9; ++k) { const int row = (k < 8) ? __builtin_amdgcn_readlane(invc, k) : Te * 256 + m; const v4u w = *(const v4u*)(YE + (size_t)row * D + c);
                const unsigned ww[4] = {w.x, w.y, w.z, w.w};
#pragma unroll
                for (int q = 0; q < 4; ++q) { const f32x2 lo = __builtin_amdgcn_cvt_pk_f32_fp8((int)ww[q], false), hi = __builtin_amdgcn_cvt_pk_f32_fp8((int)ww[q], true);
                    s[4 * q] += lo.x; s[4 * q + 1] += lo.y; s[4 * q + 2] += hi.x; s[4 * q + 3] += hi.y; } } }
        float x2[16]; float ss = 0.f;
#pragma unroll
        for (int q = 0; q < 4; ++q) { const v2u xt = *(const v2u*)(xsrc + (size_t)m * D + c + 4 * q); const f32x4 xa = {bflo(xt.x), bfhi(xt.x), bflo(xt.y), bfhi(xt.y)}, ga = *(const f32x4*)(MOD + b * 6144 + 5120 + c + 4 * q);
#pragma unroll
            for (int j = 0; j < 4; ++j) { const float v = xa[j] + ga[j] * (s[4 * q + j] * 0.015625f); x2[4 * q + j] = v; ss += v * v; } }
        const float rs = rsqrtf(wave_sum(ss) * (1.0f / D) + EPS);
#pragma unroll
        for (int q = 0; q < 4; ++q) { const f32x4 na = *(const f32x4*)(nf + c + 4 * q);
            f32x4 oa = {x2[4 * q] * rs * na.x, x2[4 * q + 1] * rs * na.y, x2[4 * q + 2] * rs * na.z, x2[4 * q + 3] * rs * na.w};
            *(f32x4*)(F.out + (size_t)m * D + c + 4 * q) = oa; }
    }
}

constexpr int NPHASE = 12;
__global__ void __launch_bounds__(NTHR, 2) fwd_kernel(Args args) {
    extern __shared__ __attribute__((aligned(16))) unsigned char lds_raw[];
    Frame F;
    F.lds = (LAS unsigned char*)lds_raw;
    F.tid = threadIdx.x; F.lane = F.tid & 63; F.wave = __builtin_amdgcn_readfirstlane(F.tid >> 6);
    F.G = gridDim.x; F.bx = blockIdx.x; F.vcu = (F.G % 8 == 0) ? (F.bx % 8) * (F.G / 8) + F.bx / 8 : F.bx;
    F.in = args.in; F.out = args.out; F.ws = args.ws;
    volatile LAS unsigned* MISC = (volatile LAS unsigned*)(F.lds + LDS_MISC);
    if (F.tid < 16) MISC[F.tid] = 0u;
    __syncthreads();
    XcdBarrier bar; bar.bar = (unsigned*)(F.ws + WS_CTL) + CW_BAR; bar.x = 0; bar.st = nullptr;
#if !PER_PHASE_LAUNCH
    bar = xcd_barrier_post((unsigned*)(F.ws + WS_CTL) + CW_BAR, MISC + 8);
#define GRID_BAR() xcd_barrier(bar)
#else
#define GRID_BAR() do {} while (0)
#endif
    const int lo = args.ph_lo, hi = args.ph_hi;
#ifndef PH_MASK
#define PH_MASK 0xFFFF
#endif
#define IN(k) (((PH_MASK >> (k)) & 1) && lo <= (k) && (k) < hi)
#ifndef PROBE_PH
#define PROBE_PH -1
#endif
#ifndef PROBE_MULT
#define PROBE_MULT 4
#endif
    volatile LAS unsigned long long* PRT = (volatile LAS unsigned long long*)(F.lds + LDS_MISC);
    if (PROBE_PH == 0 && F.wave == 0) PRT[0] = __builtin_amdgcn_s_memrealtime();
#define SEAM(k) do { if (IN(k) && IN((k) + 1)) GRID_BAR(); \
        if (PROBE_PH >= 0 && F.wave == 0) { if ((k) == PROBE_PH - 1) PRT[0] = __builtin_amdgcn_s_memrealtime(); if ((k) == PROBE_PH) PRT[1] = __builtin_amdgcn_s_memrealtime(); } } while (0)
#ifndef REPEAT_MASK
#define REPEAT_MASK 0
#endif
#define REPS(k) (1 + ((REPEAT_MASK >> (k)) & 1))
    unsigned char* ws = F.ws;

    if (IN(0)) _Pragma("unroll 1") for (int rep = 0; rep < REPS(0); ++rep) { if (rep) GRID_BAR(); phase_prologue(F); } SEAM(0);
    if (IN(1)) _Pragma("unroll 1") for (int rep = 0; rep < REPS(1); ++rep) { if (rep) GRID_BAR(); phase_norm_rows(F, 0); } SEAM(1);
    if (IN(2)) _Pragma("unroll 1") for (int rep = 0; rep < REPS(2); ++rep) { if (rep) GRID_BAR();
        unsigned* done2 = (unsigned*)(ws + WS_CTL) + CW_P2DONE;
        const int G2 = (F.G >= 256) ? 224 : F.G;
        if (F.bx < G2) {
            pg8::DenseOrder S; S.init(ws + WS_HX, ws + WS_WIN, MTOT, INC, D, G2, F.bx);
            pg8::EpiInProj E{(bf16*)(ws + WS_P), (const float*)(ws + WS_TAB)};
            pg8::gemm_phase(F.lds, D, S, E, F.wave);
            if (F.tid == 0) __hip_atomic_fetch_add(done2, 1u, __ATOMIC_RELAXED, __HIP_MEMORY_SCOPE_AGENT);
        } else convert_experts(F, done2, 1u);
    } SEAM(2);
    if (IN(3)) _Pragma("unroll 1") for (int rep = 0; rep < REPS(3); ++rep) { if (rep) GRID_BAR(); phase_lru_pass1(F); } SEAM(3);
    if (IN(4)) _Pragma("unroll 1") for (int rep = 0; rep < REPS(4); ++rep) { if (rep) GRID_BAR(); phase_lru_carry(F);
#if defined(PROBE_SUB)
        if (F.wave == 0 && PROBE_SUB == 0) PRT[0] = __builtin_amdgcn_s_memrealtime();
#endif
        if (F.bx < NB * 4 * 2) hgrn_chain2(F, F.bx);
#if defined(PROBE_SUB)
        if (F.wave == 0) { if (PROBE_SUB == 0) PRT[1] = __builtin_amdgcn_s_memrealtime(); else if (PROBE_SUB == 1) PRT[0] = __builtin_amdgcn_s_memrealtime(); }
#endif
        convert_experts(F, nullptr, 0u);
#if defined(PROBE_SUB)
        if (F.wave == 0 && PROBE_SUB == 1) PRT[1] = __builtin_amdgcn_s_memrealtime();
#endif
        } SEAM(4);
    if (IN(5)) _Pragma("unroll 1") for (int rep = 0; rep < REPS(5); ++rep) { if (rep) GRID_BAR(); phase_y2(F); } SEAM(5);
    if (IN(6)) _Pragma("unroll 1") for (int rep = 0; rep < REPS(6); ++rep) { if (rep) GRID_BAR();
        pg8::DenseOrder S; S.init(ws + WS_YL, ws + WS_WOUT, NTOK, D, D, F.G, F.bx);
        pg8::EpiResid E{F.in[I_X], (const float*)(ws + WS_MOD), (bf16*)(ws + WS_X1)};
        pg8::gemm_phase(F.lds, D, S, E, F.wave);
    } SEAM(6);
    if (IN(7)) _Pragma("unroll 1") for (int rep = 0; rep < REPS(7); ++rep) { if (rep) GRID_BAR(); phase_norm_route(F); } SEAM(7);
    if (IN(8)) _Pragma("unroll 1") for (int rep = 0; rep < REPS(8); ++rep) { if (rep) GRID_BAR(); phase_lists(F); } SEAM(8);
    if (IN(9)) _Pragma("unroll 1") for (int rep = 0; rep < REPS(9); ++rep) { if (rep) GRID_BAR();
        int total, nfull; moe_setup<true>(F, 2, total, nfull);
        pg8::MoeOrder<true> S; S.A = (const char*)(ws + WS_HX2F); S.Bt = (const char*)(ws + WS_EW13); S.BtS = (const char*)(ws + WS_SW13); S.K = D / 2; S.ncol = 2; S.estride = (size_t)512 * 1024; S.dump = nullptr;
        S.ut = (const LAS int*)(F.lds + LDS_UT); S.idx = (const LAS int*)(F.lds + LDS_IDX); S.nunits = total; S.nfull = nfull;
        pg8::EpiSwiGLU8 E{ws + WS_ACT};
        pg8::gemm_phase<pg8::EpiSwiGLU8, pg8::MoeOrder<true>, false, true>(F.lds, D / 2, S, E, F.wave);
    } SEAM(9);
    if (IN(10)) _Pragma("unroll 1") for (int rep = 0; rep < REPS(10); ++rep) { if (rep) GRID_BAR();
        int total, nfull; moe_setup<false>(F, 4, total, nfull);
        pg8::MoeOrder<false> S; S.A = (const char*)(ws + WS_ACT); S.Bt = (const char*)(ws + WS_EW2); S.BtS = (const char*)(ws + WS_SW2); S.K = DE / 2; S.ncol = 4; S.estride = (size_t)1024 * 256; S.dump = (const char*)(ws + WS_CTL + 0x80000 + F.bx * 256);
        S.ut = (const LAS int*)(F.lds + LDS_UT); S.idx = (const LAS int*)(F.lds + LDS_IDX); S.nunits = total; S.nfull = nfull;
        pg8::EpiScatter E{ws + WS_YE, (const LAS float*)(F.lds + LDS_IDX), 0.5f};
#if defined(PROBE_GEMM)
        pg8::GProf gp{0ull, 0ull, 0ull};
        pg8::gemm_phase<pg8::EpiScatter, pg8::MoeOrder<false>, true, true, true>(F.lds, DE / 2, S, E, F.wave, &gp);
        if (F.wave == 0) { PRT[0] = 0ull; PRT[1] = (PROBE_GEMM == 0) ? gp.t_loop : (PROBE_GEMM == 1) ? gp.t_epi : gp.t_next; }
#else
        pg8::gemm_phase<pg8::EpiScatter, pg8::MoeOrder<false>, false, true, true>(F.lds, DE / 2, S, E, F.wave);
#endif
    } SEAM(10);
    if (IN(11)) _Pragma("unroll 1") for (int rep = 0; rep < REPS(11); ++rep) { if (rep) GRID_BAR(); phase_combine(F, 0); }
#if defined(PROBE_GEMM) || defined(PROBE_SUB)
    if (F.bx == 0 && F.wave == 0) {
#else
    if (PROBE_PH >= 0 && F.bx == 0 && F.wave == 0) {
#endif
        const unsigned long long te = __builtin_amdgcn_s_memrealtime(); if (PROBE_PH == NPHASE - 1) PRT[1] = te;
        const unsigned long long target = (unsigned long long)PROBE_MULT * (PRT[1] - PRT[0]);
        while (__builtin_amdgcn_s_memrealtime() - te < target) __builtin_amdgcn_s_sleep(20);
    }
}

extern "C" void kernel_launch(void* const* d_in, const int* in_sizes, int n_in, void* d_out, int out_size, void* d_ws, size_t ws_size, hipStream_t stream) {
    static int grid = 0;
    if (grid == 0) {
        if (n_in != 26 || in_sizes[0] != NTOK * D || out_size != NTOK * D || ws_size < WS_END) { fprintf(stderr, "kernel_launch: unexpected shapes (n_in %d, ws %zu)\n", n_in, ws_size); grid = -1; return; }
        int dev = 0, cus = 0, per_cu = 0;
        if (hipGetDevice(&dev) != hipSuccess || hipDeviceGetAttribute(&cus, hipDeviceAttributeMultiprocessorCount, dev) != hipSuccess) { grid = -1; return; }
        if (hipFuncSetAttribute((const void*)fwd_kernel, hipFuncAttributeMaxDynamicSharedMemorySize, LDS_BYTES) != hipSuccess) { fprintf(stderr, "kernel_launch: hipFuncSetAttribute failed\n"); grid = -1; return; }
        if (hipOccupancyMaxActiveBlocksPerMultiprocessor(&per_cu, (const void*)fwd_kernel, NTHR, LDS_BYTES) != hipSuccess || per_cu < 1) { fprintf(stderr, "kernel_launch: occupancy query says %d\n", per_cu); }
        (void)hipGetLastError();
        grid = cus;
        if (grid < 128) { fprintf(stderr, "kernel_launch: needs >= 128 CUs (HGRN2 chains run one per workgroup)\n"); grid = -1; return; }
    }
    if (grid < 0) return;
    hipMemsetAsync((char*)d_ws + WS_CTL, 0, CTL_ZERO_BYTES, stream);
    Args a{};
    for (int i = 0; i < 26; ++i) a.in[i] = (const float*)d_in[i];
    a.out = (float*)d_out; a.ws = (unsigned char*)d_ws;
#if PER_PHASE_LAUNCH
    for (int p = 0; p < NPHASE; ++p) { a.ph_lo = p; a.ph_hi = p + 1; hipLaunchKernelGGL(fwd_kernel, dim3(grid), dim3(NTHR), LDS_BYTES, stream, a); }
#else
    a.ph_lo = 0; a.ph_hi = NPHASE;
    hipLaunchKernelGGL(fwd_kernel, dim3(grid), dim3(NTHR), LDS_BYTES, stream, a);
#endif
}
```

```cpp
#include <hip/hip_runtime.h>
#include <cstdio>
#include <cstdint>

#ifndef PER_PHASE_LAUNCH
#define PER_PHASE_LAUNCH 0
#endif
#ifndef DBG_STOP
#define DBG_STOP 0
#endif

#define GAS __attribute__((address_space(1)))
#define LAS __attribute__((address_space(3)))
#define DI __device__ __forceinline__
typedef unsigned short bf16;
typedef unsigned v4u __attribute__((ext_vector_type(4)));
typedef unsigned v2u __attribute__((ext_vector_type(2)));
typedef float f32x4 __attribute__((ext_vector_type(4)));
typedef float f32x2 __attribute__((ext_vector_type(2)));
typedef short bf16x8 __attribute__((ext_vector_type(8)));
typedef __bf16 bfv2 __attribute__((ext_vector_type(2)));

constexpr int D = 1024, NB = 16, SEQ = 2048, CTXL = 256;
constexpr int NTOK = NB * SEQ;
constexpr int NCTX = NB * CTXL;
constexpr int MTOT = NTOK + NCTX;
constexpr int INC = 3584;
constexpr int NE = 256, TOPK = 8, DE = 256;
constexpr int LISTCAP = 32768;
constexpr float EPS = 1e-6f;
constexpr int NWAVES = 8, NTHR = 512;
constexpr int NSEQT = 36;

constexpr size_t MiB = 1u << 20;
constexpr size_t WS_CTL = 0, CTL_ZERO_BYTES = 1 * MiB;
constexpr size_t WS_MOD = 1 * MiB;
constexpr size_t WS_TAB = 2 * MiB;
constexpr size_t WS_WGT = 2 * MiB + 65536;
constexpr size_t WS_WIN = 3 * MiB;
constexpr size_t WS_WOUT = 10 * MiB;
constexpr size_t WS_WR = 12 * MiB;
constexpr size_t WS_SW13 = 12 * MiB + 512 * 1024;
constexpr size_t WS_SW2 = 13 * MiB + 512 * 1024;
constexpr size_t WS_DUMP = 2 * MiB + 16384;
constexpr size_t WS_SUMA = 14 * MiB;
constexpr size_t WS_SUMH = WS_SUMA + 2359296;
constexpr size_t WS_CIN = WS_SUMH + 2359296;
constexpr size_t WS_ROUTE = 21 * MiB;
constexpr size_t WS_HIST = 23 * MiB;
constexpr size_t WS_EW13 = 32 * MiB;
constexpr size_t WS_EW2 = 288 * MiB;
constexpr size_t WS_X1 = 416 * MiB;
constexpr size_t WS_HX2 = 544 * MiB;
constexpr size_t WS_LOGIT = 608 * MiB;
constexpr size_t WS_LIST = 1620 * MiB;
constexpr size_t WS_LHS = 674 * MiB, WS_LPF = 706 * MiB, WS_LPB = 738 * MiB;
constexpr size_t WS_ACT = 674 * MiB;
constexpr size_t WS_YS = 850 * MiB;
constexpr size_t WS_P = 914 * MiB;
constexpr size_t WS_HX = 1166 * MiB;
constexpr size_t WS_OF = 1238 * MiB;
constexpr size_t WS_OB = 1270 * MiB;
constexpr size_t WS_YL = 1302 * MiB;
constexpr size_t WS_YE = 914 * MiB;
constexpr size_t WS_INV = 24 * MiB;
constexpr size_t WS_HX2F = 1684 * MiB;
constexpr size_t WS_END = 1716 * MiB;
constexpr int CW_BAR = 4096;
constexpr int CW_CNT = 16384;
constexpr int CW_CONVQ = 20480;
constexpr int CW_P2DONE = 20608;
constexpr int CW_LRUDONE = 20544;

constexpr int RING_BYTES = 131072;
constexpr int LDS_TS = RING_BYTES;
constexpr int LDS_CNT = LDS_TS + 1088;
constexpr int LDS_UT = LDS_CNT + 1024;
constexpr int LDS_IDX = LDS_UT + 192;
constexpr int LDS_MISC = LDS_IDX + 10 * 1024;
constexpr int LDS_BYTES = 155648;
static_assert(LDS_MISC + 64 <= LDS_BYTES, "lds map");

DI unsigned pk2(float lo, float hi) { f32x2 v = {lo, hi}; bfv2 b = __builtin_convertvector(v, bfv2); return __builtin_bit_cast(unsigned, b); }
DI float clamp448(float x) { return __builtin_amdgcn_fmed3f(x, -448.0f, 448.0f); }
DI unsigned pk4_f8(float a, float b, float c, float d) {
    int w = __builtin_amdgcn_cvt_pk_fp8_f32(clamp448(a), clamp448(b), 0, false); w = __builtin_amdgcn_cvt_pk_fp8_f32(clamp448(c), clamp448(d), w, true); return (unsigned)w; }
DI float bflo(unsigned w) { return __uint_as_float(w << 16); }
DI float bfhi(unsigned w) { return __uint_as_float(w & 0xffff0000u); }
DI float bf2f(bf16 h) { return __uint_as_float(((unsigned)h) << 16); }
DI bf16 f2bf(float f) { return (bf16)(pk2(f, 0.f) & 0xffffu); }
DI float rcpf_(float x) { return __builtin_amdgcn_rcpf(x); }
DI float ex2f_(float x) { return __builtin_amdgcn_exp2f(x); }
DI float expf_(float x) { return __builtin_amdgcn_exp2f(x * 1.4426950408889634f); }
DI float logf_(float x) { return __builtin_amdgcn_logf(x) * 0.6931471805599453f; }
DI float sigm(float x) { return rcpf_(1.0f + expf_(-x)); }
DI float wave_sum(float v) {
#pragma unroll
    for (int o = 1; o < 64; o <<= 1) v += __shfl_xor(v, o);
    return v;
}
#define LDS_WAIT() asm volatile("s_waitcnt lgkmcnt(0)" ::: "memory")
template <int CTRL> DI float dpp_mov_f(float v) { return __uint_as_float((unsigned)__builtin_amdgcn_update_dpp(0, (int)__float_as_uint(v), CTRL, 0xf, 0xf, true)); }
DI float wave_sum_fast(float v) {
    v += dpp_mov_f<0xB1>(v); v += dpp_mov_f<0x4E>(v); v += dpp_mov_f<0x124>(v); v += dpp_mov_f<0x128>(v);
    const unsigned u = __float_as_uint(v);
    return (__uint_as_float((unsigned)__builtin_amdgcn_readlane((int)u, 0)) + __uint_as_float((unsigned)__builtin_amdgcn_readlane((int)u, 16)))
         + (__uint_as_float((unsigned)__builtin_amdgcn_readlane((int)u, 32)) + __uint_as_float((unsigned)__builtin_amdgcn_readlane((int)u, 48)));
}

#define XB_TMO      128
#define XB_XCNT(j)  (256  + 64 * (j))
#define XB_XSUB(j)  (1280 + 64 * (j))
#define XB_XGEN(j)  (2304 + 64 * (j))
#define XB_TOP      3328
#define XB_TOPGEN   3392
#define XCD_BAR_WORDS 3456
#define XB_SPIN_CAP (1u << 18)
__device__ __forceinline__ unsigned xb_ld(unsigned* p)              { return __hip_atomic_load(p, __ATOMIC_RELAXED, __HIP_MEMORY_SCOPE_AGENT); }
__device__ __forceinline__ unsigned xb_add(unsigned* p, unsigned v) { return __hip_atomic_fetch_add(p, v, __ATOMIC_RELAXED, __HIP_MEMORY_SCOPE_AGENT); }
__device__ __forceinline__ unsigned xb_xcc_id() { return (unsigned)__builtin_amdgcn_s_getreg((3 << 11) | 20) & 0xFu; }
#define XB_SPIN(cond, bar) do { unsigned _sp = 0; while (cond) { __builtin_amdgcn_s_sleep(1); \
    if ((++_sp & 255u) == 0u) { if (xb_ld(&(bar)[XB_TMO])) break; if (_sp > XB_SPIN_CAP) { atomicAdd(&(bar)[XB_TMO], 1u); break; } } } } while (0)
struct XcdBarrier { unsigned* bar; unsigned x; volatile LAS unsigned* st; };
__device__ __forceinline__ XcdBarrier xcd_barrier_post(unsigned* bar, volatile LAS unsigned* st) {
    XcdBarrier b; b.bar = bar; b.x = xb_xcc_id(); b.st = st;
    if (threadIdx.x == 0) (void)xb_add(&bar[XB_XCNT(b.x)], 1u);
    return b;
}
__device__ __forceinline__ void xcd_barrier_complete(unsigned* bar, unsigned x, unsigned& nloc, unsigned& nx) {
    const unsigned G = gridDim.x * gridDim.y * gridDim.z;
    unsigned sum, cnt, mine, sp = 0u;
    for (;;) {
        sum = 0u; cnt = 0u; mine = 0u;
#pragma unroll
        for (unsigned j = 0; j < 16; ++j) { const unsigned c = xb_ld(&bar[XB_XCNT(j)]); sum += c; cnt += (c > 0u) ? 1u : 0u; mine = (j == x) ? c : mine; }
        if (sum == G) break;
        __builtin_amdgcn_s_sleep(1);
        if ((++sp & 255u) == 0u) { if (xb_ld(&bar[XB_TMO])) break; if (sp > XB_SPIN_CAP) { atomicAdd(&bar[XB_TMO], 1u); break; } }
    }
    nloc = mine > 0u ? mine : 1u; nx = cnt > 0u ? cnt : 1u;
}
__device__ __forceinline__ void xcd_barrier(const XcdBarrier& b) {
    asm volatile("s_waitcnt vmcnt(0)" ::: "memory");
    __syncthreads();
    if (threadIdx.x == 0) {
        unsigned* bar = b.bar;
        __builtin_amdgcn_s_waitcnt(0);
        unsigned nloc = b.st[0], nx = b.st[1];
        if (nloc == 0u) { xcd_barrier_complete(bar, b.x, nloc, nx); b.st[0] = nloc; b.st[1] = nx; }
        const unsigned old = xb_add(&bar[XB_XSUB(b.x)], 1u);
        const unsigned gen = old / nloc;
        if (old + 1u == (gen + 1u) * nloc) {
            __builtin_amdgcn_fence(__ATOMIC_RELEASE, "agent");
            asm volatile("s_waitcnt vmcnt(0)" ::: "memory");
            const unsigned og = xb_add(&bar[XB_TOP], 1u);
            const unsigned tg = og / nx;
            if (og + 1u == (tg + 1u) * nx) xb_add(&bar[XB_TOPGEN], 1u);
            else XB_SPIN(xb_ld(&bar[XB_TOPGEN]) == tg, bar);
            __builtin_amdgcn_fence(__ATOMIC_ACQUIRE, "agent");
            xb_add(&bar[XB_XGEN(b.x)], 1u);
            asm volatile("s_waitcnt vmcnt(0)" ::: "memory");
        } else {
            XB_SPIN(xb_ld(&bar[XB_XGEN(b.x)]) == gen, bar);
            __builtin_amdgcn_fence(__ATOMIC_ACQUIRE, "agent");
            asm volatile("s_waitcnt vmcnt(0)" ::: "memory");
        }
    }
    __syncthreads();
}

namespace pg8 {
constexpr int BM = 256, BK = 64, HALF = 128, HTB = HALF * BK * 2, NXCD = 8, WGM = 8;
DI int lds_byte(int r, int c) { const int st = (r >> 4) * 2 + (c >> 5), rr = r & 15, cc = c & 31, ob = rr * 64 + cc * 2; return st * 1024 + (ob ^ (((ob >> 9) & 1) << 5)); }
DI void stage_rc(int b, int& R, int& C) { const int st = b / 1024, sb = b % 1024, swz = sb ^ (((sb >> 9) & 1) << 5); R = (st >> 1) * 16 + swz / 64; C = (st & 1) * 32 + (swz % 64) / 2; }
DI int perm32(int rho) { const int n = rho >> 4, i = rho & 15; return 8 * (i >> 2) + 4 * n + (i & 3); }

struct Unit { int pm, pn, e, rt, ord, nrows; };

struct DenseOrder {
    const char* A; const char* Bt; int K, nM, nN, nwg, G, c;
    DI void init(const void* A_, const void* Bt_, int M, int N, int K_, int G_, int c_) { A = (const char*)A_; Bt = (const char*)Bt_; K = K_; nM = M / BM; nN = N / BM; nwg = nM * nN; G = G_; c = c_; }
    DI bool next(int i, Unit& u) const {
        const long L = (long)i * G + c; if (L >= nwg) return false;
        int wgid = (int)L; { const int q = nwg / NXCD, r = nwg % NXCD, xcd = wgid % NXCD, off = wgid / NXCD; wgid = (xcd < r ? xcd * (q + 1) : r * (q + 1) + (xcd - r) * q) + off; }
        const int nig = WGM * nN, gid = wgid / nig, fm = gid * WGM, gsz = (nM - fm) < WGM ? (nM - fm) : WGM;
        u.pm = fm + ((wgid % nig) % gsz); u.pn = (wgid % nig) / gsz; u.e = 0; u.rt = u.pm; u.ord = i; u.nrows = 256; return true;
    }
    DI const char* a_base(const Unit& u) const { return A + (size_t)u.pm * BM * K * 2; }
    DI const char* b_base(const Unit& u) const { return Bt + (size_t)u.pn * BM * K * 2; }
    static constexpr bool GATHER_A = false;
    DI void a_offs(const Unit&, int tid, unsigned (&v)[2][2]) const {
#pragma unroll
        for (int i = 0; i < 2; ++i) { int R, C; stage_rc(tid * 16 + i * 8192, R, C);
#pragma unroll
            for (int h = 0; h < 2; ++h) v[h][i] = (unsigned)((h * HALF + R) * K + C) * 2u; }
    }
};

template <bool GATHER> struct MoeOrder {
    const char* A; const char* Bt; const char* BtS; int K, ncol; size_t estride; const char* dump;
    const LAS int* ut; const LAS int* idx; int nunits, nfull;
    static constexpr bool GATHER_A = GATHER;
    DI bool next(int i, Unit& u) const {
        if (i >= nunits) return false;
        int j, pn;
        if (i < nfull) { j = i / ncol; pn = i - j * ncol; } else { j = nfull / ncol + (i - nfull); pn = -1; }
        const v4u t = *(const LAS v4u*)(ut + 4 * j);
        u.ord = j; u.e = (int)t.x; u.pm = (int)t.y; u.rt = (int)t.z; u.nrows = (int)(t.w & 0xffffu); u.pn = pn >= 0 ? pn : (int)(t.w >> 16);
        return true;
    }
    DI const char* a_base(const Unit& u) const { return GATHER ? A : A + (size_t)u.rt * BM * K * 2; }
    DI const char* b_base(const Unit& u) const { return (u.e < 256 ? Bt + (size_t)u.e * estride : BtS) + (size_t)u.pn * BM * K * 2; }
    DI void a_offs(const Unit& u, int tid, unsigned (&v)[2][2]) const {
#pragma unroll
        for (int i = 0; i < 2; ++i) { int R, C; stage_rc(tid * 16 + i * 8192, R, C);
#pragma unroll
            for (int h = 0; h < 2; ++h) {
                if (GATHER) v[h][i] = ((unsigned)idx[u.ord * 256 + h * HALF + R] * (unsigned)K + (unsigned)C) * 2u;
                else v[h][i] = (unsigned)((h * HALF + R) * K + C) * 2u; } }
    }
};

struct GProf { unsigned long long t_loop, t_epi, t_next; };
typedef int v8i __attribute__((ext_vector_type(8)));
template <class Epi, class Sched, bool PROF = false, bool F8 = false, bool AKEEP = false>
__device__ __forceinline__ void gemm_phase(LAS unsigned char* lds, const int K, const Sched& S, const Epi& E, const int wid  , GProf* prof = nullptr) {
    unsigned long long pt0 = 0, pt1 = 0, pt2 = 0, pt3 = 0;
    const int tid = threadIdx.x, lane = tid & 63, wr = wid >> 2, wc = wid & 3, fr = lane & 15, fq = lane >> 4;
    const int nt = K / BK;
    unsigned voffBh[2][2];
#pragma unroll
    for (int i = 0; i < 2; ++i) { int R, C; stage_rc(tid * 16 + i * 8192, R, C);
#pragma unroll
        for (int h = 0; h < 2; ++h) { int Rb;
            if (Epi::PERM == 2) Rb = 64 * ((R >> 5) & 3) + 16 * ((R >> 2) & 3) + 8 * h + 4 * ((R >> 4) & 1) + (R & 3);
            else Rb = HALF * h + (Epi::PERM == 1 ? ((R & ~31) + perm32(R & 31)) : R);
            voffBh[h][i] = (unsigned)(Rb * K + C) * 2u; } }
    const size_t kstep = (size_t)(BK * 2);
    const size_t hstep = (size_t)HALF * K * 2;
    const unsigned ldsw = (unsigned)wid * 1024u;
    const int aoff = F8 ? lds_byte(wr * 64 + fr, fq * 16) : lds_byte(wr * 64 + fr, fq * 8), boff = F8 ? lds_byte(wc * 32 + fr, fq * 16) : lds_byte(wc * 32 + fr, fq * 8);
#define PG8_SA(b, h) (((b) * 2 + (h)) * HTB)
#define PG8_SB(b, h) ((4 + (b) * 2 + (h)) * HTB)
#define PG8_STAGE(bufoff, gbase, voff) do { _Pragma("unroll") for (int _i = 0; _i < 2; ++_i) \
        __builtin_amdgcn_global_load_lds((const unsigned*)((const char*)(gbase) + (voff)[_i]), (LAS unsigned*)(lds + (bufoff) + ldsw + _i * 8192), 16, 0, 0); } while (0)
#define PG8_STAGE_A(bufoff, gbase, voff, skip) do { if (AKEEP && (skip)) { if constexpr (AKEEP) asm volatile("global_store_byte %0, %0, %1\n\tglobal_store_byte %0, %0, %1" :: "v"(sc127), "s"(S.dump) : "memory"); } \
        else PG8_STAGE(bufoff, gbase, voff); } while (0)
#define PG8_LD8(dst, off) do { const v4u _lo = *(const LAS v4u*)(lds + (off)), _hi = *(const LAS v4u*)(lds + (off) + 16); \
        dst[0] = (int)_lo.x; dst[1] = (int)_lo.y; dst[2] = (int)_lo.z; dst[3] = (int)_lo.w; dst[4] = (int)_hi.x; dst[5] = (int)_hi.y; dst[6] = (int)_hi.z; dst[7] = (int)_hi.w; } while (0)
#define PG8_LDA(dst, b, h) do { if (F8) { _Pragma("unroll") for (int m = 0; m < 4; ++m) PG8_LD8(dst##8[m], PG8_SA(b, h) + aoff + m * 2048); } \
        else { _Pragma("unroll") for (int m = 0; m < 4; ++m) _Pragma("unroll") for (int k = 0; k < 2; ++k) dst[m][k] = *(const LAS bf16x8*)(lds + PG8_SA(b, h) + aoff + m * 2048 + k * 1024); } } while (0)
#define PG8_LDB(dst, b, h) do { if (F8) { _Pragma("unroll") for (int n = 0; n < 2; ++n) PG8_LD8(dst##8[n], PG8_SB(b, h) + boff + n * 2048); } \
        else { _Pragma("unroll") for (int n = 0; n < 2; ++n) _Pragma("unroll") for (int k = 0; k < 2; ++k) dst[n][k] = *(const LAS bf16x8*)(lds + PG8_SB(b, h) + boff + n * 2048 + k * 1024); } } while (0)
#define PG8_MMA(ai, bj, At, Bt) do { __builtin_amdgcn_s_setprio(1); \
        if (F8) { _Pragma("unroll") for (int m = 0; m < 4; ++m) _Pragma("unroll") for (int n = 0; n < 2; ++n) \
            asm volatile("v_mfma_scale_f32_16x16x128_f8f6f4 %0, %1, %2, %0, %3, %3 op_sel_hi:[0,0,0]" : "+v"(acc[ai][bj][m][n]) : "v"(Bt##8[n]), "v"(At##8[m]), "v"(sc127)); } \
        else { _Pragma("unroll") for (int m = 0; m < 4; ++m) _Pragma("unroll") for (int n = 0; n < 2; ++n) _Pragma("unroll") for (int k = 0; k < 2; ++k) \
            acc[ai][bj][m][n] = __builtin_amdgcn_mfma_f32_16x16x32_bf16(Bt[n][k], At[m][k], acc[ai][bj][m][n], 0, 0, 0); } \
        __builtin_amdgcn_s_setprio(0); } while (0)
#define PG8_WAIT_V(n) asm volatile("s_waitcnt vmcnt(" #n ")" ::: "memory")
#define PG8_WAIT_L(n) asm volatile("s_waitcnt lgkmcnt(" #n ")" ::: "memory")
#define PG8_BAR __builtin_amdgcn_s_barrier()
#define PG8_SCHED __builtin_amdgcn_sched_barrier(0)
    Unit cur, nxt; int ui = 0;
    if (!S.next(0, cur)) return;
    f32x4 acc[2][2][4][2];
#pragma unroll
    for (int a = 0; a < 2; ++a)
#pragma unroll
        for (int b = 0; b < 2; ++b)
#pragma unroll
            for (int m = 0; m < 4; ++m)
#pragma unroll
                for (int n = 0; n < 2; ++n) acc[a][b][m][n] = (f32x4){0.f, 0.f, 0.f, 0.f};
    bf16x8 At[4][2], B0[2][2], B1[2][2];
    v8i At8[4], B08[2], B18[2];
    int sc127 = 127; asm volatile("" : "+v"(sc127));
    unsigned vC[2][2], vN[2][2];
    const bool keep_ok = AKEEP && nt == 2; bool sC = false;
    S.a_offs(cur, tid, vC);
    const char* cA = S.a_base(cur); const char* cB = S.b_base(cur);
    PG8_STAGE(PG8_SB(0, 0), cB, voffBh[0]); PG8_STAGE(PG8_SA(0, 0), cA, vC[0]); PG8_STAGE(PG8_SB(0, 1), cB, voffBh[1]); PG8_STAGE(PG8_SA(0, 1), cA, vC[1]);
    if (wr == 1) PG8_BAR;
    PG8_WAIT_V(4); PG8_BAR;
    PG8_STAGE(PG8_SB(1, 0), cB + kstep, voffBh[0]); PG8_STAGE(PG8_SA(1, 0), cA + kstep, vC[0]); PG8_STAGE(PG8_SB(1, 1), cB + kstep, voffBh[1]);
    PG8_WAIT_V(6); PG8_BAR;
    for (;;) {
        if (PROF) pt0 = __builtin_amdgcn_s_memrealtime();
        const bool has_next = S.next(ui + 1, nxt);
        const char* nA = has_next ? S.a_base(nxt) : cA; const char* nB = has_next ? S.b_base(nxt) : cB;
        if (Sched::GATHER_A) { if (has_next) S.a_offs(nxt, tid, vN); else { vN[0][0] = vC[0][0]; vN[0][1] = vC[0][1]; vN[1][0] = vC[1][0]; vN[1][1] = vC[1][1]; } }
        const bool sN = keep_ok && (!has_next || nxt.ord == cur.ord);
        if (PROF) pt1 = __builtin_amdgcn_s_memrealtime();
#pragma unroll 1
        for (int t = 0; t < nt; t += 2) {
            const bool last = (t == nt - 2);
            const char* a1 = cA + (size_t)(t + 1) * kstep;
            const char* a2 = last ? nA : cA + (size_t)(t + 2) * kstep; const char* b2 = last ? nB : cB + (size_t)(t + 2) * kstep;
            const char* a3 = a2 + kstep; const char* b3 = b2 + kstep;
            unsigned x0[2], x1[2];
            if (Sched::GATHER_A) { x0[0] = last ? vN[0][0] : vC[0][0]; x0[1] = last ? vN[0][1] : vC[0][1]; x1[0] = last ? vN[1][0] : vC[1][0]; x1[1] = last ? vN[1][1] : vC[1][1]; }
            else { x0[0] = vC[0][0]; x0[1] = vC[0][1]; x1[0] = vC[1][0]; x1[1] = vC[1][1]; }
            PG8_LDB(B0, 0, 0); PG8_SCHED; PG8_LDA(At, 0, 0); PG8_STAGE_A(PG8_SA(1, 1), a1, vC[1], sC);
            PG8_WAIT_L(8); PG8_BAR; PG8_WAIT_L(0); PG8_MMA(0, 0, At, B0); PG8_WAIT_V(10); PG8_BAR; PG8_SCHED;
            PG8_LDB(B1, 0, 1); PG8_STAGE(PG8_SB(0, 0), b2, voffBh[0]);
            PG8_BAR; PG8_WAIT_L(0); PG8_MMA(0, 1, At, B1); PG8_WAIT_V(10); PG8_BAR;
            PG8_LDA(At, 0, 1); PG8_STAGE_A(PG8_SA(0, 0), a2, x0, sN);
            PG8_BAR; PG8_WAIT_L(0); PG8_MMA(1, 0, At, B0); PG8_BAR; PG8_SCHED;
            PG8_STAGE(PG8_SB(0, 1), b2, voffBh[1]);
            PG8_BAR; PG8_MMA(1, 1, At, B1); PG8_WAIT_V(10); PG8_BAR;
            PG8_LDB(B0, 1, 0); PG8_SCHED; PG8_LDA(At, 1, 0); PG8_STAGE_A(PG8_SA(0, 1), a2, x1, sN);
            PG8_WAIT_L(8); PG8_BAR; PG8_WAIT_L(0); PG8_MMA(0, 0, At, B0); PG8_WAIT_V(10); PG8_BAR; PG8_SCHED;
            PG8_LDB(B1, 1, 1); PG8_STAGE(PG8_SB(1, 0), b3, voffBh[0]);
            PG8_BAR; PG8_WAIT_L(0); PG8_MMA(0, 1, At, B1); PG8_WAIT_V(10); PG8_BAR;
            PG8_LDA(At, 1, 1); PG8_STAGE_A(PG8_SA(1, 0), a3, x0, sN);
            PG8_BAR; PG8_WAIT_L(0); PG8_MMA(1, 0, At, B0); PG8_BAR; PG8_SCHED;
            PG8_STAGE(PG8_SB(1, 1), b3, voffBh[1]);
            PG8_BAR; PG8_MMA(1, 1, At, B1); PG8_WAIT_V(10); PG8_BAR;
        }
        if (PROF) pt2 = __builtin_amdgcn_s_memrealtime();
        if (F8) asm volatile("s_nop 15\n\ts_nop 15" ::: "memory");
        E(acc, cur, wr, wc, fr, fq);
        if (PROF) { asm volatile("s_waitcnt vmcnt(0)" ::: "memory"); pt3 = __builtin_amdgcn_s_memrealtime(); prof->t_next += pt1 - pt0; prof->t_loop += pt2 - pt1; prof->t_epi += pt3 - pt2; }
        if (!has_next) break;
#pragma unroll
        for (int a = 0; a < 2; ++a)
#pragma unroll
            for (int b = 0; b < 2; ++b)
#pragma unroll
                for (int m = 0; m < 4; ++m)
#pragma unroll
                    for (int n = 0; n < 2; ++n) acc[a][b][m][n] = (f32x4){0.f, 0.f, 0.f, 0.f};
        cur = nxt; cA = nA; cB = nB; ++ui; sC = sN;
        if (Sched::GATHER_A) { vC[0][0] = vN[0][0]; vC[0][1] = vN[0][1]; vC[1][0] = vN[1][0]; vC[1][1] = vN[1][1]; }
    }
    PG8_WAIT_V(0);
    if (wr == 0) PG8_BAR;
    PG8_BAR;
#undef PG8_SA
#undef PG8_SB
#undef PG8_STAGE
#undef PG8_STAGE_A
#undef PG8_LD8
#undef PG8_LDA
#undef PG8_LDB
#undef PG8_MMA
#undef PG8_WAIT_V
#undef PG8_WAIT_L
#undef PG8_BAR
#undef PG8_SCHED
}

DI float gelu_tanh(float x) { const float u = 1.5957691216f * (x + 0.044715f * x * x * x); return x * rcpf_(1.0f + expf_(-u)); }
DI float silu_f(float x) { return x * rcpf_(1.0f + expf_(-x)); }

struct EpiInProj {
    static constexpr int PERM = 2;
    bf16* P; const float* LB;
    DI void operator()(const f32x4 (&acc)[2][2][4][2], const Unit& u, int wr, int wc, int fr, int fq) const {
        const int row0 = u.pm * BM + wr * 64 + fr, col0 = u.pn * BM + wc * 64 + 16 * fq;
        const int pn = u.pn;
        const int kind = (pn == 2 || pn == 3) ? 1 : (pn >= 8 && pn < 12) ? 2 : (pn >= 12) ? 3 : 0;
        f32x4 lbv[2][2];
        { const int dir = (pn >> 1) & 1; const int cc = (pn & 1) * 256 + wc * 64 + 16 * fq;
#pragma unroll
            for (int bj = 0; bj < 2; ++bj)
#pragma unroll
                for (int n = 0; n < 2; ++n) lbv[bj][n] = *(const f32x4*)(LB + dir * 512 + cc + 8 * bj + 4 * n);
            asm volatile("" :: "v"(lbv[0][0]), "v"(lbv[0][1]), "v"(lbv[1][0]), "v"(lbv[1][1])); }
#pragma unroll
        for (int ai = 0; ai < 2; ++ai)
#pragma unroll
            for (int m = 0; m < 4; ++m) { bf16* rowp = P + (size_t)(row0 + ai * HALF + m * 16) * INC + col0;
#pragma unroll
                for (int bj = 0; bj < 2; ++bj) { f32x4 v0 = acc[ai][bj][m][0], v1 = acc[ai][bj][m][1];
                    if (kind == 1) {
#pragma unroll
                        for (int j = 0; j < 4; ++j) { v0[j] = gelu_tanh(v0[j]); v1[j] = gelu_tanh(v1[j]); } }
                    else if (kind == 2) {
#pragma unroll
                        for (int j = 0; j < 4; ++j) { const float l0 = lbv[bj][0][j], l1 = lbv[bj][1][j];
                            v0[j] = logf_(l0 + (1.0f - l0) * sigm(v0[j])); v1[j] = logf_(l1 + (1.0f - l1) * sigm(v1[j])); } }
                    else if (kind == 3) {
#pragma unroll
                        for (int j = 0; j < 4; ++j) { v0[j] = silu_f(v0[j]); v1[j] = silu_f(v1[j]); } }
                    v4u w; w.x = pk2(v0[0], v0[1]); w.y = pk2(v0[2], v0[3]); w.z = pk2(v1[0], v1[1]); w.w = pk2(v1[2], v1[3]);
                    *(v4u*)(rowp + 8 * bj) = w; } }
    }
};
struct EpiResid {
    static constexpr int PERM = 2;
    const float* x; const float* mod; bf16* X1;
    DI void operator()(const f32x4 (&acc)[2][2][4][2], const Unit& u, int wr, int wc, int fr, int fq) const {
        const int row0 = u.pm * BM + wr * 64 + fr, col0 = u.pn * BM + wc * 64 + 16 * fq;
        const int b = (u.pm * BM) >> 11;
        f32x4 gv[2][2];
#pragma unroll
        for (int bj = 0; bj < 2; ++bj)
#pragma unroll
            for (int n = 0; n < 2; ++n) gv[bj][n] = *(const f32x4*)(mod + (size_t)b * 6144 + 2048 + col0 + 8 * bj + 4 * n);
        asm volatile("" :: "v"(gv[0][0]), "v"(gv[0][1]), "v"(gv[1][0]), "v"(gv[1][1]));
#pragma unroll
        for (int ai = 0; ai < 2; ++ai) {
            f32x4 xv[4][2][2];
#pragma unroll
            for (int m = 0; m < 4; ++m) { const size_t off = (size_t)(row0 + ai * HALF + m * 16) * D + col0;
#pragma unroll
                for (int bj = 0; bj < 2; ++bj) { xv[m][bj][0] = *(const f32x4*)(x + off + 8 * bj); xv[m][bj][1] = *(const f32x4*)(x + off + 8 * bj + 4); } }
#pragma unroll
            for (int m = 0; m < 4; ++m) { const size_t off = (size_t)(row0 + ai * HALF + m * 16) * D + col0;
#pragma unroll
                for (int bj = 0; bj < 2; ++bj) {
                    const f32x4 v0 = xv[m][bj][0] + gv[bj][0] * acc[ai][bj][m][0], v1 = xv[m][bj][1] + gv[bj][1] * acc[ai][bj][m][1];
                    v4u w; w.x = pk2(v0[0], v0[1]); w.y = pk2(v0[2], v0[3]); w.z = pk2(v1[0], v1[1]); w.w = pk2(v1[2], v1[3]);
                    *(v4u*)(X1 + off + 8 * bj) = w; } }
        }
    }
};
struct EpiF32 {
    static constexpr int PERM = 0;
    float* C; int ldc;
    DI void operator()(const f32x4 (&acc)[2][2][4][2], const Unit& u, int wr, int wc, int fr, int fq) const {
        const int row0 = u.pm * BM + wr * 64 + fr, col0 = u.pn * BM + wc * 32 + 4 * fq;
#pragma unroll
        for (int ai = 0; ai < 2; ++ai)
#pragma unroll
            for (int m = 0; m < 4; ++m) { float* rowp = C + (size_t)(row0 + ai * HALF + m * 16) * ldc + col0;
#pragma unroll
                for (int bj = 0; bj < 2; ++bj)
#pragma unroll
                    for (int n = 0; n < 2; ++n) *(f32x4*)(rowp + bj * HALF + n * 16) = acc[ai][bj][m][n]; }
    }
};
struct EpiSwiGLU8 {
    static constexpr int PERM = 1;
    unsigned char* ACT;
    DI void operator()(const f32x4 (&acc)[2][2][4][2], const Unit& u, int wr, int wc, int fr, int fq) const {
        const unsigned off0 = ((unsigned)u.rt * 256u + (unsigned)(wr * 64 + fr)) * (unsigned)DE + (unsigned)(u.pn * 128 + wc * 32 + 8 * fq);
#pragma unroll
        for (int ai = 0; ai < 2; ++ai)
#pragma unroll
            for (int m = 0; m < 4; ++m) {
                f32x4 a0 = acc[ai][0][m][0] * 0.03125f, a1 = acc[ai][0][m][1] * 0.03125f; const f32x4 g0 = acc[ai][1][m][0] * 0.25f, g1 = acc[ai][1][m][1] * 0.25f;
#pragma unroll
                for (int j = 0; j < 4; ++j) { a0[j] = silu_f(a0[j]) * g0[j]; a1[j] = silu_f(a1[j]) * g1[j]; }
                v2u w; w.x = pk4_f8(a0[0], a0[1], a0[2], a0[3]); w.y = pk4_f8(a1[0], a1[1], a1[2], a1[3]);
                *(v2u*)(ACT + (off0 + (unsigned)((ai * HALF + m * 16) * DE))) = w; }
    }
};
struct EpiSwiGLU {
    static constexpr int PERM = 1;
    bf16* ACT;
    DI void operator()(const f32x4 (&acc)[2][2][4][2], const Unit& u, int wr, int wc, int fr, int fq) const {
        const int row0 = wr * 64 + fr, col0 = u.pn * 128 + wc * 32 + 8 * fq;
        bf16* base = ACT + (size_t)u.rt * 256 * DE;
#pragma unroll
        for (int ai = 0; ai < 2; ++ai)
#pragma unroll
            for (int m = 0; m < 4; ++m) { bf16* rowp = base + (size_t)(row0 + ai * HALF + m * 16) * DE + col0;
                f32x4 a0 = acc[ai][0][m][0], a1 = acc[ai][0][m][1]; const f32x4 g0 = acc[ai][1][m][0], g1 = acc[ai][1][m][1];
#pragma unroll
                for (int j = 0; j < 4; ++j) { a0[j] = silu_f(a0[j]) * g0[j]; a1[j] = silu_f(a1[j]) * g1[j]; }
                v4u w; w.x = pk2(a0[0], a0[1]); w.y = pk2(a0[2], a0[3]); w.z = pk2(a1[0], a1[1]); w.w = pk2(a1[2], a1[3]);
                *(v4u*)rowp = w; }
    }
};
struct EpiScatter {
    static constexpr int PERM = 2;
    unsigned char* YE; const LAS float* gate; float oscale;
    DI void operator()(const f32x4 (&acc)[2][2][4][2], const Unit& u, int wr, int wc, int fr, int fq) const {
        const unsigned col0 = (unsigned)(u.pn * BM + wc * 64 + 16 * fq);
        float gt[2][4];
#pragma unroll
        for (int ai = 0; ai < 2; ++ai)
#pragma unroll
            for (int m = 0; m < 4; ++m) gt[ai][m] = gate[u.ord * 256 + ai * HALF + wr * 64 + m * 16 + fr] * oscale;
#pragma unroll
        for (int ai = 0; ai < 2; ++ai)
#pragma unroll
            for (int m = 0; m < 4; ++m) { const int r = ai * HALF + wr * 64 + m * 16 + fr; const float g = gt[ai][m];
                const unsigned row = (r < u.nrows) ? (unsigned)u.rt * 256u + (unsigned)r : 360448u;
                const f32x4 v0 = acc[ai][0][m][0] * g, v1 = acc[ai][0][m][1] * g, v2 = acc[ai][1][m][0] * g, v3 = acc[ai][1][m][1] * g;
                v4u w; w.x = pk4_f8(v0[0], v0[1], v0[2], v0[3]); w.y = pk4_f8(v1[0], v1[1], v1[2], v1[3]); w.z = pk4_f8(v2[0], v2[1], v2[2], v2[3]); w.w = pk4_f8(v3[0], v3[1], v3[2], v3[3]);
                *(v4u*)(YE + (row * (unsigned)D + col0)) = w; }
    }
};
}

struct Args { const float* in[26]; float* out; unsigned char* ws; int ph_lo, ph_hi; };
enum { I_X = 0, I_C, I_CTX, I_CCTX, I_ADAW, I_ADAB, I_NMIX, I_NFFN, I_NFIN, I_WIN, I_WOUT, I_CONVW, I_CONVB, I_WA, I_BA, I_WX, I_BX, I_LAM,
       I_LBL, I_HNORM, I_RW, I_RB, I_EW13, I_EW2, I_SW13, I_SW2 };

struct Frame {
    LAS unsigned char* lds;
    int tid, lane, wave, G, vcu, bx;
    const float* const* in; float* out; unsigned char* ws;
};

DI void transpose_item(const float* W, int ldw, bf16* WT, int ldo, int k0, int n0, int orow0, LAS float* scr, int lane) {
    const int sub = lane >> 3, c4 = (lane & 7) * 4;
    f32x4 v[8];
#pragma unroll
    for (int i = 0; i < 8; ++i) v[i] = __builtin_nontemporal_load((const f32x4*)(W + (size_t)(k0 + 8 * i + sub) * ldw + n0 + c4));
#pragma unroll
    for (int i = 0; i < 8; ++i) { LAS float* d = scr + (8 * i + sub) * 33 + c4; d[0] = v[i].x; d[1] = v[i].y; d[2] = v[i].z; d[3] = v[i].w; }
    LDS_WAIT(); asm volatile("" ::: "memory");
    const int c = lane & 7;
#pragma unroll
    for (int j = 0; j < 4; ++j) { const int n = (lane >> 3) + 8 * j; const LAS float* s = scr + (8 * c) * 33 + n;
        v4u o; o.x = pk2(s[0 * 33], s[1 * 33]); o.y = pk2(s[2 * 33], s[3 * 33]); o.z = pk2(s[4 * 33], s[5 * 33]); o.w = pk2(s[6 * 33], s[7 * 33]);
        *(v4u*)(WT + (size_t)(orow0 + n) * ldo + k0 + 8 * c) = o; }
    LDS_WAIT(); asm volatile("" ::: "memory");
}
DI void transpose_item8(const float* W, int ldw, unsigned char* WT, int ldo, int k0, int n0, int orow0, float scale, LAS float* scr, int lane) {
    const int sub = lane >> 3, c4 = (lane & 7) * 4;
    f32x4 v[16];
#pragma unroll
    for (int i = 0; i < 16; ++i) v[i] = __builtin_nontemporal_load((const f32x4*)(W + (size_t)(k0 + 8 * i + sub) * ldw + n0 + c4));
#pragma unroll
    for (int i = 0; i < 16; ++i) { LAS float* d = scr + (8 * i + sub) * 33 + c4; d[0] = v[i].x; d[1] = v[i].y; d[2] = v[i].z; d[3] = v[i].w; }
    LDS_WAIT(); asm volatile("" ::: "memory");
    const int c = lane & 7;
#pragma unroll
    for (int j = 0; j < 4; ++j) { const int n = (lane >> 3) + 8 * j; const LAS float* sp = scr + (16 * c) * 33 + n;
        v4u o; o.x = pk4_f8(sp[0] * scale, sp[33] * scale, sp[66] * scale, sp[99] * scale); o.y = pk4_f8(sp[132] * scale, sp[165] * scale, sp[198] * scale, sp[231] * scale);
        o.z = pk4_f8(sp[264] * scale, sp[297] * scale, sp[330] * scale, sp[363] * scale); o.w = pk4_f8(sp[396] * scale, sp[429] * scale, sp[462] * scale, sp[495] * scale);
        *(v4u*)(WT + (size_t)(orow0 + n) * ldo + k0 + 16 * c) = o; }
    LDS_WAIT(); asm volatile("" ::: "memory");
}
DI int w13_row(int n) { const int half = n >> 8, idx = n & 255; return 256 * (idx >> 7) + 128 * half + (idx & 127); }

DI void phase_prologue(const Frame& F) {
    const float* const* in = F.in; unsigned char* ws = F.ws;
    {
        LAS float* sc = (LAS float*)F.lds;
        LAS float* red = (LAS float*)(F.lds + 17 * 1024 * 4);
        for (int i = F.tid; i < 17 * 1024; i += NTHR) { const int r = i >> 10, k = i & 1023; const float v = (r < 16) ? in[I_C][r * 1024 + k] : in[I_CCTX][k]; sc[i] = v / (1.0f + __expf(-v)); }
        __syncthreads();
        const float* aw = in[I_ADAW]; float* MOD = (float*)(ws + WS_MOD);
        for (int cg = F.bx; cg < 256; cg += F.G) {
            const int kg = F.tid >> 5, cl = F.tid & 31, col = cg * 24 + cl;
            float a[17];
#pragma unroll
            for (int r = 0; r < 17; ++r) a[r] = 0.f;
            if (cl < 24) {
#pragma unroll 1
                for (int k8 = 0; k8 < 64; k8 += 16) { float w[16];
#pragma unroll
                    for (int q = 0; q < 16; ++q) w[q] = aw[(size_t)(kg * 64 + k8 + q) * 6144 + col];
#pragma unroll
                    for (int q = 0; q < 16; ++q) { const int k = kg * 64 + k8 + q;
#pragma unroll
                        for (int r = 0; r < 17; ++r) a[r] += sc[r * 1024 + k] * w[q]; } }
#pragma unroll
                for (int r = 0; r < 17; ++r) red[(kg * 17 + r) * 24 + cl] = a[r];
            }
            __syncthreads();
            if (F.tid < 17 * 24) { const int r = F.tid / 24, c2 = F.tid % 24; float s = 0.f;
                for (int g = 0; g < 16; ++g) s += red[(g * 17 + r) * 24 + c2];
                MOD[r * 6144 + cg * 24 + c2] = s + in[I_ADAB][cg * 24 + c2]; }
            __syncthreads();
        }
    }
    {
        float* LB = (float*)(ws + WS_TAB); float* SP = LB + 1024;
        const int gt = F.bx * NTHR + F.tid, GT = F.G * NTHR;
        for (int i = gt; i < 1024; i += GT) { const int d = i >> 9, c = i & 511;
            const float l0 = in[I_LBL][(d * 2 + 0) * 512 + c], l1 = in[I_LBL][(d * 2 + 1) * 512 + c];
            LB[i] = 1.0f / (1.0f + expf(l1 - l0));
            SP[i] = -8.0f * 1.4426950408889634f * log1pf(expf(-in[I_LAM][i])); }
        bf16* WGT = (bf16*)(ws + WS_WGT);
        for (int i = gt; i < 2 * 2 * 8 * 64 * 64; i += GT) { const int ii = i & 63, j = (i >> 6) & 63, h = (i >> 12) & 7, g = (i >> 15) & 1, d = i >> 16;
            const float* src = g ? in[I_WX] : in[I_WA];
            WGT[i] = f2bf(-1.4426950408889634f * src[((size_t)(d * 8 + h) * 64 + ii) * 64 + j]); }
    }
    {
        LAS float* scr = (LAS float*)(F.lds + F.wave * 16896);
        const int gw = F.vcu * NWAVES + F.wave, NGW = F.G * NWAVES;
        constexpr int IT_WIN = 16 * 112, IT_WOUT = 16 * 32, IT_WR = 16 * 8, IT_SW13 = 8 * 16, IT_SW2 = 2 * 32;
        LAS float* scr8 = (LAS float*)(F.lds + F.wave * 16896);
        constexpr int NIT = IT_WIN + IT_WOUT + IT_WR + IT_SW13 + IT_SW2;
        for (int it = gw; it < NIT; it += NGW) {
            int r = it;
            if (r < IT_WIN) { const int kb = r / 112, nb = r % 112; transpose_item(in[I_WIN], INC, (bf16*)(ws + WS_WIN), 1024, kb * 64, nb * 32, nb * 32, scr, F.lane); continue; } r -= IT_WIN;
            if (r < IT_WOUT) { const int kb = r / 32, nb = r % 32; transpose_item(in[I_WOUT], 1024, (bf16*)(ws + WS_WOUT), 1024, kb * 64, nb * 32, nb * 32, scr, F.lane); continue; } r -= IT_WOUT;
            if (r < IT_WR) { const int kb = r / 8, nb = r % 8; transpose_item(in[I_RW], 256, (bf16*)(ws + WS_WR), 1024, kb * 64, nb * 32, nb * 32, scr, F.lane); continue; } r -= IT_WR;
            if (r < IT_SW13) { const int kb = r / 16, nb = r % 16; transpose_item8(in[I_SW13], 512, ws + WS_SW13, 1024, kb * 128, nb * 32, w13_row(nb * 32), 32.0f, scr8, F.lane); continue; } r -= IT_SW13;
            { const int kb = r / 32, nb = r % 32; transpose_item8(in[I_SW2], 1024, ws + WS_SW2, 256, kb * 128, nb * 32, nb * 32, 16.0f, scr8, F.lane); }
        }
    }
}
constexpr int CV_STR = 132, CV_B = 128 * CV_STR * 4, CV_STR2 = 144;
static_assert(CV_B + 128 * CV_STR2 <= LDS_MISC, "convert lds");
DI void convert_experts(const Frame& F, const unsigned* stop_ctr, unsigned stop_val) {
    const float* const* in = F.in; unsigned char* ws = F.ws;
    LAS float* scr = (LAS float*)F.lds; LAS unsigned char* img = F.lds + CV_B;
    volatile LAS int* slot = (volatile LAS int*)(F.lds + LDS_MISC + 48);
    unsigned* qhead = (unsigned*)(ws + WS_CTL) + CW_CONVQ;
    constexpr int NB13 = 256 * 32, NB2 = 256 * 16;
    auto decode = [&](int blk, const float*& src, int& ldw, unsigned char*& dst, int& ldo, int& orow0, float& scale) {
        if (blk < NB13) { const int e = blk >> 5, q = blk & 31, nb = q >> 3, kb = q & 7;
            src = in[I_EW13] + (size_t)e * 1024 * 512 + (size_t)(kb * 128) * 512 + nb * 128; ldw = 512;
            dst = ws + WS_EW13 + (size_t)e * 512 * 1024 + kb * 128; ldo = 1024; orow0 = w13_row(nb * 128); scale = 32.0f; }
        else { const int r = blk - NB13, e = r >> 4, q = r & 15, nb = q >> 1, kb = q & 1;
            src = in[I_EW2] + (size_t)e * 256 * 1024 + (size_t)(kb * 128) * 1024 + nb * 128; ldw = 1024;
            dst = ws + WS_EW2 + (size_t)e * 1024 * 256 + kb * 128; ldo = 256; orow0 = nb * 128; scale = 16.0f; } };
    int ch_next = 0, ch_left = 0;
    auto claim = [&]() -> int {
        if (ch_left == 0) { __syncthreads();
            if (F.tid == 0) { int v = 0x7fffffff;
                if (!stop_ctr || __hip_atomic_load(stop_ctr, __ATOMIC_RELAXED, __HIP_MEMORY_SCOPE_AGENT) < stop_val) v = (int)__hip_atomic_fetch_add(qhead, 4u, __ATOMIC_RELAXED, __HIP_MEMORY_SCOPE_AGENT);
                slot[0] = v; }
            __syncthreads(); ch_next = slot[0]; ch_left = 4; }
        const int r = ch_next; if (ch_next < 0x7ffffff0) ++ch_next; --ch_left; return r; };
    f32x4 v[8];
    int blk = claim();
    const float* src = nullptr; int ldw = 0; unsigned char* dst = nullptr; int ldo = 0, orow0 = 0; float scale = 1.f;
    if (blk < NB13 + NB2) { decode(blk, src, ldw, dst, ldo, orow0, scale);
#pragma unroll
        for (int i = 0; i < 8; ++i) { const int p = F.tid + NTHR * i; v[i] = *(const f32x4*)(src + (size_t)(p >> 5) * ldw + (p & 31) * 4); } }
    while (blk < NB13 + NB2) {
#pragma unroll
        for (int i = 0; i < 8; ++i) { const int p = F.tid + NTHR * i; *(LAS f32x4*)(scr + (p >> 5) * CV_STR + (p & 31) * 4) = v[i]; }
        unsigned char* cdst = dst; const int cldo = ldo, corow0 = orow0; const float cscale = scale;
        blk = claim();
        if (blk < NB13 + NB2) { decode(blk, src, ldw, dst, ldo, orow0, scale);
#pragma unroll
            for (int i = 0; i < 8; ++i) { const int p = F.tid + NTHR * i; v[i] = *(const f32x4*)(src + (size_t)(p >> 5) * ldw + (p & 31) * 4); } }
        __syncthreads();
#pragma unroll
        for (int i = 0; i < 2; ++i) { const int n = F.tid & 127, kc = ((F.tid >> 7) + 4 * i) * 16;
            const LAS float* sp = scr + kc * CV_STR + n;
            v4u o; o.x = pk4_f8(sp[0] * cscale, sp[CV_STR] * cscale, sp[2 * CV_STR] * cscale, sp[3 * CV_STR] * cscale);
            o.y = pk4_f8(sp[4 * CV_STR] * cscale, sp[5 * CV_STR] * cscale, sp[6 * CV_STR] * cscale, sp[7 * CV_STR] * cscale);
            o.z = pk4_f8(sp[8 * CV_STR] * cscale, sp[9 * CV_STR] * cscale, sp[10 * CV_STR] * cscale, sp[11 * CV_STR] * cscale);
            o.w = pk4_f8(sp[12 * CV_STR] * cscale, sp[13 * CV_STR] * cscale, sp[14 * CV_STR] * cscale, sp[15 * CV_STR] * cscale);
            *(LAS v4u*)(img + n * CV_STR2 + kc) = o; }
        __syncthreads();
#pragma unroll
        for (int i = 0; i < 2; ++i) { const int p = F.tid + NTHR * i; const int n = p >> 3, pc = (p & 7) * 16;
            *(v4u*)(cdst + (size_t)(corow0 + n) * cldo + pc) = *(const LAS v4u*)(img + n * CV_STR2 + pc); }
    }
    __syncthreads();
}

DI void phase_norm_rows(const Frame& F, int mode) {
    const float* MOD = (const float*)(F.ws + WS_MOD);
    const int gw = F.bx * NWAVES + F.wave, NGW = F.G * NWAVES;
    const int nrows = mode == 0 ? MTOT : NTOK;
    const float* gain = mode == 0 ? F.in[I_NMIX] : F.in[I_NFFN];
    bf16* dst = (bf16*)(F.ws + (mode == 0 ? WS_HX : WS_HX2));
    const int sh_off = mode == 0 ? 0 : 3072, sc_off = mode == 0 ? 1024 : 4096;
    const int per = (nrows + NGW - 1) / NGW, r0 = gw * per, r1 = (r0 + per < nrows) ? r0 + per : nrows;
    f32x4 gn[4];
#pragma unroll
    for (int j = 0; j < 4; ++j) gn[j] = *(const f32x4*)(gain + 4 * F.lane + 256 * j);
    auto rowsrc = [&](int m) -> const float* {
        return (m < NTOK) ? F.in[I_X] + (size_t)m * D : F.in[I_CTX] + (size_t)(m - NTOK) * D; };
    const bf16* X1b = (const bf16*)(F.ws + WS_X1);
    auto ldrow = [&](int m, f32x4 (&v)[4]) {
        if (mode == 0) {
#pragma unroll
            for (int j = 0; j < 4; ++j) v[j] = *(const f32x4*)(rowsrc(m) + 4 * F.lane + 256 * j); }
        else {
#pragma unroll
            for (int j = 0; j < 4; ++j) { const v2u t = *(const v2u*)(X1b + (size_t)m * D + 4 * F.lane + 256 * j); v[j] = (f32x4){bflo(t.x), bfhi(t.x), bflo(t.y), bfhi(t.y)}; } } };
    f32x4 va[4], vb[4], ga[4], sb4[4]; int cur_mr = -1;
#pragma unroll
    for (int j = 0; j < 4; ++j) { ga[j] = gn[j]; sb4[j] = gn[j]; }
    if (r0 < r1) { ldrow(r0, va); ldrow((r0 + 1 < r1) ? r0 + 1 : r0, vb); }
#pragma unroll 1
    for (int m = r0; m < r1; m += 2) {
        f32x4 ca[4], cb[4];
#pragma unroll
        for (int j = 0; j < 4; ++j) { ca[j] = va[j]; cb[j] = vb[j]; }
        const bool hasb = (m + 1 < r1);
        { const int na = (m + 2 < r1) ? m + 2 : m, nb = (m + 3 < r1) ? m + 3 : na; ldrow(na, va); ldrow(nb, vb); }
        float sa = 0.f, sb = 0.f;
#pragma unroll
        for (int j = 0; j < 4; ++j) { sa += (ca[j].x * ca[j].x + ca[j].y * ca[j].y) + (ca[j].z * ca[j].z + ca[j].w * ca[j].w); sb += (cb[j].x * cb[j].x + cb[j].y * cb[j].y) + (cb[j].z * cb[j].z + cb[j].w * cb[j].w); }
        const float rsa = rsqrtf(wave_sum_fast(sa) * (1.0f / D) + EPS), rsb = rsqrtf(wave_sum_fast(sb) * (1.0f / D) + EPS);
#pragma unroll
        for (int q = 0; q < 2; ++q) {
            if (q == 1 && !hasb) break;
            const int mm = m + q; const float rs = q ? rsb : rsa;
            const int mr = (mode == 0 && mm >= NTOK) ? 16 : (mm >> 11);
            if (mr != cur_mr) { cur_mr = mr;
#pragma unroll
                for (int j = 0; j < 4; ++j) { const int c = 4 * F.lane + 256 * j;
                    ga[j] = gn[j] * (*(const f32x4*)(MOD + mr * 6144 + sc_off + c) + 1.0f); sb4[j] = *(const f32x4*)(MOD + mr * 6144 + sh_off + c); } }
#pragma unroll
            for (int j = 0; j < 4; ++j) { const int c = 4 * F.lane + 256 * j;
                const f32x4 v = q ? cb[j] : ca[j];
                const f32x4 y = (v * rs) * ga[j] + sb4[j];
                v2u w; w.x = pk2(y.x, y.y); w.y = pk2(y.z, y.w);
                *(v2u*)(dst + (size_t)mm * D + c) = w;
                if (mode == 1) *(unsigned*)(F.ws + WS_HX2F + (size_t)mm * D + c) = pk4_f8(y.x, y.y, y.z, y.w); }
        }
    }
}

constexpr int LT_STR = 520;
constexpr int L_RT = 0;
constexpr int L_GT = 69888;
static_assert(L_GT + 64 * LT_STR * 2 <= LDS_MISC, "lru lds");
template <int MODE, int dir> DI void lru_dir(const Frame& F, const int b, const int s, const int h, const int fr, const int fq, const int prow0, const bf16x8 (&Af)[4][2],
                                            const bf16* WGT, const float* SP, LAS bf16* hlb, LAS bf16* gtb, LAS bf16* GT, LAS bf16* HL) {
#pragma unroll 1
        for (int nt = 0; nt < 4; ++nt) {
            const int cj = 64 * h + 16 * nt + fr;
            bf16x8 Ba[2], Bx[2], Id[2];
#pragma unroll
            for (int ks = 0; ks < 2; ++ks) {
                Ba[ks] = *(const bf16x8*)(WGT + ((size_t)((dir * 2 + 0) * 8 + h) * 64 + 16 * nt + fr) * 64 + 32 * ks + 8 * fq);
                Bx[ks] = *(const bf16x8*)(WGT + ((size_t)((dir * 2 + 1) * 8 + h) * 64 + 16 * nt + fr) * 64 + 32 * ks + 8 * fq);
#pragma unroll
                for (int jj = 0; jj < 8; ++jj) Id[ks][jj] = (32 * ks + 8 * fq + jj == 16 * nt + fr) ? (short)0x3F80 : (short)0;
            }
            const float ba = -1.4426950408889634f * F.in[I_BA][dir * 512 + cj], bx = -1.4426950408889634f * F.in[I_BX][dir * 512 + cj], sp = SP[dir * 512 + cj];
            float cin = 0.f, ptot = 1.f;
#pragma unroll
            for (int tti = 0; tti < 4; ++tti) {
                const int tt = dir ? 3 - tti : tti;
                const bf16x8 A0 = dir ? Af[3 - tti][0] : Af[tti][0], A1 = dir ? Af[3 - tti][1] : Af[tti][1];
                f32x4 pa = {0.f, 0.f, 0.f, 0.f}, px = {0.f, 0.f, 0.f, 0.f}, uc = {0.f, 0.f, 0.f, 0.f};
                pa = __builtin_amdgcn_mfma_f32_16x16x32_bf16(A0, Ba[0], pa, 0, 0, 0); pa = __builtin_amdgcn_mfma_f32_16x16x32_bf16(A1, Ba[1], pa, 0, 0, 0);
                px = __builtin_amdgcn_mfma_f32_16x16x32_bf16(A0, Bx[0], px, 0, 0, 0); px = __builtin_amdgcn_mfma_f32_16x16x32_bf16(A1, Bx[1], px, 0, 0, 0);
                uc = __builtin_amdgcn_mfma_f32_16x16x32_bf16(A0, Id[0], uc, 0, 0, 0); uc = __builtin_amdgcn_mfma_f32_16x16x32_bf16(A1, Id[1], uc, 0, 0, 0);
                float av[4], bv[4];
#pragma unroll
                for (int ri = 0; ri < 4; ++ri) { const float pav = dir ? pa[3 - ri] : pa[ri], pxv = dir ? px[3 - ri] : px[ri], ucv = dir ? uc[3 - ri] : uc[ri];
                    const float rg = rcpf_(1.0f + ex2f_(pav + ba)), ig = rcpf_(1.0f + ex2f_(pxv + bx));
                    const float a = ex2f_(rg * sp); av[ri] = a; bv[ri] = __builtin_amdgcn_sqrtf(__builtin_fmaf(-a, a, 1.0f)) * (ig * ucv); }
                float pl = 1.f, hl = 0.f;
#pragma unroll
                for (int ri = 0; ri < 4; ++ri) { hl = av[ri] * hl + bv[ri]; pl *= av[ri]; }
                float pg[4], hg[4];
#pragma unroll
                for (int gi = 0; gi < 4; ++gi) { const int g = dir ? 3 - gi : gi; pg[gi] = __shfl(pl, fr + 16 * g); hg[gi] = __shfl(hl, fr + 16 * g); }
                const int myg = dir ? 3 - fq : fq;
                float mycin = cin, run = cin, myp = ptot, prun = ptot;
#pragma unroll
                for (int gi = 0; gi < 4; ++gi) { if (gi == myg) { mycin = run; myp = prun; } run = pg[gi] * run + hg[gi]; prun *= pg[gi]; }
                if (MODE == 1) { float hc = mycin, pc = myp;
#pragma unroll
                    for (int ri = 0; ri < 4; ++ri) { const int r = dir ? 3 - ri : ri; hc = av[ri] * hc + bv[ri]; pc *= av[ri];
                        const int o = (16 * tt + r) * LT_STR + 16 * nt;
                        hlb[o] = f2bf(dir == 0 ? hc : bf2f(hlb[o]) + hc); gtb[o] = f2bf(pc); } }
                ptot = prun;
                cin = run;
            }
            if (fq == 0) { const size_t o = ((size_t)(dir * NB + b) * NSEQT + s) * 512 + cj;
                ((float*)(F.ws + WS_SUMA))[o] = ptot; ((float*)(F.ws + WS_SUMH))[o] = cin; }
        }
        if (MODE == 1) {
            __syncthreads();
            bf16* PD = (bf16*)(F.ws + (dir ? WS_LPB : WS_LPF)); bf16* HSg = (bf16*)(F.ws + WS_LHS);
#pragma unroll
            for (int it = 0; it < 8; ++it) { const int p = F.tid + it * NTHR; const int row = p >> 6, pc = p & 63;
                *(v4u*)(PD + (size_t)(prow0 + row) * 512 + 8 * pc) = *(const LAS v4u*)(GT + row * LT_STR + 8 * pc);
                if (dir == 1) *(v4u*)(HSg + (size_t)(prow0 + row) * 512 + 8 * pc) = *(const LAS v4u*)(HL + row * LT_STR + 8 * pc); }
            __syncthreads();
        }
}
template <int MODE> DI void lru_tile(const Frame& F, int b, int s) {
    const bf16* P = (const bf16*)(F.ws + WS_P);
    const int h = F.wave, fr = F.lane & 15, fq = F.lane >> 4;
    int prow0, L, t0;
    if (s < 4) { prow0 = NTOK + b * CTXL + 64 * s; L = CTXL; t0 = 64 * s; } else { prow0 = b * SEQ + 64 * (s - 4); L = SEQ; t0 = 64 * (s - 4); }
    LAS bf16* RT = (LAS bf16*)(F.lds + L_RT); LAS bf16* GT = (LAS bf16*)(F.lds + L_GT);
#pragma unroll
    for (int it = 0; it < 9; ++it) { const int p = F.tid + it * NTHR;
        if (p < 67 * 64) { const int row = p >> 6, pc = p & 63, ts = t0 + row - 1;
            v4u v = {0u, 0u, 0u, 0u};
            if (ts >= 0 && ts < L) v = *(const v4u*)(P + (size_t)(prow0 + row - 1) * INC + 8 * pc);
            *(LAS v4u*)(RT + row * LT_STR + 8 * pc) = v; } }
    __syncthreads();
    bf16x8 Af[4][2];
#pragma unroll
    for (int ks = 0; ks < 2; ++ks) {
        const int c0 = 64 * h + 32 * ks + 8 * fq;
        float cw[4][8], cb[8];
#pragma unroll
        for (int k = 0; k < 4; ++k) { const f32x4 w0 = *(const f32x4*)(F.in[I_CONVW] + k * 512 + c0), w1 = *(const f32x4*)(F.in[I_CONVW] + k * 512 + c0 + 4);
            cw[k][0] = w0.x; cw[k][1] = w0.y; cw[k][2] = w0.z; cw[k][3] = w0.w; cw[k][4] = w1.x; cw[k][5] = w1.y; cw[k][6] = w1.z; cw[k][7] = w1.w; }
        { const f32x4 w0 = *(const f32x4*)(F.in[I_CONVB] + c0), w1 = *(const f32x4*)(F.in[I_CONVB] + c0 + 4);
            cb[0] = w0.x; cb[1] = w0.y; cb[2] = w0.z; cb[3] = w0.w; cb[4] = w1.x; cb[5] = w1.y; cb[6] = w1.z; cb[7] = w1.w; }
        const LAS bf16* rbase = RT + fr * LT_STR + c0;
#pragma unroll
        for (int tt = 0; tt < 4; ++tt) {
            float u[8];
#pragma unroll
            for (int j = 0; j < 8; ++j) u[j] = cb[j];
#pragma unroll
            for (int k = 0; k < 4; ++k) { const v4u r8 = *(const LAS v4u*)(rbase + (16 * tt + k) * LT_STR);
                u[0] += cw[k][0] * bflo(r8.x); u[1] += cw[k][1] * bfhi(r8.x); u[2] += cw[k][2] * bflo(r8.y); u[3] += cw[k][3] * bfhi(r8.y);
                u[4] += cw[k][4] * bflo(r8.z); u[5] += cw[k][5] * bfhi(r8.z); u[6] += cw[k][6] * bflo(r8.w); u[7] += cw[k][7] * bfhi(r8.w); }
            v4u w; w.x = pk2(u[0], u[1]); w.y = pk2(u[2], u[3]); w.z = pk2(u[4], u[5]); w.w = pk2(u[6], u[7]);
            Af[tt][ks] = __builtin_bit_cast(bf16x8, w);
        }
    }
    const bf16* WGT = (const bf16*)(F.ws + WS_WGT);
    const float* SP = (const float*)(F.ws + WS_TAB) + 1024;
    LAS bf16* HL = RT;
    LAS bf16* hlb = HL + (4 * fq) * LT_STR + 64 * h + fr;
    LAS bf16* gtb = GT + (4 * fq) * LT_STR + 64 * h + fr;
    lru_dir<MODE, 0>(F, b, s, h, fr, fq, prow0, Af, WGT, SP, hlb, gtb, GT, HL);
    lru_dir<MODE, 1>(F, b, s, h, fr, fq, prow0, Af, WGT, SP, hlb, gtb, GT, HL);
    __syncthreads();
}
DI void phase_lru_pass1(const Frame& F) {
    unsigned* done = (unsigned*)(F.ws + WS_CTL) + CW_LRUDONE;
    const int NL = (F.G >= 256) ? 192 : F.G;
#if defined(PROBE_SUB)
    __syncthreads(); asm volatile("" ::: "memory"); if (F.wave == 0 && PROBE_SUB == 2) ((volatile LAS unsigned long long*)(F.lds + LDS_MISC))[0] = __builtin_amdgcn_s_memrealtime(); asm volatile("" ::: "memory");
#endif
    if (F.bx < NL) {
        for (int it = F.bx; it < NB * NSEQT; it += NL) { { const int bb = it / NSEQT, ss = it % NSEQT; if (ss < 4) lru_tile<0>(F, bb, ss); else lru_tile<1>(F, bb, ss); }
            if (F.tid == 0) __hip_atomic_fetch_add(done, 1u, __ATOMIC_RELAXED, __HIP_MEMORY_SCOPE_AGENT); }
    }
#if defined(PROBE_SUB)
    __syncthreads(); asm volatile("" ::: "memory"); if (F.wave == 0 && PROBE_SUB == 2) ((volatile LAS unsigned long long*)(F.lds + LDS_MISC))[1] = __builtin_amdgcn_s_memrealtime(); asm volatile("" ::: "memory");
#endif
    if (F.G >= 256) convert_experts(F, done, (unsigned)(NB * NSEQT));
}
DI void phase_lru_carry(const Frame& F) {
    if (F.wave != 0) return;
    const float* SA = (const float*)(F.ws + WS_SUMA); const float* SH = (const float*)(F.ws + WS_SUMH); float* CI = (float*)(F.ws + WS_CIN);
    for (int id = F.bx * 64 + F.lane; id < 2 * NB * 512; id += F.G * 64) {
        const int dir = id >> 13, b = (id >> 9) & 15, c = id & 511;
        float x = 0.f; const size_t o0 = (size_t)(dir * NB + b) * NSEQT * 512 + c;
#pragma unroll
        for (int hf = 0; hf < 2; ++hf) {
            float av[18], hv[18];
#pragma unroll
            for (int q = 0; q < 18; ++q) { const int st = 18 * hf + q, s = dir ? (st < 4 ? 3 - st : 39 - st) : st; av[q] = SA[o0 + (size_t)s * 512]; hv[q] = SH[o0 + (size_t)s * 512]; }
#pragma unroll
            for (int q = 0; q < 18; ++q) { const int st = 18 * hf + q, s = dir ? (st < 4 ? 3 - st : 39 - st) : st; CI[o0 + (size_t)s * 512] = x; x = av[q] * x + hv[q]; }
        }
    }
}

constexpr int HS = 144, SCS = 40;
constexpr int H_Q = 0, H_LF = H_Q + 32 * HS * 2, H_V = H_LF + 32 * HS * 2, H_QT = H_V + 32 * HS * 2, H_KT = H_QT + 32 * HS * 2, H_KH = H_KT + 32 * HS * 2,
              H_SC = H_KH + 32 * HS * 2, H_DEC = H_SC + 32 * SCS * 2, H_SET = H_DEC + 512;
static_assert(2 * H_SET <= RING_BYTES, "hgrn lds");
typedef short s16x4 __attribute__((ext_vector_type(4)));
DI bf16x8 tr_frag(const LAS bf16* tile, int c0, int lane) {
    const int g = lane >> 4, q = (lane & 15) >> 2, p = lane & 3;
    const LAS bf16* a = tile + (8 * g + q) * HS + c0 + 4 * p;
    const s16x4 lo = __builtin_amdgcn_ds_read_tr16_b64_v4i16((LAS s16x4*)a), hi = __builtin_amdgcn_ds_read_tr16_b64_v4i16((LAS s16x4*)(a + 4 * HS));
    bf16x8 r; r[0] = lo[0]; r[1] = lo[1]; r[2] = lo[2]; r[3] = lo[3]; r[4] = hi[0]; r[5] = hi[1]; r[6] = hi[2]; r[7] = hi[3]; return r;
}
constexpr int P_QR = 0, P_LR = P_QR + 2 * 9216, P_VR = P_LR + 2 * 9216, P_QT = P_VR + 4 * 9216, P_KT = P_QT + 2 * 9216, P_KH = P_KT + 2 * 9216, P_SC = P_KH + 2 * 9216, P_DEC = P_SC + 2 * 2560, P_END = P_DEC + 2 * 512;
static_assert(P_END <= LDS_MISC, "hgrn pipelined lds");
DI void hgrn_chain2(const Frame& F, int item) {
    const int b = item >> 3, h = (item >> 1) & 3, dir = item & 1;
    const bf16* P = (const bf16*)(F.ws + WS_P);
    bf16* O = (bf16*)(F.ws + (dir ? WS_OB : WS_OF));
    const int w = F.wave, lane = F.lane, fr = lane & 15, g = lane >> 4;
    const int li = F.tid >> 4, lp = F.tid & 15;
    auto prow = [&](int c, int i) -> size_t {
        const int ii = dir ? 31 - i : i;
        if (c < 8) { const int cc = dir ? 7 - c : c; return (size_t)NTOK + b * CTXL + 32 * cc + ii; }
        const int col = dir ? 63 - (c - 8) : (c - 8); return (size_t)b * SEQ + ii * 64 + col; };
    const size_t coff = 128 * h + 8 * lp;
    v4u rqA, rlA, rvA, rqB, rlB, rvB;
    { const bf16* rp = P + prow(0, li) * INC + coff; rqA = *(const v4u*)(rp + 1024); rvA = *(const v4u*)(rp + 1536); rlA = *(const v4u*)(rp + 2048 + 512 * dir); }
    { const bf16* rp = P + prow(1, li) * INC + coff; rqB = *(const v4u*)(rp + 1024); rvB = *(const v4u*)(rp + 1536); rlB = *(const v4u*)(rp + 2048 + 512 * dir); }
    LAS unsigned char* L = F.lds;
#define HG2_W(k, U, RQ, RL, RV) do { \
        const int i = (k) - 2, wch = (k), pch = (k) - 1; (void)i; (void)pch; \
        if (wch < 72) {   \
            *(LAS v4u*)((LAS bf16*)(L + P_QR + ((U) & 1) * 9216) + li * HS + 8 * lp) = RQ; *(LAS v4u*)((LAS bf16*)(L + P_LR + ((U) & 1) * 9216) + li * HS + 8 * lp) = RL; \
            *(LAS v4u*)((LAS bf16*)(L + P_VR + (U) * 9216) + li * HS + 8 * lp) = RV; \
            if (wch + 2 < 72) { const bf16* rp = P + prow(wch + 2, li) * INC + coff; RQ = *(const v4u*)(rp + 1024); RV = *(const v4u*)(rp + 1536); RL = *(const v4u*)(rp + 2048 + 512 * dir); } } \
    } while (0)
#define HG2_PREP(k, U) do { \
        const int i = (k) - 2, wch = (k), pch = (k) - 1; (void)i; (void)pch; \
        const int pw = w - 4; \
            if (pch >= 0 && pch < 72) {   \
                const LAS bf16* Qr = (const LAS bf16*)(L + P_QR + (((U) + 1) & 1) * 9216); const LAS bf16* LFr = (const LAS bf16*)(L + P_LR + (((U) + 1) & 1) * 9216); \
                LAS bf16* QT = (LAS bf16*)(L + P_QT + (((U) + 1) & 1) * 9216); LAS bf16* KT = (LAS bf16*)(L + P_KT + (((U) + 1) & 1) * 9216); LAS bf16* KH = (LAS bf16*)(L + P_KH + (((U) + 1) & 1) * 9216); \
                LAS float* DEC = (LAS float*)(L + P_DEC + (((U) + 1) & 1) * 512); \
                _Pragma("unroll") for (int db = 0; db < 2; ++db) { const int dblk = 16 * (2 * pw + db); \
                    const bf16x8 Al = tr_frag(LFr, dblk, lane); \
                    f32x4 Gm[2]; \
                    _Pragma("unroll") for (int it = 0; it < 2; ++it) Gm[it] = __builtin_amdgcn_mfma_f32_16x16x32_bf16(Al, Tri[it], (f32x4){0.f, 0.f, 0.f, 0.f}, 0, 0, 0); \
                    f32x4 dec; \
                    _Pragma("unroll") for (int r = 0; r < 4; ++r) dec[r] = expf_(__shfl(Gm[1][r], (lane & 48) | 15)); \
                    if (fr == 0) *(LAS f32x4*)(DEC + dblk + 4 * g) = dec; \
                    _Pragma("unroll") for (int it = 0; it < 2; ++it) { const int ii = 16 * it + fr, d0 = dblk + 4 * g; \
                        const v2u q4 = *(const LAS v2u*)(Qr + ii * HS + d0), l4 = *(const LAS v2u*)(LFr + ii * HS + d0); \
                        const float qv[4] = {bflo(q4.x), bfhi(q4.x), bflo(q4.y), bfhi(q4.y)}, lv[4] = {bflo(l4.x), bfhi(l4.x), bflo(l4.y), bfhi(l4.y)}; \
                        float qt[4], kt[4], kh[4]; \
                        _Pragma("unroll") for (int r = 0; r < 4; ++r) { const float eg = expf_(Gm[it][r]), ieg = rcpf_(eg), kk = 1.0f - expf_(lv[r]); qt[r] = qv[r] * eg; kt[r] = kk * ieg; kh[r] = kk * dec[r] * ieg; } \
                        *(LAS v2u*)(QT + ii * HS + d0) = (v2u){pk2(qt[0], qt[1]), pk2(qt[2], qt[3])}; \
                        *(LAS v2u*)(KT + ii * HS + d0) = (v2u){pk2(kt[0], kt[1]), pk2(kt[2], kt[3])}; \
                        *(LAS v2u*)(KH + ii * HS + d0) = (v2u){pk2(kh[0], kh[1]), pk2(kh[2], kh[3])}; } } } \
            if (i >= 8 && i < 72) {   \
                const LAS bf16* QT = (const LAS bf16*)(L + P_QT + ((U) & 1) * 9216); const LAS bf16* KT = (const LAS bf16*)(L + P_KT + ((U) & 1) * 9216); LAS bf16* SC = (LAS bf16*)(L + P_SC + ((U) & 1) * 2560); \
                const int it = pw >> 1, jt = pw & 1; f32x4 sc = {0.f, 0.f, 0.f, 0.f}; \
                _Pragma("unroll") for (int ks = 0; ks < 4; ++ks) { const bf16x8 ak = *(const LAS bf16x8*)(KT + (16 * jt + fr) * HS + 32 * ks + 8 * g), bq = *(const LAS bf16x8*)(QT + (16 * it + fr) * HS + 32 * ks + 8 * g); \
                    sc = __builtin_amdgcn_mfma_f32_16x16x32_bf16(ak, bq, sc, 0, 0, 0); } \
                const int ii = 16 * it + fr, j0 = 16 * jt + 4 * g; \
                *(LAS v2u*)(SC + ii * SCS + j0) = (v2u){pk2(j0 <= ii ? sc[0] : 0.f, j0 + 1 <= ii ? sc[1] : 0.f), pk2(j0 + 2 <= ii ? sc[2] : 0.f, j0 + 3 <= ii ? sc[3] : 0.f)}; } \
    } while (0)
#define HG2_CORE(k, U) do { \
        const int i = (k) - 2, wch = (k), pch = (k) - 1; (void)i; (void)pch; \
            f32x4 onew[2][2]; \
            _Pragma("unroll") for (int eb = 0; eb < 2; ++eb) { onew[eb][0] = (f32x4){0.f, 0.f, 0.f, 0.f}; onew[eb][1] = (f32x4){0.f, 0.f, 0.f, 0.f}; } \
            bf16x8 Vf[2]; _Pragma("unroll") for (int eb = 0; eb < 2; ++eb) Vf[eb] = Vprev[eb]; \
            if (i >= 0 && i < 72) {   \
                const LAS bf16* QT = (const LAS bf16*)(L + P_QT + ((U) & 1) * 9216); const LAS bf16* KH = (const LAS bf16*)(L + P_KH + ((U) & 1) * 9216); \
                const LAS float* DEC = (const LAS float*)(L + P_DEC + ((U) & 1) * 512); const LAS bf16* Vr = (const LAS bf16*)(L + P_VR + (((U) + 2) & 3) * 9216); \
                if (i >= 8) {   \
                    _Pragma("unroll") for (int ks = 0; ks < 4; ++ks) { bf16x8 Bq[2]; \
                        _Pragma("unroll") for (int it = 0; it < 2; ++it) { const v2u a0 = *(const LAS v2u*)(QT + (16 * it + fr) * HS + 32 * ks + 4 * g), a1 = *(const LAS v2u*)(QT + (16 * it + fr) * HS + 32 * ks + 16 + 4 * g); \
                            v4u bv; bv.x = a0.x; bv.y = a0.y; bv.z = a1.x; bv.w = a1.y; Bq[it] = __builtin_bit_cast(bf16x8, bv); } \
                        _Pragma("unroll") for (int eb = 0; eb < 2; ++eb) { \
                            v4u sb; sb.x = pk2(S[eb][2 * ks][0], S[eb][2 * ks][1]); sb.y = pk2(S[eb][2 * ks][2], S[eb][2 * ks][3]); sb.z = pk2(S[eb][2 * ks + 1][0], S[eb][2 * ks + 1][1]); sb.w = pk2(S[eb][2 * ks + 1][2], S[eb][2 * ks + 1][3]); \
                            const bf16x8 As = __builtin_bit_cast(bf16x8, sb); \
                            _Pragma("unroll") for (int it = 0; it < 2; ++it) onew[eb][it] = __builtin_amdgcn_mfma_f32_16x16x32_bf16(As, Bq[it], onew[eb][it], 0, 0, 0); } } } \
                  \
                _Pragma("unroll") for (int eb = 0; eb < 2; ++eb) Vf[eb] = tr_frag(Vr, 16 * (2 * w + eb), lane); \
                _Pragma("unroll") for (int t = 0; t < 8; ++t) { const f32x4 dv = *(const LAS f32x4*)(DEC + 16 * t + 4 * g); const bf16x8 Kf = tr_frag(KH, 16 * t, lane); \
                    _Pragma("unroll") for (int eb = 0; eb < 2; ++eb) S[eb][t] = __builtin_amdgcn_mfma_f32_16x16x32_bf16(Kf, Vf[eb], S[eb][t] * dv, 0, 0, 0); } } \
            if (i - 1 >= 8 && i - 1 < 72) {   \
                const LAS bf16* SC = (const LAS bf16*)(L + P_SC + (((U) + 1) & 1) * 2560); \
                const int col = dir ? 63 - (i - 9) : (i - 9); \
                _Pragma("unroll") for (int it = 0; it < 2; ++it) { const bf16x8 bs = *(const LAS bf16x8*)(SC + (16 * it + fr) * SCS + 8 * g); \
                    const int ip = 16 * it + fr, ii = dir ? 31 - ip : ip; \
                    _Pragma("unroll") for (int eb = 0; eb < 2; ++eb) { const f32x4 o = __builtin_amdgcn_mfma_f32_16x16x32_bf16(Vprev[eb], bs, oprev[eb][it], 0, 0, 0); \
                        *(v2u*)(O + ((size_t)b * SEQ + ii * 64 + col) * 512 + 128 * h + 16 * (2 * w + eb) + 4 * g) = (v2u){pk2(o[0], o[1]), pk2(o[2], o[3])}; } } } \
            _Pragma("unroll") for (int eb = 0; eb < 2; ++eb) { oprev[eb][0] = onew[eb][0]; oprev[eb][1] = onew[eb][1]; Vprev[eb] = Vf[eb]; } \
    } while (0)
    if (w >= 4) {
        bf16x8 Tri[2];
#pragma unroll
        for (int it = 0; it < 2; ++it)
#pragma unroll
            for (int jj = 0; jj < 8; ++jj) Tri[it][jj] = (8 * g + jj <= 16 * it + fr) ? (short)0x3F80 : (short)0;
#pragma unroll 1
        for (int k = 0; k < 76; k += 4) {
            HG2_W(k, 0, rqA, rlA, rvA); HG2_PREP(k, 0); __syncthreads();
            HG2_W(k + 1, 1, rqB, rlB, rvB); HG2_PREP(k + 1, 1); __syncthreads();
            HG2_W(k + 2, 2, rqA, rlA, rvA); HG2_PREP(k + 2, 2); __syncthreads();
            HG2_W(k + 3, 3, rqB, rlB, rvB); HG2_PREP(k + 3, 3); __syncthreads();
        }
    } else {
        f32x4 S[2][8], oprev[2][2]; bf16x8 Vprev[2];
#pragma unroll
        for (int eb = 0; eb < 2; ++eb) {
#pragma unroll
            for (int t = 0; t < 8; ++t) S[eb][t] = (f32x4){0.f, 0.f, 0.f, 0.f};
            oprev[eb][0] = (f32x4){0.f, 0.f, 0.f, 0.f}; oprev[eb][1] = (f32x4){0.f, 0.f, 0.f, 0.f};
#pragma unroll
            for (int jj = 0; jj < 8; ++jj) Vprev[eb][jj] = 0; }
#pragma unroll 1
        for (int k = 0; k < 76; k += 4) {
            HG2_W(k, 0, rqA, rlA, rvA); HG2_CORE(k, 0); __syncthreads();
            HG2_W(k + 1, 1, rqB, rlB, rvB); HG2_CORE(k + 1, 1); __syncthreads();
            HG2_W(k + 2, 2, rqA, rlA, rvA); HG2_CORE(k + 2, 2); __syncthreads();
            HG2_W(k + 3, 3, rqB, rlB, rvB); HG2_CORE(k + 3, 3); __syncthreads();
        }
    }
#undef HG2_W
#undef HG2_PREP
#undef HG2_CORE
}
DI void phase_y2(const Frame& F) {
    const bf16* OFp = (const bf16*)(F.ws + WS_OF); const bf16* OBp = (const bf16*)(F.ws + WS_OB); const bf16* P = (const bf16*)(F.ws + WS_P); bf16* YL = (bf16*)(F.ws + WS_YL);
    const bf16* HS = (const bf16*)(F.ws + WS_LHS); const bf16* PF = (const bf16*)(F.ws + WS_LPF); const bf16* PB = (const bf16*)(F.ws + WS_LPB); const float* CIN = (const float*)(F.ws + WS_CIN);
    const int gw = F.bx * NWAVES + F.wave, NGW = F.G * NWAVES;
    const int c = 8 * F.lane;
    const f32x4 g0 = *(const f32x4*)(F.in[I_HNORM] + c), g1 = *(const f32x4*)(F.in[I_HNORM] + c + 4);
    const float gn[8] = {g0.x, g0.y, g0.z, g0.w, g1.x, g1.y, g1.z, g1.w};
    for (int m0 = gw * 16; m0 < NTOK; m0 += NGW * 16) {
        const int bb = m0 >> 11, ss = 4 + ((m0 & 2047) >> 6);
        const size_t cf = ((size_t)(0 * NB + bb) * NSEQT + ss) * 512 + c, cbk = ((size_t)(1 * NB + bb) * NSEQT + ss) * 512 + c;
        const f32x4 f0 = *(const f32x4*)(CIN + cf), f1 = *(const f32x4*)(CIN + cf + 4), b0 = *(const f32x4*)(CIN + cbk), b1 = *(const f32x4*)(CIN + cbk + 4);
        const float cfv[8] = {f0.x, f0.y, f0.z, f0.w, f1.x, f1.y, f1.z, f1.w}, cbv[8] = {b0.x, b0.y, b0.z, b0.w, b1.x, b1.y, b1.z, b1.w};
#pragma unroll 2
        for (int m = m0; m < m0 + 16; ++m) {
            const v4u hs = *(const v4u*)(HS + (size_t)m * 512 + c), pf = *(const v4u*)(PF + (size_t)m * 512 + c), pb = *(const v4u*)(PB + (size_t)m * 512 + c), rg = *(const v4u*)(P + (size_t)m * INC + 512 + c);
            const v4u a = *(const v4u*)(OFp + (size_t)m * 512 + c), bq = *(const v4u*)(OBp + (size_t)m * 512 + c), sg = *(const v4u*)(P + (size_t)m * INC + 3072 + c);
            { const unsigned hw[4] = {hs.x, hs.y, hs.z, hs.w}, fw[4] = {pf.x, pf.y, pf.z, pf.w}, bw[4] = {pb.x, pb.y, pb.z, pb.w}, rw[4] = {rg.x, rg.y, rg.z, rg.w};
                unsigned ow[4];
#pragma unroll
                for (int q = 0; q < 4; ++q) { const float lo = bflo(rw[q]) * (bflo(hw[q]) + bflo(fw[q]) * cfv[2 * q] + bflo(bw[q]) * cbv[2 * q]);
                    const float hi = bfhi(rw[q]) * (bfhi(hw[q]) + bfhi(fw[q]) * cfv[2 * q + 1] + bfhi(bw[q]) * cbv[2 * q + 1]); ow[q] = pk2(lo, hi); }
                *(v4u*)(YL + (size_t)m * D + c) = (v4u){ow[0], ow[1], ow[2], ow[3]}; }
            float o[8] = {bflo(a.x) + bflo(bq.x), bfhi(a.x) + bfhi(bq.x), bflo(a.y) + bflo(bq.y), bfhi(a.y) + bfhi(bq.y), bflo(a.z) + bflo(bq.z), bfhi(a.z) + bfhi(bq.z), bflo(a.w) + bflo(bq.w), bfhi(a.w) + bfhi(bq.w)};
            const float sgv[8] = {bflo(sg.x), bfhi(sg.x), bflo(sg.y), bfhi(sg.y), bflo(sg.z), bfhi(sg.z), bflo(sg.w), bfhi(sg.w)};
            float ssq = 0.f;
#pragma unroll
            for (int j = 0; j < 8; ++j) ssq += o[j] * o[j];
            ssq += dpp_mov_f<0xB1>(ssq); ssq += dpp_mov_f<0x4E>(ssq); ssq += dpp_mov_f<0x124>(ssq); ssq += dpp_mov_f<0x128>(ssq);
            const float rs = rsqrtf(ssq * (1.0f / 128.0f) + EPS);
#pragma unroll
            for (int j = 0; j < 8; ++j) o[j] = o[j] * rs * gn[j] * sgv[j];
            v4u wv; wv.x = pk2(o[0], o[1]); wv.y = pk2(o[2], o[3]); wv.z = pk2(o[4], o[5]); wv.w = pk2(o[6], o[7]);
            *(v4u*)(YL + (size_t)m * D + 512 + c) = wv;
        }
    }
}

DI unsigned fkey(float f) { const unsigned u = __float_as_uint(f); return u ^ ((u >> 31) ? 0xFFFFFFFFu : 0x80000000u); }
template <int CTRL> DI unsigned dpp_u(unsigned v) { return (unsigned)__builtin_amdgcn_update_dpp(0, (int)v, CTRL, 0xf, 0xf, true); }
template <int CTRL> DI float dpp_f(float v) { return __uint_as_float(dpp_u<CTRL>(__float_as_uint(v))); }
DI unsigned umax_(unsigned a, unsigned b) { return a > b ? a : b; }
DI float readlane_f(float v, int lane) { return __uint_as_float((unsigned)__builtin_amdgcn_readlane((int)__float_as_uint(v), lane)); }
DI void route_token(const f32x4 lg, const f32x4 rbv, const int l, int& myexp, float& gate) {
    const float NEG = -__builtin_inff();
    float sc[4], bs[4];
#pragma unroll
    for (int k = 0; k < 4; ++k) { sc[k] = rcpf_(1.0f + expf_(-lg[k])); bs[k] = sc[k] + rbv[k]; }
    float m1 = NEG, m2 = NEG;
#pragma unroll
    for (int k = 0; k < 4; ++k) { const float v = bs[k]; if (v > m1) { m2 = m1; m1 = v; } else if (v > m2) m2 = v; }
    { float o1 = dpp_f<0xB1>(m1), o2 = dpp_f<0xB1>(m2); float n1 = fmaxf(m1, o1), n2 = fmaxf(fminf(m1, o1), fmaxf(m2, o2)); m1 = n1; m2 = n2;
      o1 = dpp_f<0x4E>(m1); o2 = dpp_f<0x4E>(m2); n1 = fmaxf(m1, o1); n2 = fmaxf(fminf(m1, o1), fmaxf(m2, o2)); m1 = n1; m2 = n2;
      const float a1 = dpp_f<0x104>(m1), a2 = dpp_f<0x104>(m2), c1 = dpp_f<0x114>(m1), c2 = dpp_f<0x114>(m2);
      o1 = (l & 4) ? c1 : a1; o2 = (l & 4) ? c2 : a2; n1 = fmaxf(m1, o1); n2 = fmaxf(fminf(m1, o1), fmaxf(m2, o2)); m1 = n1; m2 = n2; }
    const float gs = m1 + m2; const int g = l >> 3; int rank = 0;
#pragma unroll
    for (int gg = 0; gg < 8; ++gg) { const float og = readlane_f(gs, gg * 8); rank += (og > gs || (og == gs && gg < g)) ? 1 : 0; }
    const bool sel = rank < 4;
    unsigned cv[4];
#pragma unroll
    for (int k = 0; k < 4; ++k) cv[k] = sel ? fkey(bs[k]) : 0u;
    float sum = 0.f, mysc = 0.f; myexp = 0;
#pragma unroll
    for (int r = 0; r < TOPK; ++r) {
        unsigned bvk = cv[0]; int bk = 0;
#pragma unroll
        for (int k = 1; k < 4; ++k) if (cv[k] > bvk) { bvk = cv[k]; bk = k; }
        const float bsc = bk == 0 ? sc[0] : bk == 1 ? sc[1] : bk == 2 ? sc[2] : sc[3];
        unsigned m = bvk;
        m = umax_(m, dpp_u<0xB1>(m)); m = umax_(m, dpp_u<0x4E>(m)); m = umax_(m, dpp_u<0x124>(m)); m = umax_(m, dpp_u<0x128>(m));
        const unsigned M = umax_(umax_((unsigned)__builtin_amdgcn_readlane((int)m, 0), (unsigned)__builtin_amdgcn_readlane((int)m, 16)),
                                 umax_((unsigned)__builtin_amdgcn_readlane((int)m, 32), (unsigned)__builtin_amdgcn_readlane((int)m, 48)));
        const unsigned long long bal = __ballot(bvk == M);
        const int L = __builtin_ctzll(bal);
        const int kL = __builtin_amdgcn_readlane(bk, L);
        const float se = readlane_f(bsc, L);
        const int e = 4 * L + kL;
        if (l == L) {
#pragma unroll
            for (int k = 0; k < 4; ++k) if (k == bk) cv[k] = 0u; }
        sum += se; if (l == r) { myexp = e; mysc = se; }
    }
    gate = mysc * rcpf_(sum) * 2.5f;
}
constexpr int NR_XS = 1032, NR_LS = 260, NR_HIST = 133120;
static_assert(64 * NR_XS * 2 <= NR_HIST && 64 * NR_LS * 4 <= NR_HIST && NR_HIST + 1024 <= LDS_MISC, "norm/route lds");
DI void phase_norm_route(const Frame& F) {
    const float* MOD = (const float*)(F.ws + WS_MOD); const float* gain = F.in[I_NFFN];
    const bf16* X1b = (const bf16*)(F.ws + WS_X1); const bf16* WR = (const bf16*)(F.ws + WS_WR);
    v2u* ROUTE = (v2u*)(F.ws + WS_ROUTE); int* HIST = (int*)(F.ws + WS_HIST);
    LAS bf16* XT = (LAS bf16*)F.lds; LAS float* LG = (LAS float*)F.lds; LAS unsigned* hist = (LAS unsigned*)(F.lds + NR_HIST);
    const int l = F.lane, w = F.wave, fr = l & 15, g = l >> 4;
    const f32x4 rbv = *(const f32x4*)(F.in[I_RB] + 4 * l);
    for (int blk = F.bx; blk < NTOK / 128; blk += F.G) {
        if (F.tid < 256) hist[F.tid] = 0u;
        const int b = (blk * 128) >> 11;
        f32x4 ga[4], sb4[4];
#pragma unroll
        for (int j = 0; j < 4; ++j) { const int c = 4 * l + 256 * j; ga[j] = *(const f32x4*)(gain + c) * (*(const f32x4*)(MOD + b * 6144 + 4096 + c) + 1.0f); sb4[j] = *(const f32x4*)(MOD + b * 6144 + 3072 + c); }
#pragma unroll 1
        for (int half = 0; half < 2; ++half) {
            const int tok0 = blk * 128 + half * 64;
            v2u xr[4];
#pragma unroll
            for (int j = 0; j < 4; ++j) xr[j] = *(const v2u*)(X1b + (size_t)(tok0 + 8 * w) * D + 4 * l + 256 * j);
#pragma unroll 1
            for (int rr = 0; rr < 8; ++rr) { const int row = 8 * w + rr; const size_t m = (size_t)(tok0 + row);
                f32x4 v[4]; float ss = 0.f;
#pragma unroll
                for (int j = 0; j < 4; ++j) { v[j] = (f32x4){bflo(xr[j].x), bfhi(xr[j].x), bflo(xr[j].y), bfhi(xr[j].y)}; ss += (v[j].x * v[j].x + v[j].y * v[j].y) + (v[j].z * v[j].z + v[j].w * v[j].w); }
                if (rr + 1 < 8) {
#pragma unroll
                    for (int j = 0; j < 4; ++j) xr[j] = *(const v2u*)(X1b + (m + 1) * D + 4 * l + 256 * j); }
                const float rs = rsqrtf(wave_sum_fast(ss) * (1.0f / D) + EPS);
#pragma unroll
                for (int j = 0; j < 4; ++j) { const int c = 4 * l + 256 * j; const f32x4 y = (v[j] * rs) * ga[j] + sb4[j];
                    *(LAS v2u*)(XT + row * NR_XS + c) = (v2u){pk2(y.x, y.y), pk2(y.z, y.w)};
                    *(unsigned*)(F.ws + WS_HX2F + m * D + c) = pk4_f8(y.x, y.y, y.z, y.w); } }
            __syncthreads();
            f32x4 acc[4][2];
#pragma unroll
            for (int tt = 0; tt < 4; ++tt) { acc[tt][0] = (f32x4){0.f, 0.f, 0.f, 0.f}; acc[tt][1] = (f32x4){0.f, 0.f, 0.f, 0.f}; }
            const bf16* wb0 = WR + (size_t)(32 * w + fr) * D + 8 * g; const bf16* wb1 = wb0 + (size_t)16 * D;
            bf16x8 Bq[4][4][2];
#define NR_LOAD(SET, CH) do { _Pragma("unroll") for (int q = 0; q < 4; ++q) { Bq[SET][q][0] = *(const bf16x8*)(wb0 + 32 * (4 * (CH) + q)); Bq[SET][q][1] = *(const bf16x8*)(wb1 + 32 * (4 * (CH) + q)); } } while (0)
#define NR_COMP(SET, CH) do { _Pragma("unroll") for (int q = 0; q < 4; ++q) _Pragma("unroll") for (int tt = 0; tt < 4; ++tt) { \
                const bf16x8 A = *(const LAS bf16x8*)(XT + (16 * tt + fr) * NR_XS + 32 * (4 * (CH) + q) + 8 * g); \
                acc[tt][0] = __builtin_amdgcn_mfma_f32_16x16x32_bf16(A, Bq[SET][q][0], acc[tt][0], 0, 0, 0); acc[tt][1] = __builtin_amdgcn_mfma_f32_16x16x32_bf16(A, Bq[SET][q][1], acc[tt][1], 0, 0, 0); } } while (0)
            NR_LOAD(0, 0); NR_LOAD(1, 1); NR_LOAD(2, 2);
            NR_LOAD(3, 3); NR_COMP(0, 0);
            NR_LOAD(0, 4); NR_COMP(1, 1);
            NR_LOAD(1, 5); NR_COMP(2, 2);
            NR_LOAD(2, 6); NR_COMP(3, 3);
            NR_LOAD(3, 7); NR_COMP(0, 4);
            NR_COMP(1, 5); NR_COMP(2, 6); NR_COMP(3, 7);
#undef NR_LOAD
#undef NR_COMP
            __syncthreads();
#pragma unroll
            for (int tt = 0; tt < 4; ++tt)
#pragma unroll
                for (int eb = 0; eb < 2; ++eb)
#pragma unroll
                    for (int r = 0; r < 4; ++r) LG[(16 * tt + 4 * g + r) * NR_LS + 32 * w + 16 * eb + fr] = acc[tt][eb][r];
            __syncthreads();
#pragma unroll 1
            for (int ti = 0; ti < 8; ti += 2) { const int row = 8 * w + ti, tok = tok0 + row;
                const f32x4 lgA = *(const LAS f32x4*)(LG + row * NR_LS + 4 * l), lgB = *(const LAS f32x4*)(LG + (row + 1) * NR_LS + 4 * l);
                int eA, eB; float gA, gB; route_token(lgA, rbv, l, eA, gA); route_token(lgB, rbv, l, eB, gB);
                if (l < TOPK) { ROUTE[(size_t)tok * TOPK + l] = (v2u){(unsigned)eA, __float_as_uint(gA)}; ROUTE[(size_t)(tok + 1) * TOPK + l] = (v2u){(unsigned)eB, __float_as_uint(gB)};
                    (void)__hip_atomic_fetch_add(hist + eA, 1u, __ATOMIC_RELAXED, __HIP_MEMORY_SCOPE_WORKGROUP); (void)__hip_atomic_fetch_add(hist + eB, 1u, __ATOMIC_RELAXED, __HIP_MEMORY_SCOPE_WORKGROUP); } }
            __syncthreads();
        }
        if (F.tid < 256) HIST[blk * 256 + F.tid] = (int)hist[F.tid];
        __syncthreads();
    }
}
DI void tile_starts(const Frame& F, int c, LAS int* ts) {
    const int own = (c + 255) >> 8; int incl = own;
    if (F.tid < 256) {
#pragma unroll
        for (int o = 1; o < 64; o <<= 1) { const int v = __shfl_up(incl, o); if (F.lane >= o) incl += v; }
        if (F.lane == 63) ts[257 + F.wave] = incl;
    }
    __syncthreads();
    if (F.tid < 256) { int off = 0;
#pragma unroll
        for (int w = 0; w < 3; ++w) off += (w < F.wave) ? ts[257 + w] : 0;
        ts[F.tid] = off + incl - own;
        if (F.tid == 255) ts[256] = off + incl; }
    __syncthreads();
}
DI void phase_lists(const Frame& F0) {
    Frame F = F0; asm volatile("" : "+v"(F.tid)); F.lane = F.tid & 63;
    const v2u* ROUTE = (const v2u*)(F.ws + WS_ROUTE); const int* HIST = (const int*)(F.ws + WS_HIST);
    unsigned* cnt = (unsigned*)(F.ws + WS_CTL) + CW_CNT; v2u* LIST = (v2u*)(F.ws + WS_LIST);
    LAS int* part = (LAS int*)F.lds;
    LAS int* lbase = part + 4096; LAS unsigned* lcnt = (LAS unsigned*)(lbase + 256); LAS int* lts = lbase + 768;
    int* INV = (int*)(F.ws + WS_INV);
    typedef int v4i_ __attribute__((ext_vector_type(4)));
    for (int blk = F.bx; blk < NTOK / 128; blk += F.G) {
        const int e = F.tid & 255, e4 = (F.tid & 63) * 4, g = F.tid >> 6;
        v4i_ below = (v4i_){0, 0, 0, 0}, all = (v4i_){0, 0, 0, 0};
#pragma unroll 8
        for (int q = 0; q < 32; ++q) { const int row = g * 32 + q; const v4i_ v = *(const v4i_*)(HIST + row * 256 + e4); all += v; if (row < blk) below += v; }
        *(LAS v4i_*)(part + g * 512 + e4) = below; *(LAS v4i_*)(part + g * 512 + 256 + e4) = all;
        __syncthreads();
        int tot = 0;
        if (F.tid < 256) { int b = 0;
#pragma unroll
            for (int q = 0; q < 8; ++q) { b += part[q * 512 + e]; tot += part[q * 512 + 256 + e]; }
            lbase[e] = b; lcnt[e] = 0u; if (blk == 0) cnt[e] = (unsigned)tot; }
        tile_starts(F, tot, lts);
#pragma unroll
        for (int q = 0; q < 2; ++q) { const int a = F.tid + q * NTHR; const unsigned tk = (unsigned)(blk * 128 * TOPK + a);
            const v2u rt = ROUTE[tk]; const unsigned pos = (unsigned)lbase[rt.x] + __hip_atomic_fetch_add(lcnt + rt.x, 1u, __ATOMIC_RELAXED, __HIP_MEMORY_SCOPE_WORKGROUP);
            LIST[(size_t)rt.x * LISTCAP + pos] = (v2u){tk, rt.y}; INV[tk] = lts[rt.x] * 256 + (int)pos; }
        __syncthreads();
    }
}

template <bool GATHER> DI void moe_setup(const Frame& F0, int ncol, int& nunits, int& nfull) {
    Frame F = F0; asm volatile("" : "+v"(F.tid)); F.lane = F.tid & 63;
    LAS int* ts = (LAS int*)(F.lds + LDS_TS); LAS int* cl = (LAS int*)(F.lds + LDS_CNT); LAS int* ut = (LAS int*)(F.lds + LDS_UT); LAS int* idx = (LAS int*)(F.lds + LDS_IDX);
    const unsigned* cnt = (const unsigned*)(F.ws + WS_CTL) + CW_CNT;
    int c = 0; if (F.tid < 256) { c = (int)__hip_atomic_load(cnt + F.tid, __ATOMIC_RELAXED, __HIP_MEMORY_SCOPE_AGENT); cl[F.tid] = c; }
    tile_starts(F, c, ts);
    const int Te = ts[256], T = Te + NTOK / 256;
    const int Fr = T / F.G, R = T - Fr * F.G, LU = R * ncol;
    const int nleft = (LU > F.vcu) ? (LU - F.vcu + F.G - 1) / F.G : 0;
    nfull = Fr * ncol; nunits = nfull + nleft;
    const int nj = (Fr + nleft) < 10 ? (Fr + nleft) : 10;
    if (F.tid < nj) { const int j = F.tid;
        int rt, pnl = 0;
        if (j < Fr) rt = j * F.G + F.vcu; else { const int lu = (j - Fr) * F.G + F.vcu; rt = Fr * F.G + lu / ncol; pnl = lu % ncol; }
        int e, pm, nrows;
        if (rt >= Te) { e = 256; pm = rt - Te; nrows = 256; }
        else { int lo = 0, hi = 256; while (hi - lo > 1) { const int mid = (lo + hi) >> 1; if (ts[mid] <= rt) lo = mid; else hi = mid; }
            e = lo; pm = rt - ts[lo]; const int rem = cl[lo] - pm * 256; nrows = rem < 256 ? rem : 256; }
        *(LAS v4u*)(ut + 4 * j) = (v4u){(unsigned)e, (unsigned)pm, (unsigned)rt, (unsigned)nrows | ((unsigned)pnl << 16)}; }
    __syncthreads();
    const v2u* LIST = (const v2u*)(F.ws + WS_LIST);
    v2u lv[5];
#pragma unroll
    for (int q = 0; q < 5; ++q) { const int j = 2 * q + (F.tid >> 8), r = F.tid & 255; const int jc = j < nj ? j : 0;
        const v4u t = *(const LAS v4u*)(ut + 4 * jc); const int e = (int)t.x, pm = (int)t.y, nrows = (int)(t.w & 0xffffu);
        lv[q] = LIST[(size_t)(e & 255) * LISTCAP + pm * 256 + (r < nrows ? r : 0)]; }
#pragma unroll
    for (int q = 0; q < 5; ++q) { const int j = 2 * q + (F.tid >> 8), r = F.tid & 255;
        if (j < nj) { const v4u t = *(const LAS v4u*)(ut + 4 * j); const int e = (int)t.x, pm = (int)t.y, nrows = (int)(t.w & 0xffffu);
            if (GATHER) idx[j * 256 + r] = (e == 256) ? pm * 256 + r : (r < nrows ? (int)(lv[q].x >> 3) : 0);
            else ((LAS float*)idx)[j * 256 + r] = (e == 256) ? 1.0f : (r < nrows ? __uint_as_float(lv[q].y) : 0.0f); } }
    __syncthreads();
}

DI void phase_combine(const Frame& F, int mode) {
    const float* MOD = (const float*)(F.ws + WS_MOD);
    const unsigned char* YE = F.ws + WS_YE; const int* INV = (const int*)(F.ws + WS_INV);
    int Te = 0; if (mode == 0) { const unsigned* cnt = (const unsigned*)(F.ws + WS_CTL) + CW_CNT; int t4 = 0;
#pragma unroll
        for (int q = 0; q < 4; ++q) t4 += (int)((cnt[F.lane + 64 * q] + 255u) >> 8);
#pragma unroll
        for (int o = 1; o < 64; o <<= 1) t4 += __shfl_xor(t4, o);
        Te = __builtin_amdgcn_readfirstlane(t4); }
    const int gw = F.bx * NWAVES + F.wave, NGW = F.G * NWAVES;
    const float* nf = F.in[I_NFIN];
    const int c = 16 * F.lane;
    for (int m = gw; m < NTOK; m += NGW) {
        const int b = m >> 11;
        float s[16];
#pragma unroll
        for (int q = 0; q < 16; ++q) s[q] = 0.f;
        const bf16* xsrc = (const bf16*)(F.ws + WS_X1);
        if (mode == 0) {
#pragma unroll
            for (int k = 0; k < 9; ++k) { const int row = (k < 8) ? INV[m * TOPK + k] : Te * 256 + m; const v4u w = *(const v4u*)(YE + (size_t)row * D + c);
                const unsigned ww[4] = {w.x, w.y, w.z, w.w};
#pragma unroll
                for (int q = 0; q < 4; ++q) { const f32x2 lo = __builtin_amdgcn_cvt_pk_f32_fp8((int)ww[q], false), hi = __builtin_amdgcn_cvt_pk_f32_fp8((int)ww[q], true);
                    s[4 * q] += lo.x; s[4 * q + 1] += lo.y; s[4 * q + 2] += hi.x; s[4 * q + 3] += hi.y; } } }
        float x2[16]; float ss = 0.f;
#pragma unroll
        for (int q = 0; q < 4; ++q) { const v2u xt = *(const v2u*)(xsrc + (size_t)m * D + c + 4 * q); const f32x4 xa = {bflo(xt.x), bfhi(xt.x), bflo(xt.y), bfhi(xt.y)}, ga = *(const f32x4*)(MOD + b * 6144 + 5120 + c + 4 * q);
#pragma unroll
            for (int j = 0; j < 4; ++j) { const float v = xa[j] + ga[j] * (s[4 * q + j] * 0.015625f); x2[4 * q + j] = v; ss += v * v; } }
        const float rs = rsqrtf(wave_sum(ss) * (1.0f / D) + EPS);
#pragma unroll
        for (int q = 0; q < 4; ++q) { const f32x4 na = *(const f32x4*)(nf + c + 4 * q);
            f32x4 oa = {x2[4 * q] * rs * na.x, x2[4 * q + 1] * rs * na.y, x2[4 * q + 2] * rs * na.z, x2[4 * q + 3] * rs * na.w};
            *(f32x4*)(F.out + (size_t)m * D + c + 4 * q) = oa; }
    }
}

constexpr int NPHASE = 12;
__global__ void __launch_bounds__(NTHR, 2) fwd_kernel(Args args) {
    extern __shared__ __attribute__((aligned(16))) unsigned char lds_raw[];
    Frame F;
    F.lds = (LAS unsigned char*)lds_raw;
    F.tid = threadIdx.x; F.lane = F.tid & 63; F.wave = __builtin_amdgcn_readfirstlane(F.tid >> 6);
    F.G = gridDim.x; F.bx = blockIdx.x; F.vcu = (F.G % 8 == 0) ? (F.bx % 8) * (F.G / 8) + F.bx / 8 : F.bx;
    F.in = args.in; F.out = args.out; F.ws = args.ws;
    volatile LAS unsigned* MISC = (volatile LAS unsigned*)(F.lds + LDS_MISC);
    if (F.tid < 16) MISC[F.tid] = 0u;
    __syncthreads();
    XcdBarrier bar; bar.bar = (unsigned*)(F.ws + WS_CTL) + CW_BAR; bar.x = 0; bar.st = nullptr;
#if !PER_PHASE_LAUNCH
    bar = xcd_barrier_post((unsigned*)(F.ws + WS_CTL) + CW_BAR, MISC + 8);
#define GRID_BAR() xcd_barrier(bar)
#else
#define GRID_BAR() do {} while (0)
#endif
    const int lo = args.ph_lo, hi = args.ph_hi;
#ifndef PH_MASK
#define PH_MASK 0xFFFF
#endif
#define IN(k) (((PH_MASK >> (k)) & 1) && lo <= (k) && (k) < hi)
#ifndef PROBE_PH
#define PROBE_PH -1
#endif
#ifndef PROBE_MULT
#define PROBE_MULT 4
#endif
    volatile LAS unsigned long long* PRT = (volatile LAS unsigned long long*)(F.lds + LDS_MISC);
    if (PROBE_PH == 0 && F.wave == 0) PRT[0] = __builtin_amdgcn_s_memrealtime();
#define SEAM(k) do { if (IN(k) && IN((k) + 1)) GRID_BAR(); \
        if (PROBE_PH >= 0 && F.wave == 0) { if ((k) == PROBE_PH - 1) PRT[0] = __builtin_amdgcn_s_memrealtime(); if ((k) == PROBE_PH) PRT[1] = __builtin_amdgcn_s_memrealtime(); } } while (0)
#ifndef REPEAT_MASK
#define REPEAT_MASK 0
#endif
#define REPS(k) (1 + ((REPEAT_MASK >> (k)) & 1))
    unsigned char* ws = F.ws;

    if (IN(0)) _Pragma("unroll 1") for (int rep = 0; rep < REPS(0); ++rep) { if (rep) GRID_BAR(); phase_prologue(F); } SEAM(0);
    if (IN(1)) _Pragma("unroll 1") for (int rep = 0; rep < REPS(1); ++rep) { if (rep) GRID_BAR(); phase_norm_rows(F, 0); } SEAM(1);
    if (IN(2)) _Pragma("unroll 1") for (int rep = 0; rep < REPS(2); ++rep) { if (rep) GRID_BAR();
        unsigned* done2 = (unsigned*)(ws + WS_CTL) + CW_P2DONE;
        const int G2 = (F.G >= 256) ? 224 : F.G;
        if (F.bx < G2) {
            pg8::DenseOrder S; S.init(ws + WS_HX, ws + WS_WIN, MTOT, INC, D, G2, F.bx);
            pg8::EpiInProj E{(bf16*)(ws + WS_P), (const float*)(ws + WS_TAB)};
            pg8::gemm_phase(F.lds, D, S, E, F.wave);
            if (F.tid == 0) __hip_atomic_fetch_add(done2, 1u, __ATOMIC_RELAXED, __HIP_MEMORY_SCOPE_AGENT);
        } else convert_experts(F, done2, 1u);
    } SEAM(2);
    if (IN(3)) _Pragma("unroll 1") for (int rep = 0; rep < REPS(3); ++rep) { if (rep) GRID_BAR(); phase_lru_pass1(F); } SEAM(3);
    if (IN(4)) _Pragma("unroll 1") for (int rep = 0; rep < REPS(4); ++rep) { if (rep) GRID_BAR(); phase_lru_carry(F);
#if defined(PROBE_SUB)
        if (F.wave == 0 && PROBE_SUB == 0) PRT[0] = __builtin_amdgcn_s_memrealtime();
#endif
        if (F.bx < NB * 4 * 2) hgrn_chain2(F, F.bx);
#if defined(PROBE_SUB)
        if (F.wave == 0) { if (PROBE_SUB == 0) PRT[1] = __builtin_amdgcn_s_memrealtime(); else if (PROBE_SUB == 1) PRT[0] = __builtin_amdgcn_s_memrealtime(); }
#endif
        convert_experts(F, nullptr, 0u);
#if defined(PROBE_SUB)
        if (F.wave == 0 && PROBE_SUB == 1) PRT[1] = __builtin_amdgcn_s_memrealtime();
#endif
        } SEAM(4);
    if (IN(5)) _Pragma("unroll 1") for (int rep = 0; rep < REPS(5); ++rep) { if (rep) GRID_BAR(); phase_y2(F); } SEAM(5);
    if (IN(6)) _Pragma("unroll 1") for (int rep = 0; rep < REPS(6); ++rep) { if (rep) GRID_BAR();
        pg8::DenseOrder S; S.init(ws + WS_YL, ws + WS_WOUT, NTOK, D, D, F.G, F.bx);
        pg8::EpiResid E{F.in[I_X], (const float*)(ws + WS_MOD), (bf16*)(ws + WS_X1)};
        pg8::gemm_phase(F.lds, D, S, E, F.wave);
    } SEAM(6);
    if (IN(7)) _Pragma("unroll 1") for (int rep = 0; rep < REPS(7); ++rep) { if (rep) GRID_BAR(); phase_norm_route(F); } SEAM(7);
    if (IN(8)) _Pragma("unroll 1") for (int rep = 0; rep < REPS(8); ++rep) { if (rep) GRID_BAR(); phase_lists(F); } SEAM(8);
    if (IN(9)) _Pragma("unroll 1") for (int rep = 0; rep < REPS(9); ++rep) { if (rep) GRID_BAR();
        int total, nfull; moe_setup<true>(F, 2, total, nfull);
        pg8::MoeOrder<true> S; S.A = (const char*)(ws + WS_HX2F); S.Bt = (const char*)(ws + WS_EW13); S.BtS = (const char*)(ws + WS_SW13); S.K = D / 2; S.ncol = 2; S.estride = (size_t)512 * 1024; S.dump = nullptr;
        S.ut = (const LAS int*)(F.lds + LDS_UT); S.idx = (const LAS int*)(F.lds + LDS_IDX); S.nunits = total; S.nfull = nfull;
        pg8::EpiSwiGLU8 E{ws + WS_ACT};
        pg8::gemm_phase<pg8::EpiSwiGLU8, pg8::MoeOrder<true>, false, true>(F.lds, D / 2, S, E, F.wave);
    } SEAM(9);
    if (IN(10)) _Pragma("unroll 1") for (int rep = 0; rep < REPS(10); ++rep) { if (rep) GRID_BAR();
        int total, nfull; moe_setup<false>(F, 4, total, nfull);
        pg8::MoeOrder<false> S; S.A = (const char*)(ws + WS_ACT); S.Bt = (const char*)(ws + WS_EW2); S.BtS = (const char*)(ws + WS_SW2); S.K = DE / 2; S.ncol = 4; S.estride = (size_t)1024 * 256; S.dump = (const char*)(ws + WS_CTL + 0x80000 + F.bx * 256);
        S.ut = (const LAS int*)(F.lds + LDS_UT); S.idx = (const LAS int*)(F.lds + LDS_IDX); S.nunits = total; S.nfull = nfull;
        pg8::EpiScatter E{ws + WS_YE, (const LAS float*)(F.lds + LDS_IDX), 0.5f};
#if defined(PROBE_GEMM)
        pg8::GProf gp{0ull, 0ull, 0ull};
        pg8::gemm_phase<pg8::EpiScatter, pg8::MoeOrder<false>, true, true, true>(F.lds, DE / 2, S, E, F.wave, &gp);
        if (F.wave == 0) { PRT[0] = 0ull; PRT[1] = (PROBE_GEMM == 0) ? gp.t_loop : (PROBE_GEMM == 1) ? gp.t_epi : gp.t_next; }
#else
        pg8::gemm_phase<pg8::EpiScatter, pg8::MoeOrder<false>, false, true, true>(F.lds, DE / 2, S, E, F.wave);
#endif
    } SEAM(10);
    if (IN(11)) _Pragma("unroll 1") for (int rep = 0; rep < REPS(11); ++rep) { if (rep) GRID_BAR(); phase_combine(F, 0); }
#if defined(PROBE_GEMM) || defined(PROBE_SUB)
    if (F.bx == 0 && F.wave == 0) {
#else
    if (PROBE_PH >= 0 && F.bx == 0 && F.wave == 0) {
#endif
        const unsigned long long te = __builtin_amdgcn_s_memrealtime(); if (PROBE_PH == NPHASE - 1) PRT[1] = te;
        const unsigned long long target = (unsigned long long)PROBE_MULT * (PRT[1] - PRT[0]);
        while (__builtin_amdgcn_s_memrealtime() - te < target) __builtin_amdgcn_s_sleep(20);
    }
}

extern "C" void kernel_launch(void* const* d_in, const int* in_sizes, int n_in, void* d_out, int out_size, void* d_ws, size_t ws_size, hipStream_t stream) {
    static int grid = 0;
    if (grid == 0) {
        if (n_in != 26 || in_sizes[0] != NTOK * D || out_size != NTOK * D || ws_size < WS_END) { fprintf(stderr, "kernel_launch: unexpected shapes (n_in %d, ws %zu)\n", n_in, ws_size); grid = -1; return; }
        int dev = 0, cus = 0, per_cu = 0;
        if (hipGetDevice(&dev) != hipSuccess || hipDeviceGetAttribute(&cus, hipDeviceAttributeMultiprocessorCount, dev) != hipSuccess) { grid = -1; return; }
        if (hipFuncSetAttribute((const void*)fwd_kernel, hipFuncAttributeMaxDynamicSharedMemorySize, LDS_BYTES) != hipSuccess) { fprintf(stderr, "kernel_launch: hipFuncSetAttribute failed\n"); grid = -1; return; }
        if (hipOccupancyMaxActiveBlocksPerMultiprocessor(&per_cu, (const void*)fwd_kernel, NTHR, LDS_BYTES) != hipSuccess || per_cu < 1) { fprintf(stderr, "kernel_launch: occupancy query says %d\n", per_cu); }
        (void)hipGetLastError();
        grid = cus;
        if (grid < 128) { fprintf(stderr, "kernel_launch: needs >= 128 CUs (HGRN2 chains run one per workgroup)\n"); grid = -1; return; }
    }
    if (grid < 0) return;
    hipMemsetAsync((char*)d_ws + WS_CTL, 0, CTL_ZERO_BYTES, stream);
    Args a{};
    for (int i = 0; i < 26; ++i) a.in[i] = (const float*)d_in[i];
    a.out = (float*)d_out; a.ws = (unsigned char*)d_ws;
#if PER_PHASE_LAUNCH
    for (int p = 0; p < NPHASE; ++p) { a.ph_lo = p; a.ph_hi = p + 1; hipLaunchKernelGGL(fwd_kernel, dim3(grid), dim3(NTHR), LDS_BYTES, stream, a); }
#else
    a.ph_lo = 0; a.ph_hi = NPHASE;
    hipLaunchKernelGGL(fwd_kernel, dim3(grid), dim3(NTHR), LDS_BYTES, stream, a);
#endif
}
```

```cpp
#include <hip/hip_runtime.h>
#include <cstdio>
#include <cstdint>

#ifndef PER_PHASE_LAUNCH
#define PER_PHASE_LAUNCH 0
#endif
#ifndef DBG_STOP
#define DBG_STOP 0
#endif

#define GAS __attribute__((address_space(1)))
#define LAS __attribute__((address_space(3)))
#define DI __device__ __forceinline__
typedef unsigned short bf16;
typedef unsigned v4u __attribute__((ext_vector_type(4)));
typedef unsigned v2u __attribute__((ext_vector_type(2)));
typedef float f32x4 __attribute__((ext_vector_type(4)));
typedef float f32x2 __attribute__((ext_vector_type(2)));
typedef short bf16x8 __attribute__((ext_vector_type(8)));
typedef __bf16 bfv2 __attribute__((ext_vector_type(2)));

constexpr int D = 1024, NB = 16, SEQ = 2048, CTXL = 256;
constexpr int NTOK = NB * SEQ;
constexpr int NCTX = NB * CTXL;
constexpr int MTOT = NTOK + NCTX;
constexpr int INC = 3584;
constexpr int NE = 256, TOPK = 8, DE = 256;
constexpr int LISTCAP = 32768;
constexpr float EPS = 1e-6f;
constexpr int NWAVES = 8, NTHR = 512;
constexpr int NSEQT = 36;

constexpr size_t MiB = 1u << 20;
constexpr size_t WS_CTL = 0, CTL_ZERO_BYTES = 1 * MiB;
constexpr size_t WS_MOD = 1 * MiB;
constexpr size_t WS_TAB = 2 * MiB;
constexpr size_t WS_WGT = 2 * MiB + 65536;
constexpr size_t WS_WIN = 3 * MiB;
constexpr size_t WS_WOUT = 10 * MiB;
constexpr size_t WS_WR = 12 * MiB;
constexpr size_t WS_SW13 = 12 * MiB + 512 * 1024;
constexpr size_t WS_SW2 = 13 * MiB + 512 * 1024;
constexpr size_t WS_DUMP = 2 * MiB + 16384;
constexpr size_t WS_SUMA = 14 * MiB;
constexpr size_t WS_SUMH = WS_SUMA + 2359296;
constexpr size_t WS_CIN = WS_SUMH + 2359296;
constexpr size_t WS_ROUTE = 21 * MiB;
constexpr size_t WS_HIST = 23 * MiB;
constexpr size_t WS_EW13 = 32 * MiB;
constexpr size_t WS_EW2 = 288 * MiB;
constexpr size_t WS_X1 = 416 * MiB;
constexpr size_t WS_HX2 = 544 * MiB;
constexpr size_t WS_LOGIT = 608 * MiB;
constexpr size_t WS_LIST = 1620 * MiB;
constexpr size_t WS_LHS = 674 * MiB, WS_LPF = 706 * MiB, WS_LPB = 738 * MiB;
constexpr size_t WS_ACT = 674 * MiB;
constexpr size_t WS_YS = 850 * MiB;
constexpr size_t WS_P = 914 * MiB;
constexpr size_t WS_HX = 1166 * MiB;
constexpr size_t WS_OF = 1238 * MiB;
constexpr size_t WS_OB = 1270 * MiB;
constexpr size_t WS_YL = 1302 * MiB;
constexpr size_t WS_YE = 914 * MiB;
constexpr size_t WS_INV = 24 * MiB;
constexpr size_t WS_HX2F = 1684 * MiB;
constexpr size_t WS_END = 1716 * MiB;
constexpr int CW_BAR = 4096;
constexpr int CW_CNT = 16384;
constexpr int CW_CONVQ = 20480;
constexpr int CW_P2DONE = 20608;
constexpr int CW_LRUDONE = 20544;

constexpr int RING_BYTES = 131072;
constexpr int LDS_TS = RING_BYTES;
constexpr int LDS_CNT = LDS_TS + 1088;
constexpr int LDS_UT = LDS_CNT + 1024;
constexpr int LDS_IDX = LDS_UT + 192;
constexpr int LDS_MISC = LDS_IDX + 10 * 1024;
constexpr int LDS_BYTES = 155648;
static_assert(LDS_MISC + 64 <= LDS_BYTES, "lds map");

DI unsigned pk2(float lo, float hi) { f32x2 v = {lo, hi}; bfv2 b = __builtin_convertvector(v, bfv2); return __builtin_bit_cast(unsigned, b); }
DI float clamp448(float x) { return __builtin_amdgcn_fmed3f(x, -448.0f, 448.0f); }
DI unsigned pk4_f8(float a, float b, float c, float d) {
    int w = __builtin_amdgcn_cvt_pk_fp8_f32(clamp448(a), clamp448(b), 0, false); w = __builtin_amdgcn_cvt_pk_fp8_f32(clamp448(c), clamp448(d), w, true); return (unsigned)w; }
DI float bflo(unsigned w) { return __uint_as_float(w << 16); }
DI float bfhi(unsigned w) { return __uint_as_float(w & 0xffff0000u); }
DI float bf2f(bf16 h) { return __uint_as_float(((unsigned)h) << 16); }
DI bf16 f2bf(float f) { return (bf16)(pk2(f, 0.f) & 0xffffu); }
DI float rcpf_(float x) { return __builtin_amdgcn_rcpf(x); }
DI float ex2f_(float x) { return __builtin_amdgcn_exp2f(x); }
DI float expf_(float x) { return __builtin_amdgcn_exp2f(x * 1.4426950408889634f); }
DI float logf_(float x) { return __builtin_amdgcn_logf(x) * 0.6931471805599453f; }
DI float sigm(float x) { return rcpf_(1.0f + expf_(-x)); }
DI float wave_sum(float v) {
#pragma unroll
    for (int o = 1; o < 64; o <<= 1) v += __shfl_xor(v, o);
    return v;
}
#define LDS_WAIT() asm volatile("s_waitcnt lgkmcnt(0)" ::: "memory")
template <int CTRL> DI float dpp_mov_f(float v) { return __uint_as_float((unsigned)__builtin_amdgcn_update_dpp(0, (int)__float_as_uint(v), CTRL, 0xf, 0xf, true)); }
DI float wave_sum_fast(float v) {
    v += dpp_mov_f<0xB1>(v); v += dpp_mov_f<0x4E>(v); v += dpp_mov_f<0x124>(v); v += dpp_mov_f<0x128>(v);
    const unsigned u = __float_as_uint(v);
    return (__uint_as_float((unsigned)__builtin_amdgcn_readlane((int)u, 0)) + __uint_as_float((unsigned)__builtin_amdgcn_readlane((int)u, 16)))
         + (__uint_as_float((unsigned)__builtin_amdgcn_readlane((int)u, 32)) + __uint_as_float((unsigned)__builtin_amdgcn_readlane((int)u, 48)));
}

#define XB_TMO      128
#define XB_XCNT(j)  (256  + 64 * (j))
#define XB_XSUB(j)  (1280 + 64 * (j))
#define XB_XGEN(j)  (2304 + 64 * (j))
#define XB_TOP      3328
#define XB_TOPGEN   3392
#define XCD_BAR_WORDS 3456
#define XB_SPIN_CAP (1u << 18)
__device__ __forceinline__ unsigned xb_ld(unsigned* p)              { return __hip_atomic_load(p, __ATOMIC_RELAXED, __HIP_MEMORY_SCOPE_AGENT); }
__device__ __forceinline__ unsigned xb_add(unsigned* p, unsigned v) { return __hip_atomic_fetch_add(p, v, __ATOMIC_RELAXED, __HIP_MEMORY_SCOPE_AGENT); }
__device__ __forceinline__ unsigned xb_xcc_id() { return (unsigned)__builtin_amdgcn_s_getreg((3 << 11) | 20) & 0xFu; }
#define XB_SPIN(cond, bar) do { unsigned _sp = 0; while (cond) { __builtin_amdgcn_s_sleep(1); \
    if ((++_sp & 255u) == 0u) { if (xb_ld(&(bar)[XB_TMO])) break; if (_sp > XB_SPIN_CAP) { atomicAdd(&(bar)[XB_TMO], 1u); break; } } } } while (0)
struct XcdBarrier { unsigned* bar; unsigned x; volatile LAS unsigned* st; };
__device__ __forceinline__ XcdBarrier xcd_barrier_post(unsigned* bar, volatile LAS unsigned* st) {
    XcdBarrier b; b.bar = bar; b.x = xb_xcc_id(); b.st = st;
    if (threadIdx.x == 0) (void)xb_add(&bar[XB_XCNT(b.x)], 1u);
    return b;
}
__device__ __forceinline__ void xcd_barrier_complete(unsigned* bar, unsigned x, unsigned& nloc, unsigned& nx) {
    const unsigned G = gridDim.x * gridDim.y * gridDim.z;
    unsigned sum, cnt, mine, sp = 0u;
    for (;;) {
        sum = 0u; cnt = 0u; mine = 0u;
#pragma unroll
        for (unsigned j = 0; j < 16; ++j) { const unsigned c = xb_ld(&bar[XB_XCNT(j)]); sum += c; cnt += (c > 0u) ? 1u : 0u; mine = (j == x) ? c : mine; }
        if (sum == G) break;
        __builtin_amdgcn_s_sleep(1);
        if ((++sp & 255u) == 0u) { if (xb_ld(&bar[XB_TMO])) break; if (sp > XB_SPIN_CAP) { atomicAdd(&bar[XB_TMO], 1u); break; } }
    }
    nloc = mine > 0u ? mine : 1u; nx = cnt > 0u ? cnt : 1u;
}
__device__ __forceinline__ void xcd_barrier(const XcdBarrier& b) {
    asm volatile("s_waitcnt vmcnt(0)" ::: "memory");
    __syncthreads();
    if (threadIdx.x == 0) {
        unsigned* bar = b.bar;
        __builtin_amdgcn_s_waitcnt(0);
        unsigned nloc = b.st[0], nx = b.st[1];
        if (nloc == 0u) { xcd_barrier_complete(bar, b.x, nloc, nx); b.st[0] = nloc; b.st[1] = nx; }
        const unsigned old = xb_add(&bar[XB_XSUB(b.x)], 1u);
        const unsigned gen = old / nloc;
        if (old + 1u == (gen + 1u) * nloc) {
            __builtin_amdgcn_fence(__ATOMIC_RELEASE, "agent");
            asm volatile("s_waitcnt vmcnt(0)" ::: "memory");
            const unsigned og = xb_add(&bar[XB_TOP], 1u);
            const unsigned tg = og / nx;
            if (og + 1u == (tg + 1u) * nx) xb_add(&bar[XB_TOPGEN], 1u);
            else XB_SPIN(xb_ld(&bar[XB_TOPGEN]) == tg, bar);
            __builtin_amdgcn_fence(__ATOMIC_ACQUIRE, "agent");
            xb_add(&bar[XB_XGEN(b.x)], 1u);
            asm volatile("s_waitcnt vmcnt(0)" ::: "memory");
        } else {
            XB_SPIN(xb_ld(&bar[XB_XGEN(b.x)]) == gen, bar);
            __builtin_amdgcn_fence(__ATOMIC_ACQUIRE, "agent");
            asm volatile("s_waitcnt vmcnt(0)" ::: "memory");
        }
    }
    __syncthreads();
}

namespace pg8 {
constexpr int BM = 256, BK = 64, HALF = 128, HTB = HALF * BK * 2, NXCD = 8, WGM = 8;
DI int lds_byte(int r, int c) { const int st = (r >> 4) * 2 + (c >> 5), rr = r & 15, cc = c & 31, ob = rr * 64 + cc * 2; return st * 1024 + (ob ^ (((ob >> 9) & 1) << 5)); }
DI void stage_rc(int b, int& R, int& C) { const int st = b / 1024, sb = b % 1024, swz = sb ^ (((sb >> 9) & 1) << 5); R = (st >> 1) * 16 + swz / 64; C = (st & 1) * 32 + (swz % 64) / 2; }
DI int perm32(int rho) { const int n = rho >> 4, i = rho & 15; return 8 * (i >> 2) + 4 * n + (i & 3); }

struct Unit { int pm, pn, e, rt, ord, nrows; };

struct DenseOrder {
    const char* A; const char* Bt; int K, nM, nN, nwg, G, c;
    DI void init(const void* A_, const void* Bt_, int M, int N, int K_, int G_, int c_) { A = (const char*)A_; Bt = (const char*)Bt_; K = K_; nM = M / BM; nN = N / BM; nwg = nM * nN; G = G_; c = c_; }
    DI bool next(int i, Unit& u) const {
        const long L = (long)i * G + c; if (L >= nwg) return false;
        int wgid = (int)L; { const int q = nwg / NXCD, r = nwg % NXCD, xcd = wgid % NXCD, off = wgid / NXCD; wgid = (xcd < r ? xcd * (q + 1) : r * (q + 1) + (xcd - r) * q) + off; }
        const int nig = WGM * nN, gid = wgid / nig, fm = gid * WGM, gsz = (nM - fm) < WGM ? (nM - fm) : WGM;
        u.pm = fm + ((wgid % nig) % gsz); u.pn = (wgid % nig) / gsz; u.e = 0; u.rt = u.pm; u.ord = i; u.nrows = 256; return true;
    }
    DI const char* a_base(const Unit& u) const { return A + (size_t)u.pm * BM * K * 2; }
    DI const char* b_base(const Unit& u) const { return Bt + (size_t)u.pn * BM * K * 2; }
    static constexpr bool GATHER_A = false;
    DI void a_offs(const Unit&, int tid, unsigned (&v)[2][2]) const {
#pragma unroll
        for (int i = 0; i < 2; ++i) { int R, C; stage_rc(tid * 16 + i * 8192, R, C);
#pragma unroll
            for (int h = 0; h < 2; ++h) v[h][i] = (unsigned)((h * HALF + R) * K + C) * 2u; }
    }
};

template <bool GATHER> struct MoeOrder {
    const char* A; const char* Bt; const char* BtS; int K, ncol; size_t estride; const char* dump;
    const LAS int* ut; const LAS int* idx; int nunits, nfull;
    static constexpr bool GATHER_A = GATHER;
    DI bool next(int i, Unit& u) const {
        if (i >= nunits) return false;
        int j, pn;
        if (i < nfull) { j = i / ncol; pn = i - j * ncol; } else { j = nfull / ncol + (i - nfull); pn = -1; }
        const v4u t = *(const LAS v4u*)(ut + 4 * j);
        u.ord = j; u.e = (int)t.x; u.pm = (int)t.y; u.rt = (int)t.z; u.nrows = (int)(t.w & 0xffffu); u.pn = pn >= 0 ? pn : (int)(t.w >> 16);
        return true;
    }
    DI const char* a_base(const Unit& u) const { return GATHER ? A : A + (size_t)u.rt * BM * K * 2; }
    DI const char* b_base(const Unit& u) const { return (u.e < 256 ? Bt + (size_t)u.e * estride : BtS) + (size_t)u.pn * BM * K * 2; }
    DI void a_offs(const Unit& u, int tid, unsigned (&v)[2][2]) const {
#pragma unroll
        for (int i = 0; i < 2; ++i) { int R, C; stage_rc(tid * 16 + i * 8192, R, C);
#pragma unroll
            for (int h = 0; h < 2; ++h) {
                if (GATHER) v[h][i] = ((unsigned)idx[u.ord * 256 + h * HALF + R] * (unsigned)K + (unsigned)C) * 2u;
                else v[h][i] = (unsigned)((h * HALF + R) * K + C) * 2u; } }
    }
};

struct GProf { unsigned long long t_loop, t_epi, t_next; };
typedef int v8i __attribute__((ext_vector_type(8)));
template <class Epi, class Sched, bool PROF = false, bool F8 = false, bool AKEEP = false>
__device__ __forceinline__ void gemm_phase(LAS unsigned char* lds, const int K, const Sched& S, const Epi& E, const int wid  , GProf* prof = nullptr) {
    unsigned long long pt0 = 0, pt1 = 0, pt2 = 0, pt3 = 0;
    const int tid = threadIdx.x, lane = tid & 63, wr = wid >> 2, wc = wid & 3, fr = lane & 15, fq = lane >> 4;
    const int nt = K / BK;
    unsigned voffBh[2][2];
#pragma unroll
    for (int i = 0; i < 2; ++i) { int R, C; stage_rc(tid * 16 + i * 8192, R, C);
#pragma unroll
        for (int h = 0; h < 2; ++h) { int Rb;
            if (Epi::PERM == 2) Rb = 64 * ((R >> 5) & 3) + 16 * ((R >> 2) & 3) + 8 * h + 4 * ((R >> 4) & 1) + (R & 3);
            else Rb = HALF * h + (Epi::PERM == 1 ? ((R & ~31) + perm32(R & 31)) : R);
            voffBh[h][i] = (unsigned)(Rb * K + C) * 2u; } }
    const size_t kstep = (size_t)(BK * 2);
    const size_t hstep = (size_t)HALF * K * 2;
    const unsigned ldsw = (unsigned)wid * 1024u;
    const int aoff = F8 ? lds_byte(wr * 64 + fr, fq * 16) : lds_byte(wr * 64 + fr, fq * 8), boff = F8 ? lds_byte(wc * 32 + fr, fq * 16) : lds_byte(wc * 32 + fr, fq * 8);
#define PG8_SA(b, h) (((b) * 2 + (h)) * HTB)
#define PG8_SB(b, h) ((4 + (b) * 2 + (h)) * HTB)
#define PG8_STAGE(bufoff, gbase, voff) do { _Pragma("unroll") for (int _i = 0; _i < 2; ++_i) \
        __builtin_amdgcn_global_load_lds((const unsigned*)((const char*)(gbase) + (voff)[_i]), (LAS unsigned*)(lds + (bufoff) + ldsw + _i * 8192), 16, 0, 0); } while (0)
#define PG8_STAGE_A(bufoff, gbase, voff, skip) do { if (AKEEP && (skip)) { if constexpr (AKEEP) asm volatile("global_store_byte %0, %0, %1\n\tglobal_store_byte %0, %0, %1" :: "v"(sc127), "s"(S.dump) : "memory"); } \
        else PG8_STAGE(bufoff, gbase, voff); } while (0)
#define PG8_LD8(dst, off) do { const v4u _lo = *(const LAS v4u*)(lds + (off)), _hi = *(const LAS v4u*)(lds + (off) + 16); \
        dst[0] = (int)_lo.x; dst[1] = (int)_lo.y; dst[2] = (int)_lo.z; dst[3] = (int)_lo.w; dst[4] = (int)_hi.x; dst[5] = (int)_hi.y; dst[6] = (int)_hi.z; dst[7] = (int)_hi.w; } while (0)
#define PG8_LDA(dst, b, h) do { if (F8) { _Pragma("unroll") for (int m = 0; m < 4; ++m) PG8_LD8(dst##8[m], PG8_SA(b, h) + aoff + m * 2048); } \
        else { _Pragma("unroll") for (int m = 0; m < 4; ++m) _Pragma("unroll") for (int k = 0; k < 2; ++k) dst[m][k] = *(const LAS bf16x8*)(lds + PG8_SA(b, h) + aoff + m * 2048 + k * 1024); } } while (0)
#define PG8_LDB(dst, b, h) do { if (F8) { _Pragma("unroll") for (int n = 0; n < 2; ++n) PG8_LD8(dst##8[n], PG8_SB(b, h) + boff + n * 2048); } \
        else { _Pragma("unroll") for (int n = 0; n < 2; ++n) _Pragma("unroll") for (int k = 0; k < 2; ++k) dst[n][k] = *(const LAS bf16x8*)(lds + PG8_SB(b, h) + boff + n * 2048 + k * 1024); } } while (0)
#define PG8_MMA(ai, bj, At, Bt) do { __builtin_amdgcn_s_setprio(1); \
        if (F8) { _Pragma("unroll") for (int m = 0; m < 4; ++m) _Pragma("unroll") for (int n = 0; n < 2; ++n) \
            asm volatile("v_mfma_scale_f32_16x16x128_f8f6f4 %0, %1, %2, %0, %3, %3 op_sel_hi:[0,0,0]" : "+v"(acc[ai][bj][m][n]) : "v"(Bt##8[n]), "v"(At##8[m]), "v"(sc127)); } \
        else { _Pragma("unroll") for (int m = 0; m < 4; ++m) _Pragma("unroll") for (int n = 0; n < 2; ++n) _Pragma("unroll") for (int k = 0; k < 2; ++k) \
            acc[ai][bj][m][n] = __builtin_amdgcn_mfma_f32_16x16x32_bf16(Bt[n][k], At[m][k], acc[ai][bj][m][n], 0, 0, 0); } \
        __builtin_amdgcn_s_setprio(0); } while (0)
#define PG8_WAIT_V(n) asm volatile("s_waitcnt vmcnt(" #n ")" ::: "memory")
#define PG8_WAIT_L(n) asm volatile("s_waitcnt lgkmcnt(" #n ")" ::: "memory")
#define PG8_BAR __builtin_amdgcn_s_barrier()
#define PG8_SCHED __builtin_amdgcn_sched_barrier(0)
    Unit cur, nxt; int ui = 0;
    if (!S.next(0, cur)) return;
    f32x4 acc[2][2][4][2];
#pragma unroll
    for (int a = 0; a < 2; ++a)
#pragma unroll
        for (int b = 0; b < 2; ++b)
#pragma unroll
            for (int m = 0; m < 4; ++m)
#pragma unroll
                for (int n = 0; n < 2; ++n) acc[a][b][m][n] = (f32x4){0.f, 0.f, 0.f, 0.f};
    bf16x8 At[4][2], B0[2][2], B1[2][2];
    v8i At8[4], B08[2], B18[2];
    int sc127 = 127; asm volatile("" : "+v"(sc127));
    unsigned vC[2][2], vN[2][2];
    const bool keep_ok = AKEEP && nt == 2; bool sC = false;
    S.a_offs(cur, tid, vC);
    const char* cA = S.a_base(cur); const char* cB = S.b_base(cur);
    PG8_STAGE(PG8_SB(0, 0), cB, voffBh[0]); PG8_STAGE(PG8_SA(0, 0), cA, vC[0]); PG8_STAGE(PG8_SB(0, 1), cB, voffBh[1]); PG8_STAGE(PG8_SA(0, 1), cA, vC[1]);
    if (wr == 1) PG8_BAR;
    PG8_WAIT_V(4); PG8_BAR;
    PG8_STAGE(PG8_SB(1, 0), cB + kstep, voffBh[0]); PG8_STAGE(PG8_SA(1, 0), cA + kstep, vC[0]); PG8_STAGE(PG8_SB(1, 1), cB + kstep, voffBh[1]);
    PG8_WAIT_V(6); PG8_BAR;
    for (;;) {
        if (PROF) pt0 = __builtin_amdgcn_s_memrealtime();
        const bool has_next = S.next(ui + 1, nxt);
        const char* nA = has_next ? S.a_base(nxt) : cA; const char* nB = has_next ? S.b_base(nxt) : cB;
        if (Sched::GATHER_A) { if (has_next) S.a_offs(nxt, tid, vN); else { vN[0][0] = vC[0][0]; vN[0][1] = vC[0][1]; vN[1][0] = vC[1][0]; vN[1][1] = vC[1][1]; } }
        const bool sN = keep_ok && (!has_next || nxt.ord == cur.ord);
        if (PROF) pt1 = __builtin_amdgcn_s_memrealtime();
#pragma unroll 1
        for (int t = 0; t < nt; t += 2) {
            const bool last = (t == nt - 2);
            const char* a1 = cA + (size_t)(t + 1) * kstep;
            const char* a2 = last ? nA : cA + (size_t)(t + 2) * kstep; const char* b2 = last ? nB : cB + (size_t)(t + 2) * kstep;
            const char* a3 = a2 + kstep; const char* b3 = b2 + kstep;
            unsigned x0[2], x1[2];
            if (Sched::GATHER_A) { x0[0] = last ? vN[0][0] : vC[0][0]; x0[1] = last ? vN[0][1] : vC[0][1]; x1[0] = last ? vN[1][0] : vC[1][0]; x1[1] = last ? vN[1][1] : vC[1][1]; }
            else { x0[0] = vC[0][0]; x0[1] = vC[0][1]; x1[0] = vC[1][0]; x1[1] = vC[1][1]; }
            PG8_LDB(B0, 0, 0); PG8_SCHED; PG8_LDA(At, 0, 0); PG8_STAGE_A(PG8_SA(1, 1), a1, vC[1], sC);
            PG8_WAIT_L(8); PG8_BAR; PG8_WAIT_L(0); PG8_MMA(0, 0, At, B0); PG8_WAIT_V(10); PG8_BAR; PG8_SCHED;
            PG8_LDB(B1, 0, 1); PG8_STAGE(PG8_SB(0, 0), b2, voffBh[0]);
            PG8_BAR; PG8_WAIT_L(0); PG8_MMA(0, 1, At, B1); PG8_WAIT_V(10); PG8_BAR;
            PG8_LDA(At, 0, 1); PG8_STAGE_A(PG8_SA(0, 0), a2, x0, sN);
            PG8_BAR; PG8_WAIT_L(0); PG8_MMA(1, 0, At, B0); PG8_BAR; PG8_SCHED;
            PG8_STAGE(PG8_SB(0, 1), b2, voffBh[1]);
            PG8_BAR; PG8_MMA(1, 1, At, B1); PG8_WAIT_V(10); PG8_BAR;
            PG8_LDB(B0, 1, 0); PG8_SCHED; PG8_LDA(At, 1, 0); PG8_STAGE_A(PG8_SA(0, 1), a2, x1, sN);
            PG8_WAIT_L(8); PG8_BAR; PG8_WAIT_L(0); PG8_MMA(0, 0, At, B0); PG8_WAIT_V(10); PG8_BAR; PG8_SCHED;
            PG8_LDB(B1, 1, 1); PG8_STAGE(PG8_SB(1, 0), b3, voffBh[0]);
            PG8_BAR; PG8_WAIT_L(0); PG8_MMA(0, 1, At, B1); PG8_WAIT_V(10); PG8_BAR;
            PG8_LDA(At, 1, 1); PG8_STAGE_A(PG8_SA(1, 0), a3, x0, sN);
            PG8_BAR; PG8_WAIT_L(0); PG8_MMA(1, 0, At, B0); PG8_BAR; PG8_SCHED;
            PG8_STAGE(PG8_SB(1, 1), b3, voffBh[1]);
            PG8_BAR; PG8_MMA(1, 1, At, B1); PG8_WAIT_V(10); PG8_BAR;
        }
        if (PROF) pt2 = __builtin_amdgcn_s_memrealtime();
        if (F8) asm volatile("s_nop 15\n\ts_nop 15" ::: "memory");
        E(acc, cur, wr, wc, fr, fq);
        if (PROF) { asm volatile("s_waitcnt vmcnt(0)" ::: "memory"); pt3 = __builtin_amdgcn_s_memrealtime(); prof->t_next += pt1 - pt0; prof->t_loop += pt2 - pt1; prof->t_epi += pt3 - pt2; }
        if (!has_next) break;
#pragma unroll
        for (int a = 0; a < 2; ++a)
#pragma unroll
            for (int b = 0; b < 2; ++b)
#pragma unroll
                for (int m = 0; m < 4; ++m)
#pragma unroll
                    for (int n = 0; n < 2; ++n) acc[a][b][m][n] = (f32x4){0.f, 0.f, 0.f, 0.f};
        cur = nxt; cA = nA; cB = nB; ++ui; sC = sN;
        if (Sched::GATHER_A) { vC[0][0] = vN[0][0]; vC[0][1] = vN[0][1]; vC[1][0] = vN[1][0]; vC[1][1] = vN[1][1]; }
    }
    PG8_WAIT_V(0);
    if (wr == 0) PG8_BAR;
    PG8_BAR;
#undef PG8_SA
#undef PG8_SB
#undef PG8_STAGE
#undef PG8_STAGE_A
#undef PG8_LD8
#undef PG8_LDA
#undef PG8_LDB
#undef PG8_MMA
#undef PG8_WAIT_V
#undef PG8_WAIT_L
#undef PG8_BAR
#undef PG8_SCHED
}

DI float gelu_tanh(float x) { const float u = 1.5957691216f * (x + 0.044715f * x * x * x); return x * rcpf_(1.0f + expf_(-u)); }
DI float silu_f(float x) { return x * rcpf_(1.0f + expf_(-x)); }

struct EpiInProj {
    static constexpr int PERM = 2;
    bf16* P; const float* LB;
    DI void operator()(const f32x4 (&acc)[2][2][4][2], const Unit& u, int wr, int wc, int fr, int fq) const {
        const int row0 = u.pm * BM + wr * 64 + fr, col0 = u.pn * BM + wc * 64 + 16 * fq;
        const int pn = u.pn;
        const int kind = (pn == 2 || pn == 3) ? 1 : (pn >= 8 && pn < 12) ? 2 : (pn >= 12) ? 3 : 0;
        f32x4 lbv[2][2];
        { const int dir = (pn >> 1) & 1; const int cc = (pn & 1) * 256 + wc * 64 + 16 * fq;
#pragma unroll
            for (int bj = 0; bj < 2; ++bj)
#pragma unroll
                for (int n = 0; n < 2; ++n) lbv[bj][n] = *(const f32x4*)(LB + dir * 512 + cc + 8 * bj + 4 * n);
            asm volatile("" :: "v"(lbv[0][0]), "v"(lbv[0][1]), "v"(lbv[1][0]), "v"(lbv[1][1])); }
#pragma unroll
        for (int ai = 0; ai < 2; ++ai)
#pragma unroll
            for (int m = 0; m < 4; ++m) { bf16* rowp = P + (size_t)(row0 + ai * HALF + m * 16) * INC + col0;
#pragma unroll
                for (int bj = 0; bj < 2; ++bj) { f32x4 v0 = acc[ai][bj][m][0], v1 = acc[ai][bj][m][1];
                    if (kind == 1) {
#pragma unroll
                        for (int j = 0; j < 4; ++j) { v0[j] = gelu_tanh(v0[j]); v1[j] = gelu_tanh(v1[j]); } }
                    else if (kind == 2) {
#pragma unroll
                        for (int j = 0; j < 4; ++j) { const float l0 = lbv[bj][0][j], l1 = lbv[bj][1][j];
                            v0[j] = logf_(l0 + (1.0f - l0) * sigm(v0[j])); v1[j] = logf_(l1 + (1.0f - l1) * sigm(v1[j])); } }
                    else if (kind == 3) {
#pragma unroll
                        for (int j = 0; j < 4; ++j) { v0[j] = silu_f(v0[j]); v1[j] = silu_f(v1[j]); } }
                    v4u w; w.x = pk2(v0[0], v0[1]); w.y = pk2(v0[2], v0[3]); w.z = pk2(v1[0], v1[1]); w.w = pk2(v1[2], v1[3]);
                    *(v4u*)(rowp + 8 * bj) = w; } }
    }
};
struct EpiResid {
    static constexpr int PERM = 2;
    const float* x; const float* mod; bf16* X1;
    DI void operator()(const f32x4 (&acc)[2][2][4][2], const Unit& u, int wr, int wc, int fr, int fq) const {
        const int row0 = u.pm * BM + wr * 64 + fr, col0 = u.pn * BM + wc * 64 + 16 * fq;
        const int b = (u.pm * BM) >> 11;
        f32x4 gv[2][2];
#pragma unroll
        for (int bj = 0; bj < 2; ++bj)
#pragma unroll
            for (int n = 0; n < 2; ++n) gv[bj][n] = *(const f32x4*)(mod + (size_t)b * 6144 + 2048 + col0 + 8 * bj + 4 * n);
        asm volatile("" :: "v"(gv[0][0]), "v"(gv[0][1]), "v"(gv[1][0]), "v"(gv[1][1]));
#pragma unroll
        for (int ai = 0; ai < 2; ++ai) {
            f32x4 xv[4][2][2];
#pragma unroll
            for (int m = 0; m < 4; ++m) { const size_t off = (size_t)(row0 + ai * HALF + m * 16) * D + col0;
#pragma unroll
                for (int bj = 0; bj < 2; ++bj) { xv[m][bj][0] = *(const f32x4*)(x + off + 8 * bj); xv[m][bj][1] = *(const f32x4*)(x + off + 8 * bj + 4); } }
#pragma unroll
            for (int m = 0; m < 4; ++m) { const size_t off = (size_t)(row0 + ai * HALF + m * 16) * D + col0;
#pragma unroll
                for (int bj = 0; bj < 2; ++bj) {
                    const f32x4 v0 = xv[m][bj][0] + gv[bj][0] * acc[ai][bj][m][0], v1 = xv[m][bj][1] + gv[bj][1] * acc[ai][bj][m][1];
                    v4u w; w.x = pk2(v0[0], v0[1]); w.y = pk2(v0[2], v0[3]); w.z = pk2(v1[0], v1[1]); w.w = pk2(v1[2], v1[3]);
                    *(v4u*)(X1 + off + 8 * bj) = w; } }
        }
    }
};
struct EpiF32 {
    static constexpr int PERM = 0;
    float* C; int ldc;
    DI void operator()(const f32x4 (&acc)[2][2][4][2], const Unit& u, int wr, int wc, int fr, int fq) const {
        const int row0 = u.pm * BM + wr * 64 + fr, col0 = u.pn * BM + wc * 32 + 4 * fq;
#pragma unroll
        for (int ai = 0; ai < 2; ++ai)
#pragma unroll
            for (int m = 0; m < 4; ++m) { float* rowp = C + (size_t)(row0 + ai * HALF + m * 16) * ldc + col0;
#pragma unroll
                for (int bj = 0; bj < 2; ++bj)
#pragma unroll
                    for (int n = 0; n < 2; ++n) *(f32x4*)(rowp + bj * HALF + n * 16) = acc[ai][bj][m][n]; }
    }
};
struct EpiSwiGLU8 {
    static constexpr int PERM = 1;
    unsigned char* ACT;
    DI void operator()(const f32x4 (&acc)[2][2][4][2], const Unit& u, int wr, int wc, int fr, int fq) const {
        const unsigned off0 = ((unsigned)u.rt * 256u + (unsigned)(wr * 64 + fr)) * (unsigned)DE + (unsigned)(u.pn * 128 + wc * 32 + 8 * fq);
#pragma unroll
        for (int ai = 0; ai < 2; ++ai)
#pragma unroll
            for (int m = 0; m < 4; ++m) {
                f32x4 a0 = acc[ai][0][m][0] * 0.03125f, a1 = acc[ai][0][m][1] * 0.03125f; const f32x4 g0 = acc[ai][1][m][0] * 0.25f, g1 = acc[ai][1][m][1] * 0.25f;
#pragma unroll
                for (int j = 0; j < 4; ++j) { a0[j] = silu_f(a0[j]) * g0[j]; a1[j] = silu_f(a1[j]) * g1[j]; }
                v2u w; w.x = pk4_f8(a0[0], a0[1], a0[2], a0[3]); w.y = pk4_f8(a1[0], a1[1], a1[2], a1[3]);
                *(v2u*)(ACT + (off0 + (unsigned)((ai * HALF + m * 16) * DE))) = w; }
    }
};
struct EpiSwiGLU {
    static constexpr int PERM = 1;
    bf16* ACT;
    DI void operator()(const f32x4 (&acc)[2][2][4][2], const Unit& u, int wr, int wc, int fr, int fq) const {
        const int row0 = wr * 64 + fr, col0 = u.pn * 128 + wc * 32 + 8 * fq;
        bf16* base = ACT + (size_t)u.rt * 256 * DE;
#pragma unroll
        for (int ai = 0; ai < 2; ++ai)
#pragma unroll
            for (int m = 0; m < 4; ++m) { bf16* rowp = base + (size_t)(row0 + ai * HALF + m * 16) * DE + col0;
                f32x4 a0 = acc[ai][0][m][0], a1 = acc[ai][0][m][1]; const f32x4 g0 = acc[ai][1][m][0], g1 = acc[ai][1][m][1];
#pragma unroll
                for (int j = 0; j < 4; ++j) { a0[j] = silu_f(a0[j]) * g0[j]; a1[j] = silu_f(a1[j]) * g1[j]; }
                v4u w; w.x = pk2(a0[0], a0[1]); w.y = pk2(a0[2], a0[3]); w.z = pk2(a1[0], a1[1]); w.w = pk2(a1[2], a1[3]);
                *(v4u*)rowp = w; }
    }
};
struct EpiScatter {
    static constexpr int PERM = 2;
    unsigned char* YE; const LAS float* gate; float oscale;
    DI void operator()(const f32x4 (&acc)[2][2][4][2], const Unit& u, int wr, int wc, int fr, int fq) const {
        const unsigned col0 = (unsigned)(u.pn * BM + wc * 64 + 16 * fq);
        float gt[2][4];
#pragma unroll
        for (int ai = 0; ai < 2; ++ai)
#pragma unroll
            for (int m = 0; m < 4; ++m) gt[ai][m] = gate[u.ord * 256 + ai * HALF + wr * 64 + m * 16 + fr] * oscale;
#pragma unroll
        for (int ai = 0; ai < 2; ++ai)
#pragma unroll
            for (int m = 0; m < 4; ++m) { const int r = ai * HALF + wr * 64 + m * 16 + fr; const float g = gt[ai][m];
                const unsigned row = (r < u.nrows) ? (unsigned)u.rt * 256u + (unsigned)r : 360448u;
                const f32x4 v0 = acc[ai][0][m][0] * g, v1 = acc[ai][0][m][1] * g, v2 = acc[ai][1][m][0] * g, v3 = acc[ai][1][m][1] * g;
                v4u w; w.x = pk4_f8(v0[0], v0[1], v0[2], v0[3]); w.y = pk4_f8(v1[0], v1[1], v1[2], v1[3]); w.z = pk4_f8(v2[0], v2[1], v2[2], v2[3]); w.w = pk4_f8(v3[0], v3[1], v3[2], v3[3]);
                *(v4u*)(YE + (row * (unsigned)D + col0)) = w; }
    }
};
}

struct Args { const float* in[26]; float* out; unsigned char* ws; int ph_lo, ph_hi; };
enum { I_X = 0, I_C, I_CTX, I_CCTX, I_ADAW, I_ADAB, I_NMIX, I_NFFN, I_NFIN, I_WIN, I_WOUT, I_CONVW, I_CONVB, I_WA, I_BA, I_WX, I_BX, I_LAM,
       I_LBL, I_HNORM, I_RW, I_RB, I_EW13, I_EW2, I_SW13, I_SW2 };

struct Frame {
    LAS unsigned char* lds;
    int tid, lane, wave, G, vcu, bx;
    const float* const* in; float* out; unsigned char* ws;
};

DI void transpose_item(const float* W, int ldw, bf16* WT, int ldo, int k0, int n0, int orow0, LAS float* scr, int lane) {
    const int sub = lane >> 3, c4 = (lane & 7) * 4;
    f32x4 v[8];
#pragma unroll
    for (int i = 0; i < 8; ++i) v[i] = __builtin_nontemporal_load((const f32x4*)(W + (size_t)(k0 + 8 * i + sub) * ldw + n0 + c4));
#pragma unroll
    for (int i = 0; i < 8; ++i) { LAS float* d = scr + (8 * i + sub) * 33 + c4; d[0] = v[i].x; d[1] = v[i].y; d[2] = v[i].z; d[3] = v[i].w; }
    LDS_WAIT(); asm volatile("" ::: "memory");
    const int c = lane & 7;
#pragma unroll
    for (int j = 0; j < 4; ++j) { const int n = (lane >> 3) + 8 * j; const LAS float* s = scr + (8 * c) * 33 + n;
        v4u o; o.x = pk2(s[0 * 33], s[1 * 33]); o.y = pk2(s[2 * 33], s[3 * 33]); o.z = pk2(s[4 * 33], s[5 * 33]); o.w = pk2(s[6 * 33], s[7 * 33]);
        *(v4u*)(WT + (size_t)(orow0 + n) * ldo + k0 + 8 * c) = o; }
    LDS_WAIT(); asm volatile("" ::: "memory");
}
DI void transpose_item8(const float* W, int ldw, unsigned char* WT, int ldo, int k0, int n0, int orow0, float scale, LAS float* scr, int lane) {
    const int sub = lane >> 3, c4 = (lane & 7) * 4;
    f32x4 v[16];
#pragma unroll
    for (int i = 0; i < 16; ++i) v[i] = __builtin_nontemporal_load((const f32x4*)(W + (size_t)(k0 + 8 * i + sub) * ldw + n0 + c4));
#pragma unroll
    for (int i = 0; i < 16; ++i) { LAS float* d = scr + (8 * i + sub) * 33 + c4; d[0] = v[i].x; d[1] = v[i].y; d[2] = v[i].z; d[3] = v[i].w; }
    LDS_WAIT(); asm volatile("" ::: "memory");
    const int c = lane & 7;
#pragma unroll
    for (int j = 0; j < 4; ++j) { const int n = (lane >> 3) + 8 * j; const LAS float* sp = scr + (16 * c) * 33 + n;
        v4u o; o.x = pk4_f8(sp[0] * scale, sp[33] * scale, sp[66] * scale, sp[99] * scale); o.y = pk4_f8(sp[132] * scale, sp[165] * scale, sp[198] * scale, sp[231] * scale);
        o.z = pk4_f8(sp[264] * scale, sp[297] * scale, sp[330] * scale, sp[363] * scale); o.w = pk4_f8(sp[396] * scale, sp[429] * scale, sp[462] * scale, sp[495] * scale);
        *(v4u*)(WT + (size_t)(orow0 + n) * ldo + k0 + 16 * c) = o; }
    LDS_WAIT(); asm volatile("" ::: "memory");
}
DI int w13_row(int n) { const int half = n >> 8, idx = n & 255; return 256 * (idx >> 7) + 128 * half + (idx & 127); }

DI void phase_prologue(const Frame& F) {
    const float* const* in = F.in; unsigned char* ws = F.ws;
    {
        LAS float* sc = (LAS float*)F.lds;
        LAS float* red = (LAS float*)(F.lds + 17 * 1024 * 4);
        { float cv[34];
#pragma unroll
            for (int q = 0; q < 34; ++q) { const int r = q >> 1, k = F.tid + NTHR * (q & 1); cv[q] = (r < 16) ? in[I_C][r * 1024 + k] : in[I_CCTX][k]; }
#pragma unroll
            for (int q = 0; q < 34; ++q) { const int r = q >> 1, k = F.tid + NTHR * (q & 1); sc[r * 1024 + k] = cv[q] / (1.0f + __expf(-cv[q])); } }
        __syncthreads();
        const float* aw = in[I_ADAW]; float* MOD = (float*)(ws + WS_MOD);
        for (int cg = F.bx; cg < 256; cg += F.G) {
            const int kg = F.tid >> 5, cl = F.tid & 31, col = cg * 24 + cl;
            float a[17];
#pragma unroll
            for (int r = 0; r < 17; ++r) a[r] = 0.f;
            if (cl < 24) {
#pragma unroll 1
                for (int k8 = 0; k8 < 64; k8 += 16) { float w[16];
#pragma unroll
                    for (int q = 0; q < 16; ++q) w[q] = aw[(size_t)(kg * 64 + k8 + q) * 6144 + col];
#pragma unroll
                    for (int q = 0; q < 16; ++q) { const int k = kg * 64 + k8 + q;
#pragma unroll
                        for (int r = 0; r < 17; ++r) a[r] += sc[r * 1024 + k] * w[q]; } }
#pragma unroll
                for (int r = 0; r < 17; ++r) red[(kg * 17 + r) * 24 + cl] = a[r];
            }
            __syncthreads();
            if (F.tid < 17 * 24) { const int r = F.tid / 24, c2 = F.tid % 24; float s = 0.f;
                for (int g = 0; g < 16; ++g) s += red[(g * 17 + r) * 24 + c2];
                MOD[r * 6144 + cg * 24 + c2] = s + in[I_ADAB][cg * 24 + c2]; }
            __syncthreads();
        }
    }
    {
        float* LB = (float*)(ws + WS_TAB); float* SP = LB + 1024;
        const int gt = F.bx * NTHR + F.tid, GT = F.G * NTHR;
        for (int i = gt; i < 1024; i += GT) { const int d = i >> 9, c = i & 511;
            const float l0 = in[I_LBL][(d * 2 + 0) * 512 + c], l1 = in[I_LBL][(d * 2 + 1) * 512 + c];
            LB[i] = 1.0f / (1.0f + expf(l1 - l0));
            SP[i] = -8.0f * 1.4426950408889634f * log1pf(expf(-in[I_LAM][i])); }
        bf16* WGT = (bf16*)(ws + WS_WGT);
        for (int i = gt; i < 2 * 2 * 8 * 64 * 64; i += GT) { const int ii = i & 63, j = (i >> 6) & 63, h = (i >> 12) & 7, g = (i >> 15) & 1, d = i >> 16;
            const float* src = g ? in[I_WX] : in[I_WA];
            WGT[i] = f2bf(-1.4426950408889634f * src[((size_t)(d * 8 + h) * 64 + ii) * 64 + j]); }
    }
    {
        LAS float* scr = (LAS float*)(F.lds + F.wave * 16896);
        const int gw = F.vcu * NWAVES + F.wave, NGW = F.G * NWAVES;
        constexpr int IT_WIN = 16 * 112, IT_WOUT = 16 * 32, IT_WR = 16 * 8, IT_SW13 = 8 * 16, IT_SW2 = 2 * 32;
        LAS float* scr8 = (LAS float*)(F.lds + F.wave * 16896);
        constexpr int NIT = IT_WIN + IT_WOUT + IT_WR + IT_SW13 + IT_SW2;
        for (int it = gw; it < NIT; it += NGW) {
            int r = it;
            if (r < IT_WIN) { const int kb = r / 112, nb = r % 112; transpose_item(in[I_WIN], INC, (bf16*)(ws + WS_WIN), 1024, kb * 64, nb * 32, nb * 32, scr, F.lane); continue; } r -= IT_WIN;
            if (r < IT_WOUT) { const int kb = r / 32, nb = r % 32; transpose_item(in[I_WOUT], 1024, (bf16*)(ws + WS_WOUT), 1024, kb * 64, nb * 32, nb * 32, scr, F.lane); continue; } r -= IT_WOUT;
            if (r < IT_WR) { const int kb = r / 8, nb = r % 8; transpose_item(in[I_RW], 256, (bf16*)(ws + WS_WR), 1024, kb * 64, nb * 32, nb * 32, scr, F.lane); continue; } r -= IT_WR;
            if (r < IT_SW13) { const int kb = r / 16, nb = r % 16; transpose_item8(in[I_SW13], 512, ws + WS_SW13, 1024, kb * 128, nb * 32, w13_row(nb * 32), 32.0f, scr8, F.lane); continue; } r -= IT_SW13;
            { const int kb = r / 32, nb = r % 32; transpose_item8(in[I_SW2], 1024, ws + WS_SW2, 256, kb * 128, nb * 32, nb * 32, 16.0f, scr8, F.lane); }
        }
    }
}
constexpr int CV_STR = 132, CV_B = 128 * CV_STR * 4, CV_STR2 = 144;
static_assert(CV_B + 128 * CV_STR2 <= LDS_MISC, "convert lds");
DI void convert_experts(const Frame& F, const unsigned* stop_ctr, unsigned stop_val) {
    const float* const* in = F.in; unsigned char* ws = F.ws;
    LAS float* scr = (LAS float*)F.lds; LAS unsigned char* img = F.lds + CV_B;
    volatile LAS int* slot = (volatile LAS int*)(F.lds + LDS_MISC + 48);
    unsigned* qhead = (unsigned*)(ws + WS_CTL) + CW_CONVQ;
    constexpr int NB13 = 256 * 32, NB2 = 256 * 16;
    auto decode = [&](int blk, const float*& src, int& ldw, unsigned char*& dst, int& ldo, int& orow0, float& scale) {
        if (blk < NB13) { const int e = blk >> 5, q = blk & 31, nb = q >> 3, kb = q & 7;
            src = in[I_EW13] + (size_t)e * 1024 * 512 + (size_t)(kb * 128) * 512 + nb * 128; ldw = 512;
            dst = ws + WS_EW13 + (size_t)e * 512 * 1024 + kb * 128; ldo = 1024; orow0 = w13_row(nb * 128); scale = 32.0f; }
        else { const int r = blk - NB13, e = r >> 4, q = r & 15, nb = q >> 1, kb = q & 1;
            src = in[I_EW2] + (size_t)e * 256 * 1024 + (size_t)(kb * 128) * 1024 + nb * 128; ldw = 1024;
            dst = ws + WS_EW2 + (size_t)e * 1024 * 256 + kb * 128; ldo = 256; orow0 = nb * 128; scale = 16.0f; } };
    int ch_next = 0, ch_left = 0;
    auto claim = [&]() -> int {
        if (ch_left == 0) { __syncthreads();
            if (F.tid == 0) { int v = 0x7fffffff;
                if (!stop_ctr || __hip_atomic_load(stop_ctr, __ATOMIC_RELAXED, __HIP_MEMORY_SCOPE_AGENT) < stop_val) v = (int)__hip_atomic_fetch_add(qhead, 4u, __ATOMIC_RELAXED, __HIP_MEMORY_SCOPE_AGENT);
                slot[0] = v; }
            __syncthreads(); ch_next = slot[0]; ch_left = 4; }
        const int r = ch_next; if (ch_next < 0x7ffffff0) ++ch_next; --ch_left; return r; };
    f32x4 v[8];
    int blk = claim();
    const float* src = nullptr; int ldw = 0; unsigned char* dst = nullptr; int ldo = 0, orow0 = 0; float scale = 1.f;
    if (blk < NB13 + NB2) { decode(blk, src, ldw, dst, ldo, orow0, scale);
#pragma unroll
        for (int i = 0; i < 8; ++i) { const int p = F.tid + NTHR * i; v[i] = *(const f32x4*)(src + (size_t)(p >> 5) * ldw + (p & 31) * 4); } }
    while (blk < NB13 + NB2) {
#pragma unroll
        for (int i = 0; i < 8; ++i) { const int p = F.tid + NTHR * i; *(LAS f32x4*)(scr + (p >> 5) * CV_STR + (p & 31) * 4) = v[i]; }
        unsigned char* cdst = dst; const int cldo = ldo, corow0 = orow0; const float cscale = scale;
        blk = claim();
        if (blk < NB13 + NB2) { decode(blk, src, ldw, dst, ldo, orow0, scale);
#pragma unroll
            for (int i = 0; i < 8; ++i) { const int p = F.tid + NTHR * i; v[i] = *(const f32x4*)(src + (size_t)(p >> 5) * ldw + (p & 31) * 4); } }
        __syncthreads();
#pragma unroll
        for (int i = 0; i < 2; ++i) { const int n = F.tid & 127, kc = ((F.tid >> 7) + 4 * i) * 16;
            const LAS float* sp = scr + kc * CV_STR + n;
            v4u o; o.x = pk4_f8(sp[0] * cscale, sp[CV_STR] * cscale, sp[2 * CV_STR] * cscale, sp[3 * CV_STR] * cscale);
            o.y = pk4_f8(sp[4 * CV_STR] * cscale, sp[5 * CV_STR] * cscale, sp[6 * CV_STR] * cscale, sp[7 * CV_STR] * cscale);
            o.z = pk4_f8(sp[8 * CV_STR] * cscale, sp[9 * CV_STR] * cscale, sp[10 * CV_STR] * cscale, sp[11 * CV_STR] * cscale);
            o.w = pk4_f8(sp[12 * CV_STR] * cscale, sp[13 * CV_STR] * cscale, sp[14 * CV_STR] * cscale, sp[15 * CV_STR] * cscale);
            *(LAS v4u*)(img + n * CV_STR2 + kc) = o; }
        __syncthreads();
#pragma unroll
        for (int i = 0; i < 2; ++i) { const int p = F.tid + NTHR * i; const int n = p >> 3, pc = (p & 7) * 16;
            *(v4u*)(cdst + (size_t)(corow0 + n) * cldo + pc) = *(const LAS v4u*)(img + n * CV_STR2 + pc); }
    }
    __syncthreads();
}

DI void phase_norm_rows(const Frame& F, int mode) {
    const float* MOD = (const float*)(F.ws + WS_MOD);
    const int gw = F.bx * NWAVES + F.wave, NGW = F.G * NWAVES;
    const int nrows = mode == 0 ? MTOT : NTOK;
    const float* gain = mode == 0 ? F.in[I_NMIX] : F.in[I_NFFN];
    bf16* dst = (bf16*)(F.ws + (mode == 0 ? WS_HX : WS_HX2));
    const int sh_off = mode == 0 ? 0 : 3072, sc_off = mode == 0 ? 1024 : 4096;
    const int per = (nrows + NGW - 1) / NGW, r0 = gw * per, r1 = (r0 + per < nrows) ? r0 + per : nrows;
    f32x4 gn[4];
#pragma unroll
    for (int j = 0; j < 4; ++j) gn[j] = *(const f32x4*)(gain + 4 * F.lane + 256 * j);
    auto rowsrc = [&](int m) -> const float* {
        return (m < NTOK) ? F.in[I_X] + (size_t)m * D : F.in[I_CTX] + (size_t)(m - NTOK) * D; };
    const bf16* X1b = (const bf16*)(F.ws + WS_X1);
    auto ldrow = [&](int m, f32x4 (&v)[4]) {
        if (mode == 0) {
#pragma unroll
            for (int j = 0; j < 4; ++j) v[j] = *(const f32x4*)(rowsrc(m) + 4 * F.lane + 256 * j); }
        else {
#pragma unroll
            for (int j = 0; j < 4; ++j) { const v2u t = *(const v2u*)(X1b + (size_t)m * D + 4 * F.lane + 256 * j); v[j] = (f32x4){bflo(t.x), bfhi(t.x), bflo(t.y), bfhi(t.y)}; } } };
    f32x4 va[4], vb[4], ga[4], sb4[4]; int cur_mr = -1;
#pragma unroll
    for (int j = 0; j < 4; ++j) { ga[j] = gn[j]; sb4[j] = gn[j]; }
    if (r0 < r1) { ldrow(r0, va); ldrow((r0 + 1 < r1) ? r0 + 1 : r0, vb); }
#pragma unroll 1
    for (int m = r0; m < r1; m += 2) {
        f32x4 ca[4], cb[4];
#pragma unroll
        for (int j = 0; j < 4; ++j) { ca[j] = va[j]; cb[j] = vb[j]; }
        const bool hasb = (m + 1 < r1);
        { const int na = (m + 2 < r1) ? m + 2 : m, nb = (m + 3 < r1) ? m + 3 : na; ldrow(na, va); ldrow(nb, vb); }
        float sa = 0.f, sb = 0.f;
#pragma unroll
        for (int j = 0; j < 4; ++j) { sa += (ca[j].x * ca[j].x + ca[j].y * ca[j].y) + (ca[j].z * ca[j].z + ca[j].w * ca[j].w); sb += (cb[j].x * cb[j].x + cb[j].y * cb[j].y) + (cb[j].z * cb[j].z + cb[j].w * cb[j].w); }
        const float rsa = rsqrtf(wave_sum_fast(sa) * (1.0f / D) + EPS), rsb = rsqrtf(wave_sum_fast(sb) * (1.0f / D) + EPS);
#pragma unroll
        for (int q = 0; q < 2; ++q) {
            if (q == 1 && !hasb) break;
            const int mm = m + q; const float rs = q ? rsb : rsa;
            const int mr = (mode == 0 && mm >= NTOK) ? 16 : (mm >> 11);
            if (mr != cur_mr) { cur_mr = mr;
#pragma unroll
                for (int j = 0; j < 4; ++j) { const int c = 4 * F.lane + 256 * j;
                    ga[j] = gn[j] * (*(const f32x4*)(MOD + mr * 6144 + sc_off + c) + 1.0f); sb4[j] = *(const f32x4*)(MOD + mr * 6144 + sh_off + c); } }
#pragma unroll
            for (int j = 0; j < 4; ++j) { const int c = 4 * F.lane + 256 * j;
                const f32x4 v = q ? cb[j] : ca[j];
                const f32x4 y = (v * rs) * ga[j] + sb4[j];
                v2u w; w.x = pk2(y.x, y.y); w.y = pk2(y.z, y.w);
                *(v2u*)(dst + (size_t)mm * D + c) = w;
                if (mode == 1) *(unsigned*)(F.ws + WS_HX2F + (size_t)mm * D + c) = pk4_f8(y.x, y.y, y.z, y.w); }
        }
    }
}

constexpr int LT_STR = 520;
constexpr int L_RT = 0;
constexpr int L_GT = 69888;
static_assert(L_GT + 64 * LT_STR * 2 <= LDS_MISC, "lru lds");
template <int MODE, int dir> DI void lru_dir(const Frame& F, const int b, const int s, const int h, const int fr, const int fq, const int prow0, const bf16x8 (&Af)[4][2],
                                            const bf16* WGT, const float* SP, LAS bf16* hlb, LAS bf16* gtb, LAS bf16* GT, LAS bf16* HL) {
#pragma unroll 1
        for (int nt = 0; nt < 4; ++nt) {
            const int cj = 64 * h + 16 * nt + fr;
            bf16x8 Ba[2], Bx[2], Id[2];
#pragma unroll
            for (int ks = 0; ks < 2; ++ks) {
                Ba[ks] = *(const bf16x8*)(WGT + ((size_t)((dir * 2 + 0) * 8 + h) * 64 + 16 * nt + fr) * 64 + 32 * ks + 8 * fq);
                Bx[ks] = *(const bf16x8*)(WGT + ((size_t)((dir * 2 + 1) * 8 + h) * 64 + 16 * nt + fr) * 64 + 32 * ks + 8 * fq);
#pragma unroll
                for (int jj = 0; jj < 8; ++jj) Id[ks][jj] = (32 * ks + 8 * fq + jj == 16 * nt + fr) ? (short)0x3F80 : (short)0;
            }
            const float ba = -1.4426950408889634f * F.in[I_BA][dir * 512 + cj], bx = -1.4426950408889634f * F.in[I_BX][dir * 512 + cj], sp = SP[dir * 512 + cj];
            float cin = 0.f, ptot = 1.f;
#pragma unroll
            for (int tti = 0; tti < 4; ++tti) {
                const int tt = dir ? 3 - tti : tti;
                const bf16x8 A0 = dir ? Af[3 - tti][0] : Af[tti][0], A1 = dir ? Af[3 - tti][1] : Af[tti][1];
                f32x4 pa = {0.f, 0.f, 0.f, 0.f}, px = {0.f, 0.f, 0.f, 0.f}, uc = {0.f, 0.f, 0.f, 0.f};
                pa = __builtin_amdgcn_mfma_f32_16x16x32_bf16(A0, Ba[0], pa, 0, 0, 0); pa = __builtin_amdgcn_mfma_f32_16x16x32_bf16(A1, Ba[1], pa, 0, 0, 0);
                px = __builtin_amdgcn_mfma_f32_16x16x32_bf16(A0, Bx[0], px, 0, 0, 0); px = __builtin_amdgcn_mfma_f32_16x16x32_bf16(A1, Bx[1], px, 0, 0, 0);
                uc = __builtin_amdgcn_mfma_f32_16x16x32_bf16(A0, Id[0], uc, 0, 0, 0); uc = __builtin_amdgcn_mfma_f32_16x16x32_bf16(A1, Id[1], uc, 0, 0, 0);
                float av[4], bv[4];
#pragma unroll
                for (int ri = 0; ri < 4; ++ri) { const float pav = dir ? pa[3 - ri] : pa[ri], pxv = dir ? px[3 - ri] : px[ri], ucv = dir ? uc[3 - ri] : uc[ri];
                    const float rg = rcpf_(1.0f + ex2f_(pav + ba)), ig = rcpf_(1.0f + ex2f_(pxv + bx));
                    const float a = ex2f_(rg * sp); av[ri] = a; bv[ri] = __builtin_amdgcn_sqrtf(__builtin_fmaf(-a, a, 1.0f)) * (ig * ucv); }
                float pl = 1.f, hl = 0.f;
#pragma unroll
                for (int ri = 0; ri < 4; ++ri) { hl = av[ri] * hl + bv[ri]; pl *= av[ri]; }
                float pg[4], hg[4];
#pragma unroll
                for (int gi = 0; gi < 4; ++gi) { const int g = dir ? 3 - gi : gi; pg[gi] = __shfl(pl, fr + 16 * g); hg[gi] = __shfl(hl, fr + 16 * g); }
                const int myg = dir ? 3 - fq : fq;
                float mycin = cin, run = cin, myp = ptot, prun = ptot;
#pragma unroll
                for (int gi = 0; gi < 4; ++gi) { if (gi == myg) { mycin = run; myp = prun; } run = pg[gi] * run + hg[gi]; prun *= pg[gi]; }
                if (MODE == 1) { float hc = mycin, pc = myp;
#pragma unroll
                    for (int ri = 0; ri < 4; ++ri) { const int r = dir ? 3 - ri : ri; hc = av[ri] * hc + bv[ri]; pc *= av[ri];
                        const int o = (16 * tt + r) * LT_STR + 16 * nt;
                        hlb[o] = f2bf(dir == 0 ? hc : bf2f(hlb[o]) + hc); gtb[o] = f2bf(pc); } }
                ptot = prun;
                cin = run;
            }
            if (fq == 0) { const size_t o = ((size_t)(dir * NB + b) * NSEQT + s) * 512 + cj;
                ((float*)(F.ws + WS_SUMA))[o] = ptot; ((float*)(F.ws + WS_SUMH))[o] = cin; }
        }
        if (MODE == 1) {
            __syncthreads();
            bf16* PD = (bf16*)(F.ws + (dir ? WS_LPB : WS_LPF)); bf16* HSg = (bf16*)(F.ws + WS_LHS);
#pragma unroll
            for (int it = 0; it < 8; ++it) { const int p = F.tid + it * NTHR; const int row = p >> 6, pc = p & 63;
                *(v4u*)(PD + (size_t)(prow0 + row) * 512 + 8 * pc) = *(const LAS v4u*)(GT + row * LT_STR + 8 * pc);
                if (dir == 1) *(v4u*)(HSg + (size_t)(prow0 + row) * 512 + 8 * pc) = *(const LAS v4u*)(HL + row * LT_STR + 8 * pc); }
            __syncthreads();
        }
}
template <int MODE> DI void lru_tile(const Frame& F, int b, int s) {
    const bf16* P = (const bf16*)(F.ws + WS_P);
    const int h = F.wave, fr = F.lane & 15, fq = F.lane >> 4;
    int prow0, L, t0;
    if (s < 4) { prow0 = NTOK + b * CTXL + 64 * s; L = CTXL; t0 = 64 * s; } else { prow0 = b * SEQ + 64 * (s - 4); L = SEQ; t0 = 64 * (s - 4); }
    LAS bf16* RT = (LAS bf16*)(F.lds + L_RT); LAS bf16* GT = (LAS bf16*)(F.lds + L_GT);
    { v4u sv[9];
#pragma unroll
        for (int it = 0; it < 9; ++it) { const int p = F.tid + it * NTHR; const int row = p >> 6, pc = p & 63, ts = t0 + row - 1;
            const bool ok = (p < 67 * 64) && ts >= 0 && ts < L;
            sv[it] = *(const v4u*)(P + (size_t)(prow0 + (ok ? row - 1 : 0)) * INC + 8 * pc); }
#pragma unroll
        for (int it = 0; it < 9; ++it) { const int p = F.tid + it * NTHR; const int row = p >> 6, pc = p & 63, ts = t0 + row - 1;
            const bool ok = ts >= 0 && ts < L;
            if (p < 67 * 64) *(LAS v4u*)(RT + row * LT_STR + 8 * pc) = ok ? sv[it] : (v4u){0u, 0u, 0u, 0u}; } }
    __syncthreads();
    bf16x8 Af[4][2];
#pragma unroll
    for (int ks = 0; ks < 2; ++ks) {
        const int c0 = 64 * h + 32 * ks + 8 * fq;
        float cw[4][8], cb[8];
#pragma unroll
        for (int k = 0; k < 4; ++k) { const f32x4 w0 = *(const f32x4*)(F.in[I_CONVW] + k * 512 + c0), w1 = *(const f32x4*)(F.in[I_CONVW] + k * 512 + c0 + 4);
            cw[k][0] = w0.x; cw[k][1] = w0.y; cw[k][2] = w0.z; cw[k][3] = w0.w; cw[k][4] = w1.x; cw[k][5] = w1.y; cw[k][6] = w1.z; cw[k][7] = w1.w; }
        { const f32x4 w0 = *(const f32x4*)(F.in[I_CONVB] + c0), w1 = *(const f32x4*)(F.in[I_CONVB] + c0 + 4);
            cb[0] = w0.x; cb[1] = w0.y; cb[2] = w0.z; cb[3] = w0.w; cb[4] = w1.x; cb[5] = w1.y; cb[6] = w1.z; cb[7] = w1.w; }
        const LAS bf16* rbase = RT + fr * LT_STR + c0;
#pragma unroll
        for (int tt = 0; tt < 4; ++tt) {
            float u[8];
#pragma unroll
            for (int j = 0; j < 8; ++j) u[j] = cb[j];
#pragma unroll
            for (int k = 0; k < 4; ++k) { const v4u r8 = *(const LAS v4u*)(rbase + (16 * tt + k) * LT_STR);
                u[0] += cw[k][0] * bflo(r8.x); u[1] += cw[k][1] * bfhi(r8.x); u[2] += cw[k][2] * bflo(r8.y); u[3] += cw[k][3] * bfhi(r8.y);
                u[4] += cw[k][4] * bflo(r8.z); u[5] += cw[k][5] * bfhi(r8.z); u[6] += cw[k][6] * bflo(r8.w); u[7] += cw[k][7] * bfhi(r8.w); }
            v4u w; w.x = pk2(u[0], u[1]); w.y = pk2(u[2], u[3]); w.z = pk2(u[4], u[5]); w.w = pk2(u[6], u[7]);
            Af[tt][ks] = __builtin_bit_cast(bf16x8, w);
        }
    }
    const bf16* WGT = (const bf16*)(F.ws + WS_WGT);
    const float* SP = (const float*)(F.ws + WS_TAB) + 1024;
    LAS bf16* HL = RT;
    LAS bf16* hlb = HL + (4 * fq) * LT_STR + 64 * h + fr;
    LAS bf16* gtb = GT + (4 * fq) * LT_STR + 64 * h + fr;
    lru_dir<MODE, 0>(F, b, s, h, fr, fq, prow0, Af, WGT, SP, hlb, gtb, GT, HL);
    lru_dir<MODE, 1>(F, b, s, h, fr, fq, prow0, Af, WGT, SP, hlb, gtb, GT, HL);
    __syncthreads();
}
DI void phase_lru_pass1(const Frame& F) {
    unsigned* done = (unsigned*)(F.ws + WS_CTL) + CW_LRUDONE;
    const int NL = (F.G >= 256) ? 192 : F.G;
#if defined(PROBE_SUB)
    __syncthreads(); asm volatile("" ::: "memory"); if (F.wave == 0 && PROBE_SUB == 2) ((volatile LAS unsigned long long*)(F.lds + LDS_MISC))[0] = __builtin_amdgcn_s_memrealtime(); asm volatile("" ::: "memory");
#endif
    if (F.bx < NL) {
        for (int it = F.bx; it < NB * NSEQT; it += NL) { { const int bb = it / NSEQT, ss = it % NSEQT; if (ss < 4) lru_tile<0>(F, bb, ss); else lru_tile<1>(F, bb, ss); }
            if (F.tid == 0) __hip_atomic_fetch_add(done, 1u, __ATOMIC_RELAXED, __HIP_MEMORY_SCOPE_AGENT); }
    }
#if defined(PROBE_SUB)
    __syncthreads(); asm volatile("" ::: "memory"); if (F.wave == 0 && PROBE_SUB == 2) ((volatile LAS unsigned long long*)(F.lds + LDS_MISC))[1] = __builtin_amdgcn_s_memrealtime(); asm volatile("" ::: "memory");
#endif
    if (F.G >= 256) convert_experts(F, done, (unsigned)(NB * NSEQT));
}
DI void phase_lru_carry(const Frame& F) {
    if (F.wave != 0) return;
    const float* SA = (const float*)(F.ws + WS_SUMA); const float* SH = (const float*)(F.ws + WS_SUMH); float* CI = (float*)(F.ws + WS_CIN);
    for (int id = F.bx * 64 + F.lane; id < 2 * NB * 512; id += F.G * 64) {
        const int dir = id >> 13, b = (id >> 9) & 15, c = id & 511;
        float x = 0.f; const size_t o0 = (size_t)(dir * NB + b) * NSEQT * 512 + c;
#pragma unroll
        for (int hf = 0; hf < 2; ++hf) {
            float av[18], hv[18];
#pragma unroll
            for (int q = 0; q < 18; ++q) { const int st = 18 * hf + q, s = dir ? (st < 4 ? 3 - st : 39 - st) : st; av[q] = SA[o0 + (size_t)s * 512]; hv[q] = SH[o0 + (size_t)s * 512]; }
#pragma unroll
            for (int q = 0; q < 18; ++q) { const int st = 18 * hf + q, s = dir ? (st < 4 ? 3 - st : 39 - st) : st; CI[o0 + (size_t)s * 512] = x; x = av[q] * x + hv[q]; }
        }
    }
}

constexpr int HS = 144, SCS = 40;
constexpr int H_Q = 0, H_LF = H_Q + 32 * HS * 2, H_V = H_LF + 32 * HS * 2, H_QT = H_V + 32 * HS * 2, H_KT = H_QT + 32 * HS * 2, H_KH = H_KT + 32 * HS * 2,
              H_SC = H_KH + 32 * HS * 2, H_DEC = H_SC + 32 * SCS * 2, H_SET = H_DEC + 512;
static_assert(2 * H_SET <= RING_BYTES, "hgrn lds");
typedef short s16x4 __attribute__((ext_vector_type(4)));
DI bf16x8 tr_frag(const LAS bf16* tile, int c0, int lane) {
    const int g = lane >> 4, q = (lane & 15) >> 2, p = lane & 3;
    const LAS bf16* a = tile + (8 * g + q) * HS + c0 + 4 * p;
    const s16x4 lo = __builtin_amdgcn_ds_read_tr16_b64_v4i16((LAS s16x4*)a), hi = __builtin_amdgcn_ds_read_tr16_b64_v4i16((LAS s16x4*)(a + 4 * HS));
    bf16x8 r; r[0] = lo[0]; r[1] = lo[1]; r[2] = lo[2]; r[3] = lo[3]; r[4] = hi[0]; r[5] = hi[1]; r[6] = hi[2]; r[7] = hi[3]; return r;
}
constexpr int P_QR = 0, P_LR = P_QR + 2 * 9216, P_VR = P_LR + 2 * 9216, P_QT = P_VR + 4 * 9216, P_KT = P_QT + 2 * 9216, P_KH = P_KT + 2 * 9216, P_SC = P_KH + 2 * 9216, P_DEC = P_SC + 2 * 2560, P_END = P_DEC + 2 * 512;
static_assert(P_END <= LDS_MISC, "hgrn pipelined lds");
DI void hgrn_chain2(const Frame& F, int item) {
    const int b = item >> 3, h = (item >> 1) & 3, dir = item & 1;
    const bf16* P = (const bf16*)(F.ws + WS_P);
    bf16* O = (bf16*)(F.ws + (dir ? WS_OB : WS_OF));
    const int w = F.wave, lane = F.lane, fr = lane & 15, g = lane >> 4;
    const int li = F.tid >> 4, lp = F.tid & 15;
    auto prow = [&](int c, int i) -> size_t {
        const int ii = dir ? 31 - i : i;
        if (c < 8) { const int cc = dir ? 7 - c : c; return (size_t)NTOK + b * CTXL + 32 * cc + ii; }
        const int col = dir ? 63 - (c - 8) : (c - 8); return (size_t)b * SEQ + ii * 64 + col; };
    const size_t coff = 128 * h + 8 * lp;
    v4u rqA, rlA, rvA, rqB, rlB, rvB;
    { const bf16* rp = P + prow(0, li) * INC + coff; rqA = *(const v4u*)(rp + 1024); rvA = *(const v4u*)(rp + 1536); rlA = *(const v4u*)(rp + 2048 + 512 * dir); }
    { const bf16* rp = P + prow(1, li) * INC + coff; rqB = *(const v4u*)(rp + 1024); rvB = *(const v4u*)(rp + 1536); rlB = *(const v4u*)(rp + 2048 + 512 * dir); }
    LAS unsigned char* L = F.lds;
#define HG2_W(k, U, RQ, RL, RV) do { \
        const int i = (k) - 2, wch = (k), pch = (k) - 1; (void)i; (void)pch; \
        if (wch < 72) {   \
            *(LAS v4u*)((LAS bf16*)(L + P_QR + ((U) & 1) * 9216) + li * HS + 8 * lp) = RQ; *(LAS v4u*)((LAS bf16*)(L + P_LR + ((U) & 1) * 9216) + li * HS + 8 * lp) = RL; \
            *(LAS v4u*)((LAS bf16*)(L + P_VR + (U) * 9216) + li * HS + 8 * lp) = RV; \
            if (wch + 2 < 72) { const bf16* rp = P + prow(wch + 2, li) * INC + coff; RQ = *(const v4u*)(rp + 1024); RV = *(const v4u*)(rp + 1536); RL = *(const v4u*)(rp + 2048 + 512 * dir); } } \
    } while (0)
#define HG2_PREP(k, U) do { \
        const int i = (k) - 2, wch = (k), pch = (k) - 1; (void)i; (void)pch; \
        const int pw = w - 4; \
            if (pch >= 0 && pch < 72) {   \
                const LAS bf16* Qr = (const LAS bf16*)(L + P_QR + (((U) + 1) & 1) * 9216); const LAS bf16* LFr = (const LAS bf16*)(L + P_LR + (((U) + 1) & 1) * 9216); \
                LAS bf16* QT = (LAS bf16*)(L + P_QT + (((U) + 1) & 1) * 9216); LAS bf16* KT = (LAS bf16*)(L + P_KT + (((U) + 1) & 1) * 9216); LAS bf16* KH = (LAS bf16*)(L + P_KH + (((U) + 1) & 1) * 9216); \
                LAS float* DEC = (LAS float*)(L + P_DEC + (((U) + 1) & 1) * 512); \
                _Pragma("unroll") for (int db = 0; db < 2; ++db) { const int dblk = 16 * (2 * pw + db); \
                    const bf16x8 Al = tr_frag(LFr, dblk, lane); \
                    f32x4 Gm[2]; \
                    _Pragma("unroll") for (int it = 0; it < 2; ++it) Gm[it] = __builtin_amdgcn_mfma_f32_16x16x32_bf16(Al, Tri[it], (f32x4){0.f, 0.f, 0.f, 0.f}, 0, 0, 0); \
                    f32x4 dec; \
                    _Pragma("unroll") for (int r = 0; r < 4; ++r) dec[r] = expf_(__shfl(Gm[1][r], (lane & 48) | 15)); \
                    if (fr == 0) *(LAS f32x4*)(DEC + dblk + 4 * g) = dec; \
                    _Pragma("unroll") for (int it = 0; it < 2; ++it) { const int ii = 16 * it + fr, d0 = dblk + 4 * g; \
                        const v2u q4 = *(const LAS v2u*)(Qr + ii * HS + d0), l4 = *(const LAS v2u*)(LFr + ii * HS + d0); \
                        const float qv[4] = {bflo(q4.x), bfhi(q4.x), bflo(q4.y), bfhi(q4.y)}, lv[4] = {bflo(l4.x), bfhi(l4.x), bflo(l4.y), bfhi(l4.y)}; \
                        float qt[4], kt[4], kh[4]; \
                        _Pragma("unroll") for (int r = 0; r < 4; ++r) { const float eg = expf_(Gm[it][r]), ieg = rcpf_(eg), kk = 1.0f - expf_(lv[r]); qt[r] = qv[r] * eg; kt[r] = kk * ieg; kh[r] = kk * dec[r] * ieg; } \
                        *(LAS v2u*)(QT + ii * HS + d0) = (v2u){pk2(qt[0], qt[1]), pk2(qt[2], qt[3])}; \
                        *(LAS v2u*)(KT + ii * HS + d0) = (v2u){pk2(kt[0], kt[1]), pk2(kt[2], kt[3])}; \
                        *(LAS v2u*)(KH + ii * HS + d0) = (v2u){pk2(kh[0], kh[1]), pk2(kh[2], kh[3])}; } } } \
            if (i >= 8 && i < 72) {   \
                const LAS bf16* QT = (const LAS bf16*)(L + P_QT + ((U) & 1) * 9216); const LAS bf16* KT = (const LAS bf16*)(L + P_KT + ((U) & 1) * 9216); LAS bf16* SC = (LAS bf16*)(L + P_SC + ((U) & 1) * 2560); \
                const int it = pw >> 1, jt = pw & 1; f32x4 sc = {0.f, 0.f, 0.f, 0.f}; \
                _Pragma("unroll") for (int ks = 0; ks < 4; ++ks) { const bf16x8 ak = *(const LAS bf16x8*)(KT + (16 * jt + fr) * HS + 32 * ks + 8 * g), bq = *(const LAS bf16x8*)(QT + (16 * it + fr) * HS + 32 * ks + 8 * g); \
                    sc = __builtin_amdgcn_mfma_f32_16x16x32_bf16(ak, bq, sc, 0, 0, 0); } \
                const int ii = 16 * it + fr, j0 = 16 * jt + 4 * g; \
                *(LAS v2u*)(SC + ii * SCS + j0) = (v2u){pk2(j0 <= ii ? sc[0] : 0.f, j0 + 1 <= ii ? sc[1] : 0.f), pk2(j0 + 2 <= ii ? sc[2] : 0.f, j0 + 3 <= ii ? sc[3] : 0.f)}; } \
    } while (0)
#define HG2_CORE(k, U) do { \
        const int i = (k) - 2, wch = (k), pch = (k) - 1; (void)i; (void)pch; \
            f32x4 onew[2][2]; \
            _Pragma("unroll") for (int eb = 0; eb < 2; ++eb) { onew[eb][0] = (f32x4){0.f, 0.f, 0.f, 0.f}; onew[eb][1] = (f32x4){0.f, 0.f, 0.f, 0.f}; } \
            bf16x8 Vf[2]; _Pragma("unroll") for (int eb = 0; eb < 2; ++eb) Vf[eb] = Vprev[eb]; \
            if (i >= 0 && i < 72) {   \
                const LAS bf16* QT = (const LAS bf16*)(L + P_QT + ((U) & 1) * 9216); const LAS bf16* KH = (const LAS bf16*)(L + P_KH + ((U) & 1) * 9216); \
                const LAS float* DEC = (const LAS float*)(L + P_DEC + ((U) & 1) * 512); const LAS bf16* Vr = (const LAS bf16*)(L + P_VR + (((U) + 2) & 3) * 9216); \
                if (i >= 8) {   \
                    _Pragma("unroll") for (int ks = 0; ks < 4; ++ks) { bf16x8 Bq[2]; \
                        _Pragma("unroll") for (int it = 0; it < 2; ++it) { const v2u a0 = *(const LAS v2u*)(QT + (16 * it + fr) * HS + 32 * ks + 4 * g), a1 = *(const LAS v2u*)(QT + (16 * it + fr) * HS + 32 * ks + 16 + 4 * g); \
                            v4u bv; bv.x = a0.x; bv.y = a0.y; bv.z = a1.x; bv.w = a1.y; Bq[it] = __builtin_bit_cast(bf16x8, bv); } \
                        _Pragma("unroll") for (int eb = 0; eb < 2; ++eb) { \
                            v4u sb; sb.x = pk2(S[eb][2 * ks][0], S[eb][2 * ks][1]); sb.y = pk2(S[eb][2 * ks][2], S[eb][2 * ks][3]); sb.z = pk2(S[eb][2 * ks + 1][0], S[eb][2 * ks + 1][1]); sb.w = pk2(S[eb][2 * ks + 1][2], S[eb][2 * ks + 1][3]); \
                            const bf16x8 As = __builtin_bit_cast(bf16x8, sb); \
                            _Pragma("unroll") for (int it = 0; it < 2; ++it) onew[eb][it] = __builtin_amdgcn_mfma_f32_16x16x32_bf16(As, Bq[it], onew[eb][it], 0, 0, 0); } } } \
                  \
                _Pragma("unroll") for (int eb = 0; eb < 2; ++eb) Vf[eb] = tr_frag(Vr, 16 * (2 * w + eb), lane); \
                _Pragma("unroll") for (int t = 0; t < 8; ++t) { const f32x4 dv = *(const LAS f32x4*)(DEC + 16 * t + 4 * g); const bf16x8 Kf = tr_frag(KH, 16 * t, lane); \
                    _Pragma("unroll") for (int eb = 0; eb < 2; ++eb) S[eb][t] = __builtin_amdgcn_mfma_f32_16x16x32_bf16(Kf, Vf[eb], S[eb][t] * dv, 0, 0, 0); } } \
            if (i - 1 >= 8 && i - 1 < 72) {   \
                const LAS bf16* SC = (const LAS bf16*)(L + P_SC + (((U) + 1) & 1) * 2560); \
                const int col = dir ? 63 - (i - 9) : (i - 9); \
                _Pragma("unroll") for (int it = 0; it < 2; ++it) { const bf16x8 bs = *(const LAS bf16x8*)(SC + (16 * it + fr) * SCS + 8 * g); \
                    const int ip = 16 * it + fr, ii = dir ? 31 - ip : ip; \
                    _Pragma("unroll") for (int eb = 0; eb < 2; ++eb) { const f32x4 o = __builtin_amdgcn_mfma_f32_16x16x32_bf16(Vprev[eb], bs, oprev[eb][it], 0, 0, 0); \
                        *(v2u*)(O + ((size_t)b * SEQ + ii * 64 + col) * 512 + 128 * h + 16 * (2 * w + eb) + 4 * g) = (v2u){pk2(o[0], o[1]), pk2(o[2], o[3])}; } } } \
            _Pragma("unroll") for (int eb = 0; eb < 2; ++eb) { oprev[eb][0] = onew[eb][0]; oprev[eb][1] = onew[eb][1]; Vprev[eb] = Vf[eb]; } \
    } while (0)
    if (w >= 4) {
        bf16x8 Tri[2];
#pragma unroll
        for (int it = 0; it < 2; ++it)
#pragma unroll
            for (int jj = 0; jj < 8; ++jj) Tri[it][jj] = (8 * g + jj <= 16 * it + fr) ? (short)0x3F80 : (short)0;
#pragma unroll 1
        for (int k = 0; k < 76; k += 4) {
            HG2_W(k, 0, rqA, rlA, rvA); HG2_PREP(k, 0); __syncthreads();
            HG2_W(k + 1, 1, rqB, rlB, rvB); HG2_PREP(k + 1, 1); __syncthreads();
            HG2_W(k + 2, 2, rqA, rlA, rvA); HG2_PREP(k + 2, 2); __syncthreads();
            HG2_W(k + 3, 3, rqB, rlB, rvB); HG2_PREP(k + 3, 3); __syncthreads();
        }
    } else {
        f32x4 S[2][8], oprev[2][2]; bf16x8 Vprev[2];
#pragma unroll
        for (int eb = 0; eb < 2; ++eb) {
#pragma unroll
            for (int t = 0; t < 8; ++t) S[eb][t] = (f32x4){0.f, 0.f, 0.f, 0.f};
            oprev[eb][0] = (f32x4){0.f, 0.f, 0.f, 0.f}; oprev[eb][1] = (f32x4){0.f, 0.f, 0.f, 0.f};
#pragma unroll
            for (int jj = 0; jj < 8; ++jj) Vprev[eb][jj] = 0; }
#pragma unroll 1
        for (int k = 0; k < 76; k += 4) {
            HG2_W(k, 0, rqA, rlA, rvA); HG2_CORE(k, 0); __syncthreads();
            HG2_W(k + 1, 1, rqB, rlB, rvB); HG2_CORE(k + 1, 1); __syncthreads();
            HG2_W(k + 2, 2, rqA, rlA, rvA); HG2_CORE(k + 2, 2); __syncthreads();
            HG2_W(k + 3, 3, rqB, rlB, rvB); HG2_CORE(k + 3, 3); __syncthreads();
        }
    }
#undef HG2_W
#undef HG2_PREP
#undef HG2_CORE
}
DI void phase_y2(const Frame& F) {
    const bf16* OFp = (const bf16*)(F.ws + WS_OF); const bf16* OBp = (const bf16*)(F.ws + WS_OB); const bf16* P = (const bf16*)(F.ws + WS_P); bf16* YL = (bf16*)(F.ws + WS_YL);
    const bf16* HS = (const bf16*)(F.ws + WS_LHS); const bf16* PF = (const bf16*)(F.ws + WS_LPF); const bf16* PB = (const bf16*)(F.ws + WS_LPB); const float* CIN = (const float*)(F.ws + WS_CIN);
    const int gw = F.bx * NWAVES + F.wave, NGW = F.G * NWAVES;
    const int c = 8 * F.lane;
    const f32x4 g0 = *(const f32x4*)(F.in[I_HNORM] + c), g1 = *(const f32x4*)(F.in[I_HNORM] + c + 4);
    const float gn[8] = {g0.x, g0.y, g0.z, g0.w, g1.x, g1.y, g1.z, g1.w};
    for (int m0 = gw * 16; m0 < NTOK; m0 += NGW * 16) {
        const int bb = m0 >> 11, ss = 4 + ((m0 & 2047) >> 6);
        const size_t cf = ((size_t)(0 * NB + bb) * NSEQT + ss) * 512 + c, cbk = ((size_t)(1 * NB + bb) * NSEQT + ss) * 512 + c;
        const f32x4 f0 = *(const f32x4*)(CIN + cf), f1 = *(const f32x4*)(CIN + cf + 4), b0 = *(const f32x4*)(CIN + cbk), b1 = *(const f32x4*)(CIN + cbk + 4);
        const float cfv[8] = {f0.x, f0.y, f0.z, f0.w, f1.x, f1.y, f1.z, f1.w}, cbv[8] = {b0.x, b0.y, b0.z, b0.w, b1.x, b1.y, b1.z, b1.w};
#pragma unroll 2
        for (int m = m0; m < m0 + 16; ++m) {
            const v4u hs = *(const v4u*)(HS + (size_t)m * 512 + c), pf = *(const v4u*)(PF + (size_t)m * 512 + c), pb = *(const v4u*)(PB + (size_t)m * 512 + c), rg = *(const v4u*)(P + (size_t)m * INC + 512 + c);
            const v4u a = *(const v4u*)(OFp + (size_t)m * 512 + c), bq = *(const v4u*)(OBp + (size_t)m * 512 + c), sg = *(const v4u*)(P + (size_t)m * INC + 3072 + c);
            { const unsigned hw[4] = {hs.x, hs.y, hs.z, hs.w}, fw[4] = {pf.x, pf.y, pf.z, pf.w}, bw[4] = {pb.x, pb.y, pb.z, pb.w}, rw[4] = {rg.x, rg.y, rg.z, rg.w};
                unsigned ow[4];
#pragma unroll
                for (int q = 0; q < 4; ++q) { const float lo = bflo(rw[q]) * (bflo(hw[q]) + bflo(fw[q]) * cfv[2 * q] + bflo(bw[q]) * cbv[2 * q]);
                    const float hi = bfhi(rw[q]) * (bfhi(hw[q]) + bfhi(fw[q]) * cfv[2 * q + 1] + bfhi(bw[q]) * cbv[2 * q + 1]); ow[q] = pk2(lo, hi); }
                *(v4u*)(YL + (size_t)m * D + c) = (v4u){ow[0], ow[1], ow[2], ow[3]}; }
            float o[8] = {bflo(a.x) + bflo(bq.x), bfhi(a.x) + bfhi(bq.x), bflo(a.y) + bflo(bq.y), bfhi(a.y) + bfhi(bq.y), bflo(a.z) + bflo(bq.z), bfhi(a.z) + bfhi(bq.z), bflo(a.w) + bflo(bq.w), bfhi(a.w) + bfhi(bq.w)};
            const float sgv[8] = {bflo(sg.x), bfhi(sg.x), bflo(sg.y), bfhi(sg.y), bflo(sg.z), bfhi(sg.z), bflo(sg.w), bfhi(sg.w)};
            float ssq = 0.f;
#pragma unroll
            for (int j = 0; j < 8; ++j) ssq += o[j] * o[j];
            ssq += dpp_mov_f<0xB1>(ssq); ssq += dpp_mov_f<0x4E>(ssq); ssq += dpp_mov_f<0x124>(ssq); ssq += dpp_mov_f<0x128>(ssq);
            const float rs = rsqrtf(ssq * (1.0f / 128.0f) + EPS);
#pragma unroll
            for (int j = 0; j < 8; ++j) o[j] = o[j] * rs * gn[j] * sgv[j];
            v4u wv; wv.x = pk2(o[0], o[1]); wv.y = pk2(o[2], o[3]); wv.z = pk2(o[4], o[5]); wv.w = pk2(o[6], o[7]);
            *(v4u*)(YL + (size_t)m * D + 512 + c) = wv;
        }
    }
}

DI unsigned fkey(float f) { const unsigned u = __float_as_uint(f); return u ^ ((u >> 31) ? 0xFFFFFFFFu : 0x80000000u); }
template <int CTRL> DI unsigned dpp_u(unsigned v) { return (unsigned)__builtin_amdgcn_update_dpp(0, (int)v, CTRL, 0xf, 0xf, true); }
template <int CTRL> DI float dpp_f(float v) { return __uint_as_float(dpp_u<CTRL>(__float_as_uint(v))); }
DI unsigned umax_(unsigned a, unsigned b) { return a > b ? a : b; }
DI float readlane_f(float v, int lane) { return __uint_as_float((unsigned)__builtin_amdgcn_readlane((int)__float_as_uint(v), lane)); }
DI void route_token(const f32x4 lg, const f32x4 rbv, const int l, int& myexp, float& gate) {
    const float NEG = -__builtin_inff();
    float sc[4], bs[4];
#pragma unroll
    for (int k = 0; k < 4; ++k) { sc[k] = rcpf_(1.0f + expf_(-lg[k])); bs[k] = sc[k] + rbv[k]; }
    float m1 = NEG, m2 = NEG;
#pragma unroll
    for (int k = 0; k < 4; ++k) { const float v = bs[k]; if (v > m1) { m2 = m1; m1 = v; } else if (v > m2) m2 = v; }
    { float o1 = dpp_f<0xB1>(m1), o2 = dpp_f<0xB1>(m2); float n1 = fmaxf(m1, o1), n2 = fmaxf(fminf(m1, o1), fmaxf(m2, o2)); m1 = n1; m2 = n2;
      o1 = dpp_f<0x4E>(m1); o2 = dpp_f<0x4E>(m2); n1 = fmaxf(m1, o1); n2 = fmaxf(fminf(m1, o1), fmaxf(m2, o2)); m1 = n1; m2 = n2;
      const float a1 = dpp_f<0x104>(m1), a2 = dpp_f<0x104>(m2), c1 = dpp_f<0x114>(m1), c2 = dpp_f<0x114>(m2);
      o1 = (l & 4) ? c1 : a1; o2 = (l & 4) ? c2 : a2; n1 = fmaxf(m1, o1); n2 = fmaxf(fminf(m1, o1), fmaxf(m2, o2)); m1 = n1; m2 = n2; }
    const float gs = m1 + m2; const int g = l >> 3; int rank = 0;
#pragma unroll
    for (int gg = 0; gg < 8; ++gg) { const float og = readlane_f(gs, gg * 8); rank += (og > gs || (og == gs && gg < g)) ? 1 : 0; }
    const bool sel = rank < 4;
    unsigned cv[4];
#pragma unroll
    for (int k = 0; k < 4; ++k) cv[k] = sel ? fkey(bs[k]) : 0u;
    float sum = 0.f, mysc = 0.f; myexp = 0;
#pragma unroll
    for (int r = 0; r < TOPK; ++r) {
        unsigned bvk = cv[0]; int bk = 0;
#pragma unroll
        for (int k = 1; k < 4; ++k) if (cv[k] > bvk) { bvk = cv[k]; bk = k; }
        const float bsc = bk == 0 ? sc[0] : bk == 1 ? sc[1] : bk == 2 ? sc[2] : sc[3];
        unsigned m = bvk;
        m = umax_(m, dpp_u<0xB1>(m)); m = umax_(m, dpp_u<0x4E>(m)); m = umax_(m, dpp_u<0x124>(m)); m = umax_(m, dpp_u<0x128>(m));
        const unsigned M = umax_(umax_((unsigned)__builtin_amdgcn_readlane((int)m, 0), (unsigned)__builtin_amdgcn_readlane((int)m, 16)),
                                 umax_((unsigned)__builtin_amdgcn_readlane((int)m, 32), (unsigned)__builtin_amdgcn_readlane((int)m, 48)));
        const unsigned long long bal = __ballot(bvk == M);
        const int L = __builtin_ctzll(bal);
        const int kL = __builtin_amdgcn_readlane(bk, L);
        const float se = readlane_f(bsc, L);
        const int e = 4 * L + kL;
        if (l == L) {
#pragma unroll
            for (int k = 0; k < 4; ++k) if (k == bk) cv[k] = 0u; }
        sum += se; if (l == r) { myexp = e; mysc = se; }
    }
    gate = mysc * rcpf_(sum) * 2.5f;
}
constexpr int NR_XS = 1032, NR_LS = 260, NR_HIST = 133120;
static_assert(64 * NR_XS * 2 <= NR_HIST && 64 * NR_LS * 4 <= NR_HIST && NR_HIST + 1024 <= LDS_MISC, "norm/route lds");
DI void phase_norm_route(const Frame& F) {
    const float* MOD = (const float*)(F.ws + WS_MOD); const float* gain = F.in[I_NFFN];
    const bf16* X1b = (const bf16*)(F.ws + WS_X1); const bf16* WR = (const bf16*)(F.ws + WS_WR);
    v2u* ROUTE = (v2u*)(F.ws + WS_ROUTE); int* HIST = (int*)(F.ws + WS_HIST);
    LAS bf16* XT = (LAS bf16*)F.lds; LAS float* LG = (LAS float*)F.lds; LAS unsigned* hist = (LAS unsigned*)(F.lds + NR_HIST);
    const int l = F.lane, w = F.wave, fr = l & 15, g = l >> 4;
    const f32x4 rbv = *(const f32x4*)(F.in[I_RB] + 4 * l);
    for (int blk = F.bx; blk < NTOK / 128; blk += F.G) {
        if (F.tid < 256) hist[F.tid] = 0u;
        const int b = (blk * 128) >> 11;
        f32x4 ga[4], sb4[4];
#pragma unroll
        for (int j = 0; j < 4; ++j) { const int c = 4 * l + 256 * j; ga[j] = *(const f32x4*)(gain + c) * (*(const f32x4*)(MOD + b * 6144 + 4096 + c) + 1.0f); sb4[j] = *(const f32x4*)(MOD + b * 6144 + 3072 + c); }
#pragma unroll 1
        for (int half = 0; half < 2; ++half) {
            const int tok0 = blk * 128 + half * 64;
            v2u xr[4];
#pragma unroll
            for (int j = 0; j < 4; ++j) xr[j] = *(const v2u*)(X1b + (size_t)(tok0 + 8 * w) * D + 4 * l + 256 * j);
#pragma unroll 1
            for (int rr = 0; rr < 8; ++rr) { const int row = 8 * w + rr; const size_t m = (size_t)(tok0 + row);
                f32x4 v[4]; float ss = 0.f;
#pragma unroll
                for (int j = 0; j < 4; ++j) { v[j] = (f32x4){bflo(xr[j].x), bfhi(xr[j].x), bflo(xr[j].y), bfhi(xr[j].y)}; ss += (v[j].x * v[j].x + v[j].y * v[j].y) + (v[j].z * v[j].z + v[j].w * v[j].w); }
                if (rr + 1 < 8) {
#pragma unroll
                    for (int j = 0; j < 4; ++j) xr[j] = *(const v2u*)(X1b + (m + 1) * D + 4 * l + 256 * j); }
                const float rs = rsqrtf(wave_sum_fast(ss) * (1.0f / D) + EPS);
#pragma unroll
                for (int j = 0; j < 4; ++j) { const int c = 4 * l + 256 * j; const f32x4 y = (v[j] * rs) * ga[j] + sb4[j];
                    *(LAS v2u*)(XT + row * NR_XS + c) = (v2u){pk2(y.x, y.y), pk2(y.z, y.w)};
                    *(unsigned*)(F.ws + WS_HX2F + m * D + c) = pk4_f8(y.x, y.y, y.z, y.w); } }
            __syncthreads();
            f32x4 acc[4][2];
#pragma unroll
            for (int tt = 0; tt < 4; ++tt) { acc[tt][0] = (f32x4){0.f, 0.f, 0.f, 0.f}; acc[tt][1] = (f32x4){0.f, 0.f, 0.f, 0.f}; }
            const bf16* wb0 = WR + (size_t)(32 * w + fr) * D + 8 * g; const bf16* wb1 = wb0 + (size_t)16 * D;
            bf16x8 Bq[4][4][2];
#define NR_LOAD(SET, CH) do { _Pragma("unroll") for (int q = 0; q < 4; ++q) { Bq[SET][q][0] = *(const bf16x8*)(wb0 + 32 * (4 * (CH) + q)); Bq[SET][q][1] = *(const bf16x8*)(wb1 + 32 * (4 * (CH) + q)); } } while (0)
#define NR_COMP(SET, CH) do { _Pragma("unroll") for (int q = 0; q < 4; ++q) _Pragma("unroll") for (int tt = 0; tt < 4; ++tt) { \
                const bf16x8 A = *(const LAS bf16x8*)(XT + (16 * tt + fr) * NR_XS + 32 * (4 * (CH) + q) + 8 * g); \
                acc[tt][0] = __builtin_amdgcn_mfma_f32_16x16x32_bf16(A, Bq[SET][q][0], acc[tt][0], 0, 0, 0); acc[tt][1] = __builtin_amdgcn_mfma_f32_16x16x32_bf16(A, Bq[SET][q][1], acc[tt][1], 0, 0, 0); } } while (0)
            NR_LOAD(0, 0); NR_LOAD(1, 1); NR_LOAD(2, 2);
            NR_LOAD(3, 3); NR_COMP(0, 0);
            NR_LOAD(0, 4); NR_COMP(1, 1);
            NR_LOAD(1, 5); NR_COMP(2, 2);
            NR_LOAD(2, 6); NR_COMP(3, 3);
            NR_LOAD(3, 7); NR_COMP(0, 4);
            NR_COMP(1, 5); NR_COMP(2, 6); NR_COMP(3, 7);
#undef NR_LOAD
#undef NR_COMP
            __syncthreads();
#pragma unroll
            for (int tt = 0; tt < 4; ++tt)
#pragma unroll
                for (int eb = 0; eb < 2; ++eb)
#pragma unroll
                    for (int r = 0; r < 4; ++r) LG[(16 * tt + 4 * g + r) * NR_LS + 32 * w + 16 * eb + fr] = acc[tt][eb][r];
            __syncthreads();
#pragma unroll 1
            for (int ti = 0; ti < 8; ti += 2) { const int row = 8 * w + ti, tok = tok0 + row;
                const f32x4 lgA = *(const LAS f32x4*)(LG + row * NR_LS + 4 * l), lgB = *(const LAS f32x4*)(LG + (row + 1) * NR_LS + 4 * l);
                int eA, eB; float gA, gB; route_token(lgA, rbv, l, eA, gA); route_token(lgB, rbv, l, eB, gB);
                if (l < TOPK) { ROUTE[(size_t)tok * TOPK + l] = (v2u){(unsigned)eA, __float_as_uint(gA)}; ROUTE[(size_t)(tok + 1) * TOPK + l] = (v2u){(unsigned)eB, __float_as_uint(gB)};
                    (void)__hip_atomic_fetch_add(hist + eA, 1u, __ATOMIC_RELAXED, __HIP_MEMORY_SCOPE_WORKGROUP); (void)__hip_atomic_fetch_add(hist + eB, 1u, __ATOMIC_RELAXED, __HIP_MEMORY_SCOPE_WORKGROUP); } }
            __syncthreads();
        }
        if (F.tid < 256) HIST[blk * 256 + F.tid] = (int)hist[F.tid];
        __syncthreads();
    }
}
DI void tile_starts(const Frame& F, int c, LAS int* ts) {
    const int own = (c + 255) >> 8; int incl = own;
    if (F.tid < 256) {
#pragma unroll
        for (int o = 1; o < 64; o <<= 1) { const int v = __shfl_up(incl, o); if (F.lane >= o) incl += v; }
        if (F.lane == 63) ts[257 + F.wave] = incl;
    }
    __syncthreads();
    if (F.tid < 256) { int off = 0;
#pragma unroll
        for (int w = 0; w < 3; ++w) off += (w < F.wave) ? ts[257 + w] : 0;
        ts[F.tid] = off + incl - own;
        if (F.tid == 255) ts[256] = off + incl; }
    __syncthreads();
}
DI void phase_lists(const Frame& F0) {
    Frame F = F0; asm volatile("" : "+v"(F.tid)); F.lane = F.tid & 63;
    const v2u* ROUTE = (const v2u*)(F.ws + WS_ROUTE); const int* HIST = (const int*)(F.ws + WS_HIST);
    unsigned* cnt = (unsigned*)(F.ws + WS_CTL) + CW_CNT; v2u* LIST = (v2u*)(F.ws + WS_LIST);
    LAS int* part = (LAS int*)F.lds;
    LAS int* lbase = part + 4096; LAS unsigned* lcnt = (LAS unsigned*)(lbase + 256); LAS int* lts = lbase + 768;
    int* INV = (int*)(F.ws + WS_INV);
    typedef int v4i_ __attribute__((ext_vector_type(4)));
    for (int blk = F.bx; blk < NTOK / 128; blk += F.G) {
        const int e = F.tid & 255, e4 = (F.tid & 63) * 4, g = F.tid >> 6;
        v4i_ below = (v4i_){0, 0, 0, 0}, all = (v4i_){0, 0, 0, 0};
#pragma unroll 8
        for (int q = 0; q < 32; ++q) { const int row = g * 32 + q; const v4i_ v = *(const v4i_*)(HIST + row * 256 + e4); all += v; if (row < blk) below += v; }
        *(LAS v4i_*)(part + g * 512 + e4) = below; *(LAS v4i_*)(part + g * 512 + 256 + e4) = all;
        __syncthreads();
        int tot = 0;
        if (F.tid < 256) { int b = 0;
#pragma unroll
            for (int q = 0; q < 8; ++q) { b += part[q * 512 + e]; tot += part[q * 512 + 256 + e]; }
            lbase[e] = b; lcnt[e] = 0u; if (blk == 0) cnt[e] = (unsigned)tot; }
        tile_starts(F, tot, lts);
#pragma unroll
        for (int q = 0; q < 2; ++q) { const int a = F.tid + q * NTHR; const unsigned tk = (unsigned)(blk * 128 * TOPK + a);
            const v2u rt = ROUTE[tk]; const unsigned pos = (unsigned)lbase[rt.x] + __hip_atomic_fetch_add(lcnt + rt.x, 1u, __ATOMIC_RELAXED, __HIP_MEMORY_SCOPE_WORKGROUP);
            LIST[(size_t)rt.x * LISTCAP + pos] = (v2u){tk, rt.y}; INV[tk] = lts[rt.x] * 256 + (int)pos; }
        __syncthreads();
    }
}

template <bool GATHER> DI void moe_setup(const Frame& F0, int ncol, int& nunits, int& nfull) {
    Frame F = F0; asm volatile("" : "+v"(F.tid)); F.lane = F.tid & 63;
    LAS int* ts = (LAS int*)(F.lds + LDS_TS); LAS int* cl = (LAS int*)(F.lds + LDS_CNT); LAS int* ut = (LAS int*)(F.lds + LDS_UT); LAS int* idx = (LAS int*)(F.lds + LDS_IDX);
    const unsigned* cnt = (const unsigned*)(F.ws + WS_CTL) + CW_CNT;
    int c = 0; if (F.tid < 256) { c = (int)__hip_atomic_load(cnt + F.tid, __ATOMIC_RELAXED, __HIP_MEMORY_SCOPE_AGENT); cl[F.tid] = c; }
    tile_starts(F, c, ts);
    const int Te = ts[256], T = Te + NTOK / 256;
    const int Fr = T / F.G, R = T - Fr * F.G, LU = R * ncol;
    const int nleft = (LU > F.vcu) ? (LU - F.vcu + F.G - 1) / F.G : 0;
    nfull = Fr * ncol; nunits = nfull + nleft;
    const int nj = (Fr + nleft) < 10 ? (Fr + nleft) : 10;
    if (F.tid < nj) { const int j = F.tid;
        int rt, pnl = 0;
        if (j < Fr) rt = j * F.G + F.vcu; else { const int lu = (j - Fr) * F.G + F.vcu; rt = Fr * F.G + lu / ncol; pnl = lu % ncol; }
        int e, pm, nrows;
        if (rt >= Te) { e = 256; pm = rt - Te; nrows = 256; }
        else { int lo = 0, hi = 256; while (hi - lo > 1) { const int mid = (lo + hi) >> 1; if (ts[mid] <= rt) lo = mid; else hi = mid; }
            e = lo; pm = rt - ts[lo]; const int rem = cl[lo] - pm * 256; nrows = rem < 256 ? rem : 256; }
        *(LAS v4u*)(ut + 4 * j) = (v4u){(unsigned)e, (unsigned)pm, (unsigned)rt, (unsigned)nrows | ((unsigned)pnl << 16)}; }
    __syncthreads();
    const v2u* LIST = (const v2u*)(F.ws + WS_LIST);
    v2u lv[5];
#pragma unroll
    for (int q = 0; q < 5; ++q) { const int j = 2 * q + (F.tid >> 8), r = F.tid & 255; const int jc = j < nj ? j : 0;
        const v4u t = *(const LAS v4u*)(ut + 4 * jc); const int e = (int)t.x, pm = (int)t.y, nrows = (int)(t.w & 0xffffu);
        lv[q] = LIST[(size_t)(e & 255) * LISTCAP + pm * 256 + (r < nrows ? r : 0)]; }
#pragma unroll
    for (int q = 0; q < 5; ++q) { const int j = 2 * q + (F.tid >> 8), r = F.tid & 255;
        if (j < nj) { const v4u t = *(const LAS v4u*)(ut + 4 * j); const int e = (int)t.x, pm = (int)t.y, nrows = (int)(t.w & 0xffffu);
            if (GATHER) idx[j * 256 + r] = (e == 256) ? pm * 256 + r : (r < nrows ? (int)(lv[q].x >> 3) : 0);
            else ((LAS float*)idx)[j * 256 + r] = (e == 256) ? 1.0f : (r < nrows ? __uint_as_float(lv[q].y) : 0.0f); } }
    __syncthreads();
}

DI void phase_combine(const Frame& F, int mode) {
    const float* MOD = (const float*)(F.ws + WS_MOD);
    const unsigned char* YE = F.ws + WS_YE; const int* INV = (const int*)(F.ws + WS_INV);
    int Te = 0; if (mode == 0) { const unsigned* cnt = (const unsigned*)(F.ws + WS_CTL) + CW_CNT; int t4 = 0;
#pragma unroll
        for (int q = 0; q < 4; ++q) t4 += (int)((cnt[F.lane + 64 * q] + 255u) >> 8);
#pragma unroll
        for (int o = 1; o < 64; o <<= 1) t4 += __shfl_xor(t4, o);
        Te = __builtin_amdgcn_readfirstlane(t4); }
    const int gw = F.bx * NWAVES + F.wave, NGW = F.G * NWAVES;
    const float* nf = F.in[I_NFIN];
    const int c = 16 * F.lane;
    for (int m = gw; m < NTOK; m += NGW) {
        const int b = m >> 11;
        float s[16];
#pragma unroll
        for (int q = 0; q < 16; ++q) s[q] = 0.f;
        const bf16* xsrc = (const bf16*)(F.ws + WS_X1);
        if (mode == 0) {
#pragma unroll
            for (int k = 0; k < 9; ++k) { const int row = (k < 8) ? INV[m * TOPK + k] : Te * 256 + m; const v4u w = *(const v4u*)(YE + (size_t)row * D + c);
                const unsigned ww[4] = {w.x, w.y, w.z, w.w};
#pragma unroll
                for (int q = 0; q < 4; ++q) { const f32x2 lo = __builtin_amdgcn_cvt_pk_f32_fp8((int)ww[q], false), hi = __builtin_amdgcn_cvt_pk_f32_fp8((int)ww[q], true);
                    s[4 * q] += lo.x; s[4 * q + 1] += lo.y; s[4 * q + 2] += hi.x; s[4 * q + 3] += hi.y; } } }
        float x2[16]; float ss = 0.f;
#pragma unroll
        for (int q = 0; q < 4; ++q) { const v2u xt = *(const v2u*)(xsrc + (size_t)m * D + c + 4 * q); const f32x4 xa = {bflo(xt.x), bfhi(xt.x), bflo(xt.y), bfhi(xt.y)}, ga = *(const f32x4*)(MOD + b * 6144 + 5120 + c + 4 * q);
#pragma unroll
            for (int j = 0; j < 4; ++j) { const float v = xa[j] + ga[j] * (s[4 * q + j] * 0.015625f); x2[4 * q + j] = v; ss += v * v; } }
        const float rs = rsqrtf(wave_sum(ss) * (1.0f / D) + EPS);
#pragma unroll
        for (int q = 0; q < 4; ++q) { const f32x4 na = *(const f32x4*)(nf + c + 4 * q);
            f32x4 oa = {x2[4 * q] * rs * na.x, x2[4 * q + 1] * rs * na.y, x2[4 * q + 2] * rs * na.z, x2[4 * q + 3] * rs * na.w};
            *(f32x4*)(F.out + (size_t)m * D + c + 4 * q) = oa; }
    }
}

constexpr int NPHASE = 12;
__global__ void __launch_bounds__(NTHR, 2) fwd_kernel(Args args) {
    extern __shared__ __attribute__((aligned(16))) unsigned char lds_raw[];
    Frame F;
    F.lds = (LAS unsigned char*)lds_raw;
    F.tid = threadIdx.x; F.lane = F.tid & 63; F.wave = __builtin_amdgcn_readfirstlane(F.tid >> 6);
    F.G = gridDim.x; F.bx = blockIdx.x; F.vcu = (F.G % 8 == 0) ? (F.bx % 8) * (F.G / 8) + F.bx / 8 : F.bx;
    F.in = args.in; F.out = args.out; F.ws = args.ws;
    volatile LAS unsigned* MISC = (volatile LAS unsigned*)(F.lds + LDS_MISC);
    if (F.tid < 16) MISC[F.tid] = 0u;
    __syncthreads();
    XcdBarrier bar; bar.bar = (unsigned*)(F.ws + WS_CTL) + CW_BAR; bar.x = 0; bar.st = nullptr;
#if !PER_PHASE_LAUNCH
    bar = xcd_barrier_post((unsigned*)(F.ws + WS_CTL) + CW_BAR, MISC + 8);
#define GRID_BAR() xcd_barrier(bar)
#else
#define GRID_BAR() do {} while (0)
#endif
    const int lo = args.ph_lo, hi = args.ph_hi;
#ifndef PH_MASK
#define PH_MASK 0xFFFF
#endif
#define IN(k) (((PH_MASK >> (k)) & 1) && lo <= (k) && (k) < hi)
#ifndef PROBE_PH
#define PROBE_PH -1
#endif
#ifndef PROBE_MULT
#define PROBE_MULT 4
#endif
    volatile LAS unsigned long long* PRT = (volatile LAS unsigned long long*)(F.lds + LDS_MISC);
    if (PROBE_PH == 0 && F.wave == 0) PRT[0] = __builtin_amdgcn_s_memrealtime();
#define SEAM(k) do { if (IN(k) && IN((k) + 1)) GRID_BAR(); \
        if (PROBE_PH >= 0 && F.wave == 0) { if ((k) == PROBE_PH - 1) PRT[0] = __builtin_amdgcn_s_memrealtime(); if ((k) == PROBE_PH) PRT[1] = __builtin_amdgcn_s_memrealtime(); } } while (0)
#ifndef REPEAT_MASK
#define REPEAT_MASK 0
#endif
#define REPS(k) (1 + ((REPEAT_MASK >> (k)) & 1))
    unsigned char* ws = F.ws;

    if (IN(0)) _Pragma("unroll 1") for (int rep = 0; rep < REPS(0); ++rep) { if (rep) GRID_BAR(); phase_prologue(F); } SEAM(0);
    if (IN(1)) _Pragma("unroll 1") for (int rep = 0; rep < REPS(1); ++rep) { if (rep) GRID_BAR(); phase_norm_rows(F, 0); } SEAM(1);
    if (IN(2)) _Pragma("unroll 1") for (int rep = 0; rep < REPS(2); ++rep) { if (rep) GRID_BAR();
        unsigned* done2 = (unsigned*)(ws + WS_CTL) + CW_P2DONE;
        const int G2 = (F.G >= 256) ? 224 : F.G;
        if (F.bx < G2) {
            pg8::DenseOrder S; S.init(ws + WS_HX, ws + WS_WIN, MTOT, INC, D, G2, F.bx);
            pg8::EpiInProj E{(bf16*)(ws + WS_P), (const float*)(ws + WS_TAB)};
            pg8::gemm_phase(F.lds, D, S, E, F.wave);
            if (F.tid == 0) __hip_atomic_fetch_add(done2, 1u, __ATOMIC_RELAXED, __HIP_MEMORY_SCOPE_AGENT);
        } else convert_experts(F, done2, 1u);
    } SEAM(2);
    if (IN(3)) _Pragma("unroll 1") for (int rep = 0; rep < REPS(3); ++rep) { if (rep) GRID_BAR(); phase_lru_pass1(F); } SEAM(3);
    if (IN(4)) _Pragma("unroll 1") for (int rep = 0; rep < REPS(4); ++rep) { if (rep) GRID_BAR(); phase_lru_carry(F);
#if defined(PROBE_SUB)
        if (F.wave == 0 && PROBE_SUB == 0) PRT[0] = __builtin_amdgcn_s_memrealtime();
#endif
        if (F.bx < NB * 4 * 2) hgrn_chain2(F, F.bx);
#if defined(PROBE_SUB)
        if (F.wave == 0) { if (PROBE_SUB == 0) PRT[1] = __builtin_amdgcn_s_memrealtime(); else if (PROBE_SUB == 1) PRT[0] = __builtin_amdgcn_s_memrealtime(); }
#endif
        convert_experts(F, nullptr, 0u);
#if defined(PROBE_SUB)
        if (F.wave == 0 && PROBE_SUB == 1) PRT[1] = __builtin_amdgcn_s_memrealtime();
#endif
        } SEAM(4);
    if (IN(5)) _Pragma("unroll 1") for (int rep = 0; rep < REPS(5); ++rep) { if (rep) GRID_BAR(); phase_y2(F); } SEAM(5);
    if (IN(6)) _Pragma("unroll 1") for (int rep = 0; rep < REPS(6); ++rep) { if (rep) GRID_BAR();
        pg8::DenseOrder S; S.init(ws + WS_YL, ws + WS_WOUT, NTOK, D, D, F.G, F.bx);
        pg8::EpiResid E{F.in[I_X], (const float*)(ws + WS_MOD), (bf16*)(ws + WS_X1)};
        pg8::gemm_phase(F.lds, D, S, E, F.wave);
    } SEAM(6);
    if (IN(7)) _Pragma("unroll 1") for (int rep = 0; rep < REPS(7); ++rep) { if (rep) GRID_BAR(); phase_norm_route(F); } SEAM(7);
    if (IN(8)) _Pragma("unroll 1") for (int rep = 0; rep < REPS(8); ++rep) { if (rep) GRID_BAR(); phase_lists(F); } SEAM(8);
    if (IN(9)) _Pragma("unroll 1") for (int rep = 0; rep < REPS(9); ++rep) { if (rep) GRID_BAR();
        int total, nfull; moe_setup<true>(F, 2, total, nfull);
        pg8::MoeOrder<true> S; S.A = (const char*)(ws + WS_HX2F); S.Bt = (const char*)(ws + WS_EW13); S.BtS = (const char*)(ws + WS_SW13); S.K = D / 2; S.ncol = 2; S.estride = (size_t)512 * 1024; S.dump = nullptr;
        S.ut = (const LAS int*)(F.lds + LDS_UT); S.idx = (const LAS int*)(F.lds + LDS_IDX); S.nunits = total; S.nfull = nfull;
        pg8::EpiSwiGLU8 E{ws + WS_ACT};
        pg8::gemm_phase<pg8::EpiSwiGLU8, pg8::MoeOrder<true>, false, true>(F.lds, D / 2, S, E, F.wave);
    } SEAM(9);
    if (IN(10)) _Pragma("unroll 1") for (int rep = 0; rep < REPS(10); ++rep) { if (rep) GRID_BAR();
        int total, nfull; moe_setup<false>(F, 4, total, nfull);
        pg8::MoeOrder<false> S; S.A = (const char*)(ws + WS_ACT); S.Bt = (const char*)(ws + WS_EW2); S.BtS = (const char*)(ws + WS_SW2); S.K = DE / 2; S.ncol = 4; S.estride = (size_t)1024 * 256; S.dump = (const char*)(ws + WS_CTL + 0x80000 + F.bx * 256);
        S.ut = (const LAS int*)(F.lds + LDS_UT); S.idx = (const LAS int*)(F.lds + LDS_IDX); S.nunits = total; S.nfull = nfull;
        pg8::EpiScatter E{ws + WS_YE, (const LAS float*)(F.lds + LDS_IDX), 0.5f};
#if defined(PROBE_GEMM)
        pg8::GProf gp{0ull, 0ull, 0ull};
        pg8::gemm_phase<pg8::EpiScatter, pg8::MoeOrder<false>, true, true, true>(F.lds, DE / 2, S, E, F.wave, &gp);
        if (F.wave == 0) { PRT[0] = 0ull; PRT[1] = (PROBE_GEMM == 0) ? gp.t_loop : (PROBE_GEMM == 1) ? gp.t_epi : gp.t_next; }
#else
        pg8::gemm_phase<pg8::EpiScatter, pg8::MoeOrder<false>, false, true, true>(F.lds, DE / 2, S, E, F.wave);
#endif
    } SEAM(10);
    if (IN(11)) _Pragma("unroll 1") for (int rep = 0; rep < REPS(11); ++rep) { if (rep) GRID_BAR(); phase_combine(F, 0); }
#if defined(PROBE_GEMM) || defined(PROBE_SUB)
    if (F.bx == 0 && F.wave == 0) {
#else
    if (PROBE_PH >= 0 && F.bx == 0 && F.wave == 0) {
#endif
        const unsigned long long te = __builtin_amdgcn_s_memrealtime(); if (PROBE_PH == NPHASE - 1) PRT[1] = te;
        const unsigned long long target = (unsigned long long)PROBE_MULT * (PRT[1] - PRT[0]);
        while (__builtin_amdgcn_s_memrealtime() - te < target) __builtin_amdgcn_s_sleep(20);
    }
}

extern "C" void kernel_launch(void* const* d_in, const int* in_sizes, int n_in, void* d_out, int out_size, void* d_ws, size_t ws_size, hipStream_t stream) {
    static int grid = 0;
    if (grid == 0) {
        if (n_in != 26 || in_sizes[0] != NTOK * D || out_size != NTOK * D || ws_size < WS_END) { fprintf(stderr, "kernel_launch: unexpected shapes (n_in %d, ws %zu)\n", n_in, ws_size); grid = -1; return; }
        int dev = 0, cus = 0, per_cu = 0;
        if (hipGetDevice(&dev) != hipSuccess || hipDeviceGetAttribute(&cus, hipDeviceAttributeMultiprocessorCount, dev) != hipSuccess) { grid = -1; return; }
        if (hipFuncSetAttribute((const void*)fwd_kernel, hipFuncAttributeMaxDynamicSharedMemorySize, LDS_BYTES) != hipSuccess) { fprintf(stderr, "kernel_launch: hipFuncSetAttribute failed\n"); grid = -1; return; }
        if (hipOccupancyMaxActiveBlocksPerMultiprocessor(&per_cu, (const void*)fwd_kernel, NTHR, LDS_BYTES) != hipSuccess || per_cu < 1) { fprintf(stderr, "kernel_launch: occupancy query says %d\n", per_cu); }
        (void)hipGetLastError();
        grid = cus;
        if (grid < 128) { fprintf(stderr, "kernel_launch: needs >= 128 CUs (HGRN2 chains run one per workgroup)\n"); grid = -1; return; }
    }
    if (grid < 0) return;
    hipMemsetAsync((char*)d_ws + WS_CTL, 0, CTL_ZERO_BYTES, stream);
    Args a{};
    for (int i = 0; i < 26; ++i) a.in[i] = (const float*)d_in[i];
    a.out = (float*)d_out; a.ws = (unsigned char*)d_ws;
#if PER_PHASE_LAUNCH
    for (int p = 0; p < NPHASE; ++p) { a.ph_lo = p; a.ph_hi = p + 1; hipLaunchKernelGGL(fwd_kernel, dim3(grid), dim3(NTHR), LDS_BYTES, stream, a); }
#else
    a.ph_lo = 0; a.ph_hi = NPHASE;
    hipLaunchKernelGGL(fwd_kernel, dim3(grid), dim3(NTHR), LDS_BYTES, stream, a);
#endif
}
```

```cpp
#include <hip/hip_runtime.h>
#include <cstdio>
#include <cstdint>

#ifndef PER_PHASE_LAUNCH
#define PER_PHASE_LAUNCH 0
#endif
#ifndef DBG_STOP
#define DBG_STOP 0
#endif

#define GAS __attribute__((address_space(1)))
#define LAS __attribute__((address_space(3)))
#define DI __device__ __forceinline__
typedef unsigned short bf16;
typedef unsigned v4u __attribute__((ext_vector_type(4)));
typedef unsigned v2u __attribute__((ext_vector_type(2)));
typedef float f32x4 __attribute__((ext_vector_type(4)));
typedef float f32x2 __attribute__((ext_vector_type(2)));
typedef short bf16x8 __attribute__((ext_vector_type(8)));
typedef __bf16 bfv2 __attribute__((ext_vector_type(2)));

constexpr int D = 1024, NB = 16, SEQ = 2048, CTXL = 256;
constexpr int NTOK = NB * SEQ;
constexpr int NCTX = NB * CTXL;
constexpr int MTOT = NTOK + NCTX;
constexpr int INC = 3584;
constexpr int NE = 256, TOPK = 8, DE = 256;
constexpr int LISTCAP = 32768;
constexpr float EPS = 1e-6f;
constexpr int NWAVES = 8, NTHR = 512;
constexpr int NSEQT = 36;

constexpr size_t MiB = 1u << 20;
constexpr size_t WS_CTL = 0, CTL_ZERO_BYTES = 1 * MiB;
constexpr size_t WS_MOD = 1 * MiB;
constexpr size_t WS_TAB = 2 * MiB;
constexpr size_t WS_WGT = 2 * MiB + 65536;
constexpr size_t WS_WIN = 3 * MiB;
constexpr size_t WS_WOUT = 10 * MiB;
constexpr size_t WS_WR = 12 * MiB;
constexpr size_t WS_SW13 = 12 * MiB + 512 * 1024;
constexpr size_t WS_SW2 = 13 * MiB + 512 * 1024;
constexpr size_t WS_DUMP = 2 * MiB + 16384;
constexpr size_t WS_SUMA = 14 * MiB;
constexpr size_t WS_SUMH = WS_SUMA + 2359296;
constexpr size_t WS_CIN = WS_SUMH + 2359296;
constexpr size_t WS_ROUTE = 21 * MiB;
constexpr size_t WS_HIST = 23 * MiB;
constexpr size_t WS_EW13 = 32 * MiB;
constexpr size_t WS_EW2 = 288 * MiB;
constexpr size_t WS_X1 = 416 * MiB;
constexpr size_t WS_HX2 = 544 * MiB;
constexpr size_t WS_LOGIT = 608 * MiB;
constexpr size_t WS_HX8 = 608 * MiB;
constexpr size_t WS_WIN8 = 648 * MiB;
constexpr int INP_C0 = 4;
constexpr size_t WS_LIST = 1620 * MiB;
constexpr size_t WS_LHS = 674 * MiB, WS_LPF = 706 * MiB, WS_LPB = 738 * MiB;
constexpr size_t WS_ACT = 674 * MiB;
constexpr size_t WS_YS = 850 * MiB;
constexpr size_t WS_P = 914 * MiB;
constexpr size_t WS_HX = 1166 * MiB;
constexpr size_t WS_OF = 1238 * MiB;
constexpr size_t WS_OB = 1270 * MiB;
constexpr size_t WS_YL = 1302 * MiB;
constexpr size_t WS_YE = 914 * MiB;
constexpr size_t WS_INV = 24 * MiB;
constexpr size_t WS_HX2F = 1684 * MiB;
constexpr size_t WS_END = 1716 * MiB;
constexpr int CW_BAR = 4096;
constexpr int CW_CNT = 16384;
constexpr int CW_CONVQ = 20480;
constexpr int CW_P2DONE = 20608;
constexpr int CW_LRUDONE = 20544;

constexpr int RING_BYTES = 131072;
constexpr int LDS_TS = RING_BYTES;
constexpr int LDS_CNT = LDS_TS + 1088;
constexpr int LDS_UT = LDS_CNT + 1024;
constexpr int LDS_IDX = LDS_UT + 192;
constexpr int LDS_MISC = LDS_IDX + 10 * 1024;
constexpr int LDS_BYTES = 155648;
static_assert(LDS_MISC + 64 <= LDS_BYTES, "lds map");

DI unsigned pk2(float lo, float hi) { f32x2 v = {lo, hi}; bfv2 b = __builtin_convertvector(v, bfv2); return __builtin_bit_cast(unsigned, b); }
DI float clamp448(float x) { return __builtin_amdgcn_fmed3f(x, -448.0f, 448.0f); }
DI unsigned pk4_f8(float a, float b, float c, float d) {
    int w = __builtin_amdgcn_cvt_pk_fp8_f32(clamp448(a), clamp448(b), 0, false); w = __builtin_amdgcn_cvt_pk_fp8_f32(clamp448(c), clamp448(d), w, true); return (unsigned)w; }
DI float bflo(unsigned w) { return __uint_as_float(w << 16); }
DI float bfhi(unsigned w) { return __uint_as_float(w & 0xffff0000u); }
DI float bf2f(bf16 h) { return __uint_as_float(((unsigned)h) << 16); }
DI bf16 f2bf(float f) { return (bf16)(pk2(f, 0.f) & 0xffffu); }
DI float rcpf_(float x) { return __builtin_amdgcn_rcpf(x); }
DI float ex2f_(float x) { return __builtin_amdgcn_exp2f(x); }
DI float expf_(float x) { return __builtin_amdgcn_exp2f(x * 1.4426950408889634f); }
DI float logf_(float x) { return __builtin_amdgcn_logf(x) * 0.6931471805599453f; }
DI float sigm(float x) { return rcpf_(1.0f + expf_(-x)); }
DI float wave_sum(float v) {
#pragma unroll
    for (int o = 1; o < 64; o <<= 1) v += __shfl_xor(v, o);
    return v;
}
#define LDS_WAIT() asm volatile("s_waitcnt lgkmcnt(0)" ::: "memory")
template <int CTRL> DI float dpp_mov_f(float v) { return __uint_as_float((unsigned)__builtin_amdgcn_update_dpp(0, (int)__float_as_uint(v), CTRL, 0xf, 0xf, true)); }
DI float wave_sum_fast(float v) {
    v += dpp_mov_f<0xB1>(v); v += dpp_mov_f<0x4E>(v); v += dpp_mov_f<0x124>(v); v += dpp_mov_f<0x128>(v);
    const unsigned u = __float_as_uint(v);
    return (__uint_as_float((unsigned)__builtin_amdgcn_readlane((int)u, 0)) + __uint_as_float((unsigned)__builtin_amdgcn_readlane((int)u, 16)))
         + (__uint_as_float((unsigned)__builtin_amdgcn_readlane((int)u, 32)) + __uint_as_float((unsigned)__builtin_amdgcn_readlane((int)u, 48)));
}

#define XB_TMO      128
#define XB_XCNT(j)  (256  + 64 * (j))
#define XB_XSUB(j)  (1280 + 64 * (j))
#define XB_XGEN(j)  (2304 + 64 * (j))
#define XB_TOP      3328
#define XB_TOPGEN   3392
#define XCD_BAR_WORDS 3456
#define XB_SPIN_CAP (1u << 18)
__device__ __forceinline__ unsigned xb_ld(unsigned* p)              { return __hip_atomic_load(p, __ATOMIC_RELAXED, __HIP_MEMORY_SCOPE_AGENT); }
__device__ __forceinline__ unsigned xb_add(unsigned* p, unsigned v) { return __hip_atomic_fetch_add(p, v, __ATOMIC_RELAXED, __HIP_MEMORY_SCOPE_AGENT); }
__device__ __forceinline__ unsigned xb_xcc_id() { return (unsigned)__builtin_amdgcn_s_getreg((3 << 11) | 20) & 0xFu; }
#define XB_SPIN(cond, bar) do { unsigned _sp = 0; while (cond) { __builtin_amdgcn_s_sleep(1); \
    if ((++_sp & 255u) == 0u) { if (xb_ld(&(bar)[XB_TMO])) break; if (_sp > XB_SPIN_CAP) { atomicAdd(&(bar)[XB_TMO], 1u); break; } } } } while (0)
struct XcdBarrier { unsigned* bar; unsigned x; volatile LAS unsigned* st; };
__device__ __forceinline__ XcdBarrier xcd_barrier_post(unsigned* bar, volatile LAS unsigned* st) {
    XcdBarrier b; b.bar = bar; b.x = xb_xcc_id(); b.st = st;
    if (threadIdx.x == 0) (void)xb_add(&bar[XB_XCNT(b.x)], 1u);
    return b;
}
__device__ __forceinline__ void xcd_barrier_complete(unsigned* bar, unsigned x, unsigned& nloc, unsigned& nx) {
    const unsigned G = gridDim.x * gridDim.y * gridDim.z;
    unsigned sum, cnt, mine, sp = 0u;
    for (;;) {
        sum = 0u; cnt = 0u; mine = 0u;
#pragma unroll
        for (unsigned j = 0; j < 16; ++j) { const unsigned c = xb_ld(&bar[XB_XCNT(j)]); sum += c; cnt += (c > 0u) ? 1u : 0u; mine = (j == x) ? c : mine; }
        if (sum == G) break;
        __builtin_amdgcn_s_sleep(1);
        if ((++sp & 255u) == 0u) { if (xb_ld(&bar[XB_TMO])) break; if (sp > XB_SPIN_CAP) { atomicAdd(&bar[XB_TMO], 1u); break; } }
    }
    nloc = mine > 0u ? mine : 1u; nx = cnt > 0u ? cnt : 1u;
}
__device__ __forceinline__ void xcd_barrier(const XcdBarrier& b) {
    asm volatile("s_waitcnt vmcnt(0)" ::: "memory");
    __syncthreads();
    if (threadIdx.x == 0) {
        unsigned* bar = b.bar;
        __builtin_amdgcn_s_waitcnt(0);
        unsigned nloc = b.st[0], nx = b.st[1];
        if (nloc == 0u) { xcd_barrier_complete(bar, b.x, nloc, nx); b.st[0] = nloc; b.st[1] = nx; }
        const unsigned old = xb_add(&bar[XB_XSUB(b.x)], 1u);
        const unsigned gen = old / nloc;
        if (old + 1u == (gen + 1u) * nloc) {
            __builtin_amdgcn_fence(__ATOMIC_RELEASE, "agent");
            asm volatile("s_waitcnt vmcnt(0)" ::: "memory");
            const unsigned og = xb_add(&bar[XB_TOP], 1u);
            const unsigned tg = og / nx;
            if (og + 1u == (tg + 1u) * nx) xb_add(&bar[XB_TOPGEN], 1u);
            else XB_SPIN(xb_ld(&bar[XB_TOPGEN]) == tg, bar);
            __builtin_amdgcn_fence(__ATOMIC_ACQUIRE, "agent");
            xb_add(&bar[XB_XGEN(b.x)], 1u);
            asm volatile("s_waitcnt vmcnt(0)" ::: "memory");
        } else {
            XB_SPIN(xb_ld(&bar[XB_XGEN(b.x)]) == gen, bar);
            __builtin_amdgcn_fence(__ATOMIC_ACQUIRE, "agent");
            asm volatile("s_waitcnt vmcnt(0)" ::: "memory");
        }
    }
    __syncthreads();
}

namespace pg8 {
constexpr int BM = 256, BK = 64, HALF = 128, HTB = HALF * BK * 2, NXCD = 8, WGM = 8;
DI int lds_byte(int r, int c) { const int st = (r >> 4) * 2 + (c >> 5), rr = r & 15, cc = c & 31, ob = rr * 64 + cc * 2; return st * 1024 + (ob ^ (((ob >> 9) & 1) << 5)); }
DI void stage_rc(int b, int& R, int& C) { const int st = b / 1024, sb = b % 1024, swz = sb ^ (((sb >> 9) & 1) << 5); R = (st >> 1) * 16 + swz / 64; C = (st & 1) * 32 + (swz % 64) / 2; }
DI int perm32(int rho) { const int n = rho >> 4, i = rho & 15; return 8 * (i >> 2) + 4 * n + (i & 3); }

struct Unit { int pm, pn, e, rt, ord, nrows; };

struct DenseOrder {
    const char* A; const char* Bt; int K, nM, nN, nwg, G, c, i0, Loff;
    DI void init(const void* A_, const void* Bt_, int M, int N, int K_, int G_, int c_, int Loff_ = 0) { A = (const char*)A_; Bt = (const char*)Bt_; K = K_; nM = M / BM; nN = N / BM; nwg = nM * nN; G = G_; c = c_;
        Loff = Loff_; i0 = Loff_ > c_ ? (Loff_ - c_ + G_ - 1) / G_ : 0; }
    DI bool next(int i, Unit& u) const {
        const long L = (long)(i + i0) * G + c - Loff; if (L >= nwg) return false;
        int wgid = (int)L; { const int q = nwg / NXCD, r = nwg % NXCD, xcd = wgid % NXCD, off = wgid / NXCD; wgid = (xcd < r ? xcd * (q + 1) : r * (q + 1) + (xcd - r) * q) + off; }
        const int nig = WGM * nN, gid = wgid / nig, fm = gid * WGM, gsz = (nM - fm) < WGM ? (nM - fm) : WGM;
        u.pm = fm + ((wgid % nig) % gsz); u.pn = (wgid % nig) / gsz; u.e = 0; u.rt = u.pm; u.ord = i; u.nrows = 256; return true;
    }
    DI const char* a_base(const Unit& u) const { return A + (size_t)u.pm * BM * K * 2; }
    DI const char* b_base(const Unit& u) const { return Bt + (size_t)u.pn * BM * K * 2; }
    static constexpr bool GATHER_A = false;
    DI void a_offs(const Unit&, int tid, unsigned (&v)[2][2]) const {
#pragma unroll
        for (int i = 0; i < 2; ++i) { int R, C; stage_rc(tid * 16 + i * 8192, R, C);
#pragma unroll
            for (int h = 0; h < 2; ++h) v[h][i] = (unsigned)((h * HALF + R) * K + C) * 2u; }
    }
};

template <bool GATHER> struct MoeOrder {
    const char* A; const char* Bt; const char* BtS; int K, ncol; size_t estride; const char* dump;
    const LAS int* ut; const LAS int* idx; int nunits, nfull;
    static constexpr bool GATHER_A = GATHER;
    DI bool next(int i, Unit& u) const {
        if (i >= nunits) return false;
        int j, pn;
        if (i < nfull) { j = i / ncol; pn = i - j * ncol; } else { j = nfull / ncol + (i - nfull); pn = -1; }
        const v4u t = *(const LAS v4u*)(ut + 4 * j);
        u.ord = j; u.e = (int)t.x; u.pm = (int)t.y; u.rt = (int)t.z; u.nrows = (int)(t.w & 0xffffu); u.pn = pn >= 0 ? pn : (int)(t.w >> 16);
        return true;
    }
    DI const char* a_base(const Unit& u) const { return GATHER ? A : A + (size_t)u.rt * BM * K * 2; }
    DI const char* b_base(const Unit& u) const { return (u.e < 256 ? Bt + (size_t)u.e * estride : BtS) + (size_t)u.pn * BM * K * 2; }
    DI void a_offs(const Unit& u, int tid, unsigned (&v)[2][2]) const {
#pragma unroll
        for (int i = 0; i < 2; ++i) { int R, C; stage_rc(tid * 16 + i * 8192, R, C);
#pragma unroll
            for (int h = 0; h < 2; ++h) {
                if (GATHER) v[h][i] = ((unsigned)idx[u.ord * 256 + h * HALF + R] * (unsigned)K + (unsigned)C) * 2u;
                else v[h][i] = (unsigned)((h * HALF + R) * K + C) * 2u; } }
    }
};

struct GProf { unsigned long long t_loop, t_epi, t_next; };
typedef int v8i __attribute__((ext_vector_type(8)));
template <class Epi, class Sched, bool PROF = false, bool F8 = false, bool AKEEP = false>
__device__ __forceinline__ void gemm_phase(LAS unsigned char* lds, const int K, const Sched& S, const Epi& E, const int wid  , GProf* prof = nullptr) {
    unsigned long long pt0 = 0, pt1 = 0, pt2 = 0, pt3 = 0;
    const int tid = threadIdx.x, lane = tid & 63, wr = wid >> 2, wc = wid & 3, fr = lane & 15, fq = lane >> 4;
    const int nt = K / BK;
    unsigned voffBh[2][2];
#pragma unroll
    for (int i = 0; i < 2; ++i) { int R, C; stage_rc(tid * 16 + i * 8192, R, C);
#pragma unroll
        for (int h = 0; h < 2; ++h) { int Rb;
            if (Epi::PERM == 2) Rb = 64 * ((R >> 5) & 3) + 16 * ((R >> 2) & 3) + 8 * h + 4 * ((R >> 4) & 1) + (R & 3);
            else Rb = HALF * h + (Epi::PERM == 1 ? ((R & ~31) + perm32(R & 31)) : R);
            voffBh[h][i] = (unsigned)(Rb * K + C) * 2u; } }
    const size_t kstep = (size_t)(BK * 2);
    const size_t hstep = (size_t)HALF * K * 2;
    const unsigned ldsw = (unsigned)wid * 1024u;
    const int aoff = F8 ? lds_byte(wr * 64 + fr, fq * 16) : lds_byte(wr * 64 + fr, fq * 8), boff = F8 ? lds_byte(wc * 32 + fr, fq * 16) : lds_byte(wc * 32 + fr, fq * 8);
#define PG8_SA(b, h) (((b) * 2 + (h)) * HTB)
#define PG8_SB(b, h) ((4 + (b) * 2 + (h)) * HTB)
#define PG8_STAGE(bufoff, gbase, voff) do { _Pragma("unroll") for (int _i = 0; _i < 2; ++_i) \
        __builtin_amdgcn_global_load_lds((const unsigned*)((const char*)(gbase) + (voff)[_i]), (LAS unsigned*)(lds + (bufoff) + ldsw + _i * 8192), 16, 0, 0); } while (0)
#define PG8_STAGE_A(bufoff, gbase, voff, skip) do { if (AKEEP && (skip)) { if constexpr (AKEEP) asm volatile("global_store_byte %0, %0, %1\n\tglobal_store_byte %0, %0, %1" :: "v"(sc127), "s"(S.dump) : "memory"); } \
        else PG8_STAGE(bufoff, gbase, voff); } while (0)
#define PG8_LD8(dst, off) do { const v4u _lo = *(const LAS v4u*)(lds + (off)), _hi = *(const LAS v4u*)(lds + (off) + 16); \
        dst[0] = (int)_lo.x; dst[1] = (int)_lo.y; dst[2] = (int)_lo.z; dst[3] = (int)_lo.w; dst[4] = (int)_hi.x; dst[5] = (int)_hi.y; dst[6] = (int)_hi.z; dst[7] = (int)_hi.w; } while (0)
#define PG8_LDA(dst, b, h) do { if (F8) { _Pragma("unroll") for (int m = 0; m < 4; ++m) PG8_LD8(dst##8[m], PG8_SA(b, h) + aoff + m * 2048); } \
        else { _Pragma("unroll") for (int m = 0; m < 4; ++m) _Pragma("unroll") for (int k = 0; k < 2; ++k) dst[m][k] = *(const LAS bf16x8*)(lds + PG8_SA(b, h) + aoff + m * 2048 + k * 1024); } } while (0)
#define PG8_LDB(dst, b, h) do { if (F8) { _Pragma("unroll") for (int n = 0; n < 2; ++n) PG8_LD8(dst##8[n], PG8_SB(b, h) + boff + n * 2048); } \
        else { _Pragma("unroll") for (int n = 0; n < 2; ++n) _Pragma("unroll") for (int k = 0; k < 2; ++k) dst[n][k] = *(const LAS bf16x8*)(lds + PG8_SB(b, h) + boff + n * 2048 + k * 1024); } } while (0)
#define PG8_MMA(ai, bj, At, Bt) do { __builtin_amdgcn_s_setprio(1); \
        if (F8) { _Pragma("unroll") for (int m = 0; m < 4; ++m) _Pragma("unroll") for (int n = 0; n < 2; ++n) \
            asm volatile("v_mfma_scale_f32_16x16x128_f8f6f4 %0, %1, %2, %0, %3, %3 op_sel_hi:[0,0,0]" : "+v"(acc[ai][bj][m][n]) : "v"(Bt##8[n]), "v"(At##8[m]), "v"(sc127)); } \
        else { _Pragma("unroll") for (int m = 0; m < 4; ++m) _Pragma("unroll") for (int n = 0; n < 2; ++n) _Pragma("unroll") for (int k = 0; k < 2; ++k) \
            acc[ai][bj][m][n] = __builtin_amdgcn_mfma_f32_16x16x32_bf16(Bt[n][k], At[m][k], acc[ai][bj][m][n], 0, 0, 0); } \
        __builtin_amdgcn_s_setprio(0); } while (0)
#define PG8_WAIT_V(n) asm volatile("s_waitcnt vmcnt(" #n ")" ::: "memory")
#define PG8_WAIT_L(n) asm volatile("s_waitcnt lgkmcnt(" #n ")" ::: "memory")
#define PG8_BAR __builtin_amdgcn_s_barrier()
#define PG8_SCHED __builtin_amdgcn_sched_barrier(0)
    Unit cur, nxt; int ui = 0;
    if (!S.next(0, cur)) return;
    f32x4 acc[2][2][4][2];
#pragma unroll
    for (int a = 0; a < 2; ++a)
#pragma unroll
        for (int b = 0; b < 2; ++b)
#pragma unroll
            for (int m = 0; m < 4; ++m)
#pragma unroll
                for (int n = 0; n < 2; ++n) acc[a][b][m][n] = (f32x4){0.f, 0.f, 0.f, 0.f};
    bf16x8 At[4][2], B0[2][2], B1[2][2];
    v8i At8[4], B08[2], B18[2];
    int sc127 = 127; asm volatile("" : "+v"(sc127));
    unsigned vC[2][2], vN[2][2];
    const bool keep_ok = AKEEP && nt == 2; bool sC = false;
    S.a_offs(cur, tid, vC);
    const char* cA = S.a_base(cur); const char* cB = S.b_base(cur);
    PG8_STAGE(PG8_SB(0, 0), cB, voffBh[0]); PG8_STAGE(PG8_SA(0, 0), cA, vC[0]); PG8_STAGE(PG8_SB(0, 1), cB, voffBh[1]); PG8_STAGE(PG8_SA(0, 1), cA, vC[1]);
    if (wr == 1) PG8_BAR;
    PG8_WAIT_V(4); PG8_BAR;
    PG8_STAGE(PG8_SB(1, 0), cB + kstep, voffBh[0]); PG8_STAGE(PG8_SA(1, 0), cA + kstep, vC[0]); PG8_STAGE(PG8_SB(1, 1), cB + kstep, voffBh[1]);
    PG8_WAIT_V(6); PG8_BAR;
    for (;;) {
        if (PROF) pt0 = __builtin_amdgcn_s_memrealtime();
        const bool has_next = S.next(ui + 1, nxt);
        const char* nA = has_next ? S.a_base(nxt) : cA; const char* nB = has_next ? S.b_base(nxt) : cB;
        if (Sched::GATHER_A) { if (has_next) S.a_offs(nxt, tid, vN); else { vN[0][0] = vC[0][0]; vN[0][1] = vC[0][1]; vN[1][0] = vC[1][0]; vN[1][1] = vC[1][1]; } }
        const bool sN = keep_ok && (!has_next || nxt.ord == cur.ord);
        if (PROF) pt1 = __builtin_amdgcn_s_memrealtime();
#pragma unroll 1
        for (int t = 0; t < nt; t += 2) {
            const bool last = (t == nt - 2);
            const char* a1 = cA + (size_t)(t + 1) * kstep;
            const char* a2 = last ? nA : cA + (size_t)(t + 2) * kstep; const char* b2 = last ? nB : cB + (size_t)(t + 2) * kstep;
            const char* a3 = a2 + kstep; const char* b3 = b2 + kstep;
            unsigned x0[2], x1[2];
            if (Sched::GATHER_A) { x0[0] = last ? vN[0][0] : vC[0][0]; x0[1] = last ? vN[0][1] : vC[0][1]; x1[0] = last ? vN[1][0] : vC[1][0]; x1[1] = last ? vN[1][1] : vC[1][1]; }
            else { x0[0] = vC[0][0]; x0[1] = vC[0][1]; x1[0] = vC[1][0]; x1[1] = vC[1][1]; }
            PG8_LDB(B0, 0, 0); PG8_SCHED; PG8_LDA(At, 0, 0); PG8_STAGE_A(PG8_SA(1, 1), a1, vC[1], sC);
            PG8_WAIT_L(8); PG8_BAR; PG8_WAIT_L(0); PG8_MMA(0, 0, At, B0); PG8_WAIT_V(10); PG8_BAR; PG8_SCHED;
            PG8_LDB(B1, 0, 1); PG8_STAGE(PG8_SB(0, 0), b2, voffBh[0]);
            PG8_BAR; PG8_WAIT_L(0); PG8_MMA(0, 1, At, B1); PG8_WAIT_V(10); PG8_BAR;
            PG8_LDA(At, 0, 1); PG8_STAGE_A(PG8_SA(0, 0), a2, x0, sN);
            PG8_BAR; PG8_WAIT_L(0); PG8_MMA(1, 0, At, B0); PG8_BAR; PG8_SCHED;
            PG8_STAGE(PG8_SB(0, 1), b2, voffBh[1]);
            PG8_BAR; PG8_MMA(1, 1, At, B1); PG8_WAIT_V(10); PG8_BAR;
            PG8_LDB(B0, 1, 0); PG8_SCHED; PG8_LDA(At, 1, 0); PG8_STAGE_A(PG8_SA(0, 1), a2, x1, sN);
            PG8_WAIT_L(8); PG8_BAR; PG8_WAIT_L(0); PG8_MMA(0, 0, At, B0); PG8_WAIT_V(10); PG8_BAR; PG8_SCHED;
            PG8_LDB(B1, 1, 1); PG8_STAGE(PG8_SB(1, 0), b3, voffBh[0]);
            PG8_BAR; PG8_WAIT_L(0); PG8_MMA(0, 1, At, B1); PG8_WAIT_V(10); PG8_BAR;
            PG8_LDA(At, 1, 1); PG8_STAGE_A(PG8_SA(1, 0), a3, x0, sN);
            PG8_BAR; PG8_WAIT_L(0); PG8_MMA(1, 0, At, B0); PG8_BAR; PG8_SCHED;
            PG8_STAGE(PG8_SB(1, 1), b3, voffBh[1]);
            PG8_BAR; PG8_MMA(1, 1, At, B1); PG8_WAIT_V(10); PG8_BAR;
        }
        if (PROF) pt2 = __builtin_amdgcn_s_memrealtime();
        if (F8) asm volatile("s_nop 15\n\ts_nop 15" ::: "memory");
        E(acc, cur, wr, wc, fr, fq);
        if (PROF) { asm volatile("s_waitcnt vmcnt(0)" ::: "memory"); pt3 = __builtin_amdgcn_s_memrealtime(); prof->t_next += pt1 - pt0; prof->t_loop += pt2 - pt1; prof->t_epi += pt3 - pt2; }
        if (!has_next) break;
#pragma unroll
        for (int a = 0; a < 2; ++a)
#pragma unroll
            for (int b = 0; b < 2; ++b)
#pragma unroll
                for (int m = 0; m < 4; ++m)
#pragma unroll
                    for (int n = 0; n < 2; ++n) acc[a][b][m][n] = (f32x4){0.f, 0.f, 0.f, 0.f};
        cur = nxt; cA = nA; cB = nB; ++ui; sC = sN;
        if (Sched::GATHER_A) { vC[0][0] = vN[0][0]; vC[0][1] = vN[0][1]; vC[1][0] = vN[1][0]; vC[1][1] = vN[1][1]; }
    }
    PG8_WAIT_V(0);
    if (wr == 0) PG8_BAR;
    PG8_BAR;
#undef PG8_SA
#undef PG8_SB
#undef PG8_STAGE
#undef PG8_STAGE_A
#undef PG8_LD8
#undef PG8_LDA
#undef PG8_LDB
#undef PG8_MMA
#undef PG8_WAIT_V
#undef PG8_WAIT_L
#undef PG8_BAR
#undef PG8_SCHED
}

DI float gelu_tanh(float x) { const float u = 1.5957691216f * (x + 0.044715f * x * x * x); return x * rcpf_(1.0f + expf_(-u)); }
DI float silu_f(float x) { return x * rcpf_(1.0f + expf_(-x)); }

struct EpiInProj {
    static constexpr int PERM = 2;
    bf16* P; const float* LB; int pn0; float sc;
    DI void operator()(const f32x4 (&acc)[2][2][4][2], const Unit& u, int wr, int wc, int fr, int fq) const {
        const int pn = u.pn + pn0;
        const int row0 = u.pm * BM + wr * 64 + fr, col0 = pn * BM + wc * 64 + 16 * fq;
        const int kind = (pn >= 8 && pn < 12) ? 2 : 0;
        f32x4 lbv[2][2];
        { const int dir = (pn >> 1) & 1; const int cc = (pn & 1) * 256 + wc * 64 + 16 * fq;
#pragma unroll
            for (int bj = 0; bj < 2; ++bj)
#pragma unroll
                for (int n = 0; n < 2; ++n) lbv[bj][n] = *(const f32x4*)(LB + dir * 512 + cc + 8 * bj + 4 * n);
            asm volatile("" :: "v"(lbv[0][0]), "v"(lbv[0][1]), "v"(lbv[1][0]), "v"(lbv[1][1])); }
#pragma unroll
        for (int ai = 0; ai < 2; ++ai)
#pragma unroll
            for (int m = 0; m < 4; ++m) { bf16* rowp = P + (size_t)(row0 + ai * HALF + m * 16) * INC + col0;
#pragma unroll
                for (int bj = 0; bj < 2; ++bj) { f32x4 v0 = acc[ai][bj][m][0] * sc, v1 = acc[ai][bj][m][1] * sc;
                    if (kind == 1) {
#pragma unroll
                        for (int j = 0; j < 4; ++j) { v0[j] = gelu_tanh(v0[j]); v1[j] = gelu_tanh(v1[j]); } }
                    else if (kind == 2) {
#pragma unroll
                        for (int j = 0; j < 4; ++j) { const float l0 = lbv[bj][0][j], l1 = lbv[bj][1][j];
                            v0[j] = logf_(l0 + (1.0f - l0) * sigm(v0[j])); v1[j] = logf_(l1 + (1.0f - l1) * sigm(v1[j])); } }
                    else if (kind == 3) {
#pragma unroll
                        for (int j = 0; j < 4; ++j) { v0[j] = silu_f(v0[j]); v1[j] = silu_f(v1[j]); } }
                    v4u w; w.x = pk2(v0[0], v0[1]); w.y = pk2(v0[2], v0[3]); w.z = pk2(v1[0], v1[1]); w.w = pk2(v1[2], v1[3]);
                    *(v4u*)(rowp + 8 * bj) = w; } }
    }
};
struct EpiResid {
    static constexpr int PERM = 2;
    const float* x; const float* mod; bf16* X1;
    DI void operator()(const f32x4 (&acc)[2][2][4][2], const Unit& u, int wr, int wc, int fr, int fq) const {
        const int row0 = u.pm * BM + wr * 64 + fr, col0 = u.pn * BM + wc * 64 + 16 * fq;
        const int b = (u.pm * BM) >> 11;
        f32x4 gv[2][2];
#pragma unroll
        for (int bj = 0; bj < 2; ++bj)
#pragma unroll
            for (int n = 0; n < 2; ++n) gv[bj][n] = *(const f32x4*)(mod + (size_t)b * 6144 + 2048 + col0 + 8 * bj + 4 * n);
        asm volatile("" :: "v"(gv[0][0]), "v"(gv[0][1]), "v"(gv[1][0]), "v"(gv[1][1]));
#pragma unroll
        for (int ai = 0; ai < 2; ++ai) {
            f32x4 xv[4][2][2];
#pragma unroll
            for (int m = 0; m < 4; ++m) { const size_t off = (size_t)(row0 + ai * HALF + m * 16) * D + col0;
#pragma unroll
                for (int bj = 0; bj < 2; ++bj) { xv[m][bj][0] = *(const f32x4*)(x + off + 8 * bj); xv[m][bj][1] = *(const f32x4*)(x + off + 8 * bj + 4); } }
#pragma unroll
            for (int m = 0; m < 4; ++m) { const size_t off = (size_t)(row0 + ai * HALF + m * 16) * D + col0;
#pragma unroll
                for (int bj = 0; bj < 2; ++bj) {
                    const f32x4 v0 = xv[m][bj][0] + gv[bj][0] * acc[ai][bj][m][0], v1 = xv[m][bj][1] + gv[bj][1] * acc[ai][bj][m][1];
                    v4u w; w.x = pk2(v0[0], v0[1]); w.y = pk2(v0[2], v0[3]); w.z = pk2(v1[0], v1[1]); w.w = pk2(v1[2], v1[3]);
                    *(v4u*)(X1 + off + 8 * bj) = w; } }
        }
    }
};
struct EpiF32 {
    static constexpr int PERM = 0;
    float* C; int ldc;
    DI void operator()(const f32x4 (&acc)[2][2][4][2], const Unit& u, int wr, int wc, int fr, int fq) const {
        const int row0 = u.pm * BM + wr * 64 + fr, col0 = u.pn * BM + wc * 32 + 4 * fq;
#pragma unroll
        for (int ai = 0; ai < 2; ++ai)
#pragma unroll
            for (int m = 0; m < 4; ++m) { float* rowp = C + (size_t)(row0 + ai * HALF + m * 16) * ldc + col0;
#pragma unroll
                for (int bj = 0; bj < 2; ++bj)
#pragma unroll
                    for (int n = 0; n < 2; ++n) *(f32x4*)(rowp + bj * HALF + n * 16) = acc[ai][bj][m][n]; }
    }
};
struct EpiSwiGLU8 {
    static constexpr int PERM = 1;
    unsigned char* ACT;
    DI void operator()(const f32x4 (&acc)[2][2][4][2], const Unit& u, int wr, int wc, int fr, int fq) const {
        const unsigned off0 = ((unsigned)u.rt * 256u + (unsigned)(wr * 64 + fr)) * (unsigned)DE + (unsigned)(u.pn * 128 + wc * 32 + 8 * fq);
#pragma unroll
        for (int ai = 0; ai < 2; ++ai)
#pragma unroll
            for (int m = 0; m < 4; ++m) {
                const f32x4 x0 = acc[ai][0][m][0], x1 = acc[ai][0][m][1];
                const f32x4 p0 = x0 * (acc[ai][1][m][0] * 0.0078125f), p1 = x1 * (acc[ai][1][m][1] * 0.0078125f);
                const f32x4 t0 = x0 * (-1.4426950408889634f * 0.03125f), t1 = x1 * (-1.4426950408889634f * 0.03125f);
                f32x4 d0, d1;
#pragma unroll
                for (int j = 0; j < 4; ++j) { d0[j] = __builtin_amdgcn_exp2f(t0[j]); d1[j] = __builtin_amdgcn_exp2f(t1[j]); }
                d0 = d0 + 1.0f; d1 = d1 + 1.0f;
#pragma unroll
                for (int j = 0; j < 4; ++j) { d0[j] = rcpf_(d0[j]); d1[j] = rcpf_(d1[j]); }
                const f32x4 a0 = p0 * d0, a1 = p1 * d1;
                v2u w; w.x = pk4_f8(a0[0], a0[1], a0[2], a0[3]); w.y = pk4_f8(a1[0], a1[1], a1[2], a1[3]);
                *(v2u*)(ACT + (off0 + (unsigned)((ai * HALF + m * 16) * DE))) = w; }
    }
};
struct EpiSwiGLU {
    static constexpr int PERM = 1;
    bf16* ACT;
    DI void operator()(const f32x4 (&acc)[2][2][4][2], const Unit& u, int wr, int wc, int fr, int fq) const {
        const int row0 = wr * 64 + fr, col0 = u.pn * 128 + wc * 32 + 8 * fq;
        bf16* base = ACT + (size_t)u.rt * 256 * DE;
#pragma unroll
        for (int ai = 0; ai < 2; ++ai)
#pragma unroll
            for (int m = 0; m < 4; ++m) { bf16* rowp = base + (size_t)(row0 + ai * HALF + m * 16) * DE + col0;
                f32x4 a0 = acc[ai][0][m][0], a1 = acc[ai][0][m][1]; const f32x4 g0 = acc[ai][1][m][0], g1 = acc[ai][1][m][1];
#pragma unroll
                for (int j = 0; j < 4; ++j) { a0[j] = silu_f(a0[j]) * g0[j]; a1[j] = silu_f(a1[j]) * g1[j]; }
                v4u w; w.x = pk2(a0[0], a0[1]); w.y = pk2(a0[2], a0[3]); w.z = pk2(a1[0], a1[1]); w.w = pk2(a1[2], a1[3]);
                *(v4u*)rowp = w; }
    }
};
struct EpiScatter {
    static constexpr int PERM = 2;
    unsigned char* YE; const LAS float* gate; float oscale;
    DI void operator()(const f32x4 (&acc)[2][2][4][2], const Unit& u, int wr, int wc, int fr, int fq) const {
        const unsigned col0 = (unsigned)(u.pn * BM + wc * 64 + 16 * fq);
        float gt[2][4];
#pragma unroll
        for (int ai = 0; ai < 2; ++ai)
#pragma unroll
            for (int m = 0; m < 4; ++m) gt[ai][m] = gate[u.ord * 256 + ai * HALF + wr * 64 + m * 16 + fr] * oscale;
#pragma unroll
        for (int ai = 0; ai < 2; ++ai)
#pragma unroll
            for (int m = 0; m < 4; ++m) { const int r = ai * HALF + wr * 64 + m * 16 + fr; const float g = gt[ai][m];
                const unsigned row = (r < u.nrows) ? (unsigned)u.rt * 256u + (unsigned)r : 360448u;
                const f32x4 v0 = acc[ai][0][m][0] * g, v1 = acc[ai][0][m][1] * g, v2 = acc[ai][1][m][0] * g, v3 = acc[ai][1][m][1] * g;
                v4u w; w.x = pk4_f8(v0[0], v0[1], v0[2], v0[3]); w.y = pk4_f8(v1[0], v1[1], v1[2], v1[3]); w.z = pk4_f8(v2[0], v2[1], v2[2], v2[3]); w.w = pk4_f8(v3[0], v3[1], v3[2], v3[3]);
                *(v4u*)(YE + (row * (unsigned)D + col0)) = w; }
    }
};
}

struct Args { const float* in[26]; float* out; unsigned char* ws; int ph_lo, ph_hi; };
enum { I_X = 0, I_C, I_CTX, I_CCTX, I_ADAW, I_ADAB, I_NMIX, I_NFFN, I_NFIN, I_WIN, I_WOUT, I_CONVW, I_CONVB, I_WA, I_BA, I_WX, I_BX, I_LAM,
       I_LBL, I_HNORM, I_RW, I_RB, I_EW13, I_EW2, I_SW13, I_SW2 };

struct Frame {
    LAS unsigned char* lds;
    int tid, lane, wave, G, vcu, bx;
    const float* const* in; float* out; unsigned char* ws;
};

DI void transpose_item(const float* W, int ldw, bf16* WT, int ldo, int k0, int n0, int orow0, LAS float* scr, int lane) {
    const int sub = lane >> 3, c4 = (lane & 7) * 4;
    f32x4 v[8];
#pragma unroll
    for (int i = 0; i < 8; ++i) v[i] = __builtin_nontemporal_load((const f32x4*)(W + (size_t)(k0 + 8 * i + sub) * ldw + n0 + c4));
#pragma unroll
    for (int i = 0; i < 8; ++i) { LAS float* d = scr + (8 * i + sub) * 33 + c4; d[0] = v[i].x; d[1] = v[i].y; d[2] = v[i].z; d[3] = v[i].w; }
    LDS_WAIT(); asm volatile("" ::: "memory");
    const int c = lane & 7;
#pragma unroll
    for (int j = 0; j < 4; ++j) { const int n = (lane >> 3) + 8 * j; const LAS float* s = scr + (8 * c) * 33 + n;
        v4u o; o.x = pk2(s[0 * 33], s[1 * 33]); o.y = pk2(s[2 * 33], s[3 * 33]); o.z = pk2(s[4 * 33], s[5 * 33]); o.w = pk2(s[6 * 33], s[7 * 33]);
        *(v4u*)(WT + (size_t)(orow0 + n) * ldo + k0 + 8 * c) = o; }
    LDS_WAIT(); asm volatile("" ::: "memory");
}
DI void transpose_item8(const float* W, int ldw, unsigned char* WT, int ldo, int k0, int n0, int orow0, float scale, LAS float* scr, int lane) {
    const int sub = lane >> 3, c4 = (lane & 7) * 4;
    f32x4 v[16];
#pragma unroll
    for (int i = 0; i < 16; ++i) v[i] = __builtin_nontemporal_load((const f32x4*)(W + (size_t)(k0 + 8 * i + sub) * ldw + n0 + c4));
#pragma unroll
    for (int i = 0; i < 16; ++i) { LAS float* d = scr + (8 * i + sub) * 33 + c4; d[0] = v[i].x; d[1] = v[i].y; d[2] = v[i].z; d[3] = v[i].w; }
    LDS_WAIT(); asm volatile("" ::: "memory");
    const int c = lane & 7;
#pragma unroll
    for (int j = 0; j < 4; ++j) { const int n = (lane >> 3) + 8 * j; const LAS float* sp = scr + (16 * c) * 33 + n;
        v4u o; o.x = pk4_f8(sp[0] * scale, sp[33] * scale, sp[66] * scale, sp[99] * scale); o.y = pk4_f8(sp[132] * scale, sp[165] * scale, sp[198] * scale, sp[231] * scale);
        o.z = pk4_f8(sp[264] * scale, sp[297] * scale, sp[330] * scale, sp[363] * scale); o.w = pk4_f8(sp[396] * scale, sp[429] * scale, sp[462] * scale, sp[495] * scale);
        *(v4u*)(WT + (size_t)(orow0 + n) * ldo + k0 + 16 * c) = o; }
    LDS_WAIT(); asm volatile("" ::: "memory");
}
DI int w13_row(int n) { const int half = n >> 8, idx = n & 255; return 256 * (idx >> 7) + 128 * half + (idx & 127); }

DI void phase_prologue(const Frame& F) {
    const float* const* in = F.in; unsigned char* ws = F.ws;
    {
        LAS float* sc = (LAS float*)F.lds;
        LAS float* red = (LAS float*)(F.lds + 17 * 1024 * 4);
        { float cv[34];
#pragma unroll
            for (int q = 0; q < 34; ++q) { const int r = q >> 1, k = F.tid + NTHR * (q & 1); cv[q] = (r < 16) ? in[I_C][r * 1024 + k] : in[I_CCTX][k]; }
#pragma unroll
            for (int q = 0; q < 34; ++q) { const int r = q >> 1, k = F.tid + NTHR * (q & 1); sc[r * 1024 + k] = cv[q] / (1.0f + __expf(-cv[q])); } }
        __syncthreads();
        const float* aw = in[I_ADAW]; float* MOD = (float*)(ws + WS_MOD);
        for (int cg = F.bx; cg < 256; cg += F.G) {
            const int kg = F.tid >> 5, cl = F.tid & 31, col = cg * 24 + cl;
            float a[17];
#pragma unroll
            for (int r = 0; r < 17; ++r) a[r] = 0.f;
            if (cl < 24) {
#pragma unroll 1
                for (int k8 = 0; k8 < 64; k8 += 16) { float w[16];
#pragma unroll
                    for (int q = 0; q < 16; ++q) w[q] = aw[(size_t)(kg * 64 + k8 + q) * 6144 + col];
#pragma unroll
                    for (int q = 0; q < 16; ++q) { const int k = kg * 64 + k8 + q;
#pragma unroll
                        for (int r = 0; r < 17; ++r) a[r] += sc[r * 1024 + k] * w[q]; } }
#pragma unroll
                for (int r = 0; r < 17; ++r) red[(kg * 17 + r) * 24 + cl] = a[r];
            }
            __syncthreads();
            if (F.tid < 17 * 24) { const int r = F.tid / 24, c2 = F.tid % 24; float s = 0.f;
                for (int g = 0; g < 16; ++g) s += red[(g * 17 + r) * 24 + c2];
                MOD[r * 6144 + cg * 24 + c2] = s + in[I_ADAB][cg * 24 + c2]; }
            __syncthreads();
        }
    }
    {
        float* LB = (float*)(ws + WS_TAB); float* SP = LB + 1024;
        const int gt = F.bx * NTHR + F.tid, GT = F.G * NTHR;
        for (int i = gt; i < 1024; i += GT) { const int d = i >> 9, c = i & 511;
            const float l0 = in[I_LBL][(d * 2 + 0) * 512 + c], l1 = in[I_LBL][(d * 2 + 1) * 512 + c];
            LB[i] = 1.0f / (1.0f + expf(l1 - l0));
            SP[i] = -8.0f * 1.4426950408889634f * log1pf(expf(-in[I_LAM][i])); }
        bf16* WGT = (bf16*)(ws + WS_WGT);
        for (int i = gt; i < 2 * 2 * 8 * 64 * 64; i += GT) { const int ii = i & 63, j = (i >> 6) & 63, h = (i >> 12) & 7, g = (i >> 15) & 1, d = i >> 16;
            const float* src = g ? in[I_WX] : in[I_WA];
            WGT[i] = f2bf(-1.4426950408889634f * src[((size_t)(d * 8 + h) * 64 + ii) * 64 + j]); }
    }
    {
        LAS float* scr = (LAS float*)(F.lds + F.wave * 16896);
        const int gw = F.vcu * NWAVES + F.wave, NGW = F.G * NWAVES;
        constexpr int NB_BF = 8 * INP_C0, NB_F8 = 112 - NB_BF;
        constexpr int IT_WIN = 16 * NB_BF, IT_WIN8 = 8 * NB_F8, IT_WOUT = 16 * 32, IT_WR = 16 * 8, IT_SW13 = 8 * 16, IT_SW2 = 2 * 32;
        LAS float* scr8 = (LAS float*)(F.lds + F.wave * 16896);
        constexpr int NIT = IT_WIN + IT_WIN8 + IT_WOUT + IT_WR + IT_SW13 + IT_SW2;
        for (int it = gw; it < NIT; it += NGW) {
            int r = it;
            if (r < IT_WIN) { const int kb = r / NB_BF, nb = r % NB_BF; transpose_item(in[I_WIN], INC, (bf16*)(ws + WS_WIN), 1024, kb * 64, nb * 32, nb * 32, scr, F.lane); continue; } r -= IT_WIN;
            if (r < IT_WIN8) { const int kb = r / NB_F8, nb = NB_BF + r % NB_F8; transpose_item8(in[I_WIN], INC, ws + WS_WIN8, 1024, kb * 128, nb * 32, nb * 32, 32.0f, scr8, F.lane); continue; } r -= IT_WIN8;
            if (r < IT_WOUT) { const int kb = r / 32, nb = r % 32; transpose_item(in[I_WOUT], 1024, (bf16*)(ws + WS_WOUT), 1024, kb * 64, nb * 32, nb * 32, scr, F.lane); continue; } r -= IT_WOUT;
            if (r < IT_WR) { const int kb = r / 8, nb = r % 8; transpose_item(in[I_RW], 256, (bf16*)(ws + WS_WR), 1024, kb * 64, nb * 32, nb * 32, scr, F.lane); continue; } r -= IT_WR;
            if (r < IT_SW13) { const int kb = r / 16, nb = r % 16; transpose_item8(in[I_SW13], 512, ws + WS_SW13, 1024, kb * 128, nb * 32, w13_row(nb * 32), 32.0f, scr8, F.lane); continue; } r -= IT_SW13;
            { const int kb = r / 32, nb = r % 32; transpose_item8(in[I_SW2], 1024, ws + WS_SW2, 256, kb * 128, nb * 32, nb * 32, 16.0f, scr8, F.lane); }
        }
    }
}
constexpr int CV_STR = 132, CV_B = 128 * CV_STR * 4, CV_STR2 = 144;
static_assert(CV_B + 128 * CV_STR2 <= LDS_MISC, "convert lds");
DI void convert_experts(const Frame& F, const unsigned* stop_ctr, unsigned stop_val) {
    const float* const* in = F.in; unsigned char* ws = F.ws;
    LAS float* scr = (LAS float*)F.lds; LAS unsigned char* img = F.lds + CV_B;
    volatile LAS int* slot = (volatile LAS int*)(F.lds + LDS_MISC + 48);
    unsigned* qhead = (unsigned*)(ws + WS_CTL) + CW_CONVQ;
    constexpr int NB13 = 256 * 32, NB2 = 256 * 16;
    auto decode = [&](int blk, const float*& src, int& ldw, unsigned char*& dst, int& ldo, int& orow0, float& scale) {
        if (blk < NB13) { const int e = blk >> 5, q = blk & 31, nb = q >> 3, kb = q & 7;
            src = in[I_EW13] + (size_t)e * 1024 * 512 + (size_t)(kb * 128) * 512 + nb * 128; ldw = 512;
            dst = ws + WS_EW13 + (size_t)e * 512 * 1024 + kb * 128; ldo = 1024; orow0 = w13_row(nb * 128); scale = 32.0f; }
        else { const int r = blk - NB13, e = r >> 4, q = r & 15, nb = q >> 1, kb = q & 1;
            src = in[I_EW2] + (size_t)e * 256 * 1024 + (size_t)(kb * 128) * 1024 + nb * 128; ldw = 1024;
            dst = ws + WS_EW2 + (size_t)e * 1024 * 256 + kb * 128; ldo = 256; orow0 = nb * 128; scale = 16.0f; } };
    int ch_next = 0, ch_left = 0;
    auto claim = [&]() -> int {
        if (ch_left == 0) { __syncthreads();
            if (F.tid == 0) { int v = 0x7fffffff;
                if (!stop_ctr || __hip_atomic_load(stop_ctr, __ATOMIC_RELAXED, __HIP_MEMORY_SCOPE_AGENT) < stop_val) v = (int)__hip_atomic_fetch_add(qhead, 4u, __ATOMIC_RELAXED, __HIP_MEMORY_SCOPE_AGENT);
                slot[0] = v; }
            __syncthreads(); ch_next = slot[0]; ch_left = 4; }
        const int r = ch_next; if (ch_next < 0x7ffffff0) ++ch_next; --ch_left; return r; };
    f32x4 v[8];
    int blk = claim();
    const float* src = nullptr; int ldw = 0; unsigned char* dst = nullptr; int ldo = 0, orow0 = 0; float scale = 1.f;
    if (blk < NB13 + NB2) { decode(blk, src, ldw, dst, ldo, orow0, scale);
#pragma unroll
        for (int i = 0; i < 8; ++i) { const int p = F.tid + NTHR * i; v[i] = *(const f32x4*)(src + (size_t)(p >> 5) * ldw + (p & 31) * 4); } }
    while (blk < NB13 + NB2) {
#pragma unroll
        for (int i = 0; i < 8; ++i) { const int p = F.tid + NTHR * i; *(LAS f32x4*)(scr + (p >> 5) * CV_STR + (p & 31) * 4) = v[i]; }
        unsigned char* cdst = dst; const int cldo = ldo, corow0 = orow0; const float cscale = scale;
        blk = claim();
        if (blk < NB13 + NB2) { decode(blk, src, ldw, dst, ldo, orow0, scale);
#pragma unroll
            for (int i = 0; i < 8; ++i) { const int p = F.tid + NTHR * i; v[i] = *(const f32x4*)(src + (size_t)(p >> 5) * ldw + (p & 31) * 4); } }
        __syncthreads();
#pragma unroll
        for (int i = 0; i < 2; ++i) { const int n = F.tid & 127, kc = ((F.tid >> 7) + 4 * i) * 16;
            const LAS float* sp = scr + kc * CV_STR + n;
            v4u o; o.x = pk4_f8(sp[0] * cscale, sp[CV_STR] * cscale, sp[2 * CV_STR] * cscale, sp[3 * CV_STR] * cscale);
            o.y = pk4_f8(sp[4 * CV_STR] * cscale, sp[5 * CV_STR] * cscale, sp[6 * CV_STR] * cscale, sp[7 * CV_STR] * cscale);
            o.z = pk4_f8(sp[8 * CV_STR] * cscale, sp[9 * CV_STR] * cscale, sp[10 * CV_STR] * cscale, sp[11 * CV_STR] * cscale);
            o.w = pk4_f8(sp[12 * CV_STR] * cscale, sp[13 * CV_STR] * cscale, sp[14 * CV_STR] * cscale, sp[15 * CV_STR] * cscale);
            *(LAS v4u*)(img + n * CV_STR2 + kc) = o; }
        __syncthreads();
#pragma unroll
        for (int i = 0; i < 2; ++i) { const int p = F.tid + NTHR * i; const int n = p >> 3, pc = (p & 7) * 16;
            *(v4u*)(cdst + (size_t)(corow0 + n) * cldo + pc) = *(const LAS v4u*)(img + n * CV_STR2 + pc); }
    }
    __syncthreads();
}

DI void phase_norm_rows(const Frame& F, int mode) {
    const float* MOD = (const float*)(F.ws + WS_MOD);
    const int gw = F.bx * NWAVES + F.wave, NGW = F.G * NWAVES;
    const int nrows = mode == 0 ? MTOT : NTOK;
    const float* gain = mode == 0 ? F.in[I_NMIX] : F.in[I_NFFN];
    bf16* dst = (bf16*)(F.ws + (mode == 0 ? WS_HX : WS_HX2));
    const int sh_off = mode == 0 ? 0 : 3072, sc_off = mode == 0 ? 1024 : 4096;
    const int per = (nrows + NGW - 1) / NGW, r0 = gw * per, r1 = (r0 + per < nrows) ? r0 + per : nrows;
    f32x4 gn[4];
#pragma unroll
    for (int j = 0; j < 4; ++j) gn[j] = *(const f32x4*)(gain + 4 * F.lane + 256 * j);
    auto rowsrc = [&](int m) -> const float* {
        return (m < NTOK) ? F.in[I_X] + (size_t)m * D : F.in[I_CTX] + (size_t)(m - NTOK) * D; };
    const bf16* X1b = (const bf16*)(F.ws + WS_X1);
    auto ldrow = [&](int m, f32x4 (&v)[4]) {
        if (mode == 0) {
#pragma unroll
            for (int j = 0; j < 4; ++j) v[j] = *(const f32x4*)(rowsrc(m) + 4 * F.lane + 256 * j); }
        else {
#pragma unroll
            for (int j = 0; j < 4; ++j) { const v2u t = *(const v2u*)(X1b + (size_t)m * D + 4 * F.lane + 256 * j); v[j] = (f32x4){bflo(t.x), bfhi(t.x), bflo(t.y), bfhi(t.y)}; } } };
    f32x4 va[4], vb[4], ga[4], sb4[4]; int cur_mr = -1;
#pragma unroll
    for (int j = 0; j < 4; ++j) { ga[j] = gn[j]; sb4[j] = gn[j]; }
    if (r0 < r1) { ldrow(r0, va); ldrow((r0 + 1 < r1) ? r0 + 1 : r0, vb); }
#pragma unroll 1
    for (int m = r0; m < r1; m += 2) {
        f32x4 ca[4], cb[4];
#pragma unroll
        for (int j = 0; j < 4; ++j) { ca[j] = va[j]; cb[j] = vb[j]; }
        const bool hasb = (m + 1 < r1);
        { const int na = (m + 2 < r1) ? m + 2 : m, nb = (m + 3 < r1) ? m + 3 : na; ldrow(na, va); ldrow(nb, vb); }
        float sa = 0.f, sb = 0.f;
#pragma unroll
        for (int j = 0; j < 4; ++j) { sa += (ca[j].x * ca[j].x + ca[j].y * ca[j].y) + (ca[j].z * ca[j].z + ca[j].w * ca[j].w); sb += (cb[j].x * cb[j].x + cb[j].y * cb[j].y) + (cb[j].z * cb[j].z + cb[j].w * cb[j].w); }
        const float rsa = rsqrtf(wave_sum_fast(sa) * (1.0f / D) + EPS), rsb = rsqrtf(wave_sum_fast(sb) * (1.0f / D) + EPS);
#pragma unroll
        for (int q = 0; q < 2; ++q) {
            if (q == 1 && !hasb) break;
            const int mm = m + q; const float rs = q ? rsb : rsa;
            const int mr = (mode == 0 && mm >= NTOK) ? 16 : (mm >> 11);
            if (mr != cur_mr) { cur_mr = mr;
#pragma unroll
                for (int j = 0; j < 4; ++j) { const int c = 4 * F.lane + 256 * j;
                    ga[j] = gn[j] * (*(const f32x4*)(MOD + mr * 6144 + sc_off + c) + 1.0f); sb4[j] = *(const f32x4*)(MOD + mr * 6144 + sh_off + c); } }
#pragma unroll
            for (int j = 0; j < 4; ++j) { const int c = 4 * F.lane + 256 * j;
                const f32x4 v = q ? cb[j] : ca[j];
                const f32x4 y = (v * rs) * ga[j] + sb4[j];
                v2u w; w.x = pk2(y.x, y.y); w.y = pk2(y.z, y.w);
                *(v2u*)(dst + (size_t)mm * D + c) = w;
                *(unsigned*)(F.ws + (mode == 0 ? WS_HX8 : WS_HX2F) + (size_t)mm * D + c) = pk4_f8(y.x, y.y, y.z, y.w); }
        }
    }
}

constexpr int LT_STR = 520;
constexpr int L_RT = 0;
constexpr int L_GT = 69888;
static_assert(L_GT + 64 * LT_STR * 2 <= LDS_MISC, "lru lds");
template <int MODE, int dir> DI void lru_dir(const Frame& F, const int b, const int s, const int h, const int fr, const int fq, const int prow0, const bf16x8 (&Af)[4][2],
                                            const bf16* WGT, const float* SP, LAS bf16* hlb, LAS bf16* gtb, LAS bf16* GT, LAS bf16* HL) {
#pragma unroll 1
        for (int nt = 0; nt < 4; ++nt) {
            const int cj = 64 * h + 16 * nt + fr;
            bf16x8 Ba[2], Bx[2], Id[2];
#pragma unroll
            for (int ks = 0; ks < 2; ++ks) {
                Ba[ks] = *(const bf16x8*)(WGT + ((size_t)((dir * 2 + 0) * 8 + h) * 64 + 16 * nt + fr) * 64 + 32 * ks + 8 * fq);
                Bx[ks] = *(const bf16x8*)(WGT + ((size_t)((dir * 2 + 1) * 8 + h) * 64 + 16 * nt + fr) * 64 + 32 * ks + 8 * fq);
#pragma unroll
                for (int jj = 0; jj < 8; ++jj) Id[ks][jj] = (32 * ks + 8 * fq + jj == 16 * nt + fr) ? (short)0x3F80 : (short)0;
            }
            const float ba = -1.4426950408889634f * F.in[I_BA][dir * 512 + cj], bx = -1.4426950408889634f * F.in[I_BX][dir * 512 + cj], sp = SP[dir * 512 + cj];
            float cin = 0.f, ptot = 1.f;
#pragma unroll
            for (int tti = 0; tti < 4; ++tti) {
                const int tt = dir ? 3 - tti : tti;
                const bf16x8 A0 = dir ? Af[3 - tti][0] : Af[tti][0], A1 = dir ? Af[3 - tti][1] : Af[tti][1];
                f32x4 pa = {0.f, 0.f, 0.f, 0.f}, px = {0.f, 0.f, 0.f, 0.f}, uc = {0.f, 0.f, 0.f, 0.f};
                pa = __builtin_amdgcn_mfma_f32_16x16x32_bf16(A0, Ba[0], pa, 0, 0, 0); pa = __builtin_amdgcn_mfma_f32_16x16x32_bf16(A1, Ba[1], pa, 0, 0, 0);
                px = __builtin_amdgcn_mfma_f32_16x16x32_bf16(A0, Bx[0], px, 0, 0, 0); px = __builtin_amdgcn_mfma_f32_16x16x32_bf16(A1, Bx[1], px, 0, 0, 0);
                uc = __builtin_amdgcn_mfma_f32_16x16x32_bf16(A0, Id[0], uc, 0, 0, 0); uc = __builtin_amdgcn_mfma_f32_16x16x32_bf16(A1, Id[1], uc, 0, 0, 0);
                float av[4], bv[4];
#pragma unroll
                for (int ri = 0; ri < 4; ++ri) { const float pav = dir ? pa[3 - ri] : pa[ri], pxv = dir ? px[3 - ri] : px[ri], ucv = dir ? uc[3 - ri] : uc[ri];
                    const float rg = rcpf_(1.0f + ex2f_(pav + ba)), ig = rcpf_(1.0f + ex2f_(pxv + bx));
                    const float a = ex2f_(rg * sp); av[ri] = a; bv[ri] = __builtin_amdgcn_sqrtf(__builtin_fmaf(-a, a, 1.0f)) * (ig * ucv); }
                float pl = 1.f, hl = 0.f;
#pragma unroll
                for (int ri = 0; ri < 4; ++ri) { hl = av[ri] * hl + bv[ri]; pl *= av[ri]; }
                float pg[4], hg[4];
#pragma unroll
                for (int gi = 0; gi < 4; ++gi) { const int g = dir ? 3 - gi : gi; pg[gi] = __shfl(pl, fr + 16 * g); hg[gi] = __shfl(hl, fr + 16 * g); }
                const int myg = dir ? 3 - fq : fq;
                float mycin = cin, run = cin, myp = ptot, prun = ptot;
#pragma unroll
                for (int gi = 0; gi < 4; ++gi) { if (gi == myg) { mycin = run; myp = prun; } run = pg[gi] * run + hg[gi]; prun *= pg[gi]; }
                if (MODE == 1) { float hc = mycin, pc = myp;
#pragma unroll
                    for (int ri = 0; ri < 4; ++ri) { const int r = dir ? 3 - ri : ri; hc = av[ri] * hc + bv[ri]; pc *= av[ri];
                        const int o = (16 * tt + r) * LT_STR + 16 * nt;
                        hlb[o] = f2bf(dir == 0 ? hc : bf2f(hlb[o]) + hc); gtb[o] = f2bf(pc); } }
                ptot = prun;
                cin = run;
            }
            if (fq == 0) { const size_t o = ((size_t)(dir * NB + b) * NSEQT + s) * 512 + cj;
                ((float*)(F.ws + WS_SUMA))[o] = ptot; ((float*)(F.ws + WS_SUMH))[o] = cin; }
        }
        if (MODE == 1) {
            __syncthreads();
            bf16* PD = (bf16*)(F.ws + (dir ? WS_LPB : WS_LPF)); bf16* HSg = (bf16*)(F.ws + WS_LHS);
#pragma unroll
            for (int it = 0; it < 8; ++it) { const int p = F.tid + it * NTHR; const int row = p >> 6, pc = p & 63;
                *(v4u*)(PD + (size_t)(prow0 + row) * 512 + 8 * pc) = *(const LAS v4u*)(GT + row * LT_STR + 8 * pc);
                if (dir == 1) *(v4u*)(HSg + (size_t)(prow0 + row) * 512 + 8 * pc) = *(const LAS v4u*)(HL + row * LT_STR + 8 * pc); }
            __syncthreads();
        }
}
template <int MODE> DI void lru_tile(const Frame& F, int b, int s) {
    const bf16* P = (const bf16*)(F.ws + WS_P);
    const int h = F.wave, fr = F.lane & 15, fq = F.lane >> 4;
    int prow0, L, t0;
    if (s < 4) { prow0 = NTOK + b * CTXL + 64 * s; L = CTXL; t0 = 64 * s; } else { prow0 = b * SEQ + 64 * (s - 4); L = SEQ; t0 = 64 * (s - 4); }
    LAS bf16* RT = (LAS bf16*)(F.lds + L_RT); LAS bf16* GT = (LAS bf16*)(F.lds + L_GT);
    { v4u sv[9];
#pragma unroll
        for (int it = 0; it < 9; ++it) { const int p = F.tid + it * NTHR; const int row = p >> 6, pc = p & 63, ts = t0 + row - 1;
            const bool ok = (p < 67 * 64) && ts >= 0 && ts < L;
            sv[it] = *(const v4u*)(P + (size_t)(prow0 + (ok ? row - 1 : 0)) * INC + 8 * pc); }
#pragma unroll
        for (int it = 0; it < 9; ++it) { const int p = F.tid + it * NTHR; const int row = p >> 6, pc = p & 63, ts = t0 + row - 1;
            const bool ok = ts >= 0 && ts < L;
            if (p < 67 * 64) *(LAS v4u*)(RT + row * LT_STR + 8 * pc) = ok ? sv[it] : (v4u){0u, 0u, 0u, 0u}; } }
    __syncthreads();
    bf16x8 Af[4][2];
#pragma unroll
    for (int ks = 0; ks < 2; ++ks) {
        const int c0 = 64 * h + 32 * ks + 8 * fq;
        float cw[4][8], cb[8];
#pragma unroll
        for (int k = 0; k < 4; ++k) { const f32x4 w0 = *(const f32x4*)(F.in[I_CONVW] + k * 512 + c0), w1 = *(const f32x4*)(F.in[I_CONVW] + k * 512 + c0 + 4);
            cw[k][0] = w0.x; cw[k][1] = w0.y; cw[k][2] = w0.z; cw[k][3] = w0.w; cw[k][4] = w1.x; cw[k][5] = w1.y; cw[k][6] = w1.z; cw[k][7] = w1.w; }
        { const f32x4 w0 = *(const f32x4*)(F.in[I_CONVB] + c0), w1 = *(const f32x4*)(F.in[I_CONVB] + c0 + 4);
            cb[0] = w0.x; cb[1] = w0.y; cb[2] = w0.z; cb[3] = w0.w; cb[4] = w1.x; cb[5] = w1.y; cb[6] = w1.z; cb[7] = w1.w; }
        const LAS bf16* rbase = RT + fr * LT_STR + c0;
#pragma unroll
        for (int tt = 0; tt < 4; ++tt) {
            float u[8];
#pragma unroll
            for (int j = 0; j < 8; ++j) u[j] = cb[j];
#pragma unroll
            for (int k = 0; k < 4; ++k) { const v4u r8 = *(const LAS v4u*)(rbase + (16 * tt + k) * LT_STR);
                u[0] += cw[k][0] * bflo(r8.x); u[1] += cw[k][1] * bfhi(r8.x); u[2] += cw[k][2] * bflo(r8.y); u[3] += cw[k][3] * bfhi(r8.y);
                u[4] += cw[k][4] * bflo(r8.z); u[5] += cw[k][5] * bfhi(r8.z); u[6] += cw[k][6] * bflo(r8.w); u[7] += cw[k][7] * bfhi(r8.w); }
            v4u w; w.x = pk2(u[0], u[1]); w.y = pk2(u[2], u[3]); w.z = pk2(u[4], u[5]); w.w = pk2(u[6], u[7]);
            Af[tt][ks] = __builtin_bit_cast(bf16x8, w);
        }
    }
    const bf16* WGT = (const bf16*)(F.ws + WS_WGT);
    const float* SP = (const float*)(F.ws + WS_TAB) + 1024;
    LAS bf16* HL = RT;
    LAS bf16* hlb = HL + (4 * fq) * LT_STR + 64 * h + fr;
    LAS bf16* gtb = GT + (4 * fq) * LT_STR + 64 * h + fr;
    lru_dir<MODE, 0>(F, b, s, h, fr, fq, prow0, Af, WGT, SP, hlb, gtb, GT, HL);
    lru_dir<MODE, 1>(F, b, s, h, fr, fq, prow0, Af, WGT, SP, hlb, gtb, GT, HL);
    __syncthreads();
}
DI void phase_lru_pass1(const Frame& F) {
    unsigned* done = (unsigned*)(F.ws + WS_CTL) + CW_LRUDONE;
    const int NL = (F.G >= 256) ? 192 : F.G;
#if defined(PROBE_SUB)
    __syncthreads(); asm volatile("" ::: "memory"); if (F.wave == 0 && PROBE_SUB == 2) ((volatile LAS unsigned long long*)(F.lds + LDS_MISC))[0] = __builtin_amdgcn_s_memrealtime(); asm volatile("" ::: "memory");
#endif
    if (F.bx < NL) {
        for (int it = F.bx; it < NB * NSEQT; it += NL) { { const int bb = it / NSEQT, ss = it % NSEQT; if (ss < 4) lru_tile<0>(F, bb, ss); else lru_tile<1>(F, bb, ss); }
            if (F.tid == 0) __hip_atomic_fetch_add(done, 1u, __ATOMIC_RELAXED, __HIP_MEMORY_SCOPE_AGENT); }
    }
#if defined(PROBE_SUB)
    __syncthreads(); asm volatile("" ::: "memory"); if (F.wave == 0 && PROBE_SUB == 2) ((volatile LAS unsigned long long*)(F.lds + LDS_MISC))[1] = __builtin_amdgcn_s_memrealtime(); asm volatile("" ::: "memory");
#endif
    if (F.G >= 256) convert_experts(F, done, (unsigned)(NB * NSEQT));
}
DI void phase_lru_carry(const Frame& F) {
    const bool split = F.G >= 256;
    if (split ? (F.bx < 128) : (F.wave != 0)) return;
    const float* SA = (const float*)(F.ws + WS_SUMA); const float* SH = (const float*)(F.ws + WS_SUMH); float* CI = (float*)(F.ws + WS_CIN);
    for (int id = split ? (F.bx - 128) * NTHR + F.tid : F.bx * 64 + F.lane; id < 2 * NB * 512; id += split ? 128 * NTHR : F.G * 64) {
        const int dir = id >> 13, b = (id >> 9) & 15, c = id & 511;
        float x = 0.f; const size_t o0 = (size_t)(dir * NB + b) * NSEQT * 512 + c;
#pragma unroll
        for (int hf = 0; hf < 2; ++hf) {
            float av[18], hv[18];
#pragma unroll
            for (int q = 0; q < 18; ++q) { const int st = 18 * hf + q, s = dir ? (st < 4 ? 3 - st : 39 - st) : st; av[q] = SA[o0 + (size_t)s * 512]; hv[q] = SH[o0 + (size_t)s * 512]; }
#pragma unroll
            for (int q = 0; q < 18; ++q) { const int st = 18 * hf + q, s = dir ? (st < 4 ? 3 - st : 39 - st) : st; CI[o0 + (size_t)s * 512] = x; x = av[q] * x + hv[q]; }
        }
    }
}

constexpr int HS = 144, SCS = 40;
constexpr int H_Q = 0, H_LF = H_Q + 32 * HS * 2, H_V = H_LF + 32 * HS * 2, H_QT = H_V + 32 * HS * 2, H_KT = H_QT + 32 * HS * 2, H_KH = H_KT + 32 * HS * 2,
              H_SC = H_KH + 32 * HS * 2, H_DEC = H_SC + 32 * SCS * 2, H_SET = H_DEC + 512;
static_assert(2 * H_SET <= RING_BYTES, "hgrn lds");
typedef short s16x4 __attribute__((ext_vector_type(4)));
DI bf16x8 tr_frag(const LAS bf16* tile, int c0, int lane) {
    const int g = lane >> 4, q = (lane & 15) >> 2, p = lane & 3;
    const LAS bf16* a = tile + (8 * g + q) * HS + c0 + 4 * p;
    const s16x4 lo = __builtin_amdgcn_ds_read_tr16_b64_v4i16((LAS s16x4*)a), hi = __builtin_amdgcn_ds_read_tr16_b64_v4i16((LAS s16x4*)(a + 4 * HS));
    bf16x8 r; r[0] = lo[0]; r[1] = lo[1]; r[2] = lo[2]; r[3] = lo[3]; r[4] = hi[0]; r[5] = hi[1]; r[6] = hi[2]; r[7] = hi[3]; return r;
}
constexpr int P_QR = 0, P_LR = P_QR + 2 * 9216, P_VR = P_LR + 2 * 9216, P_QT = P_VR + 4 * 9216, P_KT = P_QT + 2 * 9216, P_KH = P_KT + 2 * 9216, P_SC = P_KH + 2 * 9216, P_DEC = P_SC + 2 * 2560, P_END = P_DEC + 2 * 512;
static_assert(P_END <= LDS_MISC, "hgrn pipelined lds");
DI void hgrn_chain2(const Frame& F, int item) {
    const int b = item >> 3, h = (item >> 1) & 3, dir = item & 1;
    const bf16* P = (const bf16*)(F.ws + WS_P);
    bf16* O = (bf16*)(F.ws + (dir ? WS_OB : WS_OF));
    const int w = F.wave, lane = F.lane, fr = lane & 15, g = lane >> 4;
    const int li = F.tid >> 4, lp = F.tid & 15;
    auto prow = [&](int c, int i) -> size_t {
        const int ii = dir ? 31 - i : i;
        if (c < 8) { const int cc = dir ? 7 - c : c; return (size_t)NTOK + b * CTXL + 32 * cc + ii; }
        const int col = dir ? 63 - (c - 8) : (c - 8); return (size_t)b * SEQ + ii * 64 + col; };
    const size_t coff = 128 * h + 8 * lp;
    v4u rqA, rlA, rvA, rqB, rlB, rvB;
    { const bf16* rp = P + prow(0, li) * INC + coff; rqA = *(const v4u*)(rp + 1024); rvA = *(const v4u*)(rp + 1536); rlA = *(const v4u*)(rp + 2048 + 512 * dir); }
    { const bf16* rp = P + prow(1, li) * INC + coff; rqB = *(const v4u*)(rp + 1024); rvB = *(const v4u*)(rp + 1536); rlB = *(const v4u*)(rp + 2048 + 512 * dir); }
    LAS unsigned char* L = F.lds;
#define HG2_W(k, U, RQ, RL, RV) do { \
        const int i = (k) - 2, wch = (k), pch = (k) - 1; (void)i; (void)pch; \
        if (wch < 72) {   \
            *(LAS v4u*)((LAS bf16*)(L + P_QR + ((U) & 1) * 9216) + li * HS + 8 * lp) = RQ; *(LAS v4u*)((LAS bf16*)(L + P_LR + ((U) & 1) * 9216) + li * HS + 8 * lp) = RL; \
            *(LAS v4u*)((LAS bf16*)(L + P_VR + (U) * 9216) + li * HS + 8 * lp) = RV; \
            if (wch + 2 < 72) { const bf16* rp = P + prow(wch + 2, li) * INC + coff; RQ = *(const v4u*)(rp + 1024); RV = *(const v4u*)(rp + 1536); RL = *(const v4u*)(rp + 2048 + 512 * dir); } } \
    } while (0)
#define HG2_PREP(k, U) do { \
        const int i = (k) - 2, wch = (k), pch = (k) - 1; (void)i; (void)pch; \
        const int pw = w - 4; \
            if (pch >= 0 && pch < 72) {   \
                const LAS bf16* Qr = (const LAS bf16*)(L + P_QR + (((U) + 1) & 1) * 9216); const LAS bf16* LFr = (const LAS bf16*)(L + P_LR + (((U) + 1) & 1) * 9216); \
                LAS bf16* QT = (LAS bf16*)(L + P_QT + (((U) + 1) & 1) * 9216); LAS bf16* KT = (LAS bf16*)(L + P_KT + (((U) + 1) & 1) * 9216); LAS bf16* KH = (LAS bf16*)(L + P_KH + (((U) + 1) & 1) * 9216); \
                LAS float* DEC = (LAS float*)(L + P_DEC + (((U) + 1) & 1) * 512); \
                _Pragma("unroll") for (int db = 0; db < 2; ++db) { const int dblk = 16 * (2 * pw + db); \
                    const bf16x8 Al = tr_frag(LFr, dblk, lane); \
                    f32x4 Gm[2]; \
                    _Pragma("unroll") for (int it = 0; it < 2; ++it) Gm[it] = __builtin_amdgcn_mfma_f32_16x16x32_bf16(Al, Tri[it], (f32x4){0.f, 0.f, 0.f, 0.f}, 0, 0, 0); \
                    f32x4 dec; \
                    _Pragma("unroll") for (int r = 0; r < 4; ++r) dec[r] = expf_(__shfl(Gm[1][r], (lane & 48) | 15)); \
                    if (fr == 0) *(LAS f32x4*)(DEC + dblk + 4 * g) = dec; \
                    _Pragma("unroll") for (int it = 0; it < 2; ++it) { const int ii = 16 * it + fr, d0 = dblk + 4 * g; \
                        const v2u q4 = *(const LAS v2u*)(Qr + ii * HS + d0), l4 = *(const LAS v2u*)(LFr + ii * HS + d0); \
                        const float qv[4] = {bflo(q4.x), bfhi(q4.x), bflo(q4.y), bfhi(q4.y)}, lv[4] = {bflo(l4.x), bfhi(l4.x), bflo(l4.y), bfhi(l4.y)}; \
                        float qt[4], kt[4], kh[4]; \
                        _Pragma("unroll") for (int r = 0; r < 4; ++r) { const float eg = expf_(Gm[it][r]), ieg = rcpf_(eg), kk = 1.0f - expf_(lv[r]); qt[r] = qv[r] * eg; kt[r] = kk * ieg; kh[r] = kk * dec[r] * ieg; } \
                        *(LAS v2u*)(QT + ii * HS + d0) = (v2u){pk2(qt[0], qt[1]), pk2(qt[2], qt[3])}; \
                        *(LAS v2u*)(KT + ii * HS + d0) = (v2u){pk2(kt[0], kt[1]), pk2(kt[2], kt[3])}; \
                        *(LAS v2u*)(KH + ii * HS + d0) = (v2u){pk2(kh[0], kh[1]), pk2(kh[2], kh[3])}; } } } \
            if (i >= 8 && i < 72) {   \
                const LAS bf16* QT = (const LAS bf16*)(L + P_QT + ((U) & 1) * 9216); const LAS bf16* KT = (const LAS bf16*)(L + P_KT + ((U) & 1) * 9216); LAS bf16* SC = (LAS bf16*)(L + P_SC + ((U) & 1) * 2560); \
                const int it = pw >> 1, jt = pw & 1; f32x4 sc = {0.f, 0.f, 0.f, 0.f}; \
                _Pragma("unroll") for (int ks = 0; ks < 4; ++ks) { const bf16x8 ak = *(const LAS bf16x8*)(KT + (16 * jt + fr) * HS + 32 * ks + 8 * g), bq = *(const LAS bf16x8*)(QT + (16 * it + fr) * HS + 32 * ks + 8 * g); \
                    sc = __builtin_amdgcn_mfma_f32_16x16x32_bf16(ak, bq, sc, 0, 0, 0); } \
                const int ii = 16 * it + fr, j0 = 16 * jt + 4 * g; \
                *(LAS v2u*)(SC + ii * SCS + j0) = (v2u){pk2(j0 <= ii ? sc[0] : 0.f, j0 + 1 <= ii ? sc[1] : 0.f), pk2(j0 + 2 <= ii ? sc[2] : 0.f, j0 + 3 <= ii ? sc[3] : 0.f)}; } \
    } while (0)
#define HG2_CORE(k, U) do { \
        const int i = (k) - 2, wch = (k), pch = (k) - 1; (void)i; (void)pch; \
            f32x4 onew[2][2]; \
            _Pragma("unroll") for (int eb = 0; eb < 2; ++eb) { onew[eb][0] = (f32x4){0.f, 0.f, 0.f, 0.f}; onew[eb][1] = (f32x4){0.f, 0.f, 0.f, 0.f}; } \
            bf16x8 Vf[2]; _Pragma("unroll") for (int eb = 0; eb < 2; ++eb) Vf[eb] = Vprev[eb]; \
            if (i >= 0 && i < 72) {   \
                const LAS bf16* QT = (const LAS bf16*)(L + P_QT + ((U) & 1) * 9216); const LAS bf16* KH = (const LAS bf16*)(L + P_KH + ((U) & 1) * 9216); \
                const LAS float* DEC = (const LAS float*)(L + P_DEC + ((U) & 1) * 512); const LAS bf16* Vr = (const LAS bf16*)(L + P_VR + (((U) + 2) & 3) * 9216); \
                if (i >= 8) {   \
                    _Pragma("unroll") for (int ks = 0; ks < 4; ++ks) { bf16x8 Bq[2]; \
                        _Pragma("unroll") for (int it = 0; it < 2; ++it) { const v2u a0 = *(const LAS v2u*)(QT + (16 * it + fr) * HS + 32 * ks + 4 * g), a1 = *(const LAS v2u*)(QT + (16 * it + fr) * HS + 32 * ks + 16 + 4 * g); \
                            v4u bv; bv.x = a0.x; bv.y = a0.y; bv.z = a1.x; bv.w = a1.y; Bq[it] = __builtin_bit_cast(bf16x8, bv); } \
                        _Pragma("unroll") for (int eb = 0; eb < 2; ++eb) { \
                            v4u sb; sb.x = pk2(S[eb][2 * ks][0], S[eb][2 * ks][1]); sb.y = pk2(S[eb][2 * ks][2], S[eb][2 * ks][3]); sb.z = pk2(S[eb][2 * ks + 1][0], S[eb][2 * ks + 1][1]); sb.w = pk2(S[eb][2 * ks + 1][2], S[eb][2 * ks + 1][3]); \
                            const bf16x8 As = __builtin_bit_cast(bf16x8, sb); \
                            _Pragma("unroll") for (int it = 0; it < 2; ++it) onew[eb][it] = __builtin_amdgcn_mfma_f32_16x16x32_bf16(As, Bq[it], onew[eb][it], 0, 0, 0); } } } \
                  \
                _Pragma("unroll") for (int eb = 0; eb < 2; ++eb) Vf[eb] = tr_frag(Vr, 16 * (2 * w + eb), lane); \
                _Pragma("unroll") for (int t = 0; t < 8; ++t) { const f32x4 dv = *(const LAS f32x4*)(DEC + 16 * t + 4 * g); const bf16x8 Kf = tr_frag(KH, 16 * t, lane); \
                    _Pragma("unroll") for (int eb = 0; eb < 2; ++eb) S[eb][t] = __builtin_amdgcn_mfma_f32_16x16x32_bf16(Kf, Vf[eb], S[eb][t] * dv, 0, 0, 0); } } \
            if (i - 1 >= 8 && i - 1 < 72) {   \
                const LAS bf16* SC = (const LAS bf16*)(L + P_SC + (((U) + 1) & 1) * 2560); \
                const int col = dir ? 63 - (i - 9) : (i - 9); \
                _Pragma("unroll") for (int it = 0; it < 2; ++it) { const bf16x8 bs = *(const LAS bf16x8*)(SC + (16 * it + fr) * SCS + 8 * g); \
                    const int ip = 16 * it + fr, ii = dir ? 31 - ip : ip; \
                    _Pragma("unroll") for (int eb = 0; eb < 2; ++eb) { const f32x4 o = __builtin_amdgcn_mfma_f32_16x16x32_bf16(Vprev[eb], bs, oprev[eb][it], 0, 0, 0); \
                        *(v2u*)(O + ((size_t)b * SEQ + ii * 64 + col) * 512 + 128 * h + 16 * (2 * w + eb) + 4 * g) = (v2u){pk2(o[0], o[1]), pk2(o[2], o[3])}; } } } \
            _Pragma("unroll") for (int eb = 0; eb < 2; ++eb) { oprev[eb][0] = onew[eb][0]; oprev[eb][1] = onew[eb][1]; Vprev[eb] = Vf[eb]; } \
    } while (0)
    if (w >= 4) {
        bf16x8 Tri[2];
#pragma unroll
        for (int it = 0; it < 2; ++it)
#pragma unroll
            for (int jj = 0; jj < 8; ++jj) Tri[it][jj] = (8 * g + jj <= 16 * it + fr) ? (short)0x3F80 : (short)0;
#pragma unroll 1
        for (int k = 0; k < 76; k += 4) {
            HG2_W(k, 0, rqA, rlA, rvA); HG2_PREP(k, 0); __syncthreads();
            HG2_W(k + 1, 1, rqB, rlB, rvB); HG2_PREP(k + 1, 1); __syncthreads();
            HG2_W(k + 2, 2, rqA, rlA, rvA); HG2_PREP(k + 2, 2); __syncthreads();
            HG2_W(k + 3, 3, rqB, rlB, rvB); HG2_PREP(k + 3, 3); __syncthreads();
        }
    } else {
        f32x4 S[2][8], oprev[2][2]; bf16x8 Vprev[2];
#pragma unroll
        for (int eb = 0; eb < 2; ++eb) {
#pragma unroll
            for (int t = 0; t < 8; ++t) S[eb][t] = (f32x4){0.f, 0.f, 0.f, 0.f};
            oprev[eb][0] = (f32x4){0.f, 0.f, 0.f, 0.f}; oprev[eb][1] = (f32x4){0.f, 0.f, 0.f, 0.f};
#pragma unroll
            for (int jj = 0; jj < 8; ++jj) Vprev[eb][jj] = 0; }
#pragma unroll 1
        for (int k = 0; k < 76; k += 4) {
            HG2_W(k, 0, rqA, rlA, rvA); HG2_CORE(k, 0); __syncthreads();
            HG2_W(k + 1, 1, rqB, rlB, rvB); HG2_CORE(k + 1, 1); __syncthreads();
            HG2_W(k + 2, 2, rqA, rlA, rvA); HG2_CORE(k + 2, 2); __syncthreads();
            HG2_W(k + 3, 3, rqB, rlB, rvB); HG2_CORE(k + 3, 3); __syncthreads();
        }
    }
#undef HG2_W
#undef HG2_PREP
#undef HG2_CORE
}
DI void phase_y2(const Frame& F) {
    const bf16* OFp = (const bf16*)(F.ws + WS_OF); const bf16* OBp = (const bf16*)(F.ws + WS_OB); const bf16* P = (const bf16*)(F.ws + WS_P); bf16* YL = (bf16*)(F.ws + WS_YL);
    const bf16* HS = (const bf16*)(F.ws + WS_LHS); const bf16* PF = (const bf16*)(F.ws + WS_LPF); const bf16* PB = (const bf16*)(F.ws + WS_LPB); const float* CIN = (const float*)(F.ws + WS_CIN);
    const int gw = F.bx * NWAVES + F.wave, NGW = F.G * NWAVES;
    const int c = 8 * F.lane;
    const f32x4 g0 = *(const f32x4*)(F.in[I_HNORM] + c), g1 = *(const f32x4*)(F.in[I_HNORM] + c + 4);
    const float gn[8] = {g0.x, g0.y, g0.z, g0.w, g1.x, g1.y, g1.z, g1.w};
    for (int m0 = gw * 16; m0 < NTOK; m0 += NGW * 16) {
        const int bb = m0 >> 11, ss = 4 + ((m0 & 2047) >> 6);
        const size_t cf = ((size_t)(0 * NB + bb) * NSEQT + ss) * 512 + c, cbk = ((size_t)(1 * NB + bb) * NSEQT + ss) * 512 + c;
        const f32x4 f0 = *(const f32x4*)(CIN + cf), f1 = *(const f32x4*)(CIN + cf + 4), b0 = *(const f32x4*)(CIN + cbk), b1 = *(const f32x4*)(CIN + cbk + 4);
        const float cfv[8] = {f0.x, f0.y, f0.z, f0.w, f1.x, f1.y, f1.z, f1.w}, cbv[8] = {b0.x, b0.y, b0.z, b0.w, b1.x, b1.y, b1.z, b1.w};
#pragma unroll 2
        for (int m = m0; m < m0 + 16; ++m) {
            const v4u hs = *(const v4u*)(HS + (size_t)m * 512 + c), pf = *(const v4u*)(PF + (size_t)m * 512 + c), pb = *(const v4u*)(PB + (size_t)m * 512 + c), rg = *(const v4u*)(P + (size_t)m * INC + 512 + c);
            const v4u a = *(const v4u*)(OFp + (size_t)m * 512 + c), bq = *(const v4u*)(OBp + (size_t)m * 512 + c), sg = *(const v4u*)(P + (size_t)m * INC + 3072 + c);
            { const unsigned hw[4] = {hs.x, hs.y, hs.z, hs.w}, fw[4] = {pf.x, pf.y, pf.z, pf.w}, bw[4] = {pb.x, pb.y, pb.z, pb.w}, rw[4] = {rg.x, rg.y, rg.z, rg.w};
                unsigned ow[4];
#pragma unroll
                for (int q = 0; q < 4; ++q) { const float lo = pg8::gelu_tanh(bflo(rw[q])) * (bflo(hw[q]) + bflo(fw[q]) * cfv[2 * q] + bflo(bw[q]) * cbv[2 * q]);
                    const float hi = pg8::gelu_tanh(bfhi(rw[q])) * (bfhi(hw[q]) + bfhi(fw[q]) * cfv[2 * q + 1] + bfhi(bw[q]) * cbv[2 * q + 1]); ow[q] = pk2(lo, hi); }
                *(v4u*)(YL + (size_t)m * D + c) = (v4u){ow[0], ow[1], ow[2], ow[3]}; }
            float o[8] = {bflo(a.x) + bflo(bq.x), bfhi(a.x) + bfhi(bq.x), bflo(a.y) + bflo(bq.y), bfhi(a.y) + bfhi(bq.y), bflo(a.z) + bflo(bq.z), bfhi(a.z) + bfhi(bq.z), bflo(a.w) + bflo(bq.w), bfhi(a.w) + bfhi(bq.w)};
            const float sgv[8] = {bflo(sg.x), bfhi(sg.x), bflo(sg.y), bfhi(sg.y), bflo(sg.z), bfhi(sg.z), bflo(sg.w), bfhi(sg.w)};
            float ssq = 0.f;
#pragma unroll
            for (int j = 0; j < 8; ++j) ssq += o[j] * o[j];
            ssq += dpp_mov_f<0xB1>(ssq); ssq += dpp_mov_f<0x4E>(ssq); ssq += dpp_mov_f<0x124>(ssq); ssq += dpp_mov_f<0x128>(ssq);
            const float rs = rsqrtf(ssq * (1.0f / 128.0f) + EPS);
#pragma unroll
            for (int j = 0; j < 8; ++j) o[j] = o[j] * rs * gn[j] * pg8::silu_f(sgv[j]);
            v4u wv; wv.x = pk2(o[0], o[1]); wv.y = pk2(o[2], o[3]); wv.z = pk2(o[4], o[5]); wv.w = pk2(o[6], o[7]);
            *(v4u*)(YL + (size_t)m * D + 512 + c) = wv;
        }
    }
}

DI unsigned fkey(float f) { const unsigned u = __float_as_uint(f); return u ^ ((u >> 31) ? 0xFFFFFFFFu : 0x80000000u); }
template <int CTRL> DI unsigned dpp_u(unsigned v) { return (unsigned)__builtin_amdgcn_update_dpp(0, (int)v, CTRL, 0xf, 0xf, true); }
template <int CTRL> DI float dpp_f(float v) { return __uint_as_float(dpp_u<CTRL>(__float_as_uint(v))); }
DI unsigned umax_(unsigned a, unsigned b) { return a > b ? a : b; }
DI float readlane_f(float v, int lane) { return __uint_as_float((unsigned)__builtin_amdgcn_readlane((int)__float_as_uint(v), lane)); }
DI void route_token(const f32x4 lg, const f32x4 rbv, const int l, int& myexp, float& gate) {
    const float NEG = -__builtin_inff();
    float sc[4], bs[4];
#pragma unroll
    for (int k = 0; k < 4; ++k) { sc[k] = rcpf_(1.0f + expf_(-lg[k])); bs[k] = sc[k] + rbv[k]; }
    float m1 = NEG, m2 = NEG;
#pragma unroll
    for (int k = 0; k < 4; ++k) { const float v = bs[k]; if (v > m1) { m2 = m1; m1 = v; } else if (v > m2) m2 = v; }
    { float o1 = dpp_f<0xB1>(m1), o2 = dpp_f<0xB1>(m2); float n1 = fmaxf(m1, o1), n2 = fmaxf(fminf(m1, o1), fmaxf(m2, o2)); m1 = n1; m2 = n2;
      o1 = dpp_f<0x4E>(m1); o2 = dpp_f<0x4E>(m2); n1 = fmaxf(m1, o1); n2 = fmaxf(fminf(m1, o1), fmaxf(m2, o2)); m1 = n1; m2 = n2;
      const float a1 = dpp_f<0x104>(m1), a2 = dpp_f<0x104>(m2), c1 = dpp_f<0x114>(m1), c2 = dpp_f<0x114>(m2);
      o1 = (l & 4) ? c1 : a1; o2 = (l & 4) ? c2 : a2; n1 = fmaxf(m1, o1); n2 = fmaxf(fminf(m1, o1), fmaxf(m2, o2)); m1 = n1; m2 = n2; }
    const float gs = m1 + m2; const int g = l >> 3; int rank = 0;
#pragma unroll
    for (int gg = 0; gg < 8; ++gg) { const float og = readlane_f(gs, gg * 8); rank += (og > gs || (og == gs && gg < g)) ? 1 : 0; }
    const bool sel = rank < 4;
    unsigned cv[4];
#pragma unroll
    for (int k = 0; k < 4; ++k) cv[k] = sel ? fkey(bs[k]) : 0u;
    float sum = 0.f, mysc = 0.f; myexp = 0;
#pragma unroll
    for (int r = 0; r < TOPK; ++r) {
        unsigned bvk = cv[0]; int bk = 0;
#pragma unroll
        for (int k = 1; k < 4; ++k) if (cv[k] > bvk) { bvk = cv[k]; bk = k; }
        const float bsc = bk == 0 ? sc[0] : bk == 1 ? sc[1] : bk == 2 ? sc[2] : sc[3];
        unsigned m = bvk;
        m = umax_(m, dpp_u<0xB1>(m)); m = umax_(m, dpp_u<0x4E>(m)); m = umax_(m, dpp_u<0x124>(m)); m = umax_(m, dpp_u<0x128>(m));
        const unsigned M = umax_(umax_((unsigned)__builtin_amdgcn_readlane((int)m, 0), (unsigned)__builtin_amdgcn_readlane((int)m, 16)),
                                 umax_((unsigned)__builtin_amdgcn_readlane((int)m, 32), (unsigned)__builtin_amdgcn_readlane((int)m, 48)));
        const unsigned long long bal = __ballot(bvk == M);
        const int L = __builtin_ctzll(bal);
        const int kL = __builtin_amdgcn_readlane(bk, L);
        const float se = readlane_f(bsc, L);
        const int e = 4 * L + kL;
        if (l == L) {
#pragma unroll
            for (int k = 0; k < 4; ++k) if (k == bk) cv[k] = 0u; }
        sum += se; if (l == r) { myexp = e; mysc = se; }
    }
    gate = mysc * rcpf_(sum) * 2.5f;
}
DI int mbcnt64(unsigned long long m) { return (int)__builtin_amdgcn_mbcnt_hi((unsigned)(m >> 32), __builtin_amdgcn_mbcnt_lo((unsigned)m, 0u)); }
DI void route_store(const f32x4 lg, const f32x4 rbv, const int l, const int tok, v2u* ROUTE, LAS unsigned* hist) {
    const float NEG = -__builtin_inff();
    float sc[4], bs[4];
#pragma unroll
    for (int k = 0; k < 4; ++k) { sc[k] = rcpf_(1.0f + expf_(-lg[k])); bs[k] = sc[k] + rbv[k]; }
    float m1 = NEG, m2 = NEG;
#pragma unroll
    for (int k = 0; k < 4; ++k) { const float v = bs[k]; if (v > m1) { m2 = m1; m1 = v; } else if (v > m2) m2 = v; }
    { float o1 = dpp_f<0xB1>(m1), o2 = dpp_f<0xB1>(m2); float n1 = fmaxf(m1, o1), n2 = fmaxf(fminf(m1, o1), fmaxf(m2, o2)); m1 = n1; m2 = n2;
      o1 = dpp_f<0x4E>(m1); o2 = dpp_f<0x4E>(m2); n1 = fmaxf(m1, o1); n2 = fmaxf(fminf(m1, o1), fmaxf(m2, o2)); m1 = n1; m2 = n2;
      const float a1 = dpp_f<0x104>(m1), a2 = dpp_f<0x104>(m2), c1 = dpp_f<0x114>(m1), c2 = dpp_f<0x114>(m2);
      o1 = (l & 4) ? c1 : a1; o2 = (l & 4) ? c2 : a2; n1 = fmaxf(m1, o1); n2 = fmaxf(fminf(m1, o1), fmaxf(m2, o2)); m1 = n1; m2 = n2; }
    const float gs = m1 + m2; const int g = l >> 3; int rank = 0;
#pragma unroll
    for (int gg = 0; gg < 8; ++gg) { const float og = readlane_f(gs, gg * 8); rank += (og > gs || (og == gs && gg < g)) ? 1 : 0; }
    const bool sel = rank < 4;
    unsigned key[4];
#pragma unroll
    for (int k = 0; k < 4; ++k) key[k] = sel ? fkey(bs[k]) : 0u;
    unsigned T = 0u; bool exact = false;
    auto cnt_ge = [&](unsigned x) -> int { return __popcll(__ballot(key[0] >= x)) + __popcll(__ballot(key[1] >= x)) + __popcll(__ballot(key[2] >= x)) + __popcll(__ballot(key[3] >= x)); };
#pragma unroll 1
    for (int bit = 30; bit >= 0; bit -= 2) {
        const unsigned c3 = T | (3u << bit), c2 = T | (2u << bit), c1 = T | (1u << bit);
        const int n3 = cnt_ge(c3), n2 = cnt_ge(c2), n1 = cnt_ge(c1);
        const int n = n3 >= TOPK ? n3 : n2 >= TOPK ? n2 : n1;
        if (n >= TOPK) { T = n3 >= TOPK ? c3 : n2 >= TOPK ? c2 : c1; if (n == TOPK) { exact = true; break; } }
    }
    bool s[4];
    if (exact) {
#pragma unroll
        for (int k = 0; k < 4; ++k) s[k] = key[k] >= T;
    } else {
        int ngt = 0, below = 0;
#pragma unroll
        for (int k = 0; k < 4; ++k) { ngt += __popcll(__ballot(key[k] > T)); below += mbcnt64(__ballot(key[k] == T)); }
        const int m = TOPK - ngt; int own = 0;
#pragma unroll
        for (int k = 0; k < 4; ++k) { const bool eq = key[k] == T; s[k] = (key[k] > T) || (eq && (below + own) < m); own += eq ? 1 : 0; }
    }
    int slot = 0; float part = 0.f;
#pragma unroll
    for (int k = 0; k < 4; ++k) { slot += mbcnt64(__ballot(s[k])); part += s[k] ? sc[k] : 0.f; }
    const float inv = rcpf_(wave_sum_fast(part)) * 2.5f;
#pragma unroll
    for (int k = 0; k < 4; ++k) {
        if (s[k]) { const int e = 4 * l + k;
            ROUTE[(size_t)tok * TOPK + slot] = (v2u){(unsigned)e, __float_as_uint(sc[k] * inv)};
            (void)__hip_atomic_fetch_add(hist + e, 1u, __ATOMIC_RELAXED, __HIP_MEMORY_SCOPE_WORKGROUP); }
        slot += s[k] ? 1 : 0; }
}
constexpr int NR_XS = 520, NR_LS = 260, NR_HIST = 133120, NR_RS = NR_HIST + 1024;
static_assert(128 * NR_XS * 2 <= NR_HIST && 128 * NR_LS * 4 <= NR_HIST && NR_RS + 512 <= LDS_MISC, "norm/route lds");
DI void nr_gemm_half(f32x4 (&acc)[8][2], const LAS bf16* xa, const bf16* wb0, const bf16* wb1, const int ch0) {
    bf16x8 B0[4][2], B1[4][2];
#define NRG_LD(B, ch) do { _Pragma("unroll") for (int q = 0; q < 4; ++q) { B[q][0] = *(const bf16x8*)(wb0 + 128 * (ch) + 32 * q); B[q][1] = *(const bf16x8*)(wb1 + 128 * (ch) + 32 * q); } } while (0)
#define NRG_MM(B, cc) do { const LAS bf16* xc = xa + 128 * (cc); _Pragma("unroll") for (int q = 0; q < 4; ++q) { _Pragma("unroll") for (int tt = 0; tt < 8; ++tt) { \
            const bf16x8 A = *(const LAS bf16x8*)(xc + 16 * tt * NR_XS + 32 * q); \
            acc[tt][0] = __builtin_amdgcn_mfma_f32_16x16x32_bf16(A, B[q][0], acc[tt][0], 0, 0, 0); acc[tt][1] = __builtin_amdgcn_mfma_f32_16x16x32_bf16(A, B[q][1], acc[tt][1], 0, 0, 0); } } } while (0)
    NRG_LD(B0, ch0);
#pragma unroll 1
    for (int c2 = 0; c2 < 2; ++c2) {
        NRG_LD(B1, ch0 + 2 * c2 + 1);
        NRG_MM(B0, 2 * c2);
        NRG_LD(B0, ch0 + (c2 == 0 ? 2 : 3));
        NRG_MM(B1, 2 * c2 + 1);
    }
#undef NRG_LD
#undef NRG_MM
}
DI void phase_norm_route(const Frame& F) {
    const float* MOD = (const float*)(F.ws + WS_MOD); const float* gain = F.in[I_NFFN];
    const bf16* X1b = (const bf16*)(F.ws + WS_X1); const bf16* WR = (const bf16*)(F.ws + WS_WR);
    v2u* ROUTE = (v2u*)(F.ws + WS_ROUTE); int* HIST = (int*)(F.ws + WS_HIST);
    LAS bf16* XT = (LAS bf16*)F.lds; LAS float* LG = (LAS float*)F.lds; LAS unsigned* hist = (LAS unsigned*)(F.lds + NR_HIST); LAS float* RS = (LAS float*)(F.lds + NR_RS);
    const int l = F.lane, w = F.wave, fr = l & 15, g = l >> 4;
    const f32x4 rbv = *(const f32x4*)(F.in[I_RB] + 4 * l);
    for (int blk = F.bx; blk < NTOK / 128; blk += F.G) {
        if (F.tid < 256) hist[F.tid] = 0u;
        const int b = (blk * 128) >> 11;
        const int tok0 = blk * 128;
        { f32x4 ga[4], sb4[4];
#pragma unroll
            for (int j = 0; j < 4; ++j) { const int c = 4 * l + 256 * j; ga[j] = *(const f32x4*)(gain + c) * (*(const f32x4*)(MOD + b * 6144 + 4096 + c) + 1.0f); sb4[j] = *(const f32x4*)(MOD + b * 6144 + 3072 + c); }
            v2u xr[2][4];
#pragma unroll
            for (int q = 0; q < 2; ++q)
#pragma unroll
                for (int j = 0; j < 4; ++j) xr[q][j] = *(const v2u*)(X1b + (size_t)(tok0 + 16 * w + q) * D + 4 * l + 256 * j);
#pragma unroll 1
            for (int rr = 0; rr < 16; rr += 2) { const int row = 16 * w + rr; const size_t m = (size_t)(tok0 + row);
                f32x4 v[2][4]; float ss[2] = {0.f, 0.f};
#pragma unroll
                for (int q = 0; q < 2; ++q)
#pragma unroll
                    for (int j = 0; j < 4; ++j) { v[q][j] = (f32x4){bflo(xr[q][j].x), bfhi(xr[q][j].x), bflo(xr[q][j].y), bfhi(xr[q][j].y)};
                        ss[q] += (v[q][j].x * v[q][j].x + v[q][j].y * v[q][j].y) + (v[q][j].z * v[q][j].z + v[q][j].w * v[q][j].w); }
                { const size_t mn = (rr + 2 < 16) ? m + 2 : m;
#pragma unroll
                    for (int q = 0; q < 2; ++q)
#pragma unroll
                        for (int j = 0; j < 4; ++j) xr[q][j] = *(const v2u*)(X1b + (mn + q) * D + 4 * l + 256 * j); }
                const float rs0 = rsqrtf(wave_sum_fast(ss[0]) * (1.0f / D) + EPS), rs1 = rsqrtf(wave_sum_fast(ss[1]) * (1.0f / D) + EPS);
                if (l == 0) { RS[row] = rs0; RS[row + 1] = rs1; }
#pragma unroll
                for (int q = 0; q < 2; ++q)
#pragma unroll
                    for (int j = 0; j < 4; ++j) { const int c = 4 * l + 256 * j; const f32x4 y = (v[q][j] * (q ? rs1 : rs0)) * ga[j] + sb4[j];
                        if (j < 2) *(LAS v2u*)(XT + (row + q) * NR_XS + c) = (v2u){pk2(y.x, y.y), pk2(y.z, y.w)};
                        *(unsigned*)(F.ws + WS_HX2F + (m + q) * D + c) = pk4_f8(y.x, y.y, y.z, y.w); } } }
        __syncthreads();
        f32x4 acc[8][2];
#pragma unroll
        for (int tt = 0; tt < 8; ++tt) { acc[tt][0] = (f32x4){0.f, 0.f, 0.f, 0.f}; acc[tt][1] = (f32x4){0.f, 0.f, 0.f, 0.f}; }
        const bf16* wb0 = WR + (size_t)(32 * w + fr) * D + 8 * g; const bf16* wb1 = wb0 + (size_t)16 * D;
        const LAS bf16* xa = XT + fr * NR_XS + 8 * g;
        nr_gemm_half(acc, xa, wb0, wb1, 0);
        __syncthreads();
        { f32x4 ga[2], sb4[2];
#pragma unroll
            for (int j = 0; j < 2; ++j) { const int c = 512 + 4 * l + 256 * j; ga[j] = *(const f32x4*)(gain + c) * (*(const f32x4*)(MOD + b * 6144 + 4096 + c) + 1.0f); sb4[j] = *(const f32x4*)(MOD + b * 6144 + 3072 + c); }
            v2u xr[2][2];
#pragma unroll
            for (int q = 0; q < 2; ++q)
#pragma unroll
                for (int j = 0; j < 2; ++j) xr[q][j] = *(const v2u*)(X1b + (size_t)(tok0 + 16 * w + q) * D + 512 + 4 * l + 256 * j);
#pragma unroll 1
            for (int rr = 0; rr < 16; rr += 2) { const int row = 16 * w + rr; const size_t m = (size_t)(tok0 + row);
                f32x4 v[2][2];
#pragma unroll
                for (int q = 0; q < 2; ++q)
#pragma unroll
                    for (int j = 0; j < 2; ++j) v[q][j] = (f32x4){bflo(xr[q][j].x), bfhi(xr[q][j].x), bflo(xr[q][j].y), bfhi(xr[q][j].y)};
                { const size_t mn = (rr + 2 < 16) ? m + 2 : m;
#pragma unroll
                    for (int q = 0; q < 2; ++q)
#pragma unroll
                        for (int j = 0; j < 2; ++j) xr[q][j] = *(const v2u*)(X1b + (mn + q) * D + 512 + 4 * l + 256 * j); }
                const float rs0 = RS[row], rs1 = RS[row + 1];
#pragma unroll
                for (int q = 0; q < 2; ++q)
#pragma unroll
                    for (int j = 0; j < 2; ++j) { const int c = 4 * l + 256 * j; const f32x4 y = (v[q][j] * (q ? rs1 : rs0)) * ga[j] + sb4[j];
                        *(LAS v2u*)(XT + (row + q) * NR_XS + c) = (v2u){pk2(y.x, y.y), pk2(y.z, y.w)}; } } }
        __syncthreads();
        nr_gemm_half(acc, xa, wb0, wb1, 4);
        __syncthreads();
#pragma unroll
        for (int tt = 0; tt < 8; ++tt)
#pragma unroll
            for (int eb = 0; eb < 2; ++eb)
#pragma unroll
                for (int r = 0; r < 4; ++r) LG[(16 * tt + 4 * g + r) * NR_LS + 32 * w + 16 * eb + fr] = acc[tt][eb][r];
        __syncthreads();
#pragma unroll 1
        for (int ti = 0; ti < 16; ti += 2) { const int row = 16 * w + ti, tok = tok0 + row;
            const f32x4 lgA = *(const LAS f32x4*)(LG + row * NR_LS + 4 * l), lgB = *(const LAS f32x4*)(LG + (row + 1) * NR_LS + 4 * l);
            route_store(lgA, rbv, l, tok, ROUTE, hist); route_store(lgB, rbv, l, tok + 1, ROUTE, hist); }
        __syncthreads();
        if (F.tid < 256) HIST[blk * 256 + F.tid] = (int)hist[F.tid];
        __syncthreads();
    }
}
DI void tile_starts(const Frame& F, int c, LAS int* ts) {
    const int own = (c + 255) >> 8; int incl = own;
    if (F.tid < 256) {
#pragma unroll
        for (int o = 1; o < 64; o <<= 1) { const int v = __shfl_up(incl, o); if (F.lane >= o) incl += v; }
        if (F.lane == 63) ts[257 + F.wave] = incl;
    }
    __syncthreads();
    if (F.tid < 256) { int off = 0;
#pragma unroll
        for (int w = 0; w < 3; ++w) off += (w < F.wave) ? ts[257 + w] : 0;
        ts[F.tid] = off + incl - own;
        if (F.tid == 255) ts[256] = off + incl; }
    __syncthreads();
}
DI void phase_lists(const Frame& F0) {
    Frame F = F0; asm volatile("" : "+v"(F.tid)); F.lane = F.tid & 63;
    const v2u* ROUTE = (const v2u*)(F.ws + WS_ROUTE); const int* HIST = (const int*)(F.ws + WS_HIST);
    unsigned* cnt = (unsigned*)(F.ws + WS_CTL) + CW_CNT; v2u* LIST = (v2u*)(F.ws + WS_LIST);
    LAS int* part = (LAS int*)F.lds;
    LAS int* lbase = part + 4096; LAS unsigned* lcnt = (LAS unsigned*)(lbase + 256); LAS int* lts = lbase + 768;
    int* INV = (int*)(F.ws + WS_INV);
    typedef int v4i_ __attribute__((ext_vector_type(4)));
    for (int blk = F.bx; blk < NTOK / 128; blk += F.G) {
        const int e = F.tid & 255, e4 = (F.tid & 63) * 4, g = F.tid >> 6;
        v4i_ below = (v4i_){0, 0, 0, 0}, all = (v4i_){0, 0, 0, 0};
#pragma unroll 8
        for (int q = 0; q < 32; ++q) { const int row = g * 32 + q; const v4i_ v = *(const v4i_*)(HIST + row * 256 + e4); all += v; if (row < blk) below += v; }
        *(LAS v4i_*)(part + g * 512 + e4) = below; *(LAS v4i_*)(part + g * 512 + 256 + e4) = all;
        __syncthreads();
        int tot = 0;
        if (F.tid < 256) { int b = 0;
#pragma unroll
            for (int q = 0; q < 8; ++q) { b += part[q * 512 + e]; tot += part[q * 512 + 256 + e]; }
            lbase[e] = b; lcnt[e] = 0u; if (blk == 0) cnt[e] = (unsigned)tot; }
        tile_starts(F, tot, lts);
#pragma unroll
        for (int q = 0; q < 2; ++q) { const int a = F.tid + q * NTHR; const unsigned tk = (unsigned)(blk * 128 * TOPK + a);
            const v2u rt = ROUTE[tk]; const unsigned pos = (unsigned)lbase[rt.x] + __hip_atomic_fetch_add(lcnt + rt.x, 1u, __ATOMIC_RELAXED, __HIP_MEMORY_SCOPE_WORKGROUP);
            LIST[(size_t)rt.x * LISTCAP + pos] = (v2u){tk, rt.y}; INV[tk] = lts[rt.x] * 256 + (int)pos; }
        __syncthreads();
    }
}

template <bool GATHER> DI void moe_setup(const Frame& F0, int ncol, int& nunits, int& nfull) {
    Frame F = F0; asm volatile("" : "+v"(F.tid)); F.lane = F.tid & 63;
    LAS int* ts = (LAS int*)(F.lds + LDS_TS); LAS int* cl = (LAS int*)(F.lds + LDS_CNT); LAS int* ut = (LAS int*)(F.lds + LDS_UT); LAS int* idx = (LAS int*)(F.lds + LDS_IDX);
    const unsigned* cnt = (const unsigned*)(F.ws + WS_CTL) + CW_CNT;
    int c = 0; if (F.tid < 256) { c = (int)__hip_atomic_load(cnt + F.tid, __ATOMIC_RELAXED, __HIP_MEMORY_SCOPE_AGENT); cl[F.tid] = c; }
    tile_starts(F, c, ts);
    const int Te = ts[256], T = Te + NTOK / 256;
    const int Fr = T / F.G, R = T - Fr * F.G, LU = R * ncol;
    const int nleft = (LU > F.vcu) ? (LU - F.vcu + F.G - 1) / F.G : 0;
    nfull = Fr * ncol; nunits = nfull + nleft;
    const int nj = (Fr + nleft) < 10 ? (Fr + nleft) : 10;
    if (F.tid < nj) { const int j = F.tid;
        int rt, pnl = 0;
        if (j < Fr) rt = j * F.G + F.vcu; else { const int lu = (j - Fr) * F.G + F.vcu; rt = Fr * F.G + lu / ncol; pnl = lu % ncol; }
        int e, pm, nrows;
        if (rt >= Te) { e = 256; pm = rt - Te; nrows = 256; }
        else { int lo = 0, hi = 256; while (hi - lo > 1) { const int mid = (lo + hi) >> 1; if (ts[mid] <= rt) lo = mid; else hi = mid; }
            e = lo; pm = rt - ts[lo]; const int rem = cl[lo] - pm * 256; nrows = rem < 256 ? rem : 256; }
        *(LAS v4u*)(ut + 4 * j) = (v4u){(unsigned)e, (unsigned)pm, (unsigned)rt, (unsigned)nrows | ((unsigned)pnl << 16)}; }
    __syncthreads();
    const v2u* LIST = (const v2u*)(F.ws + WS_LIST);
    v2u lv[5];
#pragma unroll
    for (int q = 0; q < 5; ++q) { const int j = 2 * q + (F.tid >> 8), r = F.tid & 255; const int jc = j < nj ? j : 0;
        const v4u t = *(const LAS v4u*)(ut + 4 * jc); const int e = (int)t.x, pm = (int)t.y, nrows = (int)(t.w & 0xffffu);
        lv[q] = LIST[(size_t)(e & 255) * LISTCAP + pm * 256 + (r < nrows ? r : 0)]; }
#pragma unroll
    for (int q = 0; q < 5; ++q) { const int j = 2 * q + (F.tid >> 8), r = F.tid & 255;
        if (j < nj) { const v4u t = *(const LAS v4u*)(ut + 4 * j); const int e = (int)t.x, pm = (int)t.y, nrows = (int)(t.w & 0xffffu);
            if (GATHER) idx[j * 256 + r] = (e == 256) ? pm * 256 + r : (r < nrows ? (int)(lv[q].x >> 3) : 0);
            else ((LAS float*)idx)[j * 256 + r] = (e == 256) ? 1.0f : (r < nrows ? __uint_as_float(lv[q].y) : 0.0f); } }
    __syncthreads();
}

DI void phase_combine(const Frame& F0, int mode) {
    Frame F = F0; F.lane = (int)__builtin_amdgcn_mbcnt_hi(~0u, __builtin_amdgcn_mbcnt_lo(~0u, 0u)); asm volatile("" : "+v"(F.lane));
    const float* MOD = (const float*)(F.ws + WS_MOD);
    const unsigned char* YE = F.ws + WS_YE; const int* INV = (const int*)(F.ws + WS_INV);
    int Te = 0; if (mode == 0) { const unsigned* cnt = (const unsigned*)(F.ws + WS_CTL) + CW_CNT; int t4 = 0;
#pragma unroll
        for (int q = 0; q < 4; ++q) t4 += (int)((cnt[F.lane + 64 * q] + 255u) >> 8);
#pragma unroll
        for (int o = 1; o < 64; o <<= 1) t4 += __shfl_xor(t4, o);
        Te = __builtin_amdgcn_readfirstlane(t4); }
    const int gw = F.bx * NWAVES + F.wave, NGW = F.G * NWAVES;
    const float* nf = F.in[I_NFIN];
    const int c = 16 * F.lane;
    for (int m = gw; m < NTOK; m += NGW) {
        const int b = m >> 11;
        float s[16];
#pragma unroll
        for (int q = 0; q < 16; ++q) s[q] = 0.f;
        const bf16* xsrc = (const bf16*)(F.ws + WS_X1);
        if (mode == 0) {
#pragma unroll
            for (int k = 0; k < 9; ++k) { const int row = (k < 8) ? INV[m * TOPK + k] : Te * 256 + m; const v4u w = *(const v4u*)(YE + (size_t)row * D + c);
                const unsigned ww[4] = {w.x, w.y, w.z, w.w};
#pragma unroll
                for (int q = 0; q < 4; ++q) { const f32x2 lo = __builtin_amdgcn_cvt_pk_f32_fp8((int)ww[q], false), hi = __builtin_amdgcn_cvt_pk_f32_fp8((int)ww[q], true);
                    s[4 * q] += lo.x; s[4 * q + 1] += lo.y; s[4 * q + 2] += hi.x; s[4 * q + 3] += hi.y; } } }
        float x2[16]; float ss = 0.f;
#pragma unroll
        for (int q = 0; q < 4; ++q) { const v2u xt = *(const v2u*)(xsrc + (size_t)m * D + c + 4 * q); const f32x4 xa = {bflo(xt.x), bfhi(xt.x), bflo(xt.y), bfhi(xt.y)}, ga = *(const f32x4*)(MOD + b * 6144 + 5120 + c + 4 * q);
#pragma unroll
            for (int j = 0; j < 4; ++j) { const float v = xa[j] + ga[j] * (s[4 * q + j] * 0.015625f); x2[4 * q + j] = v; ss += v * v; } }
        const float rs = rsqrtf(wave_sum(ss) * (1.0f / D) + EPS);
#pragma unroll
        for (int q = 0; q < 4; ++q) { const f32x4 na = *(const f32x4*)(nf + c + 4 * q);
            f32x4 oa = {x2[4 * q] * rs * na.x, x2[4 * q + 1] * rs * na.y, x2[4 * q + 2] * rs * na.z, x2[4 * q + 3] * rs * na.w};
            *(f32x4*)(F.out + (size_t)m * D + c + 4 * q) = oa; }
    }
}

constexpr int NPHASE = 12;
__global__ void __launch_bounds__(NTHR, 2) fwd_kernel(Args args) {
    extern __shared__ __attribute__((aligned(16))) unsigned char lds_raw[];
    Frame F;
    F.lds = (LAS unsigned char*)lds_raw;
    F.tid = threadIdx.x; F.lane = F.tid & 63; F.wave = __builtin_amdgcn_readfirstlane(F.tid >> 6);
    F.G = gridDim.x; F.bx = blockIdx.x; F.vcu = (F.G % 8 == 0) ? (F.bx % 8) * (F.G / 8) + F.bx / 8 : F.bx;
    F.in = args.in; F.out = args.out; F.ws = args.ws;
    volatile LAS unsigned* MISC = (volatile LAS unsigned*)(F.lds + LDS_MISC);
    if (F.tid < 16) MISC[F.tid] = 0u;
    __syncthreads();
    XcdBarrier bar; bar.bar = (unsigned*)(F.ws + WS_CTL) + CW_BAR; bar.x = 0; bar.st = nullptr;
#if !PER_PHASE_LAUNCH
    bar = xcd_barrier_post((unsigned*)(F.ws + WS_CTL) + CW_BAR, MISC + 8);
#define GRID_BAR() xcd_barrier(bar)
#else
#define GRID_BAR() do {} while (0)
#endif
    const int lo = args.ph_lo, hi = args.ph_hi;
#ifndef PH_MASK
#define PH_MASK 0xFFFF
#endif
#define IN(k) (((PH_MASK >> (k)) & 1) && lo <= (k) && (k) < hi)
#ifndef PROBE_PH
#define PROBE_PH -1
#endif
#ifndef PROBE_MULT
#define PROBE_MULT 4
#endif
    volatile LAS unsigned long long* PRT = (volatile LAS unsigned long long*)(F.lds + LDS_MISC);
    if (PROBE_PH == 0 && F.wave == 0) PRT[0] = __builtin_amdgcn_s_memrealtime();
#define SEAM(k) do { if (IN(k) && IN((k) + 1)) GRID_BAR(); \
        if (PROBE_PH >= 0 && F.wave == 0) { if ((k) == PROBE_PH - 1) PRT[0] = __builtin_amdgcn_s_memrealtime(); if ((k) == PROBE_PH) PRT[1] = __builtin_amdgcn_s_memrealtime(); } } while (0)
#ifndef REPEAT_MASK
#define REPEAT_MASK 0
#endif
#define REPS(k) (1 + ((REPEAT_MASK >> (k)) & 1))
    unsigned char* ws = F.ws;

    if (IN(0)) _Pragma("unroll 1") for (int rep = 0; rep < REPS(0); ++rep) { if (rep) GRID_BAR(); phase_prologue(F); } SEAM(0);
    if (IN(1)) _Pragma("unroll 1") for (int rep = 0; rep < REPS(1); ++rep) { if (rep) GRID_BAR(); phase_norm_rows(F, 0); } SEAM(1);
    if (IN(2)) _Pragma("unroll 1") for (int rep = 0; rep < REPS(2); ++rep) { if (rep) GRID_BAR();
        unsigned* done2 = (unsigned*)(ws + WS_CTL) + CW_P2DONE;
        const int G2 = (F.G >= 256) ? 224 : F.G;
        if (F.bx < G2) {
            { pg8::DenseOrder S; S.init(ws + WS_HX, ws + WS_WIN, MTOT, INP_C0 * 256, D, G2, F.bx);
              pg8::EpiInProj E{(bf16*)(ws + WS_P), (const float*)(ws + WS_TAB), 0, 1.0f};
              pg8::gemm_phase(F.lds, D, S, E, F.wave); }
            { pg8::DenseOrder S; S.init(ws + WS_HX8, ws + WS_WIN8 + (size_t)INP_C0 * 256 * 1024, MTOT, INC - INP_C0 * 256, D / 2, G2, F.bx, (MTOT / 256) * INP_C0);
              pg8::EpiInProj E{(bf16*)(ws + WS_P), (const float*)(ws + WS_TAB), INP_C0, 0.03125f};
              pg8::gemm_phase<pg8::EpiInProj, pg8::DenseOrder, false, true>(F.lds, D / 2, S, E, F.wave); }
            if (F.tid == 0) __hip_atomic_fetch_add(done2, 1u, __ATOMIC_RELAXED, __HIP_MEMORY_SCOPE_AGENT);
        } else convert_experts(F, done2, 1u);
    } SEAM(2);
    if (IN(3)) _Pragma("unroll 1") for (int rep = 0; rep < REPS(3); ++rep) { if (rep) GRID_BAR(); phase_lru_pass1(F); } SEAM(3);
    if (IN(4)) _Pragma("unroll 1") for (int rep = 0; rep < REPS(4); ++rep) { if (rep) GRID_BAR(); phase_lru_carry(F);
#if defined(PROBE_SUB)
        if (F.wave == 0 && PROBE_SUB == 0) PRT[0] = __builtin_amdgcn_s_memrealtime();
#endif
        if (F.bx < NB * 4 * 2) hgrn_chain2(F, F.bx);
#if defined(PROBE_SUB)
        if (F.wave == 0) { if (PROBE_SUB == 0) PRT[1] = __builtin_amdgcn_s_memrealtime(); else if (PROBE_SUB == 1) PRT[0] = __builtin_amdgcn_s_memrealtime(); }
#endif
        convert_experts(F, nullptr, 0u);
#if defined(PROBE_SUB)
        if (F.wave == 0 && PROBE_SUB == 1) PRT[1] = __builtin_amdgcn_s_memrealtime();
#endif
        } SEAM(4);
    if (IN(5)) _Pragma("unroll 1") for (int rep = 0; rep < REPS(5); ++rep) { if (rep) GRID_BAR(); phase_y2(F); } SEAM(5);
    if (IN(6)) _Pragma("unroll 1") for (int rep = 0; rep < REPS(6); ++rep) { if (rep) GRID_BAR();
        pg8::DenseOrder S; S.init(ws + WS_YL, ws + WS_WOUT, NTOK, D, D, F.G, F.bx);
        pg8::EpiResid E{F.in[I_X], (const float*)(ws + WS_MOD), (bf16*)(ws + WS_X1)};
        pg8::gemm_phase(F.lds, D, S, E, F.wave);
    } SEAM(6);
    if (IN(7)) _Pragma("unroll 1") for (int rep = 0; rep < REPS(7); ++rep) { if (rep) GRID_BAR(); phase_norm_route(F); } SEAM(7);
    if (IN(8)) _Pragma("unroll 1") for (int rep = 0; rep < REPS(8); ++rep) { if (rep) GRID_BAR(); phase_lists(F); } SEAM(8);
    if (IN(9)) _Pragma("unroll 1") for (int rep = 0; rep < REPS(9); ++rep) { if (rep) GRID_BAR();
        int total, nfull; moe_setup<true>(F, 2, total, nfull);
        pg8::MoeOrder<true> S; S.A = (const char*)(ws + WS_HX2F); S.Bt = (const char*)(ws + WS_EW13); S.BtS = (const char*)(ws + WS_SW13); S.K = D / 2; S.ncol = 2; S.estride = (size_t)512 * 1024; S.dump = nullptr;
        S.ut = (const LAS int*)(F.lds + LDS_UT); S.idx = (const LAS int*)(F.lds + LDS_IDX); S.nunits = total; S.nfull = nfull;
        pg8::EpiSwiGLU8 E{ws + WS_ACT};
        pg8::gemm_phase<pg8::EpiSwiGLU8, pg8::MoeOrder<true>, false, true>(F.lds, D / 2, S, E, F.wave);
    } SEAM(9);
    if (IN(10)) _Pragma("unroll 1") for (int rep = 0; rep < REPS(10); ++rep) { if (rep) GRID_BAR();
        int total, nfull; moe_setup<false>(F, 4, total, nfull);
        pg8::MoeOrder<false> S; S.A = (const char*)(ws + WS_ACT); S.Bt = (const char*)(ws + WS_EW2); S.BtS = (const char*)(ws + WS_SW2); S.K = DE / 2; S.ncol = 4; S.estride = (size_t)1024 * 256; S.dump = (const char*)(ws + WS_CTL + 0x80000 + F.bx * 256);
        S.ut = (const LAS int*)(F.lds + LDS_UT); S.idx = (const LAS int*)(F.lds + LDS_IDX); S.nunits = total; S.nfull = nfull;
        pg8::EpiScatter E{ws + WS_YE, (const LAS float*)(F.lds + LDS_IDX), 0.5f};
#if defined(PROBE_GEMM)
        pg8::GProf gp{0ull, 0ull, 0ull};
        pg8::gemm_phase<pg8::EpiScatter, pg8::MoeOrder<false>, true, true, true>(F.lds, DE / 2, S, E, F.wave, &gp);
        if (F.wave == 0) { PRT[0] = 0ull; PRT[1] = (PROBE_GEMM == 0) ? gp.t_loop : (PROBE_GEMM == 1) ? gp.t_epi : gp.t_next; }
#else
        pg8::gemm_phase<pg8::EpiScatter, pg8::MoeOrder<false>, false, true, true>(F.lds, DE / 2, S, E, F.wave);
#endif
    } SEAM(10);
    if (IN(11)) _Pragma("unroll 1") for (int rep = 0; rep < REPS(11); ++rep) { if (rep) GRID_BAR(); phase_combine(F, 0); }
#if defined(PROBE_GEMM) || defined(PROBE_SUB)
    if (F.bx == 0 && F.wave == 0) {
#else
    if (PROBE_PH >= 0 && F.bx == 0 && F.wave == 0) {
#endif
        const unsigned long long te = __builtin_amdgcn_s_memrealtime(); if (PROBE_PH == NPHASE - 1) PRT[1] = te;
        const unsigned long long target = (unsigned long long)PROBE_MULT * (PRT[1] - PRT[0]);
        while (__builtin_amdgcn_s_memrealtime() - te < target) __builtin_amdgcn_s_sleep(20);
    }
}

extern "C" void kernel_launch(void* const* d_in, const int* in_sizes, int n_in, void* d_out, int out_size, void* d_ws, size_t ws_size, hipStream_t stream) {
    static int grid = 0;
    if (grid == 0) {
        if (n_in != 26 || in_sizes[0] != NTOK * D || out_size != NTOK * D || ws_size < WS_END) { fprintf(stderr, "kernel_launch: unexpected shapes (n_in %d, ws %zu)\n", n_in, ws_size); grid = -1; return; }
        int dev = 0, cus = 0, per_cu = 0;
        if (hipGetDevice(&dev) != hipSuccess || hipDeviceGetAttribute(&cus, hipDeviceAttributeMultiprocessorCount, dev) != hipSuccess) { grid = -1; return; }
        if (hipFuncSetAttribute((const void*)fwd_kernel, hipFuncAttributeMaxDynamicSharedMemorySize, LDS_BYTES) != hipSuccess) { fprintf(stderr, "kernel_launch: hipFuncSetAttribute failed\n"); grid = -1; return; }
        if (hipOccupancyMaxActiveBlocksPerMultiprocessor(&per_cu, (const void*)fwd_kernel, NTHR, LDS_BYTES) != hipSuccess || per_cu < 1) { fprintf(stderr, "kernel_launch: occupancy query says %d\n", per_cu); }
        (void)hipGetLastError();
        grid = cus;
        if (grid < 128) { fprintf(stderr, "kernel_launch: needs >= 128 CUs (HGRN2 chains run one per workgroup)\n"); grid = -1; return; }
    }
    if (grid < 0) return;
    hipMemsetAsync((char*)d_ws + WS_CTL, 0, CTL_ZERO_BYTES, stream);
    Args a{};
    for (int i = 0; i < 26; ++i) a.in[i] = (const float*)d_in[i];
    a.out = (float*)d_out; a.ws = (unsigned char*)d_ws;
#if PER_PHASE_LAUNCH
    for (int p = 0; p < NPHASE; ++p) { a.ph_lo = p; a.ph_hi = p + 1; hipLaunchKernelGGL(fwd_kernel, dim3(grid), dim3(NTHR), LDS_BYTES, stream, a); }
#else
    a.ph_lo = 0; a.ph_hi = NPHASE;
    hipLaunchKernelGGL(fwd_kernel, dim3(grid), dim3(NTHR), LDS_BYTES, stream, a);
#endif
}
```
